# Optimizing an MI355X kernel written in HIP

```python
import functools
import jax, jax.numpy as jnp
from jax import lax
import numpy as np

D_MODEL = 1024
BATCH = 4
SEQ = 4096
DEPTH = 2
DEC_BATCH = 128
DEC_SEQ = 8
PAST_LEN = 8192
PAGE_SIZE = 128

N_EVEN = (DEPTH + 1) // 2
N_ODD = DEPTH // 2
POOL_WINDOWS = (2, 4, 8, 16)
POOL_GROUPS = len(POOL_WINDOWS)
POOL_GROUP_DIM = 128
POOL_DIM = POOL_GROUPS * POOL_GROUP_DIM
POOL_HIST = max(POOL_WINDOWS) - 1
N_HEADS = 8
QK_NOPE_DIM = 64
QK_ROPE_DIM = 32
QK_HEAD_DIM = QK_NOPE_DIM + QK_ROPE_DIM
V_HEAD_DIM = 64
KV_RANK = 256
Q_DIM = N_HEADS * QK_HEAD_DIM
ATTN_OUT_DIM = N_HEADS * V_HEAD_DIM
ROPE_BASE = 10000.0
SOFTMAX_SCALE = QK_HEAD_DIM ** -0.5
Q_BLOCK = 128
IN_EVEN_DIM = POOL_DIM + Q_DIM + KV_RANK + QK_ROPE_DIM
MIX_DIM = POOL_DIM + ATTN_OUT_DIM
RNN_DIM = D_MODEL
RNN_BLOCKS = 8
RNN_BLOCK_DIM = RNN_DIM // RNN_BLOCKS
CONV_WIDTH = 4
LRU_C = 8.0
D_FF = 4 * D_MODEL
NORM_EPS = 1e-6

kernel_name = 'hybrid_pool_mla_rglru_decode_step'


def rms_norm(x, g):
    xf = x.astype(jnp.float32)
    y = xf * lax.rsqrt(jnp.mean(xf * xf, axis=-1, keepdims=True) + NORM_EPS)
    return (y * g.astype(jnp.float32)).astype(x.dtype)


def rope(x, pos):
    half = QK_ROPE_DIM // 2
    inv = ROPE_BASE ** (-jnp.arange(half, dtype=jnp.float32) / half)
    ang = pos.astype(jnp.float32)[:, None] * inv[None, :]
    ang = ang.reshape((1, ang.shape[0]) + (1,) * (x.ndim - 3) + (half,))
    cos, sin = jnp.cos(ang), jnp.sin(ang)
    xf = x.astype(jnp.float32)
    x1, x2 = xf[..., :half], xf[..., half:]
    return jnp.concatenate([x1 * cos - x2 * sin, x1 * sin + x2 * cos], axis=-1).astype(x.dtype)


def pool_mix(u_ext, pos, w_pool, pool_scale):
    T = pos.shape[0]
    B = u_ext.shape[0]
    uf = u_ext.astype(jnp.float32)
    cs = jnp.cumsum(uf, axis=1)
    cs = jnp.concatenate([jnp.zeros_like(cs[:, :1]), cs], axis=1)
    end = cs[:, POOL_HIST + 1:]
    u_new = uf[:, POOL_HIST:]
    groups = []
    for g, w in enumerate(POOL_WINDOWS):
        sl = slice(g * POOL_GROUP_DIM, (g + 1) * POOL_GROUP_DIM)
        start = cs[:, POOL_HIST + 1 - w: POOL_HIST + 1 - w + T, sl]
        cnt = jnp.minimum(pos + 1, w).astype(jnp.float32)[None, :, None]
        groups.append((end[..., sl] - start) / cnt - u_new[..., sl])
    d = jnp.stack(groups, axis=2)
    y = jnp.einsum('btgc,gcd->btgd', d, w_pool.astype(jnp.float32)).reshape(B, T, POOL_DIM)
    return (y * pool_scale.astype(jnp.float32)).astype(u_ext.dtype)


def k_nope_from_latent(c, w_uk, g_k_nope):
    return rms_norm(jnp.einsum('bkc,chd->bkhd', c, w_uk), g_k_nope)


def mla_core(qn, qr, k_nope, k_rope, c, mask, w_uv):
    b, tq = qn.shape[:2]
    s = (jnp.einsum('bqhd,bkhd->bhqk', qn, k_nope)
         + jnp.einsum('bqhr,bkr->bhqk', qr, k_rope)).astype(jnp.float32) * SOFTMAX_SCALE
    s = jnp.where(mask[None, None], s, -jnp.inf)
    p = jax.nn.softmax(s, axis=-1)
    lat = jnp.einsum('bhqk,bkc->bqhc', p.astype(c.dtype), c)
    return jnp.einsum('bqhc,chv->bqhv', lat, w_uv).reshape(b, tq, ATTN_OUT_DIM)


def mla_attend_prompt(qn, qr, c, kr, w_uk, g_k_nope, w_uv):
    B, S = qn.shape[:2]
    k_nope = k_nope_from_latent(c, w_uk, g_k_nope)
    key_pos = jnp.arange(S)

    def block(i):
        q0 = i * Q_BLOCK
        qn_b = lax.dynamic_slice_in_dim(qn, q0, Q_BLOCK, axis=1)
        qr_b = lax.dynamic_slice_in_dim(qr, q0, Q_BLOCK, axis=1)
        mask = (q0 + jnp.arange(Q_BLOCK))[:, None] >= key_pos[None, :]
        return mla_core(qn_b, qr_b, k_nope, kr, c, mask, w_uv)

    out = lax.map(block, jnp.arange(S // Q_BLOCK))
    return out.transpose(1, 0, 2, 3).reshape(B, S, ATTN_OUT_DIM)


def mla_attend_sample(qn, qr, c, kr, ckv_pool, krope_pool, layer, page_table, w_uk, g_k_nope, w_uv):
    T = qn.shape[1]
    n_past = page_table.shape[1] * PAGE_SIZE
    key_pos = jnp.arange(n_past + T)
    q_pos = n_past + jnp.arange(T)
    mask = key_pos[None, :] <= q_pos[:, None]

    def one(args):
        qn_b, qr_b, c_b, kr_b, pt_b = args
        c_all = jnp.concatenate([ckv_pool[layer, pt_b].reshape(n_past, KV_RANK).astype(c_b.dtype), c_b], axis=0)[None]
        kr_all = jnp.concatenate([krope_pool[layer, pt_b].reshape(n_past, QK_ROPE_DIM).astype(kr_b.dtype), kr_b], axis=0)[None]
        k_nope = k_nope_from_latent(c_all, w_uk, g_k_nope)
        return mla_core(qn_b[None], qr_b[None], k_nope, kr_all, c_all, mask, w_uv)[0]

    return lax.map(one, (qn, qr, c, kr, page_table))


def even_mixer(x, pos, pool_hist, attend, g_mix, w_in, g_q_nope, g_q_rope, g_ckv, g_k_rope, w_pool, pool_scale, w_out):
    B, T, _ = x.shape
    z = rms_norm(x, g_mix) @ w_in
    u = z[..., :POOL_DIM]
    q = z[..., POOL_DIM:POOL_DIM + Q_DIM].reshape(B, T, N_HEADS, QK_HEAD_DIM)
    c = z[..., POOL_DIM + Q_DIM:POOL_DIM + Q_DIM + KV_RANK]
    kr = z[..., POOL_DIM + Q_DIM + KV_RANK:]
    qn = rms_norm(q[..., :QK_NOPE_DIM], g_q_nope)
    qr = rope(rms_norm(q[..., QK_NOPE_DIM:], g_q_rope), pos)
    c = rms_norm(c, g_ckv)
    kr = rope(rms_norm(kr, g_k_rope), pos)
    u_ext = jnp.concatenate([pool_hist.astype(u.dtype), u], axis=1)
    pool_out = pool_mix(u_ext, pos, w_pool, pool_scale)
    attn_out = attend(qn, qr, c, kr)
    out = jnp.concatenate([pool_out, attn_out], axis=-1) @ w_out
    return out, c, kr, u_ext[:, -POOL_HIST:]


def linear_scan(a, b, h0):
    b = b.at[:, 0].add(a[:, 0] * h0)

    def comb(l, r):
        al, bl = l
        ar, br = r
        return al * ar, ar * bl + br

    _, h = lax.associative_scan(comb, (a, b), axis=1)
    return h


def odd_mixer(x, pos, conv_hist, h0, g_mix, w_in, conv_w, conv_b, w_ga, b_ga, w_gx, b_gx, lam, w_out):
    B, T, _ = x.shape
    z = rms_norm(x, g_mix) @ w_in
    gate, u = z[..., :RNN_DIM], z[..., RNN_DIM:]
    u_ext = jnp.concatenate([conv_hist.astype(u.dtype), u], axis=1)
    v = conv_b
    for k in range(CONV_WIDTH):
        v = v + u_ext[:, k:k + T] * conv_w[k]
    vb = v.reshape(B, T, RNN_BLOCKS, RNN_BLOCK_DIM)
    r = jax.nn.sigmoid((jnp.einsum('btni,nij->btnj', vb, w_ga).reshape(B, T, RNN_DIM) + b_ga).astype(jnp.float32))
    i = jax.nn.sigmoid((jnp.einsum('btni,nij->btnj', vb, w_gx).reshape(B, T, RNN_DIM) + b_gx).astype(jnp.float32))
    log_a = -LRU_C * r * jax.nn.softplus(-lam.astype(jnp.float32))
    a = jnp.exp(log_a)
    mult = jnp.where((pos == 0)[None, :, None], 1.0, jnp.sqrt(-jnp.expm1(2.0 * log_a)))
    h = linear_scan(a, mult * i * v.astype(jnp.float32), h0.astype(jnp.float32))
    y = (jax.nn.gelu(gate, approximate=True).astype(jnp.float32) * h).astype(x.dtype)
    return y @ w_out, u_ext[:, -(CONV_WIDTH - 1):], h[:, -1].astype(x.dtype)


def sqrelu_mlp(x, g, w_up, w_down):
    return jnp.square(jax.nn.relu(rms_norm(x, g) @ w_up)) @ w_down


def setup_inputs(seed: int = 0) -> dict:
    key = jax.random.key(seed)
    keys = iter(jax.random.split(key, 48))
    f32 = jnp.float32

    def normal(shape, scale=1.0):
        return scale * jax.random.normal(next(keys), shape, f32)

    def gain(shape):
        return 1.0 + 0.05 * jax.random.normal(next(keys), shape, f32)

    n_pages = PAST_LEN // PAGE_SIZE
    n_used = DEC_BATCH * n_pages
    n_pool = n_used + n_used // 4
    page_table = jax.random.permutation(next(keys), n_pool)[:n_used].reshape(DEC_BATCH, n_pages).astype(jnp.int32)
    a_c = jax.random.uniform(next(keys), (N_ODD, RNN_DIM), f32, 0.9, 0.999)
    s = a_c ** (1.0 / LRU_C)
    lru_lambda = jnp.log(s) - jnp.log1p(-s)
    return {
        'x_prompt': normal((BATCH, SEQ, D_MODEL)),
        'x_sample': normal((DEC_BATCH, DEC_SEQ, D_MODEL)),
        'cache_ckv': normal((N_EVEN, n_pool, PAGE_SIZE, KV_RANK)),
        'cache_krope': normal((N_EVEN, n_pool, PAGE_SIZE, QK_ROPE_DIM)),
        'state_pool': normal((N_EVEN, DEC_BATCH, POOL_HIST, POOL_DIM)),
        'state_conv': normal((N_ODD, DEC_BATCH, CONV_WIDTH - 1, RNN_DIM)),
        'state_lru': normal((N_ODD, DEC_BATCH, RNN_DIM), 0.5),
        'page_table': page_table,
        'norm_mix': gain((DEPTH, D_MODEL)),
        'w_in_even': normal((N_EVEN, D_MODEL, IN_EVEN_DIM), D_MODEL ** -0.5),
        'g_q_nope': gain((N_EVEN, QK_NOPE_DIM)),
        'g_q_rope': gain((N_EVEN, QK_ROPE_DIM)),
        'g_ckv': gain((N_EVEN, KV_RANK)),
        'g_k_rope': gain((N_EVEN, QK_ROPE_DIM)),
        'g_k_nope': gain((N_EVEN, QK_NOPE_DIM)),
        'w_uk': normal((N_EVEN, KV_RANK, N_HEADS, QK_NOPE_DIM), KV_RANK ** -0.5),
        'w_uv': normal((N_EVEN, KV_RANK, N_HEADS, V_HEAD_DIM), KV_RANK ** -0.5),
        'w_pool': normal((N_EVEN, POOL_GROUPS, POOL_GROUP_DIM, POOL_GROUP_DIM), POOL_GROUP_DIM ** -0.5),
        'pool_scale': gain((N_EVEN, POOL_DIM)),
        'w_out_even': normal((N_EVEN, MIX_DIM, D_MODEL), MIX_DIM ** -0.5),
        'w_in_rnn': normal((N_ODD, D_MODEL, 2 * RNN_DIM), D_MODEL ** -0.5),
        'conv_w': normal((N_ODD, CONV_WIDTH, RNN_DIM), CONV_WIDTH ** -0.5),
        'conv_b': normal((N_ODD, RNN_DIM), 0.01),
        'w_gate_a': normal((N_ODD, RNN_BLOCKS, RNN_BLOCK_DIM, RNN_BLOCK_DIM), RNN_BLOCK_DIM ** -0.5),
        'b_gate_a': normal((N_ODD, RNN_DIM), 0.01),
        'w_gate_x': normal((N_ODD, RNN_BLOCKS, RNN_BLOCK_DIM, RNN_BLOCK_DIM), RNN_BLOCK_DIM ** -0.5),
        'b_gate_x': normal((N_ODD, RNN_DIM), 0.01),
        'lru_lambda': lru_lambda,
        'w_out_rnn': normal((N_ODD, RNN_DIM, D_MODEL), RNN_DIM ** -0.5),
        'norm_ffn': gain((DEPTH, D_MODEL)),
        'w_up': normal((DEPTH, D_MODEL, D_FF), D_MODEL ** -0.5),
        'w_down': normal((DEPTH, D_FF, D_MODEL), D_FF ** -0.5),
    }


def reference(x_prompt, x_sample, cache_ckv, cache_krope, state_pool, state_conv, state_lru, page_table,
              norm_mix, w_in_even, g_q_nope, g_q_rope, g_ckv, g_k_rope, g_k_nope, w_uk, w_uv, w_pool, pool_scale,
              w_out_even, w_in_rnn, conv_w, conv_b, w_gate_a, b_gate_a, w_gate_x, b_gate_x, lru_lambda, w_out_rnn,
              norm_ffn, w_up, w_down):
    B, S = x_prompt.shape[:2]
    DB, T = x_sample.shape[:2]
    n_past = page_table.shape[1] * PAGE_SIZE
    pos_p = jnp.arange(S, dtype=jnp.int32)
    pos_s = n_past + jnp.arange(T, dtype=jnp.int32)
    yp, ys = x_prompt, x_sample
    ckv_p, kr_p, pool_p, conv_p, lru_p = [], [], [], [], []
    ckv_s, kr_s, pool_s, conv_s, lru_s = [], [], [], [], []
    for layer in range(DEPTH):
        j = layer // 2
        if layer % 2 == 0:
            ew = (norm_mix[layer], w_in_even[j], g_q_nope[j], g_q_rope[j], g_ckv[j], g_k_rope[j],
                  w_pool[j], pool_scale[j], w_out_even[j])
            attend_p = functools.partial(mla_attend_prompt, w_uk=w_uk[j], g_k_nope=g_k_nope[j], w_uv=w_uv[j])
            attend_s = functools.partial(mla_attend_sample, ckv_pool=cache_ckv, krope_pool=cache_krope, layer=j,
                                         page_table=page_table, w_uk=w_uk[j], g_k_nope=g_k_nope[j], w_uv=w_uv[j])
            hist0 = jnp.zeros((B, POOL_HIST, POOL_DIM), yp.dtype)
            mp, c, kr, ph = even_mixer(yp, pos_p, hist0, attend_p, *ew)
            ms, cs_, krs, phs = even_mixer(ys, pos_s, state_pool[j], attend_s, *ew)
            ckv_p.append(c); kr_p.append(kr); pool_p.append(ph)
            ckv_s.append(cs_); kr_s.append(krs); pool_s.append(phs)
        else:
            ow = (norm_mix[layer], w_in_rnn[j], conv_w[j], conv_b[j], w_gate_a[j], b_gate_a[j],
                  w_gate_x[j], b_gate_x[j], lru_lambda[j], w_out_rnn[j])
            conv0 = jnp.zeros((B, CONV_WIDTH - 1, RNN_DIM), yp.dtype)
            h0 = jnp.zeros((B, RNN_DIM), yp.dtype)
            mp, cvp, hp = odd_mixer(yp, pos_p, conv0, h0, *ow)
            ms, cvs, hs = odd_mixer(ys, pos_s, state_conv[j], state_lru[j], *ow)
            conv_p.append(cvp); lru_p.append(hp)
            conv_s.append(cvs); lru_s.append(hs)
        yp = yp + mp
        ys = ys + ms
        yp = yp + sqrelu_mlp(yp, norm_ffn[layer], w_up[layer], w_down[layer])
        ys = ys + sqrelu_mlp(ys, norm_ffn[layer], w_up[layer], w_down[layer])
    return (yp, ys,
            jnp.stack(ckv_p), jnp.stack(kr_p), jnp.stack(pool_p), jnp.stack(conv_p), jnp.stack(lru_p),
            jnp.stack(ckv_s), jnp.stack(kr_s), jnp.stack(pool_s), jnp.stack(conv_s), jnp.stack(lru_s))
```

```cpp
#include <hip/hip_runtime.h>
#include <stdint.h>
#include <math.h>

#define DI __device__ __forceinline__
typedef unsigned short bf16_t;
typedef short bf16x8 __attribute__((ext_vector_type(8)));
typedef float f32x4 __attribute__((ext_vector_type(4)));
typedef float f32x16 __attribute__((ext_vector_type(16)));
typedef unsigned u32x2 __attribute__((ext_vector_type(2)));
typedef unsigned u32x4 __attribute__((ext_vector_type(4)));

constexpr int DM = 1024, SEQ = 4096, NB = 4, MP = NB * SEQ  , DB_ = 128, DT = 8, MS = DB_ * DT  , MT = MP + MS  ;
constexpr int PAST = 8192, PAGE = 128, NPAGES = PAST / PAGE  , NKEYS = PAST + DT  ;
constexpr int POOLD = 512, QDIM = 768, KVR = 256, ROPE = 32, NH = 8, QKH = 96, NOPE = 64, VH = 64;
constexpr int NZ0 = 1792  , DFF = 4096;
constexpr float EPS = 1e-6f;
constexpr float SM_SCALE = 0.10206207261596577f;

constexpr size_t O_Y = 0;
constexpr size_t O_CKV_P = (size_t)MT * DM;
constexpr size_t O_KR_P = O_CKV_P + (size_t)MP * KVR;
constexpr size_t O_POOL_P = O_KR_P + (size_t)MP * ROPE;
constexpr size_t O_CONV_P = O_POOL_P + (size_t)NB * 15 * POOLD;
constexpr size_t O_LRU_P = O_CONV_P + (size_t)NB * 3 * DM;
constexpr size_t O_CKV_S = O_LRU_P + (size_t)NB * DM;
constexpr size_t O_KR_S = O_CKV_S + (size_t)MS * KVR;
constexpr size_t O_POOL_S = O_KR_S + (size_t)MS * ROPE;
constexpr size_t O_CONV_S = O_POOL_S + (size_t)DB_ * 15 * POOLD;
constexpr size_t O_LRU_S = O_CONV_S + (size_t)DB_ * 3 * DM;
constexpr size_t O_END = O_LRU_S + (size_t)DB_ * DM;
static_assert(O_END == 24393728, "output size");

constexpr size_t MiB = 1u << 20;
constexpr size_t WS_CTL = 0;
constexpr size_t WS_WIN0T = 1 * MiB;
constexpr size_t WS_WKVT = 5 * MiB;
constexpr size_t WS_WPOOLT = 6 * MiB;
constexpr size_t WS_WGATET = 7 * MiB;
constexpr size_t WS_WOUT0T = 8 * MiB;
constexpr size_t WS_WOUTRT = 10 * MiB;
constexpr size_t WS_WINRT = 12 * MiB;
constexpr size_t WS_WUPT = 16 * MiB;
constexpr size_t WS_WDNT = 32 * MiB;
constexpr size_t WS_SSQ = 48 * MiB;
constexpr size_t WS_XB = 50 * MiB;
constexpr size_t WS_Z0 = 84 * MiB;
constexpr size_t WS_QB = 144 * MiB;
constexpr size_t WS_CB = 170 * MiB;
constexpr size_t WS_KRB = 179 * MiB;
constexpr size_t WS_DB = 181 * MiB;
constexpr size_t WS_KV = 198 * MiB;
constexpr size_t WS_MIX = 230 * MiB;
constexpr size_t WS_H = 264 * MiB;
constexpr size_t WS_GATE = 400 * MiB;
constexpr size_t WS_U = 434 * MiB;
constexpr size_t WS_V = 468 * MiB;
constexpr size_t WS_G = 502 * MiB;
constexpr size_t WS_YB = 638 * MiB;
constexpr size_t WS_SC = 672 * MiB;
constexpr size_t WS_LAT = 930 * MiB;
constexpr size_t WS_END = 940 * MiB;

DI unsigned f2bf(float f) { unsigned u = __float_as_uint(f); return (u + 0x7fffu + ((u >> 16) & 1u)) >> 16; }
DI float bf2f(bf16_t b) { return __uint_as_float(((unsigned)b) << 16); }
DI unsigned pk2(float lo, float hi) { return f2bf(lo) | (f2bf(hi) << 16); }
DI float wave_sum(float v) {
#pragma unroll
    for (int o = 1; o < 64; o <<= 1) v += __shfl_xor(v, o);
    return v;
}
DI float wave_max(float v) {
#pragma unroll
    for (int o = 1; o < 64; o <<= 1) v = fmaxf(v, __shfl_xor(v, o));
    return v;
}
DI float row_rinv(const float* SSQ, int row) {
    float s = 0.f;
#pragma unroll
    for (int p = 0; p < 16; ++p) s += SSQ[(size_t)p * MT + row];
    return rsqrtf(s * (1.0f / DM) + EPS);
}
DI float gelu_tanh(float x) { const float u = 0.7978845608028654f * (x + 0.044715f * x * x * x); return 0.5f * x * (1.f + tanhf(u)); }
DI float sigmoidf(float x) { return 1.f / (1.f + expf(-x)); }

__global__ __launch_bounds__(256) void k_transpose(const float* __restrict__ src, int lds_, int K, int N, bf16_t* __restrict__ dst, int ldd, const float* __restrict__ gain) {
    __shared__ float tile[64][65];
    const int k0 = blockIdx.y * 64, n0 = blockIdx.x * 64, tx = threadIdx.x & 63, ty = threadIdx.x >> 6;
    for (int i = ty; i < 64; i += 4) { const int k = k0 + i, n = n0 + tx; tile[i][tx] = (k < K && n < N) ? src[(size_t)k * lds_ + n] * (gain ? gain[k] : 1.f) : 0.f; }
    __syncthreads();
    for (int i = ty; i < 64; i += 4) { const int n = n0 + i, k = k0 + tx; if (n < N && k < K) dst[(size_t)n * ldd + k] = (bf16_t)f2bf(tile[tx][i]); }
}

__global__ __launch_bounds__(256) void k_rowprep(const float* __restrict__ xp, const float* __restrict__ xs, float* __restrict__ Ycopy, bf16_t* __restrict__ XB, float* __restrict__ SSQ) {
    const int wid = threadIdx.x >> 6, lane = threadIdx.x & 63, row = blockIdx.x * 4 + wid;
    const float* src = row < MP ? xp + (size_t)row * DM : xs + (size_t)(row - MP) * DM;
    f32x4 v[4]; float ss = 0.f;
#pragma unroll
    for (int j = 0; j < 4; ++j) { v[j] = ((const f32x4*)src)[lane + 64 * j]; ss += v[j].x * v[j].x + v[j].y * v[j].y + v[j].z * v[j].z + v[j].w * v[j].w; }
    ss = wave_sum(ss);
#pragma unroll
    for (int j = 0; j < 4; ++j) {
        u32x2 o; o.x = pk2(v[j].x, v[j].y); o.y = pk2(v[j].z, v[j].w);
        ((u32x2*)(XB + (size_t)row * DM))[lane + 64 * j] = o;
        if (Ycopy) ((f32x4*)(Ycopy + (size_t)row * DM))[lane + 64 * j] = v[j];
    }
    if (lane < 16) SSQ[(size_t)lane * MT + row] = lane == 0 ? ss : 0.f;
}

template <class Epi>
__global__ __launch_bounds__(256) void k_gemm(const bf16_t* __restrict__ A, int lda, int a_tile_off, const bf16_t* __restrict__ Bt, int K, Epi E) {
    const int wid = threadIdx.x >> 6, lane = threadIdx.x & 63, r = lane & 31, h = lane >> 5;
    const int m0 = blockIdx.y * 64 + (wid >> 1) * 32, n0 = blockIdx.x * 64 + (wid & 1) * 32;
    const bf16_t* ap = A + (size_t)(m0 + r) * lda + (size_t)(n0 / 256) * a_tile_off + 8 * h;
    const bf16_t* bp = Bt + (size_t)(n0 + r) * K + 8 * h;
    f32x16 acc;
#pragma unroll
    for (int i = 0; i < 16; ++i) acc[i] = 0.f;
    for (int k = 0; k < K; k += 16) {
        const bf16x8 a = *(const bf16x8*)(ap + k), b = *(const bf16x8*)(bp + k);
        acc = __builtin_amdgcn_mfma_f32_32x32x16_bf16(b, a, acc, 0, 0, 0);
    }
#pragma unroll
    for (int g = 0; g < 4; ++g) E(m0 + r, n0 + 8 * g + 4 * h, (f32x4){acc[4 * g], acc[4 * g + 1], acc[4 * g + 2], acc[4 * g + 3]});
}

struct EpiZ0 {
    const float* SSQ; bf16_t* Z;
    DI void operator()(int row, int col, f32x4 v) const { const float ri = row_rinv(SSQ, row); u32x2 o; o.x = pk2(v.x * ri, v.y * ri); o.y = pk2(v.z * ri, v.w * ri); *(u32x2*)(Z + (size_t)row * NZ0 + col) = o; }
};
struct EpiRawBf16 { bf16_t* O; int ldo, pad;
    DI void operator()(int row, int col, f32x4 v) const { u32x2 o; o.x = pk2(v.x, v.y); o.y = pk2(v.z, v.w); *(u32x2*)(O + (size_t)row * ldo + col) = o; } };
struct EpiPool { const float* scale; bf16_t* MIX;
    DI void operator()(int row, int col, f32x4 v) const { const f32x4 s = *(const f32x4*)(scale + col); u32x2 o; o.x = pk2(v.x * s.x, v.y * s.y); o.y = pk2(v.z * s.z, v.w * s.w); *(u32x2*)(MIX + (size_t)row * DM + col) = o; } };
struct EpiResid { float* Y;
    DI void operator()(int row, int col, f32x4 v) const { f32x4* p = (f32x4*)(Y + (size_t)row * DM + col); *p = *p + v; } };
struct EpiUp { const float* SSQ; bf16_t* H;
    DI void operator()(int row, int col, f32x4 v) const { const float ri = row_rinv(SSQ, row); f32x4 t = v * ri; t.x = fmaxf(t.x, 0.f); t.y = fmaxf(t.y, 0.f); t.z = fmaxf(t.z, 0.f); t.w = fmaxf(t.w, 0.f);
        u32x2 o; o.x = pk2(t.x * t.x, t.y * t.y); o.y = pk2(t.z * t.z, t.w * t.w); *(u32x2*)(H + (size_t)row * DFF + col) = o; } };
struct EpiRnnIn { const float* SSQ; bf16_t* GATE; bf16_t* U;
    DI void operator()(int row, int col, f32x4 v) const { const float ri = row_rinv(SSQ, row); f32x4 t = v * ri; u32x2 o;
        if (col < DM) { o.x = pk2(gelu_tanh(t.x), gelu_tanh(t.y)); o.y = pk2(gelu_tanh(t.z), gelu_tanh(t.w)); *(u32x2*)(GATE + (size_t)row * DM + col) = o; }
        else { o.x = pk2(t.x, t.y); o.y = pk2(t.z, t.w); *(u32x2*)(U + (size_t)row * DM + col - DM) = o; } } };
struct EpiF32 { float* O; int ldo, pad;
    DI void operator()(int row, int col, f32x4 v) const { *(f32x4*)(O + (size_t)row * ldo + col) = v; } };

__global__ __launch_bounds__(256) void k_post0(const bf16_t* __restrict__ Z0, const float* __restrict__ state_pool, const float* __restrict__ g_q_nope, const float* __restrict__ g_q_rope,
                                               const float* __restrict__ g_ckv, const float* __restrict__ g_k_rope, bf16_t* __restrict__ QB, bf16_t* __restrict__ CB, bf16_t* __restrict__ KRB,
                                               bf16_t* __restrict__ DBuf, float* __restrict__ out) {
    const int wid = threadIdx.x >> 6, lane = threadIdx.x & 63, row = blockIdx.x * 4 + wid;
    const bf16_t* z = Z0 + (size_t)row * NZ0;
    const bool isp = row < MP; const int t = isp ? (row & (SEQ - 1)) : ((row - MP) & 7); const int bb = isp ? (row >> 12) : ((row - MP) >> 3); const int pos = isp ? t : PAST + t;
    const int i16 = lane & 15;
    const float inv = powf(10000.0f, -(float)i16 / 16.0f);
    const float ang = (float)pos * inv; const float cs = cosf(ang), sn = sinf(ang);
    for (int h = 0; h < NH; ++h) {
        const float x = bf2f(z[POOLD + QKH * h + lane]);
        const float ss = wave_sum(x * x);
        QB[(size_t)row * QDIM + QKH * h + lane] = (bf16_t)f2bf(x * rsqrtf(ss * (1.f / 64.f) + EPS) * g_q_nope[lane]);
        const float xr = lane < 32 ? bf2f(z[POOLD + QKH * h + 64 + lane]) : 0.f;
        const float sr = wave_sum(xr * xr);
        const float y = xr * rsqrtf(sr * (1.f / 32.f) + EPS) * g_q_rope[lane & 31];
        const float pr = __shfl_xor(y, 16);
        const float o = (lane & 16) ? (pr * sn + y * cs) : (y * cs - pr * sn);
        if (lane < 32) QB[(size_t)row * QDIM + QKH * h + 64 + lane] = (bf16_t)f2bf(o);
    }
    {
        float x[4]; float ss = 0.f;
#pragma unroll
        for (int j = 0; j < 4; ++j) { x[j] = bf2f(z[POOLD + QDIM + lane * 4 + j]); ss += x[j] * x[j]; }
        ss = wave_sum(ss); const float ri = rsqrtf(ss * (1.f / 256.f) + EPS);
        f32x4 y; y.x = x[0] * ri * g_ckv[lane * 4]; y.y = x[1] * ri * g_ckv[lane * 4 + 1]; y.z = x[2] * ri * g_ckv[lane * 4 + 2]; y.w = x[3] * ri * g_ckv[lane * 4 + 3];
        u32x2 o; o.x = pk2(y.x, y.y); o.y = pk2(y.z, y.w);
        *(u32x2*)(CB + (size_t)row * KVR + lane * 4) = o;
        float* co = isp ? out + O_CKV_P + (size_t)row * KVR : out + O_CKV_S + (size_t)(row - MP) * KVR;
        *(f32x4*)(co + lane * 4) = y;
    }
    {
        const float xr = lane < 32 ? bf2f(z[POOLD + QDIM + KVR + lane]) : 0.f;
        const float sr = wave_sum(xr * xr);
        const float y = xr * rsqrtf(sr * (1.f / 32.f) + EPS) * g_k_rope[lane & 31];
        const float pr = __shfl_xor(y, 16);
        const float o = (lane & 16) ? (pr * sn + y * cs) : (y * cs - pr * sn);
        if (lane < 32) { KRB[(size_t)row * ROPE + lane] = (bf16_t)f2bf(o); float* ko = isp ? out + O_KR_P + (size_t)row * ROPE : out + O_KR_S + (size_t)(row - MP) * ROPE; ko[lane] = o; }
    }
    for (int jj = 0; jj < 8; ++jj) {
        const int col = lane + 64 * jj, g = col >> 7, w = 2 << g;
        float s = 0.f;
        for (int j = 0; j < w; ++j) {
            const int tj = t - j;
            if (tj >= 0) s += bf2f(Z0[(size_t)(row - j) * NZ0 + col]);
            else if (!isp) s += state_pool[((size_t)bb * 15 + (15 + tj)) * POOLD + col];
        }
        const float u = bf2f(z[col]);
        const float cnt = isp ? (float)((t + 1) < w ? (t + 1) : w) : (float)w;
        DBuf[(size_t)row * POOLD + col] = (bf16_t)f2bf(s / cnt - u);
        if (isp) { if (t >= SEQ - 15) out[O_POOL_P + ((size_t)bb * 15 + (t - (SEQ - 15))) * POOLD + col] = u; }
        else {
            out[O_POOL_S + ((size_t)bb * 15 + 7 + t) * POOLD + col] = u;
            if (t == 0) { for (int i = 0; i < 7; ++i) out[O_POOL_S + ((size_t)bb * 15 + i) * POOLD + col] = state_pool[((size_t)bb * 15 + 8 + i) * POOLD + col]; }
        }
    }
}

__global__ __launch_bounds__(256) void k_knorm(bf16_t* __restrict__ KV, const float* __restrict__ g_k_nope) {
    const int wid = threadIdx.x >> 6, lane = threadIdx.x & 63, row = blockIdx.x * 4 + wid;
    for (int h = 0; h < NH; ++h) {
        bf16_t* p = KV + (size_t)row * 1024 + h * 64 + lane; const float x = bf2f(*p); const float ss = wave_sum(x * x);
        *p = (bf16_t)f2bf(x * rsqrtf(ss * (1.f / 64.f) + EPS) * g_k_nope[lane]);
    }
}

__global__ __launch_bounds__(64) void k_attn_p_naive(const bf16_t* __restrict__ QB, const bf16_t* __restrict__ KV, const bf16_t* __restrict__ KRB, bf16_t* __restrict__ MIX) {
    __shared__ float sc[SEQ]; __shared__ float qs[QKH];
    const int row = blockIdx.x >> 3, h = blockIdx.x & 7, lane = threadIdx.x, b = row >> 12, t = row & (SEQ - 1);
    for (int i = lane; i < QKH; i += 64) qs[i] = bf2f(QB[(size_t)row * QDIM + h * QKH + i]);
    __syncthreads();
    float mx = -INFINITY;
    for (int j0 = 0; j0 <= t; j0 += 64) {
        const int j = j0 + lane;
        if (j <= t) {
            const bf16_t* kr = KV + (size_t)(b * SEQ + j) * 1024 + h * 64; const bf16_t* rr = KRB + (size_t)(b * SEQ + j) * ROPE;
            float s = 0.f;
            for (int d = 0; d < 64; ++d) s += qs[d] * bf2f(kr[d]);
            for (int d = 0; d < 32; ++d) s += qs[64 + d] * bf2f(rr[d]);
            s *= SM_SCALE; sc[j] = s; mx = fmaxf(mx, s);
        }
    }
    mx = wave_max(mx);
    float sum = 0.f;
    for (int j = lane; j <= t; j += 64) { const float p = expf(sc[j] - mx); sc[j] = p; sum += p; }
    sum = wave_sum(sum);
    __syncthreads();
    float acc = 0.f;
    for (int j = 0; j <= t; ++j) acc += sc[j] * bf2f(KV[(size_t)(b * SEQ + j) * 1024 + 512 + h * 64 + lane]);
    MIX[(size_t)row * DM + 512 + h * 64 + lane] = (bf16_t)f2bf(acc / sum);
}

__global__ __launch_bounds__(256) void k_attn_s_scores(const float* __restrict__ cache_ckv, const float* __restrict__ cache_kr, const int* __restrict__ page_table, const bf16_t* __restrict__ QB,
                                                       const bf16_t* __restrict__ CB, const bf16_t* __restrict__ KRB, const float* __restrict__ w_uk, const float* __restrict__ g_k_nope, float* __restrict__ SC) {
    const int chunk = blockIdx.x, sb = blockIdx.y, key = threadIdx.x & 127, hh = __builtin_amdgcn_readfirstlane(threadIdx.x >> 7);
    const bool isnew = chunk == NPAGES;
    if (isnew && key >= DT) return;
    float kr[ROPE];
    const float* crow = nullptr; const bf16_t* crowb = nullptr;
    if (!isnew) { const size_t pr = (size_t)page_table[sb * NPAGES + chunk] * PAGE + key; crow = cache_ckv + pr * KVR; const float* kp = cache_kr + pr * ROPE;
#pragma unroll
        for (int r = 0; r < ROPE; ++r) kr[r] = kp[r]; }
    else { const size_t rr = (size_t)MP + sb * DT + key; crowb = CB + rr * KVR;
#pragma unroll
        for (int r = 0; r < ROPE; ++r) kr[r] = bf2f(KRB[rr * ROPE + r]); }
    const int jglob = isnew ? PAST + key : chunk * PAGE + key;
    for (int hi = 0; hi < 4; ++hi) {
        const int h = hh * 4 + hi;
        float acc[NOPE];
#pragma unroll
        for (int d = 0; d < NOPE; ++d) acc[d] = 0.f;
        for (int c = 0; c < KVR; ++c) {
            const float cv = isnew ? bf2f(crowb[c]) : crow[c];
            const float* wr = w_uk + (size_t)c * 512 + h * 64;
#pragma unroll
            for (int d = 0; d < NOPE; ++d) acc[d] += cv * wr[d];
        }
        float ss = 0.f;
#pragma unroll
        for (int d = 0; d < NOPE; ++d) ss += acc[d] * acc[d];
        const float ri = rsqrtf(ss * (1.f / 64.f) + EPS);
        for (int q = 0; q < DT; ++q) {
            const bf16_t* qp = QB + (size_t)(MP + sb * DT + q) * QDIM + h * QKH;
            float s = 0.f;
#pragma unroll
            for (int d = 0; d < NOPE; ++d) s += acc[d] * g_k_nope[d] * bf2f(qp[d]);
            s *= ri;
#pragma unroll
            for (int r = 0; r < ROPE; ++r) s += kr[r] * bf2f(qp[64 + r]);
            s *= SM_SCALE;
            if (isnew && key > q) s = -INFINITY;
            SC[((size_t)sb * 64 + h * 8 + q) * NKEYS + jglob] = s;
        }
    }
}
__global__ __launch_bounds__(256) void k_attn_s_pv(const float* __restrict__ cache_ckv, const int* __restrict__ page_table, const bf16_t* __restrict__ CB, const float* __restrict__ SC,
                                                   const float* __restrict__ w_uv, float* __restrict__ LAT, bf16_t* __restrict__ MIX) {
    __shared__ float p[64][PAGE]; __shared__ float smx[64], sinv[64];
    const int sb = blockIdx.x, tid = threadIdx.x, wid = tid >> 6, lane = tid & 63;
    for (int i = 0; i < 16; ++i) {
        const int qh = wid * 16 + i; const float* s = SC + ((size_t)sb * 64 + qh) * NKEYS;
        float mx = -INFINITY; for (int j = lane; j < NKEYS; j += 64) mx = fmaxf(mx, s[j]);
        mx = wave_max(mx);
        float sum = 0.f; for (int j = lane; j < NKEYS; j += 64) sum += expf(s[j] - mx);
        sum = wave_sum(sum);
        if (lane == 0) { smx[qh] = mx; sinv[qh] = 1.f / sum; }
    }
    __syncthreads();
    float lat[64];
#pragma unroll
    for (int i = 0; i < 64; ++i) lat[i] = 0.f;
    for (int chunk = 0; chunk <= NPAGES; ++chunk) {
        const int nk = chunk == NPAGES ? DT : PAGE;
        for (int e = tid; e < 64 * PAGE; e += 256) { const int qh = e >> 7, j = e & 127; p[qh][j] = j < nk ? expf(SC[((size_t)sb * 64 + qh) * NKEYS + chunk * PAGE + j] - smx[qh]) * sinv[qh] : 0.f; }
        __syncthreads();
        for (int j = 0; j < nk; ++j) {
            float cv;
            if (chunk < NPAGES) cv = cache_ckv[((size_t)page_table[sb * NPAGES + chunk] * PAGE + j) * KVR + tid];
            else cv = bf2f(CB[((size_t)MP + sb * DT + j) * KVR + tid]);
#pragma unroll
            for (int i = 0; i < 64; ++i) lat[i] += p[i][j] * cv;
        }
        __syncthreads();
    }
    float* L = LAT + (size_t)sb * 64 * KVR;
#pragma unroll
    for (int i = 0; i < 64; ++i) L[i * KVR + tid] = lat[i];
    __threadfence_block(); __syncthreads();
    for (int o = tid; o < 64 * VH; o += 256) {
        const int qh = o >> 6, v = o & 63, h = qh >> 3, q = qh & 7;
        float a = 0.f;
        for (int c = 0; c < KVR; ++c) a += L[qh * KVR + c] * w_uv[(size_t)c * 512 + h * 64 + v];
        MIX[(size_t)(MP + sb * DT + q) * DM + 512 + h * 64 + v] = (bf16_t)f2bf(a);
    }
}

__global__ __launch_bounds__(256) void k_conv(const bf16_t* __restrict__ U, const float* __restrict__ state_conv, const float* __restrict__ conv_w, const float* __restrict__ conv_b, bf16_t* __restrict__ V, float* __restrict__ out) {
    const size_t idx = (size_t)blockIdx.x * 256 + threadIdx.x; const int row = (int)(idx >> 10), ch = (int)(idx & 1023);
    const bool isp = row < MP; const int t = isp ? (row & (SEQ - 1)) : ((row - MP) & 7); const int bb = isp ? (row >> 12) : ((row - MP) >> 3);
    float v = conv_b[ch];
#pragma unroll
    for (int k = 0; k < 4; ++k) {
        const int tj = t + k - 3; float u;
        if (tj >= 0) u = bf2f(U[(size_t)(row + k - 3) * DM + ch]);
        else u = isp ? 0.f : state_conv[((size_t)bb * 3 + (3 + tj)) * DM + ch];
        v += u * conv_w[k * DM + ch];
    }
    V[idx] = (bf16_t)f2bf(v);
    const float ut = bf2f(U[idx]);
    if (isp) { if (t >= SEQ - 3) out[O_CONV_P + ((size_t)bb * 3 + (t - (SEQ - 3))) * DM + ch] = ut; }
    else { if (t >= DT - 3) out[O_CONV_S + ((size_t)bb * 3 + (t - (DT - 3))) * DM + ch] = ut; }
}
__global__ __launch_bounds__(256) void k_scan_naive(const float* __restrict__ G, const bf16_t* __restrict__ V, const bf16_t* __restrict__ GATE, const float* __restrict__ b_ga, const float* __restrict__ b_gx,
                                                    const float* __restrict__ lam, const float* __restrict__ state_lru, bf16_t* __restrict__ YB, float* __restrict__ out) {
    const int idx = blockIdx.x * 256 + threadIdx.x; const int seq = idx >> 10, ch = idx & 1023;
    const bool isp = seq < NB; const int T = isp ? SEQ : DT; const int row0 = isp ? seq * SEQ : MP + (seq - NB) * DT;
    float h = isp ? 0.f : state_lru[(size_t)(seq - NB) * DM + ch];
    const float sp = log1pf(expf(-lam[ch])); const float ba = b_ga[ch], bx = b_gx[ch];
    const int n = ch >> 7, j = ch & 127;
    for (int t = 0; t < T; ++t) {
        const size_t row = (size_t)row0 + t;
        const float r = sigmoidf(G[row * 2048 + n * 256 + j] + ba), ig = sigmoidf(G[row * 2048 + n * 256 + 128 + j] + bx);
        const float la = -8.0f * r * sp; const float a = expf(la);
        const float mult = (isp && t == 0) ? 1.f : sqrtf(-expm1f(2.f * la));
        const float v = bf2f(V[row * DM + ch]);
        h = a * h + mult * ig * v;
        YB[row * DM + ch] = (bf16_t)f2bf(bf2f(GATE[row * DM + ch]) * h);
    }
    out[(isp ? O_LRU_P + (size_t)seq * DM : O_LRU_S + (size_t)(seq - NB) * DM) + ch] = h;
}

template <class Epi> static void gemm(hipStream_t st, const bf16_t* A, int lda, int a_tile_off, const bf16_t* Bt, int M, int N, int K, Epi E) {
    hipLaunchKernelGGL(k_gemm<Epi>, dim3(N / 64, M / 64), dim3(256), 0, st, A, lda, a_tile_off, Bt, K, E);
}
static void transpose(hipStream_t st, const float* src, int lds_, int K, int N, bf16_t* dst, int ldd, const float* gain) {
    hipLaunchKernelGGL(k_transpose, dim3((N + 63) / 64, (K + 63) / 64), dim3(256), 0, st, src, lds_, K, N, dst, ldd, gain);
}

extern "C" void kernel_launch(void* const* d_in, const int* in_sizes, int n_in, void* d_out, int out_size, void* d_ws, size_t ws_size, hipStream_t stream) {
    (void)in_sizes; (void)n_in; (void)out_size; (void)ws_size;
    const float* x_prompt = (const float*)d_in[0]; const float* x_sample = (const float*)d_in[1];
    const float* cache_ckv = (const float*)d_in[2]; const float* cache_kr = (const float*)d_in[3];
    const float* state_pool = (const float*)d_in[4]; const float* state_conv = (const float*)d_in[5]; const float* state_lru = (const float*)d_in[6];
    const int* page_table = (const int*)d_in[7];
    const float* norm_mix = (const float*)d_in[8]; const float* w_in_even = (const float*)d_in[9];
    const float* g_q_nope = (const float*)d_in[10]; const float* g_q_rope = (const float*)d_in[11]; const float* g_ckv = (const float*)d_in[12]; const float* g_k_rope = (const float*)d_in[13]; const float* g_k_nope = (const float*)d_in[14];
    const float* w_uk = (const float*)d_in[15]; const float* w_uv = (const float*)d_in[16]; const float* w_pool = (const float*)d_in[17]; const float* pool_scale = (const float*)d_in[18];
    const float* w_out_even = (const float*)d_in[19]; const float* w_in_rnn = (const float*)d_in[20]; const float* conv_w = (const float*)d_in[21]; const float* conv_b = (const float*)d_in[22];
    const float* w_gate_a = (const float*)d_in[23]; const float* b_gate_a = (const float*)d_in[24]; const float* w_gate_x = (const float*)d_in[25]; const float* b_gate_x = (const float*)d_in[26];
    const float* lru_lambda = (const float*)d_in[27]; const float* w_out_rnn = (const float*)d_in[28]; const float* norm_ffn = (const float*)d_in[29]; const float* w_up = (const float*)d_in[30]; const float* w_down = (const float*)d_in[31];
    float* out = (float*)d_out; unsigned char* ws = (unsigned char*)d_ws;
    bf16_t* WIN0T = (bf16_t*)(ws + WS_WIN0T); bf16_t* WKVT = (bf16_t*)(ws + WS_WKVT); bf16_t* WPOOLT = (bf16_t*)(ws + WS_WPOOLT); bf16_t* WGATET = (bf16_t*)(ws + WS_WGATET);
    bf16_t* WOUT0T = (bf16_t*)(ws + WS_WOUT0T); bf16_t* WOUTRT = (bf16_t*)(ws + WS_WOUTRT); bf16_t* WINRT = (bf16_t*)(ws + WS_WINRT); bf16_t* WUPT = (bf16_t*)(ws + WS_WUPT); bf16_t* WDNT = (bf16_t*)(ws + WS_WDNT);
    float* SSQ = (float*)(ws + WS_SSQ); bf16_t* XB = (bf16_t*)(ws + WS_XB); bf16_t* Z0 = (bf16_t*)(ws + WS_Z0); bf16_t* QB = (bf16_t*)(ws + WS_QB); bf16_t* CB = (bf16_t*)(ws + WS_CB); bf16_t* KRB = (bf16_t*)(ws + WS_KRB);
    bf16_t* DBuf = (bf16_t*)(ws + WS_DB); bf16_t* KV = (bf16_t*)(ws + WS_KV); bf16_t* MIX = (bf16_t*)(ws + WS_MIX); bf16_t* H = (bf16_t*)(ws + WS_H); bf16_t* GATE = (bf16_t*)(ws + WS_GATE); bf16_t* U = (bf16_t*)(ws + WS_U);
    bf16_t* V = (bf16_t*)(ws + WS_V); float* G = (float*)(ws + WS_G); bf16_t* YB = (bf16_t*)(ws + WS_YB); float* SC = (float*)(ws + WS_SC); float* LAT = (float*)(ws + WS_LAT);
    float* Y = out + O_Y;

    (void)hipMemsetAsync(WIN0T, 0, (size_t)NZ0 * DM * 2, stream);
    (void)hipMemsetAsync(WPOOLT, 0, (size_t)512 * 256 * 2, stream);
    transpose(stream, w_in_even, 1568, DM, 1568, WIN0T, DM, norm_mix);
    transpose(stream, w_uk, 512, KVR, 512, WKVT, KVR, nullptr);
    transpose(stream, w_uv, 512, KVR, 512, WKVT + (size_t)512 * KVR, KVR, nullptr);
    for (int g = 0; g < 4; ++g) transpose(stream, w_pool + (size_t)g * 128 * 128, 128, 128, 128, WPOOLT + (size_t)g * 128 * 256 + (g & 1) * 128, 256, nullptr);
    transpose(stream, w_out_even, DM, DM, DM, WOUT0T, DM, nullptr);
    for (int l = 0; l < 2; ++l) { transpose(stream, w_up + (size_t)l * DM * DFF, DFF, DM, DFF, WUPT + (size_t)l * DFF * DM, DM, norm_ffn + l * DM);
                                  transpose(stream, w_down + (size_t)l * DFF * DM, DM, DFF, DM, WDNT + (size_t)l * DM * DFF, DFF, nullptr); }
    transpose(stream, w_in_rnn, 2048, DM, 2048, WINRT, DM, norm_mix + DM);
    for (int n = 0; n < 8; ++n) { transpose(stream, w_gate_a + (size_t)n * 128 * 128, 128, 128, 128, WGATET + (size_t)(n * 256) * 128, 128, nullptr);
                                  transpose(stream, w_gate_x + (size_t)n * 128 * 128, 128, 128, 128, WGATET + (size_t)(n * 256 + 128) * 128, 128, nullptr); }
    transpose(stream, w_out_rnn, DM, DM, DM, WOUTRT, DM, nullptr);

    hipLaunchKernelGGL(k_rowprep, dim3(MT / 4), dim3(256), 0, stream, x_prompt, x_sample, Y, XB, SSQ);
    gemm(stream, XB, DM, 0, WIN0T, MT, NZ0, DM, EpiZ0{SSQ, Z0});
    hipLaunchKernelGGL(k_post0, dim3(MT / 4), dim3(256), 0, stream, Z0, state_pool, g_q_nope, g_q_rope, g_ckv, g_k_rope, QB, CB, KRB, DBuf, out);
    gemm(stream, CB, KVR, 0, WKVT, MP, 1024, KVR, EpiRawBf16{KV, 1024, 0});
    hipLaunchKernelGGL(k_knorm, dim3(MP / 4), dim3(256), 0, stream, KV, g_k_nope);
    gemm(stream, DBuf, POOLD, 256, WPOOLT, MT, POOLD, 256, EpiPool{pool_scale, MIX});
    hipLaunchKernelGGL(k_attn_p_naive, dim3(MP * NH), dim3(64), 0, stream, QB, KV, KRB, MIX);
    hipLaunchKernelGGL(k_attn_s_scores, dim3(NPAGES + 1, DB_), dim3(256), 0, stream, cache_ckv, cache_kr, page_table, QB, CB, KRB, w_uk, g_k_nope, SC);
    hipLaunchKernelGGL(k_attn_s_pv, dim3(DB_), dim3(256), 0, stream, cache_ckv, page_table, CB, SC, w_uv, LAT, MIX);
    gemm(stream, MIX, DM, 0, WOUT0T, MT, DM, DM, EpiResid{Y});
    hipLaunchKernelGGL(k_rowprep, dim3(MT / 4), dim3(256), 0, stream, Y, Y + (size_t)MP * DM, (float*)nullptr, XB, SSQ);
    gemm(stream, XB, DM, 0, WUPT, MT, DFF, DM, EpiUp{SSQ, H});
    gemm(stream, H, DFF, 0, WDNT, MT, DM, DFF, EpiResid{Y});
    hipLaunchKernelGGL(k_rowprep, dim3(MT / 4), dim3(256), 0, stream, Y, Y + (size_t)MP * DM, (float*)nullptr, XB, SSQ);
    gemm(stream, XB, DM, 0, WINRT, MT, 2048, DM, EpiRnnIn{SSQ, GATE, U});
    hipLaunchKernelGGL(k_conv, dim3(MT * DM / 256), dim3(256), 0, stream, U, state_conv, conv_w, conv_b, V, out);
    gemm(stream, V, DM, 128, WGATET, MT, 2048, 128, EpiF32{G, 2048, 0});
    hipLaunchKernelGGL(k_scan_naive, dim3((NB + DB_) * DM / 256), dim3(256), 0, stream, G, V, GATE, b_gate_a, b_gate_x, lru_lambda, state_lru, YB, out);
    gemm(stream, YB, DM, 0, WOUTRT, MT, DM, DM, EpiResid{Y});
    hipLaunchKernelGGL(k_rowprep, dim3(MT / 4), dim3(256), 0, stream, Y, Y + (size_t)MP * DM, (float*)nullptr, XB, SSQ);
    gemm(stream, XB, DM, 0, WUPT + (size_t)DFF * DM, MT, DFF, DM, EpiUp{SSQ, H});
    gemm(stream, H, DFF, 0, WDNT + (size_t)DM * DFF, MT, DM, DFF, EpiResid{Y});
}
```

```cpp
#include <hip/hip_runtime.h>
#include <stdint.h>
#include <math.h>
#include <stdio.h>

#define DI __device__ __forceinline__
#define LAS __attribute__((address_space(3)))
typedef unsigned short bf16_t;
typedef short bf16x8 __attribute__((ext_vector_type(8)));
typedef float f32x4 __attribute__((ext_vector_type(4)));
typedef float f32x16 __attribute__((ext_vector_type(16)));
typedef unsigned u32x2 __attribute__((ext_vector_type(2)));
typedef unsigned u32x4 __attribute__((ext_vector_type(4)));

constexpr int DM = 1024, SEQ = 4096, NB = 4, MP = NB * SEQ  , DB_ = 128, DT = 8, MS = DB_ * DT  , MT = MP + MS  ;
constexpr int PAST = 8192, PAGE = 128, NPAGES = PAST / PAGE  , NKEYS = PAST + DT  ;
constexpr int POOLD = 512, QDIM = 768, KVR = 256, ROPE = 32, NH = 8, QKH = 96, NOPE = 64, VH = 64;
constexpr int NZ0 = 1792  , DFF = 4096;
constexpr float EPS = 1e-6f;
constexpr float SM_SCALE = 0.10206207261596577f;
constexpr float QSCALE = 0.10206207261596577f * 1.4426950408889634f;

constexpr size_t O_Y = 0;
constexpr size_t O_CKV_P = (size_t)MT * DM;
constexpr size_t O_KR_P = O_CKV_P + (size_t)MP * KVR;
constexpr size_t O_POOL_P = O_KR_P + (size_t)MP * ROPE;
constexpr size_t O_CONV_P = O_POOL_P + (size_t)NB * 15 * POOLD;
constexpr size_t O_LRU_P = O_CONV_P + (size_t)NB * 3 * DM;
constexpr size_t O_CKV_S = O_LRU_P + (size_t)NB * DM;
constexpr size_t O_KR_S = O_CKV_S + (size_t)MS * KVR;
constexpr size_t O_POOL_S = O_KR_S + (size_t)MS * ROPE;
constexpr size_t O_CONV_S = O_POOL_S + (size_t)DB_ * 15 * POOLD;
constexpr size_t O_LRU_S = O_CONV_S + (size_t)DB_ * 3 * DM;
constexpr size_t O_END = O_LRU_S + (size_t)DB_ * DM;
static_assert(O_END == 24393728, "output size");

constexpr size_t MiB = 1u << 20;
constexpr size_t WS_CTL = 0, CTL_ZERO_BYTES = 256 * 1024;
constexpr size_t WS_WIN0T = 1 * MiB;
constexpr size_t WS_WKVT = 5 * MiB;
constexpr size_t WS_WPOOLT = 6 * MiB;
constexpr size_t WS_WGATET = 7 * MiB;
constexpr size_t WS_WOUT0T = 8 * MiB;
constexpr size_t WS_WOUTRT = 10 * MiB;
constexpr size_t WS_WINRT = 12 * MiB;
constexpr size_t WS_WUPT = 16 * MiB;
constexpr size_t WS_WDNT = 32 * MiB;
constexpr size_t WS_SSQ = 48 * MiB;
constexpr size_t WS_SP8 = 49 * MiB + 96 * 1024;
constexpr size_t WS_ROPE = 49 * MiB + 128 * 1024;
constexpr size_t WS_XB = 50 * MiB;
constexpr size_t WS_Z0 = 84 * MiB;
constexpr size_t WS_QB = 144 * MiB;
constexpr size_t WS_CB = 170 * MiB;
constexpr size_t WS_KRB = 179 * MiB;
constexpr size_t WS_DB = 181 * MiB;
constexpr size_t WS_KV = 944 * MiB;
constexpr size_t WS_MIX = 230 * MiB;
constexpr size_t WS_H = 264 * MiB;
constexpr size_t WS_GATE = 400 * MiB;
constexpr size_t WS_U = 434 * MiB;
constexpr size_t WS_V = 468 * MiB;
constexpr size_t WS_G = 502 * MiB;
constexpr size_t WS_HL = WS_G, WS_AC = WS_G + 34 * MiB, WS_SUM = WS_G + 68 * MiB;
constexpr size_t WS_YB = 638 * MiB;
constexpr size_t WS_SC = 672 * MiB;
constexpr size_t WS_LAT = 930 * MiB;
constexpr size_t WS_ACCS = 1136 * MiB;
constexpr size_t WS_PART = 1140 * MiB;
constexpr size_t WS_END = 1140 * MiB + 2 * 256 * 262144;
constexpr int CW_BAR = 4096;
constexpr int CW_DBG = 64;
constexpr int CW_SKT = 128;
constexpr int CW_SKF = 32768;
constexpr size_t WS_DBG = 1000 * MiB;
constexpr size_t WS_LATP = 980 * MiB;
constexpr size_t WS_ML = 998 * MiB;
#ifndef DBG_ATTN_P
#define DBG_ATTN_P 0
#endif
#ifndef DBG_ATTN_S
#define DBG_ATTN_S 0
#endif
#ifndef DBG_KNORM
#define DBG_KNORM 0
#endif
#ifndef DBG_RVR
#define DBG_RVR 0.004f
#endif
#define DBG_ANY (DBG_ATTN_P || DBG_ATTN_S || DBG_KNORM)
#ifndef REP_ID
#define REP_ID 0
#endif
#define REPN(id) ((REP_ID == (id)) ? 2 : 1)

constexpr int NWAVES = 8, NTHR = NWAVES * 64;
constexpr int LDS_BYTES = 163840;
constexpr int LDS_MISC = LDS_BYTES - 1024;

DI unsigned f2bf(float f) { unsigned u = __float_as_uint(f); return (u + 0x7fffu + ((u >> 16) & 1u)) >> 16; }
DI float bf2f(bf16_t b) { return __uint_as_float(((unsigned)b) << 16); }
DI unsigned pk2(float lo, float hi) { return f2bf(lo) | (f2bf(hi) << 16); }
DI float xsum16(float x) { auto r = __builtin_amdgcn_permlane16_swap(__float_as_uint(x), __float_as_uint(x), false, false); return __uint_as_float(r[0]) + __uint_as_float(r[1]); }
DI float xsum32(float x) { auto r = __builtin_amdgcn_permlane32_swap(__float_as_uint(x), __float_as_uint(x), false, false); return __uint_as_float(r[0]) + __uint_as_float(r[1]); }
DI float xmax16(float x) { auto r = __builtin_amdgcn_permlane16_swap(__float_as_uint(x), __float_as_uint(x), false, false); return fmaxf(__uint_as_float(r[0]), __uint_as_float(r[1])); }
DI float xmax32(float x) { auto r = __builtin_amdgcn_permlane32_swap(__float_as_uint(x), __float_as_uint(x), false, false); return fmaxf(__uint_as_float(r[0]), __uint_as_float(r[1])); }
template <int CTRL> DI float dppf(float v) { return __int_as_float(__builtin_amdgcn_update_dpp(0, __float_as_int(v), CTRL, 0xF, 0xF, true)); }
DI float xchg4(float v, bool upper) { const float a = dppf<0x104>(v), b = dppf<0x114>(v); return upper ? b : a; }
DI float max8(float v) { v = fmaxf(v, dppf<0xB1>(v)); v = fmaxf(v, dppf<0x4E>(v)); v = fmaxf(v, dppf<0x141>(v)); return v; }
DI float sum8(float v) { v += dppf<0xB1>(v); v += dppf<0x4E>(v); v += dppf<0x141>(v); return v; }
DI float sum16(float v) { v = sum8(v); v += dppf<0x140>(v); return v; }
DI float wave_sum(float v) { return xsum32(xsum16(sum16(v))); }
DI float wave_max(float v) {
#pragma unroll
    for (int o = 1; o < 64; o <<= 1) v = fmaxf(v, __shfl_xor(v, o));
    return v;
}
DI float row_rinv(const float* SSQ, int row) {
    float s = 0.f;
#pragma unroll
    for (int p = 0; p < 16; ++p) s += SSQ[(size_t)p * MT + row];
    return rsqrtf(s * (1.0f / DM) + EPS);
}
DI float max3f(float a, float b, float c) { float r; asm("v_max3_f32 %0, %1, %2, %3" : "=v"(r) : "v"(a), "v"(b), "v"(c)); return r; }
DI float gelu_tanh(float x) { const float u = 0.7978845608028654f * (x + 0.044715f * x * x * x); return x * __builtin_amdgcn_rcpf(1.0f + __builtin_amdgcn_exp2f(-2.0f * 1.4426950408889634f * u)); }
DI float sigmoidf(float x) { return 1.f / (1.f + expf(-x)); }

struct UPre { float v[8]; };
namespace pg8 {
constexpr int BM = 256, BK = 64, HALF = 128, HTB = HALF * BK * 2, STAGE_BYTES = 8 * HTB, NXCD = 8, WGM = 8;
__host__ __device__ __forceinline__ int lds_byte(int r, int c) { const int st = (r >> 4) * 2 + (c >> 5), rr = r & 15, cc = c & 31, ob = rr * 64 + cc * 2; return st * 1024 + (ob ^ (((ob >> 9) & 1) << 5)); }
__host__ __device__ __forceinline__ void stage_rc(int b, int& R, int& C) { const int st = b / 1024, sb = b % 1024, swz = sb ^ (((sb >> 9) & 1) << 5); R = (st >> 1) * 16 + swz / 64; C = (st & 1) * 32 + (swz % 64) / 2; }
struct Unit { int pm, pn; };
struct Gemm { const bf16_t* A; const bf16_t* Bt; int M, N, K, lda, a_tile_off, a_shift; unsigned* ready = nullptr; unsigned ready_target = 0; };
struct Seg { int pm, pn, t0, t1; };
struct StreamOrder {
    int nM, nN, ppu, ub, lo, hi;
    DI void init(int M, int N, int K, int G, int c) {
        nM = M / BM; nN = N / BM; ppu = K / (2 * BK);
        const int nwg = nM * nN, x = c % NXCD, k = c / NXCD, nk = G / NXCD, q = nwg / NXCD, r = nwg % NXCD;
        ub = x * q + (x < r ? x : r); const int cnt = q + (x < r ? 1 : 0); const int Pr = cnt * ppu;
        lo = (k * Pr) / nk; hi = ((k + 1) * Pr) / nk;
    }
    DI bool next(int i, Seg& s) const {
        const int ul = lo / ppu + i, start = ul * ppu; if (start >= hi) return false;
        const int p0 = (lo > start ? lo : start) - start, p1 = ((hi < start + ppu) ? hi : start + ppu) - start;
        s.t0 = 2 * p0; s.t1 = 2 * p1;
        const int wgid = ub + ul, nig = WGM * nN, gid = wgid / nig, fm = gid * WGM, gsz = (nM - fm) < WGM ? (nM - fm) : WGM;
        s.pm = fm + ((wgid % nig) % gsz); s.pn = (wgid % nig) / gsz; return true;
    }
};
struct SplitTailOrder {
    int nt, c, ways, plen;
    DI void init(int K, int c_) { nt = K / BK; c = c_; ways = 16; plen = nt / 16; if (plen < 2) { plen = 2; ways = nt / 2; } }
    DI bool next(int i, Seg& u) const {
        if (i == 0) { u.t0 = 0; u.t1 = nt; const int xcd = c % NXCD, off = c / NXCD, wgid = xcd * 32 + off; u.pm = (wgid >> 5) * 8 + (wgid & 7); u.pn = (wgid >> 3) & 3; return true; }
        if (i == 1) { const int us = c >> 4, part = c & 15; if (part >= ways) return false; u.pm = 64 + (us >> 2); u.pn = us & 3; u.t0 = part * plen; u.t1 = u.t0 + plen; return true; }
        return false;
    }
};
struct StaticOrder {
    int nM, nN, nwg, G, c, nt;
    DI void init(int M, int N, int K, int G_, int c_) { nM = M / BM; nN = N / BM; nwg = nM * nN; G = G_; c = c_; nt = K / BK; }
    DI bool next(int i, Seg& u) const {
        u.t0 = 0; u.t1 = nt;
        const long L = (long)i * G + c; if (L >= nwg) return false;
        int wgid = (int)L; { const int q = nwg / NXCD, r = nwg % NXCD, xcd = wgid % NXCD, off = wgid / NXCD; wgid = (xcd < r ? xcd * (q + 1) : r * (q + 1) + (xcd - r) * q) + off; }
        const int nig = WGM * nN, gid = wgid / nig, fm = gid * WGM, gsz = (nM - fm) < WGM ? (nM - fm) : WGM;
        u.pm = fm + ((wgid % nig) % gsz); u.pn = (wgid % nig) / gsz; return true;
    }
};
struct NoPre {};
__host__ __device__ __forceinline__ int perm32(int rho) { const int n = rho >> 4, i = rho & 15; return 8 * (i >> 2) + 4 * n + (i & 3); }
template <class F, bool P64 = false, bool P8 = false> struct EpiRows {
    F f;
    static constexpr bool PERM64 = P64;
    static constexpr bool PERM8 = P8;
    DI UPre unit_pre(int pm) const { return f.unit_pre(pm * BM); }
    DI void operator()(const f32x4 (&acc)[2][2][4][2], const Unit& u, int wr, int wc, int fr, int fq, const UPre& upre) const {
        constexpr int BJS = P64 ? 32 : HALF;
        const int row0 = u.pm * BM + wr * 64 + fr, col0 = u.pn * BM + wc * (P64 ? 64 : 32) + (P8 ? 8 : 4) * fq;
        f.unit_begin(u.pm * BM, upre);
#pragma unroll
        for (int ai = 0; ai < 2; ++ai) {
            typename F::RowPre rp[4]; typename F::Pre pr[4][2][2]; typename F::Pre8 pr8[4][2];
#pragma unroll
            for (int m = 0; m < 4; ++m) rp[m] = f.row_pre(row0 + ai * HALF + m * 16);
#pragma unroll
            for (int m = 0; m < 4; ++m)
#pragma unroll
                for (int bj = 0; bj < 2; ++bj)
#pragma unroll
                    for (int n = 0; n < 2; ++n) { if constexpr (P8) { if (n == 0) pr8[m][bj] = f.pre8(row0 + ai * HALF + m * 16, col0 + bj * BJS); } else pr[m][bj][n] = f.pre(row0 + ai * HALF + m * 16, col0 + bj * BJS + n * 16); }
#pragma unroll
            for (int m = 0; m < 4; ++m) {
                const int row = row0 + ai * HALF + m * 16;
                typename F::Ctx ctx = f.row_begin(row, rp[m]);
                if constexpr (P8) {
#pragma unroll
                    for (int bj = 0; bj < 2; ++bj) f.op8(ctx, row, col0 + bj * BJS, acc[ai][bj][m][0], acc[ai][bj][m][1], pr8[m][bj]);
                } else {
#pragma unroll
                    for (int bj = 0; bj < 2; ++bj)
#pragma unroll
                        for (int n = 0; n < 2; ++n) f(ctx, row, col0 + bj * BJS + n * 16, acc[ai][bj][m][n], pr[m][bj][n]);
                }
                f.row_end(ctx, row, u.pn, wc, fq);
            }
        }
    }
};

struct StreamCtl { float* part; unsigned* flags; unsigned* tmo; unsigned epoch; int c; int pad; };
struct NoPart { DI void operator()(const f32x4 (&)[2][2][4][2], const Unit&, int, int, int, int) const {} };
template <bool STREAM, class Sched, class Epi, class EpiPart = NoPart>
DI void gemm_phase(LAS unsigned char* lds, const Gemm g, const Sched& S, const Epi& E, const StreamCtl sc, const EpiPart EP = EpiPart()) {
    const int tid = threadIdx.x, wid = __builtin_amdgcn_readfirstlane(tid >> 6), lane = tid & 63, wr = wid >> 2, wc = wid & 3, fr = lane & 15, fq = lane >> 4;
    const int K = g.K, nt = K / BK;
    unsigned voffA[2], voffB[2];
#pragma unroll
    for (int i = 0; i < 2; ++i) { int R, C; stage_rc(tid * 16 + i * 8192, R, C); const int r31 = Epi::PERM8 ? perm32(R & 31) : (R & 31); const int Rb = Epi::PERM64 ? (64 * (R >> 5) + r31) : ((R & ~31) + r31); voffA[i] = (unsigned)(R * g.lda + C) * 2u; voffB[i] = (unsigned)(Rb * K + C) * 2u; }
    const size_t kstep = (size_t)(BK * 2);
    const size_t hstepA = (size_t)HALF * g.lda * 2, hstepB = (size_t)(Epi::PERM64 ? 32 : HALF) * K * 2;
    const size_t tstepA = 2 * hstepA, tstepB = (size_t)BM * K * 2, pstepA = (size_t)g.a_tile_off * 2;
    const unsigned ldsw = (unsigned)wid * 1024u;
    const int aoff = lds_byte(wr * 64 + fr, fq * 8), boff = lds_byte(wc * 32 + fr, fq * 8);
#define PG8_SA(b, h) (((b) * 2 + (h)) * HTB)
#define PG8_SB(b, h) ((4 + (b) * 2 + (h)) * HTB)
#define PG8_STAGE(bufoff, gbase, voff) do { _Pragma("unroll") for (int _i = 0; _i < 2; ++_i) \
        __builtin_amdgcn_global_load_lds((const unsigned*)((const char*)(gbase) + (voff)[_i]), (LAS unsigned*)(lds + (bufoff) + ldsw + _i * 8192), 16, 0, 0); } while (0)
#define PG8_LDA(dst, b, h) do { _Pragma("unroll") for (int m = 0; m < 4; ++m) _Pragma("unroll") for (int k = 0; k < 2; ++k) dst[m][k] = *(const LAS bf16x8*)(lds + PG8_SA(b, h) + aoff + m * 2048 + k * 1024); } while (0)
#define PG8_LDB(dst, b, h) do { _Pragma("unroll") for (int n = 0; n < 2; ++n) _Pragma("unroll") for (int k = 0; k < 2; ++k) dst[n][k] = *(const LAS bf16x8*)(lds + PG8_SB(b, h) + boff + n * 2048 + k * 1024); } while (0)
#define PG8_MMA(ai, bj, At, Bt) do { __builtin_amdgcn_s_setprio(1); _Pragma("unroll") for (int m = 0; m < 4; ++m) _Pragma("unroll") for (int n = 0; n < 2; ++n) _Pragma("unroll") for (int k = 0; k < 2; ++k) \
        acc[ai][bj][m][n] = __builtin_amdgcn_mfma_f32_16x16x32_bf16(Bt[n][k], At[m][k], acc[ai][bj][m][n], 0, 0, 0); __builtin_amdgcn_s_setprio(0); } while (0)
#define PG8_WAIT_V(n) asm volatile("s_waitcnt vmcnt(" #n ")" ::: "memory")
#define PG8_WAIT_L(n) asm volatile("s_waitcnt lgkmcnt(" #n ")" ::: "memory")
#define PG8_BAR __builtin_amdgcn_s_barrier()
#define PG8_SCHED __builtin_amdgcn_sched_barrier(0)
    Seg cur = {0, 0, 0, 0}, nxt = {0, 0, 0, 0}; int ui = 0;
    if (!S.next(0, cur)) return;
    bool waited = g.ready == nullptr;
#define PG8_READY_WAIT() do { if (wid == 0) { unsigned sp_ = 0; \
            while (__hip_atomic_load(g.ready, __ATOMIC_RELAXED, __HIP_MEMORY_SCOPE_AGENT) < g.ready_target) { __builtin_amdgcn_s_sleep(2); if (++sp_ > (1u << 22)) break; } \
            __builtin_amdgcn_fence(__ATOMIC_ACQUIRE, "agent"); asm volatile("s_waitcnt vmcnt(0)" ::: "memory"); } \
        PG8_BAR; asm volatile("" ::: "memory"); waited = true; } while (0)
#define PG8_BAR __builtin_amdgcn_s_barrier()
    if (!waited && cur.pm >= MP / 256) PG8_READY_WAIT();
    f32x4 acc[2][2][4][2];
#pragma unroll
    for (int a = 0; a < 2; ++a)
#pragma unroll
        for (int b = 0; b < 2; ++b)
#pragma unroll
            for (int m = 0; m < 4; ++m)
#pragma unroll
                for (int n = 0; n < 2; ++n) acc[a][b][m][n] = (f32x4){0.f, 0.f, 0.f, 0.f};
    bf16x8 At[4][2], B0[2][2], B1[2][2];
    const char* cA = (const char*)g.A + (size_t)cur.pm * tstepA + (size_t)(cur.pn >> g.a_shift) * pstepA + (size_t)cur.t0 * kstep;
    const char* cB = (const char*)g.Bt + (size_t)cur.pn * tstepB + (size_t)cur.t0 * kstep;
    PG8_STAGE(PG8_SB(0, 0), cB, voffB); PG8_STAGE(PG8_SB(0, 1), cB + hstepB, voffB); PG8_STAGE(PG8_SA(0, 0), cA, voffA); PG8_STAGE(PG8_SA(0, 1), cA + hstepA, voffA);
    if (wr == 1) PG8_BAR;
    PG8_WAIT_V(2); PG8_BAR;
    PG8_STAGE(PG8_SB(1, 0), cB + kstep, voffB); PG8_STAGE(PG8_SA(1, 0), cA + kstep, voffA); PG8_STAGE(PG8_SB(1, 1), cB + hstepB + kstep, voffB);
    PG8_WAIT_V(6); PG8_BAR;
    for (;;) {
        const bool has_next = S.next(ui + 1, nxt);
        if (!waited && has_next && nxt.pm >= MP / 256) PG8_READY_WAIT();
        const char* nA = has_next ? (const char*)g.A + (size_t)nxt.pm * tstepA + (size_t)(nxt.pn >> g.a_shift) * pstepA + (size_t)nxt.t0 * kstep : cA;
        const char* nB = has_next ? (const char*)g.Bt + (size_t)nxt.pn * tstepB + (size_t)nxt.t0 * kstep : cB;
        const int nseg = cur.t1 - cur.t0;
        UPre upre{}; if (STREAM || nseg == nt) upre = E.unit_pre(cur.pm);
#pragma unroll 1
        for (int t = 0; t < nseg; t += 2) {
            const bool last = (t == nseg - 2);
            const char* a1 = cA + (size_t)(t + 1) * kstep;
            const char* a2 = last ? nA : cA + (size_t)(t + 2) * kstep; const char* b2 = last ? nB : cB + (size_t)(t + 2) * kstep;
            const char* a3 = a2 + kstep; const char* b3 = b2 + kstep;
            PG8_LDB(B0, 0, 0); PG8_LDB(B1, 0, 1); PG8_SCHED; PG8_LDA(At, 0, 0); PG8_STAGE(PG8_SA(1, 1), a1 + hstepA, voffA);
            PG8_WAIT_V(8); PG8_WAIT_L(0); PG8_BAR; PG8_MMA(0, 0, At, B0); PG8_MMA(0, 1, At, B1); PG8_BAR; PG8_SCHED;
            PG8_LDA(At, 0, 1); PG8_STAGE(PG8_SB(0, 0), b2, voffB); PG8_STAGE(PG8_SB(0, 1), b2 + hstepB, voffB); PG8_STAGE(PG8_SA(0, 0), a2, voffA);
            PG8_WAIT_V(8); PG8_WAIT_L(0); PG8_BAR; PG8_MMA(1, 0, At, B0); PG8_MMA(1, 1, At, B1); PG8_BAR; PG8_SCHED;
            PG8_LDB(B0, 1, 0); PG8_LDB(B1, 1, 1); PG8_SCHED; PG8_LDA(At, 1, 0); PG8_STAGE(PG8_SA(0, 1), a2 + hstepA, voffA);
            PG8_WAIT_V(8); PG8_WAIT_L(0); PG8_BAR; PG8_MMA(0, 0, At, B0); PG8_MMA(0, 1, At, B1); PG8_BAR; PG8_SCHED;
            PG8_LDA(At, 1, 1); PG8_STAGE(PG8_SB(1, 0), b3, voffB); PG8_STAGE(PG8_SB(1, 1), b3 + hstepB, voffB); PG8_STAGE(PG8_SA(1, 0), a3, voffA);
            PG8_WAIT_V(8); PG8_WAIT_L(0); PG8_BAR; PG8_MMA(1, 0, At, B0); PG8_MMA(1, 1, At, B1); PG8_BAR; PG8_SCHED;
        }
        if (wr == 0) PG8_BAR;
        if (STREAM && cur.t0 > 0) {
            const __amdgpu_buffer_rsrc_t prs = __builtin_amdgcn_make_buffer_rsrc((void*)(sc.part + ((size_t)(sc.epoch & 1u) * gridDim.x + sc.c) * 65536), (short)0, 262144, 0x00020000);
#pragma unroll
            for (int a = 0; a < 2; ++a)
#pragma unroll
                for (int b = 0; b < 2; ++b)
#pragma unroll
                    for (int m = 0; m < 4; ++m)
#pragma unroll
                        for (int n = 0; n < 2; ++n) { const int j = ((a * 2 + b) * 4 + m) * 2 + n; const f32x4 v = acc[a][b][m][n];
                            __builtin_amdgcn_raw_buffer_store_b128(__builtin_bit_cast(u32x4, v), prs, (unsigned)tid * 16u, j * 8192, 16); }
            asm volatile("s_waitcnt vmcnt(0)" ::: "memory");
            PG8_BAR;
            if (tid == 0) __hip_atomic_store(sc.flags + (size_t)sc.c * 64, sc.epoch, __ATOMIC_RELAXED, __HIP_MEMORY_SCOPE_AGENT);
        } else {
            Unit uu; uu.pm = cur.pm; uu.pn = cur.pn;
            if (!STREAM && (cur.t1 - cur.t0) != nt) EP(acc, uu, wr, wc, fr, fq); else E(acc, uu, wr, wc, fr, fq, upre);
        }
        if (!has_next) break;
        if (STREAM && nxt.t1 < nt) {
            const int pc = sc.c + NXCD;
            if (wid == 0) {
                unsigned* fl = sc.flags + (size_t)pc * 64; unsigned sp = 0; bool ok = true;
                while (__hip_atomic_load(fl, __ATOMIC_RELAXED, __HIP_MEMORY_SCOPE_AGENT) != sc.epoch) {
                    __builtin_amdgcn_s_sleep(1);
                    if ((++sp & 255u) == 0u) { if (__hip_atomic_load(sc.tmo, __ATOMIC_RELAXED, __HIP_MEMORY_SCOPE_AGENT) != 0u || sp > (1u << 20)) { ok = false; break; } }
                }
                if (!ok && lane == 0) __hip_atomic_store(sc.tmo, 1u, __ATOMIC_RELAXED, __HIP_MEMORY_SCOPE_AGENT);
                __builtin_amdgcn_fence(__ATOMIC_ACQUIRE, "agent");
                asm volatile("s_waitcnt vmcnt(0)" ::: "memory");
            }
            PG8_BAR; asm volatile("" ::: "memory");
            const __amdgpu_buffer_rsrc_t crs = __builtin_amdgcn_make_buffer_rsrc((void*)(sc.part + ((size_t)(sc.epoch & 1u) * gridDim.x + pc) * 65536), (short)0, 262144, 0x00020000);
#pragma unroll
            for (int a = 0; a < 2; ++a)
#pragma unroll
                for (int b = 0; b < 2; ++b)
#pragma unroll
                    for (int m = 0; m < 4; ++m)
#pragma unroll
                        for (int n = 0; n < 2; ++n) acc[a][b][m][n] = __builtin_bit_cast(f32x4, __builtin_amdgcn_raw_buffer_load_b128(crs, (unsigned)tid * 16u, ((((a * 2 + b) * 4 + m) * 2 + n) * 8192), 0));
        } else {
#pragma unroll
            for (int a = 0; a < 2; ++a)
#pragma unroll
                for (int b = 0; b < 2; ++b)
#pragma unroll
                    for (int m = 0; m < 4; ++m)
#pragma unroll
                        for (int n = 0; n < 2; ++n) acc[a][b][m][n] = (f32x4){0.f, 0.f, 0.f, 0.f};
        }
        cur = nxt; cA = nA; cB = nB; ++ui;
        if (wr == 1) PG8_BAR;
    }
    PG8_WAIT_V(0);
    PG8_BAR;
#undef PG8_SA
#undef PG8_SB
#undef PG8_STAGE
#undef PG8_LDA
#undef PG8_LDB
#undef PG8_MMA
#undef PG8_WAIT_V
#undef PG8_WAIT_L
#undef PG8_BAR
#undef PG8_SCHED
}
}

constexpr int LDS_RINV = 131072;
DI UPre rinv_partial_load(const float* SSQ, int rowbase) {
    const int tid = threadIdx.x, r = tid >> 1, hf = tid & 1;
    UPre u;
#pragma unroll
    for (int p = 0; p < 8; ++p) u.v[p] = SSQ[(size_t)(hf * 8 + p) * MT + rowbase + r];
    return u;
}
DI void rinv_table_fill(const UPre& u) {
    extern __shared__ __attribute__((aligned(16))) unsigned char lds_raw_[];
    LAS float* tab = (LAS float*)((LAS unsigned char*)lds_raw_ + LDS_RINV);
    const int tid = threadIdx.x, r = tid >> 1, hf = tid & 1;
    float sv = ((u.v[0] + u.v[1]) + (u.v[2] + u.v[3])) + ((u.v[4] + u.v[5]) + (u.v[6] + u.v[7]));
    sv += dppf<0xB1>(sv);
    if (hf == 0) tab[r] = rsqrtf(sv * (1.0f / DM) + EPS);
    asm volatile("s_waitcnt lgkmcnt(0)" ::: "memory"); __builtin_amdgcn_s_barrier(); asm volatile("" ::: "memory");
}
DI float rinv_table_get(int row) {
    extern __shared__ __attribute__((aligned(16))) unsigned char lds_raw_[];
    return ((const LAS float*)((LAS unsigned char*)lds_raw_ + LDS_RINV))[row & 255];
}
struct FZ0 { typedef float Ctx; typedef float RowPre; typedef pg8::NoPre Pre; typedef pg8::NoPre Pre8; const float* SSQ; bf16_t* Z;
    DI UPre unit_pre(int rowbase) const { return rinv_partial_load(SSQ, rowbase); }
    DI void unit_begin(int, const UPre& sv) const { rinv_table_fill(sv); }
    DI RowPre row_pre(int row) const { return rinv_table_get(row); }
    DI Pre pre(int, int) const { return Pre{}; }
    DI pg8::NoPre pre8(int, int) const { return pg8::NoPre{}; }
    DI Ctx row_begin(int, const RowPre& rp) const { return rp; }
    DI void operator()(Ctx& ri, int row, int col, f32x4 v, const Pre&) const { u32x2 o; o.x = pk2(v.x * ri, v.y * ri); o.y = pk2(v.z * ri, v.w * ri); *(u32x2*)(Z + (size_t)row * NZ0 + col) = o; }
    DI void op8(Ctx& ri, int row, int col, f32x4 a, f32x4 b, const pg8::NoPre&) const { u32x4 o; o.x = pk2(a.x * ri, a.y * ri); o.y = pk2(a.z * ri, a.w * ri); o.z = pk2(b.x * ri, b.y * ri); o.w = pk2(b.z * ri, b.w * ri); *(u32x4*)(Z + (size_t)row * NZ0 + col) = o; }
    DI void row_end(Ctx&, int, int, int, int) const {} };
template <int LDO> struct FRawBf16 { typedef int Ctx; typedef pg8::NoPre RowPre; typedef pg8::NoPre Pre; typedef pg8::NoPre Pre8; bf16_t* O;
    DI UPre unit_pre(int) const { return UPre{}; }
    DI void unit_begin(int, const UPre&) const {}
    DI RowPre row_pre(int) const { return RowPre{}; }
    DI Pre pre(int, int) const { return Pre{}; }
    DI pg8::NoPre pre8(int, int) const { return pg8::NoPre{}; }
    DI Ctx row_begin(int, const RowPre&) const { return 0; }
    DI void operator()(Ctx&, int row, int col, f32x4 v, const Pre&) const { u32x2 o; o.x = pk2(v.x, v.y); o.y = pk2(v.z, v.w); *(u32x2*)(O + (size_t)row * LDO + col) = o; }
    DI void row_end(Ctx&, int, int, int, int) const {} };
struct KvCtx { f32x4 v[4]; int col0; int k; };
struct FKvNorm { typedef KvCtx Ctx; typedef pg8::NoPre RowPre; typedef pg8::NoPre Pre; typedef pg8::NoPre Pre8; bf16_t* O; const float* g;
    DI UPre unit_pre(int) const { return UPre{}; }
    DI void unit_begin(int, const UPre&) const {}
    DI RowPre row_pre(int) const { return RowPre{}; }
    DI Pre pre(int, int) const { return Pre{}; }
    DI pg8::NoPre pre8(int, int) const { return pg8::NoPre{}; }
    DI Ctx row_begin(int, const RowPre&) const { Ctx c; c.k = 0; c.col0 = 0; return c; }
    DI void operator()(Ctx&, int, int, f32x4, const Pre&) const {}
    DI void op8(Ctx& c, int, int col, f32x4 a, f32x4 b, const pg8::NoPre&) const { if (c.k == 0) c.col0 = col; c.v[c.k] = a; c.v[c.k + 1] = b; c.k += 2; }
    DI void row_end(Ctx& c, int row, int pn, int, int) const {
        float ri = 1.0f;
        if (pn < 2) { float ss = 0.f;
#pragma unroll
            for (int k = 0; k < 4; ++k) ss += c.v[k].x * c.v[k].x + c.v[k].y * c.v[k].y + c.v[k].z * c.v[k].z + c.v[k].w * c.v[k].w;
            ss = xsum32(xsum16(ss)); ri = rsqrtf(ss * (1.f / 64.f) + EPS); }
#pragma unroll
        for (int bj = 0; bj < 2; ++bj) { const int col = c.col0 + bj * 32; f32x4 y0 = c.v[2 * bj] * ri, y1 = c.v[2 * bj + 1] * ri;
            if (pn < 2) { y0 = y0 * *(const f32x4*)(g + (col & 63)); y1 = y1 * *(const f32x4*)(g + (col & 63) + 4); }
            u32x4 o; o.x = pk2(y0.x, y0.y); o.y = pk2(y0.z, y0.w); o.z = pk2(y1.x, y1.y); o.w = pk2(y1.z, y1.w); *(u32x4*)(O + (size_t)row * 1024 + col) = o; }
    } };
struct FPool { typedef int Ctx; typedef pg8::NoPre RowPre; typedef f32x4 Pre; typedef pg8::NoPre Pre8; const float* scale; bf16_t* MIX;
    DI pg8::NoPre pre8(int, int) const { return pg8::NoPre{}; }
    DI void op8(Ctx&, int row, int col, f32x4 a, f32x4 b, const pg8::NoPre&) const { const f32x4 s0 = *(const f32x4*)(scale + col), s1 = *(const f32x4*)(scale + col + 4);
        u32x4 o; o.x = pk2(a.x * s0.x, a.y * s0.y); o.y = pk2(a.z * s0.z, a.w * s0.w); o.z = pk2(b.x * s1.x, b.y * s1.y); o.w = pk2(b.z * s1.z, b.w * s1.w); *(u32x4*)(MIX + (size_t)row * DM + col) = o; }
    DI UPre unit_pre(int) const { return UPre{}; }
    DI void unit_begin(int, const UPre&) const {}
    DI RowPre row_pre(int) const { return RowPre{}; }
    DI Pre pre(int, int col) const { return *(const f32x4*)(scale + col); }
    DI Ctx row_begin(int, const RowPre&) const { return 0; }
    DI void operator()(Ctx&, int row, int col, f32x4 v, const Pre& s) const { u32x2 o; o.x = pk2(v.x * s.x, v.y * s.y); o.y = pk2(v.z * s.z, v.w * s.w); *(u32x2*)(MIX + (size_t)row * DM + col) = o; }
    DI void row_end(Ctx&, int, int, int, int) const {} };
template <bool FINAL> struct FResid { typedef float Ctx; typedef pg8::NoPre RowPre; typedef u32x2 Pre; typedef u32x4 Pre8; bf16_t* RB; float* Yf; float* SSQ;
    DI Pre8 pre8(int row, int col) const { return *(const u32x4*)(RB + (size_t)row * DM + col); }
    DI void op8(Ctx& ss, int row, int col, f32x4 a, f32x4 b, const Pre8& r) const {
        f32x4 y0, y1; y0.x = __uint_as_float(r.x << 16) + a.x; y0.y = __uint_as_float(r.x & 0xffff0000u) + a.y; y0.z = __uint_as_float(r.y << 16) + a.z; y0.w = __uint_as_float(r.y & 0xffff0000u) + a.w;
        y1.x = __uint_as_float(r.z << 16) + b.x; y1.y = __uint_as_float(r.z & 0xffff0000u) + b.y; y1.z = __uint_as_float(r.w << 16) + b.z; y1.w = __uint_as_float(r.w & 0xffff0000u) + b.w;
        if (FINAL) { *(f32x4*)(Yf + (size_t)row * DM + col) = y0; *(f32x4*)(Yf + (size_t)row * DM + col + 4) = y1; }
        else { u32x4 o; o.x = pk2(y0.x, y0.y); o.y = pk2(y0.z, y0.w); o.z = pk2(y1.x, y1.y); o.w = pk2(y1.z, y1.w); *(u32x4*)(RB + (size_t)row * DM + col) = o;
            ss += y0.x * y0.x + y0.y * y0.y + y0.z * y0.z + y0.w * y0.w + y1.x * y1.x + y1.y * y1.y + y1.z * y1.z + y1.w * y1.w; } }
    DI UPre unit_pre(int) const { return UPre{}; }
    DI void unit_begin(int, const UPre&) const {}
    DI RowPre row_pre(int) const { return RowPre{}; }
    DI Pre pre(int row, int col) const { return *(const u32x2*)(RB + (size_t)row * DM + col); }
    DI Ctx row_begin(int, const RowPre&) const { return 0.f; }
    DI void operator()(Ctx& ss, int row, int col, f32x4 v, const Pre& r) const {
        f32x4 y; y.x = __uint_as_float(r.x << 16) + v.x; y.y = __uint_as_float(r.x & 0xffff0000u) + v.y; y.z = __uint_as_float(r.y << 16) + v.z; y.w = __uint_as_float(r.y & 0xffff0000u) + v.w;
        if (FINAL) { *(f32x4*)(Yf + (size_t)row * DM + col) = y; }
        else { u32x2 o; o.x = pk2(y.x, y.y); o.y = pk2(y.z, y.w); *(u32x2*)(RB + (size_t)row * DM + col) = o; ss += y.x * y.x + y.y * y.y + y.z * y.z + y.w * y.w; } }
    DI void row_end(Ctx& ss, int row, int pn, int wc, int fq) const { if (!FINAL) { const float s = xsum32(xsum16(ss)); if (fq == 0) SSQ[(size_t)(pn * 4 + wc) * MT + row] = s; } } };
struct FNull { typedef int Ctx; typedef pg8::NoPre RowPre; typedef pg8::NoPre Pre; typedef pg8::NoPre Pre8; float* sink;
    DI UPre unit_pre(int) const { return UPre{}; }
    DI void unit_begin(int, const UPre&) const {}
    DI RowPre row_pre(int) const { return RowPre{}; }
    DI Pre pre(int, int) const { return Pre{}; }
    DI pg8::NoPre pre8(int, int) const { return pg8::NoPre{}; }
    DI Ctx row_begin(int, const RowPre&) const { return 0; }
    DI void operator()(Ctx&, int row, int col, f32x4 v, const Pre&) const { if (v.x == 1.2345e30f) sink[row + col] = v.y; }
    DI void row_end(Ctx&, int, int, int, int) const {} };
struct FUp { typedef float Ctx; typedef float RowPre; typedef pg8::NoPre Pre; typedef pg8::NoPre Pre8; const float* SSQ; bf16_t* H;
    DI UPre unit_pre(int rowbase) const { return rinv_partial_load(SSQ, rowbase); }
    DI void unit_begin(int, const UPre& sv) const { rinv_table_fill(sv); }
    DI RowPre row_pre(int row) const { return rinv_table_get(row); }
    DI Pre pre(int, int) const { return Pre{}; }
    DI pg8::NoPre pre8(int, int) const { return pg8::NoPre{}; }
    DI Ctx row_begin(int, const RowPre& rp) const { return rp; }
    DI void operator()(Ctx& ri, int row, int col, f32x4 v, const Pre&) const { f32x4 t = v * ri; t.x = fmaxf(t.x, 0.f); t.y = fmaxf(t.y, 0.f); t.z = fmaxf(t.z, 0.f); t.w = fmaxf(t.w, 0.f);
        u32x2 o; o.x = pk2(t.x * t.x, t.y * t.y); o.y = pk2(t.z * t.z, t.w * t.w); *(u32x2*)(H + (size_t)row * DFF + col) = o; }
    DI void op8(Ctx& ri, int row, int col, f32x4 a, f32x4 b, const pg8::NoPre&) const { f32x4 t = a * ri, w = b * ri;
        t.x = fmaxf(t.x, 0.f); t.y = fmaxf(t.y, 0.f); t.z = fmaxf(t.z, 0.f); t.w = fmaxf(t.w, 0.f); w.x = fmaxf(w.x, 0.f); w.y = fmaxf(w.y, 0.f); w.z = fmaxf(w.z, 0.f); w.w = fmaxf(w.w, 0.f);
        u32x4 o; o.x = pk2(t.x * t.x, t.y * t.y); o.y = pk2(t.z * t.z, t.w * t.w); o.z = pk2(w.x * w.x, w.y * w.y); o.w = pk2(w.z * w.z, w.w * w.w); *(u32x4*)(H + (size_t)row * DFF + col) = o; }
    DI void row_end(Ctx&, int, int, int, int) const {} };
struct FRnnIn { typedef float Ctx; typedef float RowPre; typedef pg8::NoPre Pre; typedef pg8::NoPre Pre8; const float* SSQ; bf16_t* GATE; bf16_t* U;
    DI UPre unit_pre(int rowbase) const { return rinv_partial_load(SSQ, rowbase); }
    DI void unit_begin(int, const UPre& sv) const { rinv_table_fill(sv); }
    DI RowPre row_pre(int row) const { return rinv_table_get(row); }
    DI Pre pre(int, int) const { return Pre{}; }
    DI pg8::NoPre pre8(int, int) const { return pg8::NoPre{}; }
    DI Ctx row_begin(int, const RowPre& rp) const { return rp; }
    DI void operator()(Ctx& ri, int row, int col, f32x4 v, const Pre&) const { f32x4 t = v * ri; u32x2 o;
        if (col < DM) { o.x = pk2(gelu_tanh(t.x), gelu_tanh(t.y)); o.y = pk2(gelu_tanh(t.z), gelu_tanh(t.w)); *(u32x2*)(GATE + (size_t)row * DM + col) = o; }
        else { o.x = pk2(t.x, t.y); o.y = pk2(t.z, t.w); *(u32x2*)(U + (size_t)row * DM + col - DM) = o; } }
    DI void op8(Ctx& ri, int row, int col, f32x4 a, f32x4 b, const pg8::NoPre&) const { const f32x4 t = a * ri, w = b * ri; u32x4 o;
        if (col < DM) { o.x = pk2(gelu_tanh(t.x), gelu_tanh(t.y)); o.y = pk2(gelu_tanh(t.z), gelu_tanh(t.w)); o.z = pk2(gelu_tanh(w.x), gelu_tanh(w.y)); o.w = pk2(gelu_tanh(w.z), gelu_tanh(w.w)); *(u32x4*)(GATE + (size_t)row * DM + col) = o; }
        else { o.x = pk2(t.x, t.y); o.y = pk2(t.z, t.w); o.z = pk2(w.x, w.y); o.w = pk2(w.z, w.w); *(u32x4*)(U + (size_t)row * DM + col - DM) = o; } }
    DI void row_end(Ctx&, int, int, int, int) const {} };

typedef float f32x2_t __attribute__((ext_vector_type(2))); typedef __bf16 bf16x2_t __attribute__((ext_vector_type(2)));
DI unsigned cvtpk(float lo, float hi) { f32x2_t v = {lo, hi}; bf16x2_t b = __builtin_convertvector(v, bf16x2_t); return __builtin_bit_cast(unsigned, b); }
struct EpiPartStore { float* PARTS; int part;
    DI void operator()(const f32x4 (&acc)[2][2][4][2], const pg8::Unit& u, int, int, int, int) const {
        const int us = (u.pm - MP / 256) * 4 + u.pn;
        f32x4* p = (f32x4*)(PARTS + (size_t)(us * 16 + part) * 65536) + threadIdx.x;
#pragma unroll
        for (int a = 0; a < 2; ++a)
#pragma unroll
            for (int b = 0; b < 2; ++b)
#pragma unroll
                for (int m = 0; m < 4; ++m)
#pragma unroll
                    for (int n = 0; n < 2; ++n) p[(((a * 2 + b) * 4 + m) * 2 + n) * 512] = acc[a][b][m][n];
    }
};
template <bool FINAL, int WAYS = 16> DI void sample_fixup(int b, const float* __restrict__ PARTS, bf16_t* __restrict__ RB, float* __restrict__ Yf, float* __restrict__ SSQ) {
    if (b >= 128) return;
    const int tid = threadIdx.x, wid = tid >> 6, lane = tid & 63, wr = wid >> 2, wc = wid & 3, fr = lane & 15, fq = lane >> 4;
    const int us = b >> 3, ai = (b >> 2) & 1, m = b & 3, pm = MP / 256 + (us >> 2), pn = us & 3;
    f32x4 v[2][2];
#pragma unroll
    for (int bj = 0; bj < 2; ++bj)
#pragma unroll
        for (int n = 0; n < 2; ++n) v[bj][n] = (f32x4){0.f, 0.f, 0.f, 0.f};
#pragma unroll 4
    for (int p = 0; p < WAYS; ++p) {
        const f32x4* pp = (const f32x4*)(PARTS + (size_t)(us * 16 + p) * 65536) + tid;
#pragma unroll
        for (int bj = 0; bj < 2; ++bj)
#pragma unroll
            for (int n = 0; n < 2; ++n) v[bj][n] += pp[(((ai * 2 + bj) * 4 + m) * 2 + n) * 512];
    }
    const int row = pm * 256 + ai * 128 + wr * 64 + m * 16 + fr, col0 = pn * 256 + wc * 32 + 8 * fq;
    float ss = 0.f;
#pragma unroll
    for (int bj = 0; bj < 2; ++bj)
#pragma unroll
        for (int n = 0; n < 2; ++n) { const size_t off = (size_t)row * DM + col0 + bj * 128 + n * 4; const u32x2 r = *(const u32x2*)(RB + off); const f32x4 a = v[bj][n];
            f32x4 y; y.x = __uint_as_float(r.x << 16) + a.x; y.y = __uint_as_float(r.x & 0xffff0000u) + a.y; y.z = __uint_as_float(r.y << 16) + a.z; y.w = __uint_as_float(r.y & 0xffff0000u) + a.w;
            if (FINAL) *(f32x4*)(Yf + off) = y;
            else { u32x2 o; o.x = pk2(y.x, y.y); o.y = pk2(y.z, y.w); *(u32x2*)(RB + off) = o; ss += y.x * y.x + y.y * y.y + y.z * y.z + y.w * y.w; } }
    if (!FINAL) { ss = xsum32(xsum16(ss)); if (fq == 0) SSQ[(size_t)(pn * 4 + wc) * MT + row] = ss; }
}
template <int SH> DI float dpp_row_shr(float oldv, float v) { return __int_as_float(__builtin_amdgcn_update_dpp(__float_as_int(oldv), __float_as_int(v), 0x110 + SH, 0xF, 0xF, false)); }
template <int SH> DI void scan_step(float& a, float& b, int fseg) {
    float ap = dpp_row_shr<SH>(1.0f, a), bp = dpp_row_shr<SH>(0.0f, b);
    if (fseg < SH) { ap = 1.0f; bp = 0.0f; }
    b = a * bp + b; a = a * ap;
}
struct EpiGates {
    static constexpr bool PERM64 = false, PERM8 = true;
    const bf16_t* V; const float* bga; const float* bgx; const float* lam; bf16_t* HL; bf16_t* AC; float* SUM;
    DI UPre unit_pre(int) const { return UPre{}; }
    DI void operator()(f32x4 (&acc)[2][2][4][2], const pg8::Unit& u, int wr, int wc, int fr, int fq, const UPre&) const {
        const bool isp = u.pm < MP / 256;
        const int chb = u.pn * 128 + wc * 32 + 8 * fq;
        const int rowb = u.pm * 256 + wr * 64 + fr;
        u32x4 vpre[2][4];
#pragma unroll
        for (int ai = 0; ai < 2; ++ai)
#pragma unroll
            for (int m = 0; m < 4; ++m) vpre[ai][m] = *(const u32x4*)(V + (size_t)(rowb + ai * 128 + m * 16) * DM + chb);
#pragma unroll
        for (int n = 0; n < 2; ++n) {
            const f32x4 sp = *(const f32x4*)(lam + chb + 4 * n), ba = *(const f32x4*)(bga + chb + 4 * n), bx = *(const f32x4*)(bgx + chb + 4 * n);
#pragma unroll
            for (int ai = 0; ai < 2; ++ai)
#pragma unroll
                for (int m = 0; m < 4; ++m) {
                    const int row = rowb + ai * 128 + m * 16;
                    const bool pos0 = isp && ((row & (SEQ - 1)) == 0);
                    const unsigned w0 = n == 0 ? vpre[ai][m].x : vpre[ai][m].z, w1 = n == 0 ? vpre[ai][m].y : vpre[ai][m].w;
                    const float v4[4] = {__uint_as_float(w0 << 16), __uint_as_float(w0 & 0xffff0000u), __uint_as_float(w1 << 16), __uint_as_float(w1 & 0xffff0000u)};
#pragma unroll
                    for (int e = 0; e < 4; ++e) {
                        const float r = __builtin_amdgcn_rcpf(1.0f + __builtin_amdgcn_exp2f(-1.4426950408889634f * (acc[ai][0][m][n][e] + ba[e])));
                        const float ig = __builtin_amdgcn_rcpf(1.0f + __builtin_amdgcn_exp2f(-1.4426950408889634f * (acc[ai][1][m][n][e] + bx[e])));
                        const float a = __builtin_amdgcn_exp2f(-r * sp[e]);
                        const float mult = pos0 ? 1.0f : __builtin_amdgcn_sqrtf(fmaxf(1.0f - a * a, 0.0f));
                        acc[ai][0][m][n][e] = a; acc[ai][1][m][n][e] = mult * ig * v4[e];
                    }
                }
        }
        const int fseg = isp ? fr : (fr & 7);
#pragma unroll
        for (int ai = 0; ai < 2; ++ai)
#pragma unroll
            for (int n = 0; n < 2; ++n)
#pragma unroll
                for (int e = 0; e < 4; ++e) {
                    float Ac = 1.0f, Hc = 0.0f;
#pragma unroll
                    for (int m = 0; m < 4; ++m) {
                        float a = acc[ai][0][m][n][e], b = acc[ai][1][m][n][e];
                        scan_step<1>(a, b, fseg); scan_step<2>(a, b, fseg); scan_step<4>(a, b, fseg);
                        if (isp) { scan_step<8>(a, b, fseg); b = a * Hc + b; a = a * Ac; Ac = __int_as_float(__builtin_amdgcn_update_dpp(0, __float_as_int(a), 0x15F, 0xF, 0xF, false)); Hc = __int_as_float(__builtin_amdgcn_update_dpp(0, __float_as_int(b), 0x15F, 0xF, 0xF, false)); }
                        acc[ai][0][m][n][e] = a; acc[ai][1][m][n][e] = b;
                    }
                    if (isp && fr == 15) { float* sm = SUM + ((size_t)(u.pm * 4 + ai * 2 + wr) * DM + chb + 4 * n + e) * 2; sm[0] = Ac; sm[1] = Hc; }
                }
#pragma unroll
        for (int ai = 0; ai < 2; ++ai)
#pragma unroll
            for (int m = 0; m < 4; ++m) {
                const size_t off = (size_t)(rowb + ai * 128 + m * 16) * DM + chb;
                u32x4 oa; oa.x = pk2(acc[ai][0][m][0][0], acc[ai][0][m][0][1]); oa.y = pk2(acc[ai][0][m][0][2], acc[ai][0][m][0][3]); oa.z = pk2(acc[ai][0][m][1][0], acc[ai][0][m][1][1]); oa.w = pk2(acc[ai][0][m][1][2], acc[ai][0][m][1][3]);
                *(u32x4*)(AC + off) = oa;
                u32x4 ob; ob.x = pk2(acc[ai][1][m][0][0], acc[ai][1][m][0][1]); ob.y = pk2(acc[ai][1][m][0][2], acc[ai][1][m][0][3]); ob.z = pk2(acc[ai][1][m][1][0], acc[ai][1][m][1][1]); ob.w = pk2(acc[ai][1][m][1][2], acc[ai][1][m][1][3]);
                *(u32x4*)(HL + off) = ob;
            }
    }
};

#define XB_TMO      128
#define XB_XCNT(j)  (256  + 64 * (j))
#define XB_XSUB(j)  (1280 + 64 * (j))
#define XB_XGEN(j)  (2304 + 64 * (j))
#define XB_TOP      3328
#define XB_TOPGEN   3392
#define XCD_BAR_WORDS 3456
#define XB_SPIN_CAP (1u << 18)
DI unsigned xb_ld(unsigned* p)              { return __hip_atomic_load(p, __ATOMIC_RELAXED, __HIP_MEMORY_SCOPE_AGENT); }
DI unsigned xb_add(unsigned* p, unsigned v) { return __hip_atomic_fetch_add(p, v, __ATOMIC_RELAXED, __HIP_MEMORY_SCOPE_AGENT); }
DI unsigned xb_xcc_id() { return (unsigned)__builtin_amdgcn_s_getreg((3 << 11) | 20) & 0xFu; }
#define XB_SPIN(cond, bar) do { unsigned _sp = 0; while (cond) { __builtin_amdgcn_s_sleep(1); \
    if ((++_sp & 255u) == 0u) { if (xb_ld(&(bar)[XB_TMO])) break; if (_sp > XB_SPIN_CAP) { atomicAdd(&(bar)[XB_TMO], 1u); break; } } } } while (0)
struct XcdBarrier { unsigned* bar; unsigned x; volatile LAS unsigned* st; };
DI XcdBarrier xcd_barrier_post(unsigned* bar, volatile LAS unsigned* st) {
    XcdBarrier b; b.bar = bar; b.x = xb_xcc_id(); b.st = st;
    if (threadIdx.x == 0) (void)xb_add(&bar[XB_XCNT(b.x)], 1u);
    return b;
}
DI void xcd_barrier_complete(unsigned* bar, unsigned x, unsigned& nloc, unsigned& nx) {
    const unsigned G = gridDim.x * gridDim.y * gridDim.z;
    unsigned sum, cnt, mine, sp = 0u;
    for (;;) {
        sum = 0u; cnt = 0u; mine = 0u;
#pragma unroll
        for (unsigned j = 0; j < 16; ++j) { const unsigned c = xb_ld(&bar[XB_XCNT(j)]); sum += c; cnt += (c > 0u) ? 1u : 0u; mine = (j == x) ? c : mine; }
        if (sum == G) break;
        __builtin_amdgcn_s_sleep(1);
        if ((++sp & 255u) == 0u) { if (xb_ld(&bar[XB_TMO])) break; if (sp > XB_SPIN_CAP) { atomicAdd(&bar[XB_TMO], 1u); break; } }
    }
    nloc = mine > 0u ? mine : 1u; nx = cnt > 0u ? cnt : 1u;
}
DI void xcd_barrier(const XcdBarrier& b) {
    asm volatile("s_waitcnt vmcnt(0)" ::: "memory");
    __syncthreads();
    if (threadIdx.x == 0) {
        unsigned* bar = b.bar;
        __builtin_amdgcn_s_waitcnt(0);
        unsigned nloc = b.st[0], nx = b.st[1];
        if (nloc == 0u) { xcd_barrier_complete(bar, b.x, nloc, nx); b.st[0] = nloc; b.st[1] = nx; }
        const unsigned old = xb_add(&bar[XB_XSUB(b.x)], 1u);
        const unsigned gen = old / nloc;
        if (old + 1u == (gen + 1u) * nloc) {
            __builtin_amdgcn_fence(__ATOMIC_RELEASE, "agent");
            asm volatile("s_waitcnt vmcnt(0)" ::: "memory");
            const unsigned og = xb_add(&bar[XB_TOP], 1u);
            const unsigned tg = og / nx;
            if (og + 1u == (tg + 1u) * nx) xb_add(&bar[XB_TOPGEN], 1u);
            else XB_SPIN(xb_ld(&bar[XB_TOPGEN]) == tg, bar);
            __builtin_amdgcn_fence(__ATOMIC_ACQUIRE, "agent");
            xb_add(&bar[XB_XGEN(b.x)], 1u);
            asm volatile("s_waitcnt vmcnt(0)" ::: "memory");
        } else {
            XB_SPIN(xb_ld(&bar[XB_XGEN(b.x)]) == gen, bar);
            __builtin_amdgcn_fence(__ATOMIC_ACQUIRE, "agent");
            asm volatile("s_waitcnt vmcnt(0)" ::: "memory");
        }
    }
    __syncthreads();
}

struct Args { const void* in[32]; float* out; unsigned char* ws; int ph_lo, ph_hi; };
static_assert(sizeof(Args) == 32 * 8 + 8 + 8 + 8, "Args has no padding");

DI void p0_transpose_item(const float* __restrict__ W, int lds_, int N, bf16_t* __restrict__ WT, int ldd, const float* __restrict__ gain, LAS float* scr, int item, int lane) {
    const int nblk = N / 32, kb = item / nblk, nb = item % nblk, k0 = 64 * kb, n0 = 32 * nb;
#pragma unroll 8
    for (int i = 0; i < 32; ++i) { const int kk = 2 * i + (lane >> 5); const float gsc = gain ? gain[k0 + kk] : 1.f; scr[kk * 33 + (lane & 31)] = W[(size_t)(k0 + kk) * lds_ + n0 + (lane & 31)] * gsc; }
    asm volatile("s_waitcnt lgkmcnt(0)" ::: "memory");
    const int c = lane & 7;
#pragma unroll
    for (int j = 0; j < 4; ++j) { const int n = (lane >> 3) + 8 * j; const LAS float* s = scr + (8 * c) * 33 + n;
        u32x4 o; o.x = pk2(s[0 * 33], s[1 * 33]); o.y = pk2(s[2 * 33], s[3 * 33]); o.z = pk2(s[4 * 33], s[5 * 33]); o.w = pk2(s[6 * 33], s[7 * 33]);
        *(u32x4*)(WT + (size_t)(n0 + n) * ldd + k0 + 8 * c) = o; }
    asm volatile("s_waitcnt lgkmcnt(0)" ::: "memory");
}
DI void rowprep_row(const float* __restrict__ src, int row, bf16_t* __restrict__ XB, float* __restrict__ SSQ, int lane) {
    f32x4 v[4]; float ss = 0.f;
#pragma unroll
    for (int j = 0; j < 4; ++j) { v[j] = ((const f32x4*)src)[lane + 64 * j]; ss += v[j].x * v[j].x + v[j].y * v[j].y + v[j].z * v[j].z + v[j].w * v[j].w; }
    ss = wave_sum(ss);
#pragma unroll
    for (int j = 0; j < 4; ++j) { u32x2 o; o.x = pk2(v[j].x, v[j].y); o.y = pk2(v[j].z, v[j].w); ((u32x2*)(XB + (size_t)row * DM))[lane + 64 * j] = o; }
    if (lane < 16) SSQ[(size_t)lane * MT + row] = lane == 0 ? ss : 0.f;
}

DI void unpack4(u32x2 r, float (&x)[4]) { x[0] = __uint_as_float(r.x << 16); x[1] = __uint_as_float(r.x & 0xffff0000u); x[2] = __uint_as_float(r.y << 16); x[3] = __uint_as_float(r.y & 0xffff0000u); }
DI void post0_row(int row, int lane, const bf16_t* __restrict__ Z0, const float* __restrict__ ROPET, const float* __restrict__ g_q_nope, const float* __restrict__ g_q_rope,
                  const float* __restrict__ g_ckv, const float* __restrict__ g_k_rope, bf16_t* __restrict__ QB, bf16_t* __restrict__ CB, bf16_t* __restrict__ KRB, float* __restrict__ out) {
    const bf16_t* z = Z0 + (size_t)row * NZ0;
    const bool isp = row < MP; const int pidx = isp ? (row & (SEQ - 1)) : SEQ + ((row - MP) & 7);
    { const int d = 4 * (lane & 15); const f32x4 g4 = *(const f32x4*)(g_q_nope + d);
#pragma unroll
      for (int hh = 0; hh < 2; ++hh) {
        const int h = 4 * hh + (lane >> 4); float x[4]; unpack4(*(const u32x2*)(z + POOLD + QKH * h + d), x);
        float ss = x[0] * x[0] + x[1] * x[1] + x[2] * x[2] + x[3] * x[3];
        ss = sum16(ss);
        const float ri = rsqrtf(ss * (1.f / 64.f) + EPS) * QSCALE;
        u32x2 o; o.x = pk2(x[0] * ri * g4.x, x[1] * ri * g4.y); o.y = pk2(x[2] * ri * g4.z, x[3] * ri * g4.w);
        *(u32x2*)(QB + (size_t)row * QDIM + QKH * h + d) = o; } }
    { const int r = 4 * (lane & 7), i0 = r & 15; const bool second = (lane & 4) != 0;
      const f32x4 t0 = *(const f32x4*)(ROPET + ((size_t)pidx * 16 + i0) * 2), t1 = *(const f32x4*)(ROPET + ((size_t)pidx * 16 + i0) * 2 + 4);
      const float cs[4] = {t0.x, t0.z, t1.x, t1.z}, sn[4] = {t0.y, t0.w, t1.y, t1.w};
      { const int h = lane >> 3; float x[4]; unpack4(*(const u32x2*)(z + POOLD + QKH * h + 64 + r), x);
        float ss = x[0] * x[0] + x[1] * x[1] + x[2] * x[2] + x[3] * x[3];
        ss = sum8(ss);
        const float ri = rsqrtf(ss * (1.f / 32.f) + EPS); const f32x4 g4 = *(const f32x4*)(g_q_rope + r);
        float y[4] = {x[0] * ri * g4.x, x[1] * ri * g4.y, x[2] * ri * g4.z, x[3] * ri * g4.w}, o[4];
#pragma unroll
        for (int e = 0; e < 4; ++e) { const float p = xchg4(y[e], second); o[e] = (second ? (p * sn[e] + y[e] * cs[e]) : (y[e] * cs[e] - p * sn[e])) * QSCALE; }
        u32x2 w; w.x = pk2(o[0], o[1]); w.y = pk2(o[2], o[3]); *(u32x2*)(QB + (size_t)row * QDIM + QKH * h + 64 + r) = w; }
      { float x[4]; unpack4(*(const u32x2*)(z + POOLD + QDIM + KVR + r), x);
        float ss = x[0] * x[0] + x[1] * x[1] + x[2] * x[2] + x[3] * x[3];
        ss = sum8(ss);
        const float ri = rsqrtf(ss * (1.f / 32.f) + EPS); const f32x4 g4 = *(const f32x4*)(g_k_rope + r);
        float y[4] = {x[0] * ri * g4.x, x[1] * ri * g4.y, x[2] * ri * g4.z, x[3] * ri * g4.w}; f32x4 o;
#pragma unroll
        for (int e = 0; e < 4; ++e) { const float p = xchg4(y[e], second); o[e] = second ? (p * sn[e] + y[e] * cs[e]) : (y[e] * cs[e] - p * sn[e]); }
        if (lane < 8) { u32x2 w; w.x = pk2(o[0], o[1]); w.y = pk2(o[2], o[3]); *(u32x2*)(KRB + (size_t)row * ROPE + r) = w;
            float* ko = isp ? out + O_KR_P + (size_t)row * ROPE : out + O_KR_S + (size_t)(row - MP) * ROPE; *(f32x4*)(ko + r) = o; } } }
    { float x[4]; unpack4(*(const u32x2*)(z + POOLD + QDIM + lane * 4), x);
      float ss = wave_sum(x[0] * x[0] + x[1] * x[1] + x[2] * x[2] + x[3] * x[3]); const float ri = rsqrtf(ss * (1.f / 256.f) + EPS);
      const f32x4 g4 = *(const f32x4*)(g_ckv + lane * 4);
      f32x4 y; y.x = x[0] * ri * g4.x; y.y = x[1] * ri * g4.y; y.z = x[2] * ri * g4.z; y.w = x[3] * ri * g4.w;
      u32x2 o; o.x = pk2(y.x, y.y); o.y = pk2(y.z, y.w); *(u32x2*)(CB + (size_t)row * KVR + lane * 4) = o;
      float* co = isp ? out + O_CKV_P + (size_t)row * KVR : out + O_CKV_S + (size_t)(row - MP) * KVR; *(f32x4*)(co + lane * 4) = y; }
}
DI void load8(const bf16_t* p, float (&x)[8]) { const u32x4 r = *(const u32x4*)p;
#pragma unroll
    for (int e = 0; e < 4; ++e) { x[2 * e] = __uint_as_float(r[e] << 16); x[2 * e + 1] = __uint_as_float(r[e] & 0xffff0000u); } }
template <bool ISP> DI void pool_item(int row0, int nrows, int ch, const bf16_t* __restrict__ Z0, const float* __restrict__ state_pool, bf16_t* __restrict__ DBuf, float* __restrict__ out) {
    const int w = 2 << (ch >> 7);
    const int t0 = ISP ? (row0 & (SEQ - 1)) : 0, bb = ISP ? (row0 >> 12) : ((row0 - MP) >> 3);
    float S[8];
#pragma unroll
    for (int e = 0; e < 8; ++e) S[e] = 0.f;
    for (int j = 1; j < w; ++j) { const int tj = t0 - j; float x[8];
        if (tj >= 0) { load8(Z0 + (size_t)(row0 - j) * NZ0 + ch, x); }
        else if (!ISP) { const float* hp = state_pool + ((size_t)bb * 15 + (15 + tj)) * POOLD + ch; const f32x4 a = *(const f32x4*)hp, b = *(const f32x4*)(hp + 4); x[0] = a.x; x[1] = a.y; x[2] = a.z; x[3] = a.w; x[4] = b.x; x[5] = b.y; x[6] = b.z; x[7] = b.w; }
        else {
#pragma unroll
            for (int e = 0; e < 8; ++e) x[e] = 0.f; }
#pragma unroll
        for (int e = 0; e < 8; ++e) S[e] += x[e]; }
    for (int i = 0; i < nrows; ++i) {
        const int t = t0 + i, row = row0 + i; float u[8]; load8(Z0 + (size_t)row * NZ0 + ch, u);
        const float icnt = 1.0f / (ISP ? (float)((t + 1) < w ? (t + 1) : w) : (float)w);
        u32x4 o;
#pragma unroll
        for (int e = 0; e < 8; ++e) S[e] += u[e];
#pragma unroll
        for (int e = 0; e < 4; ++e) o[e] = pk2(S[2 * e] * icnt - u[2 * e], S[2 * e + 1] * icnt - u[2 * e + 1]);
        *(u32x4*)(DBuf + (size_t)row * POOLD + ch) = o;
        { const int tj = t - w + 1; float x[8];
          if (tj >= 0) { load8(Z0 + (size_t)(row - w + 1) * NZ0 + ch, x); }
          else if (!ISP) { const float* hp = state_pool + ((size_t)bb * 15 + (15 + tj)) * POOLD + ch; const f32x4 a = *(const f32x4*)hp, b = *(const f32x4*)(hp + 4); x[0] = a.x; x[1] = a.y; x[2] = a.z; x[3] = a.w; x[4] = b.x; x[5] = b.y; x[6] = b.z; x[7] = b.w; }
          else {
#pragma unroll
              for (int e = 0; e < 8; ++e) x[e] = 0.f; }
#pragma unroll
          for (int e = 0; e < 8; ++e) S[e] -= x[e]; }
        if (ISP) { if (t >= SEQ - 15) { float* op = out + O_POOL_P + ((size_t)bb * 15 + (t - (SEQ - 15))) * POOLD + ch; *(f32x4*)op = (f32x4){u[0], u[1], u[2], u[3]}; *(f32x4*)(op + 4) = (f32x4){u[4], u[5], u[6], u[7]}; } }
        else { float* op = out + O_POOL_S + ((size_t)bb * 15 + 7 + t) * POOLD + ch; *(f32x4*)op = (f32x4){u[0], u[1], u[2], u[3]}; *(f32x4*)(op + 4) = (f32x4){u[4], u[5], u[6], u[7]}; }
    }
    if (!ISP) { for (int i = 0; i < 7; ++i) { const float* hp = state_pool + ((size_t)bb * 15 + 8 + i) * POOLD + ch; float* op = out + O_POOL_S + ((size_t)bb * 15 + i) * POOLD + ch; *(f32x4*)op = *(const f32x4*)hp; *(f32x4*)(op + 4) = *(const f32x4*)(hp + 4); } }
}
template <bool ISP> DI void conv_item(int row0, int nrows, int ch, const bf16_t* __restrict__ U, const float* __restrict__ state_conv, const float* __restrict__ conv_w, const float* __restrict__ conv_b,
                                      bf16_t* __restrict__ V, float* __restrict__ out) {
    const int t0 = ISP ? (row0 & (SEQ - 1)) : 0, bb = ISP ? (row0 >> 12) : ((row0 - MP) >> 3);
    float wk[4][8], bs[8], hist[3][8];
#pragma unroll
    for (int k = 0; k < 4; ++k) { const f32x4 a = *(const f32x4*)(conv_w + k * DM + ch), b = *(const f32x4*)(conv_w + k * DM + ch + 4); wk[k][0] = a.x; wk[k][1] = a.y; wk[k][2] = a.z; wk[k][3] = a.w; wk[k][4] = b.x; wk[k][5] = b.y; wk[k][6] = b.z; wk[k][7] = b.w; }
    { const f32x4 a = *(const f32x4*)(conv_b + ch), b = *(const f32x4*)(conv_b + ch + 4); bs[0] = a.x; bs[1] = a.y; bs[2] = a.z; bs[3] = a.w; bs[4] = b.x; bs[5] = b.y; bs[6] = b.z; bs[7] = b.w; }
#pragma unroll
    for (int j = 0; j < 3; ++j) {
        const int tj = t0 - 3 + j;
        if (tj >= 0) load8(U + (size_t)(row0 - 3 + j) * DM + ch, hist[j]);
        else if (!ISP) { const float* hp = state_conv + ((size_t)bb * 3 + (3 + tj)) * DM + ch; const f32x4 a = *(const f32x4*)hp, b = *(const f32x4*)(hp + 4); hist[j][0] = a.x; hist[j][1] = a.y; hist[j][2] = a.z; hist[j][3] = a.w; hist[j][4] = b.x; hist[j][5] = b.y; hist[j][6] = b.z; hist[j][7] = b.w; }
        else {
#pragma unroll
            for (int e = 0; e < 8; ++e) hist[j][e] = 0.f; }
    }
    for (int i = 0; i < nrows; ++i) {
        const int t = t0 + i, row = row0 + i; float u[8]; load8(U + (size_t)row * DM + ch, u);
        u32x4 o; float v[8];
#pragma unroll
        for (int e = 0; e < 8; ++e) v[e] = bs[e] + hist[0][e] * wk[0][e] + hist[1][e] * wk[1][e] + hist[2][e] * wk[2][e] + u[e] * wk[3][e];
#pragma unroll
        for (int e = 0; e < 4; ++e) o[e] = pk2(v[2 * e], v[2 * e + 1]);
        *(u32x4*)(V + (size_t)row * DM + ch) = o;
#pragma unroll
        for (int e = 0; e < 8; ++e) { hist[0][e] = hist[1][e]; hist[1][e] = hist[2][e]; hist[2][e] = u[e]; }
        const int tl = ISP ? SEQ - 3 : DT - 3;
        if (t >= tl) { float* op = out + (ISP ? O_CONV_P : O_CONV_S) + ((size_t)bb * 3 + (t - tl)) * DM + ch; *(f32x4*)op = (f32x4){u[0], u[1], u[2], u[3]}; *(f32x4*)(op + 4) = (f32x4){u[4], u[5], u[6], u[7]}; }
    }
}

DI void attn_p_naive_item(int item, int lane, LAS float* sc, const bf16_t* __restrict__ QB, const bf16_t* __restrict__ KV, const bf16_t* __restrict__ KRB, bf16_t* __restrict__ MIX) {
    LAS float* qs = sc + SEQ;
    const int row = item >> 3, h = item & 7, b = row >> 12, t = row & (SEQ - 1);
    for (int i = lane; i < QKH; i += 64) qs[i] = bf2f(QB[(size_t)row * QDIM + h * QKH + i]);
    asm volatile("s_waitcnt lgkmcnt(0)" ::: "memory");
    float mx = -INFINITY;
    for (int j0 = 0; j0 <= t; j0 += 64) {
        const int j = j0 + lane;
        if (j <= t) {
            const bf16_t* kr = KV + (size_t)(b * SEQ + j) * 1024 + h * 64; const bf16_t* rr = KRB + (size_t)(b * SEQ + j) * ROPE;
            float s = 0.f;
            for (int d = 0; d < 64; ++d) s += qs[d] * bf2f(kr[d]);
            for (int d = 0; d < 32; ++d) s += qs[64 + d] * bf2f(rr[d]);
            sc[j] = s; mx = fmaxf(mx, s);
        }
    }
    mx = wave_max(mx);
    float sum = 0.f;
    for (int j = lane; j <= t; j += 64) { const float p = exp2f(sc[j] - mx); sc[j] = p; sum += p; }
    sum = wave_sum(sum);
    asm volatile("s_waitcnt lgkmcnt(0)" ::: "memory");
    float acc = 0.f;
    for (int j = 0; j <= t; ++j) acc += sc[j] * bf2f(KV[(size_t)(b * SEQ + j) * 1024 + 512 + h * 64 + lane]);
    MIX[(size_t)row * DM + 512 + h * 64 + lane] = (bf16_t)f2bf(acc / sum);
    asm volatile("s_waitcnt lgkmcnt(0)" ::: "memory");
}


typedef short v4i16_t __attribute__((ext_vector_type(4)));
DI int crow(int r, int hi) { return (r & 3) + 8 * (r >> 2) + 4 * hi; }
constexpr int AP_KS = 12288, AP_VS = 8192, AP_LK = 0, AP_LV = 2 * AP_KS;
DI void attn_p_unit(int b, int h, int qb, LAS unsigned char* lds, const bf16_t* __restrict__ QB, const bf16_t* __restrict__ KV, const bf16_t* __restrict__ KRB, bf16_t* __restrict__ MIX) {
    const int tid = threadIdx.x, lane = tid & 63, r32 = lane & 31, hi = lane >> 5, wid = __builtin_amdgcn_readfirstlane(tid >> 6);
    const int rowbase = b * SEQ, q0 = qb * 256, NT = 4 * (qb + 1);
    const bf16_t* ksrc0 = KV + (size_t)(rowbase + lane) * 1024 + h * 64 + wid * 8;
    const bf16_t* ksrc1 = KRB + (size_t)(rowbase + lane) * ROPE + (wid & 3) * 8;
    const bf16_t* vsrc = KV + (size_t)(rowbase + 16 * (wid & 3) + (lane >> 2)) * 1024 + 512 + h * 64 + (wid >> 2) * 32 + (lane & 3) * 8;
#define AP_DMA(t, slot) do { \
        __builtin_amdgcn_global_load_lds((const unsigned*)(ksrc0 + (size_t)(t) * 64 * 1024), (LAS unsigned*)(lds + AP_LK + (slot) * AP_KS + wid * 1024), 16, 0, 0); \
        if (wid < 4) __builtin_amdgcn_global_load_lds((const unsigned*)(ksrc1 + (size_t)(t) * 64 * ROPE), (LAS unsigned*)(lds + AP_LK + (slot) * AP_KS + (8 + wid) * 1024), 16, 0, 0); \
        __builtin_amdgcn_global_load_lds((const unsigned*)(vsrc + (size_t)(t) * 64 * 1024), (LAS unsigned*)(lds + AP_LV + (slot) * AP_VS + wid * 1024), 16, 0, 0); } while (0)
    AP_DMA(0, 0);
    bf16x8 qr[6];
    { const bf16_t* qw = QB + (size_t)(rowbase + q0 + wid * 32 + r32) * QDIM + h * QKH + hi * 8;
#pragma unroll
      for (int d0 = 0; d0 < 6; ++d0) qr[d0] = *(const bf16x8*)(qw + d0 * 16); }
    float m = 0.f, l = 0.f;
    f32x16 o0, o1, negm;
#pragma unroll
    for (int r = 0; r < 16; ++r) { o0[r] = 0.f; o1[r] = 0.f; negm[r] = 0.f; }
    const int qrel = wid * 32 + r32;
    const int voff = (4 * hi + ((lane & 15) >> 2)) * 64 + ((lane >> 4) & 1) * 32 + (lane & 3) * 8;
    for (int t = 0; t < NT; ++t) {
        asm volatile("s_waitcnt vmcnt(0)" ::: "memory"); __builtin_amdgcn_s_barrier(); asm volatile("" ::: "memory");
        if (t + 1 < NT) AP_DMA(t + 1, (t + 1) & 1);
        const int slot = t & 1, trel = t - (NT - 4);
        if (trel < 0 || 64 * trel <= 32 * wid + 31) {
            const LAS unsigned char* kb = lds + AP_LK + slot * AP_KS + hi * 1024 + r32 * 16;
            f32x16 p0, p1;
            __builtin_amdgcn_s_setprio(1);
#pragma unroll
            for (int d0 = 0; d0 < 6; ++d0) {
                const bf16x8 k0 = *(const LAS bf16x8*)(kb + d0 * 2048), k1 = *(const LAS bf16x8*)(kb + d0 * 2048 + 512);
                p0 = __builtin_amdgcn_mfma_f32_32x32x16_bf16(k0, qr[d0], d0 == 0 ? negm : p0, 0, 0, 0);
                p1 = __builtin_amdgcn_mfma_f32_32x32x16_bf16(k1, qr[d0], d0 == 0 ? negm : p1, 0, 0, 0);
            }
            __builtin_amdgcn_s_setprio(0);
            if (trel >= 0) {
#pragma unroll
                for (int r = 0; r < 16; ++r) { const int kp = 64 * trel + crow(r, hi); if (kp > qrel) p0[r] = -INFINITY; if (kp + 32 > qrel) p1[r] = -INFINITY; }
            }
            float mx = max3f(p0[0], p1[0], p0[1]);
#pragma unroll
            for (int r = 1; r < 16; ++r) mx = (r < 15) ? max3f(mx, p1[r], p0[r + 1]) : fmaxf(mx, p1[r]);
            mx = xmax32(mx);
            float ps = 0.f;
#pragma unroll
            for (int r = 0; r < 16; ++r) { p0[r] = __builtin_amdgcn_exp2f(p0[r]); p1[r] = __builtin_amdgcn_exp2f(p1[r]); ps += p0[r] + p1[r]; }
            l += ps;
            const LAS unsigned char* vb = lds + AP_LV + slot * AP_VS + voff;
            __builtin_amdgcn_s_setprio(1);
#pragma unroll
            for (int ks = 0; ks < 4; ++ks) {
                u32x4 pw;
                if (ks < 2) { pw.x = cvtpk(p0[8 * ks], p0[8 * ks + 1]); pw.y = cvtpk(p0[8 * ks + 2], p0[8 * ks + 3]); pw.z = cvtpk(p0[8 * ks + 4], p0[8 * ks + 5]); pw.w = cvtpk(p0[8 * ks + 6], p0[8 * ks + 7]); }
                else { const int s8 = 8 * (ks - 2); pw.x = cvtpk(p1[s8], p1[s8 + 1]); pw.y = cvtpk(p1[s8 + 2], p1[s8 + 3]); pw.z = cvtpk(p1[s8 + 4], p1[s8 + 5]); pw.w = cvtpk(p1[s8 + 6], p1[s8 + 7]); }
                const bf16x8 pa = __builtin_bit_cast(bf16x8, pw);
#pragma unroll
                for (int db = 0; db < 2; ++db) {
                    const v4i16_t lo = __builtin_amdgcn_ds_read_tr16_b64_v4i16((LAS v4i16_t*)(vb + db * 4096 + ks * 1024));
                    const v4i16_t hh = __builtin_amdgcn_ds_read_tr16_b64_v4i16((LAS v4i16_t*)(vb + db * 4096 + ks * 1024 + 512));
                    const bf16x8 vf = (bf16x8){lo[0], lo[1], lo[2], lo[3], hh[0], hh[1], hh[2], hh[3]};
                    if (db == 0) o0 = __builtin_amdgcn_mfma_f32_32x32x16_bf16(vf, pa, o0, 0, 0, 0);
                    else o1 = __builtin_amdgcn_mfma_f32_32x32x16_bf16(vf, pa, o1, 0, 0, 0);
                }
            }
            __builtin_amdgcn_s_setprio(0);
            const float mn = (t == 0) ? mx : fmaxf(mx, 0.f);
            if (__any(mn != 0.f)) {
                const float f = __builtin_amdgcn_exp2f(-mn); l *= f; m += mn;
#pragma unroll
                for (int r = 0; r < 16; ++r) { o0[r] *= f; o1[r] *= f; negm[r] = -m; }
            }
        }
    }
    l = xsum32(l);
    const float il = 1.0f / l;
    bf16_t* orow = MIX + (size_t)(rowbase + q0 + wid * 32 + r32) * DM + 512 + h * 64 + 4 * hi;
#pragma unroll
    for (int g = 0; g < 4; ++g) {
        u32x2 a; a.x = cvtpk(o0[4 * g] * il, o0[4 * g + 1] * il); a.y = cvtpk(o0[4 * g + 2] * il, o0[4 * g + 3] * il); *(u32x2*)(orow + 8 * g) = a;
        u32x2 c; c.x = cvtpk(o1[4 * g] * il, o1[4 * g + 1] * il); c.y = cvtpk(o1[4 * g + 2] * il, o1[4 * g + 3] * il); *(u32x2*)(orow + 32 + 8 * g) = c;
    }
#undef AP_DMA
}


constexpr int SA_CB_ROW = 576, SA_CB_SZ = 64 * SA_CB_ROW;
constexpr int SA_C8_ROW = 272, SA_C8_SZ = 64 * SA_C8_ROW;
constexpr int SA_KR_ROW = 96, SA_KR_SZ = 64 * SA_KR_ROW;
constexpr int SA_CB = 0, SA_C8 = 2 * SA_CB_SZ, SA_KRB = SA_C8 + 2 * SA_C8_SZ;
constexpr int SA_P = SA_KRB + 2 * SA_KR_SZ, SA_P_ROW = 144;
constexpr int SA_QF = SA_P + 64 * SA_P_ROW;
constexpr int SA_F = SA_QF + 8 * 3 * 4 * 8 * 16;
constexpr int SA_END = SA_F + 256;
static_assert(SA_END <= LDS_MISC, "sample attention LDS map");
DI int sa_swz(int x) { return (0x78 >> (2 * x)) & 3; }
DI int sa_g8(int x) { return (0x28 >> (2 * x)) & 3; }
typedef int v8i_t __attribute__((ext_vector_type(8)));
typedef float f32x4v __attribute__((ext_vector_type(4)));

template <int VAR> DI void attn_s_unit(int unit, LAS unsigned char* lds, const float* __restrict__ cache_ckv, const float* __restrict__ cache_kr, const int* __restrict__ page_table, const bf16_t* __restrict__ QB,
                    const bf16_t* __restrict__ WKVT, const float* __restrict__ g_k_nope, float* __restrict__ LATP, float* __restrict__ ML) {
    constexpr int hot = VAR != 0;
    const int tid = threadIdx.x, lane = tid & 63, r32 = lane & 31, hi = lane >> 5, l15 = lane & 15, quad = lane >> 4, w = __builtin_amdgcn_readfirstlane(tid >> 6);
    const int sb = unit >> 1, split = unit & 1;
    const int* pt = page_table + sb * NPAGES + split * 32;
    for (int e = tid; e < 8 * 3 * 4 * 8; e += NTHR) {
        const int q = e & 7, qd = (e >> 3) & 3, st = (e >> 5) % 3, h = e / 96;
        const bf16_t* qp = QB + (size_t)(MP + sb * DT + q) * QDIM + h * QKH;
        unsigned pk[4];
#pragma unroll
        for (int jj = 0; jj < 4; ++jj) {
            float v0, v1;
            if (st < 2) { const int j0 = 2 * jj, j1 = 2 * jj + 1; const int d0 = 32 * st + 16 * (j0 >> 2) + 4 * qd + (j0 & 3), d1 = 32 * st + 16 * (j1 >> 2) + 4 * qd + (j1 & 3); v0 = bf2f(qp[d0]) * g_k_nope[d0]; v1 = bf2f(qp[d1]) * g_k_nope[d1]; }
            else { const int r0 = 8 * qd + 2 * jj; v0 = bf2f(qp[64 + r0]); v1 = bf2f(qp[64 + r0 + 1]); }
            pk[jj] = pk2(v0, v1);
        }
        *(LAS u32x4*)(lds + SA_QF + e * 16) = (u32x4){pk[0], pk[1], pk[2], pk[3]};
    }
    v8i_t wf[4][2];
#pragma unroll
    for (int db = 0; db < 4; ++db)
#pragma unroll
        for (int ch = 0; ch < 2; ++ch) {
            const bf16_t* wp = WKVT + (size_t)(w * 64 + 16 * db + l15) * KVR + 128 * ch + 32 * quad;
#pragma unroll
            for (int i = 0; i < 4; ++i) { const u32x4 r = *(const u32x4*)(wp + 8 * i); int lo = 0, hi2 = 0;
                lo = __builtin_amdgcn_cvt_pk_fp8_f32(__uint_as_float(r.x << 16) * 16.f, __uint_as_float(r.x & 0xffff0000u) * 16.f, lo, false);
                lo = __builtin_amdgcn_cvt_pk_fp8_f32(__uint_as_float(r.y << 16) * 16.f, __uint_as_float(r.y & 0xffff0000u) * 16.f, lo, true);
                hi2 = __builtin_amdgcn_cvt_pk_fp8_f32(__uint_as_float(r.z << 16) * 16.f, __uint_as_float(r.z & 0xffff0000u) * 16.f, hi2, false);
                hi2 = __builtin_amdgcn_cvt_pk_fp8_f32(__uint_as_float(r.w << 16) * 16.f, __uint_as_float(r.w & 0xffff0000u) * 16.f, hi2, true);
                wf[db][ch][2 * i] = lo; wf[db][ch][2 * i + 1] = hi2; }
        }
    const __amdgpu_buffer_rsrc_t rs_c = __builtin_amdgcn_make_buffer_rsrc((void*)cache_ckv, (short)0, (int)((size_t)(NPAGES * DB_ + NPAGES * DB_ / 4) * PAGE * KVR * 4), 0x00020000);
    const __amdgpu_buffer_rsrc_t rs_k = __builtin_amdgcn_make_buffer_rsrc((void*)cache_kr, (short)0, (int)((size_t)(NPAGES * DB_ + NPAGES * DB_ / 4) * PAGE * ROPE * 4), 0x00020000);
    const int dma_voff = lane * 16;
    u32x4 pf[9];
#define SA_LOAD(t) do { const unsigned prow = (unsigned)__builtin_amdgcn_readfirstlane(pt[hot ? 0 : ((t) >> 1)]) * PAGE + 64 * ((t) & 1) + 8 * w; \
        _Pragma("unroll") for (int i = 0; i < 8; ++i) pf[i] = __builtin_amdgcn_raw_buffer_load_b128(rs_c, dma_voff, (prow + i) * (KVR * 4), 0); \
        pf[8] = __builtin_amdgcn_raw_buffer_load_b128(rs_k, dma_voff, prow * (ROPE * 4), 0); } while (0)
    SA_LOAD(0);
    float m = 0.f, negm = 0.f, l = 0.f;
    f32x16 lat0, lat1;
#pragma unroll
    for (int r = 0; r < 16; ++r) { lat0[r] = 0.f; lat1[r] = 0.f; }
    const bool qreal = l15 < 8;
    const int g8_ = sa_g8((l15 >> 2) & 3);
    const LAS unsigned char* c8a0 = lds + SA_C8 + l15 * SA_C8_ROW + (((2 * quad) ^ g8_) * 16);
    const LAS unsigned char* c8b0 = lds + SA_C8 + l15 * SA_C8_ROW + (((2 * quad + 1) ^ g8_) * 16);
    const LAS unsigned char* qfbase = lds + SA_QF + (((w * 3) * 4 + quad) * 8 + (l15 & 7)) * 16;
    const LAS unsigned char* krbase0 = lds + SA_KRB + l15 * SA_KR_ROW + quad * 16;
    LAS unsigned char* pwbase = lds + SA_P + (8 * w + l15) * SA_P_ROW + quad * 8;
    asm volatile("s_waitcnt lgkmcnt(0)" ::: "memory"); __builtin_amdgcn_s_barrier(); asm volatile("" ::: "memory");
    bf16x8 q0 = *(const LAS bf16x8*)(qfbase), q1 = *(const LAS bf16x8*)(qfbase + 512), q2 = *(const LAS bf16x8*)(qfbase + 1024);
    if (!qreal) { q0 = (bf16x8){0, 0, 0, 0, 0, 0, 0, 0}; q1 = q0; q2 = q0; }
    LAS unsigned char* cvw0 = lds + SA_CB + 8 * w * SA_CB_ROW + (((lane >> 1) ^ sa_swz((2 * w) & 3)) * 16) + (lane & 1) * 8;
    LAS unsigned char* cvw1 = lds + SA_CB + 8 * w * SA_CB_ROW + (((lane >> 1) ^ sa_swz((2 * w + 1) & 3)) * 16) + (lane & 1) * 8;
    LAS unsigned char* c8w0 = lds + SA_C8 + 8 * w * SA_C8_ROW + (((lane >> 2) ^ sa_g8((2 * w) & 3)) * 16) + (lane & 3) * 4;
    LAS unsigned char* c8w1 = lds + SA_C8 + 8 * w * SA_C8_ROW + (((lane >> 2) ^ sa_g8((2 * w + 1) & 3)) * 16) + (lane & 3) * 4;
    LAS unsigned char* krw = lds + SA_KRB + (8 * w + (lane >> 3)) * SA_KR_ROW + (lane & 7) * 8;
    const int kr0 = 8 * hi + (l15 >> 2), cc0 = 4 * w + 2 * ((lane >> 4) & 1) + ((lane & 3) >> 1);
    const LAS unsigned char* trlo = lds + SA_CB + kr0 * SA_CB_ROW + ((cc0 ^ (hi ? 3 : 0)) * 16) + (lane & 1) * 8;
    const LAS unsigned char* trhi = lds + SA_CB + (kr0 + 4) * SA_CB_ROW + ((cc0 ^ (hi ? 1 : 2)) * 16) + (lane & 1) * 8;
    const LAS unsigned char* prd = lds + SA_P + r32 * SA_P_ROW + hi * 16;
    const LAS float* frd = (const LAS float*)(lds + SA_F + r32 * 4);
    for (int t2 = 0; t2 < 64; t2 += 2) {
#pragma unroll
      for (int tb = 0; tb < 2; ++tb) {
        const int t = t2 + tb;
        asm volatile("s_waitcnt vmcnt(0)" ::: "memory");
        if (VAR != 5) {
#pragma unroll
            for (int i = 0; i < 8; ++i) {
                const f32x4 v = __builtin_bit_cast(f32x4, pf[i]);
                u32x2 o; o.x = cvtpk(v.x, v.y); o.y = cvtpk(v.z, v.w);
                *(LAS u32x2*)((i < 4 ? cvw0 : cvw1) + tb * SA_CB_SZ + i * SA_CB_ROW) = o;
                int f8 = __builtin_amdgcn_cvt_pk_fp8_f32(v.x, v.y, 0, false); f8 = __builtin_amdgcn_cvt_pk_fp8_f32(v.z, v.w, f8, true);
                *(LAS int*)((i < 4 ? c8w0 : c8w1) + tb * SA_C8_SZ + i * SA_C8_ROW) = f8;
            }
            { const f32x4 v = __builtin_bit_cast(f32x4, pf[8]); u32x2 o; o.x = cvtpk(v.x, v.y); o.y = cvtpk(v.z, v.w);
              *(LAS u32x2*)(krw + tb * SA_KR_SZ) = o; }
        }
        constexpr bool ld_next = (VAR != 5);
        const int tn = (t + 1) & 63;
        const unsigned prow_n = (unsigned)__builtin_amdgcn_readfirstlane(pt[hot ? 0 : (tn >> 1)]) * PAGE + 64 * (tn & 1) + 8 * w;
        asm volatile("s_waitcnt lgkmcnt(0)" ::: "memory");
        __builtin_amdgcn_s_barrier(); asm volatile("" ::: "memory");
        const LAS unsigned char* c8a = c8a0 + tb * SA_C8_SZ; const LAS unsigned char* c8b = c8b0 + tb * SA_C8_SZ; const LAS unsigned char* krbase = krbase0 + tb * SA_KR_SZ;
        float tmax = -INFINITY, ps = 0.f;
        u32x4 nb00, nb01, nb10, nb11; bf16x8 nkf;
#define SA_LDB(kb_) do { const LAS unsigned char* ca_ = c8a + (kb_) * 16 * SA_C8_ROW; const LAS unsigned char* cb_ = c8b + (kb_) * 16 * SA_C8_ROW; \
            nb00 = *(const LAS u32x4*)(ca_); nb01 = *(const LAS u32x4*)(cb_); nb10 = *(const LAS u32x4*)(ca_ + 128); nb11 = *(const LAS u32x4*)(cb_ + 128); \
            nkf = *(const LAS bf16x8*)(krbase + (kb_) * 16 * SA_KR_ROW); } while (0)
        SA_LDB(0);
#pragma unroll
        for (int kb = 0; kb < 4; ++kb) {
            f32x4v k0 = {0.f, 0.f, 0.f, 0.f}, k1 = {0.f, 0.f, 0.f, 0.f}, k2 = {0.f, 0.f, 0.f, 0.f}, k3 = {0.f, 0.f, 0.f, 0.f};
            const bf16x8 kf = nkf;
            {
                const v8i_t bf0 = {(int)nb00.x, (int)nb00.y, (int)nb00.z, (int)nb00.w, (int)nb01.x, (int)nb01.y, (int)nb01.z, (int)nb01.w};
                const v8i_t bf1 = {(int)nb10.x, (int)nb10.y, (int)nb10.z, (int)nb10.w, (int)nb11.x, (int)nb11.y, (int)nb11.z, (int)nb11.w};
                if (VAR != 3) {
                    __builtin_amdgcn_s_setprio(1);
                    k0 = __builtin_amdgcn_mfma_scale_f32_16x16x128_f8f6f4(wf[0][0], bf0, k0, 0, 0, 0, 123, 0, 127); k1 = __builtin_amdgcn_mfma_scale_f32_16x16x128_f8f6f4(wf[1][0], bf0, k1, 0, 0, 0, 123, 0, 127);
                    k2 = __builtin_amdgcn_mfma_scale_f32_16x16x128_f8f6f4(wf[2][0], bf0, k2, 0, 0, 0, 123, 0, 127); k3 = __builtin_amdgcn_mfma_scale_f32_16x16x128_f8f6f4(wf[3][0], bf0, k3, 0, 0, 0, 123, 0, 127);
                    k0 = __builtin_amdgcn_mfma_scale_f32_16x16x128_f8f6f4(wf[0][1], bf1, k0, 0, 0, 0, 123, 0, 127); k1 = __builtin_amdgcn_mfma_scale_f32_16x16x128_f8f6f4(wf[1][1], bf1, k1, 0, 0, 0, 123, 0, 127);
                    k2 = __builtin_amdgcn_mfma_scale_f32_16x16x128_f8f6f4(wf[2][1], bf1, k2, 0, 0, 0, 123, 0, 127); k3 = __builtin_amdgcn_mfma_scale_f32_16x16x128_f8f6f4(wf[3][1], bf1, k3, 0, 0, 0, 123, 0, 127);
                }
                __builtin_amdgcn_sched_barrier(0);
                if (kb < 3) SA_LDB(kb + 1);
                if (ld_next) { pf[2 * kb] = __builtin_amdgcn_raw_buffer_load_b128(rs_c, dma_voff, (prow_n + 2 * kb) * (KVR * 4), 0); pf[2 * kb + 1] = __builtin_amdgcn_raw_buffer_load_b128(rs_c, dma_voff, (prow_n + 2 * kb + 1) * (KVR * 4), 0);
                    if (kb == 3) pf[8] = __builtin_amdgcn_raw_buffer_load_b128(rs_k, dma_voff, prow_n * (ROPE * 4), 0); }
                if (VAR != 3) __builtin_amdgcn_s_setprio(0);
                __builtin_amdgcn_sched_barrier(0);
            }
            float ss = k0.x * k0.x + k0.y * k0.y + k0.z * k0.z + k0.w * k0.w + k1.x * k1.x + k1.y * k1.y + k1.z * k1.z + k1.w * k1.w
                     + k2.x * k2.x + k2.y * k2.y + k2.z * k2.z + k2.w * k2.w + k3.x * k3.x + k3.y * k3.y + k3.z * k3.z + k3.w * k3.w;
            ss = xsum32(xsum16(ss));
            const float ri = __builtin_amdgcn_rsqf(ss * (1.f / 64.f) + EPS);
            u32x4 a0, a1;
            a0.x = cvtpk(k0.x * ri, k0.y * ri); a0.y = cvtpk(k0.z * ri, k0.w * ri); a0.z = cvtpk(k1.x * ri, k1.y * ri); a0.w = cvtpk(k1.z * ri, k1.w * ri);
            a1.x = cvtpk(k2.x * ri, k2.y * ri); a1.y = cvtpk(k2.z * ri, k2.w * ri); a1.z = cvtpk(k3.x * ri, k3.y * ri); a1.w = cvtpk(k3.z * ri, k3.w * ri);
            f32x4v sc = {negm, negm, negm, negm};
            sc = __builtin_amdgcn_mfma_f32_16x16x32_bf16(kf, q2, sc, 0, 0, 0);
            sc = __builtin_amdgcn_mfma_f32_16x16x32_bf16(__builtin_bit_cast(bf16x8, a0), q0, sc, 0, 0, 0);
            sc = __builtin_amdgcn_mfma_f32_16x16x32_bf16(__builtin_bit_cast(bf16x8, a1), q1, sc, 0, 0, 0);
            float bm = fmaxf(fmaxf(sc.x, sc.y), fmaxf(sc.z, sc.w));
            if (t == 0 && kb == 0) { const float m0 = xmax32(xmax16(bm)); sc.x -= m0; sc.y -= m0; sc.z -= m0; sc.w -= m0; bm -= m0; m = m0; negm = -m0; }
            tmax = fmaxf(tmax, bm);
            sc.x = __builtin_amdgcn_exp2f(sc.x); sc.y = __builtin_amdgcn_exp2f(sc.y); sc.z = __builtin_amdgcn_exp2f(sc.z); sc.w = __builtin_amdgcn_exp2f(sc.w);
            ps += (sc.x + sc.y) + (sc.z + sc.w);
            asm volatile("" : "+v"(ps), "+v"(tmax));
            if (qreal) { u32x2 o; o.x = cvtpk(sc.x, sc.y); o.y = cvtpk(sc.z, sc.w); *(LAS u32x2*)(pwbase + kb * 32) = o; }
            __builtin_amdgcn_sched_barrier(0);
        }
#undef SA_LDB
        { tmax = xmax32(xmax16(tmax));
          const float inc = fmaxf(tmax, 0.f); const float f = __builtin_amdgcn_exp2f(-inc); m += inc; negm = -m; l = (l + ps) * f;
          if (qreal && quad == 0) *(LAS float*)(lds + SA_F + (8 * w + l15) * 4) = f; }
        asm volatile("s_waitcnt lgkmcnt(0)" ::: "memory"); __builtin_amdgcn_s_barrier(); asm volatile("" ::: "memory");
        if (VAR != 4) {
            v4i16_t lo[4], hh[4]; bf16x8 p0[4], p1[4];
#pragma unroll
            for (int ks = 0; ks < 4; ++ks) {
                lo[ks] = __builtin_amdgcn_ds_read_tr16_b64_v4i16((LAS v4i16_t*)(trlo + tb * SA_CB_SZ + ks * 16 * SA_CB_ROW));
                hh[ks] = __builtin_amdgcn_ds_read_tr16_b64_v4i16((LAS v4i16_t*)(trhi + tb * SA_CB_SZ + ks * 16 * SA_CB_ROW));
                p0[ks] = *(const LAS bf16x8*)(prd + ks * 32);
                p1[ks] = *(const LAS bf16x8*)(prd + 32 * SA_P_ROW + ks * 32);
            }
            const float f0 = frd[0], f1 = frd[32];
            __builtin_amdgcn_sched_barrier(0);
            __builtin_amdgcn_s_setprio(1);
#pragma unroll
            for (int ks = 0; ks < 4; ++ks) {
                const bf16x8 cf = (bf16x8){lo[ks][0], lo[ks][1], lo[ks][2], lo[ks][3], hh[ks][0], hh[ks][1], hh[ks][2], hh[ks][3]};
                lat0 = __builtin_amdgcn_mfma_f32_32x32x16_bf16(cf, p0[ks], lat0, 0, 0, 0);
                lat1 = __builtin_amdgcn_mfma_f32_32x32x16_bf16(cf, p1[ks], lat1, 0, 0, 0);
            }
            __builtin_amdgcn_s_setprio(0);
            if (__any(f0 != 1.f || f1 != 1.f)) {
#pragma unroll
                for (int r = 0; r < 16; ++r) { lat0[r] *= f0; lat1[r] *= f1; } }
        }
      }
    }
    __builtin_amdgcn_s_barrier(); asm volatile("" ::: "memory");
    l = xsum32(xsum16(l));
    int unit2 = unit, lane2 = threadIdx.x & 63; asm volatile("" : "+s"(unit2), "+v"(lane2));
    const int r32b = lane2 & 31, hib = lane2 >> 5;
    if (lane2 < 8) { float* mlp = ML + ((size_t)unit2 * 64 + 8 * w + lane2) * 2; mlp[0] = m; mlp[1] = l; }
    float* lp = LATP + (size_t)unit2 * 64 * KVR + 32 * w + 4 * hib;
#pragma unroll
    for (int g = 0; g < 4; ++g) {
        *(f32x4*)(lp + (size_t)r32b * KVR + 8 * g) = (f32x4){lat0[4 * g], lat0[4 * g + 1], lat0[4 * g + 2], lat0[4 * g + 3]};
        *(f32x4*)(lp + (size_t)(32 + r32b) * KVR + 8 * g) = (f32x4){lat1[4 * g], lat1[4 * g + 1], lat1[4 * g + 2], lat1[4 * g + 3]};
    }
#undef SA_LOAD
}

DI void attn_s_combine(int sb, LAS unsigned char* lds, const bf16_t* __restrict__ QB, const bf16_t* __restrict__ KV, const bf16_t* __restrict__ KRB, const bf16_t* __restrict__ WKVT,
                       const float* __restrict__ LATP, const float* __restrict__ ML, bf16_t* __restrict__ MIX) {
    const int tid = threadIdx.x;
    LAS float* latc = (LAS float*)lds; LAS float* pn = latc + 64 * KVR; LAS float* wgt = pn + 64 * 8;
    {
        const int qh = tid >> 3, j = tid & 7, h = qh >> 3, q = qh & 7;
        const bf16_t* qp = QB + (size_t)(MP + sb * DT + q) * QDIM + h * QKH; const size_t krow_ = (size_t)MP + sb * DT + j;
        float sj = 0.f;
        for (int d = 0; d < 64; ++d) sj += bf2f(qp[d]) * bf2f(KV[krow_ * 1024 + h * 64 + d]);
        for (int r = 0; r < 32; ++r) sj += bf2f(qp[64 + r]) * bf2f(KRB[krow_ * ROPE + r]);
        if (j > q) sj = -INFINITY;
        const float m0 = ML[((size_t)(2 * sb) * 64 + qh) * 2], l0 = ML[((size_t)(2 * sb) * 64 + qh) * 2 + 1], m1 = ML[((size_t)(2 * sb + 1) * 64 + qh) * 2], l1 = ML[((size_t)(2 * sb + 1) * 64 + qh) * 2 + 1];
        const float mm = max8(sj);
        const float M = fmaxf(fmaxf(m0, m1), mm);
        const float pj = exp2f(sj - M), w0 = exp2f(m0 - M), w1 = exp2f(m1 - M);
        const float sp = sum8(pj);
        const float L = w0 * l0 + w1 * l1 + sp, iL = 1.f / L;
        pn[qh * 8 + j] = pj * iL;
        if (j == 0) { wgt[qh * 2] = w0 * iL; wgt[qh * 2 + 1] = w1 * iL; }
    }
    __syncthreads();
    for (int e = tid; e < 64 * KVR; e += NTHR) { const int qh = e >> 8; latc[e] = wgt[qh * 2] * LATP[(size_t)(2 * sb) * 64 * KVR + e] + wgt[qh * 2 + 1] * LATP[(size_t)(2 * sb + 1) * 64 * KVR + e]; }
    __syncthreads();
    for (int o = tid; o < 64 * VH; o += NTHR) {
        const int qh = o >> 6, v = o & 63, h = qh >> 3, q = qh & 7;
        const bf16_t* wr = WKVT + (size_t)(512 + h * 64 + v) * KVR;
        float a = 0.f;
        for (int c = 0; c < KVR; ++c) a += latc[qh * KVR + c] * bf2f(wr[c]);
        for (int j = 0; j < DT; ++j) a += pn[qh * 8 + j] * bf2f(KV[((size_t)MP + sb * DT + j) * 1024 + 512 + h * 64 + v]);
        MIX[(size_t)(MP + sb * DT + q) * DM + 512 + h * 64 + v] = (bf16_t)f2bf(a);
    }
    __syncthreads();
}

DI void attn_s_scores_item(int chunk, int sb, int tid, const float* __restrict__ cache_ckv, const float* __restrict__ cache_kr, const int* __restrict__ page_table, const bf16_t* __restrict__ QB,
                           const bf16_t* __restrict__ CB, const bf16_t* __restrict__ KRB, const float* __restrict__ w_uk, const float* __restrict__ g_k_nope, float* __restrict__ SC) {
    const int key = tid & 127, hq = __builtin_amdgcn_readfirstlane(tid >> 7);
    const bool isnew = chunk == NPAGES;
    if (isnew && key >= DT) return;
    const float* crow = nullptr; const bf16_t* crowb = nullptr; const float* kpf = nullptr; const bf16_t* kpb = nullptr;
    if (!isnew) { const size_t pr = (size_t)page_table[sb * NPAGES + chunk] * PAGE + key; crow = cache_ckv + pr * KVR; kpf = cache_kr + pr * ROPE; }
    else { const size_t rr = (size_t)MP + sb * DT + key; crowb = CB + rr * KVR; kpb = KRB + rr * ROPE; }
    const int jglob = isnew ? PAST + key : chunk * PAGE + key;
    for (int hi = 0; hi < 2; ++hi) {
        const int h = hq * 2 + hi;
        float acc[NOPE];
#pragma unroll
        for (int d = 0; d < NOPE; ++d) acc[d] = 0.f;
        for (int c = 0; c < KVR; ++c) {
            const float cv = isnew ? bf2f(crowb[c]) : crow[c];
            const float* wr = w_uk + (size_t)c * 512 + h * 64;
#pragma unroll
            for (int d = 0; d < NOPE; ++d) acc[d] += cv * wr[d];
        }
        float ss = 0.f;
#pragma unroll
        for (int d = 0; d < NOPE; ++d) ss += acc[d] * acc[d];
        const float ri = rsqrtf(ss * (1.f / 64.f) + EPS);
#pragma unroll 1
        for (int q = 0; q < DT; ++q) {
            const bf16_t* qp = QB + (size_t)(MP + sb * DT + q) * QDIM + h * QKH;
            float s = 0.f;
#pragma unroll
            for (int d = 0; d < NOPE; ++d) s += acc[d] * g_k_nope[d] * bf2f(qp[d]);
            s *= ri;
            for (int r = 0; r < ROPE; ++r) s += (isnew ? bf2f(kpb[r]) : kpf[r]) * bf2f(qp[64 + r]);
            if (isnew && key > q) s = -INFINITY;
            SC[((size_t)sb * 64 + h * 8 + q) * NKEYS + jglob] = s;
        }
    }
}
DI void attn_s_pv_item(int sb, int tid, LAS float* lds, const float* __restrict__ cache_ckv, const int* __restrict__ page_table, const bf16_t* __restrict__ CB, const float* __restrict__ SC,
                       const float* __restrict__ w_uv, float* __restrict__ LAT, bf16_t* __restrict__ MIX) {
    LAS float* p = lds; LAS float* smx = lds + 64 * PAGE; LAS float* sinv = smx + 64;
    const int wid = tid >> 6, lane = tid & 63;
    for (int i = 0; i < 8; ++i) {
        const int qh = wid * 8 + i; const float* s = SC + ((size_t)sb * 64 + qh) * NKEYS;
        float mx = -INFINITY; for (int j = lane; j < NKEYS; j += 64) mx = fmaxf(mx, s[j]);
        mx = wave_max(mx);
        float sum = 0.f; for (int j = lane; j < NKEYS; j += 64) sum += exp2f(s[j] - mx);
        sum = wave_sum(sum);
        if (lane == 0) { smx[qh] = mx; sinv[qh] = 1.f / sum; }
    }
    __syncthreads();
    const int c = tid & 255, half = tid >> 8;
    float lat[32];
#pragma unroll
    for (int i = 0; i < 32; ++i) lat[i] = 0.f;
    for (int chunk = 0; chunk <= NPAGES; ++chunk) {
        const int nk = chunk == NPAGES ? DT : PAGE;
        for (int e = tid; e < 64 * PAGE; e += NTHR) { const int qh = e >> 7, j = e & 127; p[qh * PAGE + j] = j < nk ? exp2f(SC[((size_t)sb * 64 + qh) * NKEYS + chunk * PAGE + j] - smx[qh]) * sinv[qh] : 0.f; }
        __syncthreads();
        for (int j = 0; j < nk; ++j) {
            float cv;
            if (chunk < NPAGES) cv = cache_ckv[((size_t)page_table[sb * NPAGES + chunk] * PAGE + j) * KVR + c];
            else cv = bf2f(CB[((size_t)MP + sb * DT + j) * KVR + c]);
#pragma unroll
            for (int i = 0; i < 32; ++i) lat[i] += p[(half * 32 + i) * PAGE + j] * cv;
        }
        __syncthreads();
    }
    float* L = LAT + (size_t)sb * 64 * KVR;
#pragma unroll
    for (int i = 0; i < 32; ++i) L[(half * 32 + i) * KVR + c] = lat[i];
    __threadfence_block(); __syncthreads();
    for (int o = tid; o < 64 * VH; o += NTHR) {
        const int qh = o >> 6, v = o & 63, h = qh >> 3, q = qh & 7;
        float a = 0.f;
        for (int cc = 0; cc < KVR; ++cc) a += L[qh * KVR + cc] * w_uv[(size_t)cc * 512 + h * 64 + v];
        MIX[(size_t)(MP + sb * DT + q) * DM + 512 + h * 64 + v] = (bf16_t)f2bf(a);
    }
    __syncthreads();
}

enum Phase { PH_PRO = 0, PH_Z0, PH_POST0, PH_KVPOOL, PH_KNORM, PH_ATTN, PH_ATTN2, PH_OUT0, PH_UP0, PH_DN0, PH_RNNIN, PH_CONV, PH_GATES, PH_SCAN, PH_OUTR, PH_UP1, PH_DN1, PH_COUNT };

__global__ void __launch_bounds__(NTHR, 2) mk(Args args) {
    extern __shared__ __attribute__((aligned(16))) unsigned char lds_raw[];
    LAS unsigned char* lds = (LAS unsigned char*)lds_raw;
    volatile LAS unsigned* MISC = (volatile LAS unsigned*)(lds + LDS_MISC);
    const int tid = threadIdx.x, lane = tid & 63, wave = __builtin_amdgcn_readfirstlane(tid >> 6);
    const int G = gridDim.x, bx = blockIdx.x;
    const int gw = bx * NWAVES + wave, NGW = G * NWAVES;
    const int lo = args.ph_lo, hi = args.ph_hi;

    const float* x_prompt = (const float*)args.in[0]; const float* x_sample = (const float*)args.in[1];
    const float* cache_ckv = (const float*)args.in[2]; const float* cache_kr = (const float*)args.in[3];
    const float* state_pool = (const float*)args.in[4]; const float* state_conv = (const float*)args.in[5]; const float* state_lru = (const float*)args.in[6];
    const int* page_table = (const int*)args.in[7];
    const float* norm_mix = (const float*)args.in[8]; const float* w_in_even = (const float*)args.in[9];
    const float* g_q_nope = (const float*)args.in[10]; const float* g_q_rope = (const float*)args.in[11]; const float* g_ckv = (const float*)args.in[12]; const float* g_k_rope = (const float*)args.in[13]; const float* g_k_nope = (const float*)args.in[14];
    const float* w_uk = (const float*)args.in[15]; const float* w_uv = (const float*)args.in[16]; const float* w_pool = (const float*)args.in[17]; const float* pool_scale = (const float*)args.in[18];
    const float* w_out_even = (const float*)args.in[19]; const float* w_in_rnn = (const float*)args.in[20]; const float* conv_w = (const float*)args.in[21]; const float* conv_b = (const float*)args.in[22];
    const float* w_gate_a = (const float*)args.in[23]; const float* b_gate_a = (const float*)args.in[24]; const float* w_gate_x = (const float*)args.in[25]; const float* b_gate_x = (const float*)args.in[26];
    const float* lru_lambda = (const float*)args.in[27]; const float* w_out_rnn = (const float*)args.in[28]; const float* norm_ffn = (const float*)args.in[29]; const float* w_up = (const float*)args.in[30]; const float* w_down = (const float*)args.in[31];
    float* out = args.out; unsigned char* ws = args.ws;
    bf16_t* WIN0T = (bf16_t*)(ws + WS_WIN0T); bf16_t* WKVT = (bf16_t*)(ws + WS_WKVT); bf16_t* WPOOLT = (bf16_t*)(ws + WS_WPOOLT); bf16_t* WGATET = (bf16_t*)(ws + WS_WGATET);
    bf16_t* WOUT0T = (bf16_t*)(ws + WS_WOUT0T); bf16_t* WOUTRT = (bf16_t*)(ws + WS_WOUTRT); bf16_t* WINRT = (bf16_t*)(ws + WS_WINRT); bf16_t* WUPT = (bf16_t*)(ws + WS_WUPT); bf16_t* WDNT = (bf16_t*)(ws + WS_WDNT);
    float* SSQ = (float*)(ws + WS_SSQ); bf16_t* XB = (bf16_t*)(ws + WS_XB); bf16_t* Z0 = (bf16_t*)(ws + WS_Z0); bf16_t* QB = (bf16_t*)(ws + WS_QB); bf16_t* CB = (bf16_t*)(ws + WS_CB); bf16_t* KRB = (bf16_t*)(ws + WS_KRB);
    bf16_t* DBuf = (bf16_t*)(ws + WS_DB); bf16_t* KV = (bf16_t*)(ws + WS_KV); bf16_t* MIX = (bf16_t*)(ws + WS_MIX); bf16_t* H = (bf16_t*)(ws + WS_H); bf16_t* GATE = (bf16_t*)(ws + WS_GATE); bf16_t* U = (bf16_t*)(ws + WS_U);
    bf16_t* V = (bf16_t*)(ws + WS_V); float* Gb = (float*)(ws + WS_G); bf16_t* YB = (bf16_t*)(ws + WS_YB); float* SC = (float*)(ws + WS_SC); float* LAT = (float*)(ws + WS_LAT);
    float* Y = out + O_Y;

    if (tid < 64) MISC[tid] = 0u;
    __syncthreads();
    XcdBarrier bar = xcd_barrier_post((unsigned*)(ws + WS_CTL) + CW_BAR, MISC + 8);
#ifndef PH_MASK
#define PH_MASK 0xFFFFFFFFu
#endif
#define IN(k) (((PH_MASK >> (k)) & 1u) && lo <= (k) && (k) < hi)
#define SEAM(k) do { if (IN(k) && IN((k) + 1)) xcd_barrier(bar); } while (0)
#define STREAM_CTL(ep_) pg8::StreamCtl{(float*)(ws + WS_PART), (unsigned*)(ws + WS_CTL) + CW_SKF, (unsigned*)(ws + WS_CTL) + CW_SKT, (unsigned)(ep_), bx, 0}
#define GEMM_PHASE_STATIC(ep_, Aptr, lda_, atoff_, ashift_, Bptr, M_, N_, K_, FT, ...) do { pg8::Gemm g{Aptr, Bptr, M_, N_, K_, lda_, atoff_, ashift_}; pg8::StaticOrder S; S.init(M_, N_, K_, G, bx); \
        pg8::EpiRows<FT> E{FT{__VA_ARGS__}}; pg8::gemm_phase<false>(lds, g, S, E, STREAM_CTL(ep_)); } while (0)
#define GEMM_PHASE(ep_, Aptr, lda_, atoff_, ashift_, Bptr, M_, N_, K_, FT, ...) do { pg8::Gemm g{Aptr, Bptr, M_, N_, K_, lda_, atoff_, ashift_}; pg8::StaticOrder S; S.init(M_, N_, K_, G, bx); \
        pg8::EpiRows<FT> E{FT{__VA_ARGS__}}; pg8::gemm_phase<false>(lds, g, S, E, STREAM_CTL(ep_)); } while (0)
#define GEMM_PHASE_P8(ep_, Aptr, lda_, Bptr, M_, N_, K_, FT, ...) do { pg8::Gemm g{Aptr, Bptr, M_, N_, K_, lda_, 0, 0}; pg8::StaticOrder S; S.init(M_, N_, K_, G, bx); \
        pg8::EpiRows<FT, false, true> E{FT{__VA_ARGS__}}; pg8::gemm_phase<false>(lds, g, S, E, STREAM_CTL(ep_)); } while (0)
#define GEMM_RESID(Aptr, lda_, Bptr, K_) GEMM_PHASE_P8(0, Aptr, lda_, Bptr, MT, DM, K_, FResid<false>, XB, (float*)nullptr, SSQ)
#define CW_RDY(i) ((unsigned*)(ws + WS_CTL) + 12288 + 64 * (i))
#define GEMM_RESID_SPLIT(Aptr, lda_, Bptr, K_) do { \
        if (G == 256) { pg8::Gemm g{Aptr, Bptr, MT, DM, K_, lda_, 0, 0}; pg8::SplitTailOrder S; S.init(K_, bx); pg8::EpiRows<FResid<false>, false, true> E{FResid<false>{XB, (float*)nullptr, SSQ}}; \
            pg8::gemm_phase<false>(lds, g, S, E, STREAM_CTL(0), EpiPartStore{(float*)(ws + WS_PART), bx & 15}); } \
        else GEMM_RESID(Aptr, lda_, Bptr, K_); } while (0)
#define FIXUP_DEFERRED(i, WAYS_) do { if (G == 256 && bx >= 128) { sample_fixup<false, WAYS_>(bx - 128, (const float*)(ws + WS_PART), XB, (float*)nullptr, SSQ); \
            asm volatile("s_waitcnt vmcnt(0)" ::: "memory"); __syncthreads(); \
            if (tid == 0) { __builtin_amdgcn_fence(__ATOMIC_RELEASE, "agent"); asm volatile("s_waitcnt vmcnt(0)" ::: "memory"); __hip_atomic_fetch_add(CW_RDY(i), 1u, __ATOMIC_RELAXED, __HIP_MEMORY_SCOPE_AGENT); } } } while (0)
#define GEMM_PHASE_P8_RDY(i, ep_, Aptr, lda_, Bptr, M_, N_, K_, FT, ...) do { pg8::Gemm g{Aptr, Bptr, M_, N_, K_, lda_, 0, 0}; if (G == 256) { g.ready = CW_RDY(i); g.ready_target = 128u; } pg8::StaticOrder S; S.init(M_, N_, K_, G, bx); \
        pg8::EpiRows<FT, false, true> E{FT{__VA_ARGS__}}; pg8::gemm_phase<false>(lds, g, S, E, STREAM_CTL(ep_)); } while (0)
#define GEMM_DOWN(Aptr, Bptr, FIN) do { \
        if (G == 256) { pg8::Gemm g{Aptr, Bptr, MT, DM, DFF, DFF, 0, 0}; pg8::SplitTailOrder S; S.init(DFF, bx); pg8::EpiRows<FResid<FIN>, false, true> E{FResid<FIN>{XB, Y, SSQ}}; \
            pg8::gemm_phase<false>(lds, g, S, E, STREAM_CTL(0), EpiPartStore{(float*)(ws + WS_PART), bx & 15}); \
            if (FIN) { xcd_barrier(bar); sample_fixup<FIN>(bx, (const float*)(ws + WS_PART), XB, Y, SSQ); } } \
        else GEMM_PHASE_STATIC(0, Aptr, DFF, 0, 0, Bptr, MT, DM, DFF, FResid<FIN>, XB, Y, SSQ); } while (0)

    if (IN(PH_PRO)) for (int rep_ = 0; rep_ < REPN(10); ++rep_) {
        LAS float* scr = (LAS float*)(lds + wave * 16384);
        constexpr int I0 = 16 * 49, I1 = 4 * 16, I3 = 2 * 4;
        constexpr int NITEMS = I0 + 2 * I1 + 4 * I3;
        for (int it = gw; it < NITEMS; it += NGW) {
            int r = it;
            if (r < I0) { p0_transpose_item(w_in_even, 1568, 1568, WIN0T, DM, norm_mix, scr, r, lane); continue; } r -= I0;
            if (r < I1) { p0_transpose_item(w_uk, 512, 512, WKVT, KVR, nullptr, scr, r, lane); continue; } r -= I1;
            if (r < I1) { p0_transpose_item(w_uv, 512, 512, WKVT + (size_t)512 * KVR, KVR, nullptr, scr, r, lane); continue; } r -= I1;
            { const int g = r / I3; p0_transpose_item(w_pool + (size_t)g * 128 * 128, 128, 128, WPOOLT + (size_t)g * 128 * 256 + (g & 1) * 128, 256, nullptr, scr, r % I3, lane); }
        }
        { u32x4* z0 = (u32x4*)(WIN0T + (size_t)1568 * DM); const u32x4 zz = {0u, 0u, 0u, 0u};
          for (int e = bx * NTHR + tid; e < (NZ0 - 1568) * DM / 8; e += G * NTHR) z0[e] = zz;
          for (int e = bx * NTHR + tid; e < 512 * 16; e += G * NTHR) { const int n = e >> 4, c8 = e & 15; *(u32x4*)(WPOOLT + (size_t)n * 256 + (1 - ((n >> 7) & 1)) * 128 + c8 * 8) = zz; }
          for (int e = bx * NTHR + tid; e < 2048 * 16; e += G * NTHR) { const int n = e >> 4, c8 = e & 15; *(u32x4*)(WGATET + (size_t)n * 256 + (1 - ((n >> 8) & 1)) * 128 + c8 * 8) = zz; } }
        { float* ROPET = (float*)(ws + WS_ROPE);
          for (int e = bx * NTHR + tid; e < (SEQ + DT) * 16; e += G * NTHR) { const int pi = e >> 4, i = e & 15; const int pos = pi < SEQ ? pi : PAST + (pi - SEQ);
              const float inv = powf(10000.0f, -(float)i / 16.0f); const float ang = (float)pos * inv; ROPET[e * 2] = cosf(ang); ROPET[e * 2 + 1] = sinf(ang); } }
        if (bx == G - 1) for (int c = tid; c < DM; c += NTHR) ((float*)(ws + WS_SP8))[c] = log1pf(expf(-lru_lambda[c])) * (8.0f * 1.4426950408889634f);
        for (int row = gw; row < MT; row += NGW) rowprep_row(row < MP ? x_prompt + (size_t)row * DM : x_sample + (size_t)(row - MP) * DM, row, XB, SSQ, lane);
    }
    SEAM(PH_PRO);
    if (REP_ID == 40) { for (int i = 0; i < 10; ++i) xcd_barrier(bar); }
    if (IN(PH_Z0)) for (int rep_ = 0; rep_ < REPN(1); ++rep_) GEMM_PHASE_P8(1, XB, DM, WIN0T, MT, NZ0, DM, FZ0, SSQ, Z0);
    SEAM(PH_Z0);
    if (IN(PH_POST0)) for (int rep_ = 0; rep_ < REPN(2); ++rep_) {
        const float* ROPET = (const float*)(ws + WS_ROPE);
        for (int row = gw; row < MT; row += NGW) post0_row(row, lane, Z0, ROPET, g_q_nope, g_q_rope, g_ckv, g_k_rope, QB, CB, KRB, out);
        for (int it = bx * NTHR + tid; it < (MP / 16) * 64; it += G * NTHR) pool_item<true>((it >> 6) * 16, 16, (it & 63) * 8, Z0, state_pool, DBuf, out);
        for (int it = bx * NTHR + tid; it < DB_ * 64; it += G * NTHR) pool_item<false>(MP + (it >> 6) * DT, DT, (it & 63) * 8, Z0, state_pool, DBuf, out);
    }
    SEAM(PH_POST0);
    if (IN(PH_KVPOOL) && REP_ID == 13) { GEMM_PHASE(14, CB, KVR, 0, 0, WKVT, MT, 1024, KVR, FRawBf16<1024>, (bf16_t*)(ws + WS_DBG)); GEMM_PHASE_STATIC(15, DBuf, POOLD, 256, 0, WPOOLT, MT, POOLD, 256, FPool, pool_scale, MIX); }
    if (IN(PH_KVPOOL)) {
        { pg8::Gemm g{CB, WKVT, MT, 1024, KVR, KVR, 0, 0}; pg8::StaticOrder S; S.init(MT, 1024, KVR, G, bx); pg8::EpiRows<FKvNorm, true, true> E{FKvNorm{KV, g_k_nope}}; pg8::gemm_phase<false>(lds, g, S, E, STREAM_CTL(2)); }
        { pg8::Gemm g{DBuf, WPOOLT, MT, POOLD, 256, POOLD, 256, 0}; pg8::StaticOrder S; S.init(MT, POOLD, 256, G, (G == 256) ? ((bx + 240) & 255) : bx); pg8::EpiRows<FPool, false, true> E{FPool{pool_scale, MIX}}; pg8::gemm_phase<false>(lds, g, S, E, STREAM_CTL(3)); }
    }
#if DBG_KNORM
    if (IN(PH_KVPOOL)) GEMM_PHASE_STATIC(16, CB, KVR, 0, 0, WKVT, MT, 1024, KVR, FRawBf16<1024>, (bf16_t*)(ws + WS_DBG));
#endif
    SEAM(PH_KVPOOL);
#if DBG_KNORM
    if (IN(PH_KNORM)) { const bf16_t* R = (const bf16_t*)(ws + WS_DBG); unsigned bad = 0;
        for (int row = gw; row < MT; row += NGW) {
            for (int h = 0; h < NH; ++h) { const float x = bf2f(R[(size_t)row * 1024 + h * 64 + lane]); const float ss = wave_sum(x * x); const float y = x * rsqrtf(ss * (1.f / 64.f) + EPS) * g_k_nope[lane];
                const float a = bf2f(KV[(size_t)row * 1024 + h * 64 + lane]); if (!(fabsf(a - y) <= 0.02f + 0.02f * fabsf(y))) ++bad; }
            for (int c = lane; c < 512; c += 64) { const float y = bf2f(R[(size_t)row * 1024 + 512 + c]), a = bf2f(KV[(size_t)row * 1024 + 512 + c]); if (!(fabsf(a - y) <= 1e-3f + 0.01f * fabsf(y))) ++bad; } }
        if (bad) atomicAdd((unsigned*)(ws + WS_CTL) + CW_DBG, bad); }
#endif
    if (IN(PH_ATTN)) {
        LAS float* sc = (LAS float*)(lds + wave * 16768);
#if DBG_ATTN_P
        for (int it = gw; it < MP * NH; it += NGW) attn_p_naive_item(it, lane, sc, QB, KV, KRB, (bf16_t*)(ws + WS_DBG));
        __syncthreads();
#endif
#ifndef NO_ATTN_P
        { const int vcu = (G % 8 == 0) ? (bx % 8) * (G / 8) + bx / 8 : bx;
          for (int rep_ = 0; rep_ < REPN(3); ++rep_) for (int pi = vcu; pi < 256; pi += G) { const int bh = pi >> 3, s8 = pi & 7; attn_p_unit(bh >> 3, bh & 7, 15 - s8, lds, QB, KV, KRB, MIX); attn_p_unit(bh >> 3, bh & 7, s8, lds, QB, KV, KRB, MIX); }
          asm volatile("s_waitcnt vmcnt(0)" ::: "memory"); __syncthreads(); }
#endif
#if DBG_ATTN_S
        for (int it = bx; it < (NPAGES + 1) * DB_; it += G) attn_s_scores_item(it % (NPAGES + 1), it / (NPAGES + 1), tid, cache_ckv, cache_kr, page_table, QB, CB, KRB, w_uk, g_k_nope, SC);
        __syncthreads();
#endif
        if (REP_ID >= 20 && REP_ID <= 24) for (int u = bx; u < 2 * DB_; u += G) attn_s_unit<(REP_ID >= 20 && REP_ID <= 24) ? REP_ID - 19 : 1>(u, lds, cache_ckv, cache_kr, page_table, QB, WKVT, g_k_nope, (float*)(ws + WS_DBG), (float*)(ws + WS_DBG + 40 * MiB));
        for (int rep_ = 0; rep_ < REPN(4); ++rep_) for (int u = bx; u < 2 * DB_; u += G) attn_s_unit<0>(u, lds, cache_ckv, cache_kr, page_table, QB, WKVT, g_k_nope, (float*)(ws + WS_LATP), (float*)(ws + WS_ML));
        asm volatile("s_waitcnt vmcnt(0)" ::: "memory"); __syncthreads();
    }
    SEAM(PH_ATTN);
#if DBG_ATTN_P
    if (IN(PH_ATTN2)) {
        const bf16_t* R = (const bf16_t*)(ws + WS_DBG); unsigned bad = 0;
        for (size_t i = (size_t)bx * NTHR + tid; i < (size_t)MP * 512; i += (size_t)G * NTHR) { const size_t row = i >> 9, c = 512 + (i & 511); const float a = bf2f(MIX[row * DM + c]), r = bf2f(R[row * DM + c]);
            if (!(fabsf(a - r) <= 0.01f + 0.02f * fabsf(r))) ++bad; }
        if (bad) atomicAdd((unsigned*)(ws + WS_CTL) + CW_DBG, bad);
    }
#endif
    if (IN(PH_ATTN2)) { __syncthreads();
#if DBG_ATTN_S
        for (int sb = bx; sb < DB_; sb += G) attn_s_pv_item(sb, tid, (LAS float*)lds, cache_ckv, page_table, CB, SC, w_uv, LAT, (bf16_t*)(ws + WS_DBG));
        __syncthreads();
#endif
        for (int sb = bx; sb < DB_; sb += G) attn_s_combine(sb, lds, QB, KV, KRB, WKVT, (const float*)(ws + WS_LATP), (const float*)(ws + WS_ML), MIX);
#if DBG_ATTN_S
        asm volatile("s_waitcnt vmcnt(0)" ::: "memory"); __syncthreads();
        { const bf16_t* R = (const bf16_t*)(ws + WS_DBG); unsigned bad = 0; float num_ = 0.f, den_ = 0.f;
          for (int sb = bx; sb < DB_; sb += G) for (int i = tid; i < DT * 512; i += NTHR) { const size_t row = (size_t)MP + sb * DT + (i >> 9), c = 512 + (i & 511); const float a = bf2f(MIX[row * DM + c]), r = bf2f(R[row * DM + c]);
              num_ += (a - r) * (a - r); den_ += r * r; if (!(fabsf(a - r) <= 0.02f + 0.5f * fabsf(r))) ++bad; }
          if (bad) atomicAdd((unsigned*)(ws + WS_CTL) + CW_DBG, bad);
          num_ = wave_sum(num_); den_ = wave_sum(den_); if (lane == 0) { atomicAdd((float*)(ws + WS_CTL) + CW_DBG + 2, num_); atomicAdd((float*)(ws + WS_CTL) + CW_DBG + 3, den_); } }
#endif
    }
    if (IN(PH_ATTN2) && bx >= DB_) {
        LAS float* scr = (LAS float*)(lds + wave * 16384);
        for (int it = (bx - DB_) * NWAVES + wave; it < 16 * 32; it += (G - DB_) * NWAVES) p0_transpose_item(w_out_even, DM, DM, WOUT0T, DM, nullptr, scr, it, lane);
        if (G == 256) for (int it = (bx - DB_) * NWAVES + wave; it < 16 * 128; it += (G - DB_) * NWAVES) p0_transpose_item(w_up, DFF, DFF, WUPT, DM, norm_ffn, scr, it, lane);
    }
    SEAM(PH_ATTN2);
    if (IN(PH_OUT0)) GEMM_RESID_SPLIT(MIX, DM, WOUT0T, DM);
    if (IN(PH_OUT0) && G != 256) {
        const int gw2 = bx * NWAVES + wave, NGW2 = G * NWAVES;
        LAS float* scr = (LAS float*)(lds + wave * 16384);
        constexpr int I8 = 16 * 128, I10 = 64 * 32;
        for (int it = gw2; it < I8 + I10; it += NGW2) {
            if (it < I8) p0_transpose_item(w_up, DFF, DFF, WUPT, DM, norm_ffn, scr, it, lane);
            else p0_transpose_item(w_down, DM, DM, WDNT, DFF, nullptr, scr, it - I8, lane);
        }
    }
    SEAM(PH_OUT0);
    if (IN(PH_UP0) && REP_ID == 30) GEMM_PHASE(30, XB, DM, 0, 0, WUPT, MT, DFF, DM, FNull, (float*)(ws + WS_DBG));
    if (IN(PH_UP0)) { FIXUP_DEFERRED(0, 8); GEMM_PHASE_P8_RDY(0, 5, XB, DM, WUPT, MT, DFF, DM, FUp, SSQ, H); }
    if (IN(PH_UP0)) {
        const int nidle = G - 64;
        if (G == 256 ? (bx >= 64) : true) {
            const int gw2 = (G == 256 ? (bx - 64) : bx) * NWAVES + wave, NGW2 = (G == 256 ? nidle : G) * NWAVES;
            LAS float* scr = (LAS float*)(lds + wave * 16384);
            constexpr int I3 = 2 * 4, I7 = 16 * 32, I8 = 16 * 128, I10 = 64 * 32, I12 = 16 * 64;
            constexpr int NIT2 = I8 + I10 + I12 + 16 * I3 + I7;
            if (G == 256) for (int it = gw2; it < I10; it += NGW2) p0_transpose_item(w_down, DM, DM, WDNT, DFF, nullptr, scr, it, lane);
            for (int it = gw2; it < NIT2; it += NGW2) {
                int r = it;
                if (r < I8) { p0_transpose_item(w_up + (size_t)DM * DFF, DFF, DFF, WUPT + (size_t)DFF * DM, DM, norm_ffn + DM, scr, r, lane); continue; } r -= I8;
                if (r < I10) { p0_transpose_item(w_down + (size_t)DFF * DM, DM, DM, WDNT + (size_t)DM * DFF, DFF, nullptr, scr, r, lane); continue; } r -= I10;
                if (r < I12) { p0_transpose_item(w_in_rnn, 2048, 2048, WINRT, DM, norm_mix + DM, scr, r, lane); continue; } r -= I12;
                if (r < 16 * I3) { const int q = r / I3, n = q >> 1, isx = q & 1; const float* src = (isx ? w_gate_x : w_gate_a) + (size_t)n * 128 * 128;
                    p0_transpose_item(src, 128, 128, WGATET + (size_t)(n * 256 + isx * 128) * 256 + (n & 1) * 128, 256, nullptr, scr, r % I3, lane); continue; } r -= 16 * I3;
                p0_transpose_item(w_out_rnn, DM, DM, WOUTRT, DM, nullptr, scr, r, lane);
            }
        }
    }
    SEAM(PH_UP0);
    if (IN(PH_DN0)) GEMM_DOWN(H, WDNT, false);
    SEAM(PH_DN0);
    if (IN(PH_RNNIN)) { FIXUP_DEFERRED(1, 16); GEMM_PHASE_P8_RDY(1, 7, XB, DM, WINRT, MT, 2048, DM, FRnnIn, SSQ, GATE, U); }
    SEAM(PH_RNNIN);
    if (IN(PH_CONV)) for (int rep_ = 0; rep_ < REPN(12); ++rep_) {
        for (int it = bx * NTHR + tid; it < (MP / 16) * 128; it += G * NTHR) conv_item<true>((it >> 7) * 16, 16, (it & 127) * 8, U, state_conv, conv_w, conv_b, V, out);
        for (int it = bx * NTHR + tid; it < DB_ * 128; it += G * NTHR) conv_item<false>(MP + (it >> 7) * DT, DT, (it & 127) * 8, U, state_conv, conv_w, conv_b, V, out);
    }
    SEAM(PH_CONV);
    if (IN(PH_GATES)) for (int rep_ = 0; rep_ < REPN(9); ++rep_) { pg8::Gemm g{V, WGATET, MT, 2048, 256, DM, 256, 1}; pg8::StaticOrder S; S.init(MT, 2048, 256, G, bx);
        EpiGates E{V, b_gate_a, b_gate_x, (const float*)(ws + WS_SP8), (bf16_t*)(ws + WS_HL), (bf16_t*)(ws + WS_AC), (float*)(ws + WS_SUM)}; pg8::gemm_phase<false>(lds, g, S, E, STREAM_CTL(8)); }
    SEAM(PH_GATES);
    if (IN(PH_SCAN)) for (int rep_ = 0; rep_ < REPN(11); ++rep_) {
        const bf16_t* HL = (const bf16_t*)(ws + WS_HL); const bf16_t* AC = (const bf16_t*)(ws + WS_AC); const float* SUM = (const float*)(ws + WS_SUM);
        for (int idx = bx * NTHR + tid; idx < 256 * 4 * 128; idx += G * NTHR) {
            const int cg = idx & 127, qt = (idx >> 7) & 3, segp = idx >> 9, sq = segp & 63, ch = cg * 8;
            float h[8];
#pragma unroll
            for (int e = 0; e < 8; ++e) h[e] = 0.f;
            for (int k = 0; k < sq; ++k) {
                const f32x4* sp4 = (const f32x4*)(SUM + ((size_t)(segp - sq + k) * DM + ch) * 2);
                const f32x4 s0 = sp4[0], s1 = sp4[1], s2 = sp4[2], s3 = sp4[3];
                h[0] = s0.x * h[0] + s0.y; h[1] = s0.z * h[1] + s0.w; h[2] = s1.x * h[2] + s1.y; h[3] = s1.z * h[3] + s1.w;
                h[4] = s2.x * h[4] + s2.y; h[5] = s2.z * h[5] + s2.w; h[6] = s3.x * h[6] + s3.y; h[7] = s3.z * h[7] + s3.w;
            }
            for (int t = 0; t < 16; ++t) {
                const size_t off = (size_t)(segp * 64 + qt * 16 + t) * DM + ch;
                const u32x4 hl = *(const u32x4*)(HL + off), ac = *(const u32x4*)(AC + off), gt = *(const u32x4*)(GATE + off);
                float hv[8]; u32x4 o;
#pragma unroll
                for (int e2 = 0; e2 < 4; ++e2) {
                    hv[2 * e2] = __uint_as_float(hl[e2] << 16) + __uint_as_float(ac[e2] << 16) * h[2 * e2];
                    hv[2 * e2 + 1] = __uint_as_float(hl[e2] & 0xffff0000u) + __uint_as_float(ac[e2] & 0xffff0000u) * h[2 * e2 + 1];
                    o[e2] = pk2(__uint_as_float(gt[e2] << 16) * hv[2 * e2], __uint_as_float(gt[e2] & 0xffff0000u) * hv[2 * e2 + 1]);
                }
                *(u32x4*)(YB + off) = o;
                if (sq == 63 && qt == 3 && t == 15) {
#pragma unroll
                    for (int e = 0; e < 8; ++e) out[O_LRU_P + (size_t)(segp >> 6) * DM + ch + e] = hv[e];
                }
            }
        }
        for (int idx = bx * NTHR + tid; idx < DB_ * 128; idx += G * NTHR) {
            const int cg = idx & 127, sb = idx >> 7, ch = cg * 8;
            float h[8];
#pragma unroll
            for (int e = 0; e < 8; ++e) h[e] = state_lru[(size_t)sb * DM + ch + e];
            for (int t = 0; t < DT; ++t) {
                const size_t off = (size_t)(MP + sb * DT + t) * DM + ch;
                const u32x4 hl = *(const u32x4*)(HL + off), ac = *(const u32x4*)(AC + off), gt = *(const u32x4*)(GATE + off);
                float hv[8]; u32x4 o;
#pragma unroll
                for (int e2 = 0; e2 < 4; ++e2) {
                    hv[2 * e2] = __uint_as_float(hl[e2] << 16) + __uint_as_float(ac[e2] << 16) * h[2 * e2];
                    hv[2 * e2 + 1] = __uint_as_float(hl[e2] & 0xffff0000u) + __uint_as_float(ac[e2] & 0xffff0000u) * h[2 * e2 + 1];
                    o[e2] = pk2(__uint_as_float(gt[e2] << 16) * hv[2 * e2], __uint_as_float(gt[e2] & 0xffff0000u) * hv[2 * e2 + 1]);
                }
                *(u32x4*)(YB + off) = o;
                if (t == DT - 1) {
#pragma unroll
                    for (int e = 0; e < 8; ++e) out[O_LRU_S + (size_t)sb * DM + ch + e] = hv[e];
                }
            }
        }
    }
    SEAM(PH_SCAN);
    if (IN(PH_OUTR)) GEMM_RESID_SPLIT(YB, DM, WOUTRT, DM);
    SEAM(PH_OUTR);
    if (IN(PH_UP1)) { FIXUP_DEFERRED(2, 8); GEMM_PHASE_P8_RDY(2, 10, XB, DM, WUPT + (size_t)DFF * DM, MT, DFF, DM, FUp, SSQ, H); }
    SEAM(PH_UP1);
#if DBG_ANY
    if (IN(PH_DN1)) { const float n_ = __hip_atomic_load((float*)(ws + WS_CTL) + CW_DBG + 2, __ATOMIC_RELAXED, __HIP_MEMORY_SCOPE_AGENT), d_ = __hip_atomic_load((float*)(ws + WS_CTL) + CW_DBG + 3, __ATOMIC_RELAXED, __HIP_MEMORY_SCOPE_AGENT);
        if ((__hip_atomic_load((unsigned*)(ws + WS_CTL) + CW_DBG, __ATOMIC_RELAXED, __HIP_MEMORY_SCOPE_AGENT) != 0u || n_ > DBG_RVR * d_) && bx == 0 && tid == 0) out[O_LRU_S] = __builtin_nanf(""); }
#endif
    if (IN(PH_DN1)) GEMM_DOWN(H, WDNT + (size_t)DM * DFF, true);
#undef IN
#undef SEAM
#undef GEMM_PHASE
}

#ifndef MK_ONE
#define MK_ONE 1
#endif
extern "C" void kernel_launch(void* const* d_in, const int* in_sizes, int n_in, void* d_out, int out_size, void* d_ws, size_t ws_size, hipStream_t stream) {
    (void)in_sizes; (void)out_size;
    static int grid = 0;
    if (grid == 0) {
        if (n_in != 32 || ws_size < WS_END) { fprintf(stderr, "kernel_launch: unexpected inputs / workspace\n"); grid = -1; return; }
        int dev = 0, cus = 0, per_cu = 0;
        if (hipGetDevice(&dev) != hipSuccess || hipDeviceGetAttribute(&cus, hipDeviceAttributeMultiprocessorCount, dev) != hipSuccess) { grid = -1; return; }
        if (hipFuncSetAttribute((const void*)mk, hipFuncAttributeMaxDynamicSharedMemorySize, LDS_BYTES) != hipSuccess) { fprintf(stderr, "kernel_launch: hipFuncSetAttribute failed\n"); grid = -1; return; }
        if (hipOccupancyMaxActiveBlocksPerMultiprocessor(&per_cu, (const void*)mk, NTHR, LDS_BYTES) != hipSuccess || per_cu < 1) { fprintf(stderr, "kernel_launch: occupancy query reports %d\n", per_cu); }
        (void)hipGetLastError();
        grid = cus;
    }
    if (grid < 0) return;
    unsigned char* ws = (unsigned char*)d_ws;
    (void)hipMemsetAsync(ws + WS_CTL, 0, CTL_ZERO_BYTES, stream);
    Args a{};
    for (int i = 0; i < 32; ++i) a.in[i] = d_in[i];
    a.out = (float*)d_out; a.ws = ws;
#if MK_ONE
    a.ph_lo = 0; a.ph_hi = PH_COUNT;
    hipLaunchKernelGGL(mk, dim3(grid), dim3(NTHR), LDS_BYTES, stream, a);
#else
    for (int p = 0; p < PH_COUNT; ++p) { a.ph_lo = p; a.ph_hi = p + 1; hipLaunchKernelGGL(mk, dim3(grid), dim3(NTHR), LDS_BYTES, stream, a); }
#endif
}
```

```cpp
#include <hip/hip_runtime.h>
#include <stdint.h>
#include <math.h>
#include <stdio.h>

#define DI __device__ __forceinline__
#define LAS __attribute__((address_space(3)))
typedef unsigned short bf16_t;
typedef short bf16x8 __attribute__((ext_vector_type(8)));
typedef float f32x4 __attribute__((ext_vector_type(4)));
typedef float f32x16 __attribute__((ext_vector_type(16)));
typedef unsigned u32x2 __attribute__((ext_vector_type(2)));
typedef unsigned u32x4 __attribute__((ext_vector_type(4)));

constexpr int DM = 1024, SEQ = 4096, NB = 4, MP = NB * SEQ  , DB_ = 128, DT = 8, MS = DB_ * DT  , MT = MP + MS  ;
constexpr int PAST = 8192, PAGE = 128, NPAGES = PAST / PAGE  , NKEYS = PAST + DT  ;
constexpr int POOLD = 512, QDIM = 768, KVR = 256, ROPE = 32, NH = 8, QKH = 96, NOPE = 64, VH = 64;
constexpr int NZ0 = 1792  , DFF = 4096;
constexpr float EPS = 1e-6f;
constexpr float SM_SCALE = 0.10206207261596577f;
constexpr float QSCALE = 0.10206207261596577f * 1.4426950408889634f;

constexpr size_t O_Y = 0;
constexpr size_t O_CKV_P = (size_t)MT * DM;
constexpr size_t O_KR_P = O_CKV_P + (size_t)MP * KVR;
constexpr size_t O_POOL_P = O_KR_P + (size_t)MP * ROPE;
constexpr size_t O_CONV_P = O_POOL_P + (size_t)NB * 15 * POOLD;
constexpr size_t O_LRU_P = O_CONV_P + (size_t)NB * 3 * DM;
constexpr size_t O_CKV_S = O_LRU_P + (size_t)NB * DM;
constexpr size_t O_KR_S = O_CKV_S + (size_t)MS * KVR;
constexpr size_t O_POOL_S = O_KR_S + (size_t)MS * ROPE;
constexpr size_t O_CONV_S = O_POOL_S + (size_t)DB_ * 15 * POOLD;
constexpr size_t O_LRU_S = O_CONV_S + (size_t)DB_ * 3 * DM;
constexpr size_t O_END = O_LRU_S + (size_t)DB_ * DM;
static_assert(O_END == 24393728, "output size");

constexpr size_t MiB = 1u << 20;
constexpr size_t WS_CTL = 0, CTL_ZERO_BYTES = 256 * 1024;
constexpr size_t WS_WIN0T = 1 * MiB;
constexpr size_t WS_WKVT = 5 * MiB;
constexpr size_t WS_WPOOLT = 6 * MiB;
constexpr size_t WS_WGATET = 7 * MiB;
constexpr size_t WS_WOUT0T = 8 * MiB;
constexpr size_t WS_WOUTRT = 10 * MiB;
constexpr size_t WS_WINRT = 12 * MiB;
constexpr size_t WS_WUPT = 16 * MiB;
constexpr size_t WS_WDNT = 32 * MiB;
constexpr size_t WS_SSQ = 48 * MiB;
constexpr size_t WS_SP8 = 49 * MiB + 96 * 1024;
constexpr size_t WS_ROPE = 49 * MiB + 128 * 1024;
constexpr size_t WS_XB = 50 * MiB;
constexpr size_t WS_Z0 = 84 * MiB;
constexpr size_t WS_QB = 144 * MiB;
constexpr size_t WS_CB = 170 * MiB;
constexpr size_t WS_KRB = 179 * MiB;
constexpr size_t WS_DB = 181 * MiB;
constexpr size_t WS_KV = 944 * MiB;
constexpr size_t WS_MIX = 230 * MiB;
constexpr size_t WS_H = 264 * MiB;
constexpr size_t WS_GATE = 400 * MiB;
constexpr size_t WS_U = 434 * MiB;
constexpr size_t WS_V = 468 * MiB;
constexpr size_t WS_G = 502 * MiB;
constexpr size_t WS_HL = WS_G, WS_AC = WS_G + 34 * MiB, WS_SUM = WS_G + 68 * MiB;
constexpr size_t WS_YB = 638 * MiB;
constexpr size_t WS_SC = 672 * MiB;
constexpr size_t WS_LAT = 930 * MiB;
constexpr size_t WS_ACCS = 1136 * MiB;
constexpr size_t WS_PART = 1140 * MiB;
constexpr size_t WS_END = 1140 * MiB + 2 * 256 * 262144;
constexpr int CW_BAR = 4096;
constexpr int CW_DBG = 64;
constexpr int CW_SKT = 128;
constexpr int CW_SKF = 32768;
constexpr size_t WS_DBG = 1000 * MiB;
constexpr size_t WS_LATP = 980 * MiB;
constexpr size_t WS_ML = 998 * MiB;
#ifndef DBG_ATTN_P
#define DBG_ATTN_P 0
#endif
#ifndef DBG_ATTN_S
#define DBG_ATTN_S 0
#endif
#ifndef DBG_KNORM
#define DBG_KNORM 0
#endif
#ifndef DBG_RVR
#define DBG_RVR 0.004f
#endif
#define DBG_ANY (DBG_ATTN_P || DBG_ATTN_S || DBG_KNORM)
#ifndef REP_ID
#define REP_ID 0
#endif
#define REPN(id) ((REP_ID == (id)) ? 2 : 1)

constexpr int NWAVES = 8, NTHR = NWAVES * 64;
constexpr int LDS_BYTES = 163840;
constexpr int LDS_MISC = LDS_BYTES - 1024;

DI unsigned f2bf(float f) { unsigned u = __float_as_uint(f); return (u + 0x7fffu + ((u >> 16) & 1u)) >> 16; }
DI float bf2f(bf16_t b) { return __uint_as_float(((unsigned)b) << 16); }
DI unsigned pk2(float lo, float hi) { return f2bf(lo) | (f2bf(hi) << 16); }
DI float xsum16(float x) { auto r = __builtin_amdgcn_permlane16_swap(__float_as_uint(x), __float_as_uint(x), false, false); return __uint_as_float(r[0]) + __uint_as_float(r[1]); }
DI float xsum32(float x) { auto r = __builtin_amdgcn_permlane32_swap(__float_as_uint(x), __float_as_uint(x), false, false); return __uint_as_float(r[0]) + __uint_as_float(r[1]); }
DI float xmax16(float x) { auto r = __builtin_amdgcn_permlane16_swap(__float_as_uint(x), __float_as_uint(x), false, false); return fmaxf(__uint_as_float(r[0]), __uint_as_float(r[1])); }
DI float xmax32(float x) { auto r = __builtin_amdgcn_permlane32_swap(__float_as_uint(x), __float_as_uint(x), false, false); return fmaxf(__uint_as_float(r[0]), __uint_as_float(r[1])); }
template <int CTRL> DI float dppf(float v) { return __int_as_float(__builtin_amdgcn_update_dpp(0, __float_as_int(v), CTRL, 0xF, 0xF, true)); }
DI float xchg4(float v, bool upper) { const float a = dppf<0x104>(v), b = dppf<0x114>(v); return upper ? b : a; }
DI float max8(float v) { v = fmaxf(v, dppf<0xB1>(v)); v = fmaxf(v, dppf<0x4E>(v)); v = fmaxf(v, dppf<0x141>(v)); return v; }
DI float sum8(float v) { v += dppf<0xB1>(v); v += dppf<0x4E>(v); v += dppf<0x141>(v); return v; }
DI float sum16(float v) { v = sum8(v); v += dppf<0x140>(v); return v; }
DI float wave_sum(float v) { return xsum32(xsum16(sum16(v))); }
DI float wave_max(float v) {
#pragma unroll
    for (int o = 1; o < 64; o <<= 1) v = fmaxf(v, __shfl_xor(v, o));
    return v;
}
DI float row_rinv(const float* SSQ, int row) {
    float s = 0.f;
#pragma unroll
    for (int p = 0; p < 16; ++p) s += SSQ[(size_t)p * MT + row];
    return rsqrtf(s * (1.0f / DM) + EPS);
}
DI float max3f(float a, float b, float c) { float r; asm("v_max3_f32 %0, %1, %2, %3" : "=v"(r) : "v"(a), "v"(b), "v"(c)); return r; }
DI float gelu_tanh(float x) { const float u = 0.7978845608028654f * (x + 0.044715f * x * x * x); return x * __builtin_amdgcn_rcpf(1.0f + __builtin_amdgcn_exp2f(-2.0f * 1.4426950408889634f * u)); }
DI float sigmoidf(float x) { return 1.f / (1.f + expf(-x)); }

struct UPre { float v[8]; };
namespace pg8 {
constexpr int BM = 256, BK = 64, HALF = 128, HTB = HALF * BK * 2, STAGE_BYTES = 8 * HTB, NXCD = 8, WGM = 8;
__host__ __device__ __forceinline__ int lds_byte(int r, int c) { const int st = (r >> 4) * 2 + (c >> 5), rr = r & 15, cc = c & 31, ob = rr * 64 + cc * 2; return st * 1024 + (ob ^ (((ob >> 9) & 1) << 5)); }
__host__ __device__ __forceinline__ void stage_rc(int b, int& R, int& C) { const int st = b / 1024, sb = b % 1024, swz = sb ^ (((sb >> 9) & 1) << 5); R = (st >> 1) * 16 + swz / 64; C = (st & 1) * 32 + (swz % 64) / 2; }
struct Unit { int pm, pn; };
struct Gemm { const bf16_t* A; const bf16_t* Bt; int M, N, K, lda, a_tile_off, a_shift; unsigned* ready = nullptr; unsigned ready_target = 0; };
struct Seg { int pm, pn, t0, t1; };
struct StreamOrder {
    int nM, nN, ppu, ub, lo, hi;
    DI void init(int M, int N, int K, int G, int c) {
        nM = M / BM; nN = N / BM; ppu = K / (2 * BK);
        const int nwg = nM * nN, x = c % NXCD, k = c / NXCD, nk = G / NXCD, q = nwg / NXCD, r = nwg % NXCD;
        ub = x * q + (x < r ? x : r); const int cnt = q + (x < r ? 1 : 0); const int Pr = cnt * ppu;
        lo = (k * Pr) / nk; hi = ((k + 1) * Pr) / nk;
    }
    DI bool next(int i, Seg& s) const {
        const int ul = lo / ppu + i, start = ul * ppu; if (start >= hi) return false;
        const int p0 = (lo > start ? lo : start) - start, p1 = ((hi < start + ppu) ? hi : start + ppu) - start;
        s.t0 = 2 * p0; s.t1 = 2 * p1;
        const int wgid = ub + ul, nig = WGM * nN, gid = wgid / nig, fm = gid * WGM, gsz = (nM - fm) < WGM ? (nM - fm) : WGM;
        s.pm = fm + ((wgid % nig) % gsz); s.pn = (wgid % nig) / gsz; return true;
    }
};
struct SplitTailOrder {
    int nt, c, ways, plen;
    DI void init(int K, int c_) { nt = K / BK; c = c_; ways = 16; plen = nt / 16; if (plen < 2) { plen = 2; ways = nt / 2; } }
    DI bool next(int i, Seg& u) const {
        if (i == 0) { u.t0 = 0; u.t1 = nt; const int xcd = c % NXCD, off = c / NXCD, wgid = xcd * 32 + off; u.pm = (wgid >> 5) * 8 + (wgid & 7); u.pn = (wgid >> 3) & 3; return true; }
        if (i == 1) { const int us = c >> 4, part = c & 15; if (part >= ways) return false; u.pm = 64 + (us >> 2); u.pn = us & 3; u.t0 = part * plen; u.t1 = u.t0 + plen; return true; }
        return false;
    }
};
struct StaticOrder {
    int nM, nN, nwg, G, c, nt;
    DI void init(int M, int N, int K, int G_, int c_) { nM = M / BM; nN = N / BM; nwg = nM * nN; G = G_; c = c_; nt = K / BK; }
    DI bool next(int i, Seg& u) const {
        u.t0 = 0; u.t1 = nt;
        const long L = (long)i * G + c; if (L >= nwg) return false;
        int wgid = (int)L; { const int q = nwg / NXCD, r = nwg % NXCD, xcd = wgid % NXCD, off = wgid / NXCD; wgid = (xcd < r ? xcd * (q + 1) : r * (q + 1) + (xcd - r) * q) + off; }
        const int nig = WGM * nN, gid = wgid / nig, fm = gid * WGM, gsz = (nM - fm) < WGM ? (nM - fm) : WGM;
        u.pm = fm + ((wgid % nig) % gsz); u.pn = (wgid % nig) / gsz; return true;
    }
};
struct NoPre {};
__host__ __device__ __forceinline__ int perm32(int rho) { const int n = rho >> 4, i = rho & 15; return 8 * (i >> 2) + 4 * n + (i & 3); }
template <class F, bool P64 = false, bool P8 = false> struct EpiRows {
    F f;
    static constexpr bool PERM64 = P64;
    static constexpr bool PERM8 = P8;
    DI UPre unit_pre(int pm) const { return f.unit_pre(pm * BM); }
    DI void operator()(const f32x4 (&acc)[2][2][4][2], const Unit& u, int wr, int wc, int fr, int fq, const UPre& upre) const {
        constexpr int BJS = P64 ? 32 : HALF;
        const int row0 = u.pm * BM + wr * 64 + fr, col0 = u.pn * BM + wc * (P64 ? 64 : 32) + (P8 ? 8 : 4) * fq;
        f.unit_begin(u.pm * BM, upre);
#pragma unroll
        for (int ai = 0; ai < 2; ++ai) {
            typename F::RowPre rp[4]; typename F::Pre pr[4][2][2]; typename F::Pre8 pr8[4][2];
#pragma unroll
            for (int m = 0; m < 4; ++m) rp[m] = f.row_pre(row0 + ai * HALF + m * 16);
#pragma unroll
            for (int m = 0; m < 4; ++m)
#pragma unroll
                for (int bj = 0; bj < 2; ++bj)
#pragma unroll
                    for (int n = 0; n < 2; ++n) { if constexpr (P8) { if (n == 0) pr8[m][bj] = f.pre8(row0 + ai * HALF + m * 16, col0 + bj * BJS); } else pr[m][bj][n] = f.pre(row0 + ai * HALF + m * 16, col0 + bj * BJS + n * 16); }
#pragma unroll
            for (int m = 0; m < 4; ++m) {
                const int row = row0 + ai * HALF + m * 16;
                typename F::Ctx ctx = f.row_begin(row, rp[m]);
                if constexpr (P8) {
#pragma unroll
                    for (int bj = 0; bj < 2; ++bj) f.op8(ctx, row, col0 + bj * BJS, acc[ai][bj][m][0], acc[ai][bj][m][1], pr8[m][bj]);
                } else {
#pragma unroll
                    for (int bj = 0; bj < 2; ++bj)
#pragma unroll
                        for (int n = 0; n < 2; ++n) f(ctx, row, col0 + bj * BJS + n * 16, acc[ai][bj][m][n], pr[m][bj][n]);
                }
                f.row_end(ctx, row, u.pn, wc, fq);
            }
        }
    }
};

struct StreamCtl { float* part; unsigned* flags; unsigned* tmo; unsigned epoch; int c; int pad; };
struct NoPart { DI void operator()(const f32x4 (&)[2][2][4][2], const Unit&, int, int, int, int) const {} };
template <bool STREAM, class Sched, class Epi, class EpiPart = NoPart>
DI void gemm_phase(LAS unsigned char* lds, const Gemm g, const Sched& S, const Epi& E, const StreamCtl sc, const EpiPart EP = EpiPart()) {
    const int tid = threadIdx.x, wid = __builtin_amdgcn_readfirstlane(tid >> 6), lane = tid & 63, wr = wid >> 2, wc = wid & 3, fr = lane & 15, fq = lane >> 4;
    const int K = g.K, nt = K / BK;
    unsigned voffA[2], voffB[2];
#pragma unroll
    for (int i = 0; i < 2; ++i) { int R, C; stage_rc(tid * 16 + i * 8192, R, C); const int r31 = Epi::PERM8 ? perm32(R & 31) : (R & 31); const int Rb = Epi::PERM64 ? (64 * (R >> 5) + r31) : ((R & ~31) + r31); voffA[i] = (unsigned)(R * g.lda + C) * 2u; voffB[i] = (unsigned)(Rb * K + C) * 2u; }
    const size_t kstep = (size_t)(BK * 2);
    const size_t hstepA = (size_t)HALF * g.lda * 2, hstepB = (size_t)(Epi::PERM64 ? 32 : HALF) * K * 2;
    const size_t tstepA = 2 * hstepA, tstepB = (size_t)BM * K * 2, pstepA = (size_t)g.a_tile_off * 2;
    const unsigned ldsw = (unsigned)wid * 1024u;
    const int aoff = lds_byte(wr * 64 + fr, fq * 8), boff = lds_byte(wc * 32 + fr, fq * 8);
#define PG8_SA(b, h) (((b) * 2 + (h)) * HTB)
#define PG8_SB(b, h) ((4 + (b) * 2 + (h)) * HTB)
#define PG8_STAGE(bufoff, gbase, voff) do { _Pragma("unroll") for (int _i = 0; _i < 2; ++_i) \
        __builtin_amdgcn_global_load_lds((const unsigned*)((const char*)(gbase) + (voff)[_i]), (LAS unsigned*)(lds + (bufoff) + ldsw + _i * 8192), 16, 0, 0); } while (0)
#define PG8_LDA(dst, b, h) do { _Pragma("unroll") for (int m = 0; m < 4; ++m) _Pragma("unroll") for (int k = 0; k < 2; ++k) dst[m][k] = *(const LAS bf16x8*)(lds + PG8_SA(b, h) + aoff + m * 2048 + k * 1024); } while (0)
#define PG8_LDB(dst, b, h) do { _Pragma("unroll") for (int n = 0; n < 2; ++n) _Pragma("unroll") for (int k = 0; k < 2; ++k) dst[n][k] = *(const LAS bf16x8*)(lds + PG8_SB(b, h) + boff + n * 2048 + k * 1024); } while (0)
#define PG8_MMA(ai, bj, At, Bt) do { __builtin_amdgcn_s_setprio(1); _Pragma("unroll") for (int m = 0; m < 4; ++m) _Pragma("unroll") for (int n = 0; n < 2; ++n) _Pragma("unroll") for (int k = 0; k < 2; ++k) \
        acc[ai][bj][m][n] = __builtin_amdgcn_mfma_f32_16x16x32_bf16(Bt[n][k], At[m][k], acc[ai][bj][m][n], 0, 0, 0); __builtin_amdgcn_s_setprio(0); } while (0)
#define PG8_WAIT_V(n) asm volatile("s_waitcnt vmcnt(" #n ")" ::: "memory")
#define PG8_WAIT_L(n) asm volatile("s_waitcnt lgkmcnt(" #n ")" ::: "memory")
#define PG8_BAR __builtin_amdgcn_s_barrier()
#define PG8_SCHED __builtin_amdgcn_sched_barrier(0)
    Seg cur = {0, 0, 0, 0}, nxt = {0, 0, 0, 0}; int ui = 0;
    if (!S.next(0, cur)) return;
    bool waited = g.ready == nullptr;
#define PG8_READY_WAIT() do { if (wid == 0) { unsigned sp_ = 0; \
            while (__hip_atomic_load(g.ready, __ATOMIC_RELAXED, __HIP_MEMORY_SCOPE_AGENT) < g.ready_target) { __builtin_amdgcn_s_sleep(2); if (++sp_ > (1u << 22)) break; } \
            __builtin_amdgcn_fence(__ATOMIC_ACQUIRE, "agent"); asm volatile("s_waitcnt vmcnt(0)" ::: "memory"); } \
        PG8_BAR; asm volatile("" ::: "memory"); waited = true; } while (0)
#define PG8_BAR __builtin_amdgcn_s_barrier()
    if (!waited && cur.pm >= MP / 256) PG8_READY_WAIT();
    f32x4 acc[2][2][4][2];
#pragma unroll
    for (int a = 0; a < 2; ++a)
#pragma unroll
        for (int b = 0; b < 2; ++b)
#pragma unroll
            for (int m = 0; m < 4; ++m)
#pragma unroll
                for (int n = 0; n < 2; ++n) acc[a][b][m][n] = (f32x4){0.f, 0.f, 0.f, 0.f};
    bf16x8 At[4][2], B0[2][2], B1[2][2];
    const char* cA = (const char*)g.A + (size_t)cur.pm * tstepA + (size_t)(cur.pn >> g.a_shift) * pstepA + (size_t)cur.t0 * kstep;
    const char* cB = (const char*)g.Bt + (size_t)cur.pn * tstepB + (size_t)cur.t0 * kstep;
    PG8_STAGE(PG8_SB(0, 0), cB, voffB); PG8_STAGE(PG8_SB(0, 1), cB + hstepB, voffB); PG8_STAGE(PG8_SA(0, 0), cA, voffA); PG8_STAGE(PG8_SA(0, 1), cA + hstepA, voffA);
    if (wr == 1) PG8_BAR;
    PG8_WAIT_V(2); PG8_BAR;
    PG8_STAGE(PG8_SB(1, 0), cB + kstep, voffB); PG8_STAGE(PG8_SA(1, 0), cA + kstep, voffA); PG8_STAGE(PG8_SB(1, 1), cB + hstepB + kstep, voffB);
    PG8_WAIT_V(6); PG8_BAR;
    for (;;) {
        const bool has_next = S.next(ui + 1, nxt);
        if (!waited && has_next && nxt.pm >= MP / 256) PG8_READY_WAIT();
        const char* nA = has_next ? (const char*)g.A + (size_t)nxt.pm * tstepA + (size_t)(nxt.pn >> g.a_shift) * pstepA + (size_t)nxt.t0 * kstep : cA;
        const char* nB = has_next ? (const char*)g.Bt + (size_t)nxt.pn * tstepB + (size_t)nxt.t0 * kstep : cB;
        const int nseg = cur.t1 - cur.t0;
        UPre upre{}; if (STREAM || nseg == nt) upre = E.unit_pre(cur.pm);
#pragma unroll 1
        for (int t = 0; t < nseg; t += 2) {
            const bool last = (t == nseg - 2);
            const char* a1 = cA + (size_t)(t + 1) * kstep;
            const char* a2 = last ? nA : cA + (size_t)(t + 2) * kstep; const char* b2 = last ? nB : cB + (size_t)(t + 2) * kstep;
            const char* a3 = a2 + kstep; const char* b3 = b2 + kstep;
            PG8_LDB(B0, 0, 0); PG8_LDB(B1, 0, 1); PG8_SCHED; PG8_LDA(At, 0, 0); PG8_STAGE(PG8_SA(1, 1), a1 + hstepA, voffA);
            PG8_WAIT_V(8); PG8_WAIT_L(0); PG8_BAR; PG8_MMA(0, 0, At, B0); PG8_MMA(0, 1, At, B1); PG8_BAR; PG8_SCHED;
            PG8_LDA(At, 0, 1); PG8_STAGE(PG8_SB(0, 0), b2, voffB); PG8_STAGE(PG8_SB(0, 1), b2 + hstepB, voffB); PG8_STAGE(PG8_SA(0, 0), a2, voffA);
            PG8_WAIT_V(8); PG8_WAIT_L(0); PG8_BAR; PG8_MMA(1, 0, At, B0); PG8_MMA(1, 1, At, B1); PG8_BAR; PG8_SCHED;
            PG8_LDB(B0, 1, 0); PG8_LDB(B1, 1, 1); PG8_SCHED; PG8_LDA(At, 1, 0); PG8_STAGE(PG8_SA(0, 1), a2 + hstepA, voffA);
            PG8_WAIT_V(8); PG8_WAIT_L(0); PG8_BAR; PG8_MMA(0, 0, At, B0); PG8_MMA(0, 1, At, B1); PG8_BAR; PG8_SCHED;
            PG8_LDA(At, 1, 1); PG8_STAGE(PG8_SB(1, 0), b3, voffB); PG8_STAGE(PG8_SB(1, 1), b3 + hstepB, voffB); PG8_STAGE(PG8_SA(1, 0), a3, voffA);
            PG8_WAIT_V(8); PG8_WAIT_L(0); PG8_BAR; PG8_MMA(1, 0, At, B0); PG8_MMA(1, 1, At, B1); PG8_BAR; PG8_SCHED;
        }
        if (wr == 0) PG8_BAR;
        if (STREAM && cur.t0 > 0) {
            const __amdgpu_buffer_rsrc_t prs = __builtin_amdgcn_make_buffer_rsrc((void*)(sc.part + ((size_t)(sc.epoch & 1u) * gridDim.x + sc.c) * 65536), (short)0, 262144, 0x00020000);
#pragma unroll
            for (int a = 0; a < 2; ++a)
#pragma unroll
                for (int b = 0; b < 2; ++b)
#pragma unroll
                    for (int m = 0; m < 4; ++m)
#pragma unroll
                        for (int n = 0; n < 2; ++n) { const int j = ((a * 2 + b) * 4 + m) * 2 + n; const f32x4 v = acc[a][b][m][n];
                            __builtin_amdgcn_raw_buffer_store_b128(__builtin_bit_cast(u32x4, v), prs, (unsigned)tid * 16u, j * 8192, 16); }
            asm volatile("s_waitcnt vmcnt(0)" ::: "memory");
            PG8_BAR;
            if (tid == 0) __hip_atomic_store(sc.flags + (size_t)sc.c * 64, sc.epoch, __ATOMIC_RELAXED, __HIP_MEMORY_SCOPE_AGENT);
        } else {
            Unit uu; uu.pm = cur.pm; uu.pn = cur.pn;
            if (!STREAM && (cur.t1 - cur.t0) != nt) EP(acc, uu, wr, wc, fr, fq); else E(acc, uu, wr, wc, fr, fq, upre);
        }
        if (!has_next) break;
        if (STREAM && nxt.t1 < nt) {
            const int pc = sc.c + NXCD;
            if (wid == 0) {
                unsigned* fl = sc.flags + (size_t)pc * 64; unsigned sp = 0; bool ok = true;
                while (__hip_atomic_load(fl, __ATOMIC_RELAXED, __HIP_MEMORY_SCOPE_AGENT) != sc.epoch) {
                    __builtin_amdgcn_s_sleep(1);
                    if ((++sp & 255u) == 0u) { if (__hip_atomic_load(sc.tmo, __ATOMIC_RELAXED, __HIP_MEMORY_SCOPE_AGENT) != 0u || sp > (1u << 20)) { ok = false; break; } }
                }
                if (!ok && lane == 0) __hip_atomic_store(sc.tmo, 1u, __ATOMIC_RELAXED, __HIP_MEMORY_SCOPE_AGENT);
                __builtin_amdgcn_fence(__ATOMIC_ACQUIRE, "agent");
                asm volatile("s_waitcnt vmcnt(0)" ::: "memory");
            }
            PG8_BAR; asm volatile("" ::: "memory");
            const __amdgpu_buffer_rsrc_t crs = __builtin_amdgcn_make_buffer_rsrc((void*)(sc.part + ((size_t)(sc.epoch & 1u) * gridDim.x + pc) * 65536), (short)0, 262144, 0x00020000);
#pragma unroll
            for (int a = 0; a < 2; ++a)
#pragma unroll
                for (int b = 0; b < 2; ++b)
#pragma unroll
                    for (int m = 0; m < 4; ++m)
#pragma unroll
                        for (int n = 0; n < 2; ++n) acc[a][b][m][n] = __builtin_bit_cast(f32x4, __builtin_amdgcn_raw_buffer_load_b128(crs, (unsigned)tid * 16u, ((((a * 2 + b) * 4 + m) * 2 + n) * 8192), 0));
        } else {
#pragma unroll
            for (int a = 0; a < 2; ++a)
#pragma unroll
                for (int b = 0; b < 2; ++b)
#pragma unroll
                    for (int m = 0; m < 4; ++m)
#pragma unroll
                        for (int n = 0; n < 2; ++n) acc[a][b][m][n] = (f32x4){0.f, 0.f, 0.f, 0.f};
        }
        cur = nxt; cA = nA; cB = nB; ++ui;
        if (wr == 1) PG8_BAR;
    }
    PG8_WAIT_V(0);
    PG8_BAR;
#undef PG8_SA
#undef PG8_SB
#undef PG8_STAGE
#undef PG8_LDA
#undef PG8_LDB
#undef PG8_MMA
#undef PG8_WAIT_V
#undef PG8_WAIT_L
#undef PG8_BAR
#undef PG8_SCHED
}
}

constexpr int LDS_RINV = 131072;
DI UPre rinv_partial_load(const float* SSQ, int rowbase) {
    const int tid = threadIdx.x, r = tid >> 1, hf = tid & 1;
    UPre u;
#pragma unroll
    for (int p = 0; p < 8; ++p) u.v[p] = SSQ[(size_t)(hf * 8 + p) * MT + rowbase + r];
    return u;
}
DI void rinv_table_fill(const UPre& u) {
    extern __shared__ __attribute__((aligned(16))) unsigned char lds_raw_[];
    LAS float* tab = (LAS float*)((LAS unsigned char*)lds_raw_ + LDS_RINV);
    const int tid = threadIdx.x, r = tid >> 1, hf = tid & 1;
    float sv = ((u.v[0] + u.v[1]) + (u.v[2] + u.v[3])) + ((u.v[4] + u.v[5]) + (u.v[6] + u.v[7]));
    sv += dppf<0xB1>(sv);
    if (hf == 0) tab[r] = rsqrtf(sv * (1.0f / DM) + EPS);
    asm volatile("s_waitcnt lgkmcnt(0)" ::: "memory"); __builtin_amdgcn_s_barrier(); asm volatile("" ::: "memory");
}
DI float rinv_table_get(int row) {
    extern __shared__ __attribute__((aligned(16))) unsigned char lds_raw_[];
    return ((const LAS float*)((LAS unsigned char*)lds_raw_ + LDS_RINV))[row & 255];
}
struct FZ0 { typedef float Ctx; typedef float RowPre; typedef pg8::NoPre Pre; typedef pg8::NoPre Pre8; const float* SSQ; bf16_t* Z;
    DI UPre unit_pre(int rowbase) const { return rinv_partial_load(SSQ, rowbase); }
    DI void unit_begin(int, const UPre& sv) const { rinv_table_fill(sv); }
    DI RowPre row_pre(int row) const { return rinv_table_get(row); }
    DI Pre pre(int, int) const { return Pre{}; }
    DI pg8::NoPre pre8(int, int) const { return pg8::NoPre{}; }
    DI Ctx row_begin(int, const RowPre& rp) const { return rp; }
    DI void operator()(Ctx& ri, int row, int col, f32x4 v, const Pre&) const { u32x2 o; o.x = pk2(v.x * ri, v.y * ri); o.y = pk2(v.z * ri, v.w * ri); *(u32x2*)(Z + (size_t)row * NZ0 + col) = o; }
    DI void op8(Ctx& ri, int row, int col, f32x4 a, f32x4 b, const pg8::NoPre&) const { u32x4 o; o.x = pk2(a.x * ri, a.y * ri); o.y = pk2(a.z * ri, a.w * ri); o.z = pk2(b.x * ri, b.y * ri); o.w = pk2(b.z * ri, b.w * ri); *(u32x4*)(Z + (size_t)row * NZ0 + col) = o; }
    DI void row_end(Ctx&, int, int, int, int) const {} };
template <int LDO> struct FRawBf16 { typedef int Ctx; typedef pg8::NoPre RowPre; typedef pg8::NoPre Pre; typedef pg8::NoPre Pre8; bf16_t* O;
    DI UPre unit_pre(int) const { return UPre{}; }
    DI void unit_begin(int, const UPre&) const {}
    DI RowPre row_pre(int) const { return RowPre{}; }
    DI Pre pre(int, int) const { return Pre{}; }
    DI pg8::NoPre pre8(int, int) const { return pg8::NoPre{}; }
    DI Ctx row_begin(int, const RowPre&) const { return 0; }
    DI void operator()(Ctx&, int row, int col, f32x4 v, const Pre&) const { u32x2 o; o.x = pk2(v.x, v.y); o.y = pk2(v.z, v.w); *(u32x2*)(O + (size_t)row * LDO + col) = o; }
    DI void row_end(Ctx&, int, int, int, int) const {} };
struct KvCtx { f32x4 v[4]; int col0; int k; };
struct FKvNorm { typedef KvCtx Ctx; typedef pg8::NoPre RowPre; typedef pg8::NoPre Pre; typedef pg8::NoPre Pre8; bf16_t* O; const float* g;
    DI UPre unit_pre(int) const { return UPre{}; }
    DI void unit_begin(int, const UPre&) const {}
    DI RowPre row_pre(int) const { return RowPre{}; }
    DI Pre pre(int, int) const { return Pre{}; }
    DI pg8::NoPre pre8(int, int) const { return pg8::NoPre{}; }
    DI Ctx row_begin(int, const RowPre&) const { Ctx c; c.k = 0; c.col0 = 0; return c; }
    DI void operator()(Ctx&, int, int, f32x4, const Pre&) const {}
    DI void op8(Ctx& c, int, int col, f32x4 a, f32x4 b, const pg8::NoPre&) const { if (c.k == 0) c.col0 = col; c.v[c.k] = a; c.v[c.k + 1] = b; c.k += 2; }
    DI void row_end(Ctx& c, int row, int pn, int, int) const {
        float ri = 1.0f;
        if (pn < 2) { float ss = 0.f;
#pragma unroll
            for (int k = 0; k < 4; ++k) ss += c.v[k].x * c.v[k].x + c.v[k].y * c.v[k].y + c.v[k].z * c.v[k].z + c.v[k].w * c.v[k].w;
            ss = xsum32(xsum16(ss)); ri = rsqrtf(ss * (1.f / 64.f) + EPS); }
#pragma unroll
        for (int bj = 0; bj < 2; ++bj) { const int col = c.col0 + bj * 32; f32x4 y0 = c.v[2 * bj] * ri, y1 = c.v[2 * bj + 1] * ri;
            if (pn < 2) { y0 = y0 * *(const f32x4*)(g + (col & 63)); y1 = y1 * *(const f32x4*)(g + (col & 63) + 4); }
            u32x4 o; o.x = pk2(y0.x, y0.y); o.y = pk2(y0.z, y0.w); o.z = pk2(y1.x, y1.y); o.w = pk2(y1.z, y1.w); *(u32x4*)(O + (size_t)row * 1024 + col) = o; }
    } };
struct FPool { typedef int Ctx; typedef pg8::NoPre RowPre; typedef f32x4 Pre; typedef pg8::NoPre Pre8; const float* scale; bf16_t* MIX;
    DI pg8::NoPre pre8(int, int) const { return pg8::NoPre{}; }
    DI void op8(Ctx&, int row, int col, f32x4 a, f32x4 b, const pg8::NoPre&) const { const f32x4 s0 = *(const f32x4*)(scale + col), s1 = *(const f32x4*)(scale + col + 4);
        u32x4 o; o.x = pk2(a.x * s0.x, a.y * s0.y); o.y = pk2(a.z * s0.z, a.w * s0.w); o.z = pk2(b.x * s1.x, b.y * s1.y); o.w = pk2(b.z * s1.z, b.w * s1.w); *(u32x4*)(MIX + (size_t)row * DM + col) = o; }
    DI UPre unit_pre(int) const { return UPre{}; }
    DI void unit_begin(int, const UPre&) const {}
    DI RowPre row_pre(int) const { return RowPre{}; }
    DI Pre pre(int, int col) const { return *(const f32x4*)(scale + col); }
    DI Ctx row_begin(int, const RowPre&) const { return 0; }
    DI void operator()(Ctx&, int row, int col, f32x4 v, const Pre& s) const { u32x2 o; o.x = pk2(v.x * s.x, v.y * s.y); o.y = pk2(v.z * s.z, v.w * s.w); *(u32x2*)(MIX + (size_t)row * DM + col) = o; }
    DI void row_end(Ctx&, int, int, int, int) const {} };
template <bool FINAL> struct FResid { typedef float Ctx; typedef pg8::NoPre RowPre; typedef u32x2 Pre; typedef u32x4 Pre8; bf16_t* RB; float* Yf; float* SSQ;
    DI Pre8 pre8(int row, int col) const { return *(const u32x4*)(RB + (size_t)row * DM + col); }
    DI void op8(Ctx& ss, int row, int col, f32x4 a, f32x4 b, const Pre8& r) const {
        f32x4 y0, y1; y0.x = __uint_as_float(r.x << 16) + a.x; y0.y = __uint_as_float(r.x & 0xffff0000u) + a.y; y0.z = __uint_as_float(r.y << 16) + a.z; y0.w = __uint_as_float(r.y & 0xffff0000u) + a.w;
        y1.x = __uint_as_float(r.z << 16) + b.x; y1.y = __uint_as_float(r.z & 0xffff0000u) + b.y; y1.z = __uint_as_float(r.w << 16) + b.z; y1.w = __uint_as_float(r.w & 0xffff0000u) + b.w;
        if (FINAL) { *(f32x4*)(Yf + (size_t)row * DM + col) = y0; *(f32x4*)(Yf + (size_t)row * DM + col + 4) = y1; }
        else { u32x4 o; o.x = pk2(y0.x, y0.y); o.y = pk2(y0.z, y0.w); o.z = pk2(y1.x, y1.y); o.w = pk2(y1.z, y1.w); *(u32x4*)(RB + (size_t)row * DM + col) = o;
            ss += y0.x * y0.x + y0.y * y0.y + y0.z * y0.z + y0.w * y0.w + y1.x * y1.x + y1.y * y1.y + y1.z * y1.z + y1.w * y1.w; } }
    DI UPre unit_pre(int) const { return UPre{}; }
    DI void unit_begin(int, const UPre&) const {}
    DI RowPre row_pre(int) const { return RowPre{}; }
    DI Pre pre(int row, int col) const { return *(const u32x2*)(RB + (size_t)row * DM + col); }
    DI Ctx row_begin(int, const RowPre&) const { return 0.f; }
    DI void operator()(Ctx& ss, int row, int col, f32x4 v, const Pre& r) const {
        f32x4 y; y.x = __uint_as_float(r.x << 16) + v.x; y.y = __uint_as_float(r.x & 0xffff0000u) + v.y; y.z = __uint_as_float(r.y << 16) + v.z; y.w = __uint_as_float(r.y & 0xffff0000u) + v.w;
        if (FINAL) { *(f32x4*)(Yf + (size_t)row * DM + col) = y; }
        else { u32x2 o; o.x = pk2(y.x, y.y); o.y = pk2(y.z, y.w); *(u32x2*)(RB + (size_t)row * DM + col) = o; ss += y.x * y.x + y.y * y.y + y.z * y.z + y.w * y.w; } }
    DI void row_end(Ctx& ss, int row, int pn, int wc, int fq) const { if (!FINAL) { const float s = xsum32(xsum16(ss)); if (fq == 0) SSQ[(size_t)(pn * 4 + wc) * MT + row] = s; } } };
struct FNull { typedef int Ctx; typedef pg8::NoPre RowPre; typedef pg8::NoPre Pre; typedef pg8::NoPre Pre8; float* sink;
    DI UPre unit_pre(int) const { return UPre{}; }
    DI void unit_begin(int, const UPre&) const {}
    DI RowPre row_pre(int) const { return RowPre{}; }
    DI Pre pre(int, int) const { return Pre{}; }
    DI pg8::NoPre pre8(int, int) const { return pg8::NoPre{}; }
    DI Ctx row_begin(int, const RowPre&) const { return 0; }
    DI void operator()(Ctx&, int row, int col, f32x4 v, const Pre&) const { if (v.x == 1.2345e30f) sink[row + col] = v.y; }
    DI void row_end(Ctx&, int, int, int, int) const {} };
struct FUp { typedef float Ctx; typedef float RowPre; typedef pg8::NoPre Pre; typedef pg8::NoPre Pre8; const float* SSQ; bf16_t* H;
    DI UPre unit_pre(int rowbase) const { return rinv_partial_load(SSQ, rowbase); }
    DI void unit_begin(int, const UPre& sv) const { rinv_table_fill(sv); }
    DI RowPre row_pre(int row) const { return rinv_table_get(row); }
    DI Pre pre(int, int) const { return Pre{}; }
    DI pg8::NoPre pre8(int, int) const { return pg8::NoPre{}; }
    DI Ctx row_begin(int, const RowPre& rp) const { return rp; }
    DI void operator()(Ctx& ri, int row, int col, f32x4 v, const Pre&) const { f32x4 t = v * ri; t.x = fmaxf(t.x, 0.f); t.y = fmaxf(t.y, 0.f); t.z = fmaxf(t.z, 0.f); t.w = fmaxf(t.w, 0.f);
        u32x2 o; o.x = pk2(t.x * t.x, t.y * t.y); o.y = pk2(t.z * t.z, t.w * t.w); *(u32x2*)(H + (size_t)row * DFF + col) = o; }
    DI void op8(Ctx& ri, int row, int col, f32x4 a, f32x4 b, const pg8::NoPre&) const { f32x4 t = a * ri, w = b * ri;
        t.x = fmaxf(t.x, 0.f); t.y = fmaxf(t.y, 0.f); t.z = fmaxf(t.z, 0.f); t.w = fmaxf(t.w, 0.f); w.x = fmaxf(w.x, 0.f); w.y = fmaxf(w.y, 0.f); w.z = fmaxf(w.z, 0.f); w.w = fmaxf(w.w, 0.f);
        u32x4 o; o.x = pk2(t.x * t.x, t.y * t.y); o.y = pk2(t.z * t.z, t.w * t.w); o.z = pk2(w.x * w.x, w.y * w.y); o.w = pk2(w.z * w.z, w.w * w.w); *(u32x4*)(H + (size_t)row * DFF + col) = o; }
    DI void row_end(Ctx&, int, int, int, int) const {} };
struct FRnnIn { typedef float Ctx; typedef float RowPre; typedef pg8::NoPre Pre; typedef pg8::NoPre Pre8; const float* SSQ; bf16_t* GATE; bf16_t* U;
    DI UPre unit_pre(int rowbase) const { return rinv_partial_load(SSQ, rowbase); }
    DI void unit_begin(int, const UPre& sv) const { rinv_table_fill(sv); }
    DI RowPre row_pre(int row) const { return rinv_table_get(row); }
    DI Pre pre(int, int) const { return Pre{}; }
    DI pg8::NoPre pre8(int, int) const { return pg8::NoPre{}; }
    DI Ctx row_begin(int, const RowPre& rp) const { return rp; }
    DI void operator()(Ctx& ri, int row, int col, f32x4 v, const Pre&) const { f32x4 t = v * ri; u32x2 o;
        if (col < DM) { o.x = pk2(gelu_tanh(t.x), gelu_tanh(t.y)); o.y = pk2(gelu_tanh(t.z), gelu_tanh(t.w)); *(u32x2*)(GATE + (size_t)row * DM + col) = o; }
        else { o.x = pk2(t.x, t.y); o.y = pk2(t.z, t.w); *(u32x2*)(U + (size_t)row * DM + col - DM) = o; } }
    DI void op8(Ctx& ri, int row, int col, f32x4 a, f32x4 b, const pg8::NoPre&) const { const f32x4 t = a * ri, w = b * ri; u32x4 o;
        if (col < DM) { o.x = pk2(gelu_tanh(t.x), gelu_tanh(t.y)); o.y = pk2(gelu_tanh(t.z), gelu_tanh(t.w)); o.z = pk2(gelu_tanh(w.x), gelu_tanh(w.y)); o.w = pk2(gelu_tanh(w.z), gelu_tanh(w.w)); *(u32x4*)(GATE + (size_t)row * DM + col) = o; }
        else { o.x = pk2(t.x, t.y); o.y = pk2(t.z, t.w); o.z = pk2(w.x, w.y); o.w = pk2(w.z, w.w); *(u32x4*)(U + (size_t)row * DM + col - DM) = o; } }
    DI void row_end(Ctx&, int, int, int, int) const {} };

typedef float f32x2_t __attribute__((ext_vector_type(2))); typedef __bf16 bf16x2_t __attribute__((ext_vector_type(2)));
DI unsigned cvtpk(float lo, float hi) { f32x2_t v = {lo, hi}; bf16x2_t b = __builtin_convertvector(v, bf16x2_t); return __builtin_bit_cast(unsigned, b); }
struct EpiPartStore { float* PARTS; int part;
    DI void operator()(const f32x4 (&acc)[2][2][4][2], const pg8::Unit& u, int, int, int, int) const {
        const int us = (u.pm - MP / 256) * 4 + u.pn;
        f32x4* p = (f32x4*)(PARTS + (size_t)(us * 16 + part) * 65536) + threadIdx.x;
#pragma unroll
        for (int a = 0; a < 2; ++a)
#pragma unroll
            for (int b = 0; b < 2; ++b)
#pragma unroll
                for (int m = 0; m < 4; ++m)
#pragma unroll
                    for (int n = 0; n < 2; ++n) p[(((a * 2 + b) * 4 + m) * 2 + n) * 512] = acc[a][b][m][n];
    }
};
template <bool FINAL, int WAYS = 16> DI void sample_fixup(int b, const float* __restrict__ PARTS, bf16_t* __restrict__ RB, float* __restrict__ Yf, float* __restrict__ SSQ) {
    if (b >= 128) return;
    const int tid = threadIdx.x, wid = tid >> 6, lane = tid & 63, wr = wid >> 2, wc = wid & 3, fr = lane & 15, fq = lane >> 4;
    const int us = b >> 3, ai = (b >> 2) & 1, m = b & 3, pm = MP / 256 + (us >> 2), pn = us & 3;
    f32x4 v[2][2];
#pragma unroll
    for (int bj = 0; bj < 2; ++bj)
#pragma unroll
        for (int n = 0; n < 2; ++n) v[bj][n] = (f32x4){0.f, 0.f, 0.f, 0.f};
#pragma unroll 4
    for (int p = 0; p < WAYS; ++p) {
        const f32x4* pp = (const f32x4*)(PARTS + (size_t)(us * 16 + p) * 65536) + tid;
#pragma unroll
        for (int bj = 0; bj < 2; ++bj)
#pragma unroll
            for (int n = 0; n < 2; ++n) v[bj][n] += pp[(((ai * 2 + bj) * 4 + m) * 2 + n) * 512];
    }
    const int row = pm * 256 + ai * 128 + wr * 64 + m * 16 + fr, col0 = pn * 256 + wc * 32 + 8 * fq;
    float ss = 0.f;
#pragma unroll
    for (int bj = 0; bj < 2; ++bj)
#pragma unroll
        for (int n = 0; n < 2; ++n) { const size_t off = (size_t)row * DM + col0 + bj * 128 + n * 4; const u32x2 r = *(const u32x2*)(RB + off); const f32x4 a = v[bj][n];
            f32x4 y; y.x = __uint_as_float(r.x << 16) + a.x; y.y = __uint_as_float(r.x & 0xffff0000u) + a.y; y.z = __uint_as_float(r.y << 16) + a.z; y.w = __uint_as_float(r.y & 0xffff0000u) + a.w;
            if (FINAL) *(f32x4*)(Yf + off) = y;
            else { u32x2 o; o.x = pk2(y.x, y.y); o.y = pk2(y.z, y.w); *(u32x2*)(RB + off) = o; ss += y.x * y.x + y.y * y.y + y.z * y.z + y.w * y.w; } }
    if (!FINAL) { ss = xsum32(xsum16(ss)); if (fq == 0) SSQ[(size_t)(pn * 4 + wc) * MT + row] = ss; }
}
template <int SH> DI float dpp_row_shr(float oldv, float v) { return __int_as_float(__builtin_amdgcn_update_dpp(__float_as_int(oldv), __float_as_int(v), 0x110 + SH, 0xF, 0xF, false)); }
template <int SH> DI void scan_step(float& a, float& b, int fseg) {
    float ap = dpp_row_shr<SH>(1.0f, a), bp = dpp_row_shr<SH>(0.0f, b);
    if (fseg < SH) { ap = 1.0f; bp = 0.0f; }
    b = a * bp + b; a = a * ap;
}
struct EpiGates {
    static constexpr bool PERM64 = false, PERM8 = true;
    const bf16_t* V; const float* bga; const float* bgx; const float* lam; bf16_t* HL; bf16_t* AC; float* SUM;
    DI UPre unit_pre(int) const { return UPre{}; }
    DI void operator()(f32x4 (&acc)[2][2][4][2], const pg8::Unit& u, int wr, int wc, int fr, int fq, const UPre&) const {
        const bool isp = u.pm < MP / 256;
        const int chb = u.pn * 128 + wc * 32 + 8 * fq;
        const int rowb = u.pm * 256 + wr * 64 + fr;
        u32x4 vpre[2][4];
#pragma unroll
        for (int ai = 0; ai < 2; ++ai)
#pragma unroll
            for (int m = 0; m < 4; ++m) vpre[ai][m] = *(const u32x4*)(V + (size_t)(rowb + ai * 128 + m * 16) * DM + chb);
#pragma unroll
        for (int n = 0; n < 2; ++n) {
            const f32x4 sp = *(const f32x4*)(lam + chb + 4 * n), ba = *(const f32x4*)(bga + chb + 4 * n), bx = *(const f32x4*)(bgx + chb + 4 * n);
#pragma unroll
            for (int ai = 0; ai < 2; ++ai)
#pragma unroll
                for (int m = 0; m < 4; ++m) {
                    const int row = rowb + ai * 128 + m * 16;
                    const bool pos0 = isp && ((row & (SEQ - 1)) == 0);
                    const unsigned w0 = n == 0 ? vpre[ai][m].x : vpre[ai][m].z, w1 = n == 0 ? vpre[ai][m].y : vpre[ai][m].w;
                    const float v4[4] = {__uint_as_float(w0 << 16), __uint_as_float(w0 & 0xffff0000u), __uint_as_float(w1 << 16), __uint_as_float(w1 & 0xffff0000u)};
#pragma unroll
                    for (int e = 0; e < 4; ++e) {
                        const float r = __builtin_amdgcn_rcpf(1.0f + __builtin_amdgcn_exp2f(-1.4426950408889634f * (acc[ai][0][m][n][e] + ba[e])));
                        const float ig = __builtin_amdgcn_rcpf(1.0f + __builtin_amdgcn_exp2f(-1.4426950408889634f * (acc[ai][1][m][n][e] + bx[e])));
                        const float a = __builtin_amdgcn_exp2f(-r * sp[e]);
                        const float mult = pos0 ? 1.0f : __builtin_amdgcn_sqrtf(fmaxf(1.0f - a * a, 0.0f));
                        acc[ai][0][m][n][e] = a; acc[ai][1][m][n][e] = mult * ig * v4[e];
                    }
                }
        }
        const int fseg = isp ? fr : (fr & 7);
#pragma unroll
        for (int ai = 0; ai < 2; ++ai)
#pragma unroll
            for (int n = 0; n < 2; ++n)
#pragma unroll
                for (int e = 0; e < 4; ++e) {
                    float Ac = 1.0f, Hc = 0.0f;
#pragma unroll
                    for (int m = 0; m < 4; ++m) {
                        float a = acc[ai][0][m][n][e], b = acc[ai][1][m][n][e];
                        scan_step<1>(a, b, fseg); scan_step<2>(a, b, fseg); scan_step<4>(a, b, fseg);
                        if (isp) { scan_step<8>(a, b, fseg); b = a * Hc + b; a = a * Ac; Ac = __int_as_float(__builtin_amdgcn_update_dpp(0, __float_as_int(a), 0x15F, 0xF, 0xF, false)); Hc = __int_as_float(__builtin_amdgcn_update_dpp(0, __float_as_int(b), 0x15F, 0xF, 0xF, false)); }
                        acc[ai][0][m][n][e] = a; acc[ai][1][m][n][e] = b;
                    }
                    if (isp && fr == 15) { float* sm = SUM + ((size_t)(u.pm * 4 + ai * 2 + wr) * DM + chb + 4 * n + e) * 2; sm[0] = Ac; sm[1] = Hc; }
                }
#pragma unroll
        for (int ai = 0; ai < 2; ++ai)
#pragma unroll
            for (int m = 0; m < 4; ++m) {
                const size_t off = (size_t)(rowb + ai * 128 + m * 16) * DM + chb;
                u32x4 oa; oa.x = pk2(acc[ai][0][m][0][0], acc[ai][0][m][0][1]); oa.y = pk2(acc[ai][0][m][0][2], acc[ai][0][m][0][3]); oa.z = pk2(acc[ai][0][m][1][0], acc[ai][0][m][1][1]); oa.w = pk2(acc[ai][0][m][1][2], acc[ai][0][m][1][3]);
                *(u32x4*)(AC + off) = oa;
                u32x4 ob; ob.x = pk2(acc[ai][1][m][0][0], acc[ai][1][m][0][1]); ob.y = pk2(acc[ai][1][m][0][2], acc[ai][1][m][0][3]); ob.z = pk2(acc[ai][1][m][1][0], acc[ai][1][m][1][1]); ob.w = pk2(acc[ai][1][m][1][2], acc[ai][1][m][1][3]);
                *(u32x4*)(HL + off) = ob;
            }
    }
};

#define XB_TMO      128
#define XB_XCNT(j)  (256  + 64 * (j))
#define XB_XSUB(j)  (1280 + 64 * (j))
#define XB_XGEN(j)  (2304 + 64 * (j))
#define XB_TOP      3328
#define XB_TOPGEN   3392
#define XCD_BAR_WORDS 3456
#define XB_SPIN_CAP (1u << 18)
DI unsigned xb_ld(unsigned* p)              { return __hip_atomic_load(p, __ATOMIC_RELAXED, __HIP_MEMORY_SCOPE_AGENT); }
DI unsigned xb_add(unsigned* p, unsigned v) { return __hip_atomic_fetch_add(p, v, __ATOMIC_RELAXED, __HIP_MEMORY_SCOPE_AGENT); }
DI unsigned xb_xcc_id() { return (unsigned)__builtin_amdgcn_s_getreg((3 << 11) | 20) & 0xFu; }
#define XB_SPIN(cond, bar) do { unsigned _sp = 0; while (cond) { __builtin_amdgcn_s_sleep(1); \
    if ((++_sp & 255u) == 0u) { if (xb_ld(&(bar)[XB_TMO])) break; if (_sp > XB_SPIN_CAP) { atomicAdd(&(bar)[XB_TMO], 1u); break; } } } } while (0)
struct XcdBarrier { unsigned* bar; unsigned x; volatile LAS unsigned* st; };
DI XcdBarrier xcd_barrier_post(unsigned* bar, volatile LAS unsigned* st) {
    XcdBarrier b; b.bar = bar; b.x = xb_xcc_id(); b.st = st;
    if (threadIdx.x == 0) (void)xb_add(&bar[XB_XCNT(b.x)], 1u);
    return b;
}
DI void xcd_barrier_complete(unsigned* bar, unsigned x, unsigned& nloc, unsigned& nx) {
    const unsigned G = gridDim.x * gridDim.y * gridDim.z;
    unsigned sum, cnt, mine, sp = 0u;
    for (;;) {
        sum = 0u; cnt = 0u; mine = 0u;
#pragma unroll
        for (unsigned j = 0; j < 16; ++j) { const unsigned c = xb_ld(&bar[XB_XCNT(j)]); sum += c; cnt += (c > 0u) ? 1u : 0u; mine = (j == x) ? c : mine; }
        if (sum == G) break;
        __builtin_amdgcn_s_sleep(1);
        if ((++sp & 255u) == 0u) { if (xb_ld(&bar[XB_TMO])) break; if (sp > XB_SPIN_CAP) { atomicAdd(&bar[XB_TMO], 1u); break; } }
    }
    nloc = mine > 0u ? mine : 1u; nx = cnt > 0u ? cnt : 1u;
}
DI void xcd_barrier(const XcdBarrier& b) {
    asm volatile("s_waitcnt vmcnt(0)" ::: "memory");
    __syncthreads();
    if (threadIdx.x == 0) {
        unsigned* bar = b.bar;
        __builtin_amdgcn_s_waitcnt(0);
        unsigned nloc = b.st[0], nx = b.st[1];
        if (nloc == 0u) { xcd_barrier_complete(bar, b.x, nloc, nx); b.st[0] = nloc; b.st[1] = nx; }
        const unsigned old = xb_add(&bar[XB_XSUB(b.x)], 1u);
        const unsigned gen = old / nloc;
        if (old + 1u == (gen + 1u) * nloc) {
            __builtin_amdgcn_fence(__ATOMIC_RELEASE, "agent");
            asm volatile("s_waitcnt vmcnt(0)" ::: "memory");
            const unsigned og = xb_add(&bar[XB_TOP], 1u);
            const unsigned tg = og / nx;
            if (og + 1u == (tg + 1u) * nx) xb_add(&bar[XB_TOPGEN], 1u);
            else XB_SPIN(xb_ld(&bar[XB_TOPGEN]) == tg, bar);
            __builtin_amdgcn_fence(__ATOMIC_ACQUIRE, "agent");
            xb_add(&bar[XB_XGEN(b.x)], 1u);
            asm volatile("s_waitcnt vmcnt(0)" ::: "memory");
        } else {
            XB_SPIN(xb_ld(&bar[XB_XGEN(b.x)]) == gen, bar);
            __builtin_amdgcn_fence(__ATOMIC_ACQUIRE, "agent");
            asm volatile("s_waitcnt vmcnt(0)" ::: "memory");
        }
    }
    __syncthreads();
}

struct Args { const void* in[32]; float* out; unsigned char* ws; int ph_lo, ph_hi; };
static_assert(sizeof(Args) == 32 * 8 + 8 + 8 + 8, "Args has no padding");

DI void p0_transpose_item(const float* __restrict__ W, int lds_, int N, bf16_t* __restrict__ WT, int ldd, const float* __restrict__ gain, LAS float* scr, int item, int lane) {
    const int nblk = N / 32, kb = item / nblk, nb = item % nblk, k0 = 64 * kb, n0 = 32 * nb;
#pragma unroll 8
    for (int i = 0; i < 32; ++i) { const int kk = 2 * i + (lane >> 5); const float gsc = gain ? gain[k0 + kk] : 1.f; scr[kk * 33 + (lane & 31)] = W[(size_t)(k0 + kk) * lds_ + n0 + (lane & 31)] * gsc; }
    asm volatile("s_waitcnt lgkmcnt(0)" ::: "memory");
    const int c = lane & 7;
#pragma unroll
    for (int j = 0; j < 4; ++j) { const int n = (lane >> 3) + 8 * j; const LAS float* s = scr + (8 * c) * 33 + n;
        u32x4 o; o.x = pk2(s[0 * 33], s[1 * 33]); o.y = pk2(s[2 * 33], s[3 * 33]); o.z = pk2(s[4 * 33], s[5 * 33]); o.w = pk2(s[6 * 33], s[7 * 33]);
        *(u32x4*)(WT + (size_t)(n0 + n) * ldd + k0 + 8 * c) = o; }
    asm volatile("s_waitcnt lgkmcnt(0)" ::: "memory");
}
DI void rowprep_load(const float* __restrict__ src, int lane, f32x4 (&v)[4]) {
#pragma unroll
    for (int j = 0; j < 4; ++j) v[j] = ((const f32x4*)src)[lane + 64 * j];
}
DI void rowprep_row(const f32x4 (&v)[4], int row, bf16_t* __restrict__ XB, float* __restrict__ SSQ, int lane) {
    float ss = 0.f;
#pragma unroll
    for (int j = 0; j < 4; ++j) ss += v[j].x * v[j].x + v[j].y * v[j].y + v[j].z * v[j].z + v[j].w * v[j].w;
    ss = wave_sum(ss);
#pragma unroll
    for (int j = 0; j < 4; ++j) { u32x2 o; o.x = pk2(v[j].x, v[j].y); o.y = pk2(v[j].z, v[j].w); ((u32x2*)(XB + (size_t)row * DM))[lane + 64 * j] = o; }
    if (lane < 16) SSQ[(size_t)lane * MT + row] = lane == 0 ? ss : 0.f;
}

DI void unpack4(u32x2 r, float (&x)[4]) { x[0] = __uint_as_float(r.x << 16); x[1] = __uint_as_float(r.x & 0xffff0000u); x[2] = __uint_as_float(r.y << 16); x[3] = __uint_as_float(r.y & 0xffff0000u); }
DI void post0_row(int row, int lane, const bf16_t* __restrict__ Z0, const float* __restrict__ ROPET, const float* __restrict__ g_q_nope, const float* __restrict__ g_q_rope,
                  const float* __restrict__ g_ckv, const float* __restrict__ g_k_rope, bf16_t* __restrict__ QB, bf16_t* __restrict__ CB, bf16_t* __restrict__ KRB, float* __restrict__ out) {
    const bf16_t* z = Z0 + (size_t)row * NZ0;
    const bool isp = row < MP; const int pidx = isp ? (row & (SEQ - 1)) : SEQ + ((row - MP) & 7);
    { const int d = 4 * (lane & 15); const f32x4 g4 = *(const f32x4*)(g_q_nope + d);
#pragma unroll
      for (int hh = 0; hh < 2; ++hh) {
        const int h = 4 * hh + (lane >> 4); float x[4]; unpack4(*(const u32x2*)(z + POOLD + QKH * h + d), x);
        float ss = x[0] * x[0] + x[1] * x[1] + x[2] * x[2] + x[3] * x[3];
        ss = sum16(ss);
        const float ri = rsqrtf(ss * (1.f / 64.f) + EPS) * QSCALE;
        u32x2 o; o.x = pk2(x[0] * ri * g4.x, x[1] * ri * g4.y); o.y = pk2(x[2] * ri * g4.z, x[3] * ri * g4.w);
        *(u32x2*)(QB + (size_t)row * QDIM + QKH * h + d) = o; } }
    { const int r = 4 * (lane & 7), i0 = r & 15; const bool second = (lane & 4) != 0;
      const f32x4 t0 = *(const f32x4*)(ROPET + ((size_t)pidx * 16 + i0) * 2), t1 = *(const f32x4*)(ROPET + ((size_t)pidx * 16 + i0) * 2 + 4);
      const float cs[4] = {t0.x, t0.z, t1.x, t1.z}, sn[4] = {t0.y, t0.w, t1.y, t1.w};
      { const int h = lane >> 3; float x[4]; unpack4(*(const u32x2*)(z + POOLD + QKH * h + 64 + r), x);
        float ss = x[0] * x[0] + x[1] * x[1] + x[2] * x[2] + x[3] * x[3];
        ss = sum8(ss);
        const float ri = rsqrtf(ss * (1.f / 32.f) + EPS); const f32x4 g4 = *(const f32x4*)(g_q_rope + r);
        float y[4] = {x[0] * ri * g4.x, x[1] * ri * g4.y, x[2] * ri * g4.z, x[3] * ri * g4.w}, o[4];
#pragma unroll
        for (int e = 0; e < 4; ++e) { const float p = xchg4(y[e], second); o[e] = (second ? (p * sn[e] + y[e] * cs[e]) : (y[e] * cs[e] - p * sn[e])) * QSCALE; }
        u32x2 w; w.x = pk2(o[0], o[1]); w.y = pk2(o[2], o[3]); *(u32x2*)(QB + (size_t)row * QDIM + QKH * h + 64 + r) = w; }
      { float x[4]; unpack4(*(const u32x2*)(z + POOLD + QDIM + KVR + r), x);
        float ss = x[0] * x[0] + x[1] * x[1] + x[2] * x[2] + x[3] * x[3];
        ss = sum8(ss);
        const float ri = rsqrtf(ss * (1.f / 32.f) + EPS); const f32x4 g4 = *(const f32x4*)(g_k_rope + r);
        float y[4] = {x[0] * ri * g4.x, x[1] * ri * g4.y, x[2] * ri * g4.z, x[3] * ri * g4.w}; f32x4 o;
#pragma unroll
        for (int e = 0; e < 4; ++e) { const float p = xchg4(y[e], second); o[e] = second ? (p * sn[e] + y[e] * cs[e]) : (y[e] * cs[e] - p * sn[e]); }
        if (lane < 8) { u32x2 w; w.x = pk2(o[0], o[1]); w.y = pk2(o[2], o[3]); *(u32x2*)(KRB + (size_t)row * ROPE + r) = w;
            float* ko = isp ? out + O_KR_P + (size_t)row * ROPE : out + O_KR_S + (size_t)(row - MP) * ROPE; *(f32x4*)(ko + r) = o; } } }
    { float x[4]; unpack4(*(const u32x2*)(z + POOLD + QDIM + lane * 4), x);
      float ss = wave_sum(x[0] * x[0] + x[1] * x[1] + x[2] * x[2] + x[3] * x[3]); const float ri = rsqrtf(ss * (1.f / 256.f) + EPS);
      const f32x4 g4 = *(const f32x4*)(g_ckv + lane * 4);
      f32x4 y; y.x = x[0] * ri * g4.x; y.y = x[1] * ri * g4.y; y.z = x[2] * ri * g4.z; y.w = x[3] * ri * g4.w;
      u32x2 o; o.x = pk2(y.x, y.y); o.y = pk2(y.z, y.w); *(u32x2*)(CB + (size_t)row * KVR + lane * 4) = o;
      float* co = isp ? out + O_CKV_P + (size_t)row * KVR : out + O_CKV_S + (size_t)(row - MP) * KVR; *(f32x4*)(co + lane * 4) = y; }
}
DI void load8(const bf16_t* p, float (&x)[8]) { const u32x4 r = *(const u32x4*)p;
#pragma unroll
    for (int e = 0; e < 4; ++e) { x[2 * e] = __uint_as_float(r[e] << 16); x[2 * e + 1] = __uint_as_float(r[e] & 0xffff0000u); } }
template <bool ISP> DI void pool_item(int row0, int nrows, int ch, const bf16_t* __restrict__ Z0, const float* __restrict__ state_pool, bf16_t* __restrict__ DBuf, float* __restrict__ out) {
    const int w = 2 << (ch >> 7);
    const int t0 = ISP ? (row0 & (SEQ - 1)) : 0, bb = ISP ? (row0 >> 12) : ((row0 - MP) >> 3);
    float S[8];
#pragma unroll
    for (int e = 0; e < 8; ++e) S[e] = 0.f;
    for (int j = 1; j < w; ++j) { const int tj = t0 - j; float x[8];
        if (tj >= 0) { load8(Z0 + (size_t)(row0 - j) * NZ0 + ch, x); }
        else if (!ISP) { const float* hp = state_pool + ((size_t)bb * 15 + (15 + tj)) * POOLD + ch; const f32x4 a = *(const f32x4*)hp, b = *(const f32x4*)(hp + 4); x[0] = a.x; x[1] = a.y; x[2] = a.z; x[3] = a.w; x[4] = b.x; x[5] = b.y; x[6] = b.z; x[7] = b.w; }
        else {
#pragma unroll
            for (int e = 0; e < 8; ++e) x[e] = 0.f; }
#pragma unroll
        for (int e = 0; e < 8; ++e) S[e] += x[e]; }
    for (int i = 0; i < nrows; ++i) {
        const int t = t0 + i, row = row0 + i; float u[8]; load8(Z0 + (size_t)row * NZ0 + ch, u);
        const float icnt = 1.0f / (ISP ? (float)((t + 1) < w ? (t + 1) : w) : (float)w);
        u32x4 o;
#pragma unroll
        for (int e = 0; e < 8; ++e) S[e] += u[e];
#pragma unroll
        for (int e = 0; e < 4; ++e) o[e] = pk2(S[2 * e] * icnt - u[2 * e], S[2 * e + 1] * icnt - u[2 * e + 1]);
        *(u32x4*)(DBuf + (size_t)row * POOLD + ch) = o;
        { const int tj = t - w + 1; float x[8];
          if (tj >= 0) { load8(Z0 + (size_t)(row - w + 1) * NZ0 + ch, x); }
          else if (!ISP) { const float* hp = state_pool + ((size_t)bb * 15 + (15 + tj)) * POOLD + ch; const f32x4 a = *(const f32x4*)hp, b = *(const f32x4*)(hp + 4); x[0] = a.x; x[1] = a.y; x[2] = a.z; x[3] = a.w; x[4] = b.x; x[5] = b.y; x[6] = b.z; x[7] = b.w; }
          else {
#pragma unroll
              for (int e = 0; e < 8; ++e) x[e] = 0.f; }
#pragma unroll
          for (int e = 0; e < 8; ++e) S[e] -= x[e]; }
        if (ISP) { if (t >= SEQ - 15) { float* op = out + O_POOL_P + ((size_t)bb * 15 + (t - (SEQ - 15))) * POOLD + ch; *(f32x4*)op = (f32x4){u[0], u[1], u[2], u[3]}; *(f32x4*)(op + 4) = (f32x4){u[4], u[5], u[6], u[7]}; } }
        else { float* op = out + O_POOL_S + ((size_t)bb * 15 + 7 + t) * POOLD + ch; *(f32x4*)op = (f32x4){u[0], u[1], u[2], u[3]}; *(f32x4*)(op + 4) = (f32x4){u[4], u[5], u[6], u[7]}; }
    }
    if (!ISP) { for (int i = 0; i < 7; ++i) { const float* hp = state_pool + ((size_t)bb * 15 + 8 + i) * POOLD + ch; float* op = out + O_POOL_S + ((size_t)bb * 15 + i) * POOLD + ch; *(f32x4*)op = *(const f32x4*)hp; *(f32x4*)(op + 4) = *(const f32x4*)(hp + 4); } }
}
DI void pool_item_p16(int row0, int ch, const bf16_t* __restrict__ Z0, bf16_t* __restrict__ DBuf, float* __restrict__ out) {
    const int w = 2 << (ch >> 7);
    const int t0 = row0 & (SEQ - 1), bb = row0 >> 12;
    const bf16_t* zb = Z0 + (size_t)row0 * NZ0 + ch;
    float S[8];
#pragma unroll
    for (int e = 0; e < 8; ++e) S[e] = 0.f;
#pragma unroll
    for (int j = 1; j < 16; ++j) { const bool ok = (j < w) && (t0 - j >= 0); float x[8]; load8(zb - (ok ? j : 0) * NZ0, x); const float mk = ok ? 1.f : 0.f;
#pragma unroll
        for (int e = 0; e < 8; ++e) S[e] += mk * x[e]; }
#pragma unroll
    for (int i = 0; i < 16; ++i) {
        const int t = t0 + i; float u[8], x[8]; load8(zb + i * NZ0, u);
        const bool ok = t - w + 1 >= 0; load8(zb + (i - (ok ? w - 1 : 0)) * NZ0, x); const float mk = ok ? 1.f : 0.f;
        const float icnt = 1.0f / (float)((t + 1) < w ? (t + 1) : w);
        u32x4 o;
#pragma unroll
        for (int e = 0; e < 8; ++e) S[e] += u[e];
#pragma unroll
        for (int e = 0; e < 4; ++e) o[e] = pk2(S[2 * e] * icnt - u[2 * e], S[2 * e + 1] * icnt - u[2 * e + 1]);
        *(u32x4*)(DBuf + (size_t)(row0 + i) * POOLD + ch) = o;
#pragma unroll
        for (int e = 0; e < 8; ++e) S[e] -= mk * x[e];
    }
    if (t0 == SEQ - 16) {
        for (int i = 1; i < 16; ++i) { float u[8]; load8(zb + i * NZ0, u);
            float* op = out + O_POOL_P + ((size_t)bb * 15 + (i - 1)) * POOLD + ch; *(f32x4*)op = (f32x4){u[0], u[1], u[2], u[3]}; *(f32x4*)(op + 4) = (f32x4){u[4], u[5], u[6], u[7]}; } }
}
template <bool ISP> DI void conv_item(int row0, int nrows, int ch, const bf16_t* __restrict__ U, const float* __restrict__ state_conv, const float* __restrict__ conv_w, const float* __restrict__ conv_b,
                                      bf16_t* __restrict__ V, float* __restrict__ out) {
    const int t0 = ISP ? (row0 & (SEQ - 1)) : 0, bb = ISP ? (row0 >> 12) : ((row0 - MP) >> 3);
    float wk[4][8], bs[8], hist[3][8];
#pragma unroll
    for (int k = 0; k < 4; ++k) { const f32x4 a = *(const f32x4*)(conv_w + k * DM + ch), b = *(const f32x4*)(conv_w + k * DM + ch + 4); wk[k][0] = a.x; wk[k][1] = a.y; wk[k][2] = a.z; wk[k][3] = a.w; wk[k][4] = b.x; wk[k][5] = b.y; wk[k][6] = b.z; wk[k][7] = b.w; }
    { const f32x4 a = *(const f32x4*)(conv_b + ch), b = *(const f32x4*)(conv_b + ch + 4); bs[0] = a.x; bs[1] = a.y; bs[2] = a.z; bs[3] = a.w; bs[4] = b.x; bs[5] = b.y; bs[6] = b.z; bs[7] = b.w; }
#pragma unroll
    for (int j = 0; j < 3; ++j) {
        const int tj = t0 - 3 + j;
        if (tj >= 0) load8(U + (size_t)(row0 - 3 + j) * DM + ch, hist[j]);
        else if (!ISP) { const float* hp = state_conv + ((size_t)bb * 3 + (3 + tj)) * DM + ch; const f32x4 a = *(const f32x4*)hp, b = *(const f32x4*)(hp + 4); hist[j][0] = a.x; hist[j][1] = a.y; hist[j][2] = a.z; hist[j][3] = a.w; hist[j][4] = b.x; hist[j][5] = b.y; hist[j][6] = b.z; hist[j][7] = b.w; }
        else {
#pragma unroll
            for (int e = 0; e < 8; ++e) hist[j][e] = 0.f; }
    }
    for (int i = 0; i < nrows; ++i) {
        const int t = t0 + i, row = row0 + i; float u[8]; load8(U + (size_t)row * DM + ch, u);
        u32x4 o; float v[8];
#pragma unroll
        for (int e = 0; e < 8; ++e) v[e] = bs[e] + hist[0][e] * wk[0][e] + hist[1][e] * wk[1][e] + hist[2][e] * wk[2][e] + u[e] * wk[3][e];
#pragma unroll
        for (int e = 0; e < 4; ++e) o[e] = pk2(v[2 * e], v[2 * e + 1]);
        *(u32x4*)(V + (size_t)row * DM + ch) = o;
#pragma unroll
        for (int e = 0; e < 8; ++e) { hist[0][e] = hist[1][e]; hist[1][e] = hist[2][e]; hist[2][e] = u[e]; }
        const int tl = ISP ? SEQ - 3 : DT - 3;
        if (t >= tl) { float* op = out + (ISP ? O_CONV_P : O_CONV_S) + ((size_t)bb * 3 + (t - tl)) * DM + ch; *(f32x4*)op = (f32x4){u[0], u[1], u[2], u[3]}; *(f32x4*)(op + 4) = (f32x4){u[4], u[5], u[6], u[7]}; }
    }
}

DI void conv_item_p16(int row0, int ch, const bf16_t* __restrict__ U, const float* __restrict__ conv_w, const float* __restrict__ conv_b, bf16_t* __restrict__ V, float* __restrict__ out) {
    const int t0 = row0 & (SEQ - 1), bb = row0 >> 12;
    const bf16_t* ub = U + (size_t)row0 * DM + ch;
    u32x4 raw[19];
#pragma unroll
    for (int j = 0; j < 19; ++j) raw[j] = *(const u32x4*)(ub + (j - 3 >= 0 || t0 > 0 ? (j - 3) : 0) * DM);
    float wk[4][8], bs[8];
#pragma unroll
    for (int k = 0; k < 4; ++k) { const f32x4 a = *(const f32x4*)(conv_w + k * DM + ch), b = *(const f32x4*)(conv_w + k * DM + ch + 4); wk[k][0] = a.x; wk[k][1] = a.y; wk[k][2] = a.z; wk[k][3] = a.w; wk[k][4] = b.x; wk[k][5] = b.y; wk[k][6] = b.z; wk[k][7] = b.w; }
    { const f32x4 a = *(const f32x4*)(conv_b + ch), b = *(const f32x4*)(conv_b + ch + 4); bs[0] = a.x; bs[1] = a.y; bs[2] = a.z; bs[3] = a.w; bs[4] = b.x; bs[5] = b.y; bs[6] = b.z; bs[7] = b.w; }
    const float hm = t0 > 0 ? 1.f : 0.f;
    float x[4][8];
#pragma unroll
    for (int j = 0; j < 3; ++j)
#pragma unroll
        for (int e = 0; e < 4; ++e) { x[j][2 * e] = hm * __uint_as_float(raw[j][e] << 16); x[j][2 * e + 1] = hm * __uint_as_float(raw[j][e] & 0xffff0000u); }
#pragma unroll
    for (int i = 0; i < 16; ++i) {
#pragma unroll
        for (int e = 0; e < 4; ++e) { x[3][2 * e] = __uint_as_float(raw[3 + i][e] << 16); x[3][2 * e + 1] = __uint_as_float(raw[3 + i][e] & 0xffff0000u); }
        u32x4 o; float v[8];
#pragma unroll
        for (int e = 0; e < 8; ++e) v[e] = bs[e] + x[0][e] * wk[0][e] + x[1][e] * wk[1][e] + x[2][e] * wk[2][e] + x[3][e] * wk[3][e];
#pragma unroll
        for (int e = 0; e < 4; ++e) o[e] = pk2(v[2 * e], v[2 * e + 1]);
        *(u32x4*)(V + (size_t)(row0 + i) * DM + ch) = o;
#pragma unroll
        for (int e = 0; e < 8; ++e) { x[0][e] = x[1][e]; x[1][e] = x[2][e]; x[2][e] = x[3][e]; }
    }
    if (t0 == SEQ - 16) {
#pragma unroll
        for (int i = 13; i < 16; ++i) { float* op = out + O_CONV_P + ((size_t)bb * 3 + (i - 13)) * DM + ch;
            *(f32x4*)op = (f32x4){__uint_as_float(raw[3 + i][0] << 16), __uint_as_float(raw[3 + i][0] & 0xffff0000u), __uint_as_float(raw[3 + i][1] << 16), __uint_as_float(raw[3 + i][1] & 0xffff0000u)};
            *(f32x4*)(op + 4) = (f32x4){__uint_as_float(raw[3 + i][2] << 16), __uint_as_float(raw[3 + i][2] & 0xffff0000u), __uint_as_float(raw[3 + i][3] << 16), __uint_as_float(raw[3 + i][3] & 0xffff0000u)}; } }
}

DI void attn_p_naive_item(int item, int lane, LAS float* sc, const bf16_t* __restrict__ QB, const bf16_t* __restrict__ KV, const bf16_t* __restrict__ KRB, bf16_t* __restrict__ MIX) {
    LAS float* qs = sc + SEQ;
    const int row = item >> 3, h = item & 7, b = row >> 12, t = row & (SEQ - 1);
    for (int i = lane; i < QKH; i += 64) qs[i] = bf2f(QB[(size_t)row * QDIM + h * QKH + i]);
    asm volatile("s_waitcnt lgkmcnt(0)" ::: "memory");
    float mx = -INFINITY;
    for (int j0 = 0; j0 <= t; j0 += 64) {
        const int j = j0 + lane;
        if (j <= t) {
            const bf16_t* kr = KV + (size_t)(b * SEQ + j) * 1024 + h * 64; const bf16_t* rr = KRB + (size_t)(b * SEQ + j) * ROPE;
            float s = 0.f;
            for (int d = 0; d < 64; ++d) s += qs[d] * bf2f(kr[d]);
            for (int d = 0; d < 32; ++d) s += qs[64 + d] * bf2f(rr[d]);
            sc[j] = s; mx = fmaxf(mx, s);
        }
    }
    mx = wave_max(mx);
    float sum = 0.f;
    for (int j = lane; j <= t; j += 64) { const float p = exp2f(sc[j] - mx); sc[j] = p; sum += p; }
    sum = wave_sum(sum);
    asm volatile("s_waitcnt lgkmcnt(0)" ::: "memory");
    float acc = 0.f;
    for (int j = 0; j <= t; ++j) acc += sc[j] * bf2f(KV[(size_t)(b * SEQ + j) * 1024 + 512 + h * 64 + lane]);
    MIX[(size_t)row * DM + 512 + h * 64 + lane] = (bf16_t)f2bf(acc / sum);
    asm volatile("s_waitcnt lgkmcnt(0)" ::: "memory");
}


typedef short v4i16_t __attribute__((ext_vector_type(4)));
DI int crow(int r, int hi) { return (r & 3) + 8 * (r >> 2) + 4 * hi; }
constexpr int AP_KS = 12288, AP_VS = 8192, AP_LK = 0, AP_LV = 2 * AP_KS;
DI void attn_p_unit(int b, int h, int qb, LAS unsigned char* lds, const bf16_t* __restrict__ QB, const bf16_t* __restrict__ KV, const bf16_t* __restrict__ KRB, bf16_t* __restrict__ MIX) {
    const int tid = threadIdx.x, lane = tid & 63, r32 = lane & 31, hi = lane >> 5, wid = __builtin_amdgcn_readfirstlane(tid >> 6);
    const int rowbase = b * SEQ, q0 = qb * 256, NT = 4 * (qb + 1);
    const bf16_t* ksrc0 = KV + (size_t)(rowbase + lane) * 1024 + h * 64 + wid * 8;
    const bf16_t* ksrc1 = KRB + (size_t)(rowbase + lane) * ROPE + (wid & 3) * 8;
    const bf16_t* vsrc = KV + (size_t)(rowbase + 16 * (wid & 3) + (lane >> 2)) * 1024 + 512 + h * 64 + (wid >> 2) * 32 + (lane & 3) * 8;
#define AP_DMA(t, slot) do { \
        __builtin_amdgcn_global_load_lds((const unsigned*)(ksrc0 + (size_t)(t) * 64 * 1024), (LAS unsigned*)(lds + AP_LK + (slot) * AP_KS + wid * 1024), 16, 0, 0); \
        if (wid < 4) __builtin_amdgcn_global_load_lds((const unsigned*)(ksrc1 + (size_t)(t) * 64 * ROPE), (LAS unsigned*)(lds + AP_LK + (slot) * AP_KS + (8 + wid) * 1024), 16, 0, 0); \
        __builtin_amdgcn_global_load_lds((const unsigned*)(vsrc + (size_t)(t) * 64 * 1024), (LAS unsigned*)(lds + AP_LV + (slot) * AP_VS + wid * 1024), 16, 0, 0); } while (0)
    AP_DMA(0, 0);
    bf16x8 qr[6];
    { const bf16_t* qw = QB + (size_t)(rowbase + q0 + wid * 32 + r32) * QDIM + h * QKH + hi * 8;
#pragma unroll
      for (int d0 = 0; d0 < 6; ++d0) qr[d0] = *(const bf16x8*)(qw + d0 * 16); }
    float m = 0.f, l = 0.f;
    f32x16 o0, o1, negm;
#pragma unroll
    for (int r = 0; r < 16; ++r) { o0[r] = 0.f; o1[r] = 0.f; negm[r] = 0.f; }
    const int qrel = wid * 32 + r32;
    const int voff = (4 * hi + ((lane & 15) >> 2)) * 64 + ((lane >> 4) & 1) * 32 + (lane & 3) * 8;
    for (int t = 0; t < NT; ++t) {
        asm volatile("s_waitcnt vmcnt(0)" ::: "memory"); __builtin_amdgcn_s_barrier(); asm volatile("" ::: "memory");
        if (t + 1 < NT) AP_DMA(t + 1, (t + 1) & 1);
        const int slot = t & 1, trel = t - (NT - 4);
        if (trel < 0 || 64 * trel <= 32 * wid + 31) {
            const LAS unsigned char* kb = lds + AP_LK + slot * AP_KS + hi * 1024 + r32 * 16;
            f32x16 p0, p1;
            __builtin_amdgcn_s_setprio(1);
#pragma unroll
            for (int d0 = 0; d0 < 6; ++d0) {
                const bf16x8 k0 = *(const LAS bf16x8*)(kb + d0 * 2048), k1 = *(const LAS bf16x8*)(kb + d0 * 2048 + 512);
                p0 = __builtin_amdgcn_mfma_f32_32x32x16_bf16(k0, qr[d0], d0 == 0 ? negm : p0, 0, 0, 0);
                p1 = __builtin_amdgcn_mfma_f32_32x32x16_bf16(k1, qr[d0], d0 == 0 ? negm : p1, 0, 0, 0);
            }
            __builtin_amdgcn_s_setprio(0);
            if (trel >= 0) {
#pragma unroll
                for (int r = 0; r < 16; ++r) { const int kp = 64 * trel + crow(r, hi); if (kp > qrel) p0[r] = -INFINITY; if (kp + 32 > qrel) p1[r] = -INFINITY; }
            }
            float mx = max3f(p0[0], p1[0], p0[1]);
#pragma unroll
            for (int r = 1; r < 16; ++r) mx = (r < 15) ? max3f(mx, p1[r], p0[r + 1]) : fmaxf(mx, p1[r]);
            mx = xmax32(mx);
            float ps = 0.f;
#pragma unroll
            for (int r = 0; r < 16; ++r) { p0[r] = __builtin_amdgcn_exp2f(p0[r]); p1[r] = __builtin_amdgcn_exp2f(p1[r]); ps += p0[r] + p1[r]; }
            l += ps;
            const LAS unsigned char* vb = lds + AP_LV + slot * AP_VS + voff;
            __builtin_amdgcn_s_setprio(1);
#pragma unroll
            for (int ks = 0; ks < 4; ++ks) {
                u32x4 pw;
                if (ks < 2) { pw.x = cvtpk(p0[8 * ks], p0[8 * ks + 1]); pw.y = cvtpk(p0[8 * ks + 2], p0[8 * ks + 3]); pw.z = cvtpk(p0[8 * ks + 4], p0[8 * ks + 5]); pw.w = cvtpk(p0[8 * ks + 6], p0[8 * ks + 7]); }
                else { const int s8 = 8 * (ks - 2); pw.x = cvtpk(p1[s8], p1[s8 + 1]); pw.y = cvtpk(p1[s8 + 2], p1[s8 + 3]); pw.z = cvtpk(p1[s8 + 4], p1[s8 + 5]); pw.w = cvtpk(p1[s8 + 6], p1[s8 + 7]); }
                const bf16x8 pa = __builtin_bit_cast(bf16x8, pw);
#pragma unroll
                for (int db = 0; db < 2; ++db) {
                    const v4i16_t lo = __builtin_amdgcn_ds_read_tr16_b64_v4i16((LAS v4i16_t*)(vb + db * 4096 + ks * 1024));
                    const v4i16_t hh = __builtin_amdgcn_ds_read_tr16_b64_v4i16((LAS v4i16_t*)(vb + db * 4096 + ks * 1024 + 512));
                    const bf16x8 vf = (bf16x8){lo[0], lo[1], lo[2], lo[3], hh[0], hh[1], hh[2], hh[3]};
                    if (db == 0) o0 = __builtin_amdgcn_mfma_f32_32x32x16_bf16(vf, pa, o0, 0, 0, 0);
                    else o1 = __builtin_amdgcn_mfma_f32_32x32x16_bf16(vf, pa, o1, 0, 0, 0);
                }
            }
            __builtin_amdgcn_s_setprio(0);
            const float mn = (t == 0) ? mx : fmaxf(mx, 0.f);
            if (__any(mn != 0.f)) {
                const float f = __builtin_amdgcn_exp2f(-mn); l *= f; m += mn;
#pragma unroll
                for (int r = 0; r < 16; ++r) { o0[r] *= f; o1[r] *= f; negm[r] = -m; }
            }
        }
    }
    l = xsum32(l);
    const float il = 1.0f / l;
    bf16_t* orow = MIX + (size_t)(rowbase + q0 + wid * 32 + r32) * DM + 512 + h * 64 + 4 * hi;
#pragma unroll
    for (int g = 0; g < 4; ++g) {
        u32x2 a; a.x = cvtpk(o0[4 * g] * il, o0[4 * g + 1] * il); a.y = cvtpk(o0[4 * g + 2] * il, o0[4 * g + 3] * il); *(u32x2*)(orow + 8 * g) = a;
        u32x2 c; c.x = cvtpk(o1[4 * g] * il, o1[4 * g + 1] * il); c.y = cvtpk(o1[4 * g + 2] * il, o1[4 * g + 3] * il); *(u32x2*)(orow + 32 + 8 * g) = c;
    }
#undef AP_DMA
}


constexpr int SA_CB_ROW = 576, SA_CB_SZ = 64 * SA_CB_ROW;
constexpr int SA_C8_ROW = 272, SA_C8_SZ = 64 * SA_C8_ROW;
constexpr int SA_KR_ROW = 96, SA_KR_SZ = 64 * SA_KR_ROW;
constexpr int SA_CB = 0, SA_C8 = 2 * SA_CB_SZ, SA_KRB = SA_C8 + 2 * SA_C8_SZ;
constexpr int SA_P = SA_KRB + 2 * SA_KR_SZ, SA_P_ROW = 144;
constexpr int SA_QF = SA_P + 64 * SA_P_ROW;
constexpr int SA_F = SA_QF + 8 * 3 * 4 * 8 * 16;
constexpr int SA_END = SA_F + 256;
static_assert(SA_END <= LDS_MISC, "sample attention LDS map");
DI int sa_swz(int x) { return (0x78 >> (2 * x)) & 3; }
DI int sa_g8(int x) { return (0x28 >> (2 * x)) & 3; }
typedef int v8i_t __attribute__((ext_vector_type(8)));
typedef float f32x4v __attribute__((ext_vector_type(4)));

template <int VAR> DI void attn_s_unit(int unit, LAS unsigned char* lds, const float* __restrict__ cache_ckv, const float* __restrict__ cache_kr, const int* __restrict__ page_table, const bf16_t* __restrict__ QB,
                    const bf16_t* __restrict__ WKVT, const float* __restrict__ g_k_nope, float* __restrict__ LATP, float* __restrict__ ML) {
    constexpr int hot = VAR != 0;
    const int tid = threadIdx.x, lane = tid & 63, r32 = lane & 31, hi = lane >> 5, l15 = lane & 15, quad = lane >> 4, w = __builtin_amdgcn_readfirstlane(tid >> 6);
    const int sb = unit >> 1, split = unit & 1;
    const int* pt = page_table + sb * NPAGES + split * 32;
    for (int e = tid; e < 8 * 3 * 4 * 8; e += NTHR) {
        const int q = e & 7, qd = (e >> 3) & 3, st = (e >> 5) % 3, h = e / 96;
        const bf16_t* qp = QB + (size_t)(MP + sb * DT + q) * QDIM + h * QKH;
        unsigned pk[4];
#pragma unroll
        for (int jj = 0; jj < 4; ++jj) {
            float v0, v1;
            if (st < 2) { const int j0 = 2 * jj, j1 = 2 * jj + 1; const int d0 = 32 * st + 16 * (j0 >> 2) + 4 * qd + (j0 & 3), d1 = 32 * st + 16 * (j1 >> 2) + 4 * qd + (j1 & 3); v0 = bf2f(qp[d0]) * g_k_nope[d0]; v1 = bf2f(qp[d1]) * g_k_nope[d1]; }
            else { const int r0 = 8 * qd + 2 * jj; v0 = bf2f(qp[64 + r0]); v1 = bf2f(qp[64 + r0 + 1]); }
            pk[jj] = pk2(v0, v1);
        }
        *(LAS u32x4*)(lds + SA_QF + e * 16) = (u32x4){pk[0], pk[1], pk[2], pk[3]};
    }
    v8i_t wf[4][2];
#pragma unroll
    for (int db = 0; db < 4; ++db)
#pragma unroll
        for (int ch = 0; ch < 2; ++ch) {
            const bf16_t* wp = WKVT + (size_t)(w * 64 + 16 * db + l15) * KVR + 128 * ch + 32 * quad;
#pragma unroll
            for (int i = 0; i < 4; ++i) { const u32x4 r = *(const u32x4*)(wp + 8 * i); int lo = 0, hi2 = 0;
                lo = __builtin_amdgcn_cvt_pk_fp8_f32(__uint_as_float(r.x << 16) * 16.f, __uint_as_float(r.x & 0xffff0000u) * 16.f, lo, false);
                lo = __builtin_amdgcn_cvt_pk_fp8_f32(__uint_as_float(r.y << 16) * 16.f, __uint_as_float(r.y & 0xffff0000u) * 16.f, lo, true);
                hi2 = __builtin_amdgcn_cvt_pk_fp8_f32(__uint_as_float(r.z << 16) * 16.f, __uint_as_float(r.z & 0xffff0000u) * 16.f, hi2, false);
                hi2 = __builtin_amdgcn_cvt_pk_fp8_f32(__uint_as_float(r.w << 16) * 16.f, __uint_as_float(r.w & 0xffff0000u) * 16.f, hi2, true);
                wf[db][ch][2 * i] = lo; wf[db][ch][2 * i + 1] = hi2; }
        }
    const __amdgpu_buffer_rsrc_t rs_c = __builtin_amdgcn_make_buffer_rsrc((void*)cache_ckv, (short)0, (int)((size_t)(NPAGES * DB_ + NPAGES * DB_ / 4) * PAGE * KVR * 4), 0x00020000);
    const __amdgpu_buffer_rsrc_t rs_k = __builtin_amdgcn_make_buffer_rsrc((void*)cache_kr, (short)0, (int)((size_t)(NPAGES * DB_ + NPAGES * DB_ / 4) * PAGE * ROPE * 4), 0x00020000);
    const int dma_voff = lane * 16;
    u32x4 pf[9];
#define SA_LOAD(t) do { const unsigned prow = (unsigned)__builtin_amdgcn_readfirstlane(pt[hot ? 0 : ((t) >> 1)]) * PAGE + 64 * ((t) & 1) + 8 * w; \
        _Pragma("unroll") for (int i = 0; i < 8; ++i) pf[i] = __builtin_amdgcn_raw_buffer_load_b128(rs_c, dma_voff, (prow + i) * (KVR * 4), 0); \
        pf[8] = __builtin_amdgcn_raw_buffer_load_b128(rs_k, dma_voff, prow * (ROPE * 4), 0); } while (0)
    SA_LOAD(0);
    float m = 0.f, negm = 0.f, l = 0.f;
    f32x16 lat0, lat1;
#pragma unroll
    for (int r = 0; r < 16; ++r) { lat0[r] = 0.f; lat1[r] = 0.f; }
    const bool qreal = l15 < 8;
    const int g8_ = sa_g8((l15 >> 2) & 3);
    const LAS unsigned char* c8a0 = lds + SA_C8 + l15 * SA_C8_ROW + (((2 * quad) ^ g8_) * 16);
    const LAS unsigned char* c8b0 = lds + SA_C8 + l15 * SA_C8_ROW + (((2 * quad + 1) ^ g8_) * 16);
    const LAS unsigned char* qfbase = lds + SA_QF + (((w * 3) * 4 + quad) * 8 + (l15 & 7)) * 16;
    const LAS unsigned char* krbase0 = lds + SA_KRB + l15 * SA_KR_ROW + quad * 16;
    LAS unsigned char* pwbase = lds + SA_P + (8 * w + l15) * SA_P_ROW + quad * 8;
    asm volatile("s_waitcnt lgkmcnt(0)" ::: "memory"); __builtin_amdgcn_s_barrier(); asm volatile("" ::: "memory");
    bf16x8 q0 = *(const LAS bf16x8*)(qfbase), q1 = *(const LAS bf16x8*)(qfbase + 512), q2 = *(const LAS bf16x8*)(qfbase + 1024);
    if (!qreal) { q0 = (bf16x8){0, 0, 0, 0, 0, 0, 0, 0}; q1 = q0; q2 = q0; }
    LAS unsigned char* cvw0 = lds + SA_CB + 8 * w * SA_CB_ROW + (((lane >> 1) ^ sa_swz((2 * w) & 3)) * 16) + (lane & 1) * 8;
    LAS unsigned char* cvw1 = lds + SA_CB + 8 * w * SA_CB_ROW + (((lane >> 1) ^ sa_swz((2 * w + 1) & 3)) * 16) + (lane & 1) * 8;
    LAS unsigned char* c8w0 = lds + SA_C8 + 8 * w * SA_C8_ROW + (((lane >> 2) ^ sa_g8((2 * w) & 3)) * 16) + (lane & 3) * 4;
    LAS unsigned char* c8w1 = lds + SA_C8 + 8 * w * SA_C8_ROW + (((lane >> 2) ^ sa_g8((2 * w + 1) & 3)) * 16) + (lane & 3) * 4;
    LAS unsigned char* krw = lds + SA_KRB + (8 * w + (lane >> 3)) * SA_KR_ROW + (lane & 7) * 8;
    const int kr0 = 8 * hi + (l15 >> 2), cc0 = 4 * w + 2 * ((lane >> 4) & 1) + ((lane & 3) >> 1);
    const LAS unsigned char* trlo = lds + SA_CB + kr0 * SA_CB_ROW + ((cc0 ^ (hi ? 3 : 0)) * 16) + (lane & 1) * 8;
    const LAS unsigned char* trhi = lds + SA_CB + (kr0 + 4) * SA_CB_ROW + ((cc0 ^ (hi ? 1 : 2)) * 16) + (lane & 1) * 8;
    const LAS unsigned char* prd = lds + SA_P + r32 * SA_P_ROW + hi * 16;
    const LAS float* frd = (const LAS float*)(lds + SA_F + r32 * 4);
    for (int t2 = 0; t2 < 64; t2 += 2) {
#pragma unroll
      for (int tb = 0; tb < 2; ++tb) {
        const int t = t2 + tb;
        asm volatile("s_waitcnt vmcnt(0)" ::: "memory");
        if (VAR != 5) {
#pragma unroll
            for (int i = 0; i < 8; ++i) {
                const f32x4 v = __builtin_bit_cast(f32x4, pf[i]);
                u32x2 o; o.x = cvtpk(v.x, v.y); o.y = cvtpk(v.z, v.w);
                *(LAS u32x2*)((i < 4 ? cvw0 : cvw1) + tb * SA_CB_SZ + i * SA_CB_ROW) = o;
                int f8 = __builtin_amdgcn_cvt_pk_fp8_f32(v.x, v.y, 0, false); f8 = __builtin_amdgcn_cvt_pk_fp8_f32(v.z, v.w, f8, true);
                *(LAS int*)((i < 4 ? c8w0 : c8w1) + tb * SA_C8_SZ + i * SA_C8_ROW) = f8;
            }
            { const f32x4 v = __builtin_bit_cast(f32x4, pf[8]); u32x2 o; o.x = cvtpk(v.x, v.y); o.y = cvtpk(v.z, v.w);
              *(LAS u32x2*)(krw + tb * SA_KR_SZ) = o; }
        }
        constexpr bool ld_next = (VAR != 5);
        const int tn = (t + 1) & 63;
        const unsigned prow_n = (unsigned)__builtin_amdgcn_readfirstlane(pt[hot ? 0 : (tn >> 1)]) * PAGE + 64 * (tn & 1) + 8 * w;
        asm volatile("s_waitcnt lgkmcnt(0)" ::: "memory");
        __builtin_amdgcn_s_barrier(); asm volatile("" ::: "memory");
        const LAS unsigned char* c8a = c8a0 + tb * SA_C8_SZ; const LAS unsigned char* c8b = c8b0 + tb * SA_C8_SZ; const LAS unsigned char* krbase = krbase0 + tb * SA_KR_SZ;
        float tmax = -INFINITY, ps = 0.f;
        u32x4 nb00, nb01, nb10, nb11; bf16x8 nkf;
#define SA_LDB(kb_) do { const LAS unsigned char* ca_ = c8a + (kb_) * 16 * SA_C8_ROW; const LAS unsigned char* cb_ = c8b + (kb_) * 16 * SA_C8_ROW; \
            nb00 = *(const LAS u32x4*)(ca_); nb01 = *(const LAS u32x4*)(cb_); nb10 = *(const LAS u32x4*)(ca_ + 128); nb11 = *(const LAS u32x4*)(cb_ + 128); \
            nkf = *(const LAS bf16x8*)(krbase + (kb_) * 16 * SA_KR_ROW); } while (0)
        SA_LDB(0);
#pragma unroll
        for (int kb = 0; kb < 4; ++kb) {
            f32x4v k0 = {0.f, 0.f, 0.f, 0.f}, k1 = {0.f, 0.f, 0.f, 0.f}, k2 = {0.f, 0.f, 0.f, 0.f}, k3 = {0.f, 0.f, 0.f, 0.f};
            const bf16x8 kf = nkf;
            {
                const v8i_t bf0 = {(int)nb00.x, (int)nb00.y, (int)nb00.z, (int)nb00.w, (int)nb01.x, (int)nb01.y, (int)nb01.z, (int)nb01.w};
                const v8i_t bf1 = {(int)nb10.x, (int)nb10.y, (int)nb10.z, (int)nb10.w, (int)nb11.x, (int)nb11.y, (int)nb11.z, (int)nb11.w};
                if (VAR != 3) {
                    __builtin_amdgcn_s_setprio(1);
                    k0 = __builtin_amdgcn_mfma_scale_f32_16x16x128_f8f6f4(wf[0][0], bf0, k0, 0, 0, 0, 123, 0, 127); k1 = __builtin_amdgcn_mfma_scale_f32_16x16x128_f8f6f4(wf[1][0], bf0, k1, 0, 0, 0, 123, 0, 127);
                    k2 = __builtin_amdgcn_mfma_scale_f32_16x16x128_f8f6f4(wf[2][0], bf0, k2, 0, 0, 0, 123, 0, 127); k3 = __builtin_amdgcn_mfma_scale_f32_16x16x128_f8f6f4(wf[3][0], bf0, k3, 0, 0, 0, 123, 0, 127);
                    k0 = __builtin_amdgcn_mfma_scale_f32_16x16x128_f8f6f4(wf[0][1], bf1, k0, 0, 0, 0, 123, 0, 127); k1 = __builtin_amdgcn_mfma_scale_f32_16x16x128_f8f6f4(wf[1][1], bf1, k1, 0, 0, 0, 123, 0, 127);
                    k2 = __builtin_amdgcn_mfma_scale_f32_16x16x128_f8f6f4(wf[2][1], bf1, k2, 0, 0, 0, 123, 0, 127); k3 = __builtin_amdgcn_mfma_scale_f32_16x16x128_f8f6f4(wf[3][1], bf1, k3, 0, 0, 0, 123, 0, 127);
                    __builtin_amdgcn_s_setprio(0);
                }
                __builtin_amdgcn_sched_barrier(0);
                if (kb < 3) SA_LDB(kb + 1);
                if (ld_next) { pf[2 * kb] = __builtin_amdgcn_raw_buffer_load_b128(rs_c, dma_voff, (prow_n + 2 * kb) * (KVR * 4), 0); pf[2 * kb + 1] = __builtin_amdgcn_raw_buffer_load_b128(rs_c, dma_voff, (prow_n + 2 * kb + 1) * (KVR * 4), 0);
                    if (kb == 3) pf[8] = __builtin_amdgcn_raw_buffer_load_b128(rs_k, dma_voff, prow_n * (ROPE * 4), 0); }
                __builtin_amdgcn_sched_barrier(0);
            }
            float ss = k0.x * k0.x + k0.y * k0.y + k0.z * k0.z + k0.w * k0.w + k1.x * k1.x + k1.y * k1.y + k1.z * k1.z + k1.w * k1.w
                     + k2.x * k2.x + k2.y * k2.y + k2.z * k2.z + k2.w * k2.w + k3.x * k3.x + k3.y * k3.y + k3.z * k3.z + k3.w * k3.w;
            ss = xsum32(xsum16(ss));
            const float ri = __builtin_amdgcn_rsqf(ss * (1.f / 64.f) + EPS);
            u32x4 a0, a1;
            a0.x = cvtpk(k0.x * ri, k0.y * ri); a0.y = cvtpk(k0.z * ri, k0.w * ri); a0.z = cvtpk(k1.x * ri, k1.y * ri); a0.w = cvtpk(k1.z * ri, k1.w * ri);
            a1.x = cvtpk(k2.x * ri, k2.y * ri); a1.y = cvtpk(k2.z * ri, k2.w * ri); a1.z = cvtpk(k3.x * ri, k3.y * ri); a1.w = cvtpk(k3.z * ri, k3.w * ri);
            f32x4v sc = {negm, negm, negm, negm};
            sc = __builtin_amdgcn_mfma_f32_16x16x32_bf16(kf, q2, sc, 0, 0, 0);
            sc = __builtin_amdgcn_mfma_f32_16x16x32_bf16(__builtin_bit_cast(bf16x8, a0), q0, sc, 0, 0, 0);
            sc = __builtin_amdgcn_mfma_f32_16x16x32_bf16(__builtin_bit_cast(bf16x8, a1), q1, sc, 0, 0, 0);
            float bm = fmaxf(fmaxf(sc.x, sc.y), fmaxf(sc.z, sc.w));
            if (t == 0 && kb == 0) { const float m0 = xmax32(xmax16(bm)); sc.x -= m0; sc.y -= m0; sc.z -= m0; sc.w -= m0; bm -= m0; m = m0; negm = -m0; }
            tmax = fmaxf(tmax, bm);
            sc.x = __builtin_amdgcn_exp2f(sc.x); sc.y = __builtin_amdgcn_exp2f(sc.y); sc.z = __builtin_amdgcn_exp2f(sc.z); sc.w = __builtin_amdgcn_exp2f(sc.w);
            ps += (sc.x + sc.y) + (sc.z + sc.w);
            asm volatile("" : "+v"(ps), "+v"(tmax));
            if (qreal) { u32x2 o; o.x = cvtpk(sc.x, sc.y); o.y = cvtpk(sc.z, sc.w); *(LAS u32x2*)(pwbase + kb * 32) = o; }
            __builtin_amdgcn_sched_barrier(0);
        }
#undef SA_LDB
        { tmax = xmax32(xmax16(tmax));
          const float inc = fmaxf(tmax, 0.f); const float f = __builtin_amdgcn_exp2f(-inc); m += inc; negm = -m; l = (l + ps) * f;
          if (qreal && quad == 0) *(LAS float*)(lds + SA_F + (8 * w + l15) * 4) = f; }
        asm volatile("s_waitcnt lgkmcnt(0)" ::: "memory"); __builtin_amdgcn_s_barrier(); asm volatile("" ::: "memory");
        if (VAR != 4) {
            v4i16_t lo[4], hh[4]; bf16x8 p0[4], p1[4];
#pragma unroll
            for (int ks = 0; ks < 4; ++ks) {
                lo[ks] = __builtin_amdgcn_ds_read_tr16_b64_v4i16((LAS v4i16_t*)(trlo + tb * SA_CB_SZ + ks * 16 * SA_CB_ROW));
                hh[ks] = __builtin_amdgcn_ds_read_tr16_b64_v4i16((LAS v4i16_t*)(trhi + tb * SA_CB_SZ + ks * 16 * SA_CB_ROW));
                p0[ks] = *(const LAS bf16x8*)(prd + ks * 32);
                p1[ks] = *(const LAS bf16x8*)(prd + 32 * SA_P_ROW + ks * 32);
            }
            const float f0 = frd[0], f1 = frd[32];
            __builtin_amdgcn_sched_barrier(0);
            __builtin_amdgcn_s_setprio(1);
#pragma unroll
            for (int ks = 0; ks < 4; ++ks) {
                const bf16x8 cf = (bf16x8){lo[ks][0], lo[ks][1], lo[ks][2], lo[ks][3], hh[ks][0], hh[ks][1], hh[ks][2], hh[ks][3]};
                lat0 = __builtin_amdgcn_mfma_f32_32x32x16_bf16(cf, p0[ks], lat0, 0, 0, 0);
                lat1 = __builtin_amdgcn_mfma_f32_32x32x16_bf16(cf, p1[ks], lat1, 0, 0, 0);
            }
            __builtin_amdgcn_s_setprio(0);
            if (__any(f0 != 1.f || f1 != 1.f)) {
#pragma unroll
                for (int r = 0; r < 16; ++r) { lat0[r] *= f0; lat1[r] *= f1; } }
        }
      }
    }
    __builtin_amdgcn_s_barrier(); asm volatile("" ::: "memory");
    l = xsum32(xsum16(l));
    int unit2 = unit, lane2 = threadIdx.x & 63; asm volatile("" : "+s"(unit2), "+v"(lane2));
    const int r32b = lane2 & 31, hib = lane2 >> 5;
    if (lane2 < 8) { float* mlp = ML + ((size_t)unit2 * 64 + 8 * w + lane2) * 2; mlp[0] = m; mlp[1] = l; }
    float* lp = LATP + (size_t)unit2 * 64 * KVR + 32 * w + 4 * hib;
#pragma unroll
    for (int g = 0; g < 4; ++g) {
        *(f32x4*)(lp + (size_t)r32b * KVR + 8 * g) = (f32x4){lat0[4 * g], lat0[4 * g + 1], lat0[4 * g + 2], lat0[4 * g + 3]};
        *(f32x4*)(lp + (size_t)(32 + r32b) * KVR + 8 * g) = (f32x4){lat1[4 * g], lat1[4 * g + 1], lat1[4 * g + 2], lat1[4 * g + 3]};
    }
#undef SA_LOAD
}

DI void attn_s_combine(int sb, LAS unsigned char* lds, const bf16_t* __restrict__ QB, const bf16_t* __restrict__ KV, const bf16_t* __restrict__ KRB, const bf16_t* __restrict__ WKVT,
                       const float* __restrict__ LATP, const float* __restrict__ ML, bf16_t* __restrict__ MIX) {
    const int tid = threadIdx.x;
    LAS float* latc = (LAS float*)lds; LAS float* pn = latc + 64 * KVR; LAS float* wgt = pn + 64 * 8;
    {
        const int qh = tid >> 3, j = tid & 7, h = qh >> 3, q = qh & 7;
        const bf16_t* qp = QB + (size_t)(MP + sb * DT + q) * QDIM + h * QKH; const size_t krow_ = (size_t)MP + sb * DT + j;
        float sj = 0.f;
        for (int d = 0; d < 64; ++d) sj += bf2f(qp[d]) * bf2f(KV[krow_ * 1024 + h * 64 + d]);
        for (int r = 0; r < 32; ++r) sj += bf2f(qp[64 + r]) * bf2f(KRB[krow_ * ROPE + r]);
        if (j > q) sj = -INFINITY;
        const float m0 = ML[((size_t)(2 * sb) * 64 + qh) * 2], l0 = ML[((size_t)(2 * sb) * 64 + qh) * 2 + 1], m1 = ML[((size_t)(2 * sb + 1) * 64 + qh) * 2], l1 = ML[((size_t)(2 * sb + 1) * 64 + qh) * 2 + 1];
        const float mm = max8(sj);
        const float M = fmaxf(fmaxf(m0, m1), mm);
        const float pj = exp2f(sj - M), w0 = exp2f(m0 - M), w1 = exp2f(m1 - M);
        const float sp = sum8(pj);
        const float L = w0 * l0 + w1 * l1 + sp, iL = 1.f / L;
        pn[qh * 8 + j] = pj * iL;
        if (j == 0) { wgt[qh * 2] = w0 * iL; wgt[qh * 2 + 1] = w1 * iL; }
    }
    __syncthreads();
    for (int e = tid; e < 64 * KVR; e += NTHR) { const int qh = e >> 8; latc[e] = wgt[qh * 2] * LATP[(size_t)(2 * sb) * 64 * KVR + e] + wgt[qh * 2 + 1] * LATP[(size_t)(2 * sb + 1) * 64 * KVR + e]; }
    __syncthreads();
    for (int o = tid; o < 64 * VH; o += NTHR) {
        const int qh = o >> 6, v = o & 63, h = qh >> 3, q = qh & 7;
        const bf16_t* wr = WKVT + (size_t)(512 + h * 64 + v) * KVR;
        float a = 0.f;
        for (int c = 0; c < KVR; ++c) a += latc[qh * KVR + c] * bf2f(wr[c]);
        for (int j = 0; j < DT; ++j) a += pn[qh * 8 + j] * bf2f(KV[((size_t)MP + sb * DT + j) * 1024 + 512 + h * 64 + v]);
        MIX[(size_t)(MP + sb * DT + q) * DM + 512 + h * 64 + v] = (bf16_t)f2bf(a);
    }
    __syncthreads();
}

DI void attn_s_scores_item(int chunk, int sb, int tid, const float* __restrict__ cache_ckv, const float* __restrict__ cache_kr, const int* __restrict__ page_table, const bf16_t* __restrict__ QB,
                           const bf16_t* __restrict__ CB, const bf16_t* __restrict__ KRB, const float* __restrict__ w_uk, const float* __restrict__ g_k_nope, float* __restrict__ SC) {
    const int key = tid & 127, hq = __builtin_amdgcn_readfirstlane(tid >> 7);
    const bool isnew = chunk == NPAGES;
    if (isnew && key >= DT) return;
    const float* crow = nullptr; const bf16_t* crowb = nullptr; const float* kpf = nullptr; const bf16_t* kpb = nullptr;
    if (!isnew) { const size_t pr = (size_t)page_table[sb * NPAGES + chunk] * PAGE + key; crow = cache_ckv + pr * KVR; kpf = cache_kr + pr * ROPE; }
    else { const size_t rr = (size_t)MP + sb * DT + key; crowb = CB + rr * KVR; kpb = KRB + rr * ROPE; }
    const int jglob = isnew ? PAST + key : chunk * PAGE + key;
    for (int hi = 0; hi < 2; ++hi) {
        const int h = hq * 2 + hi;
        float acc[NOPE];
#pragma unroll
        for (int d = 0; d < NOPE; ++d) acc[d] = 0.f;
        for (int c = 0; c < KVR; ++c) {
            const float cv = isnew ? bf2f(crowb[c]) : crow[c];
            const float* wr = w_uk + (size_t)c * 512 + h * 64;
#pragma unroll
            for (int d = 0; d < NOPE; ++d) acc[d] += cv * wr[d];
        }
        float ss = 0.f;
#pragma unroll
        for (int d = 0; d < NOPE; ++d) ss += acc[d] * acc[d];
        const float ri = rsqrtf(ss * (1.f / 64.f) + EPS);
#pragma unroll 1
        for (int q = 0; q < DT; ++q) {
            const bf16_t* qp = QB + (size_t)(MP + sb * DT + q) * QDIM + h * QKH;
            float s = 0.f;
#pragma unroll
            for (int d = 0; d < NOPE; ++d) s += acc[d] * g_k_nope[d] * bf2f(qp[d]);
            s *= ri;
            for (int r = 0; r < ROPE; ++r) s += (isnew ? bf2f(kpb[r]) : kpf[r]) * bf2f(qp[64 + r]);
            if (isnew && key > q) s = -INFINITY;
            SC[((size_t)sb * 64 + h * 8 + q) * NKEYS + jglob] = s;
        }
    }
}
DI void attn_s_pv_item(int sb, int tid, LAS float* lds, const float* __restrict__ cache_ckv, const int* __restrict__ page_table, const bf16_t* __restrict__ CB, const float* __restrict__ SC,
                       const float* __restrict__ w_uv, float* __restrict__ LAT, bf16_t* __restrict__ MIX) {
    LAS float* p = lds; LAS float* smx = lds + 64 * PAGE; LAS float* sinv = smx + 64;
    const int wid = tid >> 6, lane = tid & 63;
    for (int i = 0; i < 8; ++i) {
        const int qh = wid * 8 + i; const float* s = SC + ((size_t)sb * 64 + qh) * NKEYS;
        float mx = -INFINITY; for (int j = lane; j < NKEYS; j += 64) mx = fmaxf(mx, s[j]);
        mx = wave_max(mx);
        float sum = 0.f; for (int j = lane; j < NKEYS; j += 64) sum += exp2f(s[j] - mx);
        sum = wave_sum(sum);
        if (lane == 0) { smx[qh] = mx; sinv[qh] = 1.f / sum; }
    }
    __syncthreads();
    const int c = tid & 255, half = tid >> 8;
    float lat[32];
#pragma unroll
    for (int i = 0; i < 32; ++i) lat[i] = 0.f;
    for (int chunk = 0; chunk <= NPAGES; ++chunk) {
        const int nk = chunk == NPAGES ? DT : PAGE;
        for (int e = tid; e < 64 * PAGE; e += NTHR) { const int qh = e >> 7, j = e & 127; p[qh * PAGE + j] = j < nk ? exp2f(SC[((size_t)sb * 64 + qh) * NKEYS + chunk * PAGE + j] - smx[qh]) * sinv[qh] : 0.f; }
        __syncthreads();
        for (int j = 0; j < nk; ++j) {
            float cv;
            if (chunk < NPAGES) cv = cache_ckv[((size_t)page_table[sb * NPAGES + chunk] * PAGE + j) * KVR + c];
            else cv = bf2f(CB[((size_t)MP + sb * DT + j) * KVR + c]);
#pragma unroll
            for (int i = 0; i < 32; ++i) lat[i] += p[(half * 32 + i) * PAGE + j] * cv;
        }
        __syncthreads();
    }
    float* L = LAT + (size_t)sb * 64 * KVR;
#pragma unroll
    for (int i = 0; i < 32; ++i) L[(half * 32 + i) * KVR + c] = lat[i];
    __threadfence_block(); __syncthreads();
    for (int o = tid; o < 64 * VH; o += NTHR) {
        const int qh = o >> 6, v = o & 63, h = qh >> 3, q = qh & 7;
        float a = 0.f;
        for (int cc = 0; cc < KVR; ++cc) a += L[qh * KVR + cc] * w_uv[(size_t)cc * 512 + h * 64 + v];
        MIX[(size_t)(MP + sb * DT + q) * DM + 512 + h * 64 + v] = (bf16_t)f2bf(a);
    }
    __syncthreads();
}

enum Phase { PH_PRO = 0, PH_Z0, PH_POST0, PH_KVPOOL, PH_KNORM, PH_ATTN, PH_ATTN2, PH_OUT0, PH_UP0, PH_DN0, PH_RNNIN, PH_CONV, PH_GATES, PH_SCAN, PH_OUTR, PH_UP1, PH_DN1, PH_COUNT };

__global__ void __launch_bounds__(NTHR, 2) mk(Args args) {
    extern __shared__ __attribute__((aligned(16))) unsigned char lds_raw[];
    LAS unsigned char* lds = (LAS unsigned char*)lds_raw;
    volatile LAS unsigned* MISC = (volatile LAS unsigned*)(lds + LDS_MISC);
    const int tid = threadIdx.x, lane = tid & 63, wave = __builtin_amdgcn_readfirstlane(tid >> 6);
    const int G = gridDim.x, bx = blockIdx.x;
    const int gw = bx * NWAVES + wave, NGW = G * NWAVES;
    const int lo = args.ph_lo, hi = args.ph_hi;

    const float* x_prompt = (const float*)args.in[0]; const float* x_sample = (const float*)args.in[1];
    const float* cache_ckv = (const float*)args.in[2]; const float* cache_kr = (const float*)args.in[3];
    const float* state_pool = (const float*)args.in[4]; const float* state_conv = (const float*)args.in[5]; const float* state_lru = (const float*)args.in[6];
    const int* page_table = (const int*)args.in[7];
    const float* norm_mix = (const float*)args.in[8]; const float* w_in_even = (const float*)args.in[9];
    const float* g_q_nope = (const float*)args.in[10]; const float* g_q_rope = (const float*)args.in[11]; const float* g_ckv = (const float*)args.in[12]; const float* g_k_rope = (const float*)args.in[13]; const float* g_k_nope = (const float*)args.in[14];
    const float* w_uk = (const float*)args.in[15]; const float* w_uv = (const float*)args.in[16]; const float* w_pool = (const float*)args.in[17]; const float* pool_scale = (const float*)args.in[18];
    const float* w_out_even = (const float*)args.in[19]; const float* w_in_rnn = (const float*)args.in[20]; const float* conv_w = (const float*)args.in[21]; const float* conv_b = (const float*)args.in[22];
    const float* w_gate_a = (const float*)args.in[23]; const float* b_gate_a = (const float*)args.in[24]; const float* w_gate_x = (const float*)args.in[25]; const float* b_gate_x = (const float*)args.in[26];
    const float* lru_lambda = (const float*)args.in[27]; const float* w_out_rnn = (const float*)args.in[28]; const float* norm_ffn = (const float*)args.in[29]; const float* w_up = (const float*)args.in[30]; const float* w_down = (const float*)args.in[31];
    float* out = args.out; unsigned char* ws = args.ws;
    bf16_t* WIN0T = (bf16_t*)(ws + WS_WIN0T); bf16_t* WKVT = (bf16_t*)(ws + WS_WKVT); bf16_t* WPOOLT = (bf16_t*)(ws + WS_WPOOLT); bf16_t* WGATET = (bf16_t*)(ws + WS_WGATET);
    bf16_t* WOUT0T = (bf16_t*)(ws + WS_WOUT0T); bf16_t* WOUTRT = (bf16_t*)(ws + WS_WOUTRT); bf16_t* WINRT = (bf16_t*)(ws + WS_WINRT); bf16_t* WUPT = (bf16_t*)(ws + WS_WUPT); bf16_t* WDNT = (bf16_t*)(ws + WS_WDNT);
    float* SSQ = (float*)(ws + WS_SSQ); bf16_t* XB = (bf16_t*)(ws + WS_XB); bf16_t* Z0 = (bf16_t*)(ws + WS_Z0); bf16_t* QB = (bf16_t*)(ws + WS_QB); bf16_t* CB = (bf16_t*)(ws + WS_CB); bf16_t* KRB = (bf16_t*)(ws + WS_KRB);
    bf16_t* DBuf = (bf16_t*)(ws + WS_DB); bf16_t* KV = (bf16_t*)(ws + WS_KV); bf16_t* MIX = (bf16_t*)(ws + WS_MIX); bf16_t* H = (bf16_t*)(ws + WS_H); bf16_t* GATE = (bf16_t*)(ws + WS_GATE); bf16_t* U = (bf16_t*)(ws + WS_U);
    bf16_t* V = (bf16_t*)(ws + WS_V); float* Gb = (float*)(ws + WS_G); bf16_t* YB = (bf16_t*)(ws + WS_YB); float* SC = (float*)(ws + WS_SC); float* LAT = (float*)(ws + WS_LAT);
    float* Y = out + O_Y;

    if (tid < 64) MISC[tid] = 0u;
    __syncthreads();
    XcdBarrier bar = xcd_barrier_post((unsigned*)(ws + WS_CTL) + CW_BAR, MISC + 8);
#ifndef PH_MASK
#define PH_MASK 0xFFFFFFFFu
#endif
#define IN(k) (((PH_MASK >> (k)) & 1u) && lo <= (k) && (k) < hi)
#define SEAM(k) do { if (IN(k) && IN((k) + 1)) xcd_barrier(bar); } while (0)
#define STREAM_CTL(ep_) pg8::StreamCtl{(float*)(ws + WS_PART), (unsigned*)(ws + WS_CTL) + CW_SKF, (unsigned*)(ws + WS_CTL) + CW_SKT, (unsigned)(ep_), bx, 0}
#define GEMM_PHASE_STATIC(ep_, Aptr, lda_, atoff_, ashift_, Bptr, M_, N_, K_, FT, ...) do { pg8::Gemm g{Aptr, Bptr, M_, N_, K_, lda_, atoff_, ashift_}; pg8::StaticOrder S; S.init(M_, N_, K_, G, bx); \
        pg8::EpiRows<FT> E{FT{__VA_ARGS__}}; pg8::gemm_phase<false>(lds, g, S, E, STREAM_CTL(ep_)); } while (0)
#define GEMM_PHASE(ep_, Aptr, lda_, atoff_, ashift_, Bptr, M_, N_, K_, FT, ...) do { pg8::Gemm g{Aptr, Bptr, M_, N_, K_, lda_, atoff_, ashift_}; pg8::StaticOrder S; S.init(M_, N_, K_, G, bx); \
        pg8::EpiRows<FT> E{FT{__VA_ARGS__}}; pg8::gemm_phase<false>(lds, g, S, E, STREAM_CTL(ep_)); } while (0)
#define GEMM_PHASE_P8(ep_, Aptr, lda_, Bptr, M_, N_, K_, FT, ...) do { pg8::Gemm g{Aptr, Bptr, M_, N_, K_, lda_, 0, 0}; pg8::StaticOrder S; S.init(M_, N_, K_, G, bx); \
        pg8::EpiRows<FT, false, true> E{FT{__VA_ARGS__}}; pg8::gemm_phase<false>(lds, g, S, E, STREAM_CTL(ep_)); } while (0)
#define GEMM_RESID(Aptr, lda_, Bptr, K_) GEMM_PHASE_P8(0, Aptr, lda_, Bptr, MT, DM, K_, FResid<false>, XB, (float*)nullptr, SSQ)
#define CW_RDY(i) ((unsigned*)(ws + WS_CTL) + 12288 + 64 * (i))
#define GEMM_RESID_SPLIT(Aptr, lda_, Bptr, K_) do { \
        if (G == 256) { pg8::Gemm g{Aptr, Bptr, MT, DM, K_, lda_, 0, 0}; pg8::SplitTailOrder S; S.init(K_, bx); pg8::EpiRows<FResid<false>, false, true> E{FResid<false>{XB, (float*)nullptr, SSQ}}; \
            pg8::gemm_phase<false>(lds, g, S, E, STREAM_CTL(0), EpiPartStore{(float*)(ws + WS_PART), bx & 15}); } \
        else GEMM_RESID(Aptr, lda_, Bptr, K_); } while (0)
#define FIXUP_DEFERRED(i, WAYS_) do { if (G == 256 && bx >= 128) { sample_fixup<false, WAYS_>(bx - 128, (const float*)(ws + WS_PART), XB, (float*)nullptr, SSQ); \
            asm volatile("s_waitcnt vmcnt(0)" ::: "memory"); __syncthreads(); \
            if (tid == 0) { __builtin_amdgcn_fence(__ATOMIC_RELEASE, "agent"); asm volatile("s_waitcnt vmcnt(0)" ::: "memory"); __hip_atomic_fetch_add(CW_RDY(i), 1u, __ATOMIC_RELAXED, __HIP_MEMORY_SCOPE_AGENT); } } } while (0)
#define GEMM_PHASE_P8_RDY(i, ep_, Aptr, lda_, Bptr, M_, N_, K_, FT, ...) do { pg8::Gemm g{Aptr, Bptr, M_, N_, K_, lda_, 0, 0}; if (G == 256) { g.ready = CW_RDY(i); g.ready_target = 128u; } pg8::StaticOrder S; S.init(M_, N_, K_, G, bx); \
        pg8::EpiRows<FT, false, true> E{FT{__VA_ARGS__}}; pg8::gemm_phase<false>(lds, g, S, E, STREAM_CTL(ep_)); } while (0)
#define GEMM_DOWN(Aptr, Bptr, FIN) do { \
        if (G == 256) { pg8::Gemm g{Aptr, Bptr, MT, DM, DFF, DFF, 0, 0}; pg8::SplitTailOrder S; S.init(DFF, bx); pg8::EpiRows<FResid<FIN>, false, true> E{FResid<FIN>{XB, Y, SSQ}}; \
            pg8::gemm_phase<false>(lds, g, S, E, STREAM_CTL(0), EpiPartStore{(float*)(ws + WS_PART), bx & 15}); \
            if (FIN) { xcd_barrier(bar); sample_fixup<FIN>(bx, (const float*)(ws + WS_PART), XB, Y, SSQ); } } \
        else GEMM_PHASE_STATIC(0, Aptr, DFF, 0, 0, Bptr, MT, DM, DFF, FResid<FIN>, XB, Y, SSQ); } while (0)

    if (IN(PH_PRO)) for (int rep_ = 0; rep_ < REPN(10); ++rep_) {
        LAS float* scr = (LAS float*)(lds + wave * 16384);
        constexpr int I0 = 16 * 49, I1 = 4 * 16, I3 = 2 * 4;
        constexpr int NITEMS = I0 + 2 * I1 + 4 * I3;
        for (int it = gw; it < NITEMS; it += NGW) {
            int r = it;
            if (r < I0) { p0_transpose_item(w_in_even, 1568, 1568, WIN0T, DM, norm_mix, scr, r, lane); continue; } r -= I0;
            if (r < I1) { p0_transpose_item(w_uk, 512, 512, WKVT, KVR, nullptr, scr, r, lane); continue; } r -= I1;
            if (r < I1) { p0_transpose_item(w_uv, 512, 512, WKVT + (size_t)512 * KVR, KVR, nullptr, scr, r, lane); continue; } r -= I1;
            { const int g = r / I3; p0_transpose_item(w_pool + (size_t)g * 128 * 128, 128, 128, WPOOLT + (size_t)g * 128 * 256 + (g & 1) * 128, 256, nullptr, scr, r % I3, lane); }
        }
        { u32x4* z0 = (u32x4*)(WIN0T + (size_t)1568 * DM); const u32x4 zz = {0u, 0u, 0u, 0u};
          for (int e = bx * NTHR + tid; e < (NZ0 - 1568) * DM / 8; e += G * NTHR) z0[e] = zz;
          for (int e = bx * NTHR + tid; e < 512 * 16; e += G * NTHR) { const int n = e >> 4, c8 = e & 15; *(u32x4*)(WPOOLT + (size_t)n * 256 + (1 - ((n >> 7) & 1)) * 128 + c8 * 8) = zz; }
          for (int e = bx * NTHR + tid; e < 2048 * 16; e += G * NTHR) { const int n = e >> 4, c8 = e & 15; *(u32x4*)(WGATET + (size_t)n * 256 + (1 - ((n >> 8) & 1)) * 128 + c8 * 8) = zz; } }
        { float* ROPET = (float*)(ws + WS_ROPE);
          for (int e = bx * NTHR + tid; e < (SEQ + DT) * 16; e += G * NTHR) { const int pi = e >> 4, i = e & 15; const int pos = pi < SEQ ? pi : PAST + (pi - SEQ);
              const float inv = powf(10000.0f, -(float)i / 16.0f); const float ang = (float)pos * inv; ROPET[e * 2] = cosf(ang); ROPET[e * 2 + 1] = sinf(ang); } }
        if (bx == G - 1) for (int c = tid; c < DM; c += NTHR) ((float*)(ws + WS_SP8))[c] = log1pf(expf(-lru_lambda[c])) * (8.0f * 1.4426950408889634f);
        {
#define XROW(r_) ((r_) < MP ? x_prompt + (size_t)(r_) * DM : x_sample + (size_t)((r_) - MP) * DM)
            f32x4 nv[4]; if (gw < MT) rowprep_load(XROW(gw), lane, nv);
            for (int row = gw; row < MT; row += NGW) { f32x4 v[4];
#pragma unroll
                for (int j = 0; j < 4; ++j) v[j] = nv[j];
                const int nr = row + NGW; if (nr < MT) rowprep_load(XROW(nr), lane, nv);
                rowprep_row(v, row, XB, SSQ, lane); }
#undef XROW
        }
    }
    SEAM(PH_PRO);
    if (REP_ID == 40) { for (int i = 0; i < 10; ++i) xcd_barrier(bar); }
    if (IN(PH_Z0)) for (int rep_ = 0; rep_ < REPN(1); ++rep_) GEMM_PHASE_P8(1, XB, DM, WIN0T, MT, NZ0, DM, FZ0, SSQ, Z0);
    SEAM(PH_Z0);
    if (IN(PH_POST0)) for (int rep_ = 0; rep_ < REPN(2); ++rep_) {
        const float* ROPET = (const float*)(ws + WS_ROPE);
        for (int row = gw; row < MT; row += NGW) post0_row(row, lane, Z0, ROPET, g_q_nope, g_q_rope, g_ckv, g_k_rope, QB, CB, KRB, out);
        for (int it = bx * NTHR + tid; it < (MP / 16) * 64; it += G * NTHR) pool_item_p16((it >> 6) * 16, (it & 63) * 8, Z0, DBuf, out);
        for (int it = bx * NTHR + tid; it < DB_ * 64; it += G * NTHR) pool_item<false>(MP + (it >> 6) * DT, DT, (it & 63) * 8, Z0, state_pool, DBuf, out);
    }
    SEAM(PH_POST0);
    if (IN(PH_KVPOOL) && REP_ID == 13) { GEMM_PHASE(14, CB, KVR, 0, 0, WKVT, MT, 1024, KVR, FRawBf16<1024>, (bf16_t*)(ws + WS_DBG)); GEMM_PHASE_STATIC(15, DBuf, POOLD, 256, 0, WPOOLT, MT, POOLD, 256, FPool, pool_scale, MIX); }
    if (IN(PH_KVPOOL)) {
        { pg8::Gemm g{CB, WKVT, MT, 1024, KVR, KVR, 0, 0}; pg8::StaticOrder S; S.init(MT, 1024, KVR, G, bx); pg8::EpiRows<FKvNorm, true, true> E{FKvNorm{KV, g_k_nope}}; pg8::gemm_phase<false>(lds, g, S, E, STREAM_CTL(2)); }
        { pg8::Gemm g{DBuf, WPOOLT, MT, POOLD, 256, POOLD, 256, 0}; pg8::StaticOrder S; S.init(MT, POOLD, 256, G, (G == 256) ? ((bx + 240) & 255) : bx); pg8::EpiRows<FPool, false, true> E{FPool{pool_scale, MIX}}; pg8::gemm_phase<false>(lds, g, S, E, STREAM_CTL(3)); }
    }
#if DBG_KNORM
    if (IN(PH_KVPOOL)) GEMM_PHASE_STATIC(16, CB, KVR, 0, 0, WKVT, MT, 1024, KVR, FRawBf16<1024>, (bf16_t*)(ws + WS_DBG));
#endif
    SEAM(PH_KVPOOL);
#if DBG_KNORM
    if (IN(PH_KNORM)) { const bf16_t* R = (const bf16_t*)(ws + WS_DBG); unsigned bad = 0;
        for (int row = gw; row < MT; row += NGW) {
            for (int h = 0; h < NH; ++h) { const float x = bf2f(R[(size_t)row * 1024 + h * 64 + lane]); const float ss = wave_sum(x * x); const float y = x * rsqrtf(ss * (1.f / 64.f) + EPS) * g_k_nope[lane];
                const float a = bf2f(KV[(size_t)row * 1024 + h * 64 + lane]); if (!(fabsf(a - y) <= 0.02f + 0.02f * fabsf(y))) ++bad; }
            for (int c = lane; c < 512; c += 64) { const float y = bf2f(R[(size_t)row * 1024 + 512 + c]), a = bf2f(KV[(size_t)row * 1024 + 512 + c]); if (!(fabsf(a - y) <= 1e-3f + 0.01f * fabsf(y))) ++bad; } }
        if (bad) atomicAdd((unsigned*)(ws + WS_CTL) + CW_DBG, bad); }
#endif
    if (IN(PH_ATTN)) {
        LAS float* sc = (LAS float*)(lds + wave * 16768);
#if DBG_ATTN_P
        for (int it = gw; it < MP * NH; it += NGW) attn_p_naive_item(it, lane, sc, QB, KV, KRB, (bf16_t*)(ws + WS_DBG));
        __syncthreads();
#endif
#ifndef NO_ATTN_P
        { const int vcu = (G % 8 == 0) ? (bx % 8) * (G / 8) + bx / 8 : bx;
          for (int rep_ = 0; rep_ < REPN(3); ++rep_) for (int pi = vcu; pi < 256; pi += G) { const int bh = pi >> 3, s8 = pi & 7; attn_p_unit(bh >> 3, bh & 7, 15 - s8, lds, QB, KV, KRB, MIX); attn_p_unit(bh >> 3, bh & 7, s8, lds, QB, KV, KRB, MIX); }
          asm volatile("s_waitcnt vmcnt(0)" ::: "memory"); __syncthreads(); }
#endif
#if DBG_ATTN_S
        for (int it = bx; it < (NPAGES + 1) * DB_; it += G) attn_s_scores_item(it % (NPAGES + 1), it / (NPAGES + 1), tid, cache_ckv, cache_kr, page_table, QB, CB, KRB, w_uk, g_k_nope, SC);
        __syncthreads();
#endif
        if (REP_ID >= 20 && REP_ID <= 24) for (int u = bx; u < 2 * DB_; u += G) attn_s_unit<(REP_ID >= 20 && REP_ID <= 24) ? REP_ID - 19 : 1>(u, lds, cache_ckv, cache_kr, page_table, QB, WKVT, g_k_nope, (float*)(ws + WS_DBG), (float*)(ws + WS_DBG + 40 * MiB));
        for (int rep_ = 0; rep_ < REPN(4); ++rep_) for (int u = bx; u < 2 * DB_; u += G) attn_s_unit<0>(u, lds, cache_ckv, cache_kr, page_table, QB, WKVT, g_k_nope, (float*)(ws + WS_LATP), (float*)(ws + WS_ML));
        asm volatile("s_waitcnt vmcnt(0)" ::: "memory"); __syncthreads();
    }
    SEAM(PH_ATTN);
#if DBG_ATTN_P
    if (IN(PH_ATTN2)) {
        const bf16_t* R = (const bf16_t*)(ws + WS_DBG); unsigned bad = 0;
        for (size_t i = (size_t)bx * NTHR + tid; i < (size_t)MP * 512; i += (size_t)G * NTHR) { const size_t row = i >> 9, c = 512 + (i & 511); const float a = bf2f(MIX[row * DM + c]), r = bf2f(R[row * DM + c]);
            if (!(fabsf(a - r) <= 0.01f + 0.02f * fabsf(r))) ++bad; }
        if (bad) atomicAdd((unsigned*)(ws + WS_CTL) + CW_DBG, bad);
    }
#endif
    if (IN(PH_ATTN2)) { __syncthreads();
#if DBG_ATTN_S
        for (int sb = bx; sb < DB_; sb += G) attn_s_pv_item(sb, tid, (LAS float*)lds, cache_ckv, page_table, CB, SC, w_uv, LAT, (bf16_t*)(ws + WS_DBG));
        __syncthreads();
#endif
        for (int sb = bx; sb < DB_; sb += G) attn_s_combine(sb, lds, QB, KV, KRB, WKVT, (const float*)(ws + WS_LATP), (const float*)(ws + WS_ML), MIX);
#if DBG_ATTN_S
        asm volatile("s_waitcnt vmcnt(0)" ::: "memory"); __syncthreads();
        { const bf16_t* R = (const bf16_t*)(ws + WS_DBG); unsigned bad = 0; float num_ = 0.f, den_ = 0.f;
          for (int sb = bx; sb < DB_; sb += G) for (int i = tid; i < DT * 512; i += NTHR) { const size_t row = (size_t)MP + sb * DT + (i >> 9), c = 512 + (i & 511); const float a = bf2f(MIX[row * DM + c]), r = bf2f(R[row * DM + c]);
              num_ += (a - r) * (a - r); den_ += r * r; if (!(fabsf(a - r) <= 0.02f + 0.5f * fabsf(r))) ++bad; }
          if (bad) atomicAdd((unsigned*)(ws + WS_CTL) + CW_DBG, bad);
          num_ = wave_sum(num_); den_ = wave_sum(den_); if (lane == 0) { atomicAdd((float*)(ws + WS_CTL) + CW_DBG + 2, num_); atomicAdd((float*)(ws + WS_CTL) + CW_DBG + 3, den_); } }
#endif
    }
    if (IN(PH_ATTN2) && bx >= DB_) {
        LAS float* scr = (LAS float*)(lds + wave * 16384);
        for (int it = (bx - DB_) * NWAVES + wave; it < 16 * 32; it += (G - DB_) * NWAVES) p0_transpose_item(w_out_even, DM, DM, WOUT0T, DM, nullptr, scr, it, lane);
        if (G == 256) for (int it = (bx - DB_) * NWAVES + wave; it < 16 * 128; it += (G - DB_) * NWAVES) p0_transpose_item(w_up, DFF, DFF, WUPT, DM, norm_ffn, scr, it, lane);
    }
    SEAM(PH_ATTN2);
    if (IN(PH_OUT0)) GEMM_RESID_SPLIT(MIX, DM, WOUT0T, DM);
    if (IN(PH_OUT0) && G != 256) {
        const int gw2 = bx * NWAVES + wave, NGW2 = G * NWAVES;
        LAS float* scr = (LAS float*)(lds + wave * 16384);
        constexpr int I8 = 16 * 128, I10 = 64 * 32;
        for (int it = gw2; it < I8 + I10; it += NGW2) {
            if (it < I8) p0_transpose_item(w_up, DFF, DFF, WUPT, DM, norm_ffn, scr, it, lane);
            else p0_transpose_item(w_down, DM, DM, WDNT, DFF, nullptr, scr, it - I8, lane);
        }
    }
    SEAM(PH_OUT0);
    if (IN(PH_UP0) && REP_ID == 30) GEMM_PHASE(30, XB, DM, 0, 0, WUPT, MT, DFF, DM, FNull, (float*)(ws + WS_DBG));
    if (IN(PH_UP0)) { FIXUP_DEFERRED(0, 8); GEMM_PHASE_P8_RDY(0, 5, XB, DM, WUPT, MT, DFF, DM, FUp, SSQ, H); }
    if (IN(PH_UP0)) {
        const int nidle = G - 64;
        if (G == 256 ? (bx >= 64) : true) {
            const int gw2 = (G == 256 ? (bx - 64) : bx) * NWAVES + wave, NGW2 = (G == 256 ? nidle : G) * NWAVES;
            LAS float* scr = (LAS float*)(lds + wave * 16384);
            constexpr int I3 = 2 * 4, I7 = 16 * 32, I8 = 16 * 128, I10 = 64 * 32, I12 = 16 * 64;
            constexpr int NIT2 = I8 + I10 + I12 + 16 * I3 + I7;
            if (G == 256) for (int it = gw2; it < I10; it += NGW2) p0_transpose_item(w_down, DM, DM, WDNT, DFF, nullptr, scr, it, lane);
            for (int it = gw2; it < NIT2; it += NGW2) {
                int r = it;
                if (r < I8) { p0_transpose_item(w_up + (size_t)DM * DFF, DFF, DFF, WUPT + (size_t)DFF * DM, DM, norm_ffn + DM, scr, r, lane); continue; } r -= I8;
                if (r < I10) { p0_transpose_item(w_down + (size_t)DFF * DM, DM, DM, WDNT + (size_t)DM * DFF, DFF, nullptr, scr, r, lane); continue; } r -= I10;
                if (r < I12) { p0_transpose_item(w_in_rnn, 2048, 2048, WINRT, DM, norm_mix + DM, scr, r, lane); continue; } r -= I12;
                if (r < 16 * I3) { const int q = r / I3, n = q >> 1, isx = q & 1; const float* src = (isx ? w_gate_x : w_gate_a) + (size_t)n * 128 * 128;
                    p0_transpose_item(src, 128, 128, WGATET + (size_t)(n * 256 + isx * 128) * 256 + (n & 1) * 128, 256, nullptr, scr, r % I3, lane); continue; } r -= 16 * I3;
                p0_transpose_item(w_out_rnn, DM, DM, WOUTRT, DM, nullptr, scr, r, lane);
            }
        }
    }
    SEAM(PH_UP0);
    if (IN(PH_DN0)) GEMM_DOWN(H, WDNT, false);
    SEAM(PH_DN0);
    if (IN(PH_RNNIN)) { FIXUP_DEFERRED(1, 16); GEMM_PHASE_P8_RDY(1, 7, XB, DM, WINRT, MT, 2048, DM, FRnnIn, SSQ, GATE, U); }
    SEAM(PH_RNNIN);
    if (IN(PH_CONV)) for (int rep_ = 0; rep_ < REPN(12); ++rep_) {
        for (int it = bx * NTHR + tid; it < (MP / 16) * 128; it += G * NTHR) conv_item_p16((it >> 7) * 16, (it & 127) * 8, U, conv_w, conv_b, V, out);
        for (int it = bx * NTHR + tid; it < DB_ * 128; it += G * NTHR) conv_item<false>(MP + (it >> 7) * DT, DT, (it & 127) * 8, U, state_conv, conv_w, conv_b, V, out);
    }
    SEAM(PH_CONV);
    if (IN(PH_GATES)) for (int rep_ = 0; rep_ < REPN(9); ++rep_) { pg8::Gemm g{V, WGATET, MT, 2048, 256, DM, 256, 1}; pg8::StaticOrder S; S.init(MT, 2048, 256, G, bx);
        EpiGates E{V, b_gate_a, b_gate_x, (const float*)(ws + WS_SP8), (bf16_t*)(ws + WS_HL), (bf16_t*)(ws + WS_AC), (float*)(ws + WS_SUM)}; pg8::gemm_phase<false>(lds, g, S, E, STREAM_CTL(8)); }
    SEAM(PH_GATES);
    if (IN(PH_SCAN)) for (int rep_ = 0; rep_ < REPN(11); ++rep_) {
        const bf16_t* HL = (const bf16_t*)(ws + WS_HL); const bf16_t* AC = (const bf16_t*)(ws + WS_AC); const float* SUM = (const float*)(ws + WS_SUM);
        for (int idx = bx * NTHR + tid; idx < 256 * 4 * 128; idx += G * NTHR) {
            const int cg = idx & 127, qt = (idx >> 7) & 3, segp = idx >> 9, sq = segp & 63, ch = cg * 8;
            u32x4 rhl[2][8], rac[2][8], rgt[2][8];
#define SCAN_LD(bt_) do { _Pragma("unroll") for (int t = 0; t < 8; ++t) { const size_t off = (size_t)(segp * 64 + qt * 16 + (bt_) * 8 + t) * DM + ch; rhl[bt_][t] = *(const u32x4*)(HL + off); rac[bt_][t] = *(const u32x4*)(AC + off); rgt[bt_][t] = *(const u32x4*)(GATE + off); } } while (0)
            SCAN_LD(0);
            float h[8];
#pragma unroll
            for (int e = 0; e < 8; ++e) h[e] = 0.f;
#pragma unroll 4
            for (int k = 0; k < sq; ++k) {
                const f32x4* sp4 = (const f32x4*)(SUM + ((size_t)(segp - sq + k) * DM + ch) * 2);
                const f32x4 s0 = sp4[0], s1 = sp4[1], s2 = sp4[2], s3 = sp4[3];
                h[0] = s0.x * h[0] + s0.y; h[1] = s0.z * h[1] + s0.w; h[2] = s1.x * h[2] + s1.y; h[3] = s1.z * h[3] + s1.w;
                h[4] = s2.x * h[4] + s2.y; h[5] = s2.z * h[5] + s2.w; h[6] = s3.x * h[6] + s3.y; h[7] = s3.z * h[7] + s3.w;
            }
            SCAN_LD(1);
#undef SCAN_LD
#pragma unroll
            for (int t = 0; t < 16; ++t) {
                const size_t off = (size_t)(segp * 64 + qt * 16 + t) * DM + ch;
                const u32x4 hl = rhl[t >> 3][t & 7], ac = rac[t >> 3][t & 7], gt = rgt[t >> 3][t & 7];
                float hv[8]; u32x4 o;
#pragma unroll
                for (int e2 = 0; e2 < 4; ++e2) {
                    hv[2 * e2] = __uint_as_float(hl[e2] << 16) + __uint_as_float(ac[e2] << 16) * h[2 * e2];
                    hv[2 * e2 + 1] = __uint_as_float(hl[e2] & 0xffff0000u) + __uint_as_float(ac[e2] & 0xffff0000u) * h[2 * e2 + 1];
                    o[e2] = pk2(__uint_as_float(gt[e2] << 16) * hv[2 * e2], __uint_as_float(gt[e2] & 0xffff0000u) * hv[2 * e2 + 1]);
                }
                *(u32x4*)(YB + off) = o;
                if (sq == 63 && qt == 3 && t == 15) {
#pragma unroll
                    for (int e = 0; e < 8; ++e) out[O_LRU_P + (size_t)(segp >> 6) * DM + ch + e] = hv[e];
                }
            }
        }
        for (int idx = bx * NTHR + tid; idx < DB_ * 128; idx += G * NTHR) {
            const int cg = idx & 127, sb = idx >> 7, ch = cg * 8;
            float h[8];
#pragma unroll
            for (int e = 0; e < 8; ++e) h[e] = state_lru[(size_t)sb * DM + ch + e];
            for (int t = 0; t < DT; ++t) {
                const size_t off = (size_t)(MP + sb * DT + t) * DM + ch;
                const u32x4 hl = *(const u32x4*)(HL + off), ac = *(const u32x4*)(AC + off), gt = *(const u32x4*)(GATE + off);
                float hv[8]; u32x4 o;
#pragma unroll
                for (int e2 = 0; e2 < 4; ++e2) {
                    hv[2 * e2] = __uint_as_float(hl[e2] << 16) + __uint_as_float(ac[e2] << 16) * h[2 * e2];
                    hv[2 * e2 + 1] = __uint_as_float(hl[e2] & 0xffff0000u) + __uint_as_float(ac[e2] & 0xffff0000u) * h[2 * e2 + 1];
                    o[e2] = pk2(__uint_as_float(gt[e2] << 16) * hv[2 * e2], __uint_as_float(gt[e2] & 0xffff0000u) * hv[2 * e2 + 1]);
                }
                *(u32x4*)(YB + off) = o;
                if (t == DT - 1) {
#pragma unroll
                    for (int e = 0; e < 8; ++e) out[O_LRU_S + (size_t)sb * DM + ch + e] = hv[e];
                }
            }
        }
    }
    SEAM(PH_SCAN);
    if (IN(PH_OUTR)) GEMM_RESID_SPLIT(YB, DM, WOUTRT, DM);
    SEAM(PH_OUTR);
    if (IN(PH_UP1)) { FIXUP_DEFERRED(2, 8); GEMM_PHASE_P8_RDY(2, 10, XB, DM, WUPT + (size_t)DFF * DM, MT, DFF, DM, FUp, SSQ, H); }
    SEAM(PH_UP1);
#if DBG_ANY
    if (IN(PH_DN1)) { const float n_ = __hip_atomic_load((float*)(ws + WS_CTL) + CW_DBG + 2, __ATOMIC_RELAXED, __HIP_MEMORY_SCOPE_AGENT), d_ = __hip_atomic_load((float*)(ws + WS_CTL) + CW_DBG + 3, __ATOMIC_RELAXED, __HIP_MEMORY_SCOPE_AGENT);
        if ((__hip_atomic_load((unsigned*)(ws + WS_CTL) + CW_DBG, __ATOMIC_RELAXED, __HIP_MEMORY_SCOPE_AGENT) != 0u || n_ > DBG_RVR * d_) && bx == 0 && tid == 0) out[O_LRU_S] = __builtin_nanf(""); }
#endif
    if (IN(PH_DN1)) GEMM_DOWN(H, WDNT + (size_t)DM * DFF, true);
#undef IN
#undef SEAM
#undef GEMM_PHASE
}

#ifndef MK_ONE
#define MK_ONE 1
#endif
extern "C" void kernel_launch(void* const* d_in, const int* in_sizes, int n_in, void* d_out, int out_size, void* d_ws, size_t ws_size, hipStream_t stream) {
    (void)in_sizes; (void)out_size;
    static int grid = 0;
    if (grid == 0) {
        if (n_in != 32 || ws_size < WS_END) { fprintf(stderr, "kernel_launch: unexpected inputs / workspace\n"); grid = -1; return; }
        int dev = 0, cus = 0, per_cu = 0;
        if (hipGetDevice(&dev) != hipSuccess || hipDeviceGetAttribute(&cus, hipDeviceAttributeMultiprocessorCount, dev) != hipSuccess) { grid = -1; return; }
        if (hipFuncSetAttribute((const void*)mk, hipFuncAttributeMaxDynamicSharedMemorySize, LDS_BYTES) != hipSuccess) { fprintf(stderr, "kernel_launch: hipFuncSetAttribute failed\n"); grid = -1; return; }
        if (hipOccupancyMaxActiveBlocksPerMultiprocessor(&per_cu, (const void*)mk, NTHR, LDS_BYTES) != hipSuccess || per_cu < 1) { fprintf(stderr, "kernel_launch: occupancy query reports %d\n", per_cu); }
        (void)hipGetLastError();
        grid = cus;
    }
    if (grid < 0) return;
    unsigned char* ws = (unsigned char*)d_ws;
    (void)hipMemsetAsync(ws + WS_CTL, 0, CTL_ZERO_BYTES, stream);
    Args a{};
    for (int i = 0; i < 32; ++i) a.in[i] = d_in[i];
    a.out = (float*)d_out; a.ws = ws;
#if MK_ONE
    a.ph_lo = 0; a.ph_hi = PH_COUNT;
    hipLaunchKernelGGL(mk, dim3(grid), dim3(NTHR), LDS_BYTES, stream, a);
#else
    for (int p = 0; p < PH_COUNT; ++p) { a.ph_lo = p; a.ph_hi = p + 1; hipLaunchKernelGGL(mk, dim3(grid), dim3(NTHR), LDS_BYTES, stream, a); }
#endif
}
```

```cpp
#include <hip/hip_runtime.h>
#include <stdint.h>
#include <math.h>
#include <stdio.h>

#define DI __device__ __forceinline__
#define LAS __attribute__((address_space(3)))
typedef unsigned short bf16_t;
typedef short bf16x8 __attribute__((ext_vector_type(8)));
typedef float f32x4 __attribute__((ext_vector_type(4)));
typedef float f32x16 __attribute__((ext_vector_type(16)));
typedef unsigned u32x2 __attribute__((ext_vector_type(2)));
typedef unsigned u32x4 __attribute__((ext_vector_type(4)));

constexpr int DM = 1024, SEQ = 4096, NB = 4, MP = NB * SEQ  , DB_ = 128, DT = 8, MS = DB_ * DT  , MT = MP + MS  ;
constexpr int PAST = 8192, PAGE = 128, NPAGES = PAST / PAGE  , NKEYS = PAST + DT  ;
constexpr int POOLD = 512, QDIM = 768, KVR = 256, ROPE = 32, NH = 8, QKH = 96, NOPE = 64, VH = 64;
constexpr int NZ0 = 1792  , DFF = 4096;
constexpr float EPS = 1e-6f;
constexpr float SM_SCALE = 0.10206207261596577f;
constexpr float QSCALE = 0.10206207261596577f * 1.4426950408889634f;

constexpr size_t O_Y = 0;
constexpr size_t O_CKV_P = (size_t)MT * DM;
constexpr size_t O_KR_P = O_CKV_P + (size_t)MP * KVR;
constexpr size_t O_POOL_P = O_KR_P + (size_t)MP * ROPE;
constexpr size_t O_CONV_P = O_POOL_P + (size_t)NB * 15 * POOLD;
constexpr size_t O_LRU_P = O_CONV_P + (size_t)NB * 3 * DM;
constexpr size_t O_CKV_S = O_LRU_P + (size_t)NB * DM;
constexpr size_t O_KR_S = O_CKV_S + (size_t)MS * KVR;
constexpr size_t O_POOL_S = O_KR_S + (size_t)MS * ROPE;
constexpr size_t O_CONV_S = O_POOL_S + (size_t)DB_ * 15 * POOLD;
constexpr size_t O_LRU_S = O_CONV_S + (size_t)DB_ * 3 * DM;
constexpr size_t O_END = O_LRU_S + (size_t)DB_ * DM;
static_assert(O_END == 24393728, "output size");

constexpr size_t MiB = 1u << 20;
constexpr size_t WS_CTL = 0, CTL_ZERO_BYTES = 256 * 1024;
constexpr size_t WS_WIN0T = 1 * MiB;
constexpr size_t WS_WKVT = 5 * MiB;
constexpr size_t WS_WPOOLT = 6 * MiB;
constexpr size_t WS_WGATET = 7 * MiB;
constexpr size_t WS_WOUT0T = 8 * MiB;
constexpr size_t WS_WOUTRT = 10 * MiB;
constexpr size_t WS_WINRT = 12 * MiB;
constexpr size_t WS_WUPT = 16 * MiB;
constexpr size_t WS_WDNT = 32 * MiB;
constexpr size_t WS_SSQ = 48 * MiB;
constexpr size_t WS_SP8 = 49 * MiB + 96 * 1024;
constexpr size_t WS_ROPE = 49 * MiB + 128 * 1024;
constexpr size_t WS_XB = 50 * MiB;
constexpr size_t WS_Z0 = 84 * MiB;
constexpr size_t WS_QB = 144 * MiB;
constexpr size_t WS_CB = 170 * MiB;
constexpr size_t WS_KRB = 179 * MiB;
constexpr size_t WS_DB = 181 * MiB;
constexpr size_t WS_KV = 944 * MiB;
constexpr size_t WS_MIX = 230 * MiB;
constexpr size_t WS_H = 264 * MiB;
constexpr size_t WS_GATE = 400 * MiB;
constexpr size_t WS_U = 434 * MiB;
constexpr size_t WS_V = 468 * MiB;
constexpr size_t WS_G = 502 * MiB;
constexpr size_t WS_HL = WS_G, WS_AC = WS_G + 34 * MiB, WS_SUM = WS_G + 68 * MiB;
constexpr size_t WS_YB = 638 * MiB;
constexpr size_t WS_SC = 672 * MiB;
constexpr size_t WS_LAT = 930 * MiB;
constexpr size_t WS_ACCS = 1136 * MiB;
constexpr size_t WS_PART = 1140 * MiB;
constexpr size_t WS_END = 1140 * MiB + 2 * 256 * 262144;
constexpr int CW_BAR = 4096;
constexpr int CW_DBG = 64;
constexpr int CW_SKT = 128;
constexpr int CW_SKF = 32768;
constexpr size_t WS_DBG = 1000 * MiB;
constexpr size_t WS_LATP = 980 * MiB;
constexpr size_t WS_ML = 998 * MiB;
#ifndef DBG_ATTN_P
#define DBG_ATTN_P 0
#endif
#ifndef DBG_ATTN_S
#define DBG_ATTN_S 0
#endif
#ifndef DBG_KNORM
#define DBG_KNORM 0
#endif
#ifndef DBG_RVR
#define DBG_RVR 0.004f
#endif
#define DBG_ANY (DBG_ATTN_P || DBG_ATTN_S || DBG_KNORM)
#ifndef REP_ID
#define REP_ID 0
#endif
#define REPN(id) ((REP_ID == (id)) ? 2 : 1)

constexpr int NWAVES = 8, NTHR = NWAVES * 64;
constexpr int LDS_BYTES = 163840;
constexpr int LDS_MISC = LDS_BYTES - 1024;

DI unsigned f2bf(float f) { unsigned u = __float_as_uint(f); return (u + 0x7fffu + ((u >> 16) & 1u)) >> 16; }
DI float bf2f(bf16_t b) { return __uint_as_float(((unsigned)b) << 16); }
DI unsigned pk2(float lo, float hi) { return f2bf(lo) | (f2bf(hi) << 16); }
DI float xsum16(float x) { auto r = __builtin_amdgcn_permlane16_swap(__float_as_uint(x), __float_as_uint(x), false, false); return __uint_as_float(r[0]) + __uint_as_float(r[1]); }
DI float xsum32(float x) { auto r = __builtin_amdgcn_permlane32_swap(__float_as_uint(x), __float_as_uint(x), false, false); return __uint_as_float(r[0]) + __uint_as_float(r[1]); }
DI float xmax16(float x) { auto r = __builtin_amdgcn_permlane16_swap(__float_as_uint(x), __float_as_uint(x), false, false); return fmaxf(__uint_as_float(r[0]), __uint_as_float(r[1])); }
DI float xmax32(float x) { auto r = __builtin_amdgcn_permlane32_swap(__float_as_uint(x), __float_as_uint(x), false, false); return fmaxf(__uint_as_float(r[0]), __uint_as_float(r[1])); }
template <int CTRL> DI float dppf(float v) { return __int_as_float(__builtin_amdgcn_update_dpp(0, __float_as_int(v), CTRL, 0xF, 0xF, true)); }
DI float xchg4(float v, bool upper) { const float a = dppf<0x104>(v), b = dppf<0x114>(v); return upper ? b : a; }
DI float max8(float v) { v = fmaxf(v, dppf<0xB1>(v)); v = fmaxf(v, dppf<0x4E>(v)); v = fmaxf(v, dppf<0x141>(v)); return v; }
DI float sum8(float v) { v += dppf<0xB1>(v); v += dppf<0x4E>(v); v += dppf<0x141>(v); return v; }
DI float sum16(float v) { v = sum8(v); v += dppf<0x140>(v); return v; }
DI float wave_sum(float v) { return xsum32(xsum16(sum16(v))); }
DI float wave_max(float v) {
#pragma unroll
    for (int o = 1; o < 64; o <<= 1) v = fmaxf(v, __shfl_xor(v, o));
    return v;
}
DI float row_rinv(const float* SSQ, int row) {
    float s = 0.f;
#pragma unroll
    for (int p = 0; p < 16; ++p) s += SSQ[(size_t)p * MT + row];
    return rsqrtf(s * (1.0f / DM) + EPS);
}
DI float max3f(float a, float b, float c) { float r; asm("v_max3_f32 %0, %1, %2, %3" : "=v"(r) : "v"(a), "v"(b), "v"(c)); return r; }
DI float gelu_tanh(float x) { const float u = 0.7978845608028654f * (x + 0.044715f * x * x * x); return x * __builtin_amdgcn_rcpf(1.0f + __builtin_amdgcn_exp2f(-2.0f * 1.4426950408889634f * u)); }
DI float sigmoidf(float x) { return 1.f / (1.f + expf(-x)); }

struct UPre { float v[8]; };
namespace pg8 {
constexpr int BM = 256, BK = 64, HALF = 128, HTB = HALF * BK * 2, STAGE_BYTES = 8 * HTB, NXCD = 8, WGM = 8;
__host__ __device__ __forceinline__ int lds_byte(int r, int c) { const int st = (r >> 4) * 2 + (c >> 5), rr = r & 15, cc = c & 31, ob = rr * 64 + cc * 2; return st * 1024 + (ob ^ (((ob >> 9) & 1) << 5)); }
__host__ __device__ __forceinline__ void stage_rc(int b, int& R, int& C) { const int st = b / 1024, sb = b % 1024, swz = sb ^ (((sb >> 9) & 1) << 5); R = (st >> 1) * 16 + swz / 64; C = (st & 1) * 32 + (swz % 64) / 2; }
struct Unit { int pm, pn; };
struct Gemm { const bf16_t* A; const bf16_t* Bt; int M, N, K, lda, a_tile_off, a_shift; unsigned* ready = nullptr; unsigned ready_target = 0; };
struct Seg { int pm, pn, t0, t1; };
struct StreamOrder {
    int nM, nN, ppu, ub, lo, hi;
    DI void init(int M, int N, int K, int G, int c) {
        nM = M / BM; nN = N / BM; ppu = K / (2 * BK);
        const int nwg = nM * nN, x = c % NXCD, k = c / NXCD, nk = G / NXCD, q = nwg / NXCD, r = nwg % NXCD;
        ub = x * q + (x < r ? x : r); const int cnt = q + (x < r ? 1 : 0); const int Pr = cnt * ppu;
        lo = (k * Pr) / nk; hi = ((k + 1) * Pr) / nk;
    }
    DI bool next(int i, Seg& s) const {
        const int ul = lo / ppu + i, start = ul * ppu; if (start >= hi) return false;
        const int p0 = (lo > start ? lo : start) - start, p1 = ((hi < start + ppu) ? hi : start + ppu) - start;
        s.t0 = 2 * p0; s.t1 = 2 * p1;
        const int wgid = ub + ul, nig = WGM * nN, gid = wgid / nig, fm = gid * WGM, gsz = (nM - fm) < WGM ? (nM - fm) : WGM;
        s.pm = fm + ((wgid % nig) % gsz); s.pn = (wgid % nig) / gsz; return true;
    }
};
struct SplitTailOrder {
    int nt, c, ways, plen;
    DI void init(int K, int c_) { nt = K / BK; c = c_; ways = 16; plen = nt / 16; if (plen < 2) { plen = 2; ways = nt / 2; } }
    DI bool next(int i, Seg& u) const {
        if (i == 0) { u.t0 = 0; u.t1 = nt; const int xcd = c % NXCD, off = c / NXCD, wgid = xcd * 32 + off; u.pm = (wgid >> 5) * 8 + (wgid & 7); u.pn = (wgid >> 3) & 3; return true; }
        if (i == 1) { const int us = c >> 4, part = c & 15; if (part >= ways) return false; u.pm = 64 + (us >> 2); u.pn = us & 3; u.t0 = part * plen; u.t1 = u.t0 + plen; return true; }
        return false;
    }
};
struct StaticOrder {
    int nM, nN, nwg, G, c, nt;
    DI void init(int M, int N, int K, int G_, int c_) { nM = M / BM; nN = N / BM; nwg = nM * nN; G = G_; c = c_; nt = K / BK; }
    DI bool next(int i, Seg& u) const {
        u.t0 = 0; u.t1 = nt;
        const long L = (long)i * G + c; if (L >= nwg) return false;
        int wgid = (int)L; { const int q = nwg / NXCD, r = nwg % NXCD, xcd = wgid % NXCD, off = wgid / NXCD; wgid = (xcd < r ? xcd * (q + 1) : r * (q + 1) + (xcd - r) * q) + off; }
        const int nig = WGM * nN, gid = wgid / nig, fm = gid * WGM, gsz = (nM - fm) < WGM ? (nM - fm) : WGM;
        u.pm = fm + ((wgid % nig) % gsz); u.pn = (wgid % nig) / gsz; return true;
    }
};
struct NoPre {};
__host__ __device__ __forceinline__ int perm32(int rho) { const int n = rho >> 4, i = rho & 15; return 8 * (i >> 2) + 4 * n + (i & 3); }
template <class F, bool P64 = false, bool P8 = false> struct EpiRows {
    F f;
    static constexpr bool PERM64 = P64;
    static constexpr bool PERM8 = P8;
    DI UPre unit_pre(int pm) const { return f.unit_pre(pm * BM); }
    DI void operator()(const f32x4 (&acc)[2][2][4][2], const Unit& u, int wr, int wc, int fr, int fq, const UPre& upre) const {
        constexpr int BJS = P64 ? 32 : HALF;
        const int row0 = u.pm * BM + wr * 64 + fr, col0 = u.pn * BM + wc * (P64 ? 64 : 32) + (P8 ? 8 : 4) * fq;
        f.unit_begin(u.pm * BM, upre);
#pragma unroll
        for (int ai = 0; ai < 2; ++ai) {
            typename F::RowPre rp[4]; typename F::Pre pr[4][2][2]; typename F::Pre8 pr8[4][2];
#pragma unroll
            for (int m = 0; m < 4; ++m) rp[m] = f.row_pre(row0 + ai * HALF + m * 16);
#pragma unroll
            for (int m = 0; m < 4; ++m)
#pragma unroll
                for (int bj = 0; bj < 2; ++bj)
#pragma unroll
                    for (int n = 0; n < 2; ++n) { if constexpr (P8) { if (n == 0) pr8[m][bj] = f.pre8(row0 + ai * HALF + m * 16, col0 + bj * BJS); } else pr[m][bj][n] = f.pre(row0 + ai * HALF + m * 16, col0 + bj * BJS + n * 16); }
#pragma unroll
            for (int m = 0; m < 4; ++m) {
                const int row = row0 + ai * HALF + m * 16;
                typename F::Ctx ctx = f.row_begin(row, rp[m]);
                if constexpr (P8) {
#pragma unroll
                    for (int bj = 0; bj < 2; ++bj) f.op8(ctx, row, col0 + bj * BJS, acc[ai][bj][m][0], acc[ai][bj][m][1], pr8[m][bj]);
                } else {
#pragma unroll
                    for (int bj = 0; bj < 2; ++bj)
#pragma unroll
                        for (int n = 0; n < 2; ++n) f(ctx, row, col0 + bj * BJS + n * 16, acc[ai][bj][m][n], pr[m][bj][n]);
                }
                f.row_end(ctx, row, u.pn, wc, fq);
            }
        }
    }
};

struct StreamCtl { float* part; unsigned* flags; unsigned* tmo; unsigned epoch; int c; int pad; };
struct NoPart { DI void operator()(const f32x4 (&)[2][2][4][2], const Unit&, int, int, int, int) const {} };
template <bool STREAM, class Sched, class Epi, class EpiPart = NoPart>
DI void gemm_phase(LAS unsigned char* lds, const Gemm g, const Sched& S, const Epi& E, const StreamCtl sc, const EpiPart EP = EpiPart()) {
    const int tid = threadIdx.x, wid = __builtin_amdgcn_readfirstlane(tid >> 6), lane = tid & 63, wr = wid >> 2, wc = wid & 3, fr = lane & 15, fq = lane >> 4;
    const int K = g.K, nt = K / BK;
    unsigned voffA[2], voffB[2];
#pragma unroll
    for (int i = 0; i < 2; ++i) { int R, C; stage_rc(tid * 16 + i * 8192, R, C); const int r31 = Epi::PERM8 ? perm32(R & 31) : (R & 31); const int Rb = Epi::PERM64 ? (64 * (R >> 5) + r31) : ((R & ~31) + r31); voffA[i] = (unsigned)(R * g.lda + C) * 2u; voffB[i] = (unsigned)(Rb * K + C) * 2u; }
    const size_t kstep = (size_t)(BK * 2);
    const size_t hstepA = (size_t)HALF * g.lda * 2, hstepB = (size_t)(Epi::PERM64 ? 32 : HALF) * K * 2;
    const size_t tstepA = 2 * hstepA, tstepB = (size_t)BM * K * 2, pstepA = (size_t)g.a_tile_off * 2;
    const unsigned ldsw = (unsigned)wid * 1024u;
    const int aoff = lds_byte(wr * 64 + fr, fq * 8), boff = lds_byte(wc * 32 + fr, fq * 8);
#define PG8_SA(b, h) (((b) * 2 + (h)) * HTB)
#define PG8_SB(b, h) ((4 + (b) * 2 + (h)) * HTB)
#define PG8_STAGE(bufoff, gbase, voff) do { _Pragma("unroll") for (int _i = 0; _i < 2; ++_i) \
        __builtin_amdgcn_global_load_lds((const unsigned*)((const char*)(gbase) + (voff)[_i]), (LAS unsigned*)(lds + (bufoff) + ldsw + _i * 8192), 16, 0, 0); } while (0)
#define PG8_LDA(dst, b, h) do { _Pragma("unroll") for (int m = 0; m < 4; ++m) _Pragma("unroll") for (int k = 0; k < 2; ++k) dst[m][k] = *(const LAS bf16x8*)(lds + PG8_SA(b, h) + aoff + m * 2048 + k * 1024); } while (0)
#define PG8_LDB(dst, b, h) do { _Pragma("unroll") for (int n = 0; n < 2; ++n) _Pragma("unroll") for (int k = 0; k < 2; ++k) dst[n][k] = *(const LAS bf16x8*)(lds + PG8_SB(b, h) + boff + n * 2048 + k * 1024); } while (0)
#define PG8_MMA(ai, bj, At, Bt) do { __builtin_amdgcn_s_setprio(1); _Pragma("unroll") for (int m = 0; m < 4; ++m) _Pragma("unroll") for (int n = 0; n < 2; ++n) _Pragma("unroll") for (int k = 0; k < 2; ++k) \
        acc[ai][bj][m][n] = __builtin_amdgcn_mfma_f32_16x16x32_bf16(Bt[n][k], At[m][k], acc[ai][bj][m][n], 0, 0, 0); __builtin_amdgcn_s_setprio(0); } while (0)
#define PG8_WAIT_V(n) asm volatile("s_waitcnt vmcnt(" #n ")" ::: "memory")
#define PG8_WAIT_L(n) asm volatile("s_waitcnt lgkmcnt(" #n ")" ::: "memory")
#define PG8_BAR __builtin_amdgcn_s_barrier()
#define PG8_SCHED __builtin_amdgcn_sched_barrier(0)
    Seg cur = {0, 0, 0, 0}, nxt = {0, 0, 0, 0}; int ui = 0;
    if (!S.next(0, cur)) return;
    bool waited = g.ready == nullptr;
#define PG8_READY_WAIT() do { if (wid == 0) { unsigned sp_ = 0; \
            while (__hip_atomic_load(g.ready, __ATOMIC_RELAXED, __HIP_MEMORY_SCOPE_AGENT) < g.ready_target) { __builtin_amdgcn_s_sleep(2); if (++sp_ > (1u << 22)) break; } \
            __builtin_amdgcn_fence(__ATOMIC_ACQUIRE, "agent"); asm volatile("s_waitcnt vmcnt(0)" ::: "memory"); } \
        PG8_BAR; asm volatile("" ::: "memory"); waited = true; } while (0)
#define PG8_BAR __builtin_amdgcn_s_barrier()
    if (!waited && cur.pm >= MP / 256) PG8_READY_WAIT();
    f32x4 acc[2][2][4][2];
#pragma unroll
    for (int a = 0; a < 2; ++a)
#pragma unroll
        for (int b = 0; b < 2; ++b)
#pragma unroll
            for (int m = 0; m < 4; ++m)
#pragma unroll
                for (int n = 0; n < 2; ++n) acc[a][b][m][n] = (f32x4){0.f, 0.f, 0.f, 0.f};
    bf16x8 At[4][2], B0[2][2], B1[2][2];
    const char* cA = (const char*)g.A + (size_t)cur.pm * tstepA + (size_t)(cur.pn >> g.a_shift) * pstepA + (size_t)cur.t0 * kstep;
    const char* cB = (const char*)g.Bt + (size_t)cur.pn * tstepB + (size_t)cur.t0 * kstep;
    PG8_STAGE(PG8_SB(0, 0), cB, voffB); PG8_STAGE(PG8_SB(0, 1), cB + hstepB, voffB); PG8_STAGE(PG8_SA(0, 0), cA, voffA); PG8_STAGE(PG8_SA(0, 1), cA + hstepA, voffA);
    if (wr == 1) PG8_BAR;
    PG8_WAIT_V(2); PG8_BAR;
    PG8_STAGE(PG8_SB(1, 0), cB + kstep, voffB); PG8_STAGE(PG8_SA(1, 0), cA + kstep, voffA); PG8_STAGE(PG8_SB(1, 1), cB + hstepB + kstep, voffB);
    PG8_WAIT_V(6); PG8_BAR;
    for (;;) {
        const bool has_next = S.next(ui + 1, nxt);
        if (!waited && has_next && nxt.pm >= MP / 256) PG8_READY_WAIT();
        const char* nA = has_next ? (const char*)g.A + (size_t)nxt.pm * tstepA + (size_t)(nxt.pn >> g.a_shift) * pstepA + (size_t)nxt.t0 * kstep : cA;
        const char* nB = has_next ? (const char*)g.Bt + (size_t)nxt.pn * tstepB + (size_t)nxt.t0 * kstep : cB;
        const int nseg = cur.t1 - cur.t0;
        UPre upre{}; if (STREAM || nseg == nt) upre = E.unit_pre(cur.pm);
#pragma unroll 1
        for (int t = 0; t < nseg; t += 2) {
            const bool last = (t == nseg - 2);
            const char* a1 = cA + (size_t)(t + 1) * kstep;
            const char* a2 = last ? nA : cA + (size_t)(t + 2) * kstep; const char* b2 = last ? nB : cB + (size_t)(t + 2) * kstep;
            const char* a3 = a2 + kstep; const char* b3 = b2 + kstep;
            PG8_LDB(B0, 0, 0); PG8_LDB(B1, 0, 1); PG8_SCHED; PG8_LDA(At, 0, 0); PG8_STAGE(PG8_SA(1, 1), a1 + hstepA, voffA);
            PG8_WAIT_V(8); PG8_WAIT_L(0); PG8_BAR; PG8_MMA(0, 0, At, B0); PG8_MMA(0, 1, At, B1); PG8_BAR; PG8_SCHED;
            PG8_LDA(At, 0, 1); PG8_STAGE(PG8_SB(0, 0), b2, voffB); PG8_STAGE(PG8_SB(0, 1), b2 + hstepB, voffB); PG8_STAGE(PG8_SA(0, 0), a2, voffA);
            PG8_WAIT_V(8); PG8_WAIT_L(0); PG8_BAR; PG8_MMA(1, 0, At, B0); PG8_MMA(1, 1, At, B1); PG8_BAR; PG8_SCHED;
            PG8_LDB(B0, 1, 0); PG8_LDB(B1, 1, 1); PG8_SCHED; PG8_LDA(At, 1, 0); PG8_STAGE(PG8_SA(0, 1), a2 + hstepA, voffA);
            PG8_WAIT_V(8); PG8_WAIT_L(0); PG8_BAR; PG8_MMA(0, 0, At, B0); PG8_MMA(0, 1, At, B1); PG8_BAR; PG8_SCHED;
            PG8_LDA(At, 1, 1); PG8_STAGE(PG8_SB(1, 0), b3, voffB); PG8_STAGE(PG8_SB(1, 1), b3 + hstepB, voffB); PG8_STAGE(PG8_SA(1, 0), a3, voffA);
            PG8_WAIT_V(8); PG8_WAIT_L(0); PG8_BAR; PG8_MMA(1, 0, At, B0); PG8_MMA(1, 1, At, B1); PG8_BAR; PG8_SCHED;
        }
        if (wr == 0) PG8_BAR;
        if (STREAM && cur.t0 > 0) {
            const __amdgpu_buffer_rsrc_t prs = __builtin_amdgcn_make_buffer_rsrc((void*)(sc.part + ((size_t)(sc.epoch & 1u) * gridDim.x + sc.c) * 65536), (short)0, 262144, 0x00020000);
#pragma unroll
            for (int a = 0; a < 2; ++a)
#pragma unroll
                for (int b = 0; b < 2; ++b)
#pragma unroll
                    for (int m = 0; m < 4; ++m)
#pragma unroll
                        for (int n = 0; n < 2; ++n) { const int j = ((a * 2 + b) * 4 + m) * 2 + n; const f32x4 v = acc[a][b][m][n];
                            __builtin_amdgcn_raw_buffer_store_b128(__builtin_bit_cast(u32x4, v), prs, (unsigned)tid * 16u, j * 8192, 16); }
            asm volatile("s_waitcnt vmcnt(0)" ::: "memory");
            PG8_BAR;
            if (tid == 0) __hip_atomic_store(sc.flags + (size_t)sc.c * 64, sc.epoch, __ATOMIC_RELAXED, __HIP_MEMORY_SCOPE_AGENT);
        } else {
            Unit uu; uu.pm = cur.pm; uu.pn = cur.pn;
            if (!STREAM && (cur.t1 - cur.t0) != nt) EP(acc, uu, wr, wc, fr, fq); else E(acc, uu, wr, wc, fr, fq, upre);
        }
        if (!has_next) break;
        if (STREAM && nxt.t1 < nt) {
            const int pc = sc.c + NXCD;
            if (wid == 0) {
                unsigned* fl = sc.flags + (size_t)pc * 64; unsigned sp = 0; bool ok = true;
                while (__hip_atomic_load(fl, __ATOMIC_RELAXED, __HIP_MEMORY_SCOPE_AGENT) != sc.epoch) {
                    __builtin_amdgcn_s_sleep(1);
                    if ((++sp & 255u) == 0u) { if (__hip_atomic_load(sc.tmo, __ATOMIC_RELAXED, __HIP_MEMORY_SCOPE_AGENT) != 0u || sp > (1u << 20)) { ok = false; break; } }
                }
                if (!ok && lane == 0) __hip_atomic_store(sc.tmo, 1u, __ATOMIC_RELAXED, __HIP_MEMORY_SCOPE_AGENT);
                __builtin_amdgcn_fence(__ATOMIC_ACQUIRE, "agent");
                asm volatile("s_waitcnt vmcnt(0)" ::: "memory");
            }
            PG8_BAR; asm volatile("" ::: "memory");
            const __amdgpu_buffer_rsrc_t crs = __builtin_amdgcn_make_buffer_rsrc((void*)(sc.part + ((size_t)(sc.epoch & 1u) * gridDim.x + pc) * 65536), (short)0, 262144, 0x00020000);
#pragma unroll
            for (int a = 0; a < 2; ++a)
#pragma unroll
                for (int b = 0; b < 2; ++b)
#pragma unroll
                    for (int m = 0; m < 4; ++m)
#pragma unroll
                        for (int n = 0; n < 2; ++n) acc[a][b][m][n] = __builtin_bit_cast(f32x4, __builtin_amdgcn_raw_buffer_load_b128(crs, (unsigned)tid * 16u, ((((a * 2 + b) * 4 + m) * 2 + n) * 8192), 0));
        } else {
#pragma unroll
            for (int a = 0; a < 2; ++a)
#pragma unroll
                for (int b = 0; b < 2; ++b)
#pragma unroll
                    for (int m = 0; m < 4; ++m)
#pragma unroll
                        for (int n = 0; n < 2; ++n) acc[a][b][m][n] = (f32x4){0.f, 0.f, 0.f, 0.f};
        }
        cur = nxt; cA = nA; cB = nB; ++ui;
        if (wr == 1) PG8_BAR;
    }
    PG8_WAIT_V(0);
    PG8_BAR;
#undef PG8_SA
#undef PG8_SB
#undef PG8_STAGE
#undef PG8_LDA
#undef PG8_LDB
#undef PG8_MMA
#undef PG8_WAIT_V
#undef PG8_WAIT_L
#undef PG8_BAR
#undef PG8_SCHED
}
}

constexpr int LDS_RINV = 131072;
DI UPre rinv_partial_load(const float* SSQ, int rowbase) {
    const int tid = threadIdx.x, r = tid >> 1, hf = tid & 1;
    UPre u;
#pragma unroll
    for (int p = 0; p < 8; ++p) u.v[p] = SSQ[(size_t)(hf * 8 + p) * MT + rowbase + r];
    return u;
}
DI void rinv_table_fill(const UPre& u) {
    extern __shared__ __attribute__((aligned(16))) unsigned char lds_raw_[];
    LAS float* tab = (LAS float*)((LAS unsigned char*)lds_raw_ + LDS_RINV);
    const int tid = threadIdx.x, r = tid >> 1, hf = tid & 1;
    float sv = ((u.v[0] + u.v[1]) + (u.v[2] + u.v[3])) + ((u.v[4] + u.v[5]) + (u.v[6] + u.v[7]));
    sv += dppf<0xB1>(sv);
    if (hf == 0) tab[r] = rsqrtf(sv * (1.0f / DM) + EPS);
    asm volatile("s_waitcnt lgkmcnt(0)" ::: "memory"); __builtin_amdgcn_s_barrier(); asm volatile("" ::: "memory");
}
DI float rinv_table_get(int row) {
    extern __shared__ __attribute__((aligned(16))) unsigned char lds_raw_[];
    return ((const LAS float*)((LAS unsigned char*)lds_raw_ + LDS_RINV))[row & 255];
}
struct FZ0 { typedef float Ctx; typedef float RowPre; typedef pg8::NoPre Pre; typedef pg8::NoPre Pre8; const float* SSQ; bf16_t* Z;
    DI UPre unit_pre(int rowbase) const { return rinv_partial_load(SSQ, rowbase); }
    DI void unit_begin(int, const UPre& sv) const { rinv_table_fill(sv); }
    DI RowPre row_pre(int row) const { return rinv_table_get(row); }
    DI Pre pre(int, int) const { return Pre{}; }
    DI pg8::NoPre pre8(int, int) const { return pg8::NoPre{}; }
    DI Ctx row_begin(int, const RowPre& rp) const { return rp; }
    DI void operator()(Ctx& ri, int row, int col, f32x4 v, const Pre&) const { u32x2 o; o.x = pk2(v.x * ri, v.y * ri); o.y = pk2(v.z * ri, v.w * ri); *(u32x2*)(Z + (size_t)row * NZ0 + col) = o; }
    DI void op8(Ctx& ri, int row, int col, f32x4 a, f32x4 b, const pg8::NoPre&) const { u32x4 o; o.x = pk2(a.x * ri, a.y * ri); o.y = pk2(a.z * ri, a.w * ri); o.z = pk2(b.x * ri, b.y * ri); o.w = pk2(b.z * ri, b.w * ri); *(u32x4*)(Z + (size_t)row * NZ0 + col) = o; }
    DI void row_end(Ctx&, int, int, int, int) const {} };
template <int LDO> struct FRawBf16 { typedef int Ctx; typedef pg8::NoPre RowPre; typedef pg8::NoPre Pre; typedef pg8::NoPre Pre8; bf16_t* O;
    DI UPre unit_pre(int) const { return UPre{}; }
    DI void unit_begin(int, const UPre&) const {}
    DI RowPre row_pre(int) const { return RowPre{}; }
    DI Pre pre(int, int) const { return Pre{}; }
    DI pg8::NoPre pre8(int, int) const { return pg8::NoPre{}; }
    DI Ctx row_begin(int, const RowPre&) const { return 0; }
    DI void operator()(Ctx&, int row, int col, f32x4 v, const Pre&) const { u32x2 o; o.x = pk2(v.x, v.y); o.y = pk2(v.z, v.w); *(u32x2*)(O + (size_t)row * LDO + col) = o; }
    DI void row_end(Ctx&, int, int, int, int) const {} };
struct KvCtx { f32x4 v[4]; int col0; int k; };
struct FKvNorm { typedef KvCtx Ctx; typedef pg8::NoPre RowPre; typedef pg8::NoPre Pre; typedef pg8::NoPre Pre8; bf16_t* O; const float* g;
    DI UPre unit_pre(int) const { return UPre{}; }
    DI void unit_begin(int, const UPre&) const {}
    DI RowPre row_pre(int) const { return RowPre{}; }
    DI Pre pre(int, int) const { return Pre{}; }
    DI pg8::NoPre pre8(int, int) const { return pg8::NoPre{}; }
    DI Ctx row_begin(int, const RowPre&) const { Ctx c; c.k = 0; c.col0 = 0; return c; }
    DI void operator()(Ctx&, int, int, f32x4, const Pre&) const {}
    DI void op8(Ctx& c, int, int col, f32x4 a, f32x4 b, const pg8::NoPre&) const { if (c.k == 0) c.col0 = col; c.v[c.k] = a; c.v[c.k + 1] = b; c.k += 2; }
    DI void row_end(Ctx& c, int row, int pn, int, int) const {
        float ri = 1.0f;
        if (pn < 2) { float ss = 0.f;
#pragma unroll
            for (int k = 0; k < 4; ++k) ss += c.v[k].x * c.v[k].x + c.v[k].y * c.v[k].y + c.v[k].z * c.v[k].z + c.v[k].w * c.v[k].w;
            ss = xsum32(xsum16(ss)); ri = rsqrtf(ss * (1.f / 64.f) + EPS); }
#pragma unroll
        for (int bj = 0; bj < 2; ++bj) { const int col = c.col0 + bj * 32; f32x4 y0 = c.v[2 * bj] * ri, y1 = c.v[2 * bj + 1] * ri;
            if (pn < 2) { y0 = y0 * *(const f32x4*)(g + (col & 63)); y1 = y1 * *(const f32x4*)(g + (col & 63) + 4); }
            u32x4 o; o.x = pk2(y0.x, y0.y); o.y = pk2(y0.z, y0.w); o.z = pk2(y1.x, y1.y); o.w = pk2(y1.z, y1.w); *(u32x4*)(O + (size_t)row * 1024 + col) = o; }
    } };
struct FPool { typedef int Ctx; typedef pg8::NoPre RowPre; typedef f32x4 Pre; typedef pg8::NoPre Pre8; const float* scale; bf16_t* MIX;
    DI pg8::NoPre pre8(int, int) const { return pg8::NoPre{}; }
    DI void op8(Ctx&, int row, int col, f32x4 a, f32x4 b, const pg8::NoPre&) const { const f32x4 s0 = *(const f32x4*)(scale + col), s1 = *(const f32x4*)(scale + col + 4);
        u32x4 o; o.x = pk2(a.x * s0.x, a.y * s0.y); o.y = pk2(a.z * s0.z, a.w * s0.w); o.z = pk2(b.x * s1.x, b.y * s1.y); o.w = pk2(b.z * s1.z, b.w * s1.w); *(u32x4*)(MIX + (size_t)row * DM + col) = o; }
    DI UPre unit_pre(int) const { return UPre{}; }
    DI void unit_begin(int, const UPre&) const {}
    DI RowPre row_pre(int) const { return RowPre{}; }
    DI Pre pre(int, int col) const { return *(const f32x4*)(scale + col); }
    DI Ctx row_begin(int, const RowPre&) const { return 0; }
    DI void operator()(Ctx&, int row, int col, f32x4 v, const Pre& s) const { u32x2 o; o.x = pk2(v.x * s.x, v.y * s.y); o.y = pk2(v.z * s.z, v.w * s.w); *(u32x2*)(MIX + (size_t)row * DM + col) = o; }
    DI void row_end(Ctx&, int, int, int, int) const {} };
template <bool FINAL> struct FResid { typedef float Ctx; typedef pg8::NoPre RowPre; typedef u32x2 Pre; typedef u32x4 Pre8; bf16_t* RB; float* Yf; float* SSQ;
    DI Pre8 pre8(int row, int col) const { return *(const u32x4*)(RB + (size_t)row * DM + col); }
    DI void op8(Ctx& ss, int row, int col, f32x4 a, f32x4 b, const Pre8& r) const {
        f32x4 y0, y1; y0.x = __uint_as_float(r.x << 16) + a.x; y0.y = __uint_as_float(r.x & 0xffff0000u) + a.y; y0.z = __uint_as_float(r.y << 16) + a.z; y0.w = __uint_as_float(r.y & 0xffff0000u) + a.w;
        y1.x = __uint_as_float(r.z << 16) + b.x; y1.y = __uint_as_float(r.z & 0xffff0000u) + b.y; y1.z = __uint_as_float(r.w << 16) + b.z; y1.w = __uint_as_float(r.w & 0xffff0000u) + b.w;
        if (FINAL) { *(f32x4*)(Yf + (size_t)row * DM + col) = y0; *(f32x4*)(Yf + (size_t)row * DM + col + 4) = y1; }
        else { u32x4 o; o.x = pk2(y0.x, y0.y); o.y = pk2(y0.z, y0.w); o.z = pk2(y1.x, y1.y); o.w = pk2(y1.z, y1.w); *(u32x4*)(RB + (size_t)row * DM + col) = o;
            ss += y0.x * y0.x + y0.y * y0.y + y0.z * y0.z + y0.w * y0.w + y1.x * y1.x + y1.y * y1.y + y1.z * y1.z + y1.w * y1.w; } }
    DI UPre unit_pre(int) const { return UPre{}; }
    DI void unit_begin(int, const UPre&) const {}
    DI RowPre row_pre(int) const { return RowPre{}; }
    DI Pre pre(int row, int col) const { return *(const u32x2*)(RB + (size_t)row * DM + col); }
    DI Ctx row_begin(int, const RowPre&) const { return 0.f; }
    DI void operator()(Ctx& ss, int row, int col, f32x4 v, const Pre& r) const {
        f32x4 y; y.x = __uint_as_float(r.x << 16) + v.x; y.y = __uint_as_float(r.x & 0xffff0000u) + v.y; y.z = __uint_as_float(r.y << 16) + v.z; y.w = __uint_as_float(r.y & 0xffff0000u) + v.w;
        if (FINAL) { *(f32x4*)(Yf + (size_t)row * DM + col) = y; }
        else { u32x2 o; o.x = pk2(y.x, y.y); o.y = pk2(y.z, y.w); *(u32x2*)(RB + (size_t)row * DM + col) = o; ss += y.x * y.x + y.y * y.y + y.z * y.z + y.w * y.w; } }
    DI void row_end(Ctx& ss, int row, int pn, int wc, int fq) const { if (!FINAL) { const float s = xsum32(xsum16(ss)); if (fq == 0) SSQ[(size_t)(pn * 4 + wc) * MT + row] = s; } } };
struct FNull { typedef int Ctx; typedef pg8::NoPre RowPre; typedef pg8::NoPre Pre; typedef pg8::NoPre Pre8; float* sink;
    DI UPre unit_pre(int) const { return UPre{}; }
    DI void unit_begin(int, const UPre&) const {}
    DI RowPre row_pre(int) const { return RowPre{}; }
    DI Pre pre(int, int) const { return Pre{}; }
    DI pg8::NoPre pre8(int, int) const { return pg8::NoPre{}; }
    DI Ctx row_begin(int, const RowPre&) const { return 0; }
    DI void operator()(Ctx&, int row, int col, f32x4 v, const Pre&) const { if (v.x == 1.2345e30f) sink[row + col] = v.y; }
    DI void row_end(Ctx&, int, int, int, int) const {} };
struct FUp { typedef float Ctx; typedef float RowPre; typedef pg8::NoPre Pre; typedef pg8::NoPre Pre8; const float* SSQ; bf16_t* H;
    DI UPre unit_pre(int rowbase) const { return rinv_partial_load(SSQ, rowbase); }
    DI void unit_begin(int, const UPre& sv) const { rinv_table_fill(sv); }
    DI RowPre row_pre(int row) const { return rinv_table_get(row); }
    DI Pre pre(int, int) const { return Pre{}; }
    DI pg8::NoPre pre8(int, int) const { return pg8::NoPre{}; }
    DI Ctx row_begin(int, const RowPre& rp) const { return rp; }
    DI void operator()(Ctx& ri, int row, int col, f32x4 v, const Pre&) const { f32x4 t = v * ri; t.x = fmaxf(t.x, 0.f); t.y = fmaxf(t.y, 0.f); t.z = fmaxf(t.z, 0.f); t.w = fmaxf(t.w, 0.f);
        u32x2 o; o.x = pk2(t.x * t.x, t.y * t.y); o.y = pk2(t.z * t.z, t.w * t.w); *(u32x2*)(H + (size_t)row * DFF + col) = o; }
    DI void op8(Ctx& ri, int row, int col, f32x4 a, f32x4 b, const pg8::NoPre&) const { f32x4 t = a * ri, w = b * ri;
        t.x = fmaxf(t.x, 0.f); t.y = fmaxf(t.y, 0.f); t.z = fmaxf(t.z, 0.f); t.w = fmaxf(t.w, 0.f); w.x = fmaxf(w.x, 0.f); w.y = fmaxf(w.y, 0.f); w.z = fmaxf(w.z, 0.f); w.w = fmaxf(w.w, 0.f);
        u32x4 o; o.x = pk2(t.x * t.x, t.y * t.y); o.y = pk2(t.z * t.z, t.w * t.w); o.z = pk2(w.x * w.x, w.y * w.y); o.w = pk2(w.z * w.z, w.w * w.w); *(u32x4*)(H + (size_t)row * DFF + col) = o; }
    DI void row_end(Ctx&, int, int, int, int) const {} };
struct FRnnIn { typedef float Ctx; typedef float RowPre; typedef pg8::NoPre Pre; typedef pg8::NoPre Pre8; const float* SSQ; bf16_t* GATE; bf16_t* U;
    DI UPre unit_pre(int rowbase) const { return rinv_partial_load(SSQ, rowbase); }
    DI void unit_begin(int, const UPre& sv) const { rinv_table_fill(sv); }
    DI RowPre row_pre(int row) const { return rinv_table_get(row); }
    DI Pre pre(int, int) const { return Pre{}; }
    DI pg8::NoPre pre8(int, int) const { return pg8::NoPre{}; }
    DI Ctx row_begin(int, const RowPre& rp) const { return rp; }
    DI void operator()(Ctx& ri, int row, int col, f32x4 v, const Pre&) const { f32x4 t = v * ri; u32x2 o;
        if (col < DM) { o.x = pk2(gelu_tanh(t.x), gelu_tanh(t.y)); o.y = pk2(gelu_tanh(t.z), gelu_tanh(t.w)); *(u32x2*)(GATE + (size_t)row * DM + col) = o; }
        else { o.x = pk2(t.x, t.y); o.y = pk2(t.z, t.w); *(u32x2*)(U + (size_t)row * DM + col - DM) = o; } }
    DI void op8(Ctx& ri, int row, int col, f32x4 a, f32x4 b, const pg8::NoPre&) const { const f32x4 t = a * ri, w = b * ri; u32x4 o;
        if (col < DM) { o.x = pk2(gelu_tanh(t.x), gelu_tanh(t.y)); o.y = pk2(gelu_tanh(t.z), gelu_tanh(t.w)); o.z = pk2(gelu_tanh(w.x), gelu_tanh(w.y)); o.w = pk2(gelu_tanh(w.z), gelu_tanh(w.w)); *(u32x4*)(GATE + (size_t)row * DM + col) = o; }
        else { o.x = pk2(t.x, t.y); o.y = pk2(t.z, t.w); o.z = pk2(w.x, w.y); o.w = pk2(w.z, w.w); *(u32x4*)(U + (size_t)row * DM + col - DM) = o; } }
    DI void row_end(Ctx&, int, int, int, int) const {} };

typedef float f32x2_t __attribute__((ext_vector_type(2))); typedef __bf16 bf16x2_t __attribute__((ext_vector_type(2)));
DI unsigned cvtpk(float lo, float hi) { f32x2_t v = {lo, hi}; bf16x2_t b = __builtin_convertvector(v, bf16x2_t); return __builtin_bit_cast(unsigned, b); }
struct EpiPartStore { float* PARTS; int part;
    DI void operator()(const f32x4 (&acc)[2][2][4][2], const pg8::Unit& u, int, int, int, int) const {
        const int us = (u.pm - MP / 256) * 4 + u.pn;
        f32x4* p = (f32x4*)(PARTS + (size_t)(us * 16 + part) * 65536) + threadIdx.x;
#pragma unroll
        for (int a = 0; a < 2; ++a)
#pragma unroll
            for (int b = 0; b < 2; ++b)
#pragma unroll
                for (int m = 0; m < 4; ++m)
#pragma unroll
                    for (int n = 0; n < 2; ++n) p[(((a * 2 + b) * 4 + m) * 2 + n) * 512] = acc[a][b][m][n];
    }
};
template <bool FINAL, int WAYS = 16> DI void sample_fixup(int b, const float* __restrict__ PARTS, bf16_t* __restrict__ RB, float* __restrict__ Yf, float* __restrict__ SSQ) {
    if (b >= 128) return;
    const int tid = threadIdx.x, wid = tid >> 6, lane = tid & 63, wr = wid >> 2, wc = wid & 3, fr = lane & 15, fq = lane >> 4;
    const int us = b >> 3, ai = (b >> 2) & 1, m = b & 3, pm = MP / 256 + (us >> 2), pn = us & 3;
    f32x4 v[2][2];
#pragma unroll
    for (int bj = 0; bj < 2; ++bj)
#pragma unroll
        for (int n = 0; n < 2; ++n) v[bj][n] = (f32x4){0.f, 0.f, 0.f, 0.f};
#pragma unroll 4
    for (int p = 0; p < WAYS; ++p) {
        const f32x4* pp = (const f32x4*)(PARTS + (size_t)(us * 16 + p) * 65536) + tid;
#pragma unroll
        for (int bj = 0; bj < 2; ++bj)
#pragma unroll
            for (int n = 0; n < 2; ++n) v[bj][n] += pp[(((ai * 2 + bj) * 4 + m) * 2 + n) * 512];
    }
    const int row = pm * 256 + ai * 128 + wr * 64 + m * 16 + fr, col0 = pn * 256 + wc * 32 + 8 * fq;
    float ss = 0.f;
#pragma unroll
    for (int bj = 0; bj < 2; ++bj)
#pragma unroll
        for (int n = 0; n < 2; ++n) { const size_t off = (size_t)row * DM + col0 + bj * 128 + n * 4; const u32x2 r = *(const u32x2*)(RB + off); const f32x4 a = v[bj][n];
            f32x4 y; y.x = __uint_as_float(r.x << 16) + a.x; y.y = __uint_as_float(r.x & 0xffff0000u) + a.y; y.z = __uint_as_float(r.y << 16) + a.z; y.w = __uint_as_float(r.y & 0xffff0000u) + a.w;
            if (FINAL) *(f32x4*)(Yf + off) = y;
            else { u32x2 o; o.x = pk2(y.x, y.y); o.y = pk2(y.z, y.w); *(u32x2*)(RB + off) = o; ss += y.x * y.x + y.y * y.y + y.z * y.z + y.w * y.w; } }
    if (!FINAL) { ss = xsum32(xsum16(ss)); if (fq == 0) SSQ[(size_t)(pn * 4 + wc) * MT + row] = ss; }
}
template <int SH> DI float dpp_row_shr(float oldv, float v) { return __int_as_float(__builtin_amdgcn_update_dpp(__float_as_int(oldv), __float_as_int(v), 0x110 + SH, 0xF, 0xF, false)); }
template <int SH> DI void scan_step(float& a, float& b, int fseg) {
    float ap = dpp_row_shr<SH>(1.0f, a), bp = dpp_row_shr<SH>(0.0f, b);
    if (fseg < SH) { ap = 1.0f; bp = 0.0f; }
    b = a * bp + b; a = a * ap;
}
struct EpiGates {
    static constexpr bool PERM64 = false, PERM8 = true;
    const bf16_t* V; const float* bga; const float* bgx; const float* lam; bf16_t* HL; bf16_t* AC; float* SUM;
    DI UPre unit_pre(int) const { return UPre{}; }
    DI void operator()(f32x4 (&acc)[2][2][4][2], const pg8::Unit& u, int wr, int wc, int fr, int fq, const UPre&) const {
        const bool isp = u.pm < MP / 256;
        const int chb = u.pn * 128 + wc * 32 + 8 * fq;
        const int rowb = u.pm * 256 + wr * 64 + fr;
        u32x4 vpre[2][4];
#pragma unroll
        for (int ai = 0; ai < 2; ++ai)
#pragma unroll
            for (int m = 0; m < 4; ++m) vpre[ai][m] = *(const u32x4*)(V + (size_t)(rowb + ai * 128 + m * 16) * DM + chb);
#pragma unroll
        for (int n = 0; n < 2; ++n) {
            const f32x4 sp = *(const f32x4*)(lam + chb + 4 * n), ba = *(const f32x4*)(bga + chb + 4 * n), bx = *(const f32x4*)(bgx + chb + 4 * n);
#pragma unroll
            for (int ai = 0; ai < 2; ++ai)
#pragma unroll
                for (int m = 0; m < 4; ++m) {
                    const int row = rowb + ai * 128 + m * 16;
                    const bool pos0 = isp && ((row & (SEQ - 1)) == 0);
                    const unsigned w0 = n == 0 ? vpre[ai][m].x : vpre[ai][m].z, w1 = n == 0 ? vpre[ai][m].y : vpre[ai][m].w;
                    const float v4[4] = {__uint_as_float(w0 << 16), __uint_as_float(w0 & 0xffff0000u), __uint_as_float(w1 << 16), __uint_as_float(w1 & 0xffff0000u)};
#pragma unroll
                    for (int e = 0; e < 4; ++e) {
                        const float r = __builtin_amdgcn_rcpf(1.0f + __builtin_amdgcn_exp2f(-1.4426950408889634f * (acc[ai][0][m][n][e] + ba[e])));
                        const float ig = __builtin_amdgcn_rcpf(1.0f + __builtin_amdgcn_exp2f(-1.4426950408889634f * (acc[ai][1][m][n][e] + bx[e])));
                        const float a = __builtin_amdgcn_exp2f(-r * sp[e]);
                        const float mult = pos0 ? 1.0f : __builtin_amdgcn_sqrtf(fmaxf(1.0f - a * a, 0.0f));
                        acc[ai][0][m][n][e] = a; acc[ai][1][m][n][e] = mult * ig * v4[e];
                    }
                }
        }
        const int fseg = isp ? fr : (fr & 7);
#pragma unroll
        for (int ai = 0; ai < 2; ++ai)
#pragma unroll
            for (int n = 0; n < 2; ++n)
#pragma unroll
                for (int e = 0; e < 4; ++e) {
                    float Ac = 1.0f, Hc = 0.0f;
#pragma unroll
                    for (int m = 0; m < 4; ++m) {
                        float a = acc[ai][0][m][n][e], b = acc[ai][1][m][n][e];
                        scan_step<1>(a, b, fseg); scan_step<2>(a, b, fseg); scan_step<4>(a, b, fseg);
                        if (isp) { scan_step<8>(a, b, fseg); b = a * Hc + b; a = a * Ac; Ac = __int_as_float(__builtin_amdgcn_update_dpp(0, __float_as_int(a), 0x15F, 0xF, 0xF, false)); Hc = __int_as_float(__builtin_amdgcn_update_dpp(0, __float_as_int(b), 0x15F, 0xF, 0xF, false)); }
                        acc[ai][0][m][n][e] = a; acc[ai][1][m][n][e] = b;
                    }
                    if (isp && fr == 15) { float* sm = SUM + ((size_t)(u.pm * 4 + ai * 2 + wr) * DM + chb + 4 * n + e) * 2; sm[0] = Ac; sm[1] = Hc; }
                }
#pragma unroll
        for (int ai = 0; ai < 2; ++ai)
#pragma unroll
            for (int m = 0; m < 4; ++m) {
                const size_t off = (size_t)(rowb + ai * 128 + m * 16) * DM + chb;
                u32x4 oa; oa.x = pk2(acc[ai][0][m][0][0], acc[ai][0][m][0][1]); oa.y = pk2(acc[ai][0][m][0][2], acc[ai][0][m][0][3]); oa.z = pk2(acc[ai][0][m][1][0], acc[ai][0][m][1][1]); oa.w = pk2(acc[ai][0][m][1][2], acc[ai][0][m][1][3]);
                *(u32x4*)(AC + off) = oa;
                u32x4 ob; ob.x = pk2(acc[ai][1][m][0][0], acc[ai][1][m][0][1]); ob.y = pk2(acc[ai][1][m][0][2], acc[ai][1][m][0][3]); ob.z = pk2(acc[ai][1][m][1][0], acc[ai][1][m][1][1]); ob.w = pk2(acc[ai][1][m][1][2], acc[ai][1][m][1][3]);
                *(u32x4*)(HL + off) = ob;
            }
    }
};

DI void gates_sample_item(int item, int w, int lane, const bf16_t* __restrict__ V, const bf16_t* __restrict__ WGATET, const float* __restrict__ bga, const float* __restrict__ bgx, const float* __restrict__ SP8,
                          const bf16_t* __restrict__ GATE, const float* __restrict__ state_lru, bf16_t* __restrict__ YB, float* __restrict__ out) {
    const int p = item >> 3, n = item & 7, l15 = lane & 15, quad = lane >> 4;
    const int row0 = MP + p * 16, jch = 16 * w + l15, ch = 128 * n + jch;
    const bf16_t* ap = V + (size_t)(row0 + l15) * DM + 128 * n + 8 * quad;
    const bf16_t* bpa = WGATET + (size_t)(n * 256 + jch) * 256 + (n & 1) * 128 + 8 * quad;
    const bf16_t* bpx = bpa + (size_t)128 * 256;
    f32x4 ca = {0.f, 0.f, 0.f, 0.f}, cx = {0.f, 0.f, 0.f, 0.f};
#pragma unroll
    for (int st = 0; st < 4; ++st) {
        const bf16x8 a = *(const bf16x8*)(ap + 32 * st), wa = *(const bf16x8*)(bpa + 32 * st), wx = *(const bf16x8*)(bpx + 32 * st);
        ca = __builtin_amdgcn_mfma_f32_16x16x32_bf16(a, wa, ca, 0, 0, 0);
        cx = __builtin_amdgcn_mfma_f32_16x16x32_bf16(a, wx, cx, 0, 0, 0);
    }
    const float ba = bga[ch], bx_ = bgx[ch], sp = SP8[ch];
    const int seq = 2 * p + (quad >> 1), rbase = row0 + 4 * quad;
    float Aq[4], Hq[4], gt[4];
    float Ac = 1.f, Hc = 0.f;
#pragma unroll
    for (int j = 0; j < 4; ++j) {
        const float v = bf2f(V[(size_t)(rbase + j) * DM + ch]); gt[j] = bf2f(GATE[(size_t)(rbase + j) * DM + ch]);
        const float r = __builtin_amdgcn_rcpf(1.0f + __builtin_amdgcn_exp2f(-1.4426950408889634f * (ca[j] + ba)));
        const float ig = __builtin_amdgcn_rcpf(1.0f + __builtin_amdgcn_exp2f(-1.4426950408889634f * (cx[j] + bx_)));
        const float a = __builtin_amdgcn_exp2f(-r * sp);
        const float b = __builtin_amdgcn_sqrtf(fmaxf(1.0f - a * a, 0.0f)) * ig * v;
        Hc = a * Hc + b; Ac = a * Ac; Aq[j] = Ac; Hq[j] = Hc;
    }
    const float h0 = state_lru[(size_t)seq * DM + ch];
    const float pA = __int_as_float(__builtin_amdgcn_ds_bpermute((lane - 16) * 4, __float_as_int(Ac)));
    const float pH = __int_as_float(__builtin_amdgcn_ds_bpermute((lane - 16) * 4, __float_as_int(Hc)));
    const float hin = (quad & 1) ? (pA * h0 + pH) : h0;
#pragma unroll
    for (int j = 0; j < 4; ++j) {
        const float h = Aq[j] * hin + Hq[j];
        YB[(size_t)(rbase + j) * DM + ch] = f2bf(gt[j] * h);
        if ((quad & 1) && j == 3) out[O_LRU_S + (size_t)seq * DM + ch] = h;
    }
}
#define XB_TMO      128
#define XB_XCNT(j)  (256  + 64 * (j))
#define XB_XSUB(j)  (1280 + 64 * (j))
#define XB_XGEN(j)  (2304 + 64 * (j))
#define XB_TOP      3328
#define XB_TOPGEN   3392
#define XCD_BAR_WORDS 3456
#define XB_SPIN_CAP (1u << 18)
DI unsigned xb_ld(unsigned* p)              { return __hip_atomic_load(p, __ATOMIC_RELAXED, __HIP_MEMORY_SCOPE_AGENT); }
DI unsigned xb_add(unsigned* p, unsigned v) { return __hip_atomic_fetch_add(p, v, __ATOMIC_RELAXED, __HIP_MEMORY_SCOPE_AGENT); }
DI unsigned xb_xcc_id() { return (unsigned)__builtin_amdgcn_s_getreg((3 << 11) | 20) & 0xFu; }
#define XB_SPIN(cond, bar) do { unsigned _sp = 0; while (cond) { __builtin_amdgcn_s_sleep(1); \
    if ((++_sp & 255u) == 0u) { if (xb_ld(&(bar)[XB_TMO])) break; if (_sp > XB_SPIN_CAP) { atomicAdd(&(bar)[XB_TMO], 1u); break; } } } } while (0)
struct XcdBarrier { unsigned* bar; unsigned x; volatile LAS unsigned* st; };
DI XcdBarrier xcd_barrier_post(unsigned* bar, volatile LAS unsigned* st) {
    XcdBarrier b; b.bar = bar; b.x = xb_xcc_id(); b.st = st;
    if (threadIdx.x == 0) (void)xb_add(&bar[XB_XCNT(b.x)], 1u);
    return b;
}
DI void xcd_barrier_complete(unsigned* bar, unsigned x, unsigned& nloc, unsigned& nx) {
    const unsigned G = gridDim.x * gridDim.y * gridDim.z;
    unsigned sum, cnt, mine, sp = 0u;
    for (;;) {
        sum = 0u; cnt = 0u; mine = 0u;
#pragma unroll
        for (unsigned j = 0; j < 16; ++j) { const unsigned c = xb_ld(&bar[XB_XCNT(j)]); sum += c; cnt += (c > 0u) ? 1u : 0u; mine = (j == x) ? c : mine; }
        if (sum == G) break;
        __builtin_amdgcn_s_sleep(1);
        if ((++sp & 255u) == 0u) { if (xb_ld(&bar[XB_TMO])) break; if (sp > XB_SPIN_CAP) { atomicAdd(&bar[XB_TMO], 1u); break; } }
    }
    nloc = mine > 0u ? mine : 1u; nx = cnt > 0u ? cnt : 1u;
}
DI void xcd_barrier(const XcdBarrier& b) {
    asm volatile("s_waitcnt vmcnt(0)" ::: "memory");
    __syncthreads();
    if (threadIdx.x == 0) {
        unsigned* bar = b.bar;
        __builtin_amdgcn_s_waitcnt(0);
        unsigned nloc = b.st[0], nx = b.st[1];
        if (nloc == 0u) { xcd_barrier_complete(bar, b.x, nloc, nx); b.st[0] = nloc; b.st[1] = nx; }
        const unsigned old = xb_add(&bar[XB_XSUB(b.x)], 1u);
        const unsigned gen = old / nloc;
        if (old + 1u == (gen + 1u) * nloc) {
            __builtin_amdgcn_fence(__ATOMIC_RELEASE, "agent");
            asm volatile("s_waitcnt vmcnt(0)" ::: "memory");
            const unsigned og = xb_add(&bar[XB_TOP], 1u);
            const unsigned tg = og / nx;
            if (og + 1u == (tg + 1u) * nx) xb_add(&bar[XB_TOPGEN], 1u);
            else XB_SPIN(xb_ld(&bar[XB_TOPGEN]) == tg, bar);
            __builtin_amdgcn_fence(__ATOMIC_ACQUIRE, "agent");
            xb_add(&bar[XB_XGEN(b.x)], 1u);
            asm volatile("s_waitcnt vmcnt(0)" ::: "memory");
        } else {
            XB_SPIN(xb_ld(&bar[XB_XGEN(b.x)]) == gen, bar);
            __builtin_amdgcn_fence(__ATOMIC_ACQUIRE, "agent");
            asm volatile("s_waitcnt vmcnt(0)" ::: "memory");
        }
    }
    __syncthreads();
}

struct Args { const void* in[32]; float* out; unsigned char* ws; int ph_lo, ph_hi; };
static_assert(sizeof(Args) == 32 * 8 + 8 + 8 + 8, "Args has no padding");

DI void p0_transpose_item(const float* __restrict__ W, int lds_, int N, bf16_t* __restrict__ WT, int ldd, const float* __restrict__ gain, LAS float* scr, int item, int lane) {
    const int nblk = N / 32, kb = item / nblk, nb = item % nblk, k0 = 64 * kb, n0 = 32 * nb;
#pragma unroll 8
    for (int i = 0; i < 32; ++i) { const int kk = 2 * i + (lane >> 5); const float gsc = gain ? gain[k0 + kk] : 1.f; scr[kk * 33 + (lane & 31)] = W[(size_t)(k0 + kk) * lds_ + n0 + (lane & 31)] * gsc; }
    asm volatile("s_waitcnt lgkmcnt(0)" ::: "memory");
    const int c = lane & 7;
#pragma unroll
    for (int j = 0; j < 4; ++j) { const int n = (lane >> 3) + 8 * j; const LAS float* s = scr + (8 * c) * 33 + n;
        u32x4 o; o.x = pk2(s[0 * 33], s[1 * 33]); o.y = pk2(s[2 * 33], s[3 * 33]); o.z = pk2(s[4 * 33], s[5 * 33]); o.w = pk2(s[6 * 33], s[7 * 33]);
        *(u32x4*)(WT + (size_t)(n0 + n) * ldd + k0 + 8 * c) = o; }
    asm volatile("s_waitcnt lgkmcnt(0)" ::: "memory");
}
DI void rowprep_load(const float* __restrict__ src, int lane, f32x4 (&v)[4]) {
#pragma unroll
    for (int j = 0; j < 4; ++j) v[j] = ((const f32x4*)src)[lane + 64 * j];
}
DI void rowprep_row(const f32x4 (&v)[4], int row, bf16_t* __restrict__ XB, float* __restrict__ SSQ, int lane) {
    float ss = 0.f;
#pragma unroll
    for (int j = 0; j < 4; ++j) ss += v[j].x * v[j].x + v[j].y * v[j].y + v[j].z * v[j].z + v[j].w * v[j].w;
    ss = wave_sum(ss);
#pragma unroll
    for (int j = 0; j < 4; ++j) { u32x2 o; o.x = pk2(v[j].x, v[j].y); o.y = pk2(v[j].z, v[j].w); ((u32x2*)(XB + (size_t)row * DM))[lane + 64 * j] = o; }
    if (lane < 16) SSQ[(size_t)lane * MT + row] = lane == 0 ? ss : 0.f;
}

DI void unpack4(u32x2 r, float (&x)[4]) { x[0] = __uint_as_float(r.x << 16); x[1] = __uint_as_float(r.x & 0xffff0000u); x[2] = __uint_as_float(r.y << 16); x[3] = __uint_as_float(r.y & 0xffff0000u); }
DI void post0_row(int row, int lane, const bf16_t* __restrict__ Z0, const float* __restrict__ ROPET, const float* __restrict__ g_q_nope, const float* __restrict__ g_q_rope,
                  const float* __restrict__ g_ckv, const float* __restrict__ g_k_rope, bf16_t* __restrict__ QB, bf16_t* __restrict__ CB, bf16_t* __restrict__ KRB, float* __restrict__ out) {
    const bf16_t* z = Z0 + (size_t)row * NZ0;
    const bool isp = row < MP; const int pidx = isp ? (row & (SEQ - 1)) : SEQ + ((row - MP) & 7);
    { const int d = 4 * (lane & 15); const f32x4 g4 = *(const f32x4*)(g_q_nope + d);
#pragma unroll
      for (int hh = 0; hh < 2; ++hh) {
        const int h = 4 * hh + (lane >> 4); float x[4]; unpack4(*(const u32x2*)(z + POOLD + QKH * h + d), x);
        float ss = x[0] * x[0] + x[1] * x[1] + x[2] * x[2] + x[3] * x[3];
        ss = sum16(ss);
        const float ri = rsqrtf(ss * (1.f / 64.f) + EPS) * QSCALE;
        u32x2 o; o.x = pk2(x[0] * ri * g4.x, x[1] * ri * g4.y); o.y = pk2(x[2] * ri * g4.z, x[3] * ri * g4.w);
        *(u32x2*)(QB + (size_t)row * QDIM + QKH * h + d) = o; } }
    { const int r = 4 * (lane & 7), i0 = r & 15; const bool second = (lane & 4) != 0;
      const f32x4 t0 = *(const f32x4*)(ROPET + ((size_t)pidx * 16 + i0) * 2), t1 = *(const f32x4*)(ROPET + ((size_t)pidx * 16 + i0) * 2 + 4);
      const float cs[4] = {t0.x, t0.z, t1.x, t1.z}, sn[4] = {t0.y, t0.w, t1.y, t1.w};
      { const int h = lane >> 3; float x[4]; unpack4(*(const u32x2*)(z + POOLD + QKH * h + 64 + r), x);
        float ss = x[0] * x[0] + x[1] * x[1] + x[2] * x[2] + x[3] * x[3];
        ss = sum8(ss);
        const float ri = rsqrtf(ss * (1.f / 32.f) + EPS); const f32x4 g4 = *(const f32x4*)(g_q_rope + r);
        float y[4] = {x[0] * ri * g4.x, x[1] * ri * g4.y, x[2] * ri * g4.z, x[3] * ri * g4.w}, o[4];
#pragma unroll
        for (int e = 0; e < 4; ++e) { const float p = xchg4(y[e], second); o[e] = (second ? (p * sn[e] + y[e] * cs[e]) : (y[e] * cs[e] - p * sn[e])) * QSCALE; }
        u32x2 w; w.x = pk2(o[0], o[1]); w.y = pk2(o[2], o[3]); *(u32x2*)(QB + (size_t)row * QDIM + QKH * h + 64 + r) = w; }
      { float x[4]; unpack4(*(const u32x2*)(z + POOLD + QDIM + KVR + r), x);
        float ss = x[0] * x[0] + x[1] * x[1] + x[2] * x[2] + x[3] * x[3];
        ss = sum8(ss);
        const float ri = rsqrtf(ss * (1.f / 32.f) + EPS); const f32x4 g4 = *(const f32x4*)(g_k_rope + r);
        float y[4] = {x[0] * ri * g4.x, x[1] * ri * g4.y, x[2] * ri * g4.z, x[3] * ri * g4.w}; f32x4 o;
#pragma unroll
        for (int e = 0; e < 4; ++e) { const float p = xchg4(y[e], second); o[e] = second ? (p * sn[e] + y[e] * cs[e]) : (y[e] * cs[e] - p * sn[e]); }
        if (lane < 8) { u32x2 w; w.x = pk2(o[0], o[1]); w.y = pk2(o[2], o[3]); *(u32x2*)(KRB + (size_t)row * ROPE + r) = w;
            float* ko = isp ? out + O_KR_P + (size_t)row * ROPE : out + O_KR_S + (size_t)(row - MP) * ROPE; *(f32x4*)(ko + r) = o; } } }
    { float x[4]; unpack4(*(const u32x2*)(z + POOLD + QDIM + lane * 4), x);
      float ss = wave_sum(x[0] * x[0] + x[1] * x[1] + x[2] * x[2] + x[3] * x[3]); const float ri = rsqrtf(ss * (1.f / 256.f) + EPS);
      const f32x4 g4 = *(const f32x4*)(g_ckv + lane * 4);
      f32x4 y; y.x = x[0] * ri * g4.x; y.y = x[1] * ri * g4.y; y.z = x[2] * ri * g4.z; y.w = x[3] * ri * g4.w;
      u32x2 o; o.x = pk2(y.x, y.y); o.y = pk2(y.z, y.w); *(u32x2*)(CB + (size_t)row * KVR + lane * 4) = o;
      float* co = isp ? out + O_CKV_P + (size_t)row * KVR : out + O_CKV_S + (size_t)(row - MP) * KVR; *(f32x4*)(co + lane * 4) = y; }
}
DI void load8(const bf16_t* p, float (&x)[8]) { const u32x4 r = *(const u32x4*)p;
#pragma unroll
    for (int e = 0; e < 4; ++e) { x[2 * e] = __uint_as_float(r[e] << 16); x[2 * e + 1] = __uint_as_float(r[e] & 0xffff0000u); } }
template <bool ISP> DI void pool_item(int row0, int nrows, int ch, const bf16_t* __restrict__ Z0, const float* __restrict__ state_pool, bf16_t* __restrict__ DBuf, float* __restrict__ out) {
    const int w = 2 << (ch >> 7);
    const int t0 = ISP ? (row0 & (SEQ - 1)) : 0, bb = ISP ? (row0 >> 12) : ((row0 - MP) >> 3);
    float S[8];
#pragma unroll
    for (int e = 0; e < 8; ++e) S[e] = 0.f;
    for (int j = 1; j < w; ++j) { const int tj = t0 - j; float x[8];
        if (tj >= 0) { load8(Z0 + (size_t)(row0 - j) * NZ0 + ch, x); }
        else if (!ISP) { const float* hp = state_pool + ((size_t)bb * 15 + (15 + tj)) * POOLD + ch; const f32x4 a = *(const f32x4*)hp, b = *(const f32x4*)(hp + 4); x[0] = a.x; x[1] = a.y; x[2] = a.z; x[3] = a.w; x[4] = b.x; x[5] = b.y; x[6] = b.z; x[7] = b.w; }
        else {
#pragma unroll
            for (int e = 0; e < 8; ++e) x[e] = 0.f; }
#pragma unroll
        for (int e = 0; e < 8; ++e) S[e] += x[e]; }
    for (int i = 0; i < nrows; ++i) {
        const int t = t0 + i, row = row0 + i; float u[8]; load8(Z0 + (size_t)row * NZ0 + ch, u);
        const float icnt = 1.0f / (ISP ? (float)((t + 1) < w ? (t + 1) : w) : (float)w);
        u32x4 o;
#pragma unroll
        for (int e = 0; e < 8; ++e) S[e] += u[e];
#pragma unroll
        for (int e = 0; e < 4; ++e) o[e] = pk2(S[2 * e] * icnt - u[2 * e], S[2 * e + 1] * icnt - u[2 * e + 1]);
        *(u32x4*)(DBuf + (size_t)row * POOLD + ch) = o;
        { const int tj = t - w + 1; float x[8];
          if (tj >= 0) { load8(Z0 + (size_t)(row - w + 1) * NZ0 + ch, x); }
          else if (!ISP) { const float* hp = state_pool + ((size_t)bb * 15 + (15 + tj)) * POOLD + ch; const f32x4 a = *(const f32x4*)hp, b = *(const f32x4*)(hp + 4); x[0] = a.x; x[1] = a.y; x[2] = a.z; x[3] = a.w; x[4] = b.x; x[5] = b.y; x[6] = b.z; x[7] = b.w; }
          else {
#pragma unroll
              for (int e = 0; e < 8; ++e) x[e] = 0.f; }
#pragma unroll
          for (int e = 0; e < 8; ++e) S[e] -= x[e]; }
        if (ISP) { if (t >= SEQ - 15) { float* op = out + O_POOL_P + ((size_t)bb * 15 + (t - (SEQ - 15))) * POOLD + ch; *(f32x4*)op = (f32x4){u[0], u[1], u[2], u[3]}; *(f32x4*)(op + 4) = (f32x4){u[4], u[5], u[6], u[7]}; } }
        else { float* op = out + O_POOL_S + ((size_t)bb * 15 + 7 + t) * POOLD + ch; *(f32x4*)op = (f32x4){u[0], u[1], u[2], u[3]}; *(f32x4*)(op + 4) = (f32x4){u[4], u[5], u[6], u[7]}; }
    }
    if (!ISP) { for (int i = 0; i < 7; ++i) { const float* hp = state_pool + ((size_t)bb * 15 + 8 + i) * POOLD + ch; float* op = out + O_POOL_S + ((size_t)bb * 15 + i) * POOLD + ch; *(f32x4*)op = *(const f32x4*)hp; *(f32x4*)(op + 4) = *(const f32x4*)(hp + 4); } }
}
DI void pool_item_p16(int row0, int ch, const bf16_t* __restrict__ Z0, bf16_t* __restrict__ DBuf, float* __restrict__ out) {
    const int w = 2 << (ch >> 7);
    const int t0 = row0 & (SEQ - 1), bb = row0 >> 12;
    const bf16_t* zb = Z0 + (size_t)row0 * NZ0 + ch;
    float S[8];
#pragma unroll
    for (int e = 0; e < 8; ++e) S[e] = 0.f;
#pragma unroll
    for (int j = 1; j < 16; ++j) { const bool ok = (j < w) && (t0 - j >= 0); float x[8]; load8(zb - (ok ? j : 0) * NZ0, x); const float mk = ok ? 1.f : 0.f;
#pragma unroll
        for (int e = 0; e < 8; ++e) S[e] += mk * x[e]; }
#pragma unroll
    for (int i = 0; i < 16; ++i) {
        const int t = t0 + i; float u[8], x[8]; load8(zb + i * NZ0, u);
        const bool ok = t - w + 1 >= 0; load8(zb + (i - (ok ? w - 1 : 0)) * NZ0, x); const float mk = ok ? 1.f : 0.f;
        const float icnt = 1.0f / (float)((t + 1) < w ? (t + 1) : w);
        u32x4 o;
#pragma unroll
        for (int e = 0; e < 8; ++e) S[e] += u[e];
#pragma unroll
        for (int e = 0; e < 4; ++e) o[e] = pk2(S[2 * e] * icnt - u[2 * e], S[2 * e + 1] * icnt - u[2 * e + 1]);
        *(u32x4*)(DBuf + (size_t)(row0 + i) * POOLD + ch) = o;
#pragma unroll
        for (int e = 0; e < 8; ++e) S[e] -= mk * x[e];
    }
    if (t0 == SEQ - 16) {
        for (int i = 1; i < 16; ++i) { float u[8]; load8(zb + i * NZ0, u);
            float* op = out + O_POOL_P + ((size_t)bb * 15 + (i - 1)) * POOLD + ch; *(f32x4*)op = (f32x4){u[0], u[1], u[2], u[3]}; *(f32x4*)(op + 4) = (f32x4){u[4], u[5], u[6], u[7]}; } }
}
template <bool ISP> DI void conv_item(int row0, int nrows, int ch, const bf16_t* __restrict__ U, const float* __restrict__ state_conv, const float* __restrict__ conv_w, const float* __restrict__ conv_b,
                                      bf16_t* __restrict__ V, float* __restrict__ out) {
    const int t0 = ISP ? (row0 & (SEQ - 1)) : 0, bb = ISP ? (row0 >> 12) : ((row0 - MP) >> 3);
    float wk[4][8], bs[8], hist[3][8];
#pragma unroll
    for (int k = 0; k < 4; ++k) { const f32x4 a = *(const f32x4*)(conv_w + k * DM + ch), b = *(const f32x4*)(conv_w + k * DM + ch + 4); wk[k][0] = a.x; wk[k][1] = a.y; wk[k][2] = a.z; wk[k][3] = a.w; wk[k][4] = b.x; wk[k][5] = b.y; wk[k][6] = b.z; wk[k][7] = b.w; }
    { const f32x4 a = *(const f32x4*)(conv_b + ch), b = *(const f32x4*)(conv_b + ch + 4); bs[0] = a.x; bs[1] = a.y; bs[2] = a.z; bs[3] = a.w; bs[4] = b.x; bs[5] = b.y; bs[6] = b.z; bs[7] = b.w; }
#pragma unroll
    for (int j = 0; j < 3; ++j) {
        const int tj = t0 - 3 + j;
        if (tj >= 0) load8(U + (size_t)(row0 - 3 + j) * DM + ch, hist[j]);
        else if (!ISP) { const float* hp = state_conv + ((size_t)bb * 3 + (3 + tj)) * DM + ch; const f32x4 a = *(const f32x4*)hp, b = *(const f32x4*)(hp + 4); hist[j][0] = a.x; hist[j][1] = a.y; hist[j][2] = a.z; hist[j][3] = a.w; hist[j][4] = b.x; hist[j][5] = b.y; hist[j][6] = b.z; hist[j][7] = b.w; }
        else {
#pragma unroll
            for (int e = 0; e < 8; ++e) hist[j][e] = 0.f; }
    }
    for (int i = 0; i < nrows; ++i) {
        const int t = t0 + i, row = row0 + i; float u[8]; load8(U + (size_t)row * DM + ch, u);
        u32x4 o; float v[8];
#pragma unroll
        for (int e = 0; e < 8; ++e) v[e] = bs[e] + hist[0][e] * wk[0][e] + hist[1][e] * wk[1][e] + hist[2][e] * wk[2][e] + u[e] * wk[3][e];
#pragma unroll
        for (int e = 0; e < 4; ++e) o[e] = pk2(v[2 * e], v[2 * e + 1]);
        *(u32x4*)(V + (size_t)row * DM + ch) = o;
#pragma unroll
        for (int e = 0; e < 8; ++e) { hist[0][e] = hist[1][e]; hist[1][e] = hist[2][e]; hist[2][e] = u[e]; }
        const int tl = ISP ? SEQ - 3 : DT - 3;
        if (t >= tl) { float* op = out + (ISP ? O_CONV_P : O_CONV_S) + ((size_t)bb * 3 + (t - tl)) * DM + ch; *(f32x4*)op = (f32x4){u[0], u[1], u[2], u[3]}; *(f32x4*)(op + 4) = (f32x4){u[4], u[5], u[6], u[7]}; }
    }
}

DI void conv_item_p16(int row0, int ch, const bf16_t* __restrict__ U, const float* __restrict__ conv_w, const float* __restrict__ conv_b, bf16_t* __restrict__ V, float* __restrict__ out) {
    const int t0 = row0 & (SEQ - 1), bb = row0 >> 12;
    const bf16_t* ub = U + (size_t)row0 * DM + ch;
    u32x4 raw[19];
#pragma unroll
    for (int j = 0; j < 19; ++j) raw[j] = *(const u32x4*)(ub + (j - 3 >= 0 || t0 > 0 ? (j - 3) : 0) * DM);
    float wk[4][8], bs[8];
#pragma unroll
    for (int k = 0; k < 4; ++k) { const f32x4 a = *(const f32x4*)(conv_w + k * DM + ch), b = *(const f32x4*)(conv_w + k * DM + ch + 4); wk[k][0] = a.x; wk[k][1] = a.y; wk[k][2] = a.z; wk[k][3] = a.w; wk[k][4] = b.x; wk[k][5] = b.y; wk[k][6] = b.z; wk[k][7] = b.w; }
    { const f32x4 a = *(const f32x4*)(conv_b + ch), b = *(const f32x4*)(conv_b + ch + 4); bs[0] = a.x; bs[1] = a.y; bs[2] = a.z; bs[3] = a.w; bs[4] = b.x; bs[5] = b.y; bs[6] = b.z; bs[7] = b.w; }
    const float hm = t0 > 0 ? 1.f : 0.f;
    float x[4][8];
#pragma unroll
    for (int j = 0; j < 3; ++j)
#pragma unroll
        for (int e = 0; e < 4; ++e) { x[j][2 * e] = hm * __uint_as_float(raw[j][e] << 16); x[j][2 * e + 1] = hm * __uint_as_float(raw[j][e] & 0xffff0000u); }
#pragma unroll
    for (int i = 0; i < 16; ++i) {
#pragma unroll
        for (int e = 0; e < 4; ++e) { x[3][2 * e] = __uint_as_float(raw[3 + i][e] << 16); x[3][2 * e + 1] = __uint_as_float(raw[3 + i][e] & 0xffff0000u); }
        u32x4 o; float v[8];
#pragma unroll
        for (int e = 0; e < 8; ++e) v[e] = bs[e] + x[0][e] * wk[0][e] + x[1][e] * wk[1][e] + x[2][e] * wk[2][e] + x[3][e] * wk[3][e];
#pragma unroll
        for (int e = 0; e < 4; ++e) o[e] = pk2(v[2 * e], v[2 * e + 1]);
        *(u32x4*)(V + (size_t)(row0 + i) * DM + ch) = o;
#pragma unroll
        for (int e = 0; e < 8; ++e) { x[0][e] = x[1][e]; x[1][e] = x[2][e]; x[2][e] = x[3][e]; }
    }
    if (t0 == SEQ - 16) {
#pragma unroll
        for (int i = 13; i < 16; ++i) { float* op = out + O_CONV_P + ((size_t)bb * 3 + (i - 13)) * DM + ch;
            *(f32x4*)op = (f32x4){__uint_as_float(raw[3 + i][0] << 16), __uint_as_float(raw[3 + i][0] & 0xffff0000u), __uint_as_float(raw[3 + i][1] << 16), __uint_as_float(raw[3 + i][1] & 0xffff0000u)};
            *(f32x4*)(op + 4) = (f32x4){__uint_as_float(raw[3 + i][2] << 16), __uint_as_float(raw[3 + i][2] & 0xffff0000u), __uint_as_float(raw[3 + i][3] << 16), __uint_as_float(raw[3 + i][3] & 0xffff0000u)}; } }
}

DI void attn_p_naive_item(int item, int lane, LAS float* sc, const bf16_t* __restrict__ QB, const bf16_t* __restrict__ KV, const bf16_t* __restrict__ KRB, bf16_t* __restrict__ MIX) {
    LAS float* qs = sc + SEQ;
    const int row = item >> 3, h = item & 7, b = row >> 12, t = row & (SEQ - 1);
    for (int i = lane; i < QKH; i += 64) qs[i] = bf2f(QB[(size_t)row * QDIM + h * QKH + i]);
    asm volatile("s_waitcnt lgkmcnt(0)" ::: "memory");
    float mx = -INFINITY;
    for (int j0 = 0; j0 <= t; j0 += 64) {
        const int j = j0 + lane;
        if (j <= t) {
            const bf16_t* kr = KV + (size_t)(b * SEQ + j) * 1024 + h * 64; const bf16_t* rr = KRB + (size_t)(b * SEQ + j) * ROPE;
            float s = 0.f;
            for (int d = 0; d < 64; ++d) s += qs[d] * bf2f(kr[d]);
            for (int d = 0; d < 32; ++d) s += qs[64 + d] * bf2f(rr[d]);
            sc[j] = s; mx = fmaxf(mx, s);
        }
    }
    mx = wave_max(mx);
    float sum = 0.f;
    for (int j = lane; j <= t; j += 64) { const float p = exp2f(sc[j] - mx); sc[j] = p; sum += p; }
    sum = wave_sum(sum);
    asm volatile("s_waitcnt lgkmcnt(0)" ::: "memory");
    float acc = 0.f;
    for (int j = 0; j <= t; ++j) acc += sc[j] * bf2f(KV[(size_t)(b * SEQ + j) * 1024 + 512 + h * 64 + lane]);
    MIX[(size_t)row * DM + 512 + h * 64 + lane] = (bf16_t)f2bf(acc / sum);
    asm volatile("s_waitcnt lgkmcnt(0)" ::: "memory");
}


typedef short v4i16_t __attribute__((ext_vector_type(4)));
DI int crow(int r, int hi) { return (r & 3) + 8 * (r >> 2) + 4 * hi; }
constexpr int AP_KS = 12288, AP_VS = 8192, AP_LK = 0, AP_LV = 2 * AP_KS;
DI void attn_p_unit(int b, int h, int qb, LAS unsigned char* lds, const bf16_t* __restrict__ QB, const bf16_t* __restrict__ KV, const bf16_t* __restrict__ KRB, bf16_t* __restrict__ MIX) {
    const int tid = threadIdx.x, lane = tid & 63, r32 = lane & 31, hi = lane >> 5, wid = __builtin_amdgcn_readfirstlane(tid >> 6);
    const int rowbase = b * SEQ, q0 = qb * 256, NT = 4 * (qb + 1);
    const bf16_t* ksrc0 = KV + (size_t)(rowbase + lane) * 1024 + h * 64 + wid * 8;
    const bf16_t* ksrc1 = KRB + (size_t)(rowbase + lane) * ROPE + (wid & 3) * 8;
    const bf16_t* vsrc = KV + (size_t)(rowbase + 16 * (wid & 3) + (lane >> 2)) * 1024 + 512 + h * 64 + (wid >> 2) * 32 + (lane & 3) * 8;
#define AP_DMA(t, slot) do { \
        __builtin_amdgcn_global_load_lds((const unsigned*)(ksrc0 + (size_t)(t) * 64 * 1024), (LAS unsigned*)(lds + AP_LK + (slot) * AP_KS + wid * 1024), 16, 0, 0); \
        if (wid < 4) __builtin_amdgcn_global_load_lds((const unsigned*)(ksrc1 + (size_t)(t) * 64 * ROPE), (LAS unsigned*)(lds + AP_LK + (slot) * AP_KS + (8 + wid) * 1024), 16, 0, 0); \
        __builtin_amdgcn_global_load_lds((const unsigned*)(vsrc + (size_t)(t) * 64 * 1024), (LAS unsigned*)(lds + AP_LV + (slot) * AP_VS + wid * 1024), 16, 0, 0); } while (0)
    AP_DMA(0, 0);
    bf16x8 qr[6];
    { const bf16_t* qw = QB + (size_t)(rowbase + q0 + wid * 32 + r32) * QDIM + h * QKH + hi * 8;
#pragma unroll
      for (int d0 = 0; d0 < 6; ++d0) qr[d0] = *(const bf16x8*)(qw + d0 * 16); }
    float m = 0.f, l = 0.f;
    f32x16 o0, o1, negm;
#pragma unroll
    for (int r = 0; r < 16; ++r) { o0[r] = 0.f; o1[r] = 0.f; negm[r] = 0.f; }
    const int qrel = wid * 32 + r32;
    const int voff = (4 * hi + ((lane & 15) >> 2)) * 64 + ((lane >> 4) & 1) * 32 + (lane & 3) * 8;
    for (int t = 0; t < NT; ++t) {
        asm volatile("s_waitcnt vmcnt(0)" ::: "memory"); __builtin_amdgcn_s_barrier(); asm volatile("" ::: "memory");
        if (t + 1 < NT) AP_DMA(t + 1, (t + 1) & 1);
        const int slot = t & 1, trel = t - (NT - 4);
        if (trel < 0 || 64 * trel <= 32 * wid + 31) {
            const LAS unsigned char* kb = lds + AP_LK + slot * AP_KS + hi * 1024 + r32 * 16;
            f32x16 p0, p1;
            __builtin_amdgcn_s_setprio(1);
#pragma unroll
            for (int d0 = 0; d0 < 6; ++d0) {
                const bf16x8 k0 = *(const LAS bf16x8*)(kb + d0 * 2048), k1 = *(const LAS bf16x8*)(kb + d0 * 2048 + 512);
                p0 = __builtin_amdgcn_mfma_f32_32x32x16_bf16(k0, qr[d0], d0 == 0 ? negm : p0, 0, 0, 0);
                p1 = __builtin_amdgcn_mfma_f32_32x32x16_bf16(k1, qr[d0], d0 == 0 ? negm : p1, 0, 0, 0);
            }
            __builtin_amdgcn_s_setprio(0);
            if (trel >= 0) {
#pragma unroll
                for (int r = 0; r < 16; ++r) { const int kp = 64 * trel + crow(r, hi); if (kp > qrel) p0[r] = -INFINITY; if (kp + 32 > qrel) p1[r] = -INFINITY; }
            }
            float mx = max3f(p0[0], p1[0], p0[1]);
#pragma unroll
            for (int r = 1; r < 16; ++r) mx = (r < 15) ? max3f(mx, p1[r], p0[r + 1]) : fmaxf(mx, p1[r]);
            mx = xmax32(mx);
            float ps = 0.f;
#pragma unroll
            for (int r = 0; r < 16; ++r) { p0[r] = __builtin_amdgcn_exp2f(p0[r]); p1[r] = __builtin_amdgcn_exp2f(p1[r]); ps += p0[r] + p1[r]; }
            l += ps;
            const LAS unsigned char* vb = lds + AP_LV + slot * AP_VS + voff;
            __builtin_amdgcn_s_setprio(1);
#pragma unroll
            for (int ks = 0; ks < 4; ++ks) {
                u32x4 pw;
                if (ks < 2) { pw.x = cvtpk(p0[8 * ks], p0[8 * ks + 1]); pw.y = cvtpk(p0[8 * ks + 2], p0[8 * ks + 3]); pw.z = cvtpk(p0[8 * ks + 4], p0[8 * ks + 5]); pw.w = cvtpk(p0[8 * ks + 6], p0[8 * ks + 7]); }
                else { const int s8 = 8 * (ks - 2); pw.x = cvtpk(p1[s8], p1[s8 + 1]); pw.y = cvtpk(p1[s8 + 2], p1[s8 + 3]); pw.z = cvtpk(p1[s8 + 4], p1[s8 + 5]); pw.w = cvtpk(p1[s8 + 6], p1[s8 + 7]); }
                const bf16x8 pa = __builtin_bit_cast(bf16x8, pw);
#pragma unroll
                for (int db = 0; db < 2; ++db) {
                    const v4i16_t lo = __builtin_amdgcn_ds_read_tr16_b64_v4i16((LAS v4i16_t*)(vb + db * 4096 + ks * 1024));
                    const v4i16_t hh = __builtin_amdgcn_ds_read_tr16_b64_v4i16((LAS v4i16_t*)(vb + db * 4096 + ks * 1024 + 512));
                    const bf16x8 vf = (bf16x8){lo[0], lo[1], lo[2], lo[3], hh[0], hh[1], hh[2], hh[3]};
                    if (db == 0) o0 = __builtin_amdgcn_mfma_f32_32x32x16_bf16(vf, pa, o0, 0, 0, 0);
                    else o1 = __builtin_amdgcn_mfma_f32_32x32x16_bf16(vf, pa, o1, 0, 0, 0);
                }
            }
            __builtin_amdgcn_s_setprio(0);
            const float mn = (t == 0) ? mx : fmaxf(mx, 0.f);
            if (__any(mn != 0.f)) {
                const float f = __builtin_amdgcn_exp2f(-mn); l *= f; m += mn;
#pragma unroll
                for (int r = 0; r < 16; ++r) { o0[r] *= f; o1[r] *= f; negm[r] = -m; }
            }
        }
    }
    l = xsum32(l);
    const float il = 1.0f / l;
    bf16_t* orow = MIX + (size_t)(rowbase + q0 + wid * 32 + r32) * DM + 512 + h * 64 + 4 * hi;
#pragma unroll
    for (int g = 0; g < 4; ++g) {
        u32x2 a; a.x = cvtpk(o0[4 * g] * il, o0[4 * g + 1] * il); a.y = cvtpk(o0[4 * g + 2] * il, o0[4 * g + 3] * il); *(u32x2*)(orow + 8 * g) = a;
        u32x2 c; c.x = cvtpk(o1[4 * g] * il, o1[4 * g + 1] * il); c.y = cvtpk(o1[4 * g + 2] * il, o1[4 * g + 3] * il); *(u32x2*)(orow + 32 + 8 * g) = c;
    }
#undef AP_DMA
}


constexpr int SA_CB_ROW = 576, SA_CB_SZ = 64 * SA_CB_ROW;
constexpr int SA_C8_ROW = 272, SA_C8_SZ = 64 * SA_C8_ROW;
constexpr int SA_KR_ROW = 96, SA_KR_SZ = 64 * SA_KR_ROW;
constexpr int SA_CB = 0, SA_C8 = 2 * SA_CB_SZ, SA_KRB = SA_C8 + 2 * SA_C8_SZ;
constexpr int SA_P = SA_KRB + 2 * SA_KR_SZ, SA_P_ROW = 144;
constexpr int SA_QF = SA_P + 64 * SA_P_ROW;
constexpr int SA_F = SA_QF + 8 * 3 * 4 * 8 * 16;
constexpr int SA_END = SA_F + 256;
static_assert(SA_END <= LDS_MISC, "sample attention LDS map");
DI int sa_swz(int x) { return (0x78 >> (2 * x)) & 3; }
DI int sa_g8(int x) { return (0x28 >> (2 * x)) & 3; }
typedef int v8i_t __attribute__((ext_vector_type(8)));
typedef float f32x4v __attribute__((ext_vector_type(4)));

template <int VAR> DI void attn_s_unit(int unit, LAS unsigned char* lds, const float* __restrict__ cache_ckv, const float* __restrict__ cache_kr, const int* __restrict__ page_table, const bf16_t* __restrict__ QB,
                    const bf16_t* __restrict__ WKVT, const float* __restrict__ g_k_nope, float* __restrict__ LATP, float* __restrict__ ML) {
    constexpr int hot = VAR != 0;
    const int tid = threadIdx.x, lane = tid & 63, r32 = lane & 31, hi = lane >> 5, l15 = lane & 15, quad = lane >> 4, w = __builtin_amdgcn_readfirstlane(tid >> 6);
    const int sb = unit >> 1, split = unit & 1;
    const int* pt = page_table + sb * NPAGES + split * 32;
    for (int e = tid; e < 8 * 3 * 4 * 8; e += NTHR) {
        const int q = e & 7, qd = (e >> 3) & 3, st = (e >> 5) % 3, h = e / 96;
        const bf16_t* qp = QB + (size_t)(MP + sb * DT + q) * QDIM + h * QKH;
        unsigned pk[4];
#pragma unroll
        for (int jj = 0; jj < 4; ++jj) {
            float v0, v1;
            if (st < 2) { const int j0 = 2 * jj, j1 = 2 * jj + 1; const int d0 = 32 * st + 16 * (j0 >> 2) + 4 * qd + (j0 & 3), d1 = 32 * st + 16 * (j1 >> 2) + 4 * qd + (j1 & 3); v0 = bf2f(qp[d0]) * g_k_nope[d0]; v1 = bf2f(qp[d1]) * g_k_nope[d1]; }
            else { const int r0 = 8 * qd + 2 * jj; v0 = bf2f(qp[64 + r0]); v1 = bf2f(qp[64 + r0 + 1]); }
            pk[jj] = pk2(v0, v1);
        }
        *(LAS u32x4*)(lds + SA_QF + e * 16) = (u32x4){pk[0], pk[1], pk[2], pk[3]};
    }
    v8i_t wf[4][2];
#pragma unroll
    for (int db = 0; db < 4; ++db)
#pragma unroll
        for (int ch = 0; ch < 2; ++ch) {
            const bf16_t* wp = WKVT + (size_t)(w * 64 + 16 * db + l15) * KVR + 128 * ch + 32 * quad;
#pragma unroll
            for (int i = 0; i < 4; ++i) { const u32x4 r = *(const u32x4*)(wp + 8 * i); int lo = 0, hi2 = 0;
                lo = __builtin_amdgcn_cvt_pk_fp8_f32(__uint_as_float(r.x << 16) * 16.f, __uint_as_float(r.x & 0xffff0000u) * 16.f, lo, false);
                lo = __builtin_amdgcn_cvt_pk_fp8_f32(__uint_as_float(r.y << 16) * 16.f, __uint_as_float(r.y & 0xffff0000u) * 16.f, lo, true);
                hi2 = __builtin_amdgcn_cvt_pk_fp8_f32(__uint_as_float(r.z << 16) * 16.f, __uint_as_float(r.z & 0xffff0000u) * 16.f, hi2, false);
                hi2 = __builtin_amdgcn_cvt_pk_fp8_f32(__uint_as_float(r.w << 16) * 16.f, __uint_as_float(r.w & 0xffff0000u) * 16.f, hi2, true);
                wf[db][ch][2 * i] = lo; wf[db][ch][2 * i + 1] = hi2; }
        }
    const __amdgpu_buffer_rsrc_t rs_c = __builtin_amdgcn_make_buffer_rsrc((void*)cache_ckv, (short)0, (int)((size_t)(NPAGES * DB_ + NPAGES * DB_ / 4) * PAGE * KVR * 4), 0x00020000);
    const __amdgpu_buffer_rsrc_t rs_k = __builtin_amdgcn_make_buffer_rsrc((void*)cache_kr, (short)0, (int)((size_t)(NPAGES * DB_ + NPAGES * DB_ / 4) * PAGE * ROPE * 4), 0x00020000);
    const int dma_voff = lane * 16;
    u32x4 pf[9];
#define SA_LOAD(t) do { const unsigned prow = (unsigned)__builtin_amdgcn_readfirstlane(pt[hot ? 0 : ((t) >> 1)]) * PAGE + 64 * ((t) & 1) + 8 * w; \
        _Pragma("unroll") for (int i = 0; i < 8; ++i) pf[i] = __builtin_amdgcn_raw_buffer_load_b128(rs_c, dma_voff, (prow + i) * (KVR * 4), 0); \
        pf[8] = __builtin_amdgcn_raw_buffer_load_b128(rs_k, dma_voff, prow * (ROPE * 4), 0); } while (0)
    SA_LOAD(0);
    float m = 0.f, negm = 0.f, l = 0.f;
    f32x16 lat0, lat1;
#pragma unroll
    for (int r = 0; r < 16; ++r) { lat0[r] = 0.f; lat1[r] = 0.f; }
    const bool qreal = l15 < 8;
    const int g8_ = sa_g8((l15 >> 2) & 3);
    const LAS unsigned char* c8a0 = lds + SA_C8 + l15 * SA_C8_ROW + (((2 * quad) ^ g8_) * 16);
    const LAS unsigned char* c8b0 = lds + SA_C8 + l15 * SA_C8_ROW + (((2 * quad + 1) ^ g8_) * 16);
    const LAS unsigned char* qfbase = lds + SA_QF + (((w * 3) * 4 + quad) * 8 + (l15 & 7)) * 16;
    const LAS unsigned char* krbase0 = lds + SA_KRB + l15 * SA_KR_ROW + quad * 16;
    LAS unsigned char* pwbase = lds + SA_P + (8 * w + l15) * SA_P_ROW + quad * 8;
    asm volatile("s_waitcnt lgkmcnt(0)" ::: "memory"); __builtin_amdgcn_s_barrier(); asm volatile("" ::: "memory");
    bf16x8 q0 = *(const LAS bf16x8*)(qfbase), q1 = *(const LAS bf16x8*)(qfbase + 512), q2 = *(const LAS bf16x8*)(qfbase + 1024);
    if (!qreal) { q0 = (bf16x8){0, 0, 0, 0, 0, 0, 0, 0}; q1 = q0; q2 = q0; }
    LAS unsigned char* cvw0 = lds + SA_CB + 8 * w * SA_CB_ROW + (((lane >> 1) ^ sa_swz((2 * w) & 3)) * 16) + (lane & 1) * 8;
    LAS unsigned char* cvw1 = lds + SA_CB + 8 * w * SA_CB_ROW + (((lane >> 1) ^ sa_swz((2 * w + 1) & 3)) * 16) + (lane & 1) * 8;
    LAS unsigned char* c8w0 = lds + SA_C8 + 8 * w * SA_C8_ROW + (((lane >> 2) ^ sa_g8((2 * w) & 3)) * 16) + (lane & 3) * 4;
    LAS unsigned char* c8w1 = lds + SA_C8 + 8 * w * SA_C8_ROW + (((lane >> 2) ^ sa_g8((2 * w + 1) & 3)) * 16) + (lane & 3) * 4;
    LAS unsigned char* krw = lds + SA_KRB + (8 * w + (lane >> 3)) * SA_KR_ROW + (lane & 7) * 8;
    const int kr0 = 8 * hi + (l15 >> 2), cc0 = 4 * w + 2 * ((lane >> 4) & 1) + ((lane & 3) >> 1);
    const LAS unsigned char* trlo = lds + SA_CB + kr0 * SA_CB_ROW + ((cc0 ^ (hi ? 3 : 0)) * 16) + (lane & 1) * 8;
    const LAS unsigned char* trhi = lds + SA_CB + (kr0 + 4) * SA_CB_ROW + ((cc0 ^ (hi ? 1 : 2)) * 16) + (lane & 1) * 8;
    const LAS unsigned char* prd = lds + SA_P + r32 * SA_P_ROW + hi * 16;
    const LAS float* frd = (const LAS float*)(lds + SA_F + r32 * 4);
    for (int t2 = 0; t2 < 64; t2 += 2) {
#pragma unroll
      for (int tb = 0; tb < 2; ++tb) {
        const int t = t2 + tb;
        asm volatile("s_waitcnt vmcnt(0)" ::: "memory");
        if (VAR != 5) {
#pragma unroll
            for (int i = 0; i < 8; ++i) {
                const f32x4 v = __builtin_bit_cast(f32x4, pf[i]);
                u32x2 o; o.x = cvtpk(v.x, v.y); o.y = cvtpk(v.z, v.w);
                *(LAS u32x2*)((i < 4 ? cvw0 : cvw1) + tb * SA_CB_SZ + i * SA_CB_ROW) = o;
                int f8 = __builtin_amdgcn_cvt_pk_fp8_f32(v.x, v.y, 0, false); f8 = __builtin_amdgcn_cvt_pk_fp8_f32(v.z, v.w, f8, true);
                *(LAS int*)((i < 4 ? c8w0 : c8w1) + tb * SA_C8_SZ + i * SA_C8_ROW) = f8;
            }
            { const f32x4 v = __builtin_bit_cast(f32x4, pf[8]); u32x2 o; o.x = cvtpk(v.x, v.y); o.y = cvtpk(v.z, v.w);
              *(LAS u32x2*)(krw + tb * SA_KR_SZ) = o; }
        }
        constexpr bool ld_next = (VAR != 5);
        const int tn = (t + 1) & 63;
        const unsigned prow_n = (unsigned)__builtin_amdgcn_readfirstlane(pt[hot ? 0 : (tn >> 1)]) * PAGE + 64 * (tn & 1) + 8 * w;
        asm volatile("s_waitcnt lgkmcnt(0)" ::: "memory");
        __builtin_amdgcn_s_barrier(); asm volatile("" ::: "memory");
        const LAS unsigned char* c8a = c8a0 + tb * SA_C8_SZ; const LAS unsigned char* c8b = c8b0 + tb * SA_C8_SZ; const LAS unsigned char* krbase = krbase0 + tb * SA_KR_SZ;
        float tmax = -INFINITY, ps = 0.f;
        u32x4 nb00, nb01, nb10, nb11; bf16x8 nkf;
#define SA_LDB(kb_) do { const LAS unsigned char* ca_ = c8a + (kb_) * 16 * SA_C8_ROW; const LAS unsigned char* cb_ = c8b + (kb_) * 16 * SA_C8_ROW; \
            nb00 = *(const LAS u32x4*)(ca_); nb01 = *(const LAS u32x4*)(cb_); nb10 = *(const LAS u32x4*)(ca_ + 128); nb11 = *(const LAS u32x4*)(cb_ + 128); \
            nkf = *(const LAS bf16x8*)(krbase + (kb_) * 16 * SA_KR_ROW); } while (0)
        SA_LDB(0);
#pragma unroll
        for (int kb = 0; kb < 4; ++kb) {
            f32x4v k0 = {0.f, 0.f, 0.f, 0.f}, k1 = {0.f, 0.f, 0.f, 0.f}, k2 = {0.f, 0.f, 0.f, 0.f}, k3 = {0.f, 0.f, 0.f, 0.f};
            const bf16x8 kf = nkf;
            {
                const v8i_t bf0 = {(int)nb00.x, (int)nb00.y, (int)nb00.z, (int)nb00.w, (int)nb01.x, (int)nb01.y, (int)nb01.z, (int)nb01.w};
                const v8i_t bf1 = {(int)nb10.x, (int)nb10.y, (int)nb10.z, (int)nb10.w, (int)nb11.x, (int)nb11.y, (int)nb11.z, (int)nb11.w};
                if (VAR != 3) {
                    __builtin_amdgcn_s_setprio(1);
                    k0 = __builtin_amdgcn_mfma_scale_f32_16x16x128_f8f6f4(wf[0][0], bf0, k0, 0, 0, 0, 123, 0, 127); k1 = __builtin_amdgcn_mfma_scale_f32_16x16x128_f8f6f4(wf[1][0], bf0, k1, 0, 0, 0, 123, 0, 127);
                    k2 = __builtin_amdgcn_mfma_scale_f32_16x16x128_f8f6f4(wf[2][0], bf0, k2, 0, 0, 0, 123, 0, 127); k3 = __builtin_amdgcn_mfma_scale_f32_16x16x128_f8f6f4(wf[3][0], bf0, k3, 0, 0, 0, 123, 0, 127);
                    k0 = __builtin_amdgcn_mfma_scale_f32_16x16x128_f8f6f4(wf[0][1], bf1, k0, 0, 0, 0, 123, 0, 127); k1 = __builtin_amdgcn_mfma_scale_f32_16x16x128_f8f6f4(wf[1][1], bf1, k1, 0, 0, 0, 123, 0, 127);
                    k2 = __builtin_amdgcn_mfma_scale_f32_16x16x128_f8f6f4(wf[2][1], bf1, k2, 0, 0, 0, 123, 0, 127); k3 = __builtin_amdgcn_mfma_scale_f32_16x16x128_f8f6f4(wf[3][1], bf1, k3, 0, 0, 0, 123, 0, 127);
                    __builtin_amdgcn_s_setprio(0);
                }
                __builtin_amdgcn_sched_barrier(0);
                if (kb < 3) SA_LDB(kb + 1);
                if (ld_next) { pf[2 * kb] = __builtin_amdgcn_raw_buffer_load_b128(rs_c, dma_voff, (prow_n + 2 * kb) * (KVR * 4), 0); pf[2 * kb + 1] = __builtin_amdgcn_raw_buffer_load_b128(rs_c, dma_voff, (prow_n + 2 * kb + 1) * (KVR * 4), 0);
                    if (kb == 3) pf[8] = __builtin_amdgcn_raw_buffer_load_b128(rs_k, dma_voff, prow_n * (ROPE * 4), 0); }
                __builtin_amdgcn_sched_barrier(0);
            }
            float ss = k0.x * k0.x + k0.y * k0.y + k0.z * k0.z + k0.w * k0.w + k1.x * k1.x + k1.y * k1.y + k1.z * k1.z + k1.w * k1.w
                     + k2.x * k2.x + k2.y * k2.y + k2.z * k2.z + k2.w * k2.w + k3.x * k3.x + k3.y * k3.y + k3.z * k3.z + k3.w * k3.w;
            ss = xsum32(xsum16(ss));
            const float ri = __builtin_amdgcn_rsqf(ss * (1.f / 64.f) + EPS);
            u32x4 a0, a1;
            a0.x = cvtpk(k0.x * ri, k0.y * ri); a0.y = cvtpk(k0.z * ri, k0.w * ri); a0.z = cvtpk(k1.x * ri, k1.y * ri); a0.w = cvtpk(k1.z * ri, k1.w * ri);
            a1.x = cvtpk(k2.x * ri, k2.y * ri); a1.y = cvtpk(k2.z * ri, k2.w * ri); a1.z = cvtpk(k3.x * ri, k3.y * ri); a1.w = cvtpk(k3.z * ri, k3.w * ri);
            f32x4v sc = {negm, negm, negm, negm};
            sc = __builtin_amdgcn_mfma_f32_16x16x32_bf16(kf, q2, sc, 0, 0, 0);
            sc = __builtin_amdgcn_mfma_f32_16x16x32_bf16(__builtin_bit_cast(bf16x8, a0), q0, sc, 0, 0, 0);
            sc = __builtin_amdgcn_mfma_f32_16x16x32_bf16(__builtin_bit_cast(bf16x8, a1), q1, sc, 0, 0, 0);
            float bm = fmaxf(fmaxf(sc.x, sc.y), fmaxf(sc.z, sc.w));
            if (t == 0 && kb == 0) { const float m0 = xmax32(xmax16(bm)); sc.x -= m0; sc.y -= m0; sc.z -= m0; sc.w -= m0; bm -= m0; m = m0; negm = -m0; }
            tmax = fmaxf(tmax, bm);
            sc.x = __builtin_amdgcn_exp2f(sc.x); sc.y = __builtin_amdgcn_exp2f(sc.y); sc.z = __builtin_amdgcn_exp2f(sc.z); sc.w = __builtin_amdgcn_exp2f(sc.w);
            ps += (sc.x + sc.y) + (sc.z + sc.w);
            asm volatile("" : "+v"(ps), "+v"(tmax));
            if (qreal) { u32x2 o; o.x = cvtpk(sc.x, sc.y); o.y = cvtpk(sc.z, sc.w); *(LAS u32x2*)(pwbase + kb * 32) = o; }
            __builtin_amdgcn_sched_barrier(0);
        }
#undef SA_LDB
        { tmax = xmax32(xmax16(tmax));
          const float inc = fmaxf(tmax, 0.f); const float f = __builtin_amdgcn_exp2f(-inc); m += inc; negm = -m; l = (l + ps) * f;
          if (qreal && quad == 0) *(LAS float*)(lds + SA_F + (8 * w + l15) * 4) = f; }
        asm volatile("s_waitcnt lgkmcnt(0)" ::: "memory"); __builtin_amdgcn_s_barrier(); asm volatile("" ::: "memory");
        if (VAR != 4) {
            v4i16_t lo[4], hh[4]; bf16x8 p0[4], p1[4];
#pragma unroll
            for (int ks = 0; ks < 4; ++ks) {
                lo[ks] = __builtin_amdgcn_ds_read_tr16_b64_v4i16((LAS v4i16_t*)(trlo + tb * SA_CB_SZ + ks * 16 * SA_CB_ROW));
                hh[ks] = __builtin_amdgcn_ds_read_tr16_b64_v4i16((LAS v4i16_t*)(trhi + tb * SA_CB_SZ + ks * 16 * SA_CB_ROW));
                p0[ks] = *(const LAS bf16x8*)(prd + ks * 32);
                p1[ks] = *(const LAS bf16x8*)(prd + 32 * SA_P_ROW + ks * 32);
            }
            const float f0 = frd[0], f1 = frd[32];
            __builtin_amdgcn_sched_barrier(0);
            __builtin_amdgcn_s_setprio(1);
#pragma unroll
            for (int ks = 0; ks < 4; ++ks) {
                const bf16x8 cf = (bf16x8){lo[ks][0], lo[ks][1], lo[ks][2], lo[ks][3], hh[ks][0], hh[ks][1], hh[ks][2], hh[ks][3]};
                lat0 = __builtin_amdgcn_mfma_f32_32x32x16_bf16(cf, p0[ks], lat0, 0, 0, 0);
                lat1 = __builtin_amdgcn_mfma_f32_32x32x16_bf16(cf, p1[ks], lat1, 0, 0, 0);
            }
            __builtin_amdgcn_s_setprio(0);
            if (__any(f0 != 1.f || f1 != 1.f)) {
#pragma unroll
                for (int r = 0; r < 16; ++r) { lat0[r] *= f0; lat1[r] *= f1; } }
        }
      }
    }
    __builtin_amdgcn_s_barrier(); asm volatile("" ::: "memory");
    l = xsum32(xsum16(l));
    int unit2 = unit, lane2 = threadIdx.x & 63; asm volatile("" : "+s"(unit2), "+v"(lane2));
    const int r32b = lane2 & 31, hib = lane2 >> 5;
    if (lane2 < 8) { float* mlp = ML + ((size_t)unit2 * 64 + 8 * w + lane2) * 2; mlp[0] = m; mlp[1] = l; }
    float* lp = LATP + (size_t)unit2 * 64 * KVR + 32 * w + 4 * hib;
#pragma unroll
    for (int g = 0; g < 4; ++g) {
        *(f32x4*)(lp + (size_t)r32b * KVR + 8 * g) = (f32x4){lat0[4 * g], lat0[4 * g + 1], lat0[4 * g + 2], lat0[4 * g + 3]};
        *(f32x4*)(lp + (size_t)(32 + r32b) * KVR + 8 * g) = (f32x4){lat1[4 * g], lat1[4 * g + 1], lat1[4 * g + 2], lat1[4 * g + 3]};
    }
#undef SA_LOAD
}

DI void attn_s_combine(int sb, LAS unsigned char* lds, const bf16_t* __restrict__ QB, const bf16_t* __restrict__ KV, const bf16_t* __restrict__ KRB, const bf16_t* __restrict__ WKVT,
                       const float* __restrict__ LATP, const float* __restrict__ ML, bf16_t* __restrict__ MIX) {
    const int tid = threadIdx.x;
    LAS float* latc = (LAS float*)lds; LAS float* pn = latc + 64 * KVR; LAS float* wgt = pn + 64 * 8;
    {
        const int qh = tid >> 3, j = tid & 7, h = qh >> 3, q = qh & 7;
        const bf16_t* qp = QB + (size_t)(MP + sb * DT + q) * QDIM + h * QKH; const size_t krow_ = (size_t)MP + sb * DT + j;
        float sj = 0.f;
        for (int d = 0; d < 64; ++d) sj += bf2f(qp[d]) * bf2f(KV[krow_ * 1024 + h * 64 + d]);
        for (int r = 0; r < 32; ++r) sj += bf2f(qp[64 + r]) * bf2f(KRB[krow_ * ROPE + r]);
        if (j > q) sj = -INFINITY;
        const float m0 = ML[((size_t)(2 * sb) * 64 + qh) * 2], l0 = ML[((size_t)(2 * sb) * 64 + qh) * 2 + 1], m1 = ML[((size_t)(2 * sb + 1) * 64 + qh) * 2], l1 = ML[((size_t)(2 * sb + 1) * 64 + qh) * 2 + 1];
        const float mm = max8(sj);
        const float M = fmaxf(fmaxf(m0, m1), mm);
        const float pj = exp2f(sj - M), w0 = exp2f(m0 - M), w1 = exp2f(m1 - M);
        const float sp = sum8(pj);
        const float L = w0 * l0 + w1 * l1 + sp, iL = 1.f / L;
        pn[qh * 8 + j] = pj * iL;
        if (j == 0) { wgt[qh * 2] = w0 * iL; wgt[qh * 2 + 1] = w1 * iL; }
    }
    __syncthreads();
    for (int e = tid; e < 64 * KVR; e += NTHR) { const int qh = e >> 8; latc[e] = wgt[qh * 2] * LATP[(size_t)(2 * sb) * 64 * KVR + e] + wgt[qh * 2 + 1] * LATP[(size_t)(2 * sb + 1) * 64 * KVR + e]; }
    __syncthreads();
    for (int o = tid; o < 64 * VH; o += NTHR) {
        const int qh = o >> 6, v = o & 63, h = qh >> 3, q = qh & 7;
        const bf16_t* wr = WKVT + (size_t)(512 + h * 64 + v) * KVR;
        float a = 0.f;
        for (int c = 0; c < KVR; ++c) a += latc[qh * KVR + c] * bf2f(wr[c]);
        for (int j = 0; j < DT; ++j) a += pn[qh * 8 + j] * bf2f(KV[((size_t)MP + sb * DT + j) * 1024 + 512 + h * 64 + v]);
        MIX[(size_t)(MP + sb * DT + q) * DM + 512 + h * 64 + v] = (bf16_t)f2bf(a);
    }
    __syncthreads();
}

DI void attn_s_scores_item(int chunk, int sb, int tid, const float* __restrict__ cache_ckv, const float* __restrict__ cache_kr, const int* __restrict__ page_table, const bf16_t* __restrict__ QB,
                           const bf16_t* __restrict__ CB, const bf16_t* __restrict__ KRB, const float* __restrict__ w_uk, const float* __restrict__ g_k_nope, float* __restrict__ SC) {
    const int key = tid & 127, hq = __builtin_amdgcn_readfirstlane(tid >> 7);
    const bool isnew = chunk == NPAGES;
    if (isnew && key >= DT) return;
    const float* crow = nullptr; const bf16_t* crowb = nullptr; const float* kpf = nullptr; const bf16_t* kpb = nullptr;
    if (!isnew) { const size_t pr = (size_t)page_table[sb * NPAGES + chunk] * PAGE + key; crow = cache_ckv + pr * KVR; kpf = cache_kr + pr * ROPE; }
    else { const size_t rr = (size_t)MP + sb * DT + key; crowb = CB + rr * KVR; kpb = KRB + rr * ROPE; }
    const int jglob = isnew ? PAST + key : chunk * PAGE + key;
    for (int hi = 0; hi < 2; ++hi) {
        const int h = hq * 2 + hi;
        float acc[NOPE];
#pragma unroll
        for (int d = 0; d < NOPE; ++d) acc[d] = 0.f;
        for (int c = 0; c < KVR; ++c) {
            const float cv = isnew ? bf2f(crowb[c]) : crow[c];
            const float* wr = w_uk + (size_t)c * 512 + h * 64;
#pragma unroll
            for (int d = 0; d < NOPE; ++d) acc[d] += cv * wr[d];
        }
        float ss = 0.f;
#pragma unroll
        for (int d = 0; d < NOPE; ++d) ss += acc[d] * acc[d];
        const float ri = rsqrtf(ss * (1.f / 64.f) + EPS);
#pragma unroll 1
        for (int q = 0; q < DT; ++q) {
            const bf16_t* qp = QB + (size_t)(MP + sb * DT + q) * QDIM + h * QKH;
            float s = 0.f;
#pragma unroll
            for (int d = 0; d < NOPE; ++d) s += acc[d] * g_k_nope[d] * bf2f(qp[d]);
            s *= ri;
            for (int r = 0; r < ROPE; ++r) s += (isnew ? bf2f(kpb[r]) : kpf[r]) * bf2f(qp[64 + r]);
            if (isnew && key > q) s = -INFINITY;
            SC[((size_t)sb * 64 + h * 8 + q) * NKEYS + jglob] = s;
        }
    }
}
DI void attn_s_pv_item(int sb, int tid, LAS float* lds, const float* __restrict__ cache_ckv, const int* __restrict__ page_table, const bf16_t* __restrict__ CB, const float* __restrict__ SC,
                       const float* __restrict__ w_uv, float* __restrict__ LAT, bf16_t* __restrict__ MIX) {
    LAS float* p = lds; LAS float* smx = lds + 64 * PAGE; LAS float* sinv = smx + 64;
    const int wid = tid >> 6, lane = tid & 63;
    for (int i = 0; i < 8; ++i) {
        const int qh = wid * 8 + i; const float* s = SC + ((size_t)sb * 64 + qh) * NKEYS;
        float mx = -INFINITY; for (int j = lane; j < NKEYS; j += 64) mx = fmaxf(mx, s[j]);
        mx = wave_max(mx);
        float sum = 0.f; for (int j = lane; j < NKEYS; j += 64) sum += exp2f(s[j] - mx);
        sum = wave_sum(sum);
        if (lane == 0) { smx[qh] = mx; sinv[qh] = 1.f / sum; }
    }
    __syncthreads();
    const int c = tid & 255, half = tid >> 8;
    float lat[32];
#pragma unroll
    for (int i = 0; i < 32; ++i) lat[i] = 0.f;
    for (int chunk = 0; chunk <= NPAGES; ++chunk) {
        const int nk = chunk == NPAGES ? DT : PAGE;
        for (int e = tid; e < 64 * PAGE; e += NTHR) { const int qh = e >> 7, j = e & 127; p[qh * PAGE + j] = j < nk ? exp2f(SC[((size_t)sb * 64 + qh) * NKEYS + chunk * PAGE + j] - smx[qh]) * sinv[qh] : 0.f; }
        __syncthreads();
        for (int j = 0; j < nk; ++j) {
            float cv;
            if (chunk < NPAGES) cv = cache_ckv[((size_t)page_table[sb * NPAGES + chunk] * PAGE + j) * KVR + c];
            else cv = bf2f(CB[((size_t)MP + sb * DT + j) * KVR + c]);
#pragma unroll
            for (int i = 0; i < 32; ++i) lat[i] += p[(half * 32 + i) * PAGE + j] * cv;
        }
        __syncthreads();
    }
    float* L = LAT + (size_t)sb * 64 * KVR;
#pragma unroll
    for (int i = 0; i < 32; ++i) L[(half * 32 + i) * KVR + c] = lat[i];
    __threadfence_block(); __syncthreads();
    for (int o = tid; o < 64 * VH; o += NTHR) {
        const int qh = o >> 6, v = o & 63, h = qh >> 3, q = qh & 7;
        float a = 0.f;
        for (int cc = 0; cc < KVR; ++cc) a += L[qh * KVR + cc] * w_uv[(size_t)cc * 512 + h * 64 + v];
        MIX[(size_t)(MP + sb * DT + q) * DM + 512 + h * 64 + v] = (bf16_t)f2bf(a);
    }
    __syncthreads();
}

enum Phase { PH_PRO = 0, PH_Z0, PH_POST0, PH_KVPOOL, PH_KNORM, PH_ATTN, PH_ATTN2, PH_OUT0, PH_UP0, PH_DN0, PH_RNNIN, PH_CONV, PH_GATES, PH_SCAN, PH_OUTR, PH_UP1, PH_DN1, PH_COUNT };

__global__ void __launch_bounds__(NTHR, 2) mk(Args args) {
    extern __shared__ __attribute__((aligned(16))) unsigned char lds_raw[];
    LAS unsigned char* lds = (LAS unsigned char*)lds_raw;
    volatile LAS unsigned* MISC = (volatile LAS unsigned*)(lds + LDS_MISC);
    const int tid = threadIdx.x, lane = tid & 63, wave = __builtin_amdgcn_readfirstlane(tid >> 6);
    const int G = gridDim.x, bx = blockIdx.x;
    const int gw = bx * NWAVES + wave, NGW = G * NWAVES;
    const int lo = args.ph_lo, hi = args.ph_hi;

    const float* x_prompt = (const float*)args.in[0]; const float* x_sample = (const float*)args.in[1];
    const float* cache_ckv = (const float*)args.in[2]; const float* cache_kr = (const float*)args.in[3];
    const float* state_pool = (const float*)args.in[4]; const float* state_conv = (const float*)args.in[5]; const float* state_lru = (const float*)args.in[6];
    const int* page_table = (const int*)args.in[7];
    const float* norm_mix = (const float*)args.in[8]; const float* w_in_even = (const float*)args.in[9];
    const float* g_q_nope = (const float*)args.in[10]; const float* g_q_rope = (const float*)args.in[11]; const float* g_ckv = (const float*)args.in[12]; const float* g_k_rope = (const float*)args.in[13]; const float* g_k_nope = (const float*)args.in[14];
    const float* w_uk = (const float*)args.in[15]; const float* w_uv = (const float*)args.in[16]; const float* w_pool = (const float*)args.in[17]; const float* pool_scale = (const float*)args.in[18];
    const float* w_out_even = (const float*)args.in[19]; const float* w_in_rnn = (const float*)args.in[20]; const float* conv_w = (const float*)args.in[21]; const float* conv_b = (const float*)args.in[22];
    const float* w_gate_a = (const float*)args.in[23]; const float* b_gate_a = (const float*)args.in[24]; const float* w_gate_x = (const float*)args.in[25]; const float* b_gate_x = (const float*)args.in[26];
    const float* lru_lambda = (const float*)args.in[27]; const float* w_out_rnn = (const float*)args.in[28]; const float* norm_ffn = (const float*)args.in[29]; const float* w_up = (const float*)args.in[30]; const float* w_down = (const float*)args.in[31];
    float* out = args.out; unsigned char* ws = args.ws;
    bf16_t* WIN0T = (bf16_t*)(ws + WS_WIN0T); bf16_t* WKVT = (bf16_t*)(ws + WS_WKVT); bf16_t* WPOOLT = (bf16_t*)(ws + WS_WPOOLT); bf16_t* WGATET = (bf16_t*)(ws + WS_WGATET);
    bf16_t* WOUT0T = (bf16_t*)(ws + WS_WOUT0T); bf16_t* WOUTRT = (bf16_t*)(ws + WS_WOUTRT); bf16_t* WINRT = (bf16_t*)(ws + WS_WINRT); bf16_t* WUPT = (bf16_t*)(ws + WS_WUPT); bf16_t* WDNT = (bf16_t*)(ws + WS_WDNT);
    float* SSQ = (float*)(ws + WS_SSQ); bf16_t* XB = (bf16_t*)(ws + WS_XB); bf16_t* Z0 = (bf16_t*)(ws + WS_Z0); bf16_t* QB = (bf16_t*)(ws + WS_QB); bf16_t* CB = (bf16_t*)(ws + WS_CB); bf16_t* KRB = (bf16_t*)(ws + WS_KRB);
    bf16_t* DBuf = (bf16_t*)(ws + WS_DB); bf16_t* KV = (bf16_t*)(ws + WS_KV); bf16_t* MIX = (bf16_t*)(ws + WS_MIX); bf16_t* H = (bf16_t*)(ws + WS_H); bf16_t* GATE = (bf16_t*)(ws + WS_GATE); bf16_t* U = (bf16_t*)(ws + WS_U);
    bf16_t* V = (bf16_t*)(ws + WS_V); float* Gb = (float*)(ws + WS_G); bf16_t* YB = (bf16_t*)(ws + WS_YB); float* SC = (float*)(ws + WS_SC); float* LAT = (float*)(ws + WS_LAT);
    float* Y = out + O_Y;

    if (tid < 64) MISC[tid] = 0u;
    __syncthreads();
    XcdBarrier bar = xcd_barrier_post((unsigned*)(ws + WS_CTL) + CW_BAR, MISC + 8);
#ifndef PH_MASK
#define PH_MASK 0xFFFFFFFFu
#endif
#define IN(k) (((PH_MASK >> (k)) & 1u) && lo <= (k) && (k) < hi)
#define SEAM(k) do { if (IN(k) && IN((k) + 1)) xcd_barrier(bar); } while (0)
#define STREAM_CTL(ep_) pg8::StreamCtl{(float*)(ws + WS_PART), (unsigned*)(ws + WS_CTL) + CW_SKF, (unsigned*)(ws + WS_CTL) + CW_SKT, (unsigned)(ep_), bx, 0}
#define GEMM_PHASE_STATIC(ep_, Aptr, lda_, atoff_, ashift_, Bptr, M_, N_, K_, FT, ...) do { pg8::Gemm g{Aptr, Bptr, M_, N_, K_, lda_, atoff_, ashift_}; pg8::StaticOrder S; S.init(M_, N_, K_, G, bx); \
        pg8::EpiRows<FT> E{FT{__VA_ARGS__}}; pg8::gemm_phase<false>(lds, g, S, E, STREAM_CTL(ep_)); } while (0)
#define GEMM_PHASE(ep_, Aptr, lda_, atoff_, ashift_, Bptr, M_, N_, K_, FT, ...) do { pg8::Gemm g{Aptr, Bptr, M_, N_, K_, lda_, atoff_, ashift_}; pg8::StaticOrder S; S.init(M_, N_, K_, G, bx); \
        pg8::EpiRows<FT> E{FT{__VA_ARGS__}}; pg8::gemm_phase<false>(lds, g, S, E, STREAM_CTL(ep_)); } while (0)
#define GEMM_PHASE_P8(ep_, Aptr, lda_, Bptr, M_, N_, K_, FT, ...) do { pg8::Gemm g{Aptr, Bptr, M_, N_, K_, lda_, 0, 0}; pg8::StaticOrder S; S.init(M_, N_, K_, G, bx); \
        pg8::EpiRows<FT, false, true> E{FT{__VA_ARGS__}}; pg8::gemm_phase<false>(lds, g, S, E, STREAM_CTL(ep_)); } while (0)
#define GEMM_RESID(Aptr, lda_, Bptr, K_) GEMM_PHASE_P8(0, Aptr, lda_, Bptr, MT, DM, K_, FResid<false>, XB, (float*)nullptr, SSQ)
#define CW_RDY(i) ((unsigned*)(ws + WS_CTL) + 12288 + 64 * (i))
#define GEMM_RESID_SPLIT(Aptr, lda_, Bptr, K_) do { \
        if (G == 256) { pg8::Gemm g{Aptr, Bptr, MT, DM, K_, lda_, 0, 0}; pg8::SplitTailOrder S; S.init(K_, bx); pg8::EpiRows<FResid<false>, false, true> E{FResid<false>{XB, (float*)nullptr, SSQ}}; \
            pg8::gemm_phase<false>(lds, g, S, E, STREAM_CTL(0), EpiPartStore{(float*)(ws + WS_PART), bx & 15}); } \
        else GEMM_RESID(Aptr, lda_, Bptr, K_); } while (0)
#define FIXUP_DEFERRED(i, WAYS_) do { if (G == 256 && bx >= 128) { sample_fixup<false, WAYS_>(bx - 128, (const float*)(ws + WS_PART), XB, (float*)nullptr, SSQ); \
            asm volatile("s_waitcnt vmcnt(0)" ::: "memory"); __syncthreads(); \
            if (tid == 0) { __builtin_amdgcn_fence(__ATOMIC_RELEASE, "agent"); asm volatile("s_waitcnt vmcnt(0)" ::: "memory"); __hip_atomic_fetch_add(CW_RDY(i), 1u, __ATOMIC_RELAXED, __HIP_MEMORY_SCOPE_AGENT); } } } while (0)
#define GEMM_PHASE_P8_RDY(i, ep_, Aptr, lda_, Bptr, M_, N_, K_, FT, ...) do { pg8::Gemm g{Aptr, Bptr, M_, N_, K_, lda_, 0, 0}; if (G == 256) { g.ready = CW_RDY(i); g.ready_target = 128u; } pg8::StaticOrder S; S.init(M_, N_, K_, G, bx); \
        pg8::EpiRows<FT, false, true> E{FT{__VA_ARGS__}}; pg8::gemm_phase<false>(lds, g, S, E, STREAM_CTL(ep_)); } while (0)
#define GEMM_DOWN(Aptr, Bptr, FIN) do { \
        if (G == 256) { pg8::Gemm g{Aptr, Bptr, MT, DM, DFF, DFF, 0, 0}; pg8::SplitTailOrder S; S.init(DFF, bx); pg8::EpiRows<FResid<FIN>, false, true> E{FResid<FIN>{XB, Y, SSQ}}; \
            pg8::gemm_phase<false>(lds, g, S, E, STREAM_CTL(0), EpiPartStore{(float*)(ws + WS_PART), bx & 15}); \
            if (FIN) { xcd_barrier(bar); sample_fixup<FIN>(bx, (const float*)(ws + WS_PART), XB, Y, SSQ); } } \
        else GEMM_PHASE_STATIC(0, Aptr, DFF, 0, 0, Bptr, MT, DM, DFF, FResid<FIN>, XB, Y, SSQ); } while (0)

    if (IN(PH_PRO)) for (int rep_ = 0; rep_ < REPN(10); ++rep_) {
        LAS float* scr = (LAS float*)(lds + wave * 16384);
        constexpr int I0 = 16 * 49, I1 = 4 * 16, I3 = 2 * 4;
        constexpr int NITEMS = I0 + 2 * I1 + 4 * I3;
        for (int it = gw; it < NITEMS; it += NGW) {
            int r = it;
            if (r < I0) { p0_transpose_item(w_in_even, 1568, 1568, WIN0T, DM, norm_mix, scr, r, lane); continue; } r -= I0;
            if (r < I1) { p0_transpose_item(w_uk, 512, 512, WKVT, KVR, nullptr, scr, r, lane); continue; } r -= I1;
            if (r < I1) { p0_transpose_item(w_uv, 512, 512, WKVT + (size_t)512 * KVR, KVR, nullptr, scr, r, lane); continue; } r -= I1;
            { const int g = r / I3; p0_transpose_item(w_pool + (size_t)g * 128 * 128, 128, 128, WPOOLT + (size_t)g * 128 * 256 + (g & 1) * 128, 256, nullptr, scr, r % I3, lane); }
        }
        { u32x4* z0 = (u32x4*)(WIN0T + (size_t)1568 * DM); const u32x4 zz = {0u, 0u, 0u, 0u};
          for (int e = bx * NTHR + tid; e < (NZ0 - 1568) * DM / 8; e += G * NTHR) z0[e] = zz;
          for (int e = bx * NTHR + tid; e < 512 * 16; e += G * NTHR) { const int n = e >> 4, c8 = e & 15; *(u32x4*)(WPOOLT + (size_t)n * 256 + (1 - ((n >> 7) & 1)) * 128 + c8 * 8) = zz; }
          for (int e = bx * NTHR + tid; e < 2048 * 16; e += G * NTHR) { const int n = e >> 4, c8 = e & 15; *(u32x4*)(WGATET + (size_t)n * 256 + (1 - ((n >> 8) & 1)) * 128 + c8 * 8) = zz; } }
        { float* ROPET = (float*)(ws + WS_ROPE);
          for (int e = bx * NTHR + tid; e < (SEQ + DT) * 16; e += G * NTHR) { const int pi = e >> 4, i = e & 15; const int pos = pi < SEQ ? pi : PAST + (pi - SEQ);
              const float inv = powf(10000.0f, -(float)i / 16.0f); const float ang = (float)pos * inv; ROPET[e * 2] = cosf(ang); ROPET[e * 2 + 1] = sinf(ang); } }
        if (bx == G - 1) for (int c = tid; c < DM; c += NTHR) ((float*)(ws + WS_SP8))[c] = log1pf(expf(-lru_lambda[c])) * (8.0f * 1.4426950408889634f);
        {
#define XROW(r_) ((r_) < MP ? x_prompt + (size_t)(r_) * DM : x_sample + (size_t)((r_) - MP) * DM)
            f32x4 nv[4]; if (gw < MT) rowprep_load(XROW(gw), lane, nv);
            for (int row = gw; row < MT; row += NGW) { f32x4 v[4];
#pragma unroll
                for (int j = 0; j < 4; ++j) v[j] = nv[j];
                const int nr = row + NGW; if (nr < MT) rowprep_load(XROW(nr), lane, nv);
                rowprep_row(v, row, XB, SSQ, lane); }
#undef XROW
        }
    }
    SEAM(PH_PRO);
    if (REP_ID == 40) { for (int i = 0; i < 10; ++i) xcd_barrier(bar); }
    if (IN(PH_Z0)) for (int rep_ = 0; rep_ < REPN(1); ++rep_) GEMM_PHASE_P8(1, XB, DM, WIN0T, MT, NZ0, DM, FZ0, SSQ, Z0);
    SEAM(PH_Z0);
    if (IN(PH_POST0)) for (int rep_ = 0; rep_ < REPN(2); ++rep_) {
        const float* ROPET = (const float*)(ws + WS_ROPE);
        for (int row = gw; row < MT; row += NGW) post0_row(row, lane, Z0, ROPET, g_q_nope, g_q_rope, g_ckv, g_k_rope, QB, CB, KRB, out);
        for (int it = bx * NTHR + tid; it < (MP / 16) * 64; it += G * NTHR) pool_item_p16((it >> 6) * 16, (it & 63) * 8, Z0, DBuf, out);
        for (int it = bx * NTHR + tid; it < DB_ * 64; it += G * NTHR) pool_item<false>(MP + (it >> 6) * DT, DT, (it & 63) * 8, Z0, state_pool, DBuf, out);
    }
    SEAM(PH_POST0);
    if (IN(PH_KVPOOL) && REP_ID == 13) { GEMM_PHASE(14, CB, KVR, 0, 0, WKVT, MT, 1024, KVR, FRawBf16<1024>, (bf16_t*)(ws + WS_DBG)); GEMM_PHASE_STATIC(15, DBuf, POOLD, 256, 0, WPOOLT, MT, POOLD, 256, FPool, pool_scale, MIX); }
    if (IN(PH_KVPOOL)) {
        { pg8::Gemm g{CB, WKVT, MT, 1024, KVR, KVR, 0, 0}; pg8::StaticOrder S; S.init(MT, 1024, KVR, G, bx); pg8::EpiRows<FKvNorm, true, true> E{FKvNorm{KV, g_k_nope}}; pg8::gemm_phase<false>(lds, g, S, E, STREAM_CTL(2)); }
        { pg8::Gemm g{DBuf, WPOOLT, MT, POOLD, 256, POOLD, 256, 0}; pg8::StaticOrder S; S.init(MT, POOLD, 256, G, (G == 256) ? ((bx + 240) & 255) : bx); pg8::EpiRows<FPool, false, true> E{FPool{pool_scale, MIX}}; pg8::gemm_phase<false>(lds, g, S, E, STREAM_CTL(3)); }
    }
#if DBG_KNORM
    if (IN(PH_KVPOOL)) GEMM_PHASE_STATIC(16, CB, KVR, 0, 0, WKVT, MT, 1024, KVR, FRawBf16<1024>, (bf16_t*)(ws + WS_DBG));
#endif
    SEAM(PH_KVPOOL);
#if DBG_KNORM
    if (IN(PH_KNORM)) { const bf16_t* R = (const bf16_t*)(ws + WS_DBG); unsigned bad = 0;
        for (int row = gw; row < MT; row += NGW) {
            for (int h = 0; h < NH; ++h) { const float x = bf2f(R[(size_t)row * 1024 + h * 64 + lane]); const float ss = wave_sum(x * x); const float y = x * rsqrtf(ss * (1.f / 64.f) + EPS) * g_k_nope[lane];
                const float a = bf2f(KV[(size_t)row * 1024 + h * 64 + lane]); if (!(fabsf(a - y) <= 0.02f + 0.02f * fabsf(y))) ++bad; }
            for (int c = lane; c < 512; c += 64) { const float y = bf2f(R[(size_t)row * 1024 + 512 + c]), a = bf2f(KV[(size_t)row * 1024 + 512 + c]); if (!(fabsf(a - y) <= 1e-3f + 0.01f * fabsf(y))) ++bad; } }
        if (bad) atomicAdd((unsigned*)(ws + WS_CTL) + CW_DBG, bad); }
#endif
    if (IN(PH_ATTN)) {
        LAS float* sc = (LAS float*)(lds + wave * 16768);
#if DBG_ATTN_P
        for (int it = gw; it < MP * NH; it += NGW) attn_p_naive_item(it, lane, sc, QB, KV, KRB, (bf16_t*)(ws + WS_DBG));
        __syncthreads();
#endif
#ifndef NO_ATTN_P
        { const int vcu = (G % 8 == 0) ? (bx % 8) * (G / 8) + bx / 8 : bx;
          for (int rep_ = 0; rep_ < REPN(3); ++rep_) for (int pi = vcu; pi < 256; pi += G) { const int bh = pi >> 3, s8 = pi & 7; attn_p_unit(bh >> 3, bh & 7, 15 - s8, lds, QB, KV, KRB, MIX); attn_p_unit(bh >> 3, bh & 7, s8, lds, QB, KV, KRB, MIX); }
          asm volatile("s_waitcnt vmcnt(0)" ::: "memory"); __syncthreads(); }
#endif
#if DBG_ATTN_S
        for (int it = bx; it < (NPAGES + 1) * DB_; it += G) attn_s_scores_item(it % (NPAGES + 1), it / (NPAGES + 1), tid, cache_ckv, cache_kr, page_table, QB, CB, KRB, w_uk, g_k_nope, SC);
        __syncthreads();
#endif
        if (REP_ID >= 20 && REP_ID <= 24) for (int u = bx; u < 2 * DB_; u += G) attn_s_unit<(REP_ID >= 20 && REP_ID <= 24) ? REP_ID - 19 : 1>(u, lds, cache_ckv, cache_kr, page_table, QB, WKVT, g_k_nope, (float*)(ws + WS_DBG), (float*)(ws + WS_DBG + 40 * MiB));
        for (int rep_ = 0; rep_ < REPN(4); ++rep_) for (int u = bx; u < 2 * DB_; u += G) attn_s_unit<0>(u, lds, cache_ckv, cache_kr, page_table, QB, WKVT, g_k_nope, (float*)(ws + WS_LATP), (float*)(ws + WS_ML));
        asm volatile("s_waitcnt vmcnt(0)" ::: "memory"); __syncthreads();
    }
    SEAM(PH_ATTN);
#if DBG_ATTN_P
    if (IN(PH_ATTN2)) {
        const bf16_t* R = (const bf16_t*)(ws + WS_DBG); unsigned bad = 0;
        for (size_t i = (size_t)bx * NTHR + tid; i < (size_t)MP * 512; i += (size_t)G * NTHR) { const size_t row = i >> 9, c = 512 + (i & 511); const float a = bf2f(MIX[row * DM + c]), r = bf2f(R[row * DM + c]);
            if (!(fabsf(a - r) <= 0.01f + 0.02f * fabsf(r))) ++bad; }
        if (bad) atomicAdd((unsigned*)(ws + WS_CTL) + CW_DBG, bad);
    }
#endif
    if (IN(PH_ATTN2)) { __syncthreads();
#if DBG_ATTN_S
        for (int sb = bx; sb < DB_; sb += G) attn_s_pv_item(sb, tid, (LAS float*)lds, cache_ckv, page_table, CB, SC, w_uv, LAT, (bf16_t*)(ws + WS_DBG));
        __syncthreads();
#endif
        for (int sb = bx; sb < DB_; sb += G) attn_s_combine(sb, lds, QB, KV, KRB, WKVT, (const float*)(ws + WS_LATP), (const float*)(ws + WS_ML), MIX);
#if DBG_ATTN_S
        asm volatile("s_waitcnt vmcnt(0)" ::: "memory"); __syncthreads();
        { const bf16_t* R = (const bf16_t*)(ws + WS_DBG); unsigned bad = 0; float num_ = 0.f, den_ = 0.f;
          for (int sb = bx; sb < DB_; sb += G) for (int i = tid; i < DT * 512; i += NTHR) { const size_t row = (size_t)MP + sb * DT + (i >> 9), c = 512 + (i & 511); const float a = bf2f(MIX[row * DM + c]), r = bf2f(R[row * DM + c]);
              num_ += (a - r) * (a - r); den_ += r * r; if (!(fabsf(a - r) <= 0.02f + 0.5f * fabsf(r))) ++bad; }
          if (bad) atomicAdd((unsigned*)(ws + WS_CTL) + CW_DBG, bad);
          num_ = wave_sum(num_); den_ = wave_sum(den_); if (lane == 0) { atomicAdd((float*)(ws + WS_CTL) + CW_DBG + 2, num_); atomicAdd((float*)(ws + WS_CTL) + CW_DBG + 3, den_); } }
#endif
    }
    if (IN(PH_ATTN2) && bx >= DB_) {
        LAS float* scr = (LAS float*)(lds + wave * 16384);
        for (int it = (bx - DB_) * NWAVES + wave; it < 16 * 32; it += (G - DB_) * NWAVES) p0_transpose_item(w_out_even, DM, DM, WOUT0T, DM, nullptr, scr, it, lane);
        if (G == 256) for (int it = (bx - DB_) * NWAVES + wave; it < 16 * 128; it += (G - DB_) * NWAVES) p0_transpose_item(w_up, DFF, DFF, WUPT, DM, norm_ffn, scr, it, lane);
    }
    SEAM(PH_ATTN2);
    if (IN(PH_OUT0)) GEMM_RESID_SPLIT(MIX, DM, WOUT0T, DM);
    if (IN(PH_OUT0) && G != 256) {
        const int gw2 = bx * NWAVES + wave, NGW2 = G * NWAVES;
        LAS float* scr = (LAS float*)(lds + wave * 16384);
        constexpr int I8 = 16 * 128, I10 = 64 * 32;
        for (int it = gw2; it < I8 + I10; it += NGW2) {
            if (it < I8) p0_transpose_item(w_up, DFF, DFF, WUPT, DM, norm_ffn, scr, it, lane);
            else p0_transpose_item(w_down, DM, DM, WDNT, DFF, nullptr, scr, it - I8, lane);
        }
    }
    SEAM(PH_OUT0);
    if (IN(PH_UP0) && REP_ID == 30) GEMM_PHASE(30, XB, DM, 0, 0, WUPT, MT, DFF, DM, FNull, (float*)(ws + WS_DBG));
    if (IN(PH_UP0)) { FIXUP_DEFERRED(0, 8); GEMM_PHASE_P8_RDY(0, 5, XB, DM, WUPT, MT, DFF, DM, FUp, SSQ, H); }
    if (IN(PH_UP0)) {
        const int nidle = G - 64;
        if (G == 256 ? (bx >= 64) : true) {
            const int gw2 = (G == 256 ? (bx - 64) : bx) * NWAVES + wave, NGW2 = (G == 256 ? nidle : G) * NWAVES;
            LAS float* scr = (LAS float*)(lds + wave * 16384);
            constexpr int I3 = 2 * 4, I7 = 16 * 32, I8 = 16 * 128, I10 = 64 * 32, I12 = 16 * 64;
            constexpr int NIT2 = I8 + I10 + I12 + 16 * I3 + I7;
            if (G == 256) for (int it = gw2; it < I10; it += NGW2) p0_transpose_item(w_down, DM, DM, WDNT, DFF, nullptr, scr, it, lane);
            for (int it = gw2; it < NIT2; it += NGW2) {
                int r = it;
                if (r < I8) { p0_transpose_item(w_up + (size_t)DM * DFF, DFF, DFF, WUPT + (size_t)DFF * DM, DM, norm_ffn + DM, scr, r, lane); continue; } r -= I8;
                if (r < I10) { p0_transpose_item(w_down + (size_t)DFF * DM, DM, DM, WDNT + (size_t)DM * DFF, DFF, nullptr, scr, r, lane); continue; } r -= I10;
                if (r < I12) { p0_transpose_item(w_in_rnn, 2048, 2048, WINRT, DM, norm_mix + DM, scr, r, lane); continue; } r -= I12;
                if (r < 16 * I3) { const int q = r / I3, n = q >> 1, isx = q & 1; const float* src = (isx ? w_gate_x : w_gate_a) + (size_t)n * 128 * 128;
                    p0_transpose_item(src, 128, 128, WGATET + (size_t)(n * 256 + isx * 128) * 256 + (n & 1) * 128, 256, nullptr, scr, r % I3, lane); continue; } r -= 16 * I3;
                p0_transpose_item(w_out_rnn, DM, DM, WOUTRT, DM, nullptr, scr, r, lane);
            }
        }
    }
    SEAM(PH_UP0);
    if (IN(PH_DN0)) GEMM_DOWN(H, WDNT, false);
    SEAM(PH_DN0);
    if (IN(PH_RNNIN)) { FIXUP_DEFERRED(1, 16); GEMM_PHASE_P8_RDY(1, 7, XB, DM, WINRT, MT, 2048, DM, FRnnIn, SSQ, GATE, U); }
    SEAM(PH_RNNIN);
    if (IN(PH_CONV)) for (int rep_ = 0; rep_ < REPN(12); ++rep_) {
        for (int it = bx * NTHR + tid; it < (MP / 16) * 128; it += G * NTHR) conv_item_p16((it >> 7) * 16, (it & 127) * 8, U, conv_w, conv_b, V, out);
        for (int it = bx * NTHR + tid; it < DB_ * 128; it += G * NTHR) conv_item<false>(MP + (it >> 7) * DT, DT, (it & 127) * 8, U, state_conv, conv_w, conv_b, V, out);
    }
    SEAM(PH_CONV);
    if (IN(PH_GATES)) for (int rep_ = 0; rep_ < REPN(9); ++rep_) { pg8::Gemm g{V, WGATET, MT, 2048, 256, DM, 256, 1}; pg8::StaticOrder S; S.init(G == 256 ? MP : MT, 2048, 256, G, bx);
        EpiGates E{V, b_gate_a, b_gate_x, (const float*)(ws + WS_SP8), (bf16_t*)(ws + WS_HL), (bf16_t*)(ws + WS_AC), (float*)(ws + WS_SUM)}; pg8::gemm_phase<false>(lds, g, S, E, STREAM_CTL(8)); }
    SEAM(PH_GATES);
    if (IN(PH_SCAN)) for (int rep_ = 0; rep_ < REPN(11); ++rep_) {
        const bf16_t* HL = (const bf16_t*)(ws + WS_HL); const bf16_t* AC = (const bf16_t*)(ws + WS_AC); const float* SUM = (const float*)(ws + WS_SUM);
        for (int idx = bx * NTHR + tid; idx < 256 * 4 * 128; idx += G * NTHR) {
            const int cg = idx & 127, qt = (idx >> 7) & 3, segp = idx >> 9, sq = segp & 63, ch = cg * 8;
            u32x4 rhl[2][8], rac[2][8], rgt[2][8];
#define SCAN_LD(bt_) do { _Pragma("unroll") for (int t = 0; t < 8; ++t) { const size_t off = (size_t)(segp * 64 + qt * 16 + (bt_) * 8 + t) * DM + ch; rhl[bt_][t] = *(const u32x4*)(HL + off); rac[bt_][t] = *(const u32x4*)(AC + off); rgt[bt_][t] = *(const u32x4*)(GATE + off); } } while (0)
            SCAN_LD(0);
            float h[8];
#pragma unroll
            for (int e = 0; e < 8; ++e) h[e] = 0.f;
#pragma unroll 4
            for (int k = 0; k < sq; ++k) {
                const f32x4* sp4 = (const f32x4*)(SUM + ((size_t)(segp - sq + k) * DM + ch) * 2);
                const f32x4 s0 = sp4[0], s1 = sp4[1], s2 = sp4[2], s3 = sp4[3];
                h[0] = s0.x * h[0] + s0.y; h[1] = s0.z * h[1] + s0.w; h[2] = s1.x * h[2] + s1.y; h[3] = s1.z * h[3] + s1.w;
                h[4] = s2.x * h[4] + s2.y; h[5] = s2.z * h[5] + s2.w; h[6] = s3.x * h[6] + s3.y; h[7] = s3.z * h[7] + s3.w;
            }
            SCAN_LD(1);
#undef SCAN_LD
#pragma unroll
            for (int t = 0; t < 16; ++t) {
                const size_t off = (size_t)(segp * 64 + qt * 16 + t) * DM + ch;
                const u32x4 hl = rhl[t >> 3][t & 7], ac = rac[t >> 3][t & 7], gt = rgt[t >> 3][t & 7];
                float hv[8]; u32x4 o;
#pragma unroll
                for (int e2 = 0; e2 < 4; ++e2) {
                    hv[2 * e2] = __uint_as_float(hl[e2] << 16) + __uint_as_float(ac[e2] << 16) * h[2 * e2];
                    hv[2 * e2 + 1] = __uint_as_float(hl[e2] & 0xffff0000u) + __uint_as_float(ac[e2] & 0xffff0000u) * h[2 * e2 + 1];
                    o[e2] = pk2(__uint_as_float(gt[e2] << 16) * hv[2 * e2], __uint_as_float(gt[e2] & 0xffff0000u) * hv[2 * e2 + 1]);
                }
                *(u32x4*)(YB + off) = o;
                if (sq == 63 && qt == 3 && t == 15) {
#pragma unroll
                    for (int e = 0; e < 8; ++e) out[O_LRU_P + (size_t)(segp >> 6) * DM + ch + e] = hv[e];
                }
            }
        }
        if (G == 256) { for (int item = bx; item < (DB_ / 2) * 8; item += G) gates_sample_item(item, wave, lane, V, WGATET, b_gate_a, b_gate_x, (const float*)(ws + WS_SP8), GATE, state_lru, YB, out); }
        else
        for (int idx = bx * NTHR + tid; idx < DB_ * 128; idx += G * NTHR) {
            const int cg = idx & 127, sb = idx >> 7, ch = cg * 8;
            float h[8];
#pragma unroll
            for (int e = 0; e < 8; ++e) h[e] = state_lru[(size_t)sb * DM + ch + e];
            for (int t = 0; t < DT; ++t) {
                const size_t off = (size_t)(MP + sb * DT + t) * DM + ch;
                const u32x4 hl = *(const u32x4*)(HL + off), ac = *(const u32x4*)(AC + off), gt = *(const u32x4*)(GATE + off);
                float hv[8]; u32x4 o;
#pragma unroll
                for (int e2 = 0; e2 < 4; ++e2) {
                    hv[2 * e2] = __uint_as_float(hl[e2] << 16) + __uint_as_float(ac[e2] << 16) * h[2 * e2];
                    hv[2 * e2 + 1] = __uint_as_float(hl[e2] & 0xffff0000u) + __uint_as_float(ac[e2] & 0xffff0000u) * h[2 * e2 + 1];
                    o[e2] = pk2(__uint_as_float(gt[e2] << 16) * hv[2 * e2], __uint_as_float(gt[e2] & 0xffff0000u) * hv[2 * e2 + 1]);
                }
                *(u32x4*)(YB + off) = o;
                if (t == DT - 1) {
#pragma unroll
                    for (int e = 0; e < 8; ++e) out[O_LRU_S + (size_t)sb * DM + ch + e] = hv[e];
                }
            }
        }
    }
    SEAM(PH_SCAN);
    if (IN(PH_OUTR)) GEMM_RESID_SPLIT(YB, DM, WOUTRT, DM);
    SEAM(PH_OUTR);
    if (IN(PH_UP1)) { FIXUP_DEFERRED(2, 8); GEMM_PHASE_P8_RDY(2, 10, XB, DM, WUPT + (size_t)DFF * DM, MT, DFF, DM, FUp, SSQ, H); }
    SEAM(PH_UP1);
#if DBG_ANY
    if (IN(PH_DN1)) { const float n_ = __hip_atomic_load((float*)(ws + WS_CTL) + CW_DBG + 2, __ATOMIC_RELAXED, __HIP_MEMORY_SCOPE_AGENT), d_ = __hip_atomic_load((float*)(ws + WS_CTL) + CW_DBG + 3, __ATOMIC_RELAXED, __HIP_MEMORY_SCOPE_AGENT);
        if ((__hip_atomic_load((unsigned*)(ws + WS_CTL) + CW_DBG, __ATOMIC_RELAXED, __HIP_MEMORY_SCOPE_AGENT) != 0u || n_ > DBG_RVR * d_) && bx == 0 && tid == 0) out[O_LRU_S] = __builtin_nanf(""); }
#endif
    if (IN(PH_DN1)) GEMM_DOWN(H, WDNT + (size_t)DM * DFF, true);
#undef IN
#undef SEAM
#undef GEMM_PHASE
}

#ifndef MK_ONE
#define MK_ONE 1
#endif
extern "C" void kernel_launch(void* const* d_in, const int* in_sizes, int n_in, void* d_out, int out_size, void* d_ws, size_t ws_size, hipStream_t stream) {
    (void)in_sizes; (void)out_size;
    static int grid = 0;
    if (grid == 0) {
        if (n_in != 32 || ws_size < WS_END) { fprintf(stderr, "kernel_launch: unexpected inputs / workspace\n"); grid = -1; return; }
        int dev = 0, cus = 0, per_cu = 0;
        if (hipGetDevice(&dev) != hipSuccess || hipDeviceGetAttribute(&cus, hipDeviceAttributeMultiprocessorCount, dev) != hipSuccess) { grid = -1; return; }
        if (hipFuncSetAttribute((const void*)mk, hipFuncAttributeMaxDynamicSharedMemorySize, LDS_BYTES) != hipSuccess) { fprintf(stderr, "kernel_launch: hipFuncSetAttribute failed\n"); grid = -1; return; }
        if (hipOccupancyMaxActiveBlocksPerMultiprocessor(&per_cu, (const void*)mk, NTHR, LDS_BYTES) != hipSuccess || per_cu < 1) { fprintf(stderr, "kernel_launch: occupancy query reports %d\n", per_cu); }
        (void)hipGetLastError();
        grid = cus;
    }
    if (grid < 0) return;
    unsigned char* ws = (unsigned char*)d_ws;
    (void)hipMemsetAsync(ws + WS_CTL, 0, CTL_ZERO_BYTES, stream);
    Args a{};
    for (int i = 0; i < 32; ++i) a.in[i] = d_in[i];
    a.out = (float*)d_out; a.ws = ws;
#if MK_ONE
    a.ph_lo = 0; a.ph_hi = PH_COUNT;
    hipLaunchKernelGGL(mk, dim3(grid), dim3(NTHR), LDS_BYTES, stream, a);
#else
    for (int p = 0; p < PH_COUNT; ++p) { a.ph_lo = p; a.ph_hi = p + 1; hipLaunchKernelGGL(mk, dim3(grid), dim3(NTHR), LDS_BYTES, stream, a); }
#endif
}
```

```cpp
#include <hip/hip_runtime.h>
#include <stdint.h>
#include <math.h>
#include <stdio.h>

#define DI __device__ __forceinline__
#define LAS __attribute__((address_space(3)))
typedef unsigned short bf16_t;
typedef short bf16x8 __attribute__((ext_vector_type(8)));
typedef float f32x4 __attribute__((ext_vector_type(4)));
typedef float f32x16 __attribute__((ext_vector_type(16)));
typedef unsigned u32x2 __attribute__((ext_vector_type(2)));
typedef unsigned u32x4 __attribute__((ext_vector_type(4)));

constexpr int DM = 1024, SEQ = 4096, NB = 4, MP = NB * SEQ  , DB_ = 128, DT = 8, MS = DB_ * DT  , MT = MP + MS  ;
constexpr int PAST = 8192, PAGE = 128, NPAGES = PAST / PAGE  , NKEYS = PAST + DT  ;
constexpr int POOLD = 512, QDIM = 768, KVR = 256, ROPE = 32, NH = 8, QKH = 96, NOPE = 64, VH = 64;
constexpr int NZ0 = 1792  , DFF = 4096;
constexpr float EPS = 1e-6f;
constexpr float SM_SCALE = 0.10206207261596577f;
constexpr float QSCALE = 0.10206207261596577f * 1.4426950408889634f;

constexpr size_t O_Y = 0;
constexpr size_t O_CKV_P = (size_t)MT * DM;
constexpr size_t O_KR_P = O_CKV_P + (size_t)MP * KVR;
constexpr size_t O_POOL_P = O_KR_P + (size_t)MP * ROPE;
constexpr size_t O_CONV_P = O_POOL_P + (size_t)NB * 15 * POOLD;
constexpr size_t O_LRU_P = O_CONV_P + (size_t)NB * 3 * DM;
constexpr size_t O_CKV_S = O_LRU_P + (size_t)NB * DM;
constexpr size_t O_KR_S = O_CKV_S + (size_t)MS * KVR;
constexpr size_t O_POOL_S = O_KR_S + (size_t)MS * ROPE;
constexpr size_t O_CONV_S = O_POOL_S + (size_t)DB_ * 15 * POOLD;
constexpr size_t O_LRU_S = O_CONV_S + (size_t)DB_ * 3 * DM;
constexpr size_t O_END = O_LRU_S + (size_t)DB_ * DM;
static_assert(O_END == 24393728, "output size");

constexpr size_t MiB = 1u << 20;
constexpr size_t WS_CTL = 0, CTL_ZERO_BYTES = 256 * 1024;
constexpr size_t WS_WIN0T = 1 * MiB;
constexpr size_t WS_WKVT = 5 * MiB;
constexpr size_t WS_WPOOLT = 6 * MiB;
constexpr size_t WS_WGATET = 7 * MiB;
constexpr size_t WS_WOUT0T = 8 * MiB;
constexpr size_t WS_WOUTRT = 10 * MiB;
constexpr size_t WS_WINRT = 12 * MiB;
constexpr size_t WS_WUPT = 16 * MiB;
constexpr size_t WS_WDNT = 32 * MiB;
constexpr size_t WS_SSQ = 48 * MiB;
constexpr size_t WS_SP8 = 49 * MiB + 96 * 1024;
constexpr size_t WS_ROPE = 49 * MiB + 128 * 1024;
constexpr size_t WS_XB = 50 * MiB;
constexpr size_t WS_Z0 = 84 * MiB;
constexpr size_t WS_QB = 144 * MiB;
constexpr size_t WS_CB = 170 * MiB;
constexpr size_t WS_KRB = 179 * MiB;
constexpr size_t WS_DB = 181 * MiB;
constexpr size_t WS_KV = 944 * MiB;
constexpr size_t WS_MIX = 230 * MiB;
constexpr size_t WS_H = 264 * MiB;
constexpr size_t WS_GATE = 400 * MiB;
constexpr size_t WS_U = 434 * MiB;
constexpr size_t WS_V = 468 * MiB;
constexpr size_t WS_G = 502 * MiB;
constexpr size_t WS_HL = WS_G, WS_AC = WS_G + 34 * MiB, WS_SUM = WS_G + 68 * MiB;
constexpr size_t WS_YB = 638 * MiB;
constexpr size_t WS_SC = 672 * MiB;
constexpr size_t WS_LAT = 930 * MiB;
constexpr size_t WS_ACCS = 1136 * MiB;
constexpr size_t WS_PART = 1140 * MiB;
constexpr size_t WS_END = 1140 * MiB + 2 * 256 * 262144;
constexpr int CW_BAR = 4096;
constexpr int CW_DBG = 64;
constexpr int CW_SKT = 128;
constexpr int CW_SKF = 32768;
constexpr size_t WS_DBG = 1000 * MiB;
constexpr size_t WS_LATP = 980 * MiB;
constexpr size_t WS_ML = 998 * MiB;
#ifndef DBG_ATTN_P
#define DBG_ATTN_P 0
#endif
#ifndef DBG_ATTN_S
#define DBG_ATTN_S 0
#endif
#ifndef DBG_KNORM
#define DBG_KNORM 0
#endif
#ifndef DBG_RVR
#define DBG_RVR 0.004f
#endif
#define DBG_ANY (DBG_ATTN_P || DBG_ATTN_S || DBG_KNORM)
#ifndef REP_ID
#define REP_ID 0
#endif
#define REPN(id) ((REP_ID == (id)) ? 2 : 1)

constexpr int NWAVES = 8, NTHR = NWAVES * 64;
constexpr int LDS_BYTES = 163840;
constexpr int LDS_MISC = LDS_BYTES - 1024;

DI unsigned f2bf(float f) { unsigned u = __float_as_uint(f); return (u + 0x7fffu + ((u >> 16) & 1u)) >> 16; }
DI float bf2f(bf16_t b) { return __uint_as_float(((unsigned)b) << 16); }
DI unsigned pk2(float lo, float hi) { return f2bf(lo) | (f2bf(hi) << 16); }
DI float xsum16(float x) { auto r = __builtin_amdgcn_permlane16_swap(__float_as_uint(x), __float_as_uint(x), false, false); return __uint_as_float(r[0]) + __uint_as_float(r[1]); }
DI float xsum32(float x) { auto r = __builtin_amdgcn_permlane32_swap(__float_as_uint(x), __float_as_uint(x), false, false); return __uint_as_float(r[0]) + __uint_as_float(r[1]); }
DI float xmax16(float x) { auto r = __builtin_amdgcn_permlane16_swap(__float_as_uint(x), __float_as_uint(x), false, false); return fmaxf(__uint_as_float(r[0]), __uint_as_float(r[1])); }
DI float xmax32(float x) { auto r = __builtin_amdgcn_permlane32_swap(__float_as_uint(x), __float_as_uint(x), false, false); return fmaxf(__uint_as_float(r[0]), __uint_as_float(r[1])); }
template <int CTRL> DI float dppf(float v) { return __int_as_float(__builtin_amdgcn_update_dpp(0, __float_as_int(v), CTRL, 0xF, 0xF, true)); }
DI float xchg4(float v, bool upper) { const float a = dppf<0x104>(v), b = dppf<0x114>(v); return upper ? b : a; }
DI float max8(float v) { v = fmaxf(v, dppf<0xB1>(v)); v = fmaxf(v, dppf<0x4E>(v)); v = fmaxf(v, dppf<0x141>(v)); return v; }
DI float sum8(float v) { v += dppf<0xB1>(v); v += dppf<0x4E>(v); v += dppf<0x141>(v); return v; }
DI float sum16(float v) { v = sum8(v); v += dppf<0x140>(v); return v; }
DI float wave_sum(float v) { return xsum32(xsum16(sum16(v))); }
DI float wave_max(float v) {
#pragma unroll
    for (int o = 1; o < 64; o <<= 1) v = fmaxf(v, __shfl_xor(v, o));
    return v;
}
DI float row_rinv(const float* SSQ, int row) {
    float s = 0.f;
#pragma unroll
    for (int p = 0; p < 16; ++p) s += SSQ[(size_t)p * MT + row];
    return rsqrtf(s * (1.0f / DM) + EPS);
}
DI float max3f(float a, float b, float c) { float r; asm("v_max3_f32 %0, %1, %2, %3" : "=v"(r) : "v"(a), "v"(b), "v"(c)); return r; }
DI float gelu_tanh(float x) { const float u = 0.7978845608028654f * (x + 0.044715f * x * x * x); return x * __builtin_amdgcn_rcpf(1.0f + __builtin_amdgcn_exp2f(-2.0f * 1.4426950408889634f * u)); }
DI float sigmoidf(float x) { return 1.f / (1.f + expf(-x)); }

struct UPre { float v[8]; };
namespace pg8 {
constexpr int BM = 256, BK = 64, HALF = 128, HTB = HALF * BK * 2, STAGE_BYTES = 8 * HTB, NXCD = 8, WGM = 8;
__host__ __device__ __forceinline__ int lds_byte(int r, int c) { const int st = (r >> 4) * 2 + (c >> 5), rr = r & 15, cc = c & 31, ob = rr * 64 + cc * 2; return st * 1024 + (ob ^ (((ob >> 9) & 1) << 5)); }
__host__ __device__ __forceinline__ void stage_rc(int b, int& R, int& C) { const int st = b / 1024, sb = b % 1024, swz = sb ^ (((sb >> 9) & 1) << 5); R = (st >> 1) * 16 + swz / 64; C = (st & 1) * 32 + (swz % 64) / 2; }
struct Unit { int pm, pn; };
struct Gemm { const bf16_t* A; const bf16_t* Bt; int M, N, K, lda, a_tile_off, a_shift; unsigned* ready = nullptr; unsigned ready_target = 0; };
struct Seg { int pm, pn, t0, t1; };
struct StreamOrder {
    int nM, nN, ppu, ub, lo, hi;
    DI void init(int M, int N, int K, int G, int c) {
        nM = M / BM; nN = N / BM; ppu = K / (2 * BK);
        const int nwg = nM * nN, x = c % NXCD, k = c / NXCD, nk = G / NXCD, q = nwg / NXCD, r = nwg % NXCD;
        ub = x * q + (x < r ? x : r); const int cnt = q + (x < r ? 1 : 0); const int Pr = cnt * ppu;
        lo = (k * Pr) / nk; hi = ((k + 1) * Pr) / nk;
    }
    DI bool next(int i, Seg& s) const {
        const int ul = lo / ppu + i, start = ul * ppu; if (start >= hi) return false;
        const int p0 = (lo > start ? lo : start) - start, p1 = ((hi < start + ppu) ? hi : start + ppu) - start;
        s.t0 = 2 * p0; s.t1 = 2 * p1;
        const int wgid = ub + ul, nig = WGM * nN, gid = wgid / nig, fm = gid * WGM, gsz = (nM - fm) < WGM ? (nM - fm) : WGM;
        s.pm = fm + ((wgid % nig) % gsz); s.pn = (wgid % nig) / gsz; return true;
    }
};
struct SplitTailOrder {
    int nt, c, ways, plen;
    DI void init(int K, int c_) { nt = K / BK; c = c_; ways = 16; plen = nt / 16; if (plen < 2) { plen = 2; ways = nt / 2; } }
    DI bool next(int i, Seg& u) const {
        if (i == 0) { u.t0 = 0; u.t1 = nt; const int xcd = c % NXCD, off = c / NXCD, wgid = xcd * 32 + off; u.pm = (wgid >> 5) * 8 + (wgid & 7); u.pn = (wgid >> 3) & 3; return true; }
        if (i == 1) { const int us = c >> 4, part = c & 15; if (part >= ways) return false; u.pm = 64 + (us >> 2); u.pn = us & 3; u.t0 = part * plen; u.t1 = u.t0 + plen; return true; }
        return false;
    }
};
struct StaticOrder {
    int nM, nN, nwg, G, c, nt;
    DI void init(int M, int N, int K, int G_, int c_) { nM = M / BM; nN = N / BM; nwg = nM * nN; G = G_; c = c_; nt = K / BK; }
    DI bool next(int i, Seg& u) const {
        u.t0 = 0; u.t1 = nt;
        const long L = (long)i * G + c; if (L >= nwg) return false;
        int wgid = (int)L; { const int q = nwg / NXCD, r = nwg % NXCD, xcd = wgid % NXCD, off = wgid / NXCD; wgid = (xcd < r ? xcd * (q + 1) : r * (q + 1) + (xcd - r) * q) + off; }
        const int nig = WGM * nN, gid = wgid / nig, fm = gid * WGM, gsz = (nM - fm) < WGM ? (nM - fm) : WGM;
        u.pm = fm + ((wgid % nig) % gsz); u.pn = (wgid % nig) / gsz; return true;
    }
};
struct NoPre {};
__host__ __device__ __forceinline__ int perm32(int rho) { const int n = rho >> 4, i = rho & 15; return 8 * (i >> 2) + 4 * n + (i & 3); }
template <class F, bool P64 = false, bool P8 = false> struct EpiRows {
    F f;
    static constexpr bool PERM64 = P64;
    static constexpr bool PERM8 = P8;
    DI UPre unit_pre(int pm) const { return f.unit_pre(pm * BM); }
    DI void operator()(const f32x4 (&acc)[2][2][4][2], const Unit& u, int wr, int wc, int fr, int fq, const UPre& upre) const {
        constexpr int BJS = P64 ? 32 : HALF;
        const int row0 = u.pm * BM + wr * 64 + fr, col0 = u.pn * BM + wc * (P64 ? 64 : 32) + (P8 ? 8 : 4) * fq;
        f.unit_begin(u.pm * BM, upre);
#pragma unroll
        for (int ai = 0; ai < 2; ++ai) {
            typename F::RowPre rp[4]; typename F::Pre pr[4][2][2]; typename F::Pre8 pr8[4][2];
#pragma unroll
            for (int m = 0; m < 4; ++m) rp[m] = f.row_pre(row0 + ai * HALF + m * 16);
#pragma unroll
            for (int m = 0; m < 4; ++m)
#pragma unroll
                for (int bj = 0; bj < 2; ++bj)
#pragma unroll
                    for (int n = 0; n < 2; ++n) { if constexpr (P8) { if (n == 0) pr8[m][bj] = f.pre8(row0 + ai * HALF + m * 16, col0 + bj * BJS); } else pr[m][bj][n] = f.pre(row0 + ai * HALF + m * 16, col0 + bj * BJS + n * 16); }
#pragma unroll
            for (int m = 0; m < 4; ++m) {
                const int row = row0 + ai * HALF + m * 16;
                typename F::Ctx ctx = f.row_begin(row, rp[m]);
                if constexpr (P8) {
#pragma unroll
                    for (int bj = 0; bj < 2; ++bj) f.op8(ctx, row, col0 + bj * BJS, acc[ai][bj][m][0], acc[ai][bj][m][1], pr8[m][bj]);
                } else {
#pragma unroll
                    for (int bj = 0; bj < 2; ++bj)
#pragma unroll
                        for (int n = 0; n < 2; ++n) f(ctx, row, col0 + bj * BJS + n * 16, acc[ai][bj][m][n], pr[m][bj][n]);
                }
                f.row_end(ctx, row, u.pn, wc, fq);
            }
        }
    }
};

struct StreamCtl { float* part; unsigned* flags; unsigned* tmo; unsigned epoch; int c; int pad; };
struct NoPart { DI void operator()(const f32x4 (&)[2][2][4][2], const Unit&, int, int, int, int) const {} };
template <bool STREAM, class Sched, class Epi, class EpiPart = NoPart>
DI void gemm_phase(LAS unsigned char* lds, const Gemm g, const Sched& S, const Epi& E, const StreamCtl sc, const EpiPart EP = EpiPart()) {
    const int tid = threadIdx.x, wid = __builtin_amdgcn_readfirstlane(tid >> 6), lane = tid & 63, wr = wid >> 2, wc = wid & 3, fr = lane & 15, fq = lane >> 4;
    const int K = g.K, nt = K / BK;
    unsigned voffA[2], voffB[2];
#pragma unroll
    for (int i = 0; i < 2; ++i) { int R, C; stage_rc(tid * 16 + i * 8192, R, C); const int r31 = Epi::PERM8 ? perm32(R & 31) : (R & 31); const int Rb = Epi::PERM64 ? (64 * (R >> 5) + r31) : ((R & ~31) + r31); voffA[i] = (unsigned)(R * g.lda + C) * 2u; voffB[i] = (unsigned)(Rb * K + C) * 2u; }
    const size_t kstep = (size_t)(BK * 2);
    const size_t hstepA = (size_t)HALF * g.lda * 2, hstepB = (size_t)(Epi::PERM64 ? 32 : HALF) * K * 2;
    const size_t tstepA = 2 * hstepA, tstepB = (size_t)BM * K * 2, pstepA = (size_t)g.a_tile_off * 2;
    const unsigned ldsw = (unsigned)wid * 1024u;
    const int aoff = lds_byte(wr * 64 + fr, fq * 8), boff = lds_byte(wc * 32 + fr, fq * 8);
#define PG8_SA(b, h) (((b) * 2 + (h)) * HTB)
#define PG8_SB(b, h) ((4 + (b) * 2 + (h)) * HTB)
#define PG8_STAGE(bufoff, gbase, voff) do { _Pragma("unroll") for (int _i = 0; _i < 2; ++_i) \
        __builtin_amdgcn_global_load_lds((const unsigned*)((const char*)(gbase) + (voff)[_i]), (LAS unsigned*)(lds + (bufoff) + ldsw + _i * 8192), 16, 0, 0); } while (0)
#define PG8_LDA(dst, b, h) do { _Pragma("unroll") for (int m = 0; m < 4; ++m) _Pragma("unroll") for (int k = 0; k < 2; ++k) dst[m][k] = *(const LAS bf16x8*)(lds + PG8_SA(b, h) + aoff + m * 2048 + k * 1024); } while (0)
#define PG8_LDB(dst, b, h) do { _Pragma("unroll") for (int n = 0; n < 2; ++n) _Pragma("unroll") for (int k = 0; k < 2; ++k) dst[n][k] = *(const LAS bf16x8*)(lds + PG8_SB(b, h) + boff + n * 2048 + k * 1024); } while (0)
#define PG8_MMA(ai, bj, At, Bt) do { __builtin_amdgcn_s_setprio(1); _Pragma("unroll") for (int m = 0; m < 4; ++m) _Pragma("unroll") for (int n = 0; n < 2; ++n) _Pragma("unroll") for (int k = 0; k < 2; ++k) \
        acc[ai][bj][m][n] = __builtin_amdgcn_mfma_f32_16x16x32_bf16(Bt[n][k], At[m][k], acc[ai][bj][m][n], 0, 0, 0); __builtin_amdgcn_s_setprio(0); } while (0)
#define PG8_WAIT_V(n) asm volatile("s_waitcnt vmcnt(" #n ")" ::: "memory")
#define PG8_WAIT_L(n) asm volatile("s_waitcnt lgkmcnt(" #n ")" ::: "memory")
#define PG8_BAR __builtin_amdgcn_s_barrier()
#define PG8_SCHED __builtin_amdgcn_sched_barrier(0)
    Seg cur = {0, 0, 0, 0}, nxt = {0, 0, 0, 0}; int ui = 0;
    if (!S.next(0, cur)) return;
    bool waited = g.ready == nullptr;
#define PG8_READY_WAIT() do { if (wid == 0) { unsigned sp_ = 0; \
            while (__hip_atomic_load(g.ready, __ATOMIC_RELAXED, __HIP_MEMORY_SCOPE_AGENT) < g.ready_target) { __builtin_amdgcn_s_sleep(2); if (++sp_ > (1u << 22)) break; } \
            __builtin_amdgcn_fence(__ATOMIC_ACQUIRE, "agent"); asm volatile("s_waitcnt vmcnt(0)" ::: "memory"); } \
        PG8_BAR; asm volatile("" ::: "memory"); waited = true; } while (0)
#define PG8_BAR __builtin_amdgcn_s_barrier()
    if (!waited && cur.pm >= MP / 256) PG8_READY_WAIT();
    f32x4 acc[2][2][4][2];
#pragma unroll
    for (int a = 0; a < 2; ++a)
#pragma unroll
        for (int b = 0; b < 2; ++b)
#pragma unroll
            for (int m = 0; m < 4; ++m)
#pragma unroll
                for (int n = 0; n < 2; ++n) acc[a][b][m][n] = (f32x4){0.f, 0.f, 0.f, 0.f};
    bf16x8 At[4][2], B0[2][2], B1[2][2];
    const char* cA = (const char*)g.A + (size_t)cur.pm * tstepA + (size_t)(cur.pn >> g.a_shift) * pstepA + (size_t)cur.t0 * kstep;
    const char* cB = (const char*)g.Bt + (size_t)cur.pn * tstepB + (size_t)cur.t0 * kstep;
    PG8_STAGE(PG8_SB(0, 0), cB, voffB); PG8_STAGE(PG8_SB(0, 1), cB + hstepB, voffB); PG8_STAGE(PG8_SA(0, 0), cA, voffA); PG8_STAGE(PG8_SA(0, 1), cA + hstepA, voffA);
    if (wr == 1) PG8_BAR;
    PG8_WAIT_V(2); PG8_BAR;
    PG8_STAGE(PG8_SB(1, 0), cB + kstep, voffB); PG8_STAGE(PG8_SA(1, 0), cA + kstep, voffA); PG8_STAGE(PG8_SB(1, 1), cB + hstepB + kstep, voffB);
    PG8_WAIT_V(6); PG8_BAR;
    for (;;) {
        const bool has_next = S.next(ui + 1, nxt);
        if (!waited && has_next && nxt.pm >= MP / 256) PG8_READY_WAIT();
        const char* nA = has_next ? (const char*)g.A + (size_t)nxt.pm * tstepA + (size_t)(nxt.pn >> g.a_shift) * pstepA + (size_t)nxt.t0 * kstep : cA;
        const char* nB = has_next ? (const char*)g.Bt + (size_t)nxt.pn * tstepB + (size_t)nxt.t0 * kstep : cB;
        const int nseg = cur.t1 - cur.t0;
        UPre upre{}; if (STREAM || nseg == nt) upre = E.unit_pre(cur.pm);
#pragma unroll 1
        for (int t = 0; t < nseg; t += 2) {
            const bool last = (t == nseg - 2);
            const char* a1 = cA + (size_t)(t + 1) * kstep;
            const char* a2 = last ? nA : cA + (size_t)(t + 2) * kstep; const char* b2 = last ? nB : cB + (size_t)(t + 2) * kstep;
            const char* a3 = a2 + kstep; const char* b3 = b2 + kstep;
            PG8_LDB(B0, 0, 0); PG8_LDB(B1, 0, 1); PG8_SCHED; PG8_LDA(At, 0, 0); PG8_STAGE(PG8_SA(1, 1), a1 + hstepA, voffA);
            PG8_WAIT_V(8); PG8_WAIT_L(0); PG8_BAR; PG8_MMA(0, 0, At, B0); PG8_MMA(0, 1, At, B1); PG8_BAR; PG8_SCHED;
            PG8_LDA(At, 0, 1); PG8_STAGE(PG8_SB(0, 0), b2, voffB); PG8_STAGE(PG8_SB(0, 1), b2 + hstepB, voffB); PG8_STAGE(PG8_SA(0, 0), a2, voffA);
            PG8_WAIT_V(8); PG8_WAIT_L(0); PG8_BAR; PG8_MMA(1, 0, At, B0); PG8_MMA(1, 1, At, B1); PG8_BAR; PG8_SCHED;
            PG8_LDB(B0, 1, 0); PG8_LDB(B1, 1, 1); PG8_SCHED; PG8_LDA(At, 1, 0); PG8_STAGE(PG8_SA(0, 1), a2 + hstepA, voffA);
            PG8_WAIT_V(8); PG8_WAIT_L(0); PG8_BAR; PG8_MMA(0, 0, At, B0); PG8_MMA(0, 1, At, B1); PG8_BAR; PG8_SCHED;
            PG8_LDA(At, 1, 1); PG8_STAGE(PG8_SB(1, 0), b3, voffB); PG8_STAGE(PG8_SB(1, 1), b3 + hstepB, voffB); PG8_STAGE(PG8_SA(1, 0), a3, voffA);
            PG8_WAIT_V(8); PG8_WAIT_L(0); PG8_BAR; PG8_MMA(1, 0, At, B0); PG8_MMA(1, 1, At, B1); PG8_BAR; PG8_SCHED;
        }
        if (wr == 0) PG8_BAR;
        if (STREAM && cur.t0 > 0) {
            const __amdgpu_buffer_rsrc_t prs = __builtin_amdgcn_make_buffer_rsrc((void*)(sc.part + ((size_t)(sc.epoch & 1u) * gridDim.x + sc.c) * 65536), (short)0, 262144, 0x00020000);
#pragma unroll
            for (int a = 0; a < 2; ++a)
#pragma unroll
                for (int b = 0; b < 2; ++b)
#pragma unroll
                    for (int m = 0; m < 4; ++m)
#pragma unroll
                        for (int n = 0; n < 2; ++n) { const int j = ((a * 2 + b) * 4 + m) * 2 + n; const f32x4 v = acc[a][b][m][n];
                            __builtin_amdgcn_raw_buffer_store_b128(__builtin_bit_cast(u32x4, v), prs, (unsigned)tid * 16u, j * 8192, 16); }
            asm volatile("s_waitcnt vmcnt(0)" ::: "memory");
            PG8_BAR;
            if (tid == 0) __hip_atomic_store(sc.flags + (size_t)sc.c * 64, sc.epoch, __ATOMIC_RELAXED, __HIP_MEMORY_SCOPE_AGENT);
        } else {
            Unit uu; uu.pm = cur.pm; uu.pn = cur.pn;
            if (!STREAM && (cur.t1 - cur.t0) != nt) EP(acc, uu, wr, wc, fr, fq); else E(acc, uu, wr, wc, fr, fq, upre);
        }
        if (!has_next) break;
        if (STREAM && nxt.t1 < nt) {
            const int pc = sc.c + NXCD;
            if (wid == 0) {
                unsigned* fl = sc.flags + (size_t)pc * 64; unsigned sp = 0; bool ok = true;
                while (__hip_atomic_load(fl, __ATOMIC_RELAXED, __HIP_MEMORY_SCOPE_AGENT) != sc.epoch) {
                    __builtin_amdgcn_s_sleep(1);
                    if ((++sp & 255u) == 0u) { if (__hip_atomic_load(sc.tmo, __ATOMIC_RELAXED, __HIP_MEMORY_SCOPE_AGENT) != 0u || sp > (1u << 20)) { ok = false; break; } }
                }
                if (!ok && lane == 0) __hip_atomic_store(sc.tmo, 1u, __ATOMIC_RELAXED, __HIP_MEMORY_SCOPE_AGENT);
                __builtin_amdgcn_fence(__ATOMIC_ACQUIRE, "agent");
                asm volatile("s_waitcnt vmcnt(0)" ::: "memory");
            }
            PG8_BAR; asm volatile("" ::: "memory");
            const __amdgpu_buffer_rsrc_t crs = __builtin_amdgcn_make_buffer_rsrc((void*)(sc.part + ((size_t)(sc.epoch & 1u) * gridDim.x + pc) * 65536), (short)0, 262144, 0x00020000);
#pragma unroll
            for (int a = 0; a < 2; ++a)
#pragma unroll
                for (int b = 0; b < 2; ++b)
#pragma unroll
                    for (int m = 0; m < 4; ++m)
#pragma unroll
                        for (int n = 0; n < 2; ++n) acc[a][b][m][n] = __builtin_bit_cast(f32x4, __builtin_amdgcn_raw_buffer_load_b128(crs, (unsigned)tid * 16u, ((((a * 2 + b) * 4 + m) * 2 + n) * 8192), 0));
        } else {
#pragma unroll
            for (int a = 0; a < 2; ++a)
#pragma unroll
                for (int b = 0; b < 2; ++b)
#pragma unroll
                    for (int m = 0; m < 4; ++m)
#pragma unroll
                        for (int n = 0; n < 2; ++n) acc[a][b][m][n] = (f32x4){0.f, 0.f, 0.f, 0.f};
        }
        cur = nxt; cA = nA; cB = nB; ++ui;
        if (wr == 1) PG8_BAR;
    }
    PG8_WAIT_V(0);
    PG8_BAR;
#undef PG8_SA
#undef PG8_SB
#undef PG8_STAGE
#undef PG8_LDA
#undef PG8_LDB
#undef PG8_MMA
#undef PG8_WAIT_V
#undef PG8_WAIT_L
#undef PG8_BAR
#undef PG8_SCHED
}
}

constexpr int LDS_RINV = 131072;
DI UPre rinv_partial_load(const float* SSQ, int rowbase) {
    const int tid = threadIdx.x, r = tid >> 1, hf = tid & 1;
    UPre u;
#pragma unroll
    for (int p = 0; p < 8; ++p) u.v[p] = SSQ[(size_t)(hf * 8 + p) * MT + rowbase + r];
    return u;
}
DI void rinv_table_fill(const UPre& u) {
    extern __shared__ __attribute__((aligned(16))) unsigned char lds_raw_[];
    LAS float* tab = (LAS float*)((LAS unsigned char*)lds_raw_ + LDS_RINV);
    const int tid = threadIdx.x, r = tid >> 1, hf = tid & 1;
    float sv = ((u.v[0] + u.v[1]) + (u.v[2] + u.v[3])) + ((u.v[4] + u.v[5]) + (u.v[6] + u.v[7]));
    sv += dppf<0xB1>(sv);
    if (hf == 0) tab[r] = rsqrtf(sv * (1.0f / DM) + EPS);
    asm volatile("s_waitcnt lgkmcnt(0)" ::: "memory"); __builtin_amdgcn_s_barrier(); asm volatile("" ::: "memory");
}
DI float rinv_table_get(int row) {
    extern __shared__ __attribute__((aligned(16))) unsigned char lds_raw_[];
    return ((const LAS float*)((LAS unsigned char*)lds_raw_ + LDS_RINV))[row & 255];
}
struct FZ0 { typedef float Ctx; typedef float RowPre; typedef pg8::NoPre Pre; typedef pg8::NoPre Pre8; const float* SSQ; bf16_t* Z;
    DI UPre unit_pre(int rowbase) const { return rinv_partial_load(SSQ, rowbase); }
    DI void unit_begin(int, const UPre& sv) const { rinv_table_fill(sv); }
    DI RowPre row_pre(int row) const { return rinv_table_get(row); }
    DI Pre pre(int, int) const { return Pre{}; }
    DI pg8::NoPre pre8(int, int) const { return pg8::NoPre{}; }
    DI Ctx row_begin(int, const RowPre& rp) const { return rp; }
    DI void operator()(Ctx& ri, int row, int col, f32x4 v, const Pre&) const { u32x2 o; o.x = pk2(v.x * ri, v.y * ri); o.y = pk2(v.z * ri, v.w * ri); *(u32x2*)(Z + (size_t)row * NZ0 + col) = o; }
    DI void op8(Ctx& ri, int row, int col, f32x4 a, f32x4 b, const pg8::NoPre&) const { u32x4 o; o.x = pk2(a.x * ri, a.y * ri); o.y = pk2(a.z * ri, a.w * ri); o.z = pk2(b.x * ri, b.y * ri); o.w = pk2(b.z * ri, b.w * ri); *(u32x4*)(Z + (size_t)row * NZ0 + col) = o; }
    DI void row_end(Ctx&, int, int, int, int) const {} };
template <int LDO> struct FRawBf16 { typedef int Ctx; typedef pg8::NoPre RowPre; typedef pg8::NoPre Pre; typedef pg8::NoPre Pre8; bf16_t* O;
    DI UPre unit_pre(int) const { return UPre{}; }
    DI void unit_begin(int, const UPre&) const {}
    DI RowPre row_pre(int) const { return RowPre{}; }
    DI Pre pre(int, int) const { return Pre{}; }
    DI pg8::NoPre pre8(int, int) const { return pg8::NoPre{}; }
    DI Ctx row_begin(int, const RowPre&) const { return 0; }
    DI void operator()(Ctx&, int row, int col, f32x4 v, const Pre&) const { u32x2 o; o.x = pk2(v.x, v.y); o.y = pk2(v.z, v.w); *(u32x2*)(O + (size_t)row * LDO + col) = o; }
    DI void row_end(Ctx&, int, int, int, int) const {} };
struct KvCtx { f32x4 v[4]; int col0; int k; };
struct FKvNorm { typedef KvCtx Ctx; typedef pg8::NoPre RowPre; typedef pg8::NoPre Pre; typedef pg8::NoPre Pre8; bf16_t* O; const float* g;
    DI UPre unit_pre(int) const { return UPre{}; }
    DI void unit_begin(int, const UPre&) const {}
    DI RowPre row_pre(int) const { return RowPre{}; }
    DI Pre pre(int, int) const { return Pre{}; }
    DI pg8::NoPre pre8(int, int) const { return pg8::NoPre{}; }
    DI Ctx row_begin(int, const RowPre&) const { Ctx c; c.k = 0; c.col0 = 0; return c; }
    DI void operator()(Ctx&, int, int, f32x4, const Pre&) const {}
    DI void op8(Ctx& c, int, int col, f32x4 a, f32x4 b, const pg8::NoPre&) const { if (c.k == 0) c.col0 = col; c.v[c.k] = a; c.v[c.k + 1] = b; c.k += 2; }
    DI void row_end(Ctx& c, int row, int pn, int, int) const {
        float ri = 1.0f;
        if (pn < 2) { float ss = 0.f;
#pragma unroll
            for (int k = 0; k < 4; ++k) ss += c.v[k].x * c.v[k].x + c.v[k].y * c.v[k].y + c.v[k].z * c.v[k].z + c.v[k].w * c.v[k].w;
            ss = xsum32(xsum16(ss)); ri = rsqrtf(ss * (1.f / 64.f) + EPS); }
#pragma unroll
        for (int bj = 0; bj < 2; ++bj) { const int col = c.col0 + bj * 32; f32x4 y0 = c.v[2 * bj] * ri, y1 = c.v[2 * bj + 1] * ri;
            if (pn < 2) { y0 = y0 * *(const f32x4*)(g + (col & 63)); y1 = y1 * *(const f32x4*)(g + (col & 63) + 4); }
            u32x4 o; o.x = pk2(y0.x, y0.y); o.y = pk2(y0.z, y0.w); o.z = pk2(y1.x, y1.y); o.w = pk2(y1.z, y1.w); *(u32x4*)(O + (size_t)row * 1024 + col) = o; }
    } };
struct FPool { typedef int Ctx; typedef pg8::NoPre RowPre; typedef f32x4 Pre; typedef pg8::NoPre Pre8; const float* scale; bf16_t* MIX;
    DI pg8::NoPre pre8(int, int) const { return pg8::NoPre{}; }
    DI void op8(Ctx&, int row, int col, f32x4 a, f32x4 b, const pg8::NoPre&) const { const f32x4 s0 = *(const f32x4*)(scale + col), s1 = *(const f32x4*)(scale + col + 4);
        u32x4 o; o.x = pk2(a.x * s0.x, a.y * s0.y); o.y = pk2(a.z * s0.z, a.w * s0.w); o.z = pk2(b.x * s1.x, b.y * s1.y); o.w = pk2(b.z * s1.z, b.w * s1.w); *(u32x4*)(MIX + (size_t)row * DM + col) = o; }
    DI UPre unit_pre(int) const { return UPre{}; }
    DI void unit_begin(int, const UPre&) const {}
    DI RowPre row_pre(int) const { return RowPre{}; }
    DI Pre pre(int, int col) const { return *(const f32x4*)(scale + col); }
    DI Ctx row_begin(int, const RowPre&) const { return 0; }
    DI void operator()(Ctx&, int row, int col, f32x4 v, const Pre& s) const { u32x2 o; o.x = pk2(v.x * s.x, v.y * s.y); o.y = pk2(v.z * s.z, v.w * s.w); *(u32x2*)(MIX + (size_t)row * DM + col) = o; }
    DI void row_end(Ctx&, int, int, int, int) const {} };
template <bool FINAL> struct FResid { typedef float Ctx; typedef pg8::NoPre RowPre; typedef u32x2 Pre; typedef u32x4 Pre8; bf16_t* RB; float* Yf; float* SSQ;
    DI Pre8 pre8(int row, int col) const { return *(const u32x4*)(RB + (size_t)row * DM + col); }
    DI void op8(Ctx& ss, int row, int col, f32x4 a, f32x4 b, const Pre8& r) const {
        f32x4 y0, y1; y0.x = __uint_as_float(r.x << 16) + a.x; y0.y = __uint_as_float(r.x & 0xffff0000u) + a.y; y0.z = __uint_as_float(r.y << 16) + a.z; y0.w = __uint_as_float(r.y & 0xffff0000u) + a.w;
        y1.x = __uint_as_float(r.z << 16) + b.x; y1.y = __uint_as_float(r.z & 0xffff0000u) + b.y; y1.z = __uint_as_float(r.w << 16) + b.z; y1.w = __uint_as_float(r.w & 0xffff0000u) + b.w;
        if (FINAL) { *(f32x4*)(Yf + (size_t)row * DM + col) = y0; *(f32x4*)(Yf + (size_t)row * DM + col + 4) = y1; }
        else { u32x4 o; o.x = pk2(y0.x, y0.y); o.y = pk2(y0.z, y0.w); o.z = pk2(y1.x, y1.y); o.w = pk2(y1.z, y1.w); *(u32x4*)(RB + (size_t)row * DM + col) = o;
            ss += y0.x * y0.x + y0.y * y0.y + y0.z * y0.z + y0.w * y0.w + y1.x * y1.x + y1.y * y1.y + y1.z * y1.z + y1.w * y1.w; } }
    DI UPre unit_pre(int) const { return UPre{}; }
    DI void unit_begin(int, const UPre&) const {}
    DI RowPre row_pre(int) const { return RowPre{}; }
    DI Pre pre(int row, int col) const { return *(const u32x2*)(RB + (size_t)row * DM + col); }
    DI Ctx row_begin(int, const RowPre&) const { return 0.f; }
    DI void operator()(Ctx& ss, int row, int col, f32x4 v, const Pre& r) const {
        f32x4 y; y.x = __uint_as_float(r.x << 16) + v.x; y.y = __uint_as_float(r.x & 0xffff0000u) + v.y; y.z = __uint_as_float(r.y << 16) + v.z; y.w = __uint_as_float(r.y & 0xffff0000u) + v.w;
        if (FINAL) { *(f32x4*)(Yf + (size_t)row * DM + col) = y; }
        else { u32x2 o; o.x = pk2(y.x, y.y); o.y = pk2(y.z, y.w); *(u32x2*)(RB + (size_t)row * DM + col) = o; ss += y.x * y.x + y.y * y.y + y.z * y.z + y.w * y.w; } }
    DI void row_end(Ctx& ss, int row, int pn, int wc, int fq) const { if (!FINAL) { const float s = xsum32(xsum16(ss)); if (fq == 0) SSQ[(size_t)(pn * 4 + wc) * MT + row] = s; } } };
struct FNull { typedef int Ctx; typedef pg8::NoPre RowPre; typedef pg8::NoPre Pre; typedef pg8::NoPre Pre8; float* sink;
    DI UPre unit_pre(int) const { return UPre{}; }
    DI void unit_begin(int, const UPre&) const {}
    DI RowPre row_pre(int) const { return RowPre{}; }
    DI Pre pre(int, int) const { return Pre{}; }
    DI pg8::NoPre pre8(int, int) const { return pg8::NoPre{}; }
    DI Ctx row_begin(int, const RowPre&) const { return 0; }
    DI void operator()(Ctx&, int row, int col, f32x4 v, const Pre&) const { if (v.x == 1.2345e30f) sink[row + col] = v.y; }
    DI void row_end(Ctx&, int, int, int, int) const {} };
struct FUp { typedef float Ctx; typedef float RowPre; typedef pg8::NoPre Pre; typedef pg8::NoPre Pre8; const float* SSQ; bf16_t* H;
    DI UPre unit_pre(int rowbase) const { return rinv_partial_load(SSQ, rowbase); }
    DI void unit_begin(int, const UPre& sv) const { rinv_table_fill(sv); }
    DI RowPre row_pre(int row) const { return rinv_table_get(row); }
    DI Pre pre(int, int) const { return Pre{}; }
    DI pg8::NoPre pre8(int, int) const { return pg8::NoPre{}; }
    DI Ctx row_begin(int, const RowPre& rp) const { return rp; }
    DI void operator()(Ctx& ri, int row, int col, f32x4 v, const Pre&) const { f32x4 t = v * ri; t.x = fmaxf(t.x, 0.f); t.y = fmaxf(t.y, 0.f); t.z = fmaxf(t.z, 0.f); t.w = fmaxf(t.w, 0.f);
        u32x2 o; o.x = pk2(t.x * t.x, t.y * t.y); o.y = pk2(t.z * t.z, t.w * t.w); *(u32x2*)(H + (size_t)row * DFF + col) = o; }
    DI void op8(Ctx& ri, int row, int col, f32x4 a, f32x4 b, const pg8::NoPre&) const { f32x4 t = a * ri, w = b * ri;
        t.x = fmaxf(t.x, 0.f); t.y = fmaxf(t.y, 0.f); t.z = fmaxf(t.z, 0.f); t.w = fmaxf(t.w, 0.f); w.x = fmaxf(w.x, 0.f); w.y = fmaxf(w.y, 0.f); w.z = fmaxf(w.z, 0.f); w.w = fmaxf(w.w, 0.f);
        u32x4 o; o.x = pk2(t.x * t.x, t.y * t.y); o.y = pk2(t.z * t.z, t.w * t.w); o.z = pk2(w.x * w.x, w.y * w.y); o.w = pk2(w.z * w.z, w.w * w.w); *(u32x4*)(H + (size_t)row * DFF + col) = o; }
    DI void row_end(Ctx&, int, int, int, int) const {} };
struct FRnnIn { typedef float Ctx; typedef float RowPre; typedef pg8::NoPre Pre; typedef pg8::NoPre Pre8; const float* SSQ; bf16_t* GATE; bf16_t* U;
    DI UPre unit_pre(int rowbase) const { return rinv_partial_load(SSQ, rowbase); }
    DI void unit_begin(int, const UPre& sv) const { rinv_table_fill(sv); }
    DI RowPre row_pre(int row) const { return rinv_table_get(row); }
    DI Pre pre(int, int) const { return Pre{}; }
    DI pg8::NoPre pre8(int, int) const { return pg8::NoPre{}; }
    DI Ctx row_begin(int, const RowPre& rp) const { return rp; }
    DI void operator()(Ctx& ri, int row, int col, f32x4 v, const Pre&) const { f32x4 t = v * ri; u32x2 o;
        if (col < DM) { o.x = pk2(gelu_tanh(t.x), gelu_tanh(t.y)); o.y = pk2(gelu_tanh(t.z), gelu_tanh(t.w)); *(u32x2*)(GATE + (size_t)row * DM + col) = o; }
        else { o.x = pk2(t.x, t.y); o.y = pk2(t.z, t.w); *(u32x2*)(U + (size_t)row * DM + col - DM) = o; } }
    DI void op8(Ctx& ri, int row, int col, f32x4 a, f32x4 b, const pg8::NoPre&) const { const f32x4 t = a * ri, w = b * ri; u32x4 o;
        if (col < DM) { o.x = pk2(gelu_tanh(t.x), gelu_tanh(t.y)); o.y = pk2(gelu_tanh(t.z), gelu_tanh(t.w)); o.z = pk2(gelu_tanh(w.x), gelu_tanh(w.y)); o.w = pk2(gelu_tanh(w.z), gelu_tanh(w.w)); *(u32x4*)(GATE + (size_t)row * DM + col) = o; }
        else { o.x = pk2(t.x, t.y); o.y = pk2(t.z, t.w); o.z = pk2(w.x, w.y); o.w = pk2(w.z, w.w); *(u32x4*)(U + (size_t)row * DM + col - DM) = o; } }
    DI void row_end(Ctx&, int, int, int, int) const {} };

typedef float f32x2_t __attribute__((ext_vector_type(2))); typedef __bf16 bf16x2_t __attribute__((ext_vector_type(2)));
DI unsigned cvtpk(float lo, float hi) { f32x2_t v = {lo, hi}; bf16x2_t b = __builtin_convertvector(v, bf16x2_t); return __builtin_bit_cast(unsigned, b); }
struct EpiPartStore { float* PARTS; int part;
    DI void operator()(const f32x4 (&acc)[2][2][4][2], const pg8::Unit& u, int, int, int, int) const {
        const int us = (u.pm - MP / 256) * 4 + u.pn;
        f32x4* p = (f32x4*)(PARTS + (size_t)(us * 16 + part) * 65536) + threadIdx.x;
#pragma unroll
        for (int a = 0; a < 2; ++a)
#pragma unroll
            for (int b = 0; b < 2; ++b)
#pragma unroll
                for (int m = 0; m < 4; ++m)
#pragma unroll
                    for (int n = 0; n < 2; ++n) p[(((a * 2 + b) * 4 + m) * 2 + n) * 512] = acc[a][b][m][n];
    }
};
template <bool FINAL, int WAYS = 16> DI void sample_fixup(int b, const float* __restrict__ PARTS, bf16_t* __restrict__ RB, float* __restrict__ Yf, float* __restrict__ SSQ) {
    if (b >= 128) return;
    const int tid = threadIdx.x, wid = tid >> 6, lane = tid & 63, wr = wid >> 2, wc = wid & 3, fr = lane & 15, fq = lane >> 4;
    const int us = b >> 3, ai = (b >> 2) & 1, m = b & 3, pm = MP / 256 + (us >> 2), pn = us & 3;
    f32x4 v[2][2];
#pragma unroll
    for (int bj = 0; bj < 2; ++bj)
#pragma unroll
        for (int n = 0; n < 2; ++n) v[bj][n] = (f32x4){0.f, 0.f, 0.f, 0.f};
#pragma unroll 4
    for (int p = 0; p < WAYS; ++p) {
        const f32x4* pp = (const f32x4*)(PARTS + (size_t)(us * 16 + p) * 65536) + tid;
#pragma unroll
        for (int bj = 0; bj < 2; ++bj)
#pragma unroll
            for (int n = 0; n < 2; ++n) v[bj][n] += pp[(((ai * 2 + bj) * 4 + m) * 2 + n) * 512];
    }
    const int row = pm * 256 + ai * 128 + wr * 64 + m * 16 + fr, col0 = pn * 256 + wc * 32 + 8 * fq;
    float ss = 0.f;
#pragma unroll
    for (int bj = 0; bj < 2; ++bj)
#pragma unroll
        for (int n = 0; n < 2; ++n) { const size_t off = (size_t)row * DM + col0 + bj * 128 + n * 4; const u32x2 r = *(const u32x2*)(RB + off); const f32x4 a = v[bj][n];
            f32x4 y; y.x = __uint_as_float(r.x << 16) + a.x; y.y = __uint_as_float(r.x & 0xffff0000u) + a.y; y.z = __uint_as_float(r.y << 16) + a.z; y.w = __uint_as_float(r.y & 0xffff0000u) + a.w;
            if (FINAL) *(f32x4*)(Yf + off) = y;
            else { u32x2 o; o.x = pk2(y.x, y.y); o.y = pk2(y.z, y.w); *(u32x2*)(RB + off) = o; ss += y.x * y.x + y.y * y.y + y.z * y.z + y.w * y.w; } }
    if (!FINAL) { ss = xsum32(xsum16(ss)); if (fq == 0) SSQ[(size_t)(pn * 4 + wc) * MT + row] = ss; }
}
template <int SH> DI float dpp_row_shr(float oldv, float v) { return __int_as_float(__builtin_amdgcn_update_dpp(__float_as_int(oldv), __float_as_int(v), 0x110 + SH, 0xF, 0xF, false)); }
template <int SH> DI void scan_step(float& a, float& b, int fseg) {
    float ap = dpp_row_shr<SH>(1.0f, a), bp = dpp_row_shr<SH>(0.0f, b);
    if (fseg < SH) { ap = 1.0f; bp = 0.0f; }
    b = a * bp + b; a = a * ap;
}
struct EpiGates {
    static constexpr bool PERM64 = false, PERM8 = true;
    const bf16_t* V; const float* bga; const float* bgx; const float* lam; bf16_t* HL; bf16_t* AC; float* SUM;
    DI UPre unit_pre(int) const { return UPre{}; }
    DI void operator()(f32x4 (&acc)[2][2][4][2], const pg8::Unit& u, int wr, int wc, int fr, int fq, const UPre&) const {
        const bool isp = u.pm < MP / 256;
        const int chb = u.pn * 128 + wc * 32 + 8 * fq;
        const int rowb = u.pm * 256 + wr * 64 + fr;
        u32x4 vpre[2][4];
#pragma unroll
        for (int ai = 0; ai < 2; ++ai)
#pragma unroll
            for (int m = 0; m < 4; ++m) vpre[ai][m] = *(const u32x4*)(V + (size_t)(rowb + ai * 128 + m * 16) * DM + chb);
#pragma unroll
        for (int n = 0; n < 2; ++n) {
            const f32x4 sp = *(const f32x4*)(lam + chb + 4 * n), ba = *(const f32x4*)(bga + chb + 4 * n), bx = *(const f32x4*)(bgx + chb + 4 * n);
#pragma unroll
            for (int ai = 0; ai < 2; ++ai)
#pragma unroll
                for (int m = 0; m < 4; ++m) {
                    const int row = rowb + ai * 128 + m * 16;
                    const bool pos0 = isp && ((row & (SEQ - 1)) == 0);
                    const unsigned w0 = n == 0 ? vpre[ai][m].x : vpre[ai][m].z, w1 = n == 0 ? vpre[ai][m].y : vpre[ai][m].w;
                    const float v4[4] = {__uint_as_float(w0 << 16), __uint_as_float(w0 & 0xffff0000u), __uint_as_float(w1 << 16), __uint_as_float(w1 & 0xffff0000u)};
#pragma unroll
                    for (int e = 0; e < 4; ++e) {
                        const float r = __builtin_amdgcn_rcpf(1.0f + __builtin_amdgcn_exp2f(-1.4426950408889634f * (acc[ai][0][m][n][e] + ba[e])));
                        const float ig = __builtin_amdgcn_rcpf(1.0f + __builtin_amdgcn_exp2f(-1.4426950408889634f * (acc[ai][1][m][n][e] + bx[e])));
                        const float a = __builtin_amdgcn_exp2f(-r * sp[e]);
                        const float mult = pos0 ? 1.0f : __builtin_amdgcn_sqrtf(fmaxf(1.0f - a * a, 0.0f));
                        acc[ai][0][m][n][e] = a; acc[ai][1][m][n][e] = mult * ig * v4[e];
                    }
                }
        }
        const int fseg = isp ? fr : (fr & 7);
#pragma unroll
        for (int ai = 0; ai < 2; ++ai)
#pragma unroll
            for (int n = 0; n < 2; ++n)
#pragma unroll
                for (int e = 0; e < 4; ++e) {
                    float Ac = 1.0f, Hc = 0.0f;
#pragma unroll
                    for (int m = 0; m < 4; ++m) {
                        float a = acc[ai][0][m][n][e], b = acc[ai][1][m][n][e];
                        scan_step<1>(a, b, fseg); scan_step<2>(a, b, fseg); scan_step<4>(a, b, fseg);
                        if (isp) { scan_step<8>(a, b, fseg); b = a * Hc + b; a = a * Ac; Ac = __int_as_float(__builtin_amdgcn_update_dpp(0, __float_as_int(a), 0x15F, 0xF, 0xF, false)); Hc = __int_as_float(__builtin_amdgcn_update_dpp(0, __float_as_int(b), 0x15F, 0xF, 0xF, false)); }
                        acc[ai][0][m][n][e] = a; acc[ai][1][m][n][e] = b;
                    }
                    if (isp && fr == 15) { float* sm = SUM + ((size_t)(u.pm * 4 + ai * 2 + wr) * DM + chb + 4 * n + e) * 2; sm[0] = Ac; sm[1] = Hc; }
                }
#pragma unroll
        for (int ai = 0; ai < 2; ++ai)
#pragma unroll
            for (int m = 0; m < 4; ++m) {
                const size_t off = (size_t)(rowb + ai * 128 + m * 16) * DM + chb;
                u32x4 oa; oa.x = pk2(acc[ai][0][m][0][0], acc[ai][0][m][0][1]); oa.y = pk2(acc[ai][0][m][0][2], acc[ai][0][m][0][3]); oa.z = pk2(acc[ai][0][m][1][0], acc[ai][0][m][1][1]); oa.w = pk2(acc[ai][0][m][1][2], acc[ai][0][m][1][3]);
                *(u32x4*)(AC + off) = oa;
                u32x4 ob; ob.x = pk2(acc[ai][1][m][0][0], acc[ai][1][m][0][1]); ob.y = pk2(acc[ai][1][m][0][2], acc[ai][1][m][0][3]); ob.z = pk2(acc[ai][1][m][1][0], acc[ai][1][m][1][1]); ob.w = pk2(acc[ai][1][m][1][2], acc[ai][1][m][1][3]);
                *(u32x4*)(HL + off) = ob;
            }
    }
};

DI void gates_sample_item(int item, int w, int lane, const bf16_t* __restrict__ V, const bf16_t* __restrict__ WGATET, const float* __restrict__ bga, const float* __restrict__ bgx, const float* __restrict__ SP8,
                          const bf16_t* __restrict__ GATE, const float* __restrict__ state_lru, bf16_t* __restrict__ YB, float* __restrict__ out) {
    const int p = item >> 3, n = item & 7, l15 = lane & 15, quad = lane >> 4;
    const int row0 = MP + p * 16, jch = 16 * w + l15, ch = 128 * n + jch;
    const bf16_t* ap = V + (size_t)(row0 + l15) * DM + 128 * n + 8 * quad;
    const bf16_t* bpa = WGATET + (size_t)(n * 256 + jch) * 256 + (n & 1) * 128 + 8 * quad;
    const bf16_t* bpx = bpa + (size_t)128 * 256;
    f32x4 ca = {0.f, 0.f, 0.f, 0.f}, cx = {0.f, 0.f, 0.f, 0.f};
#pragma unroll
    for (int st = 0; st < 4; ++st) {
        const bf16x8 a = *(const bf16x8*)(ap + 32 * st), wa = *(const bf16x8*)(bpa + 32 * st), wx = *(const bf16x8*)(bpx + 32 * st);
        ca = __builtin_amdgcn_mfma_f32_16x16x32_bf16(a, wa, ca, 0, 0, 0);
        cx = __builtin_amdgcn_mfma_f32_16x16x32_bf16(a, wx, cx, 0, 0, 0);
    }
    const float ba = bga[ch], bx_ = bgx[ch], sp = SP8[ch];
    const int seq = 2 * p + (quad >> 1), rbase = row0 + 4 * quad;
    float Aq[4], Hq[4], gt[4];
    float Ac = 1.f, Hc = 0.f;
#pragma unroll
    for (int j = 0; j < 4; ++j) {
        const float v = bf2f(V[(size_t)(rbase + j) * DM + ch]); gt[j] = bf2f(GATE[(size_t)(rbase + j) * DM + ch]);
        const float r = __builtin_amdgcn_rcpf(1.0f + __builtin_amdgcn_exp2f(-1.4426950408889634f * (ca[j] + ba)));
        const float ig = __builtin_amdgcn_rcpf(1.0f + __builtin_amdgcn_exp2f(-1.4426950408889634f * (cx[j] + bx_)));
        const float a = __builtin_amdgcn_exp2f(-r * sp);
        const float b = __builtin_amdgcn_sqrtf(fmaxf(1.0f - a * a, 0.0f)) * ig * v;
        Hc = a * Hc + b; Ac = a * Ac; Aq[j] = Ac; Hq[j] = Hc;
    }
    const float h0 = state_lru[(size_t)seq * DM + ch];
    const float pA = __int_as_float(__builtin_amdgcn_ds_bpermute((lane - 16) * 4, __float_as_int(Ac)));
    const float pH = __int_as_float(__builtin_amdgcn_ds_bpermute((lane - 16) * 4, __float_as_int(Hc)));
    const float hin = (quad & 1) ? (pA * h0 + pH) : h0;
#pragma unroll
    for (int j = 0; j < 4; ++j) {
        const float h = Aq[j] * hin + Hq[j];
        YB[(size_t)(rbase + j) * DM + ch] = f2bf(gt[j] * h);
        if ((quad & 1) && j == 3) out[O_LRU_S + (size_t)seq * DM + ch] = h;
    }
}
constexpr int RS_ROW = 2064, RS_RINV = 64 * RS_ROW;
DI void rnnin_sample_item(int item, LAS unsigned char* lds, const bf16_t* __restrict__ XB, const bf16_t* __restrict__ WINRT, const float* __restrict__ SSQ, bf16_t* __restrict__ GATE, bf16_t* __restrict__ U) {
    const int tid = threadIdx.x, lane = tid & 63, w = __builtin_amdgcn_readfirstlane(tid >> 6), l15 = lane & 15, quad = lane >> 4;
    const int rowbase = MP + (item >> 4) * 64, colbase = (item & 15) * 128;
    __syncthreads();
    { u32x4 st[16];
#pragma unroll
      for (int i = 0; i < 16; ++i) { const int c = tid + 512 * i, r = c >> 7, cc = c & 127; st[i] = *(const u32x4*)(XB + (size_t)(rowbase + r) * DM + cc * 8); }
#pragma unroll
      for (int i = 0; i < 16; ++i) { const int c = tid + 512 * i, r = c >> 7, cc = c & 127; *(LAS u32x4*)(lds + r * RS_ROW + cc * 16) = st[i]; } }
    if (tid < 64) { float sv = 0.f;
#pragma unroll
        for (int p = 0; p < 16; ++p) sv += SSQ[(size_t)p * MT + rowbase + tid];
        *(LAS float*)(lds + RS_RINV + tid * 4) = rsqrtf(sv * (1.0f / DM) + EPS); }
    const bf16_t* bp = WINRT + (size_t)(colbase + 16 * w + l15) * DM + 8 * quad;
    constexpr int PF = 8;
    bf16x8 bq[PF];
#pragma unroll
    for (int s2 = 0; s2 < PF; ++s2) bq[s2] = *(const bf16x8*)(bp + 32 * s2);
    __syncthreads();
    f32x4 acc[4];
#pragma unroll
    for (int mi = 0; mi < 4; ++mi) acc[mi] = (f32x4){0.f, 0.f, 0.f, 0.f};
    const LAS unsigned char* abase = lds + l15 * RS_ROW + quad * 16;
#pragma unroll
    for (int s2 = 0; s2 < 32; ++s2) {
        const bf16x8 b = bq[s2 % PF];
        if (s2 + PF < 32) bq[s2 % PF] = *(const bf16x8*)(bp + 32 * (s2 + PF));
#pragma unroll
        for (int mi = 0; mi < 4; ++mi) { const bf16x8 a = *(const LAS bf16x8*)(abase + mi * 16 * RS_ROW + s2 * 64); acc[mi] = __builtin_amdgcn_mfma_f32_16x16x32_bf16(a, b, acc[mi], 0, 0, 0); }
    }
    const int col = colbase + 16 * w + l15;
#pragma unroll
    for (int mi = 0; mi < 4; ++mi)
#pragma unroll
        for (int j = 0; j < 4; ++j) { const int rl = 16 * mi + 4 * quad + j; const float t = acc[mi][j] * *(const LAS float*)(lds + RS_RINV + rl * 4);
            if (col < DM) GATE[(size_t)(rowbase + rl) * DM + col] = f2bf(gelu_tanh(t)); else U[(size_t)(rowbase + rl) * DM + col - DM] = f2bf(t); }
}
#define XB_TMO      128
#define XB_XCNT(j)  (256  + 64 * (j))
#define XB_XSUB(j)  (1280 + 64 * (j))
#define XB_XGEN(j)  (2304 + 64 * (j))
#define XB_TOP      3328
#define XB_TOPGEN   3392
#define XCD_BAR_WORDS 3456
#define XB_SPIN_CAP (1u << 18)
DI unsigned xb_ld(unsigned* p)              { return __hip_atomic_load(p, __ATOMIC_RELAXED, __HIP_MEMORY_SCOPE_AGENT); }
DI unsigned xb_add(unsigned* p, unsigned v) { return __hip_atomic_fetch_add(p, v, __ATOMIC_RELAXED, __HIP_MEMORY_SCOPE_AGENT); }
DI unsigned xb_xcc_id() { return (unsigned)__builtin_amdgcn_s_getreg((3 << 11) | 20) & 0xFu; }
#define XB_SPIN(cond, bar) do { unsigned _sp = 0; while (cond) { __builtin_amdgcn_s_sleep(1); \
    if ((++_sp & 255u) == 0u) { if (xb_ld(&(bar)[XB_TMO])) break; if (_sp > XB_SPIN_CAP) { atomicAdd(&(bar)[XB_TMO], 1u); break; } } } } while (0)
struct XcdBarrier { unsigned* bar; unsigned x; volatile LAS unsigned* st; };
DI XcdBarrier xcd_barrier_post(unsigned* bar, volatile LAS unsigned* st) {
    XcdBarrier b; b.bar = bar; b.x = xb_xcc_id(); b.st = st;
    if (threadIdx.x == 0) (void)xb_add(&bar[XB_XCNT(b.x)], 1u);
    return b;
}
DI void xcd_barrier_complete(unsigned* bar, unsigned x, unsigned& nloc, unsigned& nx) {
    const unsigned G = gridDim.x * gridDim.y * gridDim.z;
    unsigned sum, cnt, mine, sp = 0u;
    for (;;) {
        sum = 0u; cnt = 0u; mine = 0u;
#pragma unroll
        for (unsigned j = 0; j < 16; ++j) { const unsigned c = xb_ld(&bar[XB_XCNT(j)]); sum += c; cnt += (c > 0u) ? 1u : 0u; mine = (j == x) ? c : mine; }
        if (sum == G) break;
        __builtin_amdgcn_s_sleep(1);
        if ((++sp & 255u) == 0u) { if (xb_ld(&bar[XB_TMO])) break; if (sp > XB_SPIN_CAP) { atomicAdd(&bar[XB_TMO], 1u); break; } }
    }
    nloc = mine > 0u ? mine : 1u; nx = cnt > 0u ? cnt : 1u;
}
DI void xcd_barrier(const XcdBarrier& b) {
    asm volatile("s_waitcnt vmcnt(0)" ::: "memory");
    __syncthreads();
    if (threadIdx.x == 0) {
        unsigned* bar = b.bar;
        __builtin_amdgcn_s_waitcnt(0);
        unsigned nloc = b.st[0], nx = b.st[1];
        if (nloc == 0u) { xcd_barrier_complete(bar, b.x, nloc, nx); b.st[0] = nloc; b.st[1] = nx; }
        const unsigned old = xb_add(&bar[XB_XSUB(b.x)], 1u);
        const unsigned gen = old / nloc;
        if (old + 1u == (gen + 1u) * nloc) {
            __builtin_amdgcn_fence(__ATOMIC_RELEASE, "agent");
            asm volatile("s_waitcnt vmcnt(0)" ::: "memory");
            const unsigned og = xb_add(&bar[XB_TOP], 1u);
            const unsigned tg = og / nx;
            if (og + 1u == (tg + 1u) * nx) xb_add(&bar[XB_TOPGEN], 1u);
            else XB_SPIN(xb_ld(&bar[XB_TOPGEN]) == tg, bar);
            __builtin_amdgcn_fence(__ATOMIC_ACQUIRE, "agent");
            xb_add(&bar[XB_XGEN(b.x)], 1u);
            asm volatile("s_waitcnt vmcnt(0)" ::: "memory");
        } else {
            XB_SPIN(xb_ld(&bar[XB_XGEN(b.x)]) == gen, bar);
            __builtin_amdgcn_fence(__ATOMIC_ACQUIRE, "agent");
            asm volatile("s_waitcnt vmcnt(0)" ::: "memory");
        }
    }
    __syncthreads();
}

struct Args { const void* in[32]; float* out; unsigned char* ws; int ph_lo, ph_hi; };
static_assert(sizeof(Args) == 32 * 8 + 8 + 8 + 8, "Args has no padding");

DI void p0_transpose_item(const float* __restrict__ W, int lds_, int N, bf16_t* __restrict__ WT, int ldd, const float* __restrict__ gain, LAS float* scr, int item, int lane) {
    const int nblk = N / 32, kb = item / nblk, nb = item % nblk, k0 = 64 * kb, n0 = 32 * nb;
#pragma unroll 8
    for (int i = 0; i < 32; ++i) { const int kk = 2 * i + (lane >> 5); const float gsc = gain ? gain[k0 + kk] : 1.f; scr[kk * 33 + (lane & 31)] = W[(size_t)(k0 + kk) * lds_ + n0 + (lane & 31)] * gsc; }
    asm volatile("s_waitcnt lgkmcnt(0)" ::: "memory");
    const int c = lane & 7;
#pragma unroll
    for (int j = 0; j < 4; ++j) { const int n = (lane >> 3) + 8 * j; const LAS float* s = scr + (8 * c) * 33 + n;
        u32x4 o; o.x = pk2(s[0 * 33], s[1 * 33]); o.y = pk2(s[2 * 33], s[3 * 33]); o.z = pk2(s[4 * 33], s[5 * 33]); o.w = pk2(s[6 * 33], s[7 * 33]);
        *(u32x4*)(WT + (size_t)(n0 + n) * ldd + k0 + 8 * c) = o; }
    asm volatile("s_waitcnt lgkmcnt(0)" ::: "memory");
}
DI void rowprep_load(const float* __restrict__ src, int lane, f32x4 (&v)[4]) {
#pragma unroll
    for (int j = 0; j < 4; ++j) v[j] = ((const f32x4*)src)[lane + 64 * j];
}
DI void rowprep_row(const f32x4 (&v)[4], int row, bf16_t* __restrict__ XB, float* __restrict__ SSQ, int lane) {
    float ss = 0.f;
#pragma unroll
    for (int j = 0; j < 4; ++j) ss += v[j].x * v[j].x + v[j].y * v[j].y + v[j].z * v[j].z + v[j].w * v[j].w;
    ss = wave_sum(ss);
#pragma unroll
    for (int j = 0; j < 4; ++j) { u32x2 o; o.x = pk2(v[j].x, v[j].y); o.y = pk2(v[j].z, v[j].w); ((u32x2*)(XB + (size_t)row * DM))[lane + 64 * j] = o; }
    if (lane < 16) SSQ[(size_t)lane * MT + row] = lane == 0 ? ss : 0.f;
}

DI void unpack4(u32x2 r, float (&x)[4]) { x[0] = __uint_as_float(r.x << 16); x[1] = __uint_as_float(r.x & 0xffff0000u); x[2] = __uint_as_float(r.y << 16); x[3] = __uint_as_float(r.y & 0xffff0000u); }
DI void post0_row(int row, int lane, const bf16_t* __restrict__ Z0, const float* __restrict__ ROPET, const float* __restrict__ g_q_nope, const float* __restrict__ g_q_rope,
                  const float* __restrict__ g_ckv, const float* __restrict__ g_k_rope, bf16_t* __restrict__ QB, bf16_t* __restrict__ CB, bf16_t* __restrict__ KRB, float* __restrict__ out) {
    const bf16_t* z = Z0 + (size_t)row * NZ0;
    const bool isp = row < MP; const int pidx = isp ? (row & (SEQ - 1)) : SEQ + ((row - MP) & 7);
    { const int d = 4 * (lane & 15); const f32x4 g4 = *(const f32x4*)(g_q_nope + d);
#pragma unroll
      for (int hh = 0; hh < 2; ++hh) {
        const int h = 4 * hh + (lane >> 4); float x[4]; unpack4(*(const u32x2*)(z + POOLD + QKH * h + d), x);
        float ss = x[0] * x[0] + x[1] * x[1] + x[2] * x[2] + x[3] * x[3];
        ss = sum16(ss);
        const float ri = rsqrtf(ss * (1.f / 64.f) + EPS) * QSCALE;
        u32x2 o; o.x = pk2(x[0] * ri * g4.x, x[1] * ri * g4.y); o.y = pk2(x[2] * ri * g4.z, x[3] * ri * g4.w);
        *(u32x2*)(QB + (size_t)row * QDIM + QKH * h + d) = o; } }
    { const int r = 4 * (lane & 7), i0 = r & 15; const bool second = (lane & 4) != 0;
      const f32x4 t0 = *(const f32x4*)(ROPET + ((size_t)pidx * 16 + i0) * 2), t1 = *(const f32x4*)(ROPET + ((size_t)pidx * 16 + i0) * 2 + 4);
      const float cs[4] = {t0.x, t0.z, t1.x, t1.z}, sn[4] = {t0.y, t0.w, t1.y, t1.w};
      { const int h = lane >> 3; float x[4]; unpack4(*(const u32x2*)(z + POOLD + QKH * h + 64 + r), x);
        float ss = x[0] * x[0] + x[1] * x[1] + x[2] * x[2] + x[3] * x[3];
        ss = sum8(ss);
        const float ri = rsqrtf(ss * (1.f / 32.f) + EPS); const f32x4 g4 = *(const f32x4*)(g_q_rope + r);
        float y[4] = {x[0] * ri * g4.x, x[1] * ri * g4.y, x[2] * ri * g4.z, x[3] * ri * g4.w}, o[4];
#pragma unroll
        for (int e = 0; e < 4; ++e) { const float p = xchg4(y[e], second); o[e] = (second ? (p * sn[e] + y[e] * cs[e]) : (y[e] * cs[e] - p * sn[e])) * QSCALE; }
        u32x2 w; w.x = pk2(o[0], o[1]); w.y = pk2(o[2], o[3]); *(u32x2*)(QB + (size_t)row * QDIM + QKH * h + 64 + r) = w; }
      { float x[4]; unpack4(*(const u32x2*)(z + POOLD + QDIM + KVR + r), x);
        float ss = x[0] * x[0] + x[1] * x[1] + x[2] * x[2] + x[3] * x[3];
        ss = sum8(ss);
        const float ri = rsqrtf(ss * (1.f / 32.f) + EPS); const f32x4 g4 = *(const f32x4*)(g_k_rope + r);
        float y[4] = {x[0] * ri * g4.x, x[1] * ri * g4.y, x[2] * ri * g4.z, x[3] * ri * g4.w}; f32x4 o;
#pragma unroll
        for (int e = 0; e < 4; ++e) { const float p = xchg4(y[e], second); o[e] = second ? (p * sn[e] + y[e] * cs[e]) : (y[e] * cs[e] - p * sn[e]); }
        if (lane < 8) { u32x2 w; w.x = pk2(o[0], o[1]); w.y = pk2(o[2], o[3]); *(u32x2*)(KRB + (size_t)row * ROPE + r) = w;
            float* ko = isp ? out + O_KR_P + (size_t)row * ROPE : out + O_KR_S + (size_t)(row - MP) * ROPE; *(f32x4*)(ko + r) = o; } } }
    { float x[4]; unpack4(*(const u32x2*)(z + POOLD + QDIM + lane * 4), x);
      float ss = wave_sum(x[0] * x[0] + x[1] * x[1] + x[2] * x[2] + x[3] * x[3]); const float ri = rsqrtf(ss * (1.f / 256.f) + EPS);
      const f32x4 g4 = *(const f32x4*)(g_ckv + lane * 4);
      f32x4 y; y.x = x[0] * ri * g4.x; y.y = x[1] * ri * g4.y; y.z = x[2] * ri * g4.z; y.w = x[3] * ri * g4.w;
      u32x2 o; o.x = pk2(y.x, y.y); o.y = pk2(y.z, y.w); *(u32x2*)(CB + (size_t)row * KVR + lane * 4) = o;
      float* co = isp ? out + O_CKV_P + (size_t)row * KVR : out + O_CKV_S + (size_t)(row - MP) * KVR; *(f32x4*)(co + lane * 4) = y; }
}
DI void load8(const bf16_t* p, float (&x)[8]) { const u32x4 r = *(const u32x4*)p;
#pragma unroll
    for (int e = 0; e < 4; ++e) { x[2 * e] = __uint_as_float(r[e] << 16); x[2 * e + 1] = __uint_as_float(r[e] & 0xffff0000u); } }
template <bool ISP> DI void pool_item(int row0, int nrows, int ch, const bf16_t* __restrict__ Z0, const float* __restrict__ state_pool, bf16_t* __restrict__ DBuf, float* __restrict__ out) {
    const int w = 2 << (ch >> 7);
    const int t0 = ISP ? (row0 & (SEQ - 1)) : 0, bb = ISP ? (row0 >> 12) : ((row0 - MP) >> 3);
    float S[8];
#pragma unroll
    for (int e = 0; e < 8; ++e) S[e] = 0.f;
    for (int j = 1; j < w; ++j) { const int tj = t0 - j; float x[8];
        if (tj >= 0) { load8(Z0 + (size_t)(row0 - j) * NZ0 + ch, x); }
        else if (!ISP) { const float* hp = state_pool + ((size_t)bb * 15 + (15 + tj)) * POOLD + ch; const f32x4 a = *(const f32x4*)hp, b = *(const f32x4*)(hp + 4); x[0] = a.x; x[1] = a.y; x[2] = a.z; x[3] = a.w; x[4] = b.x; x[5] = b.y; x[6] = b.z; x[7] = b.w; }
        else {
#pragma unroll
            for (int e = 0; e < 8; ++e) x[e] = 0.f; }
#pragma unroll
        for (int e = 0; e < 8; ++e) S[e] += x[e]; }
    for (int i = 0; i < nrows; ++i) {
        const int t = t0 + i, row = row0 + i; float u[8]; load8(Z0 + (size_t)row * NZ0 + ch, u);
        const float icnt = 1.0f / (ISP ? (float)((t + 1) < w ? (t + 1) : w) : (float)w);
        u32x4 o;
#pragma unroll
        for (int e = 0; e < 8; ++e) S[e] += u[e];
#pragma unroll
        for (int e = 0; e < 4; ++e) o[e] = pk2(S[2 * e] * icnt - u[2 * e], S[2 * e + 1] * icnt - u[2 * e + 1]);
        *(u32x4*)(DBuf + (size_t)row * POOLD + ch) = o;
        { const int tj = t - w + 1; float x[8];
          if (tj >= 0) { load8(Z0 + (size_t)(row - w + 1) * NZ0 + ch, x); }
          else if (!ISP) { const float* hp = state_pool + ((size_t)bb * 15 + (15 + tj)) * POOLD + ch; const f32x4 a = *(const f32x4*)hp, b = *(const f32x4*)(hp + 4); x[0] = a.x; x[1] = a.y; x[2] = a.z; x[3] = a.w; x[4] = b.x; x[5] = b.y; x[6] = b.z; x[7] = b.w; }
          else {
#pragma unroll
              for (int e = 0; e < 8; ++e) x[e] = 0.f; }
#pragma unroll
          for (int e = 0; e < 8; ++e) S[e] -= x[e]; }
        if (ISP) { if (t >= SEQ - 15) { float* op = out + O_POOL_P + ((size_t)bb * 15 + (t - (SEQ - 15))) * POOLD + ch; *(f32x4*)op = (f32x4){u[0], u[1], u[2], u[3]}; *(f32x4*)(op + 4) = (f32x4){u[4], u[5], u[6], u[7]}; } }
        else { float* op = out + O_POOL_S + ((size_t)bb * 15 + 7 + t) * POOLD + ch; *(f32x4*)op = (f32x4){u[0], u[1], u[2], u[3]}; *(f32x4*)(op + 4) = (f32x4){u[4], u[5], u[6], u[7]}; }
    }
    if (!ISP) { for (int i = 0; i < 7; ++i) { const float* hp = state_pool + ((size_t)bb * 15 + 8 + i) * POOLD + ch; float* op = out + O_POOL_S + ((size_t)bb * 15 + i) * POOLD + ch; *(f32x4*)op = *(const f32x4*)hp; *(f32x4*)(op + 4) = *(const f32x4*)(hp + 4); } }
}
DI void pool_item_p16(int row0, int ch, const bf16_t* __restrict__ Z0, bf16_t* __restrict__ DBuf, float* __restrict__ out) {
    const int w = 2 << (ch >> 7);
    const int t0 = row0 & (SEQ - 1), bb = row0 >> 12;
    const bf16_t* zb = Z0 + (size_t)row0 * NZ0 + ch;
    float S[8];
#pragma unroll
    for (int e = 0; e < 8; ++e) S[e] = 0.f;
#pragma unroll
    for (int j = 1; j < 16; ++j) { const bool ok = (j < w) && (t0 - j >= 0); float x[8]; load8(zb - (ok ? j : 0) * NZ0, x); const float mk = ok ? 1.f : 0.f;
#pragma unroll
        for (int e = 0; e < 8; ++e) S[e] += mk * x[e]; }
#pragma unroll
    for (int i = 0; i < 16; ++i) {
        const int t = t0 + i; float u[8], x[8]; load8(zb + i * NZ0, u);
        const bool ok = t - w + 1 >= 0; load8(zb + (i - (ok ? w - 1 : 0)) * NZ0, x); const float mk = ok ? 1.f : 0.f;
        const float icnt = 1.0f / (float)((t + 1) < w ? (t + 1) : w);
        u32x4 o;
#pragma unroll
        for (int e = 0; e < 8; ++e) S[e] += u[e];
#pragma unroll
        for (int e = 0; e < 4; ++e) o[e] = pk2(S[2 * e] * icnt - u[2 * e], S[2 * e + 1] * icnt - u[2 * e + 1]);
        *(u32x4*)(DBuf + (size_t)(row0 + i) * POOLD + ch) = o;
#pragma unroll
        for (int e = 0; e < 8; ++e) S[e] -= mk * x[e];
    }
    if (t0 == SEQ - 16) {
        for (int i = 1; i < 16; ++i) { float u[8]; load8(zb + i * NZ0, u);
            float* op = out + O_POOL_P + ((size_t)bb * 15 + (i - 1)) * POOLD + ch; *(f32x4*)op = (f32x4){u[0], u[1], u[2], u[3]}; *(f32x4*)(op + 4) = (f32x4){u[4], u[5], u[6], u[7]}; } }
}
template <bool ISP> DI void conv_item(int row0, int nrows, int ch, const bf16_t* __restrict__ U, const float* __restrict__ state_conv, const float* __restrict__ conv_w, const float* __restrict__ conv_b,
                                      bf16_t* __restrict__ V, float* __restrict__ out) {
    const int t0 = ISP ? (row0 & (SEQ - 1)) : 0, bb = ISP ? (row0 >> 12) : ((row0 - MP) >> 3);
    float wk[4][8], bs[8], hist[3][8];
#pragma unroll
    for (int k = 0; k < 4; ++k) { const f32x4 a = *(const f32x4*)(conv_w + k * DM + ch), b = *(const f32x4*)(conv_w + k * DM + ch + 4); wk[k][0] = a.x; wk[k][1] = a.y; wk[k][2] = a.z; wk[k][3] = a.w; wk[k][4] = b.x; wk[k][5] = b.y; wk[k][6] = b.z; wk[k][7] = b.w; }
    { const f32x4 a = *(const f32x4*)(conv_b + ch), b = *(const f32x4*)(conv_b + ch + 4); bs[0] = a.x; bs[1] = a.y; bs[2] = a.z; bs[3] = a.w; bs[4] = b.x; bs[5] = b.y; bs[6] = b.z; bs[7] = b.w; }
#pragma unroll
    for (int j = 0; j < 3; ++j) {
        const int tj = t0 - 3 + j;
        if (tj >= 0) load8(U + (size_t)(row0 - 3 + j) * DM + ch, hist[j]);
        else if (!ISP) { const float* hp = state_conv + ((size_t)bb * 3 + (3 + tj)) * DM + ch; const f32x4 a = *(const f32x4*)hp, b = *(const f32x4*)(hp + 4); hist[j][0] = a.x; hist[j][1] = a.y; hist[j][2] = a.z; hist[j][3] = a.w; hist[j][4] = b.x; hist[j][5] = b.y; hist[j][6] = b.z; hist[j][7] = b.w; }
        else {
#pragma unroll
            for (int e = 0; e < 8; ++e) hist[j][e] = 0.f; }
    }
    for (int i = 0; i < nrows; ++i) {
        const int t = t0 + i, row = row0 + i; float u[8]; load8(U + (size_t)row * DM + ch, u);
        u32x4 o; float v[8];
#pragma unroll
        for (int e = 0; e < 8; ++e) v[e] = bs[e] + hist[0][e] * wk[0][e] + hist[1][e] * wk[1][e] + hist[2][e] * wk[2][e] + u[e] * wk[3][e];
#pragma unroll
        for (int e = 0; e < 4; ++e) o[e] = pk2(v[2 * e], v[2 * e + 1]);
        *(u32x4*)(V + (size_t)row * DM + ch) = o;
#pragma unroll
        for (int e = 0; e < 8; ++e) { hist[0][e] = hist[1][e]; hist[1][e] = hist[2][e]; hist[2][e] = u[e]; }
        const int tl = ISP ? SEQ - 3 : DT - 3;
        if (t >= tl) { float* op = out + (ISP ? O_CONV_P : O_CONV_S) + ((size_t)bb * 3 + (t - tl)) * DM + ch; *(f32x4*)op = (f32x4){u[0], u[1], u[2], u[3]}; *(f32x4*)(op + 4) = (f32x4){u[4], u[5], u[6], u[7]}; }
    }
}

DI void conv_item_p16(int row0, int ch, const bf16_t* __restrict__ U, const float* __restrict__ conv_w, const float* __restrict__ conv_b, bf16_t* __restrict__ V, float* __restrict__ out) {
    const int t0 = row0 & (SEQ - 1), bb = row0 >> 12;
    const bf16_t* ub = U + (size_t)row0 * DM + ch;
    u32x4 raw[19];
#pragma unroll
    for (int j = 0; j < 19; ++j) raw[j] = *(const u32x4*)(ub + (j - 3 >= 0 || t0 > 0 ? (j - 3) : 0) * DM);
    float wk[4][8], bs[8];
#pragma unroll
    for (int k = 0; k < 4; ++k) { const f32x4 a = *(const f32x4*)(conv_w + k * DM + ch), b = *(const f32x4*)(conv_w + k * DM + ch + 4); wk[k][0] = a.x; wk[k][1] = a.y; wk[k][2] = a.z; wk[k][3] = a.w; wk[k][4] = b.x; wk[k][5] = b.y; wk[k][6] = b.z; wk[k][7] = b.w; }
    { const f32x4 a = *(const f32x4*)(conv_b + ch), b = *(const f32x4*)(conv_b + ch + 4); bs[0] = a.x; bs[1] = a.y; bs[2] = a.z; bs[3] = a.w; bs[4] = b.x; bs[5] = b.y; bs[6] = b.z; bs[7] = b.w; }
    const float hm = t0 > 0 ? 1.f : 0.f;
    float x[4][8];
#pragma unroll
    for (int j = 0; j < 3; ++j)
#pragma unroll
        for (int e = 0; e < 4; ++e) { x[j][2 * e] = hm * __uint_as_float(raw[j][e] << 16); x[j][2 * e + 1] = hm * __uint_as_float(raw[j][e] & 0xffff0000u); }
#pragma unroll
    for (int i = 0; i < 16; ++i) {
#pragma unroll
        for (int e = 0; e < 4; ++e) { x[3][2 * e] = __uint_as_float(raw[3 + i][e] << 16); x[3][2 * e + 1] = __uint_as_float(raw[3 + i][e] & 0xffff0000u); }
        u32x4 o; float v[8];
#pragma unroll
        for (int e = 0; e < 8; ++e) v[e] = bs[e] + x[0][e] * wk[0][e] + x[1][e] * wk[1][e] + x[2][e] * wk[2][e] + x[3][e] * wk[3][e];
#pragma unroll
        for (int e = 0; e < 4; ++e) o[e] = pk2(v[2 * e], v[2 * e + 1]);
        *(u32x4*)(V + (size_t)(row0 + i) * DM + ch) = o;
#pragma unroll
        for (int e = 0; e < 8; ++e) { x[0][e] = x[1][e]; x[1][e] = x[2][e]; x[2][e] = x[3][e]; }
    }
    if (t0 == SEQ - 16) {
#pragma unroll
        for (int i = 13; i < 16; ++i) { float* op = out + O_CONV_P + ((size_t)bb * 3 + (i - 13)) * DM + ch;
            *(f32x4*)op = (f32x4){__uint_as_float(raw[3 + i][0] << 16), __uint_as_float(raw[3 + i][0] & 0xffff0000u), __uint_as_float(raw[3 + i][1] << 16), __uint_as_float(raw[3 + i][1] & 0xffff0000u)};
            *(f32x4*)(op + 4) = (f32x4){__uint_as_float(raw[3 + i][2] << 16), __uint_as_float(raw[3 + i][2] & 0xffff0000u), __uint_as_float(raw[3 + i][3] << 16), __uint_as_float(raw[3 + i][3] & 0xffff0000u)}; } }
}

DI void attn_p_naive_item(int item, int lane, LAS float* sc, const bf16_t* __restrict__ QB, const bf16_t* __restrict__ KV, const bf16_t* __restrict__ KRB, bf16_t* __restrict__ MIX) {
    LAS float* qs = sc + SEQ;
    const int row = item >> 3, h = item & 7, b = row >> 12, t = row & (SEQ - 1);
    for (int i = lane; i < QKH; i += 64) qs[i] = bf2f(QB[(size_t)row * QDIM + h * QKH + i]);
    asm volatile("s_waitcnt lgkmcnt(0)" ::: "memory");
    float mx = -INFINITY;
    for (int j0 = 0; j0 <= t; j0 += 64) {
        const int j = j0 + lane;
        if (j <= t) {
            const bf16_t* kr = KV + (size_t)(b * SEQ + j) * 1024 + h * 64; const bf16_t* rr = KRB + (size_t)(b * SEQ + j) * ROPE;
            float s = 0.f;
            for (int d = 0; d < 64; ++d) s += qs[d] * bf2f(kr[d]);
            for (int d = 0; d < 32; ++d) s += qs[64 + d] * bf2f(rr[d]);
            sc[j] = s; mx = fmaxf(mx, s);
        }
    }
    mx = wave_max(mx);
    float sum = 0.f;
    for (int j = lane; j <= t; j += 64) { const float p = exp2f(sc[j] - mx); sc[j] = p; sum += p; }
    sum = wave_sum(sum);
    asm volatile("s_waitcnt lgkmcnt(0)" ::: "memory");
    float acc = 0.f;
    for (int j = 0; j <= t; ++j) acc += sc[j] * bf2f(KV[(size_t)(b * SEQ + j) * 1024 + 512 + h * 64 + lane]);
    MIX[(size_t)row * DM + 512 + h * 64 + lane] = (bf16_t)f2bf(acc / sum);
    asm volatile("s_waitcnt lgkmcnt(0)" ::: "memory");
}


typedef short v4i16_t __attribute__((ext_vector_type(4)));
DI int crow(int r, int hi) { return (r & 3) + 8 * (r >> 2) + 4 * hi; }
constexpr int AP_KS = 12288, AP_VS = 8192, AP_LK = 0, AP_LV = 2 * AP_KS;
DI void attn_p_unit(int b, int h, int qb, LAS unsigned char* lds, const bf16_t* __restrict__ QB, const bf16_t* __restrict__ KV, const bf16_t* __restrict__ KRB, bf16_t* __restrict__ MIX) {
    const int tid = threadIdx.x, lane = tid & 63, r32 = lane & 31, hi = lane >> 5, wid = __builtin_amdgcn_readfirstlane(tid >> 6);
    const int rowbase = b * SEQ, q0 = qb * 256, NT = 4 * (qb + 1);
    const bf16_t* ksrc0 = KV + (size_t)(rowbase + lane) * 1024 + h * 64 + wid * 8;
    const bf16_t* ksrc1 = KRB + (size_t)(rowbase + lane) * ROPE + (wid & 3) * 8;
    const bf16_t* vsrc = KV + (size_t)(rowbase + 16 * (wid & 3) + (lane >> 2)) * 1024 + 512 + h * 64 + (wid >> 2) * 32 + (lane & 3) * 8;
#define AP_DMA(t, slot) do { \
        __builtin_amdgcn_global_load_lds((const unsigned*)(ksrc0 + (size_t)(t) * 64 * 1024), (LAS unsigned*)(lds + AP_LK + (slot) * AP_KS + wid * 1024), 16, 0, 0); \
        if (wid < 4) __builtin_amdgcn_global_load_lds((const unsigned*)(ksrc1 + (size_t)(t) * 64 * ROPE), (LAS unsigned*)(lds + AP_LK + (slot) * AP_KS + (8 + wid) * 1024), 16, 0, 0); \
        __builtin_amdgcn_global_load_lds((const unsigned*)(vsrc + (size_t)(t) * 64 * 1024), (LAS unsigned*)(lds + AP_LV + (slot) * AP_VS + wid * 1024), 16, 0, 0); } while (0)
    AP_DMA(0, 0);
    bf16x8 qr[6];
    { const bf16_t* qw = QB + (size_t)(rowbase + q0 + wid * 32 + r32) * QDIM + h * QKH + hi * 8;
#pragma unroll
      for (int d0 = 0; d0 < 6; ++d0) qr[d0] = *(const bf16x8*)(qw + d0 * 16); }
    float m = 0.f, l = 0.f;
    f32x16 o0, o1, negm;
#pragma unroll
    for (int r = 0; r < 16; ++r) { o0[r] = 0.f; o1[r] = 0.f; negm[r] = 0.f; }
    const int qrel = wid * 32 + r32;
    const int voff = (4 * hi + ((lane & 15) >> 2)) * 64 + ((lane >> 4) & 1) * 32 + (lane & 3) * 8;
    for (int t = 0; t < NT; ++t) {
        asm volatile("s_waitcnt vmcnt(0)" ::: "memory"); __builtin_amdgcn_s_barrier(); asm volatile("" ::: "memory");
        if (t + 1 < NT) AP_DMA(t + 1, (t + 1) & 1);
        const int slot = t & 1, trel = t - (NT - 4);
        if (trel < 0 || 64 * trel <= 32 * wid + 31) {
            const LAS unsigned char* kb = lds + AP_LK + slot * AP_KS + hi * 1024 + r32 * 16;
            f32x16 p0, p1;
            __builtin_amdgcn_s_setprio(1);
#pragma unroll
            for (int d0 = 0; d0 < 6; ++d0) {
                const bf16x8 k0 = *(const LAS bf16x8*)(kb + d0 * 2048), k1 = *(const LAS bf16x8*)(kb + d0 * 2048 + 512);
                p0 = __builtin_amdgcn_mfma_f32_32x32x16_bf16(k0, qr[d0], d0 == 0 ? negm : p0, 0, 0, 0);
                p1 = __builtin_amdgcn_mfma_f32_32x32x16_bf16(k1, qr[d0], d0 == 0 ? negm : p1, 0, 0, 0);
            }
            __builtin_amdgcn_s_setprio(0);
            if (trel >= 0) {
#pragma unroll
                for (int r = 0; r < 16; ++r) { const int kp = 64 * trel + crow(r, hi); if (kp > qrel) p0[r] = -INFINITY; if (kp + 32 > qrel) p1[r] = -INFINITY; }
            }
            float mx = max3f(p0[0], p1[0], p0[1]);
#pragma unroll
            for (int r = 1; r < 16; ++r) mx = (r < 15) ? max3f(mx, p1[r], p0[r + 1]) : fmaxf(mx, p1[r]);
            mx = xmax32(mx);
            float ps = 0.f;
#pragma unroll
            for (int r = 0; r < 16; ++r) { p0[r] = __builtin_amdgcn_exp2f(p0[r]); p1[r] = __builtin_amdgcn_exp2f(p1[r]); ps += p0[r] + p1[r]; }
            l += ps;
            const LAS unsigned char* vb = lds + AP_LV + slot * AP_VS + voff;
            __builtin_amdgcn_s_setprio(1);
#pragma unroll
            for (int ks = 0; ks < 4; ++ks) {
                u32x4 pw;
                if (ks < 2) { pw.x = cvtpk(p0[8 * ks], p0[8 * ks + 1]); pw.y = cvtpk(p0[8 * ks + 2], p0[8 * ks + 3]); pw.z = cvtpk(p0[8 * ks + 4], p0[8 * ks + 5]); pw.w = cvtpk(p0[8 * ks + 6], p0[8 * ks + 7]); }
                else { const int s8 = 8 * (ks - 2); pw.x = cvtpk(p1[s8], p1[s8 + 1]); pw.y = cvtpk(p1[s8 + 2], p1[s8 + 3]); pw.z = cvtpk(p1[s8 + 4], p1[s8 + 5]); pw.w = cvtpk(p1[s8 + 6], p1[s8 + 7]); }
                const bf16x8 pa = __builtin_bit_cast(bf16x8, pw);
#pragma unroll
                for (int db = 0; db < 2; ++db) {
                    const v4i16_t lo = __builtin_amdgcn_ds_read_tr16_b64_v4i16((LAS v4i16_t*)(vb + db * 4096 + ks * 1024));
                    const v4i16_t hh = __builtin_amdgcn_ds_read_tr16_b64_v4i16((LAS v4i16_t*)(vb + db * 4096 + ks * 1024 + 512));
                    const bf16x8 vf = (bf16x8){lo[0], lo[1], lo[2], lo[3], hh[0], hh[1], hh[2], hh[3]};
                    if (db == 0) o0 = __builtin_amdgcn_mfma_f32_32x32x16_bf16(vf, pa, o0, 0, 0, 0);
                    else o1 = __builtin_amdgcn_mfma_f32_32x32x16_bf16(vf, pa, o1, 0, 0, 0);
                }
            }
            __builtin_amdgcn_s_setprio(0);
            const float mn = (t == 0) ? mx : fmaxf(mx, 0.f);
            if (__any(mn != 0.f)) {
                const float f = __builtin_amdgcn_exp2f(-mn); l *= f; m += mn;
#pragma unroll
                for (int r = 0; r < 16; ++r) { o0[r] *= f; o1[r] *= f; negm[r] = -m; }
            }
        }
    }
    l = xsum32(l);
    const float il = 1.0f / l;
    bf16_t* orow = MIX + (size_t)(rowbase + q0 + wid * 32 + r32) * DM + 512 + h * 64 + 4 * hi;
#pragma unroll
    for (int g = 0; g < 4; ++g) {
        u32x2 a; a.x = cvtpk(o0[4 * g] * il, o0[4 * g + 1] * il); a.y = cvtpk(o0[4 * g + 2] * il, o0[4 * g + 3] * il); *(u32x2*)(orow + 8 * g) = a;
        u32x2 c; c.x = cvtpk(o1[4 * g] * il, o1[4 * g + 1] * il); c.y = cvtpk(o1[4 * g + 2] * il, o1[4 * g + 3] * il); *(u32x2*)(orow + 32 + 8 * g) = c;
    }
#undef AP_DMA
}


constexpr int SA_CB_ROW = 576, SA_CB_SZ = 64 * SA_CB_ROW;
constexpr int SA_C8_ROW = 272, SA_C8_SZ = 64 * SA_C8_ROW;
constexpr int SA_KR_ROW = 96, SA_KR_SZ = 64 * SA_KR_ROW;
constexpr int SA_CB = 0, SA_C8 = 2 * SA_CB_SZ, SA_KRB = SA_C8 + 2 * SA_C8_SZ;
constexpr int SA_P = SA_KRB + 2 * SA_KR_SZ, SA_P_ROW = 144;
constexpr int SA_QF = SA_P + 64 * SA_P_ROW;
constexpr int SA_F = SA_QF + 8 * 3 * 4 * 8 * 16;
constexpr int SA_END = SA_F + 256;
static_assert(SA_END <= LDS_MISC, "sample attention LDS map");
DI int sa_swz(int x) { return (0x78 >> (2 * x)) & 3; }
DI int sa_g8(int x) { return (0x28 >> (2 * x)) & 3; }
typedef int v8i_t __attribute__((ext_vector_type(8)));
typedef float f32x4v __attribute__((ext_vector_type(4)));

template <int VAR> DI void attn_s_unit(int unit, LAS unsigned char* lds, const float* __restrict__ cache_ckv, const float* __restrict__ cache_kr, const int* __restrict__ page_table, const bf16_t* __restrict__ QB,
                    const bf16_t* __restrict__ WKVT, const float* __restrict__ g_k_nope, float* __restrict__ LATP, float* __restrict__ ML) {
    constexpr int hot = VAR != 0;
    const int tid = threadIdx.x, lane = tid & 63, r32 = lane & 31, hi = lane >> 5, l15 = lane & 15, quad = lane >> 4, w = __builtin_amdgcn_readfirstlane(tid >> 6);
    const int sb = unit >> 1, split = unit & 1;
    const int* pt = page_table + sb * NPAGES + split * 32;
    for (int e = tid; e < 8 * 3 * 4 * 8; e += NTHR) {
        const int q = e & 7, qd = (e >> 3) & 3, st = (e >> 5) % 3, h = e / 96;
        const bf16_t* qp = QB + (size_t)(MP + sb * DT + q) * QDIM + h * QKH;
        unsigned pk[4];
#pragma unroll
        for (int jj = 0; jj < 4; ++jj) {
            float v0, v1;
            if (st < 2) { const int j0 = 2 * jj, j1 = 2 * jj + 1; const int d0 = 32 * st + 16 * (j0 >> 2) + 4 * qd + (j0 & 3), d1 = 32 * st + 16 * (j1 >> 2) + 4 * qd + (j1 & 3); v0 = bf2f(qp[d0]) * g_k_nope[d0]; v1 = bf2f(qp[d1]) * g_k_nope[d1]; }
            else { const int r0 = 8 * qd + 2 * jj; v0 = bf2f(qp[64 + r0]); v1 = bf2f(qp[64 + r0 + 1]); }
            pk[jj] = pk2(v0, v1);
        }
        *(LAS u32x4*)(lds + SA_QF + e * 16) = (u32x4){pk[0], pk[1], pk[2], pk[3]};
    }
    v8i_t wf[4][2];
#pragma unroll
    for (int db = 0; db < 4; ++db)
#pragma unroll
        for (int ch = 0; ch < 2; ++ch) {
            const bf16_t* wp = WKVT + (size_t)(w * 64 + 16 * db + l15) * KVR + 128 * ch + 32 * quad;
#pragma unroll
            for (int i = 0; i < 4; ++i) { const u32x4 r = *(const u32x4*)(wp + 8 * i); int lo = 0, hi2 = 0;
                lo = __builtin_amdgcn_cvt_pk_fp8_f32(__uint_as_float(r.x << 16) * 16.f, __uint_as_float(r.x & 0xffff0000u) * 16.f, lo, false);
                lo = __builtin_amdgcn_cvt_pk_fp8_f32(__uint_as_float(r.y << 16) * 16.f, __uint_as_float(r.y & 0xffff0000u) * 16.f, lo, true);
                hi2 = __builtin_amdgcn_cvt_pk_fp8_f32(__uint_as_float(r.z << 16) * 16.f, __uint_as_float(r.z & 0xffff0000u) * 16.f, hi2, false);
                hi2 = __builtin_amdgcn_cvt_pk_fp8_f32(__uint_as_float(r.w << 16) * 16.f, __uint_as_float(r.w & 0xffff0000u) * 16.f, hi2, true);
                wf[db][ch][2 * i] = lo; wf[db][ch][2 * i + 1] = hi2; }
        }
    const __amdgpu_buffer_rsrc_t rs_c = __builtin_amdgcn_make_buffer_rsrc((void*)cache_ckv, (short)0, (int)((size_t)(NPAGES * DB_ + NPAGES * DB_ / 4) * PAGE * KVR * 4), 0x00020000);
    const __amdgpu_buffer_rsrc_t rs_k = __builtin_amdgcn_make_buffer_rsrc((void*)cache_kr, (short)0, (int)((size_t)(NPAGES * DB_ + NPAGES * DB_ / 4) * PAGE * ROPE * 4), 0x00020000);
    const int dma_voff = lane * 16;
    u32x4 pf[9];
#define SA_LOAD(t) do { const unsigned prow = (unsigned)__builtin_amdgcn_readfirstlane(pt[hot ? 0 : ((t) >> 1)]) * PAGE + 64 * ((t) & 1) + 8 * w; \
        _Pragma("unroll") for (int i = 0; i < 8; ++i) pf[i] = __builtin_amdgcn_raw_buffer_load_b128(rs_c, dma_voff, (prow + i) * (KVR * 4), 0); \
        pf[8] = __builtin_amdgcn_raw_buffer_load_b128(rs_k, dma_voff, prow * (ROPE * 4), 0); } while (0)
    SA_LOAD(0);
    float m = 0.f, negm = 0.f, l = 0.f;
    f32x16 lat0, lat1;
#pragma unroll
    for (int r = 0; r < 16; ++r) { lat0[r] = 0.f; lat1[r] = 0.f; }
    const bool qreal = l15 < 8;
    const int g8_ = sa_g8((l15 >> 2) & 3);
    const LAS unsigned char* c8a0 = lds + SA_C8 + l15 * SA_C8_ROW + (((2 * quad) ^ g8_) * 16);
    const LAS unsigned char* c8b0 = lds + SA_C8 + l15 * SA_C8_ROW + (((2 * quad + 1) ^ g8_) * 16);
    const LAS unsigned char* qfbase = lds + SA_QF + (((w * 3) * 4 + quad) * 8 + (l15 & 7)) * 16;
    const LAS unsigned char* krbase0 = lds + SA_KRB + l15 * SA_KR_ROW + quad * 16;
    LAS unsigned char* pwbase = lds + SA_P + (8 * w + l15) * SA_P_ROW + quad * 8;
    asm volatile("s_waitcnt lgkmcnt(0)" ::: "memory"); __builtin_amdgcn_s_barrier(); asm volatile("" ::: "memory");
    bf16x8 q0 = *(const LAS bf16x8*)(qfbase), q1 = *(const LAS bf16x8*)(qfbase + 512), q2 = *(const LAS bf16x8*)(qfbase + 1024);
    if (!qreal) { q0 = (bf16x8){0, 0, 0, 0, 0, 0, 0, 0}; q1 = q0; q2 = q0; }
    LAS unsigned char* cvw0 = lds + SA_CB + 8 * w * SA_CB_ROW + (((lane >> 1) ^ sa_swz((2 * w) & 3)) * 16) + (lane & 1) * 8;
    LAS unsigned char* cvw1 = lds + SA_CB + 8 * w * SA_CB_ROW + (((lane >> 1) ^ sa_swz((2 * w + 1) & 3)) * 16) + (lane & 1) * 8;
    LAS unsigned char* c8w0 = lds + SA_C8 + 8 * w * SA_C8_ROW + (((lane >> 2) ^ sa_g8((2 * w) & 3)) * 16) + (lane & 3) * 4;
    LAS unsigned char* c8w1 = lds + SA_C8 + 8 * w * SA_C8_ROW + (((lane >> 2) ^ sa_g8((2 * w + 1) & 3)) * 16) + (lane & 3) * 4;
    LAS unsigned char* krw = lds + SA_KRB + (8 * w + (lane >> 3)) * SA_KR_ROW + (lane & 7) * 8;
    const int kr0 = 8 * hi + (l15 >> 2), cc0 = 4 * w + 2 * ((lane >> 4) & 1) + ((lane & 3) >> 1);
    const LAS unsigned char* trlo = lds + SA_CB + kr0 * SA_CB_ROW + ((cc0 ^ (hi ? 3 : 0)) * 16) + (lane & 1) * 8;
    const LAS unsigned char* trhi = lds + SA_CB + (kr0 + 4) * SA_CB_ROW + ((cc0 ^ (hi ? 1 : 2)) * 16) + (lane & 1) * 8;
    const LAS unsigned char* prd = lds + SA_P + r32 * SA_P_ROW + hi * 16;
    const LAS float* frd = (const LAS float*)(lds + SA_F + r32 * 4);
    for (int t2 = 0; t2 < 64; t2 += 2) {
#pragma unroll
      for (int tb = 0; tb < 2; ++tb) {
        const int t = t2 + tb;
        asm volatile("s_waitcnt vmcnt(0)" ::: "memory");
        if (VAR != 5) {
#pragma unroll
            for (int i = 0; i < 8; ++i) {
                const f32x4 v = __builtin_bit_cast(f32x4, pf[i]);
                u32x2 o; o.x = cvtpk(v.x, v.y); o.y = cvtpk(v.z, v.w);
                *(LAS u32x2*)((i < 4 ? cvw0 : cvw1) + tb * SA_CB_SZ + i * SA_CB_ROW) = o;
                int f8 = __builtin_amdgcn_cvt_pk_fp8_f32(v.x, v.y, 0, false); f8 = __builtin_amdgcn_cvt_pk_fp8_f32(v.z, v.w, f8, true);
                *(LAS int*)((i < 4 ? c8w0 : c8w1) + tb * SA_C8_SZ + i * SA_C8_ROW) = f8;
            }
            { const f32x4 v = __builtin_bit_cast(f32x4, pf[8]); u32x2 o; o.x = cvtpk(v.x, v.y); o.y = cvtpk(v.z, v.w);
              *(LAS u32x2*)(krw + tb * SA_KR_SZ) = o; }
        }
        constexpr bool ld_next = (VAR != 5);
        const int tn = (t + 1) & 63;
        const unsigned prow_n = (unsigned)__builtin_amdgcn_readfirstlane(pt[hot ? 0 : (tn >> 1)]) * PAGE + 64 * (tn & 1) + 8 * w;
        asm volatile("s_waitcnt lgkmcnt(0)" ::: "memory");
        __builtin_amdgcn_s_barrier(); asm volatile("" ::: "memory");
        const LAS unsigned char* c8a = c8a0 + tb * SA_C8_SZ; const LAS unsigned char* c8b = c8b0 + tb * SA_C8_SZ; const LAS unsigned char* krbase = krbase0 + tb * SA_KR_SZ;
        float tmax = -INFINITY, ps = 0.f;
        u32x4 nb00, nb01, nb10, nb11; bf16x8 nkf;
#define SA_LDB(kb_) do { const LAS unsigned char* ca_ = c8a + (kb_) * 16 * SA_C8_ROW; const LAS unsigned char* cb_ = c8b + (kb_) * 16 * SA_C8_ROW; \
            nb00 = *(const LAS u32x4*)(ca_); nb01 = *(const LAS u32x4*)(cb_); nb10 = *(const LAS u32x4*)(ca_ + 128); nb11 = *(const LAS u32x4*)(cb_ + 128); \
            nkf = *(const LAS bf16x8*)(krbase + (kb_) * 16 * SA_KR_ROW); } while (0)
        SA_LDB(0);
#pragma unroll
        for (int kb = 0; kb < 4; ++kb) {
            f32x4v k0 = {0.f, 0.f, 0.f, 0.f}, k1 = {0.f, 0.f, 0.f, 0.f}, k2 = {0.f, 0.f, 0.f, 0.f}, k3 = {0.f, 0.f, 0.f, 0.f};
            const bf16x8 kf = nkf;
            {
                const v8i_t bf0 = {(int)nb00.x, (int)nb00.y, (int)nb00.z, (int)nb00.w, (int)nb01.x, (int)nb01.y, (int)nb01.z, (int)nb01.w};
                const v8i_t bf1 = {(int)nb10.x, (int)nb10.y, (int)nb10.z, (int)nb10.w, (int)nb11.x, (int)nb11.y, (int)nb11.z, (int)nb11.w};
                if (VAR != 3) {
                    __builtin_amdgcn_s_setprio(1);
                    k0 = __builtin_amdgcn_mfma_scale_f32_16x16x128_f8f6f4(wf[0][0], bf0, k0, 0, 0, 0, 123, 0, 127); k1 = __builtin_amdgcn_mfma_scale_f32_16x16x128_f8f6f4(wf[1][0], bf0, k1, 0, 0, 0, 123, 0, 127);
                    k2 = __builtin_amdgcn_mfma_scale_f32_16x16x128_f8f6f4(wf[2][0], bf0, k2, 0, 0, 0, 123, 0, 127); k3 = __builtin_amdgcn_mfma_scale_f32_16x16x128_f8f6f4(wf[3][0], bf0, k3, 0, 0, 0, 123, 0, 127);
                    k0 = __builtin_amdgcn_mfma_scale_f32_16x16x128_f8f6f4(wf[0][1], bf1, k0, 0, 0, 0, 123, 0, 127); k1 = __builtin_amdgcn_mfma_scale_f32_16x16x128_f8f6f4(wf[1][1], bf1, k1, 0, 0, 0, 123, 0, 127);
                    k2 = __builtin_amdgcn_mfma_scale_f32_16x16x128_f8f6f4(wf[2][1], bf1, k2, 0, 0, 0, 123, 0, 127); k3 = __builtin_amdgcn_mfma_scale_f32_16x16x128_f8f6f4(wf[3][1], bf1, k3, 0, 0, 0, 123, 0, 127);
                    __builtin_amdgcn_s_setprio(0);
                }
                __builtin_amdgcn_sched_barrier(0);
                if (kb < 3) SA_LDB(kb + 1);
                if (ld_next) { pf[2 * kb] = __builtin_amdgcn_raw_buffer_load_b128(rs_c, dma_voff, (prow_n + 2 * kb) * (KVR * 4), 0); pf[2 * kb + 1] = __builtin_amdgcn_raw_buffer_load_b128(rs_c, dma_voff, (prow_n + 2 * kb + 1) * (KVR * 4), 0);
                    if (kb == 3) pf[8] = __builtin_amdgcn_raw_buffer_load_b128(rs_k, dma_voff, prow_n * (ROPE * 4), 0); }
                __builtin_amdgcn_sched_barrier(0);
            }
            float ss = k0.x * k0.x + k0.y * k0.y + k0.z * k0.z + k0.w * k0.w + k1.x * k1.x + k1.y * k1.y + k1.z * k1.z + k1.w * k1.w
                     + k2.x * k2.x + k2.y * k2.y + k2.z * k2.z + k2.w * k2.w + k3.x * k3.x + k3.y * k3.y + k3.z * k3.z + k3.w * k3.w;
            ss = xsum32(xsum16(ss));
            const float ri = __builtin_amdgcn_rsqf(ss * (1.f / 64.f) + EPS);
            u32x4 a0, a1;
            a0.x = cvtpk(k0.x * ri, k0.y * ri); a0.y = cvtpk(k0.z * ri, k0.w * ri); a0.z = cvtpk(k1.x * ri, k1.y * ri); a0.w = cvtpk(k1.z * ri, k1.w * ri);
            a1.x = cvtpk(k2.x * ri, k2.y * ri); a1.y = cvtpk(k2.z * ri, k2.w * ri); a1.z = cvtpk(k3.x * ri, k3.y * ri); a1.w = cvtpk(k3.z * ri, k3.w * ri);
            f32x4v sc = {negm, negm, negm, negm};
            sc = __builtin_amdgcn_mfma_f32_16x16x32_bf16(kf, q2, sc, 0, 0, 0);
            sc = __builtin_amdgcn_mfma_f32_16x16x32_bf16(__builtin_bit_cast(bf16x8, a0), q0, sc, 0, 0, 0);
            sc = __builtin_amdgcn_mfma_f32_16x16x32_bf16(__builtin_bit_cast(bf16x8, a1), q1, sc, 0, 0, 0);
            float bm = fmaxf(fmaxf(sc.x, sc.y), fmaxf(sc.z, sc.w));
            if (t == 0 && kb == 0) { const float m0 = xmax32(xmax16(bm)); sc.x -= m0; sc.y -= m0; sc.z -= m0; sc.w -= m0; bm -= m0; m = m0; negm = -m0; }
            tmax = fmaxf(tmax, bm);
            sc.x = __builtin_amdgcn_exp2f(sc.x); sc.y = __builtin_amdgcn_exp2f(sc.y); sc.z = __builtin_amdgcn_exp2f(sc.z); sc.w = __builtin_amdgcn_exp2f(sc.w);
            ps += (sc.x + sc.y) + (sc.z + sc.w);
            asm volatile("" : "+v"(ps), "+v"(tmax));
            if (qreal) { u32x2 o; o.x = cvtpk(sc.x, sc.y); o.y = cvtpk(sc.z, sc.w); *(LAS u32x2*)(pwbase + kb * 32) = o; }
            __builtin_amdgcn_sched_barrier(0);
        }
#undef SA_LDB
        { tmax = xmax32(xmax16(tmax));
          const float inc = fmaxf(tmax, 0.f); const float f = __builtin_amdgcn_exp2f(-inc); m += inc; negm = -m; l = (l + ps) * f;
          if (qreal && quad == 0) *(LAS float*)(lds + SA_F + (8 * w + l15) * 4) = f; }
        asm volatile("s_waitcnt lgkmcnt(0)" ::: "memory"); __builtin_amdgcn_s_barrier(); asm volatile("" ::: "memory");
        if (VAR != 4) {
            v4i16_t lo[4], hh[4]; bf16x8 p0[4], p1[4];
#pragma unroll
            for (int ks = 0; ks < 4; ++ks) {
                lo[ks] = __builtin_amdgcn_ds_read_tr16_b64_v4i16((LAS v4i16_t*)(trlo + tb * SA_CB_SZ + ks * 16 * SA_CB_ROW));
                hh[ks] = __builtin_amdgcn_ds_read_tr16_b64_v4i16((LAS v4i16_t*)(trhi + tb * SA_CB_SZ + ks * 16 * SA_CB_ROW));
                p0[ks] = *(const LAS bf16x8*)(prd + ks * 32);
                p1[ks] = *(const LAS bf16x8*)(prd + 32 * SA_P_ROW + ks * 32);
            }
            const float f0 = frd[0], f1 = frd[32];
            __builtin_amdgcn_sched_barrier(0);
            __builtin_amdgcn_s_setprio(1);
#pragma unroll
            for (int ks = 0; ks < 4; ++ks) {
                const bf16x8 cf = (bf16x8){lo[ks][0], lo[ks][1], lo[ks][2], lo[ks][3], hh[ks][0], hh[ks][1], hh[ks][2], hh[ks][3]};
                lat0 = __builtin_amdgcn_mfma_f32_32x32x16_bf16(cf, p0[ks], lat0, 0, 0, 0);
                lat1 = __builtin_amdgcn_mfma_f32_32x32x16_bf16(cf, p1[ks], lat1, 0, 0, 0);
            }
            __builtin_amdgcn_s_setprio(0);
            if (__any(f0 != 1.f || f1 != 1.f)) {
#pragma unroll
                for (int r = 0; r < 16; ++r) { lat0[r] *= f0; lat1[r] *= f1; } }
        }
      }
    }
    __builtin_amdgcn_s_barrier(); asm volatile("" ::: "memory");
    l = xsum32(xsum16(l));
    int unit2 = unit, lane2 = threadIdx.x & 63; asm volatile("" : "+s"(unit2), "+v"(lane2));
    const int r32b = lane2 & 31, hib = lane2 >> 5;
    if (lane2 < 8) { float* mlp = ML + ((size_t)unit2 * 64 + 8 * w + lane2) * 2; mlp[0] = m; mlp[1] = l; }
    float* lp = LATP + (size_t)unit2 * 64 * KVR + 32 * w + 4 * hib;
#pragma unroll
    for (int g = 0; g < 4; ++g) {
        *(f32x4*)(lp + (size_t)r32b * KVR + 8 * g) = (f32x4){lat0[4 * g], lat0[4 * g + 1], lat0[4 * g + 2], lat0[4 * g + 3]};
        *(f32x4*)(lp + (size_t)(32 + r32b) * KVR + 8 * g) = (f32x4){lat1[4 * g], lat1[4 * g + 1], lat1[4 * g + 2], lat1[4 * g + 3]};
    }
#undef SA_LOAD
}

DI void attn_s_combine(int sb, LAS unsigned char* lds, const bf16_t* __restrict__ QB, const bf16_t* __restrict__ KV, const bf16_t* __restrict__ KRB, const bf16_t* __restrict__ WKVT,
                       const float* __restrict__ LATP, const float* __restrict__ ML, bf16_t* __restrict__ MIX) {
    const int tid = threadIdx.x;
    LAS float* latc = (LAS float*)lds; LAS float* pn = latc + 64 * KVR; LAS float* wgt = pn + 64 * 8;
    {
        const int qh = tid >> 3, j = tid & 7, h = qh >> 3, q = qh & 7;
        const bf16_t* qp = QB + (size_t)(MP + sb * DT + q) * QDIM + h * QKH; const size_t krow_ = (size_t)MP + sb * DT + j;
        float sj = 0.f;
        for (int d = 0; d < 64; ++d) sj += bf2f(qp[d]) * bf2f(KV[krow_ * 1024 + h * 64 + d]);
        for (int r = 0; r < 32; ++r) sj += bf2f(qp[64 + r]) * bf2f(KRB[krow_ * ROPE + r]);
        if (j > q) sj = -INFINITY;
        const float m0 = ML[((size_t)(2 * sb) * 64 + qh) * 2], l0 = ML[((size_t)(2 * sb) * 64 + qh) * 2 + 1], m1 = ML[((size_t)(2 * sb + 1) * 64 + qh) * 2], l1 = ML[((size_t)(2 * sb + 1) * 64 + qh) * 2 + 1];
        const float mm = max8(sj);
        const float M = fmaxf(fmaxf(m0, m1), mm);
        const float pj = exp2f(sj - M), w0 = exp2f(m0 - M), w1 = exp2f(m1 - M);
        const float sp = sum8(pj);
        const float L = w0 * l0 + w1 * l1 + sp, iL = 1.f / L;
        pn[qh * 8 + j] = pj * iL;
        if (j == 0) { wgt[qh * 2] = w0 * iL; wgt[qh * 2 + 1] = w1 * iL; }
    }
    __syncthreads();
    for (int e = tid; e < 64 * KVR; e += NTHR) { const int qh = e >> 8; latc[e] = wgt[qh * 2] * LATP[(size_t)(2 * sb) * 64 * KVR + e] + wgt[qh * 2 + 1] * LATP[(size_t)(2 * sb + 1) * 64 * KVR + e]; }
    __syncthreads();
    for (int o = tid; o < 64 * VH; o += NTHR) {
        const int qh = o >> 6, v = o & 63, h = qh >> 3, q = qh & 7;
        const bf16_t* wr = WKVT + (size_t)(512 + h * 64 + v) * KVR;
        float a = 0.f;
        for (int c = 0; c < KVR; ++c) a += latc[qh * KVR + c] * bf2f(wr[c]);
        for (int j = 0; j < DT; ++j) a += pn[qh * 8 + j] * bf2f(KV[((size_t)MP + sb * DT + j) * 1024 + 512 + h * 64 + v]);
        MIX[(size_t)(MP + sb * DT + q) * DM + 512 + h * 64 + v] = (bf16_t)f2bf(a);
    }
    __syncthreads();
}

DI void attn_s_scores_item(int chunk, int sb, int tid, const float* __restrict__ cache_ckv, const float* __restrict__ cache_kr, const int* __restrict__ page_table, const bf16_t* __restrict__ QB,
                           const bf16_t* __restrict__ CB, const bf16_t* __restrict__ KRB, const float* __restrict__ w_uk, const float* __restrict__ g_k_nope, float* __restrict__ SC) {
    const int key = tid & 127, hq = __builtin_amdgcn_readfirstlane(tid >> 7);
    const bool isnew = chunk == NPAGES;
    if (isnew && key >= DT) return;
    const float* crow = nullptr; const bf16_t* crowb = nullptr; const float* kpf = nullptr; const bf16_t* kpb = nullptr;
    if (!isnew) { const size_t pr = (size_t)page_table[sb * NPAGES + chunk] * PAGE + key; crow = cache_ckv + pr * KVR; kpf = cache_kr + pr * ROPE; }
    else { const size_t rr = (size_t)MP + sb * DT + key; crowb = CB + rr * KVR; kpb = KRB + rr * ROPE; }
    const int jglob = isnew ? PAST + key : chunk * PAGE + key;
    for (int hi = 0; hi < 2; ++hi) {
        const int h = hq * 2 + hi;
        float acc[NOPE];
#pragma unroll
        for (int d = 0; d < NOPE; ++d) acc[d] = 0.f;
        for (int c = 0; c < KVR; ++c) {
            const float cv = isnew ? bf2f(crowb[c]) : crow[c];
            const float* wr = w_uk + (size_t)c * 512 + h * 64;
#pragma unroll
            for (int d = 0; d < NOPE; ++d) acc[d] += cv * wr[d];
        }
        float ss = 0.f;
#pragma unroll
        for (int d = 0; d < NOPE; ++d) ss += acc[d] * acc[d];
        const float ri = rsqrtf(ss * (1.f / 64.f) + EPS);
#pragma unroll 1
        for (int q = 0; q < DT; ++q) {
            const bf16_t* qp = QB + (size_t)(MP + sb * DT + q) * QDIM + h * QKH;
            float s = 0.f;
#pragma unroll
            for (int d = 0; d < NOPE; ++d) s += acc[d] * g_k_nope[d] * bf2f(qp[d]);
            s *= ri;
            for (int r = 0; r < ROPE; ++r) s += (isnew ? bf2f(kpb[r]) : kpf[r]) * bf2f(qp[64 + r]);
            if (isnew && key > q) s = -INFINITY;
            SC[((size_t)sb * 64 + h * 8 + q) * NKEYS + jglob] = s;
        }
    }
}
DI void attn_s_pv_item(int sb, int tid, LAS float* lds, const float* __restrict__ cache_ckv, const int* __restrict__ page_table, const bf16_t* __restrict__ CB, const float* __restrict__ SC,
                       const float* __restrict__ w_uv, float* __restrict__ LAT, bf16_t* __restrict__ MIX) {
    LAS float* p = lds; LAS float* smx = lds + 64 * PAGE; LAS float* sinv = smx + 64;
    const int wid = tid >> 6, lane = tid & 63;
    for (int i = 0; i < 8; ++i) {
        const int qh = wid * 8 + i; const float* s = SC + ((size_t)sb * 64 + qh) * NKEYS;
        float mx = -INFINITY; for (int j = lane; j < NKEYS; j += 64) mx = fmaxf(mx, s[j]);
        mx = wave_max(mx);
        float sum = 0.f; for (int j = lane; j < NKEYS; j += 64) sum += exp2f(s[j] - mx);
        sum = wave_sum(sum);
        if (lane == 0) { smx[qh] = mx; sinv[qh] = 1.f / sum; }
    }
    __syncthreads();
    const int c = tid & 255, half = tid >> 8;
    float lat[32];
#pragma unroll
    for (int i = 0; i < 32; ++i) lat[i] = 0.f;
    for (int chunk = 0; chunk <= NPAGES; ++chunk) {
        const int nk = chunk == NPAGES ? DT : PAGE;
        for (int e = tid; e < 64 * PAGE; e += NTHR) { const int qh = e >> 7, j = e & 127; p[qh * PAGE + j] = j < nk ? exp2f(SC[((size_t)sb * 64 + qh) * NKEYS + chunk * PAGE + j] - smx[qh]) * sinv[qh] : 0.f; }
        __syncthreads();
        for (int j = 0; j < nk; ++j) {
            float cv;
            if (chunk < NPAGES) cv = cache_ckv[((size_t)page_table[sb * NPAGES + chunk] * PAGE + j) * KVR + c];
            else cv = bf2f(CB[((size_t)MP + sb * DT + j) * KVR + c]);
#pragma unroll
            for (int i = 0; i < 32; ++i) lat[i] += p[(half * 32 + i) * PAGE + j] * cv;
        }
        __syncthreads();
    }
    float* L = LAT + (size_t)sb * 64 * KVR;
#pragma unroll
    for (int i = 0; i < 32; ++i) L[(half * 32 + i) * KVR + c] = lat[i];
    __threadfence_block(); __syncthreads();
    for (int o = tid; o < 64 * VH; o += NTHR) {
        const int qh = o >> 6, v = o & 63, h = qh >> 3, q = qh & 7;
        float a = 0.f;
        for (int cc = 0; cc < KVR; ++cc) a += L[qh * KVR + cc] * w_uv[(size_t)cc * 512 + h * 64 + v];
        MIX[(size_t)(MP + sb * DT + q) * DM + 512 + h * 64 + v] = (bf16_t)f2bf(a);
    }
    __syncthreads();
}

enum Phase { PH_PRO = 0, PH_Z0, PH_POST0, PH_KVPOOL, PH_KNORM, PH_ATTN, PH_ATTN2, PH_OUT0, PH_UP0, PH_DN0, PH_RNNIN, PH_CONV, PH_GATES, PH_SCAN, PH_OUTR, PH_UP1, PH_DN1, PH_COUNT };

__global__ void __launch_bounds__(NTHR, 2) mk(Args args) {
    extern __shared__ __attribute__((aligned(16))) unsigned char lds_raw[];
    LAS unsigned char* lds = (LAS unsigned char*)lds_raw;
    volatile LAS unsigned* MISC = (volatile LAS unsigned*)(lds + LDS_MISC);
    const int tid = threadIdx.x, lane = tid & 63, wave = __builtin_amdgcn_readfirstlane(tid >> 6);
    const int G = gridDim.x, bx = blockIdx.x;
    const int gw = bx * NWAVES + wave, NGW = G * NWAVES;
    const int lo = args.ph_lo, hi = args.ph_hi;

    const float* x_prompt = (const float*)args.in[0]; const float* x_sample = (const float*)args.in[1];
    const float* cache_ckv = (const float*)args.in[2]; const float* cache_kr = (const float*)args.in[3];
    const float* state_pool = (const float*)args.in[4]; const float* state_conv = (const float*)args.in[5]; const float* state_lru = (const float*)args.in[6];
    const int* page_table = (const int*)args.in[7];
    const float* norm_mix = (const float*)args.in[8]; const float* w_in_even = (const float*)args.in[9];
    const float* g_q_nope = (const float*)args.in[10]; const float* g_q_rope = (const float*)args.in[11]; const float* g_ckv = (const float*)args.in[12]; const float* g_k_rope = (const float*)args.in[13]; const float* g_k_nope = (const float*)args.in[14];
    const float* w_uk = (const float*)args.in[15]; const float* w_uv = (const float*)args.in[16]; const float* w_pool = (const float*)args.in[17]; const float* pool_scale = (const float*)args.in[18];
    const float* w_out_even = (const float*)args.in[19]; const float* w_in_rnn = (const float*)args.in[20]; const float* conv_w = (const float*)args.in[21]; const float* conv_b = (const float*)args.in[22];
    const float* w_gate_a = (const float*)args.in[23]; const float* b_gate_a = (const float*)args.in[24]; const float* w_gate_x = (const float*)args.in[25]; const float* b_gate_x = (const float*)args.in[26];
    const float* lru_lambda = (const float*)args.in[27]; const float* w_out_rnn = (const float*)args.in[28]; const float* norm_ffn = (const float*)args.in[29]; const float* w_up = (const float*)args.in[30]; const float* w_down = (const float*)args.in[31];
    float* out = args.out; unsigned char* ws = args.ws;
    bf16_t* WIN0T = (bf16_t*)(ws + WS_WIN0T); bf16_t* WKVT = (bf16_t*)(ws + WS_WKVT); bf16_t* WPOOLT = (bf16_t*)(ws + WS_WPOOLT); bf16_t* WGATET = (bf16_t*)(ws + WS_WGATET);
    bf16_t* WOUT0T = (bf16_t*)(ws + WS_WOUT0T); bf16_t* WOUTRT = (bf16_t*)(ws + WS_WOUTRT); bf16_t* WINRT = (bf16_t*)(ws + WS_WINRT); bf16_t* WUPT = (bf16_t*)(ws + WS_WUPT); bf16_t* WDNT = (bf16_t*)(ws + WS_WDNT);
    float* SSQ = (float*)(ws + WS_SSQ); bf16_t* XB = (bf16_t*)(ws + WS_XB); bf16_t* Z0 = (bf16_t*)(ws + WS_Z0); bf16_t* QB = (bf16_t*)(ws + WS_QB); bf16_t* CB = (bf16_t*)(ws + WS_CB); bf16_t* KRB = (bf16_t*)(ws + WS_KRB);
    bf16_t* DBuf = (bf16_t*)(ws + WS_DB); bf16_t* KV = (bf16_t*)(ws + WS_KV); bf16_t* MIX = (bf16_t*)(ws + WS_MIX); bf16_t* H = (bf16_t*)(ws + WS_H); bf16_t* GATE = (bf16_t*)(ws + WS_GATE); bf16_t* U = (bf16_t*)(ws + WS_U);
    bf16_t* V = (bf16_t*)(ws + WS_V); float* Gb = (float*)(ws + WS_G); bf16_t* YB = (bf16_t*)(ws + WS_YB); float* SC = (float*)(ws + WS_SC); float* LAT = (float*)(ws + WS_LAT);
    float* Y = out + O_Y;

    if (tid < 64) MISC[tid] = 0u;
    __syncthreads();
    XcdBarrier bar = xcd_barrier_post((unsigned*)(ws + WS_CTL) + CW_BAR, MISC + 8);
#ifndef PH_MASK
#define PH_MASK 0xFFFFFFFFu
#endif
#define IN(k) (((PH_MASK >> (k)) & 1u) && lo <= (k) && (k) < hi)
#define SEAM(k) do { if (IN(k) && IN((k) + 1)) xcd_barrier(bar); } while (0)
#define STREAM_CTL(ep_) pg8::StreamCtl{(float*)(ws + WS_PART), (unsigned*)(ws + WS_CTL) + CW_SKF, (unsigned*)(ws + WS_CTL) + CW_SKT, (unsigned)(ep_), bx, 0}
#define GEMM_PHASE_STATIC(ep_, Aptr, lda_, atoff_, ashift_, Bptr, M_, N_, K_, FT, ...) do { pg8::Gemm g{Aptr, Bptr, M_, N_, K_, lda_, atoff_, ashift_}; pg8::StaticOrder S; S.init(M_, N_, K_, G, bx); \
        pg8::EpiRows<FT> E{FT{__VA_ARGS__}}; pg8::gemm_phase<false>(lds, g, S, E, STREAM_CTL(ep_)); } while (0)
#define GEMM_PHASE(ep_, Aptr, lda_, atoff_, ashift_, Bptr, M_, N_, K_, FT, ...) do { pg8::Gemm g{Aptr, Bptr, M_, N_, K_, lda_, atoff_, ashift_}; pg8::StaticOrder S; S.init(M_, N_, K_, G, bx); \
        pg8::EpiRows<FT> E{FT{__VA_ARGS__}}; pg8::gemm_phase<false>(lds, g, S, E, STREAM_CTL(ep_)); } while (0)
#define GEMM_PHASE_P8(ep_, Aptr, lda_, Bptr, M_, N_, K_, FT, ...) do { pg8::Gemm g{Aptr, Bptr, M_, N_, K_, lda_, 0, 0}; pg8::StaticOrder S; S.init(M_, N_, K_, G, bx); \
        pg8::EpiRows<FT, false, true> E{FT{__VA_ARGS__}}; pg8::gemm_phase<false>(lds, g, S, E, STREAM_CTL(ep_)); } while (0)
#define GEMM_RESID(Aptr, lda_, Bptr, K_) GEMM_PHASE_P8(0, Aptr, lda_, Bptr, MT, DM, K_, FResid<false>, XB, (float*)nullptr, SSQ)
#define CW_RDY(i) ((unsigned*)(ws + WS_CTL) + 12288 + 64 * (i))
#define GEMM_RESID_SPLIT(Aptr, lda_, Bptr, K_) do { \
        if (G == 256) { pg8::Gemm g{Aptr, Bptr, MT, DM, K_, lda_, 0, 0}; pg8::SplitTailOrder S; S.init(K_, bx); pg8::EpiRows<FResid<false>, false, true> E{FResid<false>{XB, (float*)nullptr, SSQ}}; \
            pg8::gemm_phase<false>(lds, g, S, E, STREAM_CTL(0), EpiPartStore{(float*)(ws + WS_PART), bx & 15}); } \
        else GEMM_RESID(Aptr, lda_, Bptr, K_); } while (0)
#define FIXUP_DEFERRED(i, WAYS_) do { if (G == 256 && bx >= 128) { sample_fixup<false, WAYS_>(bx - 128, (const float*)(ws + WS_PART), XB, (float*)nullptr, SSQ); \
            asm volatile("s_waitcnt vmcnt(0)" ::: "memory"); __syncthreads(); \
            if (tid == 0) { __builtin_amdgcn_fence(__ATOMIC_RELEASE, "agent"); asm volatile("s_waitcnt vmcnt(0)" ::: "memory"); __hip_atomic_fetch_add(CW_RDY(i), 1u, __ATOMIC_RELAXED, __HIP_MEMORY_SCOPE_AGENT); } } } while (0)
#define SPLIT_WAIT_N(i, n_) do { if (tid == 0) { unsigned sp_ = 0; while (__hip_atomic_load(CW_RDY(i), __ATOMIC_RELAXED, __HIP_MEMORY_SCOPE_AGENT) < (n_)) { __builtin_amdgcn_s_sleep(2); if (++sp_ > (1u << 22)) break; } \
            __builtin_amdgcn_fence(__ATOMIC_ACQUIRE, "agent"); asm volatile("s_waitcnt vmcnt(0)" ::: "memory"); } __syncthreads(); } while (0)
#define GEMM_PHASE_P8_RDY(i, ep_, Aptr, lda_, Bptr, M_, N_, K_, FT, ...) do { pg8::Gemm g{Aptr, Bptr, M_, N_, K_, lda_, 0, 0}; if (G == 256) { g.ready = CW_RDY(i); g.ready_target = 128u; } pg8::StaticOrder S; S.init(M_, N_, K_, G, bx); \
        pg8::EpiRows<FT, false, true> E{FT{__VA_ARGS__}}; pg8::gemm_phase<false>(lds, g, S, E, STREAM_CTL(ep_)); } while (0)
#define GEMM_DOWN(Aptr, Bptr, FIN) do { \
        if (G == 256) { pg8::Gemm g{Aptr, Bptr, MT, DM, DFF, DFF, 0, 0}; pg8::SplitTailOrder S; S.init(DFF, bx); pg8::EpiRows<FResid<FIN>, false, true> E{FResid<FIN>{XB, Y, SSQ}}; \
            pg8::gemm_phase<false>(lds, g, S, E, STREAM_CTL(0), EpiPartStore{(float*)(ws + WS_PART), bx & 15}); \
            if (FIN) { xcd_barrier(bar); sample_fixup<FIN>(bx, (const float*)(ws + WS_PART), XB, Y, SSQ); } } \
        else GEMM_PHASE_STATIC(0, Aptr, DFF, 0, 0, Bptr, MT, DM, DFF, FResid<FIN>, XB, Y, SSQ); } while (0)

    if (IN(PH_PRO)) for (int rep_ = 0; rep_ < REPN(10); ++rep_) {
        LAS float* scr = (LAS float*)(lds + wave * 16384);
        constexpr int I0 = 16 * 49, I1 = 4 * 16, I3 = 2 * 4;
        constexpr int NITEMS = I0 + 2 * I1 + 4 * I3;
        for (int it = gw; it < NITEMS; it += NGW) {
            int r = it;
            if (r < I0) { p0_transpose_item(w_in_even, 1568, 1568, WIN0T, DM, norm_mix, scr, r, lane); continue; } r -= I0;
            if (r < I1) { p0_transpose_item(w_uk, 512, 512, WKVT, KVR, nullptr, scr, r, lane); continue; } r -= I1;
            if (r < I1) { p0_transpose_item(w_uv, 512, 512, WKVT + (size_t)512 * KVR, KVR, nullptr, scr, r, lane); continue; } r -= I1;
            { const int g = r / I3; p0_transpose_item(w_pool + (size_t)g * 128 * 128, 128, 128, WPOOLT + (size_t)g * 128 * 256 + (g & 1) * 128, 256, nullptr, scr, r % I3, lane); }
        }
        { u32x4* z0 = (u32x4*)(WIN0T + (size_t)1568 * DM); const u32x4 zz = {0u, 0u, 0u, 0u};
          for (int e = bx * NTHR + tid; e < (NZ0 - 1568) * DM / 8; e += G * NTHR) z0[e] = zz;
          for (int e = bx * NTHR + tid; e < 512 * 16; e += G * NTHR) { const int n = e >> 4, c8 = e & 15; *(u32x4*)(WPOOLT + (size_t)n * 256 + (1 - ((n >> 7) & 1)) * 128 + c8 * 8) = zz; }
          for (int e = bx * NTHR + tid; e < 2048 * 16; e += G * NTHR) { const int n = e >> 4, c8 = e & 15; *(u32x4*)(WGATET + (size_t)n * 256 + (1 - ((n >> 8) & 1)) * 128 + c8 * 8) = zz; } }
        { float* ROPET = (float*)(ws + WS_ROPE);
          for (int e = bx * NTHR + tid; e < (SEQ + DT) * 16; e += G * NTHR) { const int pi = e >> 4, i = e & 15; const int pos = pi < SEQ ? pi : PAST + (pi - SEQ);
              const float inv = powf(10000.0f, -(float)i / 16.0f); const float ang = (float)pos * inv; ROPET[e * 2] = cosf(ang); ROPET[e * 2 + 1] = sinf(ang); } }
        if (bx == G - 1) for (int c = tid; c < DM; c += NTHR) ((float*)(ws + WS_SP8))[c] = log1pf(expf(-lru_lambda[c])) * (8.0f * 1.4426950408889634f);
        {
#define XROW(r_) ((r_) < MP ? x_prompt + (size_t)(r_) * DM : x_sample + (size_t)((r_) - MP) * DM)
            f32x4 nv[4]; if (gw < MT) rowprep_load(XROW(gw), lane, nv);
            for (int row = gw; row < MT; row += NGW) { f32x4 v[4];
#pragma unroll
                for (int j = 0; j < 4; ++j) v[j] = nv[j];
                const int nr = row + NGW; if (nr < MT) rowprep_load(XROW(nr), lane, nv);
                rowprep_row(v, row, XB, SSQ, lane); }
#undef XROW
        }
    }
    SEAM(PH_PRO);
    if (REP_ID == 40) { for (int i = 0; i < 10; ++i) xcd_barrier(bar); }
    if (IN(PH_Z0)) for (int rep_ = 0; rep_ < REPN(1); ++rep_) GEMM_PHASE_P8(1, XB, DM, WIN0T, MT, NZ0, DM, FZ0, SSQ, Z0);
    SEAM(PH_Z0);
    if (IN(PH_POST0)) for (int rep_ = 0; rep_ < REPN(2); ++rep_) {
        const float* ROPET = (const float*)(ws + WS_ROPE);
        for (int row = gw; row < MT; row += NGW) post0_row(row, lane, Z0, ROPET, g_q_nope, g_q_rope, g_ckv, g_k_rope, QB, CB, KRB, out);
        for (int it = bx * NTHR + tid; it < (MP / 16) * 64; it += G * NTHR) pool_item_p16((it >> 6) * 16, (it & 63) * 8, Z0, DBuf, out);
        for (int it = bx * NTHR + tid; it < DB_ * 64; it += G * NTHR) pool_item<false>(MP + (it >> 6) * DT, DT, (it & 63) * 8, Z0, state_pool, DBuf, out);
    }
    SEAM(PH_POST0);
    if (IN(PH_KVPOOL) && REP_ID == 13) { GEMM_PHASE(14, CB, KVR, 0, 0, WKVT, MT, 1024, KVR, FRawBf16<1024>, (bf16_t*)(ws + WS_DBG)); GEMM_PHASE_STATIC(15, DBuf, POOLD, 256, 0, WPOOLT, MT, POOLD, 256, FPool, pool_scale, MIX); }
    if (IN(PH_KVPOOL)) {
        { pg8::Gemm g{CB, WKVT, MT, 1024, KVR, KVR, 0, 0}; pg8::StaticOrder S; S.init(MT, 1024, KVR, G, bx); pg8::EpiRows<FKvNorm, true, true> E{FKvNorm{KV, g_k_nope}}; pg8::gemm_phase<false>(lds, g, S, E, STREAM_CTL(2)); }
        { pg8::Gemm g{DBuf, WPOOLT, MT, POOLD, 256, POOLD, 256, 0}; pg8::StaticOrder S; S.init(MT, POOLD, 256, G, (G == 256) ? ((bx + 240) & 255) : bx); pg8::EpiRows<FPool, false, true> E{FPool{pool_scale, MIX}}; pg8::gemm_phase<false>(lds, g, S, E, STREAM_CTL(3)); }
    }
#if DBG_KNORM
    if (IN(PH_KVPOOL)) GEMM_PHASE_STATIC(16, CB, KVR, 0, 0, WKVT, MT, 1024, KVR, FRawBf16<1024>, (bf16_t*)(ws + WS_DBG));
#endif
    SEAM(PH_KVPOOL);
#if DBG_KNORM
    if (IN(PH_KNORM)) { const bf16_t* R = (const bf16_t*)(ws + WS_DBG); unsigned bad = 0;
        for (int row = gw; row < MT; row += NGW) {
            for (int h = 0; h < NH; ++h) { const float x = bf2f(R[(size_t)row * 1024 + h * 64 + lane]); const float ss = wave_sum(x * x); const float y = x * rsqrtf(ss * (1.f / 64.f) + EPS) * g_k_nope[lane];
                const float a = bf2f(KV[(size_t)row * 1024 + h * 64 + lane]); if (!(fabsf(a - y) <= 0.02f + 0.02f * fabsf(y))) ++bad; }
            for (int c = lane; c < 512; c += 64) { const float y = bf2f(R[(size_t)row * 1024 + 512 + c]), a = bf2f(KV[(size_t)row * 1024 + 512 + c]); if (!(fabsf(a - y) <= 1e-3f + 0.01f * fabsf(y))) ++bad; } }
        if (bad) atomicAdd((unsigned*)(ws + WS_CTL) + CW_DBG, bad); }
#endif
    if (IN(PH_ATTN)) {
        LAS float* sc = (LAS float*)(lds + wave * 16768);
#if DBG_ATTN_P
        for (int it = gw; it < MP * NH; it += NGW) attn_p_naive_item(it, lane, sc, QB, KV, KRB, (bf16_t*)(ws + WS_DBG));
        __syncthreads();
#endif
#ifndef NO_ATTN_P
        { const int vcu = (G % 8 == 0) ? (bx % 8) * (G / 8) + bx / 8 : bx;
          for (int rep_ = 0; rep_ < REPN(3); ++rep_) for (int pi = vcu; pi < 256; pi += G) { const int bh = pi >> 3, s8 = pi & 7; attn_p_unit(bh >> 3, bh & 7, 15 - s8, lds, QB, KV, KRB, MIX); attn_p_unit(bh >> 3, bh & 7, s8, lds, QB, KV, KRB, MIX); }
          asm volatile("s_waitcnt vmcnt(0)" ::: "memory"); __syncthreads(); }
#endif
#if DBG_ATTN_S
        for (int it = bx; it < (NPAGES + 1) * DB_; it += G) attn_s_scores_item(it % (NPAGES + 1), it / (NPAGES + 1), tid, cache_ckv, cache_kr, page_table, QB, CB, KRB, w_uk, g_k_nope, SC);
        __syncthreads();
#endif
        if (REP_ID >= 20 && REP_ID <= 24) for (int u = bx; u < 2 * DB_; u += G) attn_s_unit<(REP_ID >= 20 && REP_ID <= 24) ? REP_ID - 19 : 1>(u, lds, cache_ckv, cache_kr, page_table, QB, WKVT, g_k_nope, (float*)(ws + WS_DBG), (float*)(ws + WS_DBG + 40 * MiB));
        for (int rep_ = 0; rep_ < REPN(4); ++rep_) for (int u = bx; u < 2 * DB_; u += G) attn_s_unit<0>(u, lds, cache_ckv, cache_kr, page_table, QB, WKVT, g_k_nope, (float*)(ws + WS_LATP), (float*)(ws + WS_ML));
        asm volatile("s_waitcnt vmcnt(0)" ::: "memory"); __syncthreads();
    }
    SEAM(PH_ATTN);
#if DBG_ATTN_P
    if (IN(PH_ATTN2)) {
        const bf16_t* R = (const bf16_t*)(ws + WS_DBG); unsigned bad = 0;
        for (size_t i = (size_t)bx * NTHR + tid; i < (size_t)MP * 512; i += (size_t)G * NTHR) { const size_t row = i >> 9, c = 512 + (i & 511); const float a = bf2f(MIX[row * DM + c]), r = bf2f(R[row * DM + c]);
            if (!(fabsf(a - r) <= 0.01f + 0.02f * fabsf(r))) ++bad; }
        if (bad) atomicAdd((unsigned*)(ws + WS_CTL) + CW_DBG, bad);
    }
#endif
    if (IN(PH_ATTN2)) { __syncthreads();
#if DBG_ATTN_S
        for (int sb = bx; sb < DB_; sb += G) attn_s_pv_item(sb, tid, (LAS float*)lds, cache_ckv, page_table, CB, SC, w_uv, LAT, (bf16_t*)(ws + WS_DBG));
        __syncthreads();
#endif
        for (int sb = bx; sb < DB_; sb += G) attn_s_combine(sb, lds, QB, KV, KRB, WKVT, (const float*)(ws + WS_LATP), (const float*)(ws + WS_ML), MIX);
#if DBG_ATTN_S
        asm volatile("s_waitcnt vmcnt(0)" ::: "memory"); __syncthreads();
        { const bf16_t* R = (const bf16_t*)(ws + WS_DBG); unsigned bad = 0; float num_ = 0.f, den_ = 0.f;
          for (int sb = bx; sb < DB_; sb += G) for (int i = tid; i < DT * 512; i += NTHR) { const size_t row = (size_t)MP + sb * DT + (i >> 9), c = 512 + (i & 511); const float a = bf2f(MIX[row * DM + c]), r = bf2f(R[row * DM + c]);
              num_ += (a - r) * (a - r); den_ += r * r; if (!(fabsf(a - r) <= 0.02f + 0.5f * fabsf(r))) ++bad; }
          if (bad) atomicAdd((unsigned*)(ws + WS_CTL) + CW_DBG, bad);
          num_ = wave_sum(num_); den_ = wave_sum(den_); if (lane == 0) { atomicAdd((float*)(ws + WS_CTL) + CW_DBG + 2, num_); atomicAdd((float*)(ws + WS_CTL) + CW_DBG + 3, den_); } }
#endif
    }
    if (IN(PH_ATTN2) && bx >= DB_) {
        LAS float* scr = (LAS float*)(lds + wave * 16384);
        for (int it = (bx - DB_) * NWAVES + wave; it < 16 * 32; it += (G - DB_) * NWAVES) p0_transpose_item(w_out_even, DM, DM, WOUT0T, DM, nullptr, scr, it, lane);
        if (G == 256) for (int it = (bx - DB_) * NWAVES + wave; it < 16 * 128; it += (G - DB_) * NWAVES) p0_transpose_item(w_up, DFF, DFF, WUPT, DM, norm_ffn, scr, it, lane);
    }
    SEAM(PH_ATTN2);
    if (IN(PH_OUT0)) GEMM_RESID_SPLIT(MIX, DM, WOUT0T, DM);
    if (IN(PH_OUT0) && G != 256) {
        const int gw2 = bx * NWAVES + wave, NGW2 = G * NWAVES;
        LAS float* scr = (LAS float*)(lds + wave * 16384);
        constexpr int I8 = 16 * 128, I10 = 64 * 32;
        for (int it = gw2; it < I8 + I10; it += NGW2) {
            if (it < I8) p0_transpose_item(w_up, DFF, DFF, WUPT, DM, norm_ffn, scr, it, lane);
            else p0_transpose_item(w_down, DM, DM, WDNT, DFF, nullptr, scr, it - I8, lane);
        }
    }
    SEAM(PH_OUT0);
    if (IN(PH_UP0) && REP_ID == 30) GEMM_PHASE(30, XB, DM, 0, 0, WUPT, MT, DFF, DM, FNull, (float*)(ws + WS_DBG));
    if (IN(PH_UP0)) { FIXUP_DEFERRED(0, 8); GEMM_PHASE_P8_RDY(0, 5, XB, DM, WUPT, MT, DFF, DM, FUp, SSQ, H); }
    if (IN(PH_UP0)) {
        const int nidle = G - 64;
        if (G == 256 ? (bx >= 64) : true) {
            const int gw2 = (G == 256 ? (bx - 64) : bx) * NWAVES + wave, NGW2 = (G == 256 ? nidle : G) * NWAVES;
            LAS float* scr = (LAS float*)(lds + wave * 16384);
            constexpr int I3 = 2 * 4, I7 = 16 * 32, I8 = 16 * 128, I10 = 64 * 32, I12 = 16 * 64;
            constexpr int NIT2 = I8 + I10 + I12 + 16 * I3 + I7;
            if (G == 256) for (int it = gw2; it < I10; it += NGW2) p0_transpose_item(w_down, DM, DM, WDNT, DFF, nullptr, scr, it, lane);
            for (int it = gw2; it < NIT2; it += NGW2) {
                int r = it;
                if (r < I8) { p0_transpose_item(w_up + (size_t)DM * DFF, DFF, DFF, WUPT + (size_t)DFF * DM, DM, norm_ffn + DM, scr, r, lane); continue; } r -= I8;
                if (r < I10) { p0_transpose_item(w_down + (size_t)DFF * DM, DM, DM, WDNT + (size_t)DM * DFF, DFF, nullptr, scr, r, lane); continue; } r -= I10;
                if (r < I12) { p0_transpose_item(w_in_rnn, 2048, 2048, WINRT, DM, norm_mix + DM, scr, r, lane); continue; } r -= I12;
                if (r < 16 * I3) { const int q = r / I3, n = q >> 1, isx = q & 1; const float* src = (isx ? w_gate_x : w_gate_a) + (size_t)n * 128 * 128;
                    p0_transpose_item(src, 128, 128, WGATET + (size_t)(n * 256 + isx * 128) * 256 + (n & 1) * 128, 256, nullptr, scr, r % I3, lane); continue; } r -= 16 * I3;
                p0_transpose_item(w_out_rnn, DM, DM, WOUTRT, DM, nullptr, scr, r, lane);
            }
        }
    }
    SEAM(PH_UP0);
    if (IN(PH_DN0)) GEMM_DOWN(H, WDNT, false);
    SEAM(PH_DN0);
    if (IN(PH_RNNIN)) { FIXUP_DEFERRED(1, 16);
        if (G == 256) {
            GEMM_PHASE_P8(7, XB, DM, WINRT, MP, 2048, DM, FRnnIn, SSQ, GATE, U);
            SPLIT_WAIT_N(1, 128u);
            rnnin_sample_item(bx, lds, XB, WINRT, SSQ, GATE, U);
        } else GEMM_PHASE_P8_RDY(1, 7, XB, DM, WINRT, MT, 2048, DM, FRnnIn, SSQ, GATE, U); }
    SEAM(PH_RNNIN);
    if (IN(PH_CONV)) for (int rep_ = 0; rep_ < REPN(12); ++rep_) {
        for (int it = bx * NTHR + tid; it < (MP / 16) * 128; it += G * NTHR) conv_item_p16((it >> 7) * 16, (it & 127) * 8, U, conv_w, conv_b, V, out);
        for (int it = bx * NTHR + tid; it < DB_ * 128; it += G * NTHR) conv_item<false>(MP + (it >> 7) * DT, DT, (it & 127) * 8, U, state_conv, conv_w, conv_b, V, out);
    }
    SEAM(PH_CONV);
    if (IN(PH_GATES)) for (int rep_ = 0; rep_ < REPN(9); ++rep_) { pg8::Gemm g{V, WGATET, MT, 2048, 256, DM, 256, 1}; pg8::StaticOrder S; S.init(G == 256 ? MP : MT, 2048, 256, G, bx);
        EpiGates E{V, b_gate_a, b_gate_x, (const float*)(ws + WS_SP8), (bf16_t*)(ws + WS_HL), (bf16_t*)(ws + WS_AC), (float*)(ws + WS_SUM)}; pg8::gemm_phase<false>(lds, g, S, E, STREAM_CTL(8)); }
    SEAM(PH_GATES);
    if (IN(PH_SCAN)) for (int rep_ = 0; rep_ < REPN(11); ++rep_) {
        const bf16_t* HL = (const bf16_t*)(ws + WS_HL); const bf16_t* AC = (const bf16_t*)(ws + WS_AC); const float* SUM = (const float*)(ws + WS_SUM);
        for (int idx = bx * NTHR + tid; idx < 256 * 4 * 128; idx += G * NTHR) {
            const int cg = idx & 127, qt = (idx >> 7) & 3, segp = idx >> 9, sq = segp & 63, ch = cg * 8;
            u32x4 rhl[2][8], rac[2][8], rgt[2][8];
#define SCAN_LD(bt_) do { _Pragma("unroll") for (int t = 0; t < 8; ++t) { const size_t off = (size_t)(segp * 64 + qt * 16 + (bt_) * 8 + t) * DM + ch; rhl[bt_][t] = *(const u32x4*)(HL + off); rac[bt_][t] = *(const u32x4*)(AC + off); rgt[bt_][t] = *(const u32x4*)(GATE + off); } } while (0)
            SCAN_LD(0);
            float h[8];
#pragma unroll
            for (int e = 0; e < 8; ++e) h[e] = 0.f;
#pragma unroll 4
            for (int k = 0; k < sq; ++k) {
                const f32x4* sp4 = (const f32x4*)(SUM + ((size_t)(segp - sq + k) * DM + ch) * 2);
                const f32x4 s0 = sp4[0], s1 = sp4[1], s2 = sp4[2], s3 = sp4[3];
                h[0] = s0.x * h[0] + s0.y; h[1] = s0.z * h[1] + s0.w; h[2] = s1.x * h[2] + s1.y; h[3] = s1.z * h[3] + s1.w;
                h[4] = s2.x * h[4] + s2.y; h[5] = s2.z * h[5] + s2.w; h[6] = s3.x * h[6] + s3.y; h[7] = s3.z * h[7] + s3.w;
            }
            SCAN_LD(1);
#undef SCAN_LD
#pragma unroll
            for (int t = 0; t < 16; ++t) {
                const size_t off = (size_t)(segp * 64 + qt * 16 + t) * DM + ch;
                const u32x4 hl = rhl[t >> 3][t & 7], ac = rac[t >> 3][t & 7], gt = rgt[t >> 3][t & 7];
                float hv[8]; u32x4 o;
#pragma unroll
                for (int e2 = 0; e2 < 4; ++e2) {
                    hv[2 * e2] = __uint_as_float(hl[e2] << 16) + __uint_as_float(ac[e2] << 16) * h[2 * e2];
                    hv[2 * e2 + 1] = __uint_as_float(hl[e2] & 0xffff0000u) + __uint_as_float(ac[e2] & 0xffff0000u) * h[2 * e2 + 1];
                    o[e2] = pk2(__uint_as_float(gt[e2] << 16) * hv[2 * e2], __uint_as_float(gt[e2] & 0xffff0000u) * hv[2 * e2 + 1]);
                }
                *(u32x4*)(YB + off) = o;
                if (sq == 63 && qt == 3 && t == 15) {
#pragma unroll
                    for (int e = 0; e < 8; ++e) out[O_LRU_P + (size_t)(segp >> 6) * DM + ch + e] = hv[e];
                }
            }
        }
        if (G == 256) { for (int item = bx; item < (DB_ / 2) * 8; item += G) gates_sample_item(item, wave, lane, V, WGATET, b_gate_a, b_gate_x, (const float*)(ws + WS_SP8), GATE, state_lru, YB, out); }
        else
        for (int idx = bx * NTHR + tid; idx < DB_ * 128; idx += G * NTHR) {
            const int cg = idx & 127, sb = idx >> 7, ch = cg * 8;
            float h[8];
#pragma unroll
            for (int e = 0; e < 8; ++e) h[e] = state_lru[(size_t)sb * DM + ch + e];
            for (int t = 0; t < DT; ++t) {
                const size_t off = (size_t)(MP + sb * DT + t) * DM + ch;
                const u32x4 hl = *(const u32x4*)(HL + off), ac = *(const u32x4*)(AC + off), gt = *(const u32x4*)(GATE + off);
                float hv[8]; u32x4 o;
#pragma unroll
                for (int e2 = 0; e2 < 4; ++e2) {
                    hv[2 * e2] = __uint_as_float(hl[e2] << 16) + __uint_as_float(ac[e2] << 16) * h[2 * e2];
                    hv[2 * e2 + 1] = __uint_as_float(hl[e2] & 0xffff0000u) + __uint_as_float(ac[e2] & 0xffff0000u) * h[2 * e2 + 1];
                    o[e2] = pk2(__uint_as_float(gt[e2] << 16) * hv[2 * e2], __uint_as_float(gt[e2] & 0xffff0000u) * hv[2 * e2 + 1]);
                }
                *(u32x4*)(YB + off) = o;
                if (t == DT - 1) {
#pragma unroll
                    for (int e = 0; e < 8; ++e) out[O_LRU_S + (size_t)sb * DM + ch + e] = hv[e];
                }
            }
        }
    }
    SEAM(PH_SCAN);
    if (IN(PH_OUTR)) GEMM_RESID_SPLIT(YB, DM, WOUTRT, DM);
    SEAM(PH_OUTR);
    if (IN(PH_UP1)) { FIXUP_DEFERRED(2, 8); GEMM_PHASE_P8_RDY(2, 10, XB, DM, WUPT + (size_t)DFF * DM, MT, DFF, DM, FUp, SSQ, H); }
    SEAM(PH_UP1);
#if DBG_ANY
    if (IN(PH_DN1)) { const float n_ = __hip_atomic_load((float*)(ws + WS_CTL) + CW_DBG + 2, __ATOMIC_RELAXED, __HIP_MEMORY_SCOPE_AGENT), d_ = __hip_atomic_load((float*)(ws + WS_CTL) + CW_DBG + 3, __ATOMIC_RELAXED, __HIP_MEMORY_SCOPE_AGENT);
        if ((__hip_atomic_load((unsigned*)(ws + WS_CTL) + CW_DBG, __ATOMIC_RELAXED, __HIP_MEMORY_SCOPE_AGENT) != 0u || n_ > DBG_RVR * d_) && bx == 0 && tid == 0) out[O_LRU_S] = __builtin_nanf(""); }
#endif
    if (IN(PH_DN1)) GEMM_DOWN(H, WDNT + (size_t)DM * DFF, true);
#undef IN
#undef SEAM
#undef GEMM_PHASE
}

#ifndef MK_ONE
#define MK_ONE 1
#endif
extern "C" void kernel_launch(void* const* d_in, const int* in_sizes, int n_in, void* d_out, int out_size, void* d_ws, size_t ws_size, hipStream_t stream) {
    (void)in_sizes; (void)out_size;
    static int grid = 0;
    if (grid == 0) {
        if (n_in != 32 || ws_size < WS_END) { fprintf(stderr, "kernel_launch: unexpected inputs / workspace\n"); grid = -1; return; }
        int dev = 0, cus = 0, per_cu = 0;
        if (hipGetDevice(&dev) != hipSuccess || hipDeviceGetAttribute(&cus, hipDeviceAttributeMultiprocessorCount, dev) != hipSuccess) { grid = -1; return; }
        if (hipFuncSetAttribute((const void*)mk, hipFuncAttributeMaxDynamicSharedMemorySize, LDS_BYTES) != hipSuccess) { fprintf(stderr, "kernel_launch: hipFuncSetAttribute failed\n"); grid = -1; return; }
        if (hipOccupancyMaxActiveBlocksPerMultiprocessor(&per_cu, (const void*)mk, NTHR, LDS_BYTES) != hipSuccess || per_cu < 1) { fprintf(stderr, "kernel_launch: occupancy query reports %d\n", per_cu); }
        (void)hipGetLastError();
        grid = cus;
    }
    if (grid < 0) return;
    unsigned char* ws = (unsigned char*)d_ws;
    (void)hipMemsetAsync(ws + WS_CTL, 0, CTL_ZERO_BYTES, stream);
    Args a{};
    for (int i = 0; i < 32; ++i) a.in[i] = d_in[i];
    a.out = (float*)d_out; a.ws = ws;
#if MK_ONE
    a.ph_lo = 0; a.ph_hi = PH_COUNT;
    hipLaunchKernelGGL(mk, dim3(grid), dim3(NTHR), LDS_BYTES, stream, a);
#else
    for (int p = 0; p < PH_COUNT; ++p) { a.ph_lo = p; a.ph_hi = p + 1; hipLaunchKernelGGL(mk, dim3(grid), dim3(NTHR), LDS_BYTES, stream, a); }
#endif
}
```

```cpp
#include <hip/hip_runtime.h>
#include <stdint.h>
#include <math.h>
#include <stdio.h>

#define DI __device__ __forceinline__
#define LAS __attribute__((address_space(3)))
typedef unsigned short bf16_t;
typedef short bf16x8 __attribute__((ext_vector_type(8)));
typedef float f32x4 __attribute__((ext_vector_type(4)));
typedef float f32x16 __attribute__((ext_vector_type(16)));
typedef unsigned u32x2 __attribute__((ext_vector_type(2)));
typedef unsigned u32x4 __attribute__((ext_vector_type(4)));

constexpr int DM = 1024, SEQ = 4096, NB = 4, MP = NB * SEQ  , DB_ = 128, DT = 8, MS = DB_ * DT  , MT = MP + MS  ;
constexpr int PAST = 8192, PAGE = 128, NPAGES = PAST / PAGE  , NKEYS = PAST + DT  ;
constexpr int POOLD = 512, QDIM = 768, KVR = 256, ROPE = 32, NH = 8, QKH = 96, NOPE = 64, VH = 64;
constexpr int NZ0 = 1792  , DFF = 4096;
constexpr float EPS = 1e-6f;
constexpr float SM_SCALE = 0.10206207261596577f;
constexpr float QSCALE = 0.10206207261596577f * 1.4426950408889634f;

constexpr size_t O_Y = 0;
constexpr size_t O_CKV_P = (size_t)MT * DM;
constexpr size_t O_KR_P = O_CKV_P + (size_t)MP * KVR;
constexpr size_t O_POOL_P = O_KR_P + (size_t)MP * ROPE;
constexpr size_t O_CONV_P = O_POOL_P + (size_t)NB * 15 * POOLD;
constexpr size_t O_LRU_P = O_CONV_P + (size_t)NB * 3 * DM;
constexpr size_t O_CKV_S = O_LRU_P + (size_t)NB * DM;
constexpr size_t O_KR_S = O_CKV_S + (size_t)MS * KVR;
constexpr size_t O_POOL_S = O_KR_S + (size_t)MS * ROPE;
constexpr size_t O_CONV_S = O_POOL_S + (size_t)DB_ * 15 * POOLD;
constexpr size_t O_LRU_S = O_CONV_S + (size_t)DB_ * 3 * DM;
constexpr size_t O_END = O_LRU_S + (size_t)DB_ * DM;
static_assert(O_END == 24393728, "output size");

constexpr size_t MiB = 1u << 20;
constexpr size_t WS_CTL = 0, CTL_ZERO_BYTES = 256 * 1024;
constexpr size_t WS_WIN0T = 1 * MiB;
constexpr size_t WS_WKVT = 5 * MiB;
constexpr size_t WS_WPOOLT = 6 * MiB;
constexpr size_t WS_WGATET = 7 * MiB;
constexpr size_t WS_WOUT0T = 8 * MiB;
constexpr size_t WS_WOUTRT = 10 * MiB;
constexpr size_t WS_WINRT = 12 * MiB;
constexpr size_t WS_WUPT = 16 * MiB;
constexpr size_t WS_WDNT = 32 * MiB;
constexpr size_t WS_SSQ = 48 * MiB;
constexpr size_t WS_SP8 = 49 * MiB + 96 * 1024;
constexpr size_t WS_ROPE = 49 * MiB + 128 * 1024;
constexpr size_t WS_XB = 50 * MiB;
constexpr size_t WS_Z0 = 84 * MiB;
constexpr size_t WS_QB = 144 * MiB;
constexpr size_t WS_CB = 170 * MiB;
constexpr size_t WS_KRB = 179 * MiB;
constexpr size_t WS_DB = 181 * MiB;
constexpr size_t WS_KV = 944 * MiB;
constexpr size_t WS_MIX = 230 * MiB;
constexpr size_t WS_H = 264 * MiB;
constexpr size_t WS_GATE = 400 * MiB;
constexpr size_t WS_U = 434 * MiB;
constexpr size_t WS_V = 468 * MiB;
constexpr size_t WS_G = 502 * MiB;
constexpr size_t WS_HL = WS_G, WS_AC = WS_G + 34 * MiB, WS_SUM = WS_G + 68 * MiB;
constexpr size_t WS_YB = 638 * MiB;
constexpr size_t WS_SC = 672 * MiB;
constexpr size_t WS_LAT = 930 * MiB;
constexpr size_t WS_ACCS = 1136 * MiB;
constexpr size_t WS_PART = 1140 * MiB;
constexpr size_t WS_END = 1140 * MiB + 2 * 256 * 262144;
constexpr int CW_BAR = 4096;
constexpr int CW_DBG = 64;
constexpr int CW_SKT = 128;
constexpr int CW_SKF = 32768;
constexpr size_t WS_DBG = 1000 * MiB;
constexpr size_t WS_LATP = 980 * MiB;
constexpr size_t WS_ML = 998 * MiB;
#ifndef DBG_ATTN_P
#define DBG_ATTN_P 0
#endif
#ifndef DBG_ATTN_S
#define DBG_ATTN_S 0
#endif
#ifndef DBG_KNORM
#define DBG_KNORM 0
#endif
#ifndef DBG_RVR
#define DBG_RVR 0.004f
#endif
#define DBG_ANY (DBG_ATTN_P || DBG_ATTN_S || DBG_KNORM)
#ifndef REP_ID
#define REP_ID 0
#endif
#define REPN(id) ((REP_ID == (id)) ? 2 : 1)

constexpr int NWAVES = 8, NTHR = NWAVES * 64;
constexpr int LDS_BYTES = 163840;
constexpr int LDS_MISC = LDS_BYTES - 1024;

DI unsigned f2bf(float f) { unsigned u = __float_as_uint(f); return (u + 0x7fffu + ((u >> 16) & 1u)) >> 16; }
DI float bf2f(bf16_t b) { return __uint_as_float(((unsigned)b) << 16); }
DI unsigned pk2(float lo, float hi) { return f2bf(lo) | (f2bf(hi) << 16); }
DI float xsum16(float x) { auto r = __builtin_amdgcn_permlane16_swap(__float_as_uint(x), __float_as_uint(x), false, false); return __uint_as_float(r[0]) + __uint_as_float(r[1]); }
DI float xsum32(float x) { auto r = __builtin_amdgcn_permlane32_swap(__float_as_uint(x), __float_as_uint(x), false, false); return __uint_as_float(r[0]) + __uint_as_float(r[1]); }
DI float xmax16(float x) { auto r = __builtin_amdgcn_permlane16_swap(__float_as_uint(x), __float_as_uint(x), false, false); return fmaxf(__uint_as_float(r[0]), __uint_as_float(r[1])); }
DI float xmax32(float x) { auto r = __builtin_amdgcn_permlane32_swap(__float_as_uint(x), __float_as_uint(x), false, false); return fmaxf(__uint_as_float(r[0]), __uint_as_float(r[1])); }
template <int CTRL> DI float dppf(float v) { return __int_as_float(__builtin_amdgcn_update_dpp(0, __float_as_int(v), CTRL, 0xF, 0xF, true)); }
DI float xchg4(float v, bool upper) { const float a = dppf<0x104>(v), b = dppf<0x114>(v); return upper ? b : a; }
DI float max8(float v) { v = fmaxf(v, dppf<0xB1>(v)); v = fmaxf(v, dppf<0x4E>(v)); v = fmaxf(v, dppf<0x141>(v)); return v; }
DI float sum8(float v) { v += dppf<0xB1>(v); v += dppf<0x4E>(v); v += dppf<0x141>(v); return v; }
DI float sum16(float v) { v = sum8(v); v += dppf<0x140>(v); return v; }
DI float wave_sum(float v) { return xsum32(xsum16(sum16(v))); }
DI float wave_max(float v) {
#pragma unroll
    for (int o = 1; o < 64; o <<= 1) v = fmaxf(v, __shfl_xor(v, o));
    return v;
}
DI float row_rinv(const float* SSQ, int row) {
    float s = 0.f;
#pragma unroll
    for (int p = 0; p < 16; ++p) s += SSQ[(size_t)p * MT + row];
    return rsqrtf(s * (1.0f / DM) + EPS);
}
DI float max3f(float a, float b, float c) { float r; asm("v_max3_f32 %0, %1, %2, %3" : "=v"(r) : "v"(a), "v"(b), "v"(c)); return r; }
DI float gelu_tanh(float x) { const float u = 0.7978845608028654f * (x + 0.044715f * x * x * x); return x * __builtin_amdgcn_rcpf(1.0f + __builtin_amdgcn_exp2f(-2.0f * 1.4426950408889634f * u)); }
DI float sigmoidf(float x) { return 1.f / (1.f + expf(-x)); }

struct UPre { float v[8]; };
namespace pg8 {
constexpr int BM = 256, BK = 64, HALF = 128, HTB = HALF * BK * 2, STAGE_BYTES = 8 * HTB, NXCD = 8, WGM = 8;
__host__ __device__ __forceinline__ int lds_byte(int r, int c) { const int st = (r >> 4) * 2 + (c >> 5), rr = r & 15, cc = c & 31, ob = rr * 64 + cc * 2; return st * 1024 + (ob ^ (((ob >> 9) & 1) << 5)); }
__host__ __device__ __forceinline__ void stage_rc(int b, int& R, int& C) { const int st = b / 1024, sb = b % 1024, swz = sb ^ (((sb >> 9) & 1) << 5); R = (st >> 1) * 16 + swz / 64; C = (st & 1) * 32 + (swz % 64) / 2; }
struct Unit { int pm, pn; };
struct Gemm { const bf16_t* A; const bf16_t* Bt; int M, N, K, lda, a_tile_off, a_shift; unsigned* ready = nullptr; unsigned ready_target = 0; };
struct Seg { int pm, pn, t0, t1; };
struct StreamOrder {
    int nM, nN, ppu, ub, lo, hi;
    DI void init(int M, int N, int K, int G, int c) {
        nM = M / BM; nN = N / BM; ppu = K / (2 * BK);
        const int nwg = nM * nN, x = c % NXCD, k = c / NXCD, nk = G / NXCD, q = nwg / NXCD, r = nwg % NXCD;
        ub = x * q + (x < r ? x : r); const int cnt = q + (x < r ? 1 : 0); const int Pr = cnt * ppu;
        lo = (k * Pr) / nk; hi = ((k + 1) * Pr) / nk;
    }
    DI bool next(int i, Seg& s) const {
        const int ul = lo / ppu + i, start = ul * ppu; if (start >= hi) return false;
        const int p0 = (lo > start ? lo : start) - start, p1 = ((hi < start + ppu) ? hi : start + ppu) - start;
        s.t0 = 2 * p0; s.t1 = 2 * p1;
        const int wgid = ub + ul, nig = WGM * nN, gid = wgid / nig, fm = gid * WGM, gsz = (nM - fm) < WGM ? (nM - fm) : WGM;
        s.pm = fm + ((wgid % nig) % gsz); s.pn = (wgid % nig) / gsz; return true;
    }
};
struct SplitTailOrder {
    int nt, c, ways, plen;
    DI void init(int K, int c_) { nt = K / BK; c = c_; ways = 16; plen = nt / 16; if (plen < 2) { plen = 2; ways = nt / 2; } }
    DI bool next(int i, Seg& u) const {
        if (i == 0) { u.t0 = 0; u.t1 = nt; const int xcd = c % NXCD, off = c / NXCD, wgid = xcd * 32 + off; u.pm = (wgid >> 5) * 8 + (wgid & 7); u.pn = (wgid >> 3) & 3; return true; }
        if (i == 1) { const int us = c >> 4, part = c & 15; if (part >= ways) return false; u.pm = 64 + (us >> 2); u.pn = us & 3; u.t0 = part * plen; u.t1 = u.t0 + plen; return true; }
        return false;
    }
};
struct StaticOrder {
    int nM, nN, nwg, G, c, nt;
    DI void init(int M, int N, int K, int G_, int c_) { nM = M / BM; nN = N / BM; nwg = nM * nN; G = G_; c = c_; nt = K / BK; }
    DI bool next(int i, Seg& u) const {
        u.t0 = 0; u.t1 = nt;
        const long L = (long)i * G + c; if (L >= nwg) return false;
        int wgid = (int)L; { const int q = nwg / NXCD, r = nwg % NXCD, xcd = wgid % NXCD, off = wgid / NXCD; wgid = (xcd < r ? xcd * (q + 1) : r * (q + 1) + (xcd - r) * q) + off; }
        const int nig = WGM * nN, gid = wgid / nig, fm = gid * WGM, gsz = (nM - fm) < WGM ? (nM - fm) : WGM;
        u.pm = fm + ((wgid % nig) % gsz); u.pn = (wgid % nig) / gsz; return true;
    }
};
struct NoPre {};
__host__ __device__ __forceinline__ int perm32(int rho) { const int n = rho >> 4, i = rho & 15; return 8 * (i >> 2) + 4 * n + (i & 3); }
template <class F, bool P64 = false, bool P8 = false> struct EpiRows {
    F f;
    static constexpr bool PERM64 = P64;
    static constexpr bool PERM8 = P8;
    DI UPre unit_pre(int pm) const { return f.unit_pre(pm * BM); }
    DI void operator()(const f32x4 (&acc)[2][2][4][2], const Unit& u, int wr, int wc, int fr, int fq, const UPre& upre) const {
        constexpr int BJS = P64 ? 32 : HALF;
        const int row0 = u.pm * BM + wr * 64 + fr, col0 = u.pn * BM + wc * (P64 ? 64 : 32) + (P8 ? 8 : 4) * fq;
        f.unit_begin(u.pm * BM, upre);
#pragma unroll
        for (int ai = 0; ai < 2; ++ai) {
            typename F::RowPre rp[4]; typename F::Pre pr[4][2][2]; typename F::Pre8 pr8[4][2];
#pragma unroll
            for (int m = 0; m < 4; ++m) rp[m] = f.row_pre(row0 + ai * HALF + m * 16);
#pragma unroll
            for (int m = 0; m < 4; ++m)
#pragma unroll
                for (int bj = 0; bj < 2; ++bj)
#pragma unroll
                    for (int n = 0; n < 2; ++n) { if constexpr (P8) { if (n == 0) pr8[m][bj] = f.pre8(row0 + ai * HALF + m * 16, col0 + bj * BJS); } else pr[m][bj][n] = f.pre(row0 + ai * HALF + m * 16, col0 + bj * BJS + n * 16); }
#pragma unroll
            for (int m = 0; m < 4; ++m) {
                const int row = row0 + ai * HALF + m * 16;
                typename F::Ctx ctx = f.row_begin(row, rp[m]);
                if constexpr (P8) {
#pragma unroll
                    for (int bj = 0; bj < 2; ++bj) f.op8(ctx, row, col0 + bj * BJS, acc[ai][bj][m][0], acc[ai][bj][m][1], pr8[m][bj]);
                } else {
#pragma unroll
                    for (int bj = 0; bj < 2; ++bj)
#pragma unroll
                        for (int n = 0; n < 2; ++n) f(ctx, row, col0 + bj * BJS + n * 16, acc[ai][bj][m][n], pr[m][bj][n]);
                }
                f.row_end(ctx, row, u.pn, wc, fq);
            }
        }
    }
};

struct StreamCtl { float* part; unsigned* flags; unsigned* tmo; unsigned epoch; int c; int pad; };
struct NoPart { DI void operator()(const f32x4 (&)[2][2][4][2], const Unit&, int, int, int, int) const {} };
template <bool STREAM, class Sched, class Epi, class EpiPart = NoPart>
DI void gemm_phase(LAS unsigned char* lds, const Gemm g, const Sched& S, const Epi& E, const StreamCtl sc, const EpiPart EP = EpiPart()) {
    const int tid = threadIdx.x, wid = __builtin_amdgcn_readfirstlane(tid >> 6), lane = tid & 63, wr = wid >> 2, wc = wid & 3, fr = lane & 15, fq = lane >> 4;
    const int K = g.K, nt = K / BK;
    unsigned voffA[2], voffB[2];
#pragma unroll
    for (int i = 0; i < 2; ++i) { int R, C; stage_rc(tid * 16 + i * 8192, R, C); const int r31 = Epi::PERM8 ? perm32(R & 31) : (R & 31); const int Rb = Epi::PERM64 ? (64 * (R >> 5) + r31) : ((R & ~31) + r31); voffA[i] = (unsigned)(R * g.lda + C) * 2u; voffB[i] = (unsigned)(Rb * K + C) * 2u; }
    const size_t kstep = (size_t)(BK * 2);
    const size_t hstepA = (size_t)HALF * g.lda * 2, hstepB = (size_t)(Epi::PERM64 ? 32 : HALF) * K * 2;
    const size_t tstepA = 2 * hstepA, tstepB = (size_t)BM * K * 2, pstepA = (size_t)g.a_tile_off * 2;
    const unsigned ldsw = (unsigned)wid * 1024u;
    const int aoff = lds_byte(wr * 64 + fr, fq * 8), boff = lds_byte(wc * 32 + fr, fq * 8);
#define PG8_SA(b, h) (((b) * 2 + (h)) * HTB)
#define PG8_SB(b, h) ((4 + (b) * 2 + (h)) * HTB)
#define PG8_STAGE(bufoff, gbase, voff) do { _Pragma("unroll") for (int _i = 0; _i < 2; ++_i) \
        __builtin_amdgcn_global_load_lds((const unsigned*)((const char*)(gbase) + (voff)[_i]), (LAS unsigned*)(lds + (bufoff) + ldsw + _i * 8192), 16, 0, 0); } while (0)
#define PG8_LDA(dst, b, h) do { _Pragma("unroll") for (int m = 0; m < 4; ++m) _Pragma("unroll") for (int k = 0; k < 2; ++k) dst[m][k] = *(const LAS bf16x8*)(lds + PG8_SA(b, h) + aoff + m * 2048 + k * 1024); } while (0)
#define PG8_LDB(dst, b, h) do { _Pragma("unroll") for (int n = 0; n < 2; ++n) _Pragma("unroll") for (int k = 0; k < 2; ++k) dst[n][k] = *(const LAS bf16x8*)(lds + PG8_SB(b, h) + boff + n * 2048 + k * 1024); } while (0)
#define PG8_MMA(ai, bj, At, Bt) do { __builtin_amdgcn_s_setprio(1); _Pragma("unroll") for (int m = 0; m < 4; ++m) _Pragma("unroll") for (int n = 0; n < 2; ++n) _Pragma("unroll") for (int k = 0; k < 2; ++k) \
        acc[ai][bj][m][n] = __builtin_amdgcn_mfma_f32_16x16x32_bf16(Bt[n][k], At[m][k], acc[ai][bj][m][n], 0, 0, 0); __builtin_amdgcn_s_setprio(0); } while (0)
#define PG8_WAIT_V(n) asm volatile("s_waitcnt vmcnt(" #n ")" ::: "memory")
#define PG8_WAIT_L(n) asm volatile("s_waitcnt lgkmcnt(" #n ")" ::: "memory")
#define PG8_BAR __builtin_amdgcn_s_barrier()
#define PG8_SCHED __builtin_amdgcn_sched_barrier(0)
    Seg cur = {0, 0, 0, 0}, nxt = {0, 0, 0, 0}; int ui = 0;
    if (!S.next(0, cur)) return;
    bool waited = g.ready == nullptr;
#define PG8_READY_WAIT() do { if (wid == 0) { unsigned sp_ = 0; \
            while (__hip_atomic_load(g.ready, __ATOMIC_RELAXED, __HIP_MEMORY_SCOPE_AGENT) < g.ready_target) { __builtin_amdgcn_s_sleep(2); if (++sp_ > (1u << 22)) break; } \
            __builtin_amdgcn_fence(__ATOMIC_ACQUIRE, "agent"); asm volatile("s_waitcnt vmcnt(0)" ::: "memory"); } \
        PG8_BAR; asm volatile("" ::: "memory"); waited = true; } while (0)
#define PG8_BAR __builtin_amdgcn_s_barrier()
    if (!waited && cur.pm >= MP / 256) PG8_READY_WAIT();
    f32x4 acc[2][2][4][2];
#pragma unroll
    for (int a = 0; a < 2; ++a)
#pragma unroll
        for (int b = 0; b < 2; ++b)
#pragma unroll
            for (int m = 0; m < 4; ++m)
#pragma unroll
                for (int n = 0; n < 2; ++n) acc[a][b][m][n] = (f32x4){0.f, 0.f, 0.f, 0.f};
    bf16x8 At[4][2], B0[2][2], B1[2][2];
    const char* cA = (const char*)g.A + (size_t)cur.pm * tstepA + (size_t)(cur.pn >> g.a_shift) * pstepA + (size_t)cur.t0 * kstep;
    const char* cB = (const char*)g.Bt + (size_t)cur.pn * tstepB + (size_t)cur.t0 * kstep;
    PG8_STAGE(PG8_SB(0, 0), cB, voffB); PG8_STAGE(PG8_SB(0, 1), cB + hstepB, voffB); PG8_STAGE(PG8_SA(0, 0), cA, voffA); PG8_STAGE(PG8_SA(0, 1), cA + hstepA, voffA);
    if (wr == 1) PG8_BAR;
    PG8_WAIT_V(2); PG8_BAR;
    PG8_STAGE(PG8_SB(1, 0), cB + kstep, voffB); PG8_STAGE(PG8_SA(1, 0), cA + kstep, voffA); PG8_STAGE(PG8_SB(1, 1), cB + hstepB + kstep, voffB);
    PG8_WAIT_V(6); PG8_BAR;
    for (;;) {
        const bool has_next = S.next(ui + 1, nxt);
        if (!waited && has_next && nxt.pm >= MP / 256) PG8_READY_WAIT();
        const char* nA = has_next ? (const char*)g.A + (size_t)nxt.pm * tstepA + (size_t)(nxt.pn >> g.a_shift) * pstepA + (size_t)nxt.t0 * kstep : cA;
        const char* nB = has_next ? (const char*)g.Bt + (size_t)nxt.pn * tstepB + (size_t)nxt.t0 * kstep : cB;
        const int nseg = cur.t1 - cur.t0;
        UPre upre{}; if (STREAM || nseg == nt) upre = E.unit_pre(cur.pm);
#pragma unroll 1
        for (int t = 0; t < nseg; t += 2) {
            const bool last = (t == nseg - 2);
            const char* a1 = cA + (size_t)(t + 1) * kstep;
            const char* a2 = last ? nA : cA + (size_t)(t + 2) * kstep; const char* b2 = last ? nB : cB + (size_t)(t + 2) * kstep;
            const char* a3 = a2 + kstep; const char* b3 = b2 + kstep;
            PG8_LDB(B0, 0, 0); PG8_LDB(B1, 0, 1); PG8_SCHED; PG8_LDA(At, 0, 0); PG8_STAGE(PG8_SA(1, 1), a1 + hstepA, voffA);
            PG8_WAIT_V(8); PG8_WAIT_L(0); PG8_BAR; PG8_MMA(0, 0, At, B0); PG8_MMA(0, 1, At, B1); PG8_BAR; PG8_SCHED;
            PG8_LDA(At, 0, 1); PG8_STAGE(PG8_SB(0, 0), b2, voffB); PG8_STAGE(PG8_SB(0, 1), b2 + hstepB, voffB); PG8_STAGE(PG8_SA(0, 0), a2, voffA);
            PG8_WAIT_V(8); PG8_WAIT_L(0); PG8_BAR; PG8_MMA(1, 0, At, B0); PG8_MMA(1, 1, At, B1); PG8_BAR; PG8_SCHED;
            PG8_LDB(B0, 1, 0); PG8_LDB(B1, 1, 1); PG8_SCHED; PG8_LDA(At, 1, 0); PG8_STAGE(PG8_SA(0, 1), a2 + hstepA, voffA);
            PG8_WAIT_V(8); PG8_WAIT_L(0); PG8_BAR; PG8_MMA(0, 0, At, B0); PG8_MMA(0, 1, At, B1); PG8_BAR; PG8_SCHED;
            PG8_LDA(At, 1, 1); PG8_STAGE(PG8_SB(1, 0), b3, voffB); PG8_STAGE(PG8_SB(1, 1), b3 + hstepB, voffB); PG8_STAGE(PG8_SA(1, 0), a3, voffA);
            PG8_WAIT_V(8); PG8_WAIT_L(0); PG8_BAR; PG8_MMA(1, 0, At, B0); PG8_MMA(1, 1, At, B1); PG8_BAR; PG8_SCHED;
        }
        if (wr == 0) PG8_BAR;
        if (STREAM && cur.t0 > 0) {
            const __amdgpu_buffer_rsrc_t prs = __builtin_amdgcn_make_buffer_rsrc((void*)(sc.part + ((size_t)(sc.epoch & 1u) * gridDim.x + sc.c) * 65536), (short)0, 262144, 0x00020000);
#pragma unroll
            for (int a = 0; a < 2; ++a)
#pragma unroll
                for (int b = 0; b < 2; ++b)
#pragma unroll
                    for (int m = 0; m < 4; ++m)
#pragma unroll
                        for (int n = 0; n < 2; ++n) { const int j = ((a * 2 + b) * 4 + m) * 2 + n; const f32x4 v = acc[a][b][m][n];
                            __builtin_amdgcn_raw_buffer_store_b128(__builtin_bit_cast(u32x4, v), prs, (unsigned)tid * 16u, j * 8192, 16); }
            asm volatile("s_waitcnt vmcnt(0)" ::: "memory");
            PG8_BAR;
            if (tid == 0) __hip_atomic_store(sc.flags + (size_t)sc.c * 64, sc.epoch, __ATOMIC_RELAXED, __HIP_MEMORY_SCOPE_AGENT);
        } else {
            Unit uu; uu.pm = cur.pm; uu.pn = cur.pn;
            if (!STREAM && (cur.t1 - cur.t0) != nt) EP(acc, uu, wr, wc, fr, fq); else E(acc, uu, wr, wc, fr, fq, upre);
        }
        if (!has_next) break;
        if (STREAM && nxt.t1 < nt) {
            const int pc = sc.c + NXCD;
            if (wid == 0) {
                unsigned* fl = sc.flags + (size_t)pc * 64; unsigned sp = 0; bool ok = true;
                while (__hip_atomic_load(fl, __ATOMIC_RELAXED, __HIP_MEMORY_SCOPE_AGENT) != sc.epoch) {
                    __builtin_amdgcn_s_sleep(1);
                    if ((++sp & 255u) == 0u) { if (__hip_atomic_load(sc.tmo, __ATOMIC_RELAXED, __HIP_MEMORY_SCOPE_AGENT) != 0u || sp > (1u << 20)) { ok = false; break; } }
                }
                if (!ok && lane == 0) __hip_atomic_store(sc.tmo, 1u, __ATOMIC_RELAXED, __HIP_MEMORY_SCOPE_AGENT);
                __builtin_amdgcn_fence(__ATOMIC_ACQUIRE, "agent");
                asm volatile("s_waitcnt vmcnt(0)" ::: "memory");
            }
            PG8_BAR; asm volatile("" ::: "memory");
            const __amdgpu_buffer_rsrc_t crs = __builtin_amdgcn_make_buffer_rsrc((void*)(sc.part + ((size_t)(sc.epoch & 1u) * gridDim.x + pc) * 65536), (short)0, 262144, 0x00020000);
#pragma unroll
            for (int a = 0; a < 2; ++a)
#pragma unroll
                for (int b = 0; b < 2; ++b)
#pragma unroll
                    for (int m = 0; m < 4; ++m)
#pragma unroll
                        for (int n = 0; n < 2; ++n) acc[a][b][m][n] = __builtin_bit_cast(f32x4, __builtin_amdgcn_raw_buffer_load_b128(crs, (unsigned)tid * 16u, ((((a * 2 + b) * 4 + m) * 2 + n) * 8192), 0));
        } else {
#pragma unroll
            for (int a = 0; a < 2; ++a)
#pragma unroll
                for (int b = 0; b < 2; ++b)
#pragma unroll
                    for (int m = 0; m < 4; ++m)
#pragma unroll
                        for (int n = 0; n < 2; ++n) acc[a][b][m][n] = (f32x4){0.f, 0.f, 0.f, 0.f};
        }
        cur = nxt; cA = nA; cB = nB; ++ui;
        if (wr == 1) PG8_BAR;
    }
    PG8_WAIT_V(0);
    PG8_BAR;
#undef PG8_SA
#undef PG8_SB
#undef PG8_STAGE
#undef PG8_LDA
#undef PG8_LDB
#undef PG8_MMA
#undef PG8_WAIT_V
#undef PG8_WAIT_L
#undef PG8_BAR
#undef PG8_SCHED
}
}

constexpr int LDS_RINV = 131072;
DI UPre rinv_partial_load(const float* SSQ, int rowbase) {
    const int tid = threadIdx.x, r = tid >> 1, hf = tid & 1;
    UPre u;
#pragma unroll
    for (int p = 0; p < 8; ++p) u.v[p] = SSQ[(size_t)(hf * 8 + p) * MT + rowbase + r];
    return u;
}
DI void rinv_table_fill(const UPre& u) {
    extern __shared__ __attribute__((aligned(16))) unsigned char lds_raw_[];
    LAS float* tab = (LAS float*)((LAS unsigned char*)lds_raw_ + LDS_RINV);
    const int tid = threadIdx.x, r = tid >> 1, hf = tid & 1;
    float sv = ((u.v[0] + u.v[1]) + (u.v[2] + u.v[3])) + ((u.v[4] + u.v[5]) + (u.v[6] + u.v[7]));
    sv += dppf<0xB1>(sv);
    if (hf == 0) tab[r] = rsqrtf(sv * (1.0f / DM) + EPS);
    asm volatile("s_waitcnt lgkmcnt(0)" ::: "memory"); __builtin_amdgcn_s_barrier(); asm volatile("" ::: "memory");
}
DI float rinv_table_get(int row) {
    extern __shared__ __attribute__((aligned(16))) unsigned char lds_raw_[];
    return ((const LAS float*)((LAS unsigned char*)lds_raw_ + LDS_RINV))[row & 255];
}
struct FZ0 { typedef float Ctx; typedef float RowPre; typedef pg8::NoPre Pre; typedef pg8::NoPre Pre8; const float* SSQ; bf16_t* Z;
    DI UPre unit_pre(int rowbase) const { return rinv_partial_load(SSQ, rowbase); }
    DI void unit_begin(int, const UPre& sv) const { rinv_table_fill(sv); }
    DI RowPre row_pre(int row) const { return rinv_table_get(row); }
    DI Pre pre(int, int) const { return Pre{}; }
    DI pg8::NoPre pre8(int, int) const { return pg8::NoPre{}; }
    DI Ctx row_begin(int, const RowPre& rp) const { return rp; }
    DI void operator()(Ctx& ri, int row, int col, f32x4 v, const Pre&) const { u32x2 o; o.x = pk2(v.x * ri, v.y * ri); o.y = pk2(v.z * ri, v.w * ri); *(u32x2*)(Z + (size_t)row * NZ0 + col) = o; }
    DI void op8(Ctx& ri, int row, int col, f32x4 a, f32x4 b, const pg8::NoPre&) const { u32x4 o; o.x = pk2(a.x * ri, a.y * ri); o.y = pk2(a.z * ri, a.w * ri); o.z = pk2(b.x * ri, b.y * ri); o.w = pk2(b.z * ri, b.w * ri); *(u32x4*)(Z + (size_t)row * NZ0 + col) = o; }
    DI void row_end(Ctx&, int, int, int, int) const {} };
template <int LDO> struct FRawBf16 { typedef int Ctx; typedef pg8::NoPre RowPre; typedef pg8::NoPre Pre; typedef pg8::NoPre Pre8; bf16_t* O;
    DI UPre unit_pre(int) const { return UPre{}; }
    DI void unit_begin(int, const UPre&) const {}
    DI RowPre row_pre(int) const { return RowPre{}; }
    DI Pre pre(int, int) const { return Pre{}; }
    DI pg8::NoPre pre8(int, int) const { return pg8::NoPre{}; }
    DI Ctx row_begin(int, const RowPre&) const { return 0; }
    DI void operator()(Ctx&, int row, int col, f32x4 v, const Pre&) const { u32x2 o; o.x = pk2(v.x, v.y); o.y = pk2(v.z, v.w); *(u32x2*)(O + (size_t)row * LDO + col) = o; }
    DI void row_end(Ctx&, int, int, int, int) const {} };
struct KvCtx { f32x4 v[4]; int col0; int k; };
struct FKvNorm { typedef KvCtx Ctx; typedef pg8::NoPre RowPre; typedef pg8::NoPre Pre; typedef pg8::NoPre Pre8; bf16_t* O; const float* g;
    DI UPre unit_pre(int) const { return UPre{}; }
    DI void unit_begin(int, const UPre&) const {}
    DI RowPre row_pre(int) const { return RowPre{}; }
    DI Pre pre(int, int) const { return Pre{}; }
    DI pg8::NoPre pre8(int, int) const { return pg8::NoPre{}; }
    DI Ctx row_begin(int, const RowPre&) const { Ctx c; c.k = 0; c.col0 = 0; return c; }
    DI void operator()(Ctx&, int, int, f32x4, const Pre&) const {}
    DI void op8(Ctx& c, int, int col, f32x4 a, f32x4 b, const pg8::NoPre&) const { if (c.k == 0) c.col0 = col; c.v[c.k] = a; c.v[c.k + 1] = b; c.k += 2; }
    DI void row_end(Ctx& c, int row, int pn, int, int) const {
        float ri = 1.0f;
        if (pn < 2) { float ss = 0.f;
#pragma unroll
            for (int k = 0; k < 4; ++k) ss += c.v[k].x * c.v[k].x + c.v[k].y * c.v[k].y + c.v[k].z * c.v[k].z + c.v[k].w * c.v[k].w;
            ss = xsum32(xsum16(ss)); ri = rsqrtf(ss * (1.f / 64.f) + EPS); }
#pragma unroll
        for (int bj = 0; bj < 2; ++bj) { const int col = c.col0 + bj * 32; f32x4 y0 = c.v[2 * bj] * ri, y1 = c.v[2 * bj + 1] * ri;
            if (pn < 2) { y0 = y0 * *(const f32x4*)(g + (col & 63)); y1 = y1 * *(const f32x4*)(g + (col & 63) + 4); }
            u32x4 o; o.x = pk2(y0.x, y0.y); o.y = pk2(y0.z, y0.w); o.z = pk2(y1.x, y1.y); o.w = pk2(y1.z, y1.w); *(u32x4*)(O + (size_t)row * 1024 + col) = o; }
    } };
struct FPool { typedef int Ctx; typedef pg8::NoPre RowPre; typedef f32x4 Pre; typedef pg8::NoPre Pre8; const float* scale; bf16_t* MIX;
    DI pg8::NoPre pre8(int, int) const { return pg8::NoPre{}; }
    DI void op8(Ctx&, int row, int col, f32x4 a, f32x4 b, const pg8::NoPre&) const { const f32x4 s0 = *(const f32x4*)(scale + col), s1 = *(const f32x4*)(scale + col + 4);
        u32x4 o; o.x = pk2(a.x * s0.x, a.y * s0.y); o.y = pk2(a.z * s0.z, a.w * s0.w); o.z = pk2(b.x * s1.x, b.y * s1.y); o.w = pk2(b.z * s1.z, b.w * s1.w); *(u32x4*)(MIX + (size_t)row * DM + col) = o; }
    DI UPre unit_pre(int) const { return UPre{}; }
    DI void unit_begin(int, const UPre&) const {}
    DI RowPre row_pre(int) const { return RowPre{}; }
    DI Pre pre(int, int col) const { return *(const f32x4*)(scale + col); }
    DI Ctx row_begin(int, const RowPre&) const { return 0; }
    DI void operator()(Ctx&, int row, int col, f32x4 v, const Pre& s) const { u32x2 o; o.x = pk2(v.x * s.x, v.y * s.y); o.y = pk2(v.z * s.z, v.w * s.w); *(u32x2*)(MIX + (size_t)row * DM + col) = o; }
    DI void row_end(Ctx&, int, int, int, int) const {} };
template <bool FINAL> struct FResid { typedef float Ctx; typedef pg8::NoPre RowPre; typedef u32x2 Pre; typedef u32x4 Pre8; bf16_t* RB; float* Yf; float* SSQ;
    DI Pre8 pre8(int row, int col) const { return *(const u32x4*)(RB + (size_t)row * DM + col); }
    DI void op8(Ctx& ss, int row, int col, f32x4 a, f32x4 b, const Pre8& r) const {
        f32x4 y0, y1; y0.x = __uint_as_float(r.x << 16) + a.x; y0.y = __uint_as_float(r.x & 0xffff0000u) + a.y; y0.z = __uint_as_float(r.y << 16) + a.z; y0.w = __uint_as_float(r.y & 0xffff0000u) + a.w;
        y1.x = __uint_as_float(r.z << 16) + b.x; y1.y = __uint_as_float(r.z & 0xffff0000u) + b.y; y1.z = __uint_as_float(r.w << 16) + b.z; y1.w = __uint_as_float(r.w & 0xffff0000u) + b.w;
        if (FINAL) { *(f32x4*)(Yf + (size_t)row * DM + col) = y0; *(f32x4*)(Yf + (size_t)row * DM + col + 4) = y1; }
        else { u32x4 o; o.x = pk2(y0.x, y0.y); o.y = pk2(y0.z, y0.w); o.z = pk2(y1.x, y1.y); o.w = pk2(y1.z, y1.w); *(u32x4*)(RB + (size_t)row * DM + col) = o;
            ss += y0.x * y0.x + y0.y * y0.y + y0.z * y0.z + y0.w * y0.w + y1.x * y1.x + y1.y * y1.y + y1.z * y1.z + y1.w * y1.w; } }
    DI UPre unit_pre(int) const { return UPre{}; }
    DI void unit_begin(int, const UPre&) const {}
    DI RowPre row_pre(int) const { return RowPre{}; }
    DI Pre pre(int row, int col) const { return *(const u32x2*)(RB + (size_t)row * DM + col); }
    DI Ctx row_begin(int, const RowPre&) const { return 0.f; }
    DI void operator()(Ctx& ss, int row, int col, f32x4 v, const Pre& r) const {
        f32x4 y; y.x = __uint_as_float(r.x << 16) + v.x; y.y = __uint_as_float(r.x & 0xffff0000u) + v.y; y.z = __uint_as_float(r.y << 16) + v.z; y.w = __uint_as_float(r.y & 0xffff0000u) + v.w;
        if (FINAL) { *(f32x4*)(Yf + (size_t)row * DM + col) = y; }
        else { u32x2 o; o.x = pk2(y.x, y.y); o.y = pk2(y.z, y.w); *(u32x2*)(RB + (size_t)row * DM + col) = o; ss += y.x * y.x + y.y * y.y + y.z * y.z + y.w * y.w; } }
    DI void row_end(Ctx& ss, int row, int pn, int wc, int fq) const { if (!FINAL) { const float s = xsum32(xsum16(ss)); if (fq == 0) SSQ[(size_t)(pn * 4 + wc) * MT + row] = s; } } };
struct FNull { typedef int Ctx; typedef pg8::NoPre RowPre; typedef pg8::NoPre Pre; typedef pg8::NoPre Pre8; float* sink;
    DI UPre unit_pre(int) const { return UPre{}; }
    DI void unit_begin(int, const UPre&) const {}
    DI RowPre row_pre(int) const { return RowPre{}; }
    DI Pre pre(int, int) const { return Pre{}; }
    DI pg8::NoPre pre8(int, int) const { return pg8::NoPre{}; }
    DI Ctx row_begin(int, const RowPre&) const { return 0; }
    DI void operator()(Ctx&, int row, int col, f32x4 v, const Pre&) const { if (v.x == 1.2345e30f) sink[row + col] = v.y; }
    DI void row_end(Ctx&, int, int, int, int) const {} };
struct FUp { typedef float Ctx; typedef float RowPre; typedef pg8::NoPre Pre; typedef pg8::NoPre Pre8; const float* SSQ; bf16_t* H;
    DI UPre unit_pre(int rowbase) const { return rinv_partial_load(SSQ, rowbase); }
    DI void unit_begin(int, const UPre& sv) const { rinv_table_fill(sv); }
    DI RowPre row_pre(int row) const { return rinv_table_get(row); }
    DI Pre pre(int, int) const { return Pre{}; }
    DI pg8::NoPre pre8(int, int) const { return pg8::NoPre{}; }
    DI Ctx row_begin(int, const RowPre& rp) const { return rp; }
    DI void operator()(Ctx& ri, int row, int col, f32x4 v, const Pre&) const { f32x4 t = v * ri; t.x = fmaxf(t.x, 0.f); t.y = fmaxf(t.y, 0.f); t.z = fmaxf(t.z, 0.f); t.w = fmaxf(t.w, 0.f);
        u32x2 o; o.x = pk2(t.x * t.x, t.y * t.y); o.y = pk2(t.z * t.z, t.w * t.w); *(u32x2*)(H + (size_t)row * DFF + col) = o; }
    DI void op8(Ctx& ri, int row, int col, f32x4 a, f32x4 b, const pg8::NoPre&) const { f32x4 t = a * ri, w = b * ri;
        t.x = fmaxf(t.x, 0.f); t.y = fmaxf(t.y, 0.f); t.z = fmaxf(t.z, 0.f); t.w = fmaxf(t.w, 0.f); w.x = fmaxf(w.x, 0.f); w.y = fmaxf(w.y, 0.f); w.z = fmaxf(w.z, 0.f); w.w = fmaxf(w.w, 0.f);
        u32x4 o; o.x = pk2(t.x * t.x, t.y * t.y); o.y = pk2(t.z * t.z, t.w * t.w); o.z = pk2(w.x * w.x, w.y * w.y); o.w = pk2(w.z * w.z, w.w * w.w); *(u32x4*)(H + (size_t)row * DFF + col) = o; }
    DI void row_end(Ctx&, int, int, int, int) const {} };
struct FRnnIn { typedef float Ctx; typedef float RowPre; typedef pg8::NoPre Pre; typedef pg8::NoPre Pre8; const float* SSQ; bf16_t* GATE; bf16_t* U;
    DI UPre unit_pre(int rowbase) const { return rinv_partial_load(SSQ, rowbase); }
    DI void unit_begin(int, const UPre& sv) const { rinv_table_fill(sv); }
    DI RowPre row_pre(int row) const { return rinv_table_get(row); }
    DI Pre pre(int, int) const { return Pre{}; }
    DI pg8::NoPre pre8(int, int) const { return pg8::NoPre{}; }
    DI Ctx row_begin(int, const RowPre& rp) const { return rp; }
    DI void operator()(Ctx& ri, int row, int col, f32x4 v, const Pre&) const { f32x4 t = v * ri; u32x2 o;
        if (col < DM) { o.x = pk2(gelu_tanh(t.x), gelu_tanh(t.y)); o.y = pk2(gelu_tanh(t.z), gelu_tanh(t.w)); *(u32x2*)(GATE + (size_t)row * DM + col) = o; }
        else { o.x = pk2(t.x, t.y); o.y = pk2(t.z, t.w); *(u32x2*)(U + (size_t)row * DM + col - DM) = o; } }
    DI void op8(Ctx& ri, int row, int col, f32x4 a, f32x4 b, const pg8::NoPre&) const { const f32x4 t = a * ri, w = b * ri; u32x4 o;
        if (col < DM) { o.x = pk2(gelu_tanh(t.x), gelu_tanh(t.y)); o.y = pk2(gelu_tanh(t.z), gelu_tanh(t.w)); o.z = pk2(gelu_tanh(w.x), gelu_tanh(w.y)); o.w = pk2(gelu_tanh(w.z), gelu_tanh(w.w)); *(u32x4*)(GATE + (size_t)row * DM + col) = o; }
        else { o.x = pk2(t.x, t.y); o.y = pk2(t.z, t.w); o.z = pk2(w.x, w.y); o.w = pk2(w.z, w.w); *(u32x4*)(U + (size_t)row * DM + col - DM) = o; } }
    DI void row_end(Ctx&, int, int, int, int) const {} };

typedef float f32x2_t __attribute__((ext_vector_type(2))); typedef __bf16 bf16x2_t __attribute__((ext_vector_type(2)));
DI unsigned cvtpk(float lo, float hi) { f32x2_t v = {lo, hi}; bf16x2_t b = __builtin_convertvector(v, bf16x2_t); return __builtin_bit_cast(unsigned, b); }
struct EpiPartStore { float* PARTS; int part;
    DI void operator()(const f32x4 (&acc)[2][2][4][2], const pg8::Unit& u, int, int, int, int) const {
        const int us = (u.pm - MP / 256) * 4 + u.pn;
        f32x4* p = (f32x4*)(PARTS + (size_t)(us * 16 + part) * 65536) + threadIdx.x;
#pragma unroll
        for (int a = 0; a < 2; ++a)
#pragma unroll
            for (int b = 0; b < 2; ++b)
#pragma unroll
                for (int m = 0; m < 4; ++m)
#pragma unroll
                    for (int n = 0; n < 2; ++n) p[(((a * 2 + b) * 4 + m) * 2 + n) * 512] = acc[a][b][m][n];
    }
};
template <bool FINAL, int WAYS = 16> DI void sample_fixup(int b, const float* __restrict__ PARTS, bf16_t* __restrict__ RB, float* __restrict__ Yf, float* __restrict__ SSQ) {
    if (b >= 128) return;
    const int tid = threadIdx.x, wid = tid >> 6, lane = tid & 63, wr = wid >> 2, wc = wid & 3, fr = lane & 15, fq = lane >> 4;
    const int us = b >> 3, ai = (b >> 2) & 1, m = b & 3, pm = MP / 256 + (us >> 2), pn = us & 3;
    f32x4 v[2][2];
#pragma unroll
    for (int bj = 0; bj < 2; ++bj)
#pragma unroll
        for (int n = 0; n < 2; ++n) v[bj][n] = (f32x4){0.f, 0.f, 0.f, 0.f};
#pragma unroll 4
    for (int p = 0; p < WAYS; ++p) {
        const f32x4* pp = (const f32x4*)(PARTS + (size_t)(us * 16 + p) * 65536) + tid;
#pragma unroll
        for (int bj = 0; bj < 2; ++bj)
#pragma unroll
            for (int n = 0; n < 2; ++n) v[bj][n] += pp[(((ai * 2 + bj) * 4 + m) * 2 + n) * 512];
    }
    const int row = pm * 256 + ai * 128 + wr * 64 + m * 16 + fr, col0 = pn * 256 + wc * 32 + 8 * fq;
    float ss = 0.f;
#pragma unroll
    for (int bj = 0; bj < 2; ++bj)
#pragma unroll
        for (int n = 0; n < 2; ++n) { const size_t off = (size_t)row * DM + col0 + bj * 128 + n * 4; const u32x2 r = *(const u32x2*)(RB + off); const f32x4 a = v[bj][n];
            f32x4 y; y.x = __uint_as_float(r.x << 16) + a.x; y.y = __uint_as_float(r.x & 0xffff0000u) + a.y; y.z = __uint_as_float(r.y << 16) + a.z; y.w = __uint_as_float(r.y & 0xffff0000u) + a.w;
            if (FINAL) *(f32x4*)(Yf + off) = y;
            else { u32x2 o; o.x = pk2(y.x, y.y); o.y = pk2(y.z, y.w); *(u32x2*)(RB + off) = o; ss += y.x * y.x + y.y * y.y + y.z * y.z + y.w * y.w; } }
    if (!FINAL) { ss = xsum32(xsum16(ss)); if (fq == 0) SSQ[(size_t)(pn * 4 + wc) * MT + row] = ss; }
}
template <int SH> DI float dpp_row_shr(float oldv, float v) { return __int_as_float(__builtin_amdgcn_update_dpp(__float_as_int(oldv), __float_as_int(v), 0x110 + SH, 0xF, 0xF, false)); }
template <int SH> DI void scan_step(float& a, float& b, int fseg) {
    float ap = dpp_row_shr<SH>(1.0f, a), bp = dpp_row_shr<SH>(0.0f, b);
    if (fseg < SH) { ap = 1.0f; bp = 0.0f; }
    b = a * bp + b; a = a * ap;
}
struct EpiGates {
    static constexpr bool PERM64 = false, PERM8 = true;
    const bf16_t* V; const float* bga; const float* bgx; const float* lam; bf16_t* HL; bf16_t* AC; float* SUM;
    DI UPre unit_pre(int) const { return UPre{}; }
    DI void operator()(f32x4 (&acc)[2][2][4][2], const pg8::Unit& u, int wr, int wc, int fr, int fq, const UPre&) const {
        const bool isp = u.pm < MP / 256;
        const int chb = u.pn * 128 + wc * 32 + 8 * fq;
        const int rowb = u.pm * 256 + wr * 64 + fr;
        u32x4 vpre[2][4];
#pragma unroll
        for (int ai = 0; ai < 2; ++ai)
#pragma unroll
            for (int m = 0; m < 4; ++m) vpre[ai][m] = *(const u32x4*)(V + (size_t)(rowb + ai * 128 + m * 16) * DM + chb);
#pragma unroll
        for (int n = 0; n < 2; ++n) {
            const f32x4 sp = *(const f32x4*)(lam + chb + 4 * n), ba = *(const f32x4*)(bga + chb + 4 * n), bx = *(const f32x4*)(bgx + chb + 4 * n);
#pragma unroll
            for (int ai = 0; ai < 2; ++ai)
#pragma unroll
                for (int m = 0; m < 4; ++m) {
                    const int row = rowb + ai * 128 + m * 16;
                    const bool pos0 = isp && ((row & (SEQ - 1)) == 0);
                    const unsigned w0 = n == 0 ? vpre[ai][m].x : vpre[ai][m].z, w1 = n == 0 ? vpre[ai][m].y : vpre[ai][m].w;
                    const float v4[4] = {__uint_as_float(w0 << 16), __uint_as_float(w0 & 0xffff0000u), __uint_as_float(w1 << 16), __uint_as_float(w1 & 0xffff0000u)};
#pragma unroll
                    for (int e = 0; e < 4; ++e) {
                        const float r = __builtin_amdgcn_rcpf(1.0f + __builtin_amdgcn_exp2f(-1.4426950408889634f * (acc[ai][0][m][n][e] + ba[e])));
                        const float ig = __builtin_amdgcn_rcpf(1.0f + __builtin_amdgcn_exp2f(-1.4426950408889634f * (acc[ai][1][m][n][e] + bx[e])));
                        const float a = __builtin_amdgcn_exp2f(-r * sp[e]);
                        const float mult = pos0 ? 1.0f : __builtin_amdgcn_sqrtf(fmaxf(1.0f - a * a, 0.0f));
                        acc[ai][0][m][n][e] = a; acc[ai][1][m][n][e] = mult * ig * v4[e];
                    }
                }
        }
        const int fseg = isp ? fr : (fr & 7);
#pragma unroll
        for (int ai = 0; ai < 2; ++ai)
#pragma unroll
            for (int n = 0; n < 2; ++n)
#pragma unroll
                for (int e = 0; e < 4; ++e) {
                    float Ac = 1.0f, Hc = 0.0f;
#pragma unroll
                    for (int m = 0; m < 4; ++m) {
                        float a = acc[ai][0][m][n][e], b = acc[ai][1][m][n][e];
                        scan_step<1>(a, b, fseg); scan_step<2>(a, b, fseg); scan_step<4>(a, b, fseg);
                        if (isp) { scan_step<8>(a, b, fseg); b = a * Hc + b; a = a * Ac; Ac = __int_as_float(__builtin_amdgcn_update_dpp(0, __float_as_int(a), 0x15F, 0xF, 0xF, false)); Hc = __int_as_float(__builtin_amdgcn_update_dpp(0, __float_as_int(b), 0x15F, 0xF, 0xF, false)); }
                        acc[ai][0][m][n][e] = a; acc[ai][1][m][n][e] = b;
                    }
                    if (isp && fr == 15) { float* sm = SUM + ((size_t)(u.pm * 4 + ai * 2 + wr) * DM + chb + 4 * n + e) * 2; sm[0] = Ac; sm[1] = Hc; }
                }
#pragma unroll
        for (int ai = 0; ai < 2; ++ai)
#pragma unroll
            for (int m = 0; m < 4; ++m) {
                const size_t off = (size_t)(rowb + ai * 128 + m * 16) * DM + chb;
                u32x4 oa; oa.x = pk2(acc[ai][0][m][0][0], acc[ai][0][m][0][1]); oa.y = pk2(acc[ai][0][m][0][2], acc[ai][0][m][0][3]); oa.z = pk2(acc[ai][0][m][1][0], acc[ai][0][m][1][1]); oa.w = pk2(acc[ai][0][m][1][2], acc[ai][0][m][1][3]);
                *(u32x4*)(AC + off) = oa;
                u32x4 ob; ob.x = pk2(acc[ai][1][m][0][0], acc[ai][1][m][0][1]); ob.y = pk2(acc[ai][1][m][0][2], acc[ai][1][m][0][3]); ob.z = pk2(acc[ai][1][m][1][0], acc[ai][1][m][1][1]); ob.w = pk2(acc[ai][1][m][1][2], acc[ai][1][m][1][3]);
                *(u32x4*)(HL + off) = ob;
            }
    }
};

DI void gates_sample_item(int item, int w, int lane, const bf16_t* __restrict__ V, const bf16_t* __restrict__ WGATET, const float* __restrict__ bga, const float* __restrict__ bgx, const float* __restrict__ SP8,
                          const bf16_t* __restrict__ GATE, const float* __restrict__ state_lru, bf16_t* __restrict__ YB, float* __restrict__ out) {
    const int p = item >> 3, n = item & 7, l15 = lane & 15, quad = lane >> 4;
    const int row0 = MP + p * 16, jch = 16 * w + l15, ch = 128 * n + jch;
    const bf16_t* ap = V + (size_t)(row0 + l15) * DM + 128 * n + 8 * quad;
    const bf16_t* bpa = WGATET + (size_t)(n * 256 + jch) * 256 + (n & 1) * 128 + 8 * quad;
    const bf16_t* bpx = bpa + (size_t)128 * 256;
    f32x4 ca = {0.f, 0.f, 0.f, 0.f}, cx = {0.f, 0.f, 0.f, 0.f};
#pragma unroll
    for (int st = 0; st < 4; ++st) {
        const bf16x8 a = *(const bf16x8*)(ap + 32 * st), wa = *(const bf16x8*)(bpa + 32 * st), wx = *(const bf16x8*)(bpx + 32 * st);
        ca = __builtin_amdgcn_mfma_f32_16x16x32_bf16(a, wa, ca, 0, 0, 0);
        cx = __builtin_amdgcn_mfma_f32_16x16x32_bf16(a, wx, cx, 0, 0, 0);
    }
    const float ba = bga[ch], bx_ = bgx[ch], sp = SP8[ch];
    const int seq = 2 * p + (quad >> 1), rbase = row0 + 4 * quad;
    float Aq[4], Hq[4], gt[4];
    float Ac = 1.f, Hc = 0.f;
#pragma unroll
    for (int j = 0; j < 4; ++j) {
        const float v = bf2f(V[(size_t)(rbase + j) * DM + ch]); gt[j] = bf2f(GATE[(size_t)(rbase + j) * DM + ch]);
        const float r = __builtin_amdgcn_rcpf(1.0f + __builtin_amdgcn_exp2f(-1.4426950408889634f * (ca[j] + ba)));
        const float ig = __builtin_amdgcn_rcpf(1.0f + __builtin_amdgcn_exp2f(-1.4426950408889634f * (cx[j] + bx_)));
        const float a = __builtin_amdgcn_exp2f(-r * sp);
        const float b = __builtin_amdgcn_sqrtf(fmaxf(1.0f - a * a, 0.0f)) * ig * v;
        Hc = a * Hc + b; Ac = a * Ac; Aq[j] = Ac; Hq[j] = Hc;
    }
    const float h0 = state_lru[(size_t)seq * DM + ch];
    const float pA = __int_as_float(__builtin_amdgcn_ds_bpermute((lane - 16) * 4, __float_as_int(Ac)));
    const float pH = __int_as_float(__builtin_amdgcn_ds_bpermute((lane - 16) * 4, __float_as_int(Hc)));
    const float hin = (quad & 1) ? (pA * h0 + pH) : h0;
#pragma unroll
    for (int j = 0; j < 4; ++j) {
        const float h = Aq[j] * hin + Hq[j];
        YB[(size_t)(rbase + j) * DM + ch] = f2bf(gt[j] * h);
        if ((quad & 1) && j == 3) out[O_LRU_S + (size_t)seq * DM + ch] = h;
    }
}
#define XB_TMO      128
#define XB_XCNT(j)  (256  + 64 * (j))
#define XB_XSUB(j)  (1280 + 64 * (j))
#define XB_XGEN(j)  (2304 + 64 * (j))
#define XB_TOP      3328
#define XB_TOPGEN   3392
#define XCD_BAR_WORDS 3456
#define XB_SPIN_CAP (1u << 18)
DI unsigned xb_ld(unsigned* p)              { return __hip_atomic_load(p, __ATOMIC_RELAXED, __HIP_MEMORY_SCOPE_AGENT); }
DI unsigned xb_add(unsigned* p, unsigned v) { return __hip_atomic_fetch_add(p, v, __ATOMIC_RELAXED, __HIP_MEMORY_SCOPE_AGENT); }
DI unsigned xb_xcc_id() { return (unsigned)__builtin_amdgcn_s_getreg((3 << 11) | 20) & 0xFu; }
#define XB_SPIN(cond, bar) do { unsigned _sp = 0; while (cond) { __builtin_amdgcn_s_sleep(1); \
    if ((++_sp & 255u) == 0u) { if (xb_ld(&(bar)[XB_TMO])) break; if (_sp > XB_SPIN_CAP) { atomicAdd(&(bar)[XB_TMO], 1u); break; } } } } while (0)
struct XcdBarrier { unsigned* bar; unsigned x; volatile LAS unsigned* st; };
DI XcdBarrier xcd_barrier_post(unsigned* bar, volatile LAS unsigned* st) {
    XcdBarrier b; b.bar = bar; b.x = xb_xcc_id(); b.st = st;
    if (threadIdx.x == 0) (void)xb_add(&bar[XB_XCNT(b.x)], 1u);
    return b;
}
DI void xcd_barrier_complete(unsigned* bar, unsigned x, unsigned& nloc, unsigned& nx) {
    const unsigned G = gridDim.x * gridDim.y * gridDim.z;
    unsigned sum, cnt, mine, sp = 0u;
    for (;;) {
        sum = 0u; cnt = 0u; mine = 0u;
#pragma unroll
        for (unsigned j = 0; j < 16; ++j) { const unsigned c = xb_ld(&bar[XB_XCNT(j)]); sum += c; cnt += (c > 0u) ? 1u : 0u; mine = (j == x) ? c : mine; }
        if (sum == G) break;
        __builtin_amdgcn_s_sleep(1);
        if ((++sp & 255u) == 0u) { if (xb_ld(&bar[XB_TMO])) break; if (sp > XB_SPIN_CAP) { atomicAdd(&bar[XB_TMO], 1u); break; } }
    }
    nloc = mine > 0u ? mine : 1u; nx = cnt > 0u ? cnt : 1u;
}
DI void xcd_barrier(const XcdBarrier& b) {
    asm volatile("s_waitcnt vmcnt(0)" ::: "memory");
    __syncthreads();
    if (threadIdx.x == 0) {
        unsigned* bar = b.bar;
        __builtin_amdgcn_s_waitcnt(0);
        unsigned nloc = b.st[0], nx = b.st[1];
        if (nloc == 0u) { xcd_barrier_complete(bar, b.x, nloc, nx); b.st[0] = nloc; b.st[1] = nx; }
        const unsigned old = xb_add(&bar[XB_XSUB(b.x)], 1u);
        const unsigned gen = old / nloc;
        if (old + 1u == (gen + 1u) * nloc) {
            __builtin_amdgcn_fence(__ATOMIC_RELEASE, "agent");
            asm volatile("s_waitcnt vmcnt(0)" ::: "memory");
            const unsigned og = xb_add(&bar[XB_TOP], 1u);
            const unsigned tg = og / nx;
            if (og + 1u == (tg + 1u) * nx) xb_add(&bar[XB_TOPGEN], 1u);
            else XB_SPIN(xb_ld(&bar[XB_TOPGEN]) == tg, bar);
            __builtin_amdgcn_fence(__ATOMIC_ACQUIRE, "agent");
            xb_add(&bar[XB_XGEN(b.x)], 1u);
            asm volatile("s_waitcnt vmcnt(0)" ::: "memory");
        } else {
            XB_SPIN(xb_ld(&bar[XB_XGEN(b.x)]) == gen, bar);
            __builtin_amdgcn_fence(__ATOMIC_ACQUIRE, "agent");
            asm volatile("s_waitcnt vmcnt(0)" ::: "memory");
        }
    }
    __syncthreads();
}

struct Args { const void* in[32]; float* out; unsigned char* ws; int ph_lo, ph_hi; };
static_assert(sizeof(Args) == 32 * 8 + 8 + 8 + 8, "Args has no padding");

DI void p0_transpose_item(const float* __restrict__ W, int lds_, int N, bf16_t* __restrict__ WT, int ldd, const float* __restrict__ gain, LAS float* scr, int item, int lane) {
    const int nblk = N / 32, kb = item / nblk, nb = item % nblk, k0 = 64 * kb, n0 = 32 * nb;
#pragma unroll 8
    for (int i = 0; i < 32; ++i) { const int kk = 2 * i + (lane >> 5); const float gsc = gain ? gain[k0 + kk] : 1.f; scr[kk * 33 + (lane & 31)] = W[(size_t)(k0 + kk) * lds_ + n0 + (lane & 31)] * gsc; }
    asm volatile("s_waitcnt lgkmcnt(0)" ::: "memory");
    const int c = lane & 7;
#pragma unroll
    for (int j = 0; j < 4; ++j) { const int n = (lane >> 3) + 8 * j; const LAS float* s = scr + (8 * c) * 33 + n;
        u32x4 o; o.x = pk2(s[0 * 33], s[1 * 33]); o.y = pk2(s[2 * 33], s[3 * 33]); o.z = pk2(s[4 * 33], s[5 * 33]); o.w = pk2(s[6 * 33], s[7 * 33]);
        *(u32x4*)(WT + (size_t)(n0 + n) * ldd + k0 + 8 * c) = o; }
    asm volatile("s_waitcnt lgkmcnt(0)" ::: "memory");
}
DI void rowprep_load(const float* __restrict__ src, int lane, f32x4 (&v)[4]) {
#pragma unroll
    for (int j = 0; j < 4; ++j) v[j] = ((const f32x4*)src)[lane + 64 * j];
}
DI void rowprep_row(const f32x4 (&v)[4], int row, bf16_t* __restrict__ XB, float* __restrict__ SSQ, int lane) {
    float ss = 0.f;
#pragma unroll
    for (int j = 0; j < 4; ++j) ss += v[j].x * v[j].x + v[j].y * v[j].y + v[j].z * v[j].z + v[j].w * v[j].w;
    ss = wave_sum(ss);
#pragma unroll
    for (int j = 0; j < 4; ++j) { u32x2 o; o.x = pk2(v[j].x, v[j].y); o.y = pk2(v[j].z, v[j].w); ((u32x2*)(XB + (size_t)row * DM))[lane + 64 * j] = o; }
    if (lane < 16) SSQ[(size_t)lane * MT + row] = lane == 0 ? ss : 0.f;
}

DI void unpack4(u32x2 r, float (&x)[4]) { x[0] = __uint_as_float(r.x << 16); x[1] = __uint_as_float(r.x & 0xffff0000u); x[2] = __uint_as_float(r.y << 16); x[3] = __uint_as_float(r.y & 0xffff0000u); }
DI void post0_row(int row, int lane, const bf16_t* __restrict__ Z0, const float* __restrict__ ROPET, const float* __restrict__ g_q_nope, const float* __restrict__ g_q_rope,
                  const float* __restrict__ g_ckv, const float* __restrict__ g_k_rope, bf16_t* __restrict__ QB, bf16_t* __restrict__ CB, bf16_t* __restrict__ KRB, float* __restrict__ out) {
    const bf16_t* z = Z0 + (size_t)row * NZ0;
    const bool isp = row < MP; const int pidx = isp ? (row & (SEQ - 1)) : SEQ + ((row - MP) & 7);
    { const int d = 4 * (lane & 15); const f32x4 g4 = *(const f32x4*)(g_q_nope + d);
#pragma unroll
      for (int hh = 0; hh < 2; ++hh) {
        const int h = 4 * hh + (lane >> 4); float x[4]; unpack4(*(const u32x2*)(z + POOLD + QKH * h + d), x);
        float ss = x[0] * x[0] + x[1] * x[1] + x[2] * x[2] + x[3] * x[3];
        ss = sum16(ss);
        const float ri = rsqrtf(ss * (1.f / 64.f) + EPS) * QSCALE;
        u32x2 o; o.x = pk2(x[0] * ri * g4.x, x[1] * ri * g4.y); o.y = pk2(x[2] * ri * g4.z, x[3] * ri * g4.w);
        *(u32x2*)(QB + (size_t)row * QDIM + QKH * h + d) = o; } }
    { const int r = 4 * (lane & 7), i0 = r & 15; const bool second = (lane & 4) != 0;
      const f32x4 t0 = *(const f32x4*)(ROPET + ((size_t)pidx * 16 + i0) * 2), t1 = *(const f32x4*)(ROPET + ((size_t)pidx * 16 + i0) * 2 + 4);
      const float cs[4] = {t0.x, t0.z, t1.x, t1.z}, sn[4] = {t0.y, t0.w, t1.y, t1.w};
      { const int h = lane >> 3; float x[4]; unpack4(*(const u32x2*)(z + POOLD + QKH * h + 64 + r), x);
        float ss = x[0] * x[0] + x[1] * x[1] + x[2] * x[2] + x[3] * x[3];
        ss = sum8(ss);
        const float ri = rsqrtf(ss * (1.f / 32.f) + EPS); const f32x4 g4 = *(const f32x4*)(g_q_rope + r);
        float y[4] = {x[0] * ri * g4.x, x[1] * ri * g4.y, x[2] * ri * g4.z, x[3] * ri * g4.w}, o[4];
#pragma unroll
        for (int e = 0; e < 4; ++e) { const float p = xchg4(y[e], second); o[e] = (second ? (p * sn[e] + y[e] * cs[e]) : (y[e] * cs[e] - p * sn[e])) * QSCALE; }
        u32x2 w; w.x = pk2(o[0], o[1]); w.y = pk2(o[2], o[3]); *(u32x2*)(QB + (size_t)row * QDIM + QKH * h + 64 + r) = w; }
      { float x[4]; unpack4(*(const u32x2*)(z + POOLD + QDIM + KVR + r), x);
        float ss = x[0] * x[0] + x[1] * x[1] + x[2] * x[2] + x[3] * x[3];
        ss = sum8(ss);
        const float ri = rsqrtf(ss * (1.f / 32.f) + EPS); const f32x4 g4 = *(const f32x4*)(g_k_rope + r);
        float y[4] = {x[0] * ri * g4.x, x[1] * ri * g4.y, x[2] * ri * g4.z, x[3] * ri * g4.w}; f32x4 o;
#pragma unroll
        for (int e = 0; e < 4; ++e) { const float p = xchg4(y[e], second); o[e] = second ? (p * sn[e] + y[e] * cs[e]) : (y[e] * cs[e] - p * sn[e]); }
        if (lane < 8) { u32x2 w; w.x = pk2(o[0], o[1]); w.y = pk2(o[2], o[3]); *(u32x2*)(KRB + (size_t)row * ROPE + r) = w;
            float* ko = isp ? out + O_KR_P + (size_t)row * ROPE : out + O_KR_S + (size_t)(row - MP) * ROPE; *(f32x4*)(ko + r) = o; } } }
    { float x[4]; unpack4(*(const u32x2*)(z + POOLD + QDIM + lane * 4), x);
      float ss = wave_sum(x[0] * x[0] + x[1] * x[1] + x[2] * x[2] + x[3] * x[3]); const float ri = rsqrtf(ss * (1.f / 256.f) + EPS);
      const f32x4 g4 = *(const f32x4*)(g_ckv + lane * 4);
      f32x4 y; y.x = x[0] * ri * g4.x; y.y = x[1] * ri * g4.y; y.z = x[2] * ri * g4.z; y.w = x[3] * ri * g4.w;
      u32x2 o; o.x = pk2(y.x, y.y); o.y = pk2(y.z, y.w); *(u32x2*)(CB + (size_t)row * KVR + lane * 4) = o;
      float* co = isp ? out + O_CKV_P + (size_t)row * KVR : out + O_CKV_S + (size_t)(row - MP) * KVR; *(f32x4*)(co + lane * 4) = y; }
}
DI void load8(const bf16_t* p, float (&x)[8]) { const u32x4 r = *(const u32x4*)p;
#pragma unroll
    for (int e = 0; e < 4; ++e) { x[2 * e] = __uint_as_float(r[e] << 16); x[2 * e + 1] = __uint_as_float(r[e] & 0xffff0000u); } }
template <bool ISP> DI void pool_item(int row0, int nrows, int ch, const bf16_t* __restrict__ Z0, const float* __restrict__ state_pool, bf16_t* __restrict__ DBuf, float* __restrict__ out) {
    const int w = 2 << (ch >> 7);
    const int t0 = ISP ? (row0 & (SEQ - 1)) : 0, bb = ISP ? (row0 >> 12) : ((row0 - MP) >> 3);
    float S[8];
#pragma unroll
    for (int e = 0; e < 8; ++e) S[e] = 0.f;
    for (int j = 1; j < w; ++j) { const int tj = t0 - j; float x[8];
        if (tj >= 0) { load8(Z0 + (size_t)(row0 - j) * NZ0 + ch, x); }
        else if (!ISP) { const float* hp = state_pool + ((size_t)bb * 15 + (15 + tj)) * POOLD + ch; const f32x4 a = *(const f32x4*)hp, b = *(const f32x4*)(hp + 4); x[0] = a.x; x[1] = a.y; x[2] = a.z; x[3] = a.w; x[4] = b.x; x[5] = b.y; x[6] = b.z; x[7] = b.w; }
        else {
#pragma unroll
            for (int e = 0; e < 8; ++e) x[e] = 0.f; }
#pragma unroll
        for (int e = 0; e < 8; ++e) S[e] += x[e]; }
    for (int i = 0; i < nrows; ++i) {
        const int t = t0 + i, row = row0 + i; float u[8]; load8(Z0 + (size_t)row * NZ0 + ch, u);
        const float icnt = 1.0f / (ISP ? (float)((t + 1) < w ? (t + 1) : w) : (float)w);
        u32x4 o;
#pragma unroll
        for (int e = 0; e < 8; ++e) S[e] += u[e];
#pragma unroll
        for (int e = 0; e < 4; ++e) o[e] = pk2(S[2 * e] * icnt - u[2 * e], S[2 * e + 1] * icnt - u[2 * e + 1]);
        *(u32x4*)(DBuf + (size_t)row * POOLD + ch) = o;
        { const int tj = t - w + 1; float x[8];
          if (tj >= 0) { load8(Z0 + (size_t)(row - w + 1) * NZ0 + ch, x); }
          else if (!ISP) { const float* hp = state_pool + ((size_t)bb * 15 + (15 + tj)) * POOLD + ch; const f32x4 a = *(const f32x4*)hp, b = *(const f32x4*)(hp + 4); x[0] = a.x; x[1] = a.y; x[2] = a.z; x[3] = a.w; x[4] = b.x; x[5] = b.y; x[6] = b.z; x[7] = b.w; }
          else {
#pragma unroll
              for (int e = 0; e < 8; ++e) x[e] = 0.f; }
#pragma unroll
          for (int e = 0; e < 8; ++e) S[e] -= x[e]; }
        if (ISP) { if (t >= SEQ - 15) { float* op = out + O_POOL_P + ((size_t)bb * 15 + (t - (SEQ - 15))) * POOLD + ch; *(f32x4*)op = (f32x4){u[0], u[1], u[2], u[3]}; *(f32x4*)(op + 4) = (f32x4){u[4], u[5], u[6], u[7]}; } }
        else { float* op = out + O_POOL_S + ((size_t)bb * 15 + 7 + t) * POOLD + ch; *(f32x4*)op = (f32x4){u[0], u[1], u[2], u[3]}; *(f32x4*)(op + 4) = (f32x4){u[4], u[5], u[6], u[7]}; }
    }
    if (!ISP) { for (int i = 0; i < 7; ++i) { const float* hp = state_pool + ((size_t)bb * 15 + 8 + i) * POOLD + ch; float* op = out + O_POOL_S + ((size_t)bb * 15 + i) * POOLD + ch; *(f32x4*)op = *(const f32x4*)hp; *(f32x4*)(op + 4) = *(const f32x4*)(hp + 4); } }
}
DI void pool_item_p16(int row0, int ch, const bf16_t* __restrict__ Z0, bf16_t* __restrict__ DBuf, float* __restrict__ out) {
    const int w = 2 << (ch >> 7);
    const int t0 = row0 & (SEQ - 1), bb = row0 >> 12;
    const bf16_t* zb = Z0 + (size_t)row0 * NZ0 + ch;
    float S[8];
#pragma unroll
    for (int e = 0; e < 8; ++e) S[e] = 0.f;
#pragma unroll
    for (int j = 1; j < 16; ++j) { const bool ok = (j < w) && (t0 - j >= 0); float x[8]; load8(zb - (ok ? j : 0) * NZ0, x); const float mk = ok ? 1.f : 0.f;
#pragma unroll
        for (int e = 0; e < 8; ++e) S[e] += mk * x[e]; }
#pragma unroll
    for (int i = 0; i < 16; ++i) {
        const int t = t0 + i; float u[8], x[8]; load8(zb + i * NZ0, u);
        const bool ok = t - w + 1 >= 0; load8(zb + (i - (ok ? w - 1 : 0)) * NZ0, x); const float mk = ok ? 1.f : 0.f;
        const float icnt = 1.0f / (float)((t + 1) < w ? (t + 1) : w);
        u32x4 o;
#pragma unroll
        for (int e = 0; e < 8; ++e) S[e] += u[e];
#pragma unroll
        for (int e = 0; e < 4; ++e) o[e] = pk2(S[2 * e] * icnt - u[2 * e], S[2 * e + 1] * icnt - u[2 * e + 1]);
        *(u32x4*)(DBuf + (size_t)(row0 + i) * POOLD + ch) = o;
#pragma unroll
        for (int e = 0; e < 8; ++e) S[e] -= mk * x[e];
    }
    if (t0 == SEQ - 16) {
        for (int i = 1; i < 16; ++i) { float u[8]; load8(zb + i * NZ0, u);
            float* op = out + O_POOL_P + ((size_t)bb * 15 + (i - 1)) * POOLD + ch; *(f32x4*)op = (f32x4){u[0], u[1], u[2], u[3]}; *(f32x4*)(op + 4) = (f32x4){u[4], u[5], u[6], u[7]}; } }
}
template <bool ISP> DI void conv_item(int row0, int nrows, int ch, const bf16_t* __restrict__ U, const float* __restrict__ state_conv, const float* __restrict__ conv_w, const float* __restrict__ conv_b,
                                      bf16_t* __restrict__ V, float* __restrict__ out) {
    const int t0 = ISP ? (row0 & (SEQ - 1)) : 0, bb = ISP ? (row0 >> 12) : ((row0 - MP) >> 3);
    float wk[4][8], bs[8], hist[3][8];
#pragma unroll
    for (int k = 0; k < 4; ++k) { const f32x4 a = *(const f32x4*)(conv_w + k * DM + ch), b = *(const f32x4*)(conv_w + k * DM + ch + 4); wk[k][0] = a.x; wk[k][1] = a.y; wk[k][2] = a.z; wk[k][3] = a.w; wk[k][4] = b.x; wk[k][5] = b.y; wk[k][6] = b.z; wk[k][7] = b.w; }
    { const f32x4 a = *(const f32x4*)(conv_b + ch), b = *(const f32x4*)(conv_b + ch + 4); bs[0] = a.x; bs[1] = a.y; bs[2] = a.z; bs[3] = a.w; bs[4] = b.x; bs[5] = b.y; bs[6] = b.z; bs[7] = b.w; }
#pragma unroll
    for (int j = 0; j < 3; ++j) {
        const int tj = t0 - 3 + j;
        if (tj >= 0) load8(U + (size_t)(row0 - 3 + j) * DM + ch, hist[j]);
        else if (!ISP) { const float* hp = state_conv + ((size_t)bb * 3 + (3 + tj)) * DM + ch; const f32x4 a = *(const f32x4*)hp, b = *(const f32x4*)(hp + 4); hist[j][0] = a.x; hist[j][1] = a.y; hist[j][2] = a.z; hist[j][3] = a.w; hist[j][4] = b.x; hist[j][5] = b.y; hist[j][6] = b.z; hist[j][7] = b.w; }
        else {
#pragma unroll
            for (int e = 0; e < 8; ++e) hist[j][e] = 0.f; }
    }
    for (int i = 0; i < nrows; ++i) {
        const int t = t0 + i, row = row0 + i; float u[8]; load8(U + (size_t)row * DM + ch, u);
        u32x4 o; float v[8];
#pragma unroll
        for (int e = 0; e < 8; ++e) v[e] = bs[e] + hist[0][e] * wk[0][e] + hist[1][e] * wk[1][e] + hist[2][e] * wk[2][e] + u[e] * wk[3][e];
#pragma unroll
        for (int e = 0; e < 4; ++e) o[e] = pk2(v[2 * e], v[2 * e + 1]);
        *(u32x4*)(V + (size_t)row * DM + ch) = o;
#pragma unroll
        for (int e = 0; e < 8; ++e) { hist[0][e] = hist[1][e]; hist[1][e] = hist[2][e]; hist[2][e] = u[e]; }
        const int tl = ISP ? SEQ - 3 : DT - 3;
        if (t >= tl) { float* op = out + (ISP ? O_CONV_P : O_CONV_S) + ((size_t)bb * 3 + (t - tl)) * DM + ch; *(f32x4*)op = (f32x4){u[0], u[1], u[2], u[3]}; *(f32x4*)(op + 4) = (f32x4){u[4], u[5], u[6], u[7]}; }
    }
}

DI void conv_item_p16(int row0, int ch, const bf16_t* __restrict__ U, const float* __restrict__ conv_w, const float* __restrict__ conv_b, bf16_t* __restrict__ V, float* __restrict__ out) {
    const int t0 = row0 & (SEQ - 1), bb = row0 >> 12;
    const bf16_t* ub = U + (size_t)row0 * DM + ch;
    u32x4 raw[19];
#pragma unroll
    for (int j = 0; j < 19; ++j) raw[j] = *(const u32x4*)(ub + (j - 3 >= 0 || t0 > 0 ? (j - 3) : 0) * DM);
    float wk[4][8], bs[8];
#pragma unroll
    for (int k = 0; k < 4; ++k) { const f32x4 a = *(const f32x4*)(conv_w + k * DM + ch), b = *(const f32x4*)(conv_w + k * DM + ch + 4); wk[k][0] = a.x; wk[k][1] = a.y; wk[k][2] = a.z; wk[k][3] = a.w; wk[k][4] = b.x; wk[k][5] = b.y; wk[k][6] = b.z; wk[k][7] = b.w; }
    { const f32x4 a = *(const f32x4*)(conv_b + ch), b = *(const f32x4*)(conv_b + ch + 4); bs[0] = a.x; bs[1] = a.y; bs[2] = a.z; bs[3] = a.w; bs[4] = b.x; bs[5] = b.y; bs[6] = b.z; bs[7] = b.w; }
    const float hm = t0 > 0 ? 1.f : 0.f;
    float x[4][8];
#pragma unroll
    for (int j = 0; j < 3; ++j)
#pragma unroll
        for (int e = 0; e < 4; ++e) { x[j][2 * e] = hm * __uint_as_float(raw[j][e] << 16); x[j][2 * e + 1] = hm * __uint_as_float(raw[j][e] & 0xffff0000u); }
#pragma unroll
    for (int i = 0; i < 16; ++i) {
#pragma unroll
        for (int e = 0; e < 4; ++e) { x[3][2 * e] = __uint_as_float(raw[3 + i][e] << 16); x[3][2 * e + 1] = __uint_as_float(raw[3 + i][e] & 0xffff0000u); }
        u32x4 o; float v[8];
#pragma unroll
        for (int e = 0; e < 8; ++e) v[e] = bs[e] + x[0][e] * wk[0][e] + x[1][e] * wk[1][e] + x[2][e] * wk[2][e] + x[3][e] * wk[3][e];
#pragma unroll
        for (int e = 0; e < 4; ++e) o[e] = pk2(v[2 * e], v[2 * e + 1]);
        *(u32x4*)(V + (size_t)(row0 + i) * DM + ch) = o;
#pragma unroll
        for (int e = 0; e < 8; ++e) { x[0][e] = x[1][e]; x[1][e] = x[2][e]; x[2][e] = x[3][e]; }
    }
    if (t0 == SEQ - 16) {
#pragma unroll
        for (int i = 13; i < 16; ++i) { float* op = out + O_CONV_P + ((size_t)bb * 3 + (i - 13)) * DM + ch;
            *(f32x4*)op = (f32x4){__uint_as_float(raw[3 + i][0] << 16), __uint_as_float(raw[3 + i][0] & 0xffff0000u), __uint_as_float(raw[3 + i][1] << 16), __uint_as_float(raw[3 + i][1] & 0xffff0000u)};
            *(f32x4*)(op + 4) = (f32x4){__uint_as_float(raw[3 + i][2] << 16), __uint_as_float(raw[3 + i][2] & 0xffff0000u), __uint_as_float(raw[3 + i][3] << 16), __uint_as_float(raw[3 + i][3] & 0xffff0000u)}; } }
}

DI void attn_p_naive_item(int item, int lane, LAS float* sc, const bf16_t* __restrict__ QB, const bf16_t* __restrict__ KV, const bf16_t* __restrict__ KRB, bf16_t* __restrict__ MIX) {
    LAS float* qs = sc + SEQ;
    const int row = item >> 3, h = item & 7, b = row >> 12, t = row & (SEQ - 1);
    for (int i = lane; i < QKH; i += 64) qs[i] = bf2f(QB[(size_t)row * QDIM + h * QKH + i]);
    asm volatile("s_waitcnt lgkmcnt(0)" ::: "memory");
    float mx = -INFINITY;
    for (int j0 = 0; j0 <= t; j0 += 64) {
        const int j = j0 + lane;
        if (j <= t) {
            const bf16_t* kr = KV + (size_t)(b * SEQ + j) * 1024 + h * 64; const bf16_t* rr = KRB + (size_t)(b * SEQ + j) * ROPE;
            float s = 0.f;
            for (int d = 0; d < 64; ++d) s += qs[d] * bf2f(kr[d]);
            for (int d = 0; d < 32; ++d) s += qs[64 + d] * bf2f(rr[d]);
            sc[j] = s; mx = fmaxf(mx, s);
        }
    }
    mx = wave_max(mx);
    float sum = 0.f;
    for (int j = lane; j <= t; j += 64) { const float p = exp2f(sc[j] - mx); sc[j] = p; sum += p; }
    sum = wave_sum(sum);
    asm volatile("s_waitcnt lgkmcnt(0)" ::: "memory");
    float acc = 0.f;
    for (int j = 0; j <= t; ++j) acc += sc[j] * bf2f(KV[(size_t)(b * SEQ + j) * 1024 + 512 + h * 64 + lane]);
    MIX[(size_t)row * DM + 512 + h * 64 + lane] = (bf16_t)f2bf(acc / sum);
    asm volatile("s_waitcnt lgkmcnt(0)" ::: "memory");
}


typedef short v4i16_t __attribute__((ext_vector_type(4)));
DI int crow(int r, int hi) { return (r & 3) + 8 * (r >> 2) + 4 * hi; }
constexpr int AP_KS = 12288, AP_VS = 8192, AP_LK = 0, AP_LV = 2 * AP_KS;
DI void attn_p_unit(int b, int h, int qb, LAS unsigned char* lds, const bf16_t* __restrict__ QB, const bf16_t* __restrict__ KV, const bf16_t* __restrict__ KRB, bf16_t* __restrict__ MIX) {
    const int tid = threadIdx.x, lane = tid & 63, r32 = lane & 31, hi = lane >> 5, wid = __builtin_amdgcn_readfirstlane(tid >> 6);
    const int rowbase = b * SEQ, q0 = qb * 256, NT = 4 * (qb + 1);
    const bf16_t* ksrc0 = KV + (size_t)(rowbase + lane) * 1024 + h * 64 + wid * 8;
    const bf16_t* ksrc1 = KRB + (size_t)(rowbase + lane) * ROPE + (wid & 3) * 8;
    const bf16_t* vsrc = KV + (size_t)(rowbase + 16 * (wid & 3) + (lane >> 2)) * 1024 + 512 + h * 64 + (wid >> 2) * 32 + (lane & 3) * 8;
#define AP_DMA(t, slot) do { \
        __builtin_amdgcn_global_load_lds((const unsigned*)(ksrc0 + (size_t)(t) * 64 * 1024), (LAS unsigned*)(lds + AP_LK + (slot) * AP_KS + wid * 1024), 16, 0, 0); \
        if (wid < 4) __builtin_amdgcn_global_load_lds((const unsigned*)(ksrc1 + (size_t)(t) * 64 * ROPE), (LAS unsigned*)(lds + AP_LK + (slot) * AP_KS + (8 + wid) * 1024), 16, 0, 0); \
        __builtin_amdgcn_global_load_lds((const unsigned*)(vsrc + (size_t)(t) * 64 * 1024), (LAS unsigned*)(lds + AP_LV + (slot) * AP_VS + wid * 1024), 16, 0, 0); } while (0)
    AP_DMA(0, 0);
    bf16x8 qr[6];
    { const bf16_t* qw = QB + (size_t)(rowbase + q0 + wid * 32 + r32) * QDIM + h * QKH + hi * 8;
#pragma unroll
      for (int d0 = 0; d0 < 6; ++d0) qr[d0] = *(const bf16x8*)(qw + d0 * 16); }
    float m = 0.f, l = 0.f;
    f32x16 o0, o1, negm;
#pragma unroll
    for (int r = 0; r < 16; ++r) { o0[r] = 0.f; o1[r] = 0.f; negm[r] = 0.f; }
    const int qrel = wid * 32 + r32;
    const int voff = (4 * hi + ((lane & 15) >> 2)) * 64 + ((lane >> 4) & 1) * 32 + (lane & 3) * 8;
    for (int t = 0; t < NT; ++t) {
        asm volatile("s_waitcnt vmcnt(0)" ::: "memory"); __builtin_amdgcn_s_barrier(); asm volatile("" ::: "memory");
        if (t + 1 < NT) AP_DMA(t + 1, (t + 1) & 1);
        const int slot = t & 1, trel = t - (NT - 4);
        if (trel < 0 || 64 * trel <= 32 * wid + 31) {
            const LAS unsigned char* kb = lds + AP_LK + slot * AP_KS + hi * 1024 + r32 * 16;
            f32x16 p0, p1;
            __builtin_amdgcn_s_setprio(1);
#pragma unroll
            for (int d0 = 0; d0 < 6; ++d0) {
                const bf16x8 k0 = *(const LAS bf16x8*)(kb + d0 * 2048), k1 = *(const LAS bf16x8*)(kb + d0 * 2048 + 512);
                p0 = __builtin_amdgcn_mfma_f32_32x32x16_bf16(k0, qr[d0], d0 == 0 ? negm : p0, 0, 0, 0);
                p1 = __builtin_amdgcn_mfma_f32_32x32x16_bf16(k1, qr[d0], d0 == 0 ? negm : p1, 0, 0, 0);
            }
            __builtin_amdgcn_s_setprio(0);
            if (trel >= 0) {
#pragma unroll
                for (int r = 0; r < 16; ++r) { const int kp = 64 * trel + crow(r, hi); if (kp > qrel) p0[r] = -INFINITY; if (kp + 32 > qrel) p1[r] = -INFINITY; }
            }
            float mx = max3f(p0[0], p1[0], p0[1]);
#pragma unroll
            for (int r = 1; r < 16; ++r) mx = (r < 15) ? max3f(mx, p1[r], p0[r + 1]) : fmaxf(mx, p1[r]);
            mx = xmax32(mx);
            float ps = 0.f;
#pragma unroll
            for (int r = 0; r < 16; ++r) { p0[r] = __builtin_amdgcn_exp2f(p0[r]); p1[r] = __builtin_amdgcn_exp2f(p1[r]); ps += p0[r] + p1[r]; }
            l += ps;
            const LAS unsigned char* vb = lds + AP_LV + slot * AP_VS + voff;
            __builtin_amdgcn_s_setprio(1);
#pragma unroll
            for (int ks = 0; ks < 4; ++ks) {
                u32x4 pw;
                if (ks < 2) { pw.x = cvtpk(p0[8 * ks], p0[8 * ks + 1]); pw.y = cvtpk(p0[8 * ks + 2], p0[8 * ks + 3]); pw.z = cvtpk(p0[8 * ks + 4], p0[8 * ks + 5]); pw.w = cvtpk(p0[8 * ks + 6], p0[8 * ks + 7]); }
                else { const int s8 = 8 * (ks - 2); pw.x = cvtpk(p1[s8], p1[s8 + 1]); pw.y = cvtpk(p1[s8 + 2], p1[s8 + 3]); pw.z = cvtpk(p1[s8 + 4], p1[s8 + 5]); pw.w = cvtpk(p1[s8 + 6], p1[s8 + 7]); }
                const bf16x8 pa = __builtin_bit_cast(bf16x8, pw);
#pragma unroll
                for (int db = 0; db < 2; ++db) {
                    const v4i16_t lo = __builtin_amdgcn_ds_read_tr16_b64_v4i16((LAS v4i16_t*)(vb + db * 4096 + ks * 1024));
                    const v4i16_t hh = __builtin_amdgcn_ds_read_tr16_b64_v4i16((LAS v4i16_t*)(vb + db * 4096 + ks * 1024 + 512));
                    const bf16x8 vf = (bf16x8){lo[0], lo[1], lo[2], lo[3], hh[0], hh[1], hh[2], hh[3]};
                    if (db == 0) o0 = __builtin_amdgcn_mfma_f32_32x32x16_bf16(vf, pa, o0, 0, 0, 0);
                    else o1 = __builtin_amdgcn_mfma_f32_32x32x16_bf16(vf, pa, o1, 0, 0, 0);
                }
            }
            __builtin_amdgcn_s_setprio(0);
            const float mn = (t == 0) ? mx : fmaxf(mx, 0.f);
            if (__any(mn != 0.f)) {
                const float f = __builtin_amdgcn_exp2f(-mn); l *= f; m += mn;
#pragma unroll
                for (int r = 0; r < 16; ++r) { o0[r] *= f; o1[r] *= f; negm[r] = -m; }
            }
        }
    }
    l = xsum32(l);
    const float il = 1.0f / l;
    bf16_t* orow = MIX + (size_t)(rowbase + q0 + wid * 32 + r32) * DM + 512 + h * 64 + 4 * hi;
#pragma unroll
    for (int g = 0; g < 4; ++g) {
        u32x2 a; a.x = cvtpk(o0[4 * g] * il, o0[4 * g + 1] * il); a.y = cvtpk(o0[4 * g + 2] * il, o0[4 * g + 3] * il); *(u32x2*)(orow + 8 * g) = a;
        u32x2 c; c.x = cvtpk(o1[4 * g] * il, o1[4 * g + 1] * il); c.y = cvtpk(o1[4 * g + 2] * il, o1[4 * g + 3] * il); *(u32x2*)(orow + 32 + 8 * g) = c;
    }
#undef AP_DMA
}


constexpr int SA_CB_ROW = 576, SA_CB_SZ = 64 * SA_CB_ROW;
constexpr int SA_C8_ROW = 272, SA_C8_SZ = 64 * SA_C8_ROW;
constexpr int SA_KR_ROW = 96, SA_KR_SZ = 64 * SA_KR_ROW;
constexpr int SA_CB = 0, SA_C8 = 2 * SA_CB_SZ, SA_KRB = SA_C8 + 2 * SA_C8_SZ;
constexpr int SA_P = SA_KRB + 2 * SA_KR_SZ, SA_P_ROW = 144;
constexpr int SA_QF = SA_P + 64 * SA_P_ROW;
constexpr int SA_F = SA_QF + 8 * 3 * 4 * 8 * 16;
constexpr int SA_END = SA_F + 256;
static_assert(SA_END <= LDS_MISC, "sample attention LDS map");
DI int sa_swz(int x) { return (0x78 >> (2 * x)) & 3; }
DI int sa_g8(int x) { return (0x28 >> (2 * x)) & 3; }
typedef int v8i_t __attribute__((ext_vector_type(8)));
typedef float f32x4v __attribute__((ext_vector_type(4)));

template <int VAR> DI void attn_s_unit(int unit, LAS unsigned char* lds, const float* __restrict__ cache_ckv, const float* __restrict__ cache_kr, const int* __restrict__ page_table, const bf16_t* __restrict__ QB,
                    const bf16_t* __restrict__ WKVT, const float* __restrict__ g_k_nope, float* __restrict__ LATP, float* __restrict__ ML) {
    constexpr int hot = VAR != 0;
    const int tid = threadIdx.x, lane = tid & 63, r32 = lane & 31, hi = lane >> 5, l15 = lane & 15, quad = lane >> 4, w = __builtin_amdgcn_readfirstlane(tid >> 6);
    const int sb = unit >> 1, split = unit & 1;
    const int* pt = page_table + sb * NPAGES + split * 32;
    for (int e = tid; e < 8 * 3 * 4 * 8; e += NTHR) {
        const int q = e & 7, qd = (e >> 3) & 3, st = (e >> 5) % 3, h = e / 96;
        const bf16_t* qp = QB + (size_t)(MP + sb * DT + q) * QDIM + h * QKH;
        unsigned pk[4];
#pragma unroll
        for (int jj = 0; jj < 4; ++jj) {
            float v0, v1;
            if (st < 2) { const int j0 = 2 * jj, j1 = 2 * jj + 1; const int d0 = 32 * st + 16 * (j0 >> 2) + 4 * qd + (j0 & 3), d1 = 32 * st + 16 * (j1 >> 2) + 4 * qd + (j1 & 3); v0 = bf2f(qp[d0]) * g_k_nope[d0]; v1 = bf2f(qp[d1]) * g_k_nope[d1]; }
            else { const int r0 = 8 * qd + 2 * jj; v0 = bf2f(qp[64 + r0]); v1 = bf2f(qp[64 + r0 + 1]); }
            pk[jj] = pk2(v0, v1);
        }
        *(LAS u32x4*)(lds + SA_QF + e * 16) = (u32x4){pk[0], pk[1], pk[2], pk[3]};
    }
    v8i_t wf[4][2];
#pragma unroll
    for (int db = 0; db < 4; ++db)
#pragma unroll
        for (int ch = 0; ch < 2; ++ch) {
            const bf16_t* wp = WKVT + (size_t)(w * 64 + 16 * db + l15) * KVR + 128 * ch + 32 * quad;
#pragma unroll
            for (int i = 0; i < 4; ++i) { const u32x4 r = *(const u32x4*)(wp + 8 * i); int lo = 0, hi2 = 0;
                lo = __builtin_amdgcn_cvt_pk_fp8_f32(__uint_as_float(r.x << 16) * 16.f, __uint_as_float(r.x & 0xffff0000u) * 16.f, lo, false);
                lo = __builtin_amdgcn_cvt_pk_fp8_f32(__uint_as_float(r.y << 16) * 16.f, __uint_as_float(r.y & 0xffff0000u) * 16.f, lo, true);
                hi2 = __builtin_amdgcn_cvt_pk_fp8_f32(__uint_as_float(r.z << 16) * 16.f, __uint_as_float(r.z & 0xffff0000u) * 16.f, hi2, false);
                hi2 = __builtin_amdgcn_cvt_pk_fp8_f32(__uint_as_float(r.w << 16) * 16.f, __uint_as_float(r.w & 0xffff0000u) * 16.f, hi2, true);
                wf[db][ch][2 * i] = lo; wf[db][ch][2 * i + 1] = hi2; }
        }
    const __amdgpu_buffer_rsrc_t rs_c = __builtin_amdgcn_make_buffer_rsrc((void*)cache_ckv, (short)0, (int)((size_t)(NPAGES * DB_ + NPAGES * DB_ / 4) * PAGE * KVR * 4), 0x00020000);
    const __amdgpu_buffer_rsrc_t rs_k = __builtin_amdgcn_make_buffer_rsrc((void*)cache_kr, (short)0, (int)((size_t)(NPAGES * DB_ + NPAGES * DB_ / 4) * PAGE * ROPE * 4), 0x00020000);
    const int dma_voff = lane * 16;
    u32x4 pf[9];
#define SA_LOAD(t) do { const unsigned prow = (unsigned)__builtin_amdgcn_readfirstlane(pt[hot ? 0 : ((t) >> 1)]) * PAGE + 64 * ((t) & 1) + 8 * w; \
        _Pragma("unroll") for (int i = 0; i < 8; ++i) pf[i] = __builtin_amdgcn_raw_buffer_load_b128(rs_c, dma_voff, (prow + i) * (KVR * 4), 0); \
        pf[8] = __builtin_amdgcn_raw_buffer_load_b128(rs_k, dma_voff, prow * (ROPE * 4), 0); } while (0)
    SA_LOAD(0);
    float m = 0.f, negm = 0.f, l = 0.f;
    f32x16 lat0, lat1;
#pragma unroll
    for (int r = 0; r < 16; ++r) { lat0[r] = 0.f; lat1[r] = 0.f; }
    const bool qreal = l15 < 8;
    const int g8_ = sa_g8((l15 >> 2) & 3);
    const LAS unsigned char* c8a0 = lds + SA_C8 + l15 * SA_C8_ROW + (((2 * quad) ^ g8_) * 16);
    const LAS unsigned char* c8b0 = lds + SA_C8 + l15 * SA_C8_ROW + (((2 * quad + 1) ^ g8_) * 16);
    const LAS unsigned char* qfbase = lds + SA_QF + (((w * 3) * 4 + quad) * 8 + (l15 & 7)) * 16;
    const LAS unsigned char* krbase0 = lds + SA_KRB + l15 * SA_KR_ROW + quad * 16;
    LAS unsigned char* pwbase = lds + SA_P + (8 * w + l15) * SA_P_ROW + quad * 8;
    asm volatile("s_waitcnt lgkmcnt(0)" ::: "memory"); __builtin_amdgcn_s_barrier(); asm volatile("" ::: "memory");
    bf16x8 q0 = *(const LAS bf16x8*)(qfbase), q1 = *(const LAS bf16x8*)(qfbase + 512), q2 = *(const LAS bf16x8*)(qfbase + 1024);
    if (!qreal) { q0 = (bf16x8){0, 0, 0, 0, 0, 0, 0, 0}; q1 = q0; q2 = q0; }
    LAS unsigned char* cvw0 = lds + SA_CB + 8 * w * SA_CB_ROW + (((lane >> 1) ^ sa_swz((2 * w) & 3)) * 16) + (lane & 1) * 8;
    LAS unsigned char* cvw1 = lds + SA_CB + 8 * w * SA_CB_ROW + (((lane >> 1) ^ sa_swz((2 * w + 1) & 3)) * 16) + (lane & 1) * 8;
    LAS unsigned char* c8w0 = lds + SA_C8 + 8 * w * SA_C8_ROW + (((lane >> 2) ^ sa_g8((2 * w) & 3)) * 16) + (lane & 3) * 4;
    LAS unsigned char* c8w1 = lds + SA_C8 + 8 * w * SA_C8_ROW + (((lane >> 2) ^ sa_g8((2 * w + 1) & 3)) * 16) + (lane & 3) * 4;
    LAS unsigned char* krw = lds + SA_KRB + (8 * w + (lane >> 3)) * SA_KR_ROW + (lane & 7) * 8;
    const int kr0 = 8 * hi + (l15 >> 2), cc0 = 4 * w + 2 * ((lane >> 4) & 1) + ((lane & 3) >> 1);
    const LAS unsigned char* trlo = lds + SA_CB + kr0 * SA_CB_ROW + ((cc0 ^ (hi ? 3 : 0)) * 16) + (lane & 1) * 8;
    const LAS unsigned char* trhi = lds + SA_CB + (kr0 + 4) * SA_CB_ROW + ((cc0 ^ (hi ? 1 : 2)) * 16) + (lane & 1) * 8;
    const LAS unsigned char* prd = lds + SA_P + r32 * SA_P_ROW + hi * 16;
    const LAS float* frd = (const LAS float*)(lds + SA_F + r32 * 4);
    for (int t2 = 0; t2 < 64; t2 += 2) {
#pragma unroll
      for (int tb = 0; tb < 2; ++tb) {
        const int t = t2 + tb;
        asm volatile("s_waitcnt vmcnt(0)" ::: "memory");
        if (VAR != 5) {
#pragma unroll
            for (int i = 0; i < 8; ++i) {
                const f32x4 v = __builtin_bit_cast(f32x4, pf[i]);
                u32x2 o; o.x = cvtpk(v.x, v.y); o.y = cvtpk(v.z, v.w);
                *(LAS u32x2*)((i < 4 ? cvw0 : cvw1) + tb * SA_CB_SZ + i * SA_CB_ROW) = o;
                int f8 = __builtin_amdgcn_cvt_pk_fp8_f32(v.x, v.y, 0, false); f8 = __builtin_amdgcn_cvt_pk_fp8_f32(v.z, v.w, f8, true);
                *(LAS int*)((i < 4 ? c8w0 : c8w1) + tb * SA_C8_SZ + i * SA_C8_ROW) = f8;
            }
            { const f32x4 v = __builtin_bit_cast(f32x4, pf[8]); u32x2 o; o.x = cvtpk(v.x, v.y); o.y = cvtpk(v.z, v.w);
              *(LAS u32x2*)(krw + tb * SA_KR_SZ) = o; }
        }
        constexpr bool ld_next = (VAR != 5);
        const int tn = (t + 1) & 63;
        const unsigned prow_n = (unsigned)__builtin_amdgcn_readfirstlane(pt[hot ? 0 : (tn >> 1)]) * PAGE + 64 * (tn & 1) + 8 * w;
        asm volatile("s_waitcnt lgkmcnt(0)" ::: "memory");
        __builtin_amdgcn_s_barrier(); asm volatile("" ::: "memory");
        const LAS unsigned char* c8a = c8a0 + tb * SA_C8_SZ; const LAS unsigned char* c8b = c8b0 + tb * SA_C8_SZ; const LAS unsigned char* krbase = krbase0 + tb * SA_KR_SZ;
        float tmax = -INFINITY, ps = 0.f;
        u32x4 nb00, nb01, nb10, nb11; bf16x8 nkf;
#define SA_LDB(kb_) do { const LAS unsigned char* ca_ = c8a + (kb_) * 16 * SA_C8_ROW; const LAS unsigned char* cb_ = c8b + (kb_) * 16 * SA_C8_ROW; \
            nb00 = *(const LAS u32x4*)(ca_); nb01 = *(const LAS u32x4*)(cb_); nb10 = *(const LAS u32x4*)(ca_ + 128); nb11 = *(const LAS u32x4*)(cb_ + 128); \
            nkf = *(const LAS bf16x8*)(krbase + (kb_) * 16 * SA_KR_ROW); } while (0)
        SA_LDB(0);
#pragma unroll
        for (int kb = 0; kb < 4; ++kb) {
            f32x4v k0 = {0.f, 0.f, 0.f, 0.f}, k1 = {0.f, 0.f, 0.f, 0.f}, k2 = {0.f, 0.f, 0.f, 0.f}, k3 = {0.f, 0.f, 0.f, 0.f};
            const bf16x8 kf = nkf;
            {
                const v8i_t bf0 = {(int)nb00.x, (int)nb00.y, (int)nb00.z, (int)nb00.w, (int)nb01.x, (int)nb01.y, (int)nb01.z, (int)nb01.w};
                const v8i_t bf1 = {(int)nb10.x, (int)nb10.y, (int)nb10.z, (int)nb10.w, (int)nb11.x, (int)nb11.y, (int)nb11.z, (int)nb11.w};
                if (VAR != 3) {
                    __builtin_amdgcn_s_setprio(1);
                    k0 = __builtin_amdgcn_mfma_scale_f32_16x16x128_f8f6f4(wf[0][0], bf0, k0, 0, 0, 0, 123, 0, 127); k1 = __builtin_amdgcn_mfma_scale_f32_16x16x128_f8f6f4(wf[1][0], bf0, k1, 0, 0, 0, 123, 0, 127);
                    k2 = __builtin_amdgcn_mfma_scale_f32_16x16x128_f8f6f4(wf[2][0], bf0, k2, 0, 0, 0, 123, 0, 127); k3 = __builtin_amdgcn_mfma_scale_f32_16x16x128_f8f6f4(wf[3][0], bf0, k3, 0, 0, 0, 123, 0, 127);
                    k0 = __builtin_amdgcn_mfma_scale_f32_16x16x128_f8f6f4(wf[0][1], bf1, k0, 0, 0, 0, 123, 0, 127); k1 = __builtin_amdgcn_mfma_scale_f32_16x16x128_f8f6f4(wf[1][1], bf1, k1, 0, 0, 0, 123, 0, 127);
                    k2 = __builtin_amdgcn_mfma_scale_f32_16x16x128_f8f6f4(wf[2][1], bf1, k2, 0, 0, 0, 123, 0, 127); k3 = __builtin_amdgcn_mfma_scale_f32_16x16x128_f8f6f4(wf[3][1], bf1, k3, 0, 0, 0, 123, 0, 127);
                    __builtin_amdgcn_s_setprio(0);
                }
                __builtin_amdgcn_sched_barrier(0);
                if (kb < 3) SA_LDB(kb + 1);
                if (ld_next) { pf[2 * kb] = __builtin_amdgcn_raw_buffer_load_b128(rs_c, dma_voff, (prow_n + 2 * kb) * (KVR * 4), 0); pf[2 * kb + 1] = __builtin_amdgcn_raw_buffer_load_b128(rs_c, dma_voff, (prow_n + 2 * kb + 1) * (KVR * 4), 0);
                    if (kb == 3) pf[8] = __builtin_amdgcn_raw_buffer_load_b128(rs_k, dma_voff, prow_n * (ROPE * 4), 0); }
                __builtin_amdgcn_sched_barrier(0);
            }
            float ss = k0.x * k0.x + k0.y * k0.y + k0.z * k0.z + k0.w * k0.w + k1.x * k1.x + k1.y * k1.y + k1.z * k1.z + k1.w * k1.w
                     + k2.x * k2.x + k2.y * k2.y + k2.z * k2.z + k2.w * k2.w + k3.x * k3.x + k3.y * k3.y + k3.z * k3.z + k3.w * k3.w;
            ss = xsum32(xsum16(ss));
            const float ri = __builtin_amdgcn_rsqf(ss * (1.f / 64.f) + EPS);
            u32x4 a0, a1;
            a0.x = cvtpk(k0.x * ri, k0.y * ri); a0.y = cvtpk(k0.z * ri, k0.w * ri); a0.z = cvtpk(k1.x * ri, k1.y * ri); a0.w = cvtpk(k1.z * ri, k1.w * ri);
            a1.x = cvtpk(k2.x * ri, k2.y * ri); a1.y = cvtpk(k2.z * ri, k2.w * ri); a1.z = cvtpk(k3.x * ri, k3.y * ri); a1.w = cvtpk(k3.z * ri, k3.w * ri);
            f32x4v sc = {negm, negm, negm, negm};
            sc = __builtin_amdgcn_mfma_f32_16x16x32_bf16(kf, q2, sc, 0, 0, 0);
            sc = __builtin_amdgcn_mfma_f32_16x16x32_bf16(__builtin_bit_cast(bf16x8, a0), q0, sc, 0, 0, 0);
            sc = __builtin_amdgcn_mfma_f32_16x16x32_bf16(__builtin_bit_cast(bf16x8, a1), q1, sc, 0, 0, 0);
            float bm = fmaxf(fmaxf(sc.x, sc.y), fmaxf(sc.z, sc.w));
            if (t == 0 && kb == 0) { const float m0 = xmax32(xmax16(bm)); sc.x -= m0; sc.y -= m0; sc.z -= m0; sc.w -= m0; bm -= m0; m = m0; negm = -m0; }
            tmax = fmaxf(tmax, bm);
            sc.x = __builtin_amdgcn_exp2f(sc.x); sc.y = __builtin_amdgcn_exp2f(sc.y); sc.z = __builtin_amdgcn_exp2f(sc.z); sc.w = __builtin_amdgcn_exp2f(sc.w);
            ps += (sc.x + sc.y) + (sc.z + sc.w);
            asm volatile("" : "+v"(ps), "+v"(tmax));
            if (qreal) { u32x2 o; o.x = cvtpk(sc.x, sc.y); o.y = cvtpk(sc.z, sc.w); *(LAS u32x2*)(pwbase + kb * 32) = o; }
            __builtin_amdgcn_sched_barrier(0);
        }
#undef SA_LDB
        { tmax = xmax32(xmax16(tmax));
          const float inc = fmaxf(tmax, 0.f); const float f = __builtin_amdgcn_exp2f(-inc); m += inc; negm = -m; l = (l + ps) * f;
          if (qreal && quad == 0) *(LAS float*)(lds + SA_F + (8 * w + l15) * 4) = f; }
        asm volatile("s_waitcnt lgkmcnt(0)" ::: "memory"); __builtin_amdgcn_s_barrier(); asm volatile("" ::: "memory");
        if (VAR != 4) {
            v4i16_t lo[4], hh[4]; bf16x8 p0[4], p1[4];
#pragma unroll
            for (int ks = 0; ks < 4; ++ks) {
                lo[ks] = __builtin_amdgcn_ds_read_tr16_b64_v4i16((LAS v4i16_t*)(trlo + tb * SA_CB_SZ + ks * 16 * SA_CB_ROW));
                hh[ks] = __builtin_amdgcn_ds_read_tr16_b64_v4i16((LAS v4i16_t*)(trhi + tb * SA_CB_SZ + ks * 16 * SA_CB_ROW));
                p0[ks] = *(const LAS bf16x8*)(prd + ks * 32);
                p1[ks] = *(const LAS bf16x8*)(prd + 32 * SA_P_ROW + ks * 32);
            }
            const float f0 = frd[0], f1 = frd[32];
            __builtin_amdgcn_sched_barrier(0);
            __builtin_amdgcn_s_setprio(1);
#pragma unroll
            for (int ks = 0; ks < 4; ++ks) {
                const bf16x8 cf = (bf16x8){lo[ks][0], lo[ks][1], lo[ks][2], lo[ks][3], hh[ks][0], hh[ks][1], hh[ks][2], hh[ks][3]};
                lat0 = __builtin_amdgcn_mfma_f32_32x32x16_bf16(cf, p0[ks], lat0, 0, 0, 0);
                lat1 = __builtin_amdgcn_mfma_f32_32x32x16_bf16(cf, p1[ks], lat1, 0, 0, 0);
            }
            __builtin_amdgcn_s_setprio(0);
            if (__any(f0 != 1.f || f1 != 1.f)) {
#pragma unroll
                for (int r = 0; r < 16; ++r) { lat0[r] *= f0; lat1[r] *= f1; } }
        }
      }
    }
    __builtin_amdgcn_s_barrier(); asm volatile("" ::: "memory");
    l = xsum32(xsum16(l));
    int unit2 = unit, lane2 = threadIdx.x & 63; asm volatile("" : "+s"(unit2), "+v"(lane2));
    const int r32b = lane2 & 31, hib = lane2 >> 5;
    if (lane2 < 8) { float* mlp = ML + ((size_t)unit2 * 64 + 8 * w + lane2) * 2; mlp[0] = m; mlp[1] = l; }
    float* lp = LATP + (size_t)unit2 * 64 * KVR + 32 * w + 4 * hib;
#pragma unroll
    for (int g = 0; g < 4; ++g) {
        *(f32x4*)(lp + (size_t)r32b * KVR + 8 * g) = (f32x4){lat0[4 * g], lat0[4 * g + 1], lat0[4 * g + 2], lat0[4 * g + 3]};
        *(f32x4*)(lp + (size_t)(32 + r32b) * KVR + 8 * g) = (f32x4){lat1[4 * g], lat1[4 * g + 1], lat1[4 * g + 2], lat1[4 * g + 3]};
    }
#undef SA_LOAD
}

DI void attn_s_combine(int sb, LAS unsigned char* lds, const bf16_t* __restrict__ QB, const bf16_t* __restrict__ KV, const bf16_t* __restrict__ KRB, const bf16_t* __restrict__ WKVT,
                       const float* __restrict__ LATP, const float* __restrict__ ML, bf16_t* __restrict__ MIX) {
    const int tid = threadIdx.x;
    LAS float* latc = (LAS float*)lds; LAS float* pn = latc + 64 * KVR; LAS float* wgt = pn + 64 * 8;
    {
        const int qh = tid >> 3, j = tid & 7, h = qh >> 3, q = qh & 7;
        const bf16_t* qp = QB + (size_t)(MP + sb * DT + q) * QDIM + h * QKH; const size_t krow_ = (size_t)MP + sb * DT + j;
        float sj = 0.f;
        for (int d = 0; d < 64; ++d) sj += bf2f(qp[d]) * bf2f(KV[krow_ * 1024 + h * 64 + d]);
        for (int r = 0; r < 32; ++r) sj += bf2f(qp[64 + r]) * bf2f(KRB[krow_ * ROPE + r]);
        if (j > q) sj = -INFINITY;
        const float m0 = ML[((size_t)(2 * sb) * 64 + qh) * 2], l0 = ML[((size_t)(2 * sb) * 64 + qh) * 2 + 1], m1 = ML[((size_t)(2 * sb + 1) * 64 + qh) * 2], l1 = ML[((size_t)(2 * sb + 1) * 64 + qh) * 2 + 1];
        const float mm = max8(sj);
        const float M = fmaxf(fmaxf(m0, m1), mm);
        const float pj = exp2f(sj - M), w0 = exp2f(m0 - M), w1 = exp2f(m1 - M);
        const float sp = sum8(pj);
        const float L = w0 * l0 + w1 * l1 + sp, iL = 1.f / L;
        pn[qh * 8 + j] = pj * iL;
        if (j == 0) { wgt[qh * 2] = w0 * iL; wgt[qh * 2 + 1] = w1 * iL; }
    }
    __syncthreads();
    for (int e = tid; e < 64 * KVR; e += NTHR) { const int qh = e >> 8; latc[e] = wgt[qh * 2] * LATP[(size_t)(2 * sb) * 64 * KVR + e] + wgt[qh * 2 + 1] * LATP[(size_t)(2 * sb + 1) * 64 * KVR + e]; }
    __syncthreads();
    for (int o = tid; o < 64 * VH; o += NTHR) {
        const int qh = o >> 6, v = o & 63, h = qh >> 3, q = qh & 7;
        const bf16_t* wr = WKVT + (size_t)(512 + h * 64 + v) * KVR;
        float a = 0.f;
        for (int c = 0; c < KVR; ++c) a += latc[qh * KVR + c] * bf2f(wr[c]);
        for (int j = 0; j < DT; ++j) a += pn[qh * 8 + j] * bf2f(KV[((size_t)MP + sb * DT + j) * 1024 + 512 + h * 64 + v]);
        MIX[(size_t)(MP + sb * DT + q) * DM + 512 + h * 64 + v] = (bf16_t)f2bf(a);
    }
    __syncthreads();
}

DI void attn_s_scores_item(int chunk, int sb, int tid, const float* __restrict__ cache_ckv, const float* __restrict__ cache_kr, const int* __restrict__ page_table, const bf16_t* __restrict__ QB,
                           const bf16_t* __restrict__ CB, const bf16_t* __restrict__ KRB, const float* __restrict__ w_uk, const float* __restrict__ g_k_nope, float* __restrict__ SC) {
    const int key = tid & 127, hq = __builtin_amdgcn_readfirstlane(tid >> 7);
    const bool isnew = chunk == NPAGES;
    if (isnew && key >= DT) return;
    const float* crow = nullptr; const bf16_t* crowb = nullptr; const float* kpf = nullptr; const bf16_t* kpb = nullptr;
    if (!isnew) { const size_t pr = (size_t)page_table[sb * NPAGES + chunk] * PAGE + key; crow = cache_ckv + pr * KVR; kpf = cache_kr + pr * ROPE; }
    else { const size_t rr = (size_t)MP + sb * DT + key; crowb = CB + rr * KVR; kpb = KRB + rr * ROPE; }
    const int jglob = isnew ? PAST + key : chunk * PAGE + key;
    for (int hi = 0; hi < 2; ++hi) {
        const int h = hq * 2 + hi;
        float acc[NOPE];
#pragma unroll
        for (int d = 0; d < NOPE; ++d) acc[d] = 0.f;
        for (int c = 0; c < KVR; ++c) {
            const float cv = isnew ? bf2f(crowb[c]) : crow[c];
            const float* wr = w_uk + (size_t)c * 512 + h * 64;
#pragma unroll
            for (int d = 0; d < NOPE; ++d) acc[d] += cv * wr[d];
        }
        float ss = 0.f;
#pragma unroll
        for (int d = 0; d < NOPE; ++d) ss += acc[d] * acc[d];
        const float ri = rsqrtf(ss * (1.f / 64.f) + EPS);
#pragma unroll 1
        for (int q = 0; q < DT; ++q) {
            const bf16_t* qp = QB + (size_t)(MP + sb * DT + q) * QDIM + h * QKH;
            float s = 0.f;
#pragma unroll
            for (int d = 0; d < NOPE; ++d) s += acc[d] * g_k_nope[d] * bf2f(qp[d]);
            s *= ri;
            for (int r = 0; r < ROPE; ++r) s += (isnew ? bf2f(kpb[r]) : kpf[r]) * bf2f(qp[64 + r]);
            if (isnew && key > q) s = -INFINITY;
            SC[((size_t)sb * 64 + h * 8 + q) * NKEYS + jglob] = s;
        }
    }
}
DI void attn_s_pv_item(int sb, int tid, LAS float* lds, const float* __restrict__ cache_ckv, const int* __restrict__ page_table, const bf16_t* __restrict__ CB, const float* __restrict__ SC,
                       const float* __restrict__ w_uv, float* __restrict__ LAT, bf16_t* __restrict__ MIX) {
    LAS float* p = lds; LAS float* smx = lds + 64 * PAGE; LAS float* sinv = smx + 64;
    const int wid = tid >> 6, lane = tid & 63;
    for (int i = 0; i < 8; ++i) {
        const int qh = wid * 8 + i; const float* s = SC + ((size_t)sb * 64 + qh) * NKEYS;
        float mx = -INFINITY; for (int j = lane; j < NKEYS; j += 64) mx = fmaxf(mx, s[j]);
        mx = wave_max(mx);
        float sum = 0.f; for (int j = lane; j < NKEYS; j += 64) sum += exp2f(s[j] - mx);
        sum = wave_sum(sum);
        if (lane == 0) { smx[qh] = mx; sinv[qh] = 1.f / sum; }
    }
    __syncthreads();
    const int c = tid & 255, half = tid >> 8;
    float lat[32];
#pragma unroll
    for (int i = 0; i < 32; ++i) lat[i] = 0.f;
    for (int chunk = 0; chunk <= NPAGES; ++chunk) {
        const int nk = chunk == NPAGES ? DT : PAGE;
        for (int e = tid; e < 64 * PAGE; e += NTHR) { const int qh = e >> 7, j = e & 127; p[qh * PAGE + j] = j < nk ? exp2f(SC[((size_t)sb * 64 + qh) * NKEYS + chunk * PAGE + j] - smx[qh]) * sinv[qh] : 0.f; }
        __syncthreads();
        for (int j = 0; j < nk; ++j) {
            float cv;
            if (chunk < NPAGES) cv = cache_ckv[((size_t)page_table[sb * NPAGES + chunk] * PAGE + j) * KVR + c];
            else cv = bf2f(CB[((size_t)MP + sb * DT + j) * KVR + c]);
#pragma unroll
            for (int i = 0; i < 32; ++i) lat[i] += p[(half * 32 + i) * PAGE + j] * cv;
        }
        __syncthreads();
    }
    float* L = LAT + (size_t)sb * 64 * KVR;
#pragma unroll
    for (int i = 0; i < 32; ++i) L[(half * 32 + i) * KVR + c] = lat[i];
    __threadfence_block(); __syncthreads();
    for (int o = tid; o < 64 * VH; o += NTHR) {
        const int qh = o >> 6, v = o & 63, h = qh >> 3, q = qh & 7;
        float a = 0.f;
        for (int cc = 0; cc < KVR; ++cc) a += L[qh * KVR + cc] * w_uv[(size_t)cc * 512 + h * 64 + v];
        MIX[(size_t)(MP + sb * DT + q) * DM + 512 + h * 64 + v] = (bf16_t)f2bf(a);
    }
    __syncthreads();
}

enum Phase { PH_PRO = 0, PH_Z0, PH_POST0, PH_KVPOOL, PH_KNORM, PH_ATTN, PH_ATTN2, PH_OUT0, PH_UP0, PH_DN0, PH_RNNIN, PH_CONV, PH_GATES, PH_SCAN, PH_OUTR, PH_UP1, PH_DN1, PH_COUNT };

__global__ void __launch_bounds__(NTHR, 2) mk(Args args) {
    extern __shared__ __attribute__((aligned(16))) unsigned char lds_raw[];
    LAS unsigned char* lds = (LAS unsigned char*)lds_raw;
    volatile LAS unsigned* MISC = (volatile LAS unsigned*)(lds + LDS_MISC);
    const int tid = threadIdx.x, lane = tid & 63, wave = __builtin_amdgcn_readfirstlane(tid >> 6);
    const int G = gridDim.x, bx = blockIdx.x;
    const int gw = bx * NWAVES + wave, NGW = G * NWAVES;
    const int lo = args.ph_lo, hi = args.ph_hi;

    const float* x_prompt = (const float*)args.in[0]; const float* x_sample = (const float*)args.in[1];
    const float* cache_ckv = (const float*)args.in[2]; const float* cache_kr = (const float*)args.in[3];
    const float* state_pool = (const float*)args.in[4]; const float* state_conv = (const float*)args.in[5]; const float* state_lru = (const float*)args.in[6];
    const int* page_table = (const int*)args.in[7];
    const float* norm_mix = (const float*)args.in[8]; const float* w_in_even = (const float*)args.in[9];
    const float* g_q_nope = (const float*)args.in[10]; const float* g_q_rope = (const float*)args.in[11]; const float* g_ckv = (const float*)args.in[12]; const float* g_k_rope = (const float*)args.in[13]; const float* g_k_nope = (const float*)args.in[14];
    const float* w_uk = (const float*)args.in[15]; const float* w_uv = (const float*)args.in[16]; const float* w_pool = (const float*)args.in[17]; const float* pool_scale = (const float*)args.in[18];
    const float* w_out_even = (const float*)args.in[19]; const float* w_in_rnn = (const float*)args.in[20]; const float* conv_w = (const float*)args.in[21]; const float* conv_b = (const float*)args.in[22];
    const float* w_gate_a = (const float*)args.in[23]; const float* b_gate_a = (const float*)args.in[24]; const float* w_gate_x = (const float*)args.in[25]; const float* b_gate_x = (const float*)args.in[26];
    const float* lru_lambda = (const float*)args.in[27]; const float* w_out_rnn = (const float*)args.in[28]; const float* norm_ffn = (const float*)args.in[29]; const float* w_up = (const float*)args.in[30]; const float* w_down = (const float*)args.in[31];
    float* out = args.out; unsigned char* ws = args.ws;
    bf16_t* WIN0T = (bf16_t*)(ws + WS_WIN0T); bf16_t* WKVT = (bf16_t*)(ws + WS_WKVT); bf16_t* WPOOLT = (bf16_t*)(ws + WS_WPOOLT); bf16_t* WGATET = (bf16_t*)(ws + WS_WGATET);
    bf16_t* WOUT0T = (bf16_t*)(ws + WS_WOUT0T); bf16_t* WOUTRT = (bf16_t*)(ws + WS_WOUTRT); bf16_t* WINRT = (bf16_t*)(ws + WS_WINRT); bf16_t* WUPT = (bf16_t*)(ws + WS_WUPT); bf16_t* WDNT = (bf16_t*)(ws + WS_WDNT);
    float* SSQ = (float*)(ws + WS_SSQ); bf16_t* XB = (bf16_t*)(ws + WS_XB); bf16_t* Z0 = (bf16_t*)(ws + WS_Z0); bf16_t* QB = (bf16_t*)(ws + WS_QB); bf16_t* CB = (bf16_t*)(ws + WS_CB); bf16_t* KRB = (bf16_t*)(ws + WS_KRB);
    bf16_t* DBuf = (bf16_t*)(ws + WS_DB); bf16_t* KV = (bf16_t*)(ws + WS_KV); bf16_t* MIX = (bf16_t*)(ws + WS_MIX); bf16_t* H = (bf16_t*)(ws + WS_H); bf16_t* GATE = (bf16_t*)(ws + WS_GATE); bf16_t* U = (bf16_t*)(ws + WS_U);
    bf16_t* V = (bf16_t*)(ws + WS_V); float* Gb = (float*)(ws + WS_G); bf16_t* YB = (bf16_t*)(ws + WS_YB); float* SC = (float*)(ws + WS_SC); float* LAT = (float*)(ws + WS_LAT);
    float* Y = out + O_Y;

    if (tid < 64) MISC[tid] = 0u;
    __syncthreads();
    XcdBarrier bar = xcd_barrier_post((unsigned*)(ws + WS_CTL) + CW_BAR, MISC + 8);
#ifndef PH_MASK
#define PH_MASK 0xFFFFFFFFu
#endif
#define IN(k) (((PH_MASK >> (k)) & 1u) && lo <= (k) && (k) < hi)
#define SEAM(k) do { if (IN(k) && IN((k) + 1)) xcd_barrier(bar); } while (0)
#define STREAM_CTL(ep_) pg8::StreamCtl{(float*)(ws + WS_PART), (unsigned*)(ws + WS_CTL) + CW_SKF, (unsigned*)(ws + WS_CTL) + CW_SKT, (unsigned)(ep_), bx, 0}
#define GEMM_PHASE_STATIC(ep_, Aptr, lda_, atoff_, ashift_, Bptr, M_, N_, K_, FT, ...) do { pg8::Gemm g{Aptr, Bptr, M_, N_, K_, lda_, atoff_, ashift_}; pg8::StaticOrder S; S.init(M_, N_, K_, G, bx); \
        pg8::EpiRows<FT> E{FT{__VA_ARGS__}}; pg8::gemm_phase<false>(lds, g, S, E, STREAM_CTL(ep_)); } while (0)
#define GEMM_PHASE(ep_, Aptr, lda_, atoff_, ashift_, Bptr, M_, N_, K_, FT, ...) do { pg8::Gemm g{Aptr, Bptr, M_, N_, K_, lda_, atoff_, ashift_}; pg8::StaticOrder S; S.init(M_, N_, K_, G, bx); \
        pg8::EpiRows<FT> E{FT{__VA_ARGS__}}; pg8::gemm_phase<false>(lds, g, S, E, STREAM_CTL(ep_)); } while (0)
#define GEMM_PHASE_P8(ep_, Aptr, lda_, Bptr, M_, N_, K_, FT, ...) do { pg8::Gemm g{Aptr, Bptr, M_, N_, K_, lda_, 0, 0}; pg8::StaticOrder S; S.init(M_, N_, K_, G, bx); \
        pg8::EpiRows<FT, false, true> E{FT{__VA_ARGS__}}; pg8::gemm_phase<false>(lds, g, S, E, STREAM_CTL(ep_)); } while (0)
#define GEMM_RESID(Aptr, lda_, Bptr, K_) GEMM_PHASE_P8(0, Aptr, lda_, Bptr, MT, DM, K_, FResid<false>, XB, (float*)nullptr, SSQ)
#define CW_RDY(i) ((unsigned*)(ws + WS_CTL) + 12288 + 64 * (i))
#define GEMM_RESID_SPLIT(Aptr, lda_, Bptr, K_) do { \
        if (G == 256) { pg8::Gemm g{Aptr, Bptr, MT, DM, K_, lda_, 0, 0}; pg8::SplitTailOrder S; S.init(K_, bx); pg8::EpiRows<FResid<false>, false, true> E{FResid<false>{XB, (float*)nullptr, SSQ}}; \
            pg8::gemm_phase<false>(lds, g, S, E, STREAM_CTL(0), EpiPartStore{(float*)(ws + WS_PART), bx & 15}); } \
        else GEMM_RESID(Aptr, lda_, Bptr, K_); } while (0)
#define FIXUP_DEFERRED(i, WAYS_) do { if (G == 256 && bx >= 128) { sample_fixup<false, WAYS_>(bx - 128, (const float*)(ws + WS_PART), XB, (float*)nullptr, SSQ); \
            asm volatile("s_waitcnt vmcnt(0)" ::: "memory"); __syncthreads(); \
            if (tid == 0) { __builtin_amdgcn_fence(__ATOMIC_RELEASE, "agent"); asm volatile("s_waitcnt vmcnt(0)" ::: "memory"); __hip_atomic_fetch_add(CW_RDY(i), 1u, __ATOMIC_RELAXED, __HIP_MEMORY_SCOPE_AGENT); } } } while (0)
#define GEMM_PHASE_P8_RDY(i, ep_, Aptr, lda_, Bptr, M_, N_, K_, FT, ...) do { pg8::Gemm g{Aptr, Bptr, M_, N_, K_, lda_, 0, 0}; if (G == 256) { g.ready = CW_RDY(i); g.ready_target = 128u; } pg8::StaticOrder S; S.init(M_, N_, K_, G, bx); \
        pg8::EpiRows<FT, false, true> E{FT{__VA_ARGS__}}; pg8::gemm_phase<false>(lds, g, S, E, STREAM_CTL(ep_)); } while (0)
#define GEMM_DOWN(Aptr, Bptr, FIN) do { \
        if (G == 256) { pg8::Gemm g{Aptr, Bptr, MT, DM, DFF, DFF, 0, 0}; pg8::SplitTailOrder S; S.init(DFF, bx); pg8::EpiRows<FResid<FIN>, false, true> E{FResid<FIN>{XB, Y, SSQ}}; \
            pg8::gemm_phase<false>(lds, g, S, E, STREAM_CTL(0), EpiPartStore{(float*)(ws + WS_PART), bx & 15}); \
            if (FIN) { xcd_barrier(bar); sample_fixup<FIN>(bx, (const float*)(ws + WS_PART), XB, Y, SSQ); } } \
        else GEMM_PHASE_STATIC(0, Aptr, DFF, 0, 0, Bptr, MT, DM, DFF, FResid<FIN>, XB, Y, SSQ); } while (0)

    if (IN(PH_PRO)) for (int rep_ = 0; rep_ < REPN(10); ++rep_) {
        LAS float* scr = (LAS float*)(lds + wave * 16384);
        constexpr int I0 = 16 * 49, I1 = 4 * 16, I3 = 2 * 4;
        constexpr int NITEMS = I0 + 2 * I1 + 4 * I3;
        for (int it = gw; it < NITEMS; it += NGW) {
            int r = it;
            if (r < I0) { p0_transpose_item(w_in_even, 1568, 1568, WIN0T, DM, norm_mix, scr, r, lane); continue; } r -= I0;
            if (r < I1) { p0_transpose_item(w_uk, 512, 512, WKVT, KVR, nullptr, scr, r, lane); continue; } r -= I1;
            if (r < I1) { p0_transpose_item(w_uv, 512, 512, WKVT + (size_t)512 * KVR, KVR, nullptr, scr, r, lane); continue; } r -= I1;
            { const int g = r / I3; p0_transpose_item(w_pool + (size_t)g * 128 * 128, 128, 128, WPOOLT + (size_t)g * 128 * 256 + (g & 1) * 128, 256, nullptr, scr, r % I3, lane); }
        }
        { u32x4* z0 = (u32x4*)(WIN0T + (size_t)1568 * DM); const u32x4 zz = {0u, 0u, 0u, 0u};
          for (int e = bx * NTHR + tid; e < (NZ0 - 1568) * DM / 8; e += G * NTHR) z0[e] = zz;
          for (int e = bx * NTHR + tid; e < 512 * 16; e += G * NTHR) { const int n = e >> 4, c8 = e & 15; *(u32x4*)(WPOOLT + (size_t)n * 256 + (1 - ((n >> 7) & 1)) * 128 + c8 * 8) = zz; }
          for (int e = bx * NTHR + tid; e < 2048 * 16; e += G * NTHR) { const int n = e >> 4, c8 = e & 15; *(u32x4*)(WGATET + (size_t)n * 256 + (1 - ((n >> 8) & 1)) * 128 + c8 * 8) = zz; } }
        { float* ROPET = (float*)(ws + WS_ROPE);
          for (int e = bx * NTHR + tid; e < (SEQ + DT) * 16; e += G * NTHR) { const int pi = e >> 4, i = e & 15; const int pos = pi < SEQ ? pi : PAST + (pi - SEQ);
              const float inv = powf(10000.0f, -(float)i / 16.0f); const float ang = (float)pos * inv; ROPET[e * 2] = cosf(ang); ROPET[e * 2 + 1] = sinf(ang); } }
        if (bx == G - 1) for (int c = tid; c < DM; c += NTHR) ((float*)(ws + WS_SP8))[c] = log1pf(expf(-lru_lambda[c])) * (8.0f * 1.4426950408889634f);
        {
#define XROW(r_) ((r_) < MP ? x_prompt + (size_t)(r_) * DM : x_sample + (size_t)((r_) - MP) * DM)
            f32x4 nv[4]; if (gw < MT) rowprep_load(XROW(gw), lane, nv);
            for (int row = gw; row < MT; row += NGW) { f32x4 v[4];
#pragma unroll
                for (int j = 0; j < 4; ++j) v[j] = nv[j];
                const int nr = row + NGW; if (nr < MT) rowprep_load(XROW(nr), lane, nv);
                rowprep_row(v, row, XB, SSQ, lane); }
#undef XROW
        }
    }
    SEAM(PH_PRO);
    if (REP_ID == 40) { for (int i = 0; i < 10; ++i) xcd_barrier(bar); }
    if (IN(PH_Z0)) for (int rep_ = 0; rep_ < REPN(1); ++rep_) GEMM_PHASE_P8(1, XB, DM, WIN0T, MT, NZ0, DM, FZ0, SSQ, Z0);
    SEAM(PH_Z0);
    if (IN(PH_POST0)) for (int rep_ = 0; rep_ < REPN(2); ++rep_) {
        const float* ROPET = (const float*)(ws + WS_ROPE);
        for (int row = gw; row < MT; row += NGW) post0_row(row, lane, Z0, ROPET, g_q_nope, g_q_rope, g_ckv, g_k_rope, QB, CB, KRB, out);
        for (int it = bx * NTHR + tid; it < (MP / 16) * 64; it += G * NTHR) pool_item_p16((it >> 6) * 16, (it & 63) * 8, Z0, DBuf, out);
        for (int it = bx * NTHR + tid; it < DB_ * 64; it += G * NTHR) pool_item<false>(MP + (it >> 6) * DT, DT, (it & 63) * 8, Z0, state_pool, DBuf, out);
    }
    SEAM(PH_POST0);
    if (IN(PH_KVPOOL) && REP_ID == 13) { GEMM_PHASE(14, CB, KVR, 0, 0, WKVT, MT, 1024, KVR, FRawBf16<1024>, (bf16_t*)(ws + WS_DBG)); GEMM_PHASE_STATIC(15, DBuf, POOLD, 256, 0, WPOOLT, MT, POOLD, 256, FPool, pool_scale, MIX); }
    if (IN(PH_KVPOOL)) {
        { pg8::Gemm g{CB, WKVT, MT, 1024, KVR, KVR, 0, 0}; pg8::StaticOrder S; S.init(MT, 1024, KVR, G, bx); pg8::EpiRows<FKvNorm, true, true> E{FKvNorm{KV, g_k_nope}}; pg8::gemm_phase<false>(lds, g, S, E, STREAM_CTL(2)); }
        { pg8::Gemm g{DBuf, WPOOLT, MT, POOLD, 256, POOLD, 256, 0}; pg8::StaticOrder S; S.init(MT, POOLD, 256, G, (G == 256) ? ((bx + 240) & 255) : bx); pg8::EpiRows<FPool, false, true> E{FPool{pool_scale, MIX}}; pg8::gemm_phase<false>(lds, g, S, E, STREAM_CTL(3)); }
    }
#if DBG_KNORM
    if (IN(PH_KVPOOL)) GEMM_PHASE_STATIC(16, CB, KVR, 0, 0, WKVT, MT, 1024, KVR, FRawBf16<1024>, (bf16_t*)(ws + WS_DBG));
#endif
    SEAM(PH_KVPOOL);
#if DBG_KNORM
    if (IN(PH_KNORM)) { const bf16_t* R = (const bf16_t*)(ws + WS_DBG); unsigned bad = 0;
        for (int row = gw; row < MT; row += NGW) {
            for (int h = 0; h < NH; ++h) { const float x = bf2f(R[(size_t)row * 1024 + h * 64 + lane]); const float ss = wave_sum(x * x); const float y = x * rsqrtf(ss * (1.f / 64.f) + EPS) * g_k_nope[lane];
                const float a = bf2f(KV[(size_t)row * 1024 + h * 64 + lane]); if (!(fabsf(a - y) <= 0.02f + 0.02f * fabsf(y))) ++bad; }
            for (int c = lane; c < 512; c += 64) { const float y = bf2f(R[(size_t)row * 1024 + 512 + c]), a = bf2f(KV[(size_t)row * 1024 + 512 + c]); if (!(fabsf(a - y) <= 1e-3f + 0.01f * fabsf(y))) ++bad; } }
        if (bad) atomicAdd((unsigned*)(ws + WS_CTL) + CW_DBG, bad); }
#endif
    if (IN(PH_ATTN)) {
        LAS float* sc = (LAS float*)(lds + wave * 16768);
#if DBG_ATTN_P
        for (int it = gw; it < MP * NH; it += NGW) attn_p_naive_item(it, lane, sc, QB, KV, KRB, (bf16_t*)(ws + WS_DBG));
        __syncthreads();
#endif
#ifndef NO_ATTN_P
        { const int vcu = (G % 8 == 0) ? (bx % 8) * (G / 8) + bx / 8 : bx;
          for (int rep_ = 0; rep_ < REPN(3); ++rep_) for (int pi = vcu; pi < 256; pi += G) { const int bh = pi >> 3, s8 = pi & 7; attn_p_unit(bh >> 3, bh & 7, 15 - s8, lds, QB, KV, KRB, MIX); attn_p_unit(bh >> 3, bh & 7, s8, lds, QB, KV, KRB, MIX); }
          asm volatile("s_waitcnt vmcnt(0)" ::: "memory"); __syncthreads(); }
#endif
#if DBG_ATTN_S
        for (int it = bx; it < (NPAGES + 1) * DB_; it += G) attn_s_scores_item(it % (NPAGES + 1), it / (NPAGES + 1), tid, cache_ckv, cache_kr, page_table, QB, CB, KRB, w_uk, g_k_nope, SC);
        __syncthreads();
#endif
        if (REP_ID >= 20 && REP_ID <= 24) for (int u = bx; u < 2 * DB_; u += G) attn_s_unit<(REP_ID >= 20 && REP_ID <= 24) ? REP_ID - 19 : 1>(u, lds, cache_ckv, cache_kr, page_table, QB, WKVT, g_k_nope, (float*)(ws + WS_DBG), (float*)(ws + WS_DBG + 40 * MiB));
        for (int rep_ = 0; rep_ < REPN(4); ++rep_) for (int u = bx; u < 2 * DB_; u += G) attn_s_unit<0>(u, lds, cache_ckv, cache_kr, page_table, QB, WKVT, g_k_nope, (float*)(ws + WS_LATP), (float*)(ws + WS_ML));
        asm volatile("s_waitcnt vmcnt(0)" ::: "memory"); __syncthreads();
    }
    SEAM(PH_ATTN);
#if DBG_ATTN_P
    if (IN(PH_ATTN2)) {
        const bf16_t* R = (const bf16_t*)(ws + WS_DBG); unsigned bad = 0;
        for (size_t i = (size_t)bx * NTHR + tid; i < (size_t)MP * 512; i += (size_t)G * NTHR) { const size_t row = i >> 9, c = 512 + (i & 511); const float a = bf2f(MIX[row * DM + c]), r = bf2f(R[row * DM + c]);
            if (!(fabsf(a - r) <= 0.01f + 0.02f * fabsf(r))) ++bad; }
        if (bad) atomicAdd((unsigned*)(ws + WS_CTL) + CW_DBG, bad);
    }
#endif
    if (IN(PH_ATTN2)) { __syncthreads();
#if DBG_ATTN_S
        for (int sb = bx; sb < DB_; sb += G) attn_s_pv_item(sb, tid, (LAS float*)lds, cache_ckv, page_table, CB, SC, w_uv, LAT, (bf16_t*)(ws + WS_DBG));
        __syncthreads();
#endif
        for (int sb = bx; sb < DB_; sb += G) attn_s_combine(sb, lds, QB, KV, KRB, WKVT, (const float*)(ws + WS_LATP), (const float*)(ws + WS_ML), MIX);
#if DBG_ATTN_S
        asm volatile("s_waitcnt vmcnt(0)" ::: "memory"); __syncthreads();
        { const bf16_t* R = (const bf16_t*)(ws + WS_DBG); unsigned bad = 0; float num_ = 0.f, den_ = 0.f;
          for (int sb = bx; sb < DB_; sb += G) for (int i = tid; i < DT * 512; i += NTHR) { const size_t row = (size_t)MP + sb * DT + (i >> 9), c = 512 + (i & 511); const float a = bf2f(MIX[row * DM + c]), r = bf2f(R[row * DM + c]);
              num_ += (a - r) * (a - r); den_ += r * r; if (!(fabsf(a - r) <= 0.02f + 0.5f * fabsf(r))) ++bad; }
          if (bad) atomicAdd((unsigned*)(ws + WS_CTL) + CW_DBG, bad);
          num_ = wave_sum(num_); den_ = wave_sum(den_); if (lane == 0) { atomicAdd((float*)(ws + WS_CTL) + CW_DBG + 2, num_); atomicAdd((float*)(ws + WS_CTL) + CW_DBG + 3, den_); } }
#endif
    }
    if (IN(PH_ATTN2) && bx >= DB_) {
        LAS float* scr = (LAS float*)(lds + wave * 16384);
        for (int it = (bx - DB_) * NWAVES + wave; it < 16 * 32; it += (G - DB_) * NWAVES) p0_transpose_item(w_out_even, DM, DM, WOUT0T, DM, nullptr, scr, it, lane);
        if (G == 256) for (int it = (bx - DB_) * NWAVES + wave; it < 16 * 128; it += (G - DB_) * NWAVES) p0_transpose_item(w_up, DFF, DFF, WUPT, DM, norm_ffn, scr, it, lane);
    }
    SEAM(PH_ATTN2);
    if (IN(PH_OUT0)) GEMM_RESID_SPLIT(MIX, DM, WOUT0T, DM);
    if (IN(PH_OUT0) && G != 256) {
        const int gw2 = bx * NWAVES + wave, NGW2 = G * NWAVES;
        LAS float* scr = (LAS float*)(lds + wave * 16384);
        constexpr int I8 = 16 * 128, I10 = 64 * 32;
        for (int it = gw2; it < I8 + I10; it += NGW2) {
            if (it < I8) p0_transpose_item(w_up, DFF, DFF, WUPT, DM, norm_ffn, scr, it, lane);
            else p0_transpose_item(w_down, DM, DM, WDNT, DFF, nullptr, scr, it - I8, lane);
        }
    }
    SEAM(PH_OUT0);
    if (IN(PH_UP0) && REP_ID == 30) GEMM_PHASE(30, XB, DM, 0, 0, WUPT, MT, DFF, DM, FNull, (float*)(ws + WS_DBG));
    if (IN(PH_UP0)) { FIXUP_DEFERRED(0, 8); GEMM_PHASE_P8_RDY(0, 5, XB, DM, WUPT, MT, DFF, DM, FUp, SSQ, H); }
    if (IN(PH_UP0)) {
        const int nidle = G - 64;
        if (G == 256 ? (bx >= 64) : true) {
            const int gw2 = (G == 256 ? (bx - 64) : bx) * NWAVES + wave, NGW2 = (G == 256 ? nidle : G) * NWAVES;
            LAS float* scr = (LAS float*)(lds + wave * 16384);
            constexpr int I3 = 2 * 4, I7 = 16 * 32, I8 = 16 * 128, I10 = 64 * 32, I12 = 16 * 64;
            constexpr int NIT2 = I8 + I10 + I12 + 16 * I3 + I7;
            if (G == 256) for (int it = gw2; it < I10; it += NGW2) p0_transpose_item(w_down, DM, DM, WDNT, DFF, nullptr, scr, it, lane);
            for (int it = gw2; it < NIT2; it += NGW2) {
                int r = it;
                if (r < I8) { p0_transpose_item(w_up + (size_t)DM * DFF, DFF, DFF, WUPT + (size_t)DFF * DM, DM, norm_ffn + DM, scr, r, lane); continue; } r -= I8;
                if (r < I10) { p0_transpose_item(w_down + (size_t)DFF * DM, DM, DM, WDNT + (size_t)DM * DFF, DFF, nullptr, scr, r, lane); continue; } r -= I10;
                if (r < I12) { p0_transpose_item(w_in_rnn, 2048, 2048, WINRT, DM, norm_mix + DM, scr, r, lane); continue; } r -= I12;
                if (r < 16 * I3) { const int q = r / I3, n = q >> 1, isx = q & 1; const float* src = (isx ? w_gate_x : w_gate_a) + (size_t)n * 128 * 128;
                    p0_transpose_item(src, 128, 128, WGATET + (size_t)(n * 256 + isx * 128) * 256 + (n & 1) * 128, 256, nullptr, scr, r % I3, lane); continue; } r -= 16 * I3;
                p0_transpose_item(w_out_rnn, DM, DM, WOUTRT, DM, nullptr, scr, r, lane);
            }
        }
    }
    SEAM(PH_UP0);
    if (IN(PH_DN0)) GEMM_DOWN(H, WDNT, false);
    SEAM(PH_DN0);
    if (IN(PH_RNNIN)) { FIXUP_DEFERRED(1, 16); GEMM_PHASE_P8_RDY(1, 7, XB, DM, WINRT, MT, 2048, DM, FRnnIn, SSQ, GATE, U); }
    SEAM(PH_RNNIN);
    if (IN(PH_CONV)) for (int rep_ = 0; rep_ < REPN(12); ++rep_) {
        for (int it = bx * NTHR + tid; it < (MP / 16) * 128; it += G * NTHR) conv_item_p16((it >> 7) * 16, (it & 127) * 8, U, conv_w, conv_b, V, out);
        for (int it = bx * NTHR + tid; it < DB_ * 128; it += G * NTHR) conv_item<false>(MP + (it >> 7) * DT, DT, (it & 127) * 8, U, state_conv, conv_w, conv_b, V, out);
    }
    SEAM(PH_CONV);
    if (IN(PH_GATES)) for (int rep_ = 0; rep_ < REPN(9); ++rep_) { pg8::Gemm g{V, WGATET, MT, 2048, 256, DM, 256, 1}; pg8::StaticOrder S; S.init(G == 256 ? MP : MT, 2048, 256, G, bx);
        EpiGates E{V, b_gate_a, b_gate_x, (const float*)(ws + WS_SP8), (bf16_t*)(ws + WS_HL), (bf16_t*)(ws + WS_AC), (float*)(ws + WS_SUM)}; pg8::gemm_phase<false>(lds, g, S, E, STREAM_CTL(8)); }
    SEAM(PH_GATES);
    if (IN(PH_SCAN)) for (int rep_ = 0; rep_ < REPN(11); ++rep_) {
        const bf16_t* HL = (const bf16_t*)(ws + WS_HL); const bf16_t* AC = (const bf16_t*)(ws + WS_AC); const float* SUM = (const float*)(ws + WS_SUM);
        for (int idx = bx * NTHR + tid; idx < 256 * 4 * 128; idx += G * NTHR) {
            const int wv_ = idx >> 6, cg = (wv_ & 7) * 16 + (idx & 15), qt = (idx >> 4) & 3, segp = wv_ >> 3, sq = segp & 63, ch = cg * 8;
            u32x4 rhl[2][8], rac[2][8], rgt[2][8];
#define SCAN_LD(bt_) do { _Pragma("unroll") for (int t = 0; t < 8; ++t) { const size_t off = (size_t)(segp * 64 + qt * 16 + (bt_) * 8 + t) * DM + ch; rhl[bt_][t] = *(const u32x4*)(HL + off); rac[bt_][t] = *(const u32x4*)(AC + off); rgt[bt_][t] = *(const u32x4*)(GATE + off); } } while (0)
            SCAN_LD(0);
            float h[8];
#pragma unroll
            for (int e = 0; e < 8; ++e) h[e] = 0.f;
            if (qt == 0)
#pragma unroll 4
            for (int k = 0; k < sq; ++k) {
                const f32x4* sp4 = (const f32x4*)(SUM + ((size_t)(segp - sq + k) * DM + ch) * 2);
                const f32x4 s0 = sp4[0], s1 = sp4[1], s2 = sp4[2], s3 = sp4[3];
                h[0] = s0.x * h[0] + s0.y; h[1] = s0.z * h[1] + s0.w; h[2] = s1.x * h[2] + s1.y; h[3] = s1.z * h[3] + s1.w;
                h[4] = s2.x * h[4] + s2.y; h[5] = s2.z * h[5] + s2.w; h[6] = s3.x * h[6] + s3.y; h[7] = s3.z * h[7] + s3.w;
            }
#pragma unroll
            for (int e = 0; e < 8; ++e) h[e] = __int_as_float(__builtin_amdgcn_ds_bpermute((idx & 15) * 4, __float_as_int(h[e])));
            SCAN_LD(1);
#undef SCAN_LD
#pragma unroll
            for (int t = 0; t < 16; ++t) {
                const size_t off = (size_t)(segp * 64 + qt * 16 + t) * DM + ch;
                const u32x4 hl = rhl[t >> 3][t & 7], ac = rac[t >> 3][t & 7], gt = rgt[t >> 3][t & 7];
                float hv[8]; u32x4 o;
#pragma unroll
                for (int e2 = 0; e2 < 4; ++e2) {
                    hv[2 * e2] = __uint_as_float(hl[e2] << 16) + __uint_as_float(ac[e2] << 16) * h[2 * e2];
                    hv[2 * e2 + 1] = __uint_as_float(hl[e2] & 0xffff0000u) + __uint_as_float(ac[e2] & 0xffff0000u) * h[2 * e2 + 1];
                    o[e2] = pk2(__uint_as_float(gt[e2] << 16) * hv[2 * e2], __uint_as_float(gt[e2] & 0xffff0000u) * hv[2 * e2 + 1]);
                }
                *(u32x4*)(YB + off) = o;
                if (sq == 63 && qt == 3 && t == 15) {
#pragma unroll
                    for (int e = 0; e < 8; ++e) out[O_LRU_P + (size_t)(segp >> 6) * DM + ch + e] = hv[e];
                }
            }
        }
        if (G == 256) { for (int item = bx; item < (DB_ / 2) * 8; item += G) gates_sample_item(item, wave, lane, V, WGATET, b_gate_a, b_gate_x, (const float*)(ws + WS_SP8), GATE, state_lru, YB, out); }
        else
        for (int idx = bx * NTHR + tid; idx < DB_ * 128; idx += G * NTHR) {
            const int cg = idx & 127, sb = idx >> 7, ch = cg * 8;
            float h[8];
#pragma unroll
            for (int e = 0; e < 8; ++e) h[e] = state_lru[(size_t)sb * DM + ch + e];
            for (int t = 0; t < DT; ++t) {
                const size_t off = (size_t)(MP + sb * DT + t) * DM + ch;
                const u32x4 hl = *(const u32x4*)(HL + off), ac = *(const u32x4*)(AC + off), gt = *(const u32x4*)(GATE + off);
                float hv[8]; u32x4 o;
#pragma unroll
                for (int e2 = 0; e2 < 4; ++e2) {
                    hv[2 * e2] = __uint_as_float(hl[e2] << 16) + __uint_as_float(ac[e2] << 16) * h[2 * e2];
                    hv[2 * e2 + 1] = __uint_as_float(hl[e2] & 0xffff0000u) + __uint_as_float(ac[e2] & 0xffff0000u) * h[2 * e2 + 1];
                    o[e2] = pk2(__uint_as_float(gt[e2] << 16) * hv[2 * e2], __uint_as_float(gt[e2] & 0xffff0000u) * hv[2 * e2 + 1]);
                }
                *(u32x4*)(YB + off) = o;
                if (t == DT - 1) {
#pragma unroll
                    for (int e = 0; e < 8; ++e) out[O_LRU_S + (size_t)sb * DM + ch + e] = hv[e];
                }
            }
        }
    }
    SEAM(PH_SCAN);
    if (IN(PH_OUTR)) GEMM_RESID_SPLIT(YB, DM, WOUTRT, DM);
    SEAM(PH_OUTR);
    if (IN(PH_UP1)) { FIXUP_DEFERRED(2, 8); GEMM_PHASE_P8_RDY(2, 10, XB, DM, WUPT + (size_t)DFF * DM, MT, DFF, DM, FUp, SSQ, H); }
    SEAM(PH_UP1);
#if DBG_ANY
    if (IN(PH_DN1)) { const float n_ = __hip_atomic_load((float*)(ws + WS_CTL) + CW_DBG + 2, __ATOMIC_RELAXED, __HIP_MEMORY_SCOPE_AGENT), d_ = __hip_atomic_load((float*)(ws + WS_CTL) + CW_DBG + 3, __ATOMIC_RELAXED, __HIP_MEMORY_SCOPE_AGENT);
        if ((__hip_atomic_load((unsigned*)(ws + WS_CTL) + CW_DBG, __ATOMIC_RELAXED, __HIP_MEMORY_SCOPE_AGENT) != 0u || n_ > DBG_RVR * d_) && bx == 0 && tid == 0) out[O_LRU_S] = __builtin_nanf(""); }
#endif
    if (IN(PH_DN1)) GEMM_DOWN(H, WDNT + (size_t)DM * DFF, true);
#undef IN
#undef SEAM
#undef GEMM_PHASE
}

#ifndef MK_ONE
#define MK_ONE 1
#endif
extern "C" void kernel_launch(void* const* d_in, const int* in_sizes, int n_in, void* d_out, int out_size, void* d_ws, size_t ws_size, hipStream_t stream) {
    (void)in_sizes; (void)out_size;
    static int grid = 0;
    if (grid == 0) {
        if (n_in != 32 || ws_size < WS_END) { fprintf(stderr, "kernel_launch: unexpected inputs / workspace\n"); grid = -1; return; }
        int dev = 0, cus = 0, per_cu = 0;
        if (hipGetDevice(&dev) != hipSuccess || hipDeviceGetAttribute(&cus, hipDeviceAttributeMultiprocessorCount, dev) != hipSuccess) { grid = -1; return; }
        if (hipFuncSetAttribute((const void*)mk, hipFuncAttributeMaxDynamicSharedMemorySize, LDS_BYTES) != hipSuccess) { fprintf(stderr, "kernel_launch: hipFuncSetAttribute failed\n"); grid = -1; return; }
        if (hipOccupancyMaxActiveBlocksPerMultiprocessor(&per_cu, (const void*)mk, NTHR, LDS_BYTES) != hipSuccess || per_cu < 1) { fprintf(stderr, "kernel_launch: occupancy query reports %d\n", per_cu); }
        (void)hipGetLastError();
        grid = cus;
    }
    if (grid < 0) return;
    unsigned char* ws = (unsigned char*)d_ws;
    (void)hipMemsetAsync(ws + WS_CTL, 0, CTL_ZERO_BYTES, stream);
    Args a{};
    for (int i = 0; i < 32; ++i) a.in[i] = d_in[i];
    a.out = (float*)d_out; a.ws = ws;
#if MK_ONE
    a.ph_lo = 0; a.ph_hi = PH_COUNT;
    hipLaunchKernelGGL(mk, dim3(grid), dim3(NTHR), LDS_BYTES, stream, a);
#else
    for (int p = 0; p < PH_COUNT; ++p) { a.ph_lo = p; a.ph_hi = p + 1; hipLaunchKernelGGL(mk, dim3(grid), dim3(NTHR), LDS_BYTES, stream, a); }
#endif
}
```

```cpp
#include <hip/hip_runtime.h>
#include <stdint.h>
#include <math.h>
#include <stdio.h>

#define DI __device__ __forceinline__
#define LAS __attribute__((address_space(3)))
typedef unsigned short bf16_t;
typedef short bf16x8 __attribute__((ext_vector_type(8)));
typedef float f32x4 __attribute__((ext_vector_type(4)));
typedef float f32x16 __attribute__((ext_vector_type(16)));
typedef unsigned u32x2 __attribute__((ext_vector_type(2)));
typedef unsigned u32x4 __attribute__((ext_vector_type(4)));

constexpr int DM = 1024, SEQ = 4096, NB = 4, MP = NB * SEQ  , DB_ = 128, DT = 8, MS = DB_ * DT  , MT = MP + MS  ;
constexpr int PAST = 8192, PAGE = 128, NPAGES = PAST / PAGE  , NKEYS = PAST + DT  ;
constexpr int POOLD = 512, QDIM = 768, KVR = 256, ROPE = 32, NH = 8, QKH = 96, NOPE = 64, VH = 64;
constexpr int NZ0 = 1792  , DFF = 4096;
constexpr float EPS = 1e-6f;
constexpr float SM_SCALE = 0.10206207261596577f;
constexpr float QSCALE = 0.10206207261596577f * 1.4426950408889634f;

constexpr size_t O_Y = 0;
constexpr size_t O_CKV_P = (size_t)MT * DM;
constexpr size_t O_KR_P = O_CKV_P + (size_t)MP * KVR;
constexpr size_t O_POOL_P = O_KR_P + (size_t)MP * ROPE;
constexpr size_t O_CONV_P = O_POOL_P + (size_t)NB * 15 * POOLD;
constexpr size_t O_LRU_P = O_CONV_P + (size_t)NB * 3 * DM;
constexpr size_t O_CKV_S = O_LRU_P + (size_t)NB * DM;
constexpr size_t O_KR_S = O_CKV_S + (size_t)MS * KVR;
constexpr size_t O_POOL_S = O_KR_S + (size_t)MS * ROPE;
constexpr size_t O_CONV_S = O_POOL_S + (size_t)DB_ * 15 * POOLD;
constexpr size_t O_LRU_S = O_CONV_S + (size_t)DB_ * 3 * DM;
constexpr size_t O_END = O_LRU_S + (size_t)DB_ * DM;
static_assert(O_END == 24393728, "output size");

constexpr size_t MiB = 1u << 20;
constexpr size_t WS_CTL = 0, CTL_ZERO_BYTES = 256 * 1024;
constexpr size_t WS_WIN0T = 1 * MiB;
constexpr size_t WS_WKVT = 5 * MiB;
constexpr size_t WS_WPOOLT = 6 * MiB;
constexpr size_t WS_WGATET = 7 * MiB;
constexpr size_t WS_WOUT0T = 8 * MiB;
constexpr size_t WS_WOUTRT = 10 * MiB;
constexpr size_t WS_WINRT = 12 * MiB;
constexpr size_t WS_WUPT = 16 * MiB;
constexpr size_t WS_WDNT = 32 * MiB;
constexpr size_t WS_SSQ = 48 * MiB;
constexpr size_t WS_SP8 = 49 * MiB + 96 * 1024;
constexpr size_t WS_ROPE = 49 * MiB + 128 * 1024;
constexpr size_t WS_XB = 50 * MiB;
constexpr size_t WS_Z0 = 84 * MiB;
constexpr size_t WS_QB = 144 * MiB;
constexpr size_t WS_CB = 170 * MiB;
constexpr size_t WS_KRB = 179 * MiB;
constexpr size_t WS_DB = 181 * MiB;
constexpr size_t WS_KV = 944 * MiB;
constexpr size_t WS_MIX = 230 * MiB;
constexpr size_t WS_H = 264 * MiB;
constexpr size_t WS_GATE = 400 * MiB;
constexpr size_t WS_U = 434 * MiB;
constexpr size_t WS_V = 468 * MiB;
constexpr size_t WS_G = 502 * MiB;
constexpr size_t WS_HL = WS_G, WS_AC = WS_G + 34 * MiB, WS_SUM = WS_G + 68 * MiB;
constexpr size_t WS_YB = 638 * MiB;
constexpr size_t WS_SC = 672 * MiB;
constexpr size_t WS_LAT = 930 * MiB;
constexpr size_t WS_ACCS = 1136 * MiB;
constexpr size_t WS_PART = 1140 * MiB;
constexpr size_t WS_END = 1140 * MiB + 2 * 256 * 262144;
constexpr int CW_BAR = 4096;
constexpr int CW_DBG = 64;
constexpr int CW_SKT = 128;
constexpr int CW_SKF = 32768;
constexpr size_t WS_DBG = 1000 * MiB;
constexpr size_t WS_LATP = 980 * MiB;
constexpr size_t WS_ML = 998 * MiB;
#ifndef DBG_ATTN_P
#define DBG_ATTN_P 0
#endif
#ifndef DBG_ATTN_S
#define DBG_ATTN_S 0
#endif
#ifndef DBG_KNORM
#define DBG_KNORM 0
#endif
#ifndef DBG_RVR
#define DBG_RVR 0.004f
#endif
#define DBG_ANY (DBG_ATTN_P || DBG_ATTN_S || DBG_KNORM)
#ifndef REP_ID
#define REP_ID 0
#endif
#define REPN(id) ((REP_ID == (id)) ? 2 : 1)

constexpr int NWAVES = 8, NTHR = NWAVES * 64;
constexpr int LDS_BYTES = 163840;
constexpr int LDS_MISC = LDS_BYTES - 1024;

DI unsigned f2bf(float f) { unsigned u = __float_as_uint(f); return (u + 0x7fffu + ((u >> 16) & 1u)) >> 16; }
DI float bf2f(bf16_t b) { return __uint_as_float(((unsigned)b) << 16); }
DI unsigned pk2(float lo, float hi) { return f2bf(lo) | (f2bf(hi) << 16); }
DI float xsum16(float x) { auto r = __builtin_amdgcn_permlane16_swap(__float_as_uint(x), __float_as_uint(x), false, false); return __uint_as_float(r[0]) + __uint_as_float(r[1]); }
DI float xsum32(float x) { auto r = __builtin_amdgcn_permlane32_swap(__float_as_uint(x), __float_as_uint(x), false, false); return __uint_as_float(r[0]) + __uint_as_float(r[1]); }
DI float xmax16(float x) { auto r = __builtin_amdgcn_permlane16_swap(__float_as_uint(x), __float_as_uint(x), false, false); return fmaxf(__uint_as_float(r[0]), __uint_as_float(r[1])); }
DI float xmax32(float x) { auto r = __builtin_amdgcn_permlane32_swap(__float_as_uint(x), __float_as_uint(x), false, false); return fmaxf(__uint_as_float(r[0]), __uint_as_float(r[1])); }
template <int CTRL> DI float dppf(float v) { return __int_as_float(__builtin_amdgcn_update_dpp(0, __float_as_int(v), CTRL, 0xF, 0xF, true)); }
DI float xchg4(float v, bool upper) { const float a = dppf<0x104>(v), b = dppf<0x114>(v); return upper ? b : a; }
DI float max8(float v) { v = fmaxf(v, dppf<0xB1>(v)); v = fmaxf(v, dppf<0x4E>(v)); v = fmaxf(v, dppf<0x141>(v)); return v; }
DI float sum8(float v) { v += dppf<0xB1>(v); v += dppf<0x4E>(v); v += dppf<0x141>(v); return v; }
DI float sum16(float v) { v = sum8(v); v += dppf<0x140>(v); return v; }
DI float wave_sum(float v) { return xsum32(xsum16(sum16(v))); }
DI float wave_max(float v) {
#pragma unroll
    for (int o = 1; o < 64; o <<= 1) v = fmaxf(v, __shfl_xor(v, o));
    return v;
}
DI float row_rinv(const float* SSQ, int row) {
    float s = 0.f;
#pragma unroll
    for (int p = 0; p < 16; ++p) s += SSQ[(size_t)p * MT + row];
    return rsqrtf(s * (1.0f / DM) + EPS);
}
DI float max3f(float a, float b, float c) { float r; asm("v_max3_f32 %0, %1, %2, %3" : "=v"(r) : "v"(a), "v"(b), "v"(c)); return r; }
DI float gelu_tanh(float x) { const float u = 0.7978845608028654f * (x + 0.044715f * x * x * x); return x * __builtin_amdgcn_rcpf(1.0f + __builtin_amdgcn_exp2f(-2.0f * 1.4426950408889634f * u)); }
DI float sigmoidf(float x) { return 1.f / (1.f + expf(-x)); }

struct UPre { float v[8]; };
namespace pg8 {
constexpr int BM = 256, BK = 64, HALF = 128, HTB = HALF * BK * 2, STAGE_BYTES = 8 * HTB, NXCD = 8, WGM = 8;
__host__ __device__ __forceinline__ int lds_byte(int r, int c) { const int st = (r >> 4) * 2 + (c >> 5), rr = r & 15, cc = c & 31, ob = rr * 64 + cc * 2; return st * 1024 + (ob ^ (((ob >> 9) & 1) << 5)); }
__host__ __device__ __forceinline__ void stage_rc(int b, int& R, int& C) { const int st = b / 1024, sb = b % 1024, swz = sb ^ (((sb >> 9) & 1) << 5); R = (st >> 1) * 16 + swz / 64; C = (st & 1) * 32 + (swz % 64) / 2; }
struct Unit { int pm, pn; };
struct Gemm { const bf16_t* A; const bf16_t* Bt; int M, N, K, lda, a_tile_off, a_shift; unsigned* ready = nullptr; unsigned ready_target = 0; };
struct Seg { int pm, pn, t0, t1; };
struct StreamOrder {
    int nM, nN, ppu, ub, lo, hi;
    DI void init(int M, int N, int K, int G, int c) {
        nM = M / BM; nN = N / BM; ppu = K / (2 * BK);
        const int nwg = nM * nN, x = c % NXCD, k = c / NXCD, nk = G / NXCD, q = nwg / NXCD, r = nwg % NXCD;
        ub = x * q + (x < r ? x : r); const int cnt = q + (x < r ? 1 : 0); const int Pr = cnt * ppu;
        lo = (k * Pr) / nk; hi = ((k + 1) * Pr) / nk;
    }
    DI bool next(int i, Seg& s) const {
        const int ul = lo / ppu + i, start = ul * ppu; if (start >= hi) return false;
        const int p0 = (lo > start ? lo : start) - start, p1 = ((hi < start + ppu) ? hi : start + ppu) - start;
        s.t0 = 2 * p0; s.t1 = 2 * p1;
        const int wgid = ub + ul, nig = WGM * nN, gid = wgid / nig, fm = gid * WGM, gsz = (nM - fm) < WGM ? (nM - fm) : WGM;
        s.pm = fm + ((wgid % nig) % gsz); s.pn = (wgid % nig) / gsz; return true;
    }
};
struct SplitTailOrder {
    int nt, c, ways, plen;
    DI void init(int K, int c_) { nt = K / BK; c = c_; ways = 16; plen = nt / 16; if (plen < 2) { plen = 2; ways = nt / 2; } }
    DI bool next(int i, Seg& u) const {
        if (i == 0) { u.t0 = 0; u.t1 = nt; const int xcd = c % NXCD, off = c / NXCD, wgid = xcd * 32 + off; u.pm = (wgid >> 5) * 8 + (wgid & 7); u.pn = (wgid >> 3) & 3; return true; }
        if (i == 1) { const int us = c >> 4, part = c & 15; if (part >= ways) return false; u.pm = 64 + (us >> 2); u.pn = us & 3; u.t0 = part * plen; u.t1 = u.t0 + plen; return true; }
        return false;
    }
};
struct StaticOrder {
    int nM, nN, nwg, G, c, nt;
    DI void init(int M, int N, int K, int G_, int c_) { nM = M / BM; nN = N / BM; nwg = nM * nN; G = G_; c = c_; nt = K / BK; }
    DI bool next(int i, Seg& u) const {
        u.t0 = 0; u.t1 = nt;
        const long L = (long)i * G + c; if (L >= nwg) return false;
        int wgid = (int)L; { const int q = nwg / NXCD, r = nwg % NXCD, xcd = wgid % NXCD, off = wgid / NXCD; wgid = (xcd < r ? xcd * (q + 1) : r * (q + 1) + (xcd - r) * q) + off; }
        const int nig = WGM * nN, gid = wgid / nig, fm = gid * WGM, gsz = (nM - fm) < WGM ? (nM - fm) : WGM;
        u.pm = fm + ((wgid % nig) % gsz); u.pn = (wgid % nig) / gsz; return true;
    }
};
struct NoPre {};
__host__ __device__ __forceinline__ int perm32(int rho) { const int n = rho >> 4, i = rho & 15; return 8 * (i >> 2) + 4 * n + (i & 3); }
template <class F, bool P64 = false, bool P8 = false> struct EpiRows {
    F f;
    static constexpr bool PERM64 = P64;
    static constexpr bool PERM8 = P8;
    DI UPre unit_pre(int pm) const { return f.unit_pre(pm * BM); }
    DI void operator()(const f32x4 (&acc)[2][2][4][2], const Unit& u, int wr, int wc, int fr, int fq, const UPre& upre) const {
        constexpr int BJS = P64 ? 32 : HALF;
        const int row0 = u.pm * BM + wr * 64 + fr, col0 = u.pn * BM + wc * (P64 ? 64 : 32) + (P8 ? 8 : 4) * fq;
        f.unit_begin(u.pm * BM, upre);
#pragma unroll
        for (int ai = 0; ai < 2; ++ai) {
            typename F::RowPre rp[4]; typename F::Pre pr[4][2][2]; typename F::Pre8 pr8[4][2];
#pragma unroll
            for (int m = 0; m < 4; ++m) rp[m] = f.row_pre(row0 + ai * HALF + m * 16);
#pragma unroll
            for (int m = 0; m < 4; ++m)
#pragma unroll
                for (int bj = 0; bj < 2; ++bj)
#pragma unroll
                    for (int n = 0; n < 2; ++n) { if constexpr (P8) { if (n == 0) pr8[m][bj] = f.pre8(row0 + ai * HALF + m * 16, col0 + bj * BJS); } else pr[m][bj][n] = f.pre(row0 + ai * HALF + m * 16, col0 + bj * BJS + n * 16); }
#pragma unroll
            for (int m = 0; m < 4; ++m) {
                const int row = row0 + ai * HALF + m * 16;
                typename F::Ctx ctx = f.row_begin(row, rp[m]);
                if constexpr (P8) {
#pragma unroll
                    for (int bj = 0; bj < 2; ++bj) f.op8(ctx, row, col0 + bj * BJS, acc[ai][bj][m][0], acc[ai][bj][m][1], pr8[m][bj]);
                } else {
#pragma unroll
                    for (int bj = 0; bj < 2; ++bj)
#pragma unroll
                        for (int n = 0; n < 2; ++n) f(ctx, row, col0 + bj * BJS + n * 16, acc[ai][bj][m][n], pr[m][bj][n]);
                }
                f.row_end(ctx, row, u.pn, wc, fq);
            }
        }
    }
};

struct StreamCtl { float* part; unsigned* flags; unsigned* tmo; unsigned epoch; int c; int pad; };
struct NoPart { DI void operator()(const f32x4 (&)[2][2][4][2], const Unit&, int, int, int, int) const {} };
template <bool STREAM, class Sched, class Epi, class EpiPart = NoPart>
DI void gemm_phase(LAS unsigned char* lds, const Gemm g, const Sched& S, const Epi& E, const StreamCtl sc, const EpiPart EP = EpiPart()) {
    const int tid = threadIdx.x, wid = __builtin_amdgcn_readfirstlane(tid >> 6), lane = tid & 63, wr = wid >> 2, wc = wid & 3, fr = lane & 15, fq = lane >> 4;
    const int K = g.K, nt = K / BK;
    unsigned voffA[2], voffB[2];
#pragma unroll
    for (int i = 0; i < 2; ++i) { int R, C; stage_rc(tid * 16 + i * 8192, R, C); const int r31 = Epi::PERM8 ? perm32(R & 31) : (R & 31); const int Rb = Epi::PERM64 ? (64 * (R >> 5) + r31) : ((R & ~31) + r31); voffA[i] = (unsigned)(R * g.lda + C) * 2u; voffB[i] = (unsigned)(Rb * K + C) * 2u; }
    const size_t kstep = (size_t)(BK * 2);
    const size_t hstepA = (size_t)HALF * g.lda * 2, hstepB = (size_t)(Epi::PERM64 ? 32 : HALF) * K * 2;
    const size_t tstepA = 2 * hstepA, tstepB = (size_t)BM * K * 2, pstepA = (size_t)g.a_tile_off * 2;
    const unsigned ldsw = (unsigned)wid * 1024u;
    const int aoff = lds_byte(wr * 64 + fr, fq * 8), boff = lds_byte(wc * 32 + fr, fq * 8);
#define PG8_SA(b, h) (((b) * 2 + (h)) * HTB)
#define PG8_SB(b, h) ((4 + (b) * 2 + (h)) * HTB)
#define PG8_STAGE(bufoff, gbase, voff) do { _Pragma("unroll") for (int _i = 0; _i < 2; ++_i) \
        __builtin_amdgcn_global_load_lds((const unsigned*)((const char*)(gbase) + (voff)[_i]), (LAS unsigned*)(lds + (bufoff) + ldsw + _i * 8192), 16, 0, 0); } while (0)
#define PG8_LDA(dst, b, h) do { _Pragma("unroll") for (int m = 0; m < 4; ++m) _Pragma("unroll") for (int k = 0; k < 2; ++k) dst[m][k] = *(const LAS bf16x8*)(lds + PG8_SA(b, h) + aoff + m * 2048 + k * 1024); } while (0)
#define PG8_LDB(dst, b, h) do { _Pragma("unroll") for (int n = 0; n < 2; ++n) _Pragma("unroll") for (int k = 0; k < 2; ++k) dst[n][k] = *(const LAS bf16x8*)(lds + PG8_SB(b, h) + boff + n * 2048 + k * 1024); } while (0)
#define PG8_MMA(ai, bj, At, Bt) do { __builtin_amdgcn_s_setprio(1); _Pragma("unroll") for (int m = 0; m < 4; ++m) _Pragma("unroll") for (int n = 0; n < 2; ++n) _Pragma("unroll") for (int k = 0; k < 2; ++k) \
        acc[ai][bj][m][n] = __builtin_amdgcn_mfma_f32_16x16x32_bf16(Bt[n][k], At[m][k], acc[ai][bj][m][n], 0, 0, 0); __builtin_amdgcn_s_setprio(0); } while (0)
#define PG8_WAIT_V(n) asm volatile("s_waitcnt vmcnt(" #n ")" ::: "memory")
#define PG8_WAIT_L(n) asm volatile("s_waitcnt lgkmcnt(" #n ")" ::: "memory")
#define PG8_BAR __builtin_amdgcn_s_barrier()
#define PG8_SCHED __builtin_amdgcn_sched_barrier(0)
    Seg cur = {0, 0, 0, 0}, nxt = {0, 0, 0, 0}; int ui = 0;
    if (!S.next(0, cur)) return;
    bool waited = g.ready == nullptr;
#define PG8_READY_WAIT() do { if (wid == 0) { unsigned sp_ = 0; \
            while (__hip_atomic_load(g.ready, __ATOMIC_RELAXED, __HIP_MEMORY_SCOPE_AGENT) < g.ready_target) { __builtin_amdgcn_s_sleep(2); if (++sp_ > (1u << 22)) break; } \
            __builtin_amdgcn_fence(__ATOMIC_ACQUIRE, "agent"); asm volatile("s_waitcnt vmcnt(0)" ::: "memory"); } \
        PG8_BAR; asm volatile("" ::: "memory"); waited = true; } while (0)
#define PG8_BAR __builtin_amdgcn_s_barrier()
    if (!waited && cur.pm >= MP / 256) PG8_READY_WAIT();
    f32x4 acc[2][2][4][2];
#pragma unroll
    for (int a = 0; a < 2; ++a)
#pragma unroll
        for (int b = 0; b < 2; ++b)
#pragma unroll
            for (int m = 0; m < 4; ++m)
#pragma unroll
                for (int n = 0; n < 2; ++n) acc[a][b][m][n] = (f32x4){0.f, 0.f, 0.f, 0.f};
    bf16x8 At[4][2], B0[2][2], B1[2][2];
    const char* cA = (const char*)g.A + (size_t)cur.pm * tstepA + (size_t)(cur.pn >> g.a_shift) * pstepA + (size_t)cur.t0 * kstep;
    const char* cB = (const char*)g.Bt + (size_t)cur.pn * tstepB + (size_t)cur.t0 * kstep;
    PG8_STAGE(PG8_SB(0, 0), cB, voffB); PG8_STAGE(PG8_SB(0, 1), cB + hstepB, voffB); PG8_STAGE(PG8_SA(0, 0), cA, voffA); PG8_STAGE(PG8_SA(0, 1), cA + hstepA, voffA);
    if (wr == 1) PG8_BAR;
    PG8_WAIT_V(2); PG8_BAR;
    PG8_STAGE(PG8_SB(1, 0), cB + kstep, voffB); PG8_STAGE(PG8_SA(1, 0), cA + kstep, voffA); PG8_STAGE(PG8_SB(1, 1), cB + hstepB + kstep, voffB);
    PG8_WAIT_V(6); PG8_BAR;
    for (;;) {
        const bool has_next = S.next(ui + 1, nxt);
        if (!waited && has_next && nxt.pm >= MP / 256) PG8_READY_WAIT();
        const char* nA = has_next ? (const char*)g.A + (size_t)nxt.pm * tstepA + (size_t)(nxt.pn >> g.a_shift) * pstepA + (size_t)nxt.t0 * kstep : cA;
        const char* nB = has_next ? (const char*)g.Bt + (size_t)nxt.pn * tstepB + (size_t)nxt.t0 * kstep : cB;
        const int nseg = cur.t1 - cur.t0;
        UPre upre{}; if (STREAM || nseg == nt) upre = E.unit_pre(cur.pm);
#pragma unroll 1
        for (int t = 0; t < nseg; t += 2) {
            const bool last = (t == nseg - 2);
            const char* a1 = cA + (size_t)(t + 1) * kstep;
            const char* a2 = last ? nA : cA + (size_t)(t + 2) * kstep; const char* b2 = last ? nB : cB + (size_t)(t + 2) * kstep;
            const char* a3 = a2 + kstep; const char* b3 = b2 + kstep;
            PG8_LDB(B0, 0, 0); PG8_LDB(B1, 0, 1); PG8_SCHED; PG8_LDA(At, 0, 0); PG8_STAGE(PG8_SA(1, 1), a1 + hstepA, voffA);
            PG8_WAIT_V(8); PG8_WAIT_L(0); PG8_BAR; PG8_MMA(0, 0, At, B0); PG8_MMA(0, 1, At, B1); PG8_BAR; PG8_SCHED;
            PG8_LDA(At, 0, 1); PG8_STAGE(PG8_SB(0, 0), b2, voffB); PG8_STAGE(PG8_SB(0, 1), b2 + hstepB, voffB); PG8_STAGE(PG8_SA(0, 0), a2, voffA);
            PG8_WAIT_V(8); PG8_WAIT_L(0); PG8_BAR; PG8_MMA(1, 0, At, B0); PG8_MMA(1, 1, At, B1); PG8_BAR; PG8_SCHED;
            PG8_LDB(B0, 1, 0); PG8_LDB(B1, 1, 1); PG8_SCHED; PG8_LDA(At, 1, 0); PG8_STAGE(PG8_SA(0, 1), a2 + hstepA, voffA);
            PG8_WAIT_V(8); PG8_WAIT_L(0); PG8_BAR; PG8_MMA(0, 0, At, B0); PG8_MMA(0, 1, At, B1); PG8_BAR; PG8_SCHED;
            PG8_LDA(At, 1, 1); PG8_STAGE(PG8_SB(1, 0), b3, voffB); PG8_STAGE(PG8_SB(1, 1), b3 + hstepB, voffB); PG8_STAGE(PG8_SA(1, 0), a3, voffA);
            PG8_WAIT_V(8); PG8_WAIT_L(0); PG8_BAR; PG8_MMA(1, 0, At, B0); PG8_MMA(1, 1, At, B1); PG8_BAR; PG8_SCHED;
        }
        if (wr == 0) PG8_BAR;
        if (STREAM && cur.t0 > 0) {
            const __amdgpu_buffer_rsrc_t prs = __builtin_amdgcn_make_buffer_rsrc((void*)(sc.part + ((size_t)(sc.epoch & 1u) * gridDim.x + sc.c) * 65536), (short)0, 262144, 0x00020000);
#pragma unroll
            for (int a = 0; a < 2; ++a)
#pragma unroll
                for (int b = 0; b < 2; ++b)
#pragma unroll
                    for (int m = 0; m < 4; ++m)
#pragma unroll
                        for (int n = 0; n < 2; ++n) { const int j = ((a * 2 + b) * 4 + m) * 2 + n; const f32x4 v = acc[a][b][m][n];
                            __builtin_amdgcn_raw_buffer_store_b128(__builtin_bit_cast(u32x4, v), prs, (unsigned)tid * 16u, j * 8192, 16); }
            asm volatile("s_waitcnt vmcnt(0)" ::: "memory");
            PG8_BAR;
            if (tid == 0) __hip_atomic_store(sc.flags + (size_t)sc.c * 64, sc.epoch, __ATOMIC_RELAXED, __HIP_MEMORY_SCOPE_AGENT);
        } else {
            Unit uu; uu.pm = cur.pm; uu.pn = cur.pn;
            if (!STREAM && (cur.t1 - cur.t0) != nt) EP(acc, uu, wr, wc, fr, fq); else E(acc, uu, wr, wc, fr, fq, upre);
        }
        if (!has_next) break;
        if (STREAM && nxt.t1 < nt) {
            const int pc = sc.c + NXCD;
            if (wid == 0) {
                unsigned* fl = sc.flags + (size_t)pc * 64; unsigned sp = 0; bool ok = true;
                while (__hip_atomic_load(fl, __ATOMIC_RELAXED, __HIP_MEMORY_SCOPE_AGENT) != sc.epoch) {
                    __builtin_amdgcn_s_sleep(1);
                    if ((++sp & 255u) == 0u) { if (__hip_atomic_load(sc.tmo, __ATOMIC_RELAXED, __HIP_MEMORY_SCOPE_AGENT) != 0u || sp > (1u << 20)) { ok = false; break; } }
                }
                if (!ok && lane == 0) __hip_atomic_store(sc.tmo, 1u, __ATOMIC_RELAXED, __HIP_MEMORY_SCOPE_AGENT);
                __builtin_amdgcn_fence(__ATOMIC_ACQUIRE, "agent");
                asm volatile("s_waitcnt vmcnt(0)" ::: "memory");
            }
            PG8_BAR; asm volatile("" ::: "memory");
            const __amdgpu_buffer_rsrc_t crs = __builtin_amdgcn_make_buffer_rsrc((void*)(sc.part + ((size_t)(sc.epoch & 1u) * gridDim.x + pc) * 65536), (short)0, 262144, 0x00020000);
#pragma unroll
            for (int a = 0; a < 2; ++a)
#pragma unroll
                for (int b = 0; b < 2; ++b)
#pragma unroll
                    for (int m = 0; m < 4; ++m)
#pragma unroll
                        for (int n = 0; n < 2; ++n) acc[a][b][m][n] = __builtin_bit_cast(f32x4, __builtin_amdgcn_raw_buffer_load_b128(crs, (unsigned)tid * 16u, ((((a * 2 + b) * 4 + m) * 2 + n) * 8192), 0));
        } else {
#pragma unroll
            for (int a = 0; a < 2; ++a)
#pragma unroll
                for (int b = 0; b < 2; ++b)
#pragma unroll
                    for (int m = 0; m < 4; ++m)
#pragma unroll
                        for (int n = 0; n < 2; ++n) acc[a][b][m][n] = (f32x4){0.f, 0.f, 0.f, 0.f};
        }
        cur = nxt; cA = nA; cB = nB; ++ui;
        if (wr == 1) PG8_BAR;
    }
    PG8_WAIT_V(0);
    PG8_BAR;
#undef PG8_SA
#undef PG8_SB
#undef PG8_STAGE
#undef PG8_LDA
#undef PG8_LDB
#undef PG8_MMA
#undef PG8_WAIT_V
#undef PG8_WAIT_L
#undef PG8_BAR
#undef PG8_SCHED
}
}

constexpr int LDS_RINV = 131072;
DI UPre rinv_partial_load(const float* SSQ, int rowbase) {
    const int tid = threadIdx.x, r = tid >> 1, hf = tid & 1;
    UPre u;
#pragma unroll
    for (int p = 0; p < 8; ++p) u.v[p] = SSQ[(size_t)(hf * 8 + p) * MT + rowbase + r];
    return u;
}
DI void rinv_table_fill(const UPre& u) {
    extern __shared__ __attribute__((aligned(16))) unsigned char lds_raw_[];
    LAS float* tab = (LAS float*)((LAS unsigned char*)lds_raw_ + LDS_RINV);
    const int tid = threadIdx.x, r = tid >> 1, hf = tid & 1;
    float sv = ((u.v[0] + u.v[1]) + (u.v[2] + u.v[3])) + ((u.v[4] + u.v[5]) + (u.v[6] + u.v[7]));
    sv += dppf<0xB1>(sv);
    if (hf == 0) tab[r] = rsqrtf(sv * (1.0f / DM) + EPS);
    asm volatile("s_waitcnt lgkmcnt(0)" ::: "memory"); __builtin_amdgcn_s_barrier(); asm volatile("" ::: "memory");
}
DI float rinv_table_get(int row) {
    extern __shared__ __attribute__((aligned(16))) unsigned char lds_raw_[];
    return ((const LAS float*)((LAS unsigned char*)lds_raw_ + LDS_RINV))[row & 255];
}
struct FZ0 { typedef float Ctx; typedef float RowPre; typedef pg8::NoPre Pre; typedef pg8::NoPre Pre8; const float* SSQ; bf16_t* Z;
    DI UPre unit_pre(int rowbase) const { return rinv_partial_load(SSQ, rowbase); }
    DI void unit_begin(int, const UPre& sv) const { rinv_table_fill(sv); }
    DI RowPre row_pre(int row) const { return rinv_table_get(row); }
    DI Pre pre(int, int) const { return Pre{}; }
    DI pg8::NoPre pre8(int, int) const { return pg8::NoPre{}; }
    DI Ctx row_begin(int, const RowPre& rp) const { return rp; }
    DI void operator()(Ctx& ri, int row, int col, f32x4 v, const Pre&) const { u32x2 o; o.x = pk2(v.x * ri, v.y * ri); o.y = pk2(v.z * ri, v.w * ri); *(u32x2*)(Z + (size_t)row * NZ0 + col) = o; }
    DI void op8(Ctx& ri, int row, int col, f32x4 a, f32x4 b, const pg8::NoPre&) const { u32x4 o; o.x = pk2(a.x * ri, a.y * ri); o.y = pk2(a.z * ri, a.w * ri); o.z = pk2(b.x * ri, b.y * ri); o.w = pk2(b.z * ri, b.w * ri); *(u32x4*)(Z + (size_t)row * NZ0 + col) = o; }
    DI void row_end(Ctx&, int, int, int, int) const {} };
template <int LDO> struct FRawBf16 { typedef int Ctx; typedef pg8::NoPre RowPre; typedef pg8::NoPre Pre; typedef pg8::NoPre Pre8; bf16_t* O;
    DI UPre unit_pre(int) const { return UPre{}; }
    DI void unit_begin(int, const UPre&) const {}
    DI RowPre row_pre(int) const { return RowPre{}; }
    DI Pre pre(int, int) const { return Pre{}; }
    DI pg8::NoPre pre8(int, int) const { return pg8::NoPre{}; }
    DI Ctx row_begin(int, const RowPre&) const { return 0; }
    DI void operator()(Ctx&, int row, int col, f32x4 v, const Pre&) const { u32x2 o; o.x = pk2(v.x, v.y); o.y = pk2(v.z, v.w); *(u32x2*)(O + (size_t)row * LDO + col) = o; }
    DI void row_end(Ctx&, int, int, int, int) const {} };
struct KvCtx { f32x4 v[4]; int col0; int k; };
struct FKvNorm { typedef KvCtx Ctx; typedef pg8::NoPre RowPre; typedef pg8::NoPre Pre; typedef pg8::NoPre Pre8; bf16_t* O; const float* g;
    DI UPre unit_pre(int) const { return UPre{}; }
    DI void unit_begin(int, const UPre&) const {}
    DI RowPre row_pre(int) const { return RowPre{}; }
    DI Pre pre(int, int) const { return Pre{}; }
    DI pg8::NoPre pre8(int, int) const { return pg8::NoPre{}; }
    DI Ctx row_begin(int, const RowPre&) const { Ctx c; c.k = 0; c.col0 = 0; return c; }
    DI void operator()(Ctx&, int, int, f32x4, const Pre&) const {}
    DI void op8(Ctx& c, int, int col, f32x4 a, f32x4 b, const pg8::NoPre&) const { if (c.k == 0) c.col0 = col; c.v[c.k] = a; c.v[c.k + 1] = b; c.k += 2; }
    DI void row_end(Ctx& c, int row, int pn, int, int) const {
        float ri = 1.0f;
        if (pn < 2) { float ss = 0.f;
#pragma unroll
            for (int k = 0; k < 4; ++k) ss += c.v[k].x * c.v[k].x + c.v[k].y * c.v[k].y + c.v[k].z * c.v[k].z + c.v[k].w * c.v[k].w;
            ss = xsum32(xsum16(ss)); ri = rsqrtf(ss * (1.f / 64.f) + EPS); }
#pragma unroll
        for (int bj = 0; bj < 2; ++bj) { const int col = c.col0 + bj * 32; f32x4 y0 = c.v[2 * bj] * ri, y1 = c.v[2 * bj + 1] * ri;
            if (pn < 2) { y0 = y0 * *(const f32x4*)(g + (col & 63)); y1 = y1 * *(const f32x4*)(g + (col & 63) + 4); }
            u32x4 o; o.x = pk2(y0.x, y0.y); o.y = pk2(y0.z, y0.w); o.z = pk2(y1.x, y1.y); o.w = pk2(y1.z, y1.w); *(u32x4*)(O + (size_t)row * 1024 + col) = o; }
    } };
struct FPool { typedef int Ctx; typedef pg8::NoPre RowPre; typedef f32x4 Pre; typedef pg8::NoPre Pre8; const float* scale; bf16_t* MIX;
    DI pg8::NoPre pre8(int, int) const { return pg8::NoPre{}; }
    DI void op8(Ctx&, int row, int col, f32x4 a, f32x4 b, const pg8::NoPre&) const { const f32x4 s0 = *(const f32x4*)(scale + col), s1 = *(const f32x4*)(scale + col + 4);
        u32x4 o; o.x = pk2(a.x * s0.x, a.y * s0.y); o.y = pk2(a.z * s0.z, a.w * s0.w); o.z = pk2(b.x * s1.x, b.y * s1.y); o.w = pk2(b.z * s1.z, b.w * s1.w); *(u32x4*)(MIX + (size_t)row * DM + col) = o; }
    DI UPre unit_pre(int) const { return UPre{}; }
    DI void unit_begin(int, const UPre&) const {}
    DI RowPre row_pre(int) const { return RowPre{}; }
    DI Pre pre(int, int col) const { return *(const f32x4*)(scale + col); }
    DI Ctx row_begin(int, const RowPre&) const { return 0; }
    DI void operator()(Ctx&, int row, int col, f32x4 v, const Pre& s) const { u32x2 o; o.x = pk2(v.x * s.x, v.y * s.y); o.y = pk2(v.z * s.z, v.w * s.w); *(u32x2*)(MIX + (size_t)row * DM + col) = o; }
    DI void row_end(Ctx&, int, int, int, int) const {} };
template <bool FINAL> struct FResid { typedef float Ctx; typedef pg8::NoPre RowPre; typedef u32x2 Pre; typedef u32x4 Pre8; bf16_t* RB; float* Yf; float* SSQ;
    DI Pre8 pre8(int row, int col) const { return *(const u32x4*)(RB + (size_t)row * DM + col); }
    DI void op8(Ctx& ss, int row, int col, f32x4 a, f32x4 b, const Pre8& r) const {
        f32x4 y0, y1; y0.x = __uint_as_float(r.x << 16) + a.x; y0.y = __uint_as_float(r.x & 0xffff0000u) + a.y; y0.z = __uint_as_float(r.y << 16) + a.z; y0.w = __uint_as_float(r.y & 0xffff0000u) + a.w;
        y1.x = __uint_as_float(r.z << 16) + b.x; y1.y = __uint_as_float(r.z & 0xffff0000u) + b.y; y1.z = __uint_as_float(r.w << 16) + b.z; y1.w = __uint_as_float(r.w & 0xffff0000u) + b.w;
        if (FINAL) { *(f32x4*)(Yf + (size_t)row * DM + col) = y0; *(f32x4*)(Yf + (size_t)row * DM + col + 4) = y1; }
        else { u32x4 o; o.x = pk2(y0.x, y0.y); o.y = pk2(y0.z, y0.w); o.z = pk2(y1.x, y1.y); o.w = pk2(y1.z, y1.w); *(u32x4*)(RB + (size_t)row * DM + col) = o;
            ss += y0.x * y0.x + y0.y * y0.y + y0.z * y0.z + y0.w * y0.w + y1.x * y1.x + y1.y * y1.y + y1.z * y1.z + y1.w * y1.w; } }
    DI UPre unit_pre(int) const { return UPre{}; }
    DI void unit_begin(int, const UPre&) const {}
    DI RowPre row_pre(int) const { return RowPre{}; }
    DI Pre pre(int row, int col) const { return *(const u32x2*)(RB + (size_t)row * DM + col); }
    DI Ctx row_begin(int, const RowPre&) const { return 0.f; }
    DI void operator()(Ctx& ss, int row, int col, f32x4 v, const Pre& r) const {
        f32x4 y; y.x = __uint_as_float(r.x << 16) + v.x; y.y = __uint_as_float(r.x & 0xffff0000u) + v.y; y.z = __uint_as_float(r.y << 16) + v.z; y.w = __uint_as_float(r.y & 0xffff0000u) + v.w;
        if (FINAL) { *(f32x4*)(Yf + (size_t)row * DM + col) = y; }
        else { u32x2 o; o.x = pk2(y.x, y.y); o.y = pk2(y.z, y.w); *(u32x2*)(RB + (size_t)row * DM + col) = o; ss += y.x * y.x + y.y * y.y + y.z * y.z + y.w * y.w; } }
    DI void row_end(Ctx& ss, int row, int pn, int wc, int fq) const { if (!FINAL) { const float s = xsum32(xsum16(ss)); if (fq == 0) SSQ[(size_t)(pn * 4 + wc) * MT + row] = s; } } };
struct FNull { typedef int Ctx; typedef pg8::NoPre RowPre; typedef pg8::NoPre Pre; typedef pg8::NoPre Pre8; float* sink;
    DI UPre unit_pre(int) const { return UPre{}; }
    DI void unit_begin(int, const UPre&) const {}
    DI RowPre row_pre(int) const { return RowPre{}; }
    DI Pre pre(int, int) const { return Pre{}; }
    DI pg8::NoPre pre8(int, int) const { return pg8::NoPre{}; }
    DI Ctx row_begin(int, const RowPre&) const { return 0; }
    DI void operator()(Ctx&, int row, int col, f32x4 v, const Pre&) const { if (v.x == 1.2345e30f) sink[row + col] = v.y; }
    DI void row_end(Ctx&, int, int, int, int) const {} };
struct FUp { typedef float Ctx; typedef float RowPre; typedef pg8::NoPre Pre; typedef pg8::NoPre Pre8; const float* SSQ; bf16_t* H;
    DI UPre unit_pre(int rowbase) const { return rinv_partial_load(SSQ, rowbase); }
    DI void unit_begin(int, const UPre& sv) const { rinv_table_fill(sv); }
    DI RowPre row_pre(int row) const { return rinv_table_get(row); }
    DI Pre pre(int, int) const { return Pre{}; }
    DI pg8::NoPre pre8(int, int) const { return pg8::NoPre{}; }
    DI Ctx row_begin(int, const RowPre& rp) const { return rp; }
    DI void operator()(Ctx& ri, int row, int col, f32x4 v, const Pre&) const { f32x4 t = v * ri; t.x = fmaxf(t.x, 0.f); t.y = fmaxf(t.y, 0.f); t.z = fmaxf(t.z, 0.f); t.w = fmaxf(t.w, 0.f);
        u32x2 o; o.x = pk2(t.x * t.x, t.y * t.y); o.y = pk2(t.z * t.z, t.w * t.w); *(u32x2*)(H + (size_t)row * DFF + col) = o; }
    DI void op8(Ctx& ri, int row, int col, f32x4 a, f32x4 b, const pg8::NoPre&) const { f32x4 t = a * ri, w = b * ri;
        t.x = fmaxf(t.x, 0.f); t.y = fmaxf(t.y, 0.f); t.z = fmaxf(t.z, 0.f); t.w = fmaxf(t.w, 0.f); w.x = fmaxf(w.x, 0.f); w.y = fmaxf(w.y, 0.f); w.z = fmaxf(w.z, 0.f); w.w = fmaxf(w.w, 0.f);
        u32x4 o; o.x = pk2(t.x * t.x, t.y * t.y); o.y = pk2(t.z * t.z, t.w * t.w); o.z = pk2(w.x * w.x, w.y * w.y); o.w = pk2(w.z * w.z, w.w * w.w); *(u32x4*)(H + (size_t)row * DFF + col) = o; }
    DI void row_end(Ctx&, int, int, int, int) const {} };
struct FRnnIn { typedef float Ctx; typedef float RowPre; typedef pg8::NoPre Pre; typedef pg8::NoPre Pre8; const float* SSQ; bf16_t* GATE; bf16_t* U;
    DI UPre unit_pre(int rowbase) const { return rinv_partial_load(SSQ, rowbase); }
    DI void unit_begin(int, const UPre& sv) const { rinv_table_fill(sv); }
    DI RowPre row_pre(int row) const { return rinv_table_get(row); }
    DI Pre pre(int, int) const { return Pre{}; }
    DI pg8::NoPre pre8(int, int) const { return pg8::NoPre{}; }
    DI Ctx row_begin(int, const RowPre& rp) const { return rp; }
    DI void operator()(Ctx& ri, int row, int col, f32x4 v, const Pre&) const { f32x4 t = v * ri; u32x2 o;
        if (col < DM) { o.x = pk2(gelu_tanh(t.x), gelu_tanh(t.y)); o.y = pk2(gelu_tanh(t.z), gelu_tanh(t.w)); *(u32x2*)(GATE + (size_t)row * DM + col) = o; }
        else { o.x = pk2(t.x, t.y); o.y = pk2(t.z, t.w); *(u32x2*)(U + (size_t)row * DM + col - DM) = o; } }
    DI void op8(Ctx& ri, int row, int col, f32x4 a, f32x4 b, const pg8::NoPre&) const { const f32x4 t = a * ri, w = b * ri; u32x4 o;
        if (col < DM) { o.x = pk2(gelu_tanh(t.x), gelu_tanh(t.y)); o.y = pk2(gelu_tanh(t.z), gelu_tanh(t.w)); o.z = pk2(gelu_tanh(w.x), gelu_tanh(w.y)); o.w = pk2(gelu_tanh(w.z), gelu_tanh(w.w)); *(u32x4*)(GATE + (size_t)row * DM + col) = o; }
        else { o.x = pk2(t.x, t.y); o.y = pk2(t.z, t.w); o.z = pk2(w.x, w.y); o.w = pk2(w.z, w.w); *(u32x4*)(U + (size_t)row * DM + col - DM) = o; } }
    DI void row_end(Ctx&, int, int, int, int) const {} };

typedef float f32x2_t __attribute__((ext_vector_type(2))); typedef __bf16 bf16x2_t __attribute__((ext_vector_type(2)));
DI unsigned cvtpk(float lo, float hi) { f32x2_t v = {lo, hi}; bf16x2_t b = __builtin_convertvector(v, bf16x2_t); return __builtin_bit_cast(unsigned, b); }
struct EpiPartStore { float* PARTS; int part;
    DI void operator()(const f32x4 (&acc)[2][2][4][2], const pg8::Unit& u, int, int, int, int) const {
        const int us = (u.pm - MP / 256) * 4 + u.pn;
        f32x4* p = (f32x4*)(PARTS + (size_t)(us * 16 + part) * 65536) + threadIdx.x;
#pragma unroll
        for (int a = 0; a < 2; ++a)
#pragma unroll
            for (int b = 0; b < 2; ++b)
#pragma unroll
                for (int m = 0; m < 4; ++m)
#pragma unroll
                    for (int n = 0; n < 2; ++n) p[(((a * 2 + b) * 4 + m) * 2 + n) * 512] = acc[a][b][m][n];
    }
};
template <bool FINAL, int WAYS = 16> DI void sample_fixup(int b, const float* __restrict__ PARTS, bf16_t* __restrict__ RB, float* __restrict__ Yf, float* __restrict__ SSQ) {
    if (b >= 128) return;
    const int tid = threadIdx.x, wid = tid >> 6, lane = tid & 63, wr = wid >> 2, wc = wid & 3, fr = lane & 15, fq = lane >> 4;
    const int us = b >> 3, ai = (b >> 2) & 1, m = b & 3, pm = MP / 256 + (us >> 2), pn = us & 3;
    f32x4 v[2][2];
#pragma unroll
    for (int bj = 0; bj < 2; ++bj)
#pragma unroll
        for (int n = 0; n < 2; ++n) v[bj][n] = (f32x4){0.f, 0.f, 0.f, 0.f};
#pragma unroll 4
    for (int p = 0; p < WAYS; ++p) {
        const f32x4* pp = (const f32x4*)(PARTS + (size_t)(us * 16 + p) * 65536) + tid;
#pragma unroll
        for (int bj = 0; bj < 2; ++bj)
#pragma unroll
            for (int n = 0; n < 2; ++n) v[bj][n] += pp[(((ai * 2 + bj) * 4 + m) * 2 + n) * 512];
    }
    const int row = pm * 256 + ai * 128 + wr * 64 + m * 16 + fr, col0 = pn * 256 + wc * 32 + 8 * fq;
    float ss = 0.f;
#pragma unroll
    for (int bj = 0; bj < 2; ++bj)
#pragma unroll
        for (int n = 0; n < 2; ++n) { const size_t off = (size_t)row * DM + col0 + bj * 128 + n * 4; const u32x2 r = *(const u32x2*)(RB + off); const f32x4 a = v[bj][n];
            f32x4 y; y.x = __uint_as_float(r.x << 16) + a.x; y.y = __uint_as_float(r.x & 0xffff0000u) + a.y; y.z = __uint_as_float(r.y << 16) + a.z; y.w = __uint_as_float(r.y & 0xffff0000u) + a.w;
            if (FINAL) *(f32x4*)(Yf + off) = y;
            else { u32x2 o; o.x = pk2(y.x, y.y); o.y = pk2(y.z, y.w); *(u32x2*)(RB + off) = o; ss += y.x * y.x + y.y * y.y + y.z * y.z + y.w * y.w; } }
    if (!FINAL) { ss = xsum32(xsum16(ss)); if (fq == 0) SSQ[(size_t)(pn * 4 + wc) * MT + row] = ss; }
}
template <int SH> DI float dpp_row_shr(float oldv, float v) { return __int_as_float(__builtin_amdgcn_update_dpp(__float_as_int(oldv), __float_as_int(v), 0x110 + SH, 0xF, 0xF, false)); }
template <int SH> DI void scan_step(float& a, float& b, int fseg) {
    float ap = dpp_row_shr<SH>(1.0f, a), bp = dpp_row_shr<SH>(0.0f, b);
    if (fseg < SH) { ap = 1.0f; bp = 0.0f; }
    b = a * bp + b; a = a * ap;
}
struct EpiGates {
    static constexpr bool PERM64 = false, PERM8 = true;
    const bf16_t* V; const float* bga; const float* bgx; const float* lam; bf16_t* HL; bf16_t* AC; float* SUM;
    DI UPre unit_pre(int) const { return UPre{}; }
    DI void operator()(f32x4 (&acc)[2][2][4][2], const pg8::Unit& u, int wr, int wc, int fr, int fq, const UPre&) const {
        const bool isp = u.pm < MP / 256;
        const int chb = u.pn * 128 + wc * 32 + 8 * fq;
        const int rowb = u.pm * 256 + wr * 64 + fr;
        u32x4 vpre[2][4];
#pragma unroll
        for (int ai = 0; ai < 2; ++ai)
#pragma unroll
            for (int m = 0; m < 4; ++m) vpre[ai][m] = *(const u32x4*)(V + (size_t)(rowb + ai * 128 + m * 16) * DM + chb);
        f32x4 sp2[2], ba2[2], bx2[2];
#pragma unroll
        for (int n = 0; n < 2; ++n) { sp2[n] = *(const f32x4*)(lam + chb + 4 * n); ba2[n] = *(const f32x4*)(bga + chb + 4 * n); bx2[n] = *(const f32x4*)(bgx + chb + 4 * n); }
        const int fseg = isp ? fr : (fr & 7);
#pragma unroll
        for (int ai = 0; ai < 2; ++ai) {
#pragma unroll
            for (int n = 0; n < 2; ++n) {
                const f32x4 sp = sp2[n], ba = ba2[n], bx = bx2[n];
#pragma unroll
                for (int m = 0; m < 4; ++m) {
                    const int row = rowb + ai * 128 + m * 16;
                    const bool pos0 = isp && ((row & (SEQ - 1)) == 0);
                    const unsigned w0 = n == 0 ? vpre[ai][m].x : vpre[ai][m].z, w1 = n == 0 ? vpre[ai][m].y : vpre[ai][m].w;
                    const float v4[4] = {__uint_as_float(w0 << 16), __uint_as_float(w0 & 0xffff0000u), __uint_as_float(w1 << 16), __uint_as_float(w1 & 0xffff0000u)};
#pragma unroll
                    for (int e = 0; e < 4; ++e) {
                        const float r = __builtin_amdgcn_rcpf(1.0f + __builtin_amdgcn_exp2f(-1.4426950408889634f * (acc[ai][0][m][n][e] + ba[e])));
                        const float ig = __builtin_amdgcn_rcpf(1.0f + __builtin_amdgcn_exp2f(-1.4426950408889634f * (acc[ai][1][m][n][e] + bx[e])));
                        const float a = __builtin_amdgcn_exp2f(-r * sp[e]);
                        const float mult = pos0 ? 1.0f : __builtin_amdgcn_sqrtf(fmaxf(1.0f - a * a, 0.0f));
                        acc[ai][0][m][n][e] = a; acc[ai][1][m][n][e] = mult * ig * v4[e];
                    }
                }
            }
#pragma unroll
            for (int n = 0; n < 2; ++n)
#pragma unroll
                for (int e = 0; e < 4; ++e) {
                    float Ac = 1.0f, Hc = 0.0f;
#pragma unroll
                    for (int m = 0; m < 4; ++m) {
                        float a = acc[ai][0][m][n][e], b = acc[ai][1][m][n][e];
                        scan_step<1>(a, b, fseg); scan_step<2>(a, b, fseg); scan_step<4>(a, b, fseg);
                        if (isp) { scan_step<8>(a, b, fseg); b = a * Hc + b; a = a * Ac; Ac = __int_as_float(__builtin_amdgcn_update_dpp(0, __float_as_int(a), 0x15F, 0xF, 0xF, false)); Hc = __int_as_float(__builtin_amdgcn_update_dpp(0, __float_as_int(b), 0x15F, 0xF, 0xF, false)); }
                        acc[ai][0][m][n][e] = a; acc[ai][1][m][n][e] = b;
                    }
                    if (isp && fr == 15) { float* sm = SUM + ((size_t)(u.pm * 4 + ai * 2 + wr) * DM + chb + 4 * n + e) * 2; sm[0] = Ac; sm[1] = Hc; }
                }
#pragma unroll
            for (int m = 0; m < 4; ++m) {
                const size_t off = (size_t)(rowb + ai * 128 + m * 16) * DM + chb;
                u32x4 oa; oa.x = pk2(acc[ai][0][m][0][0], acc[ai][0][m][0][1]); oa.y = pk2(acc[ai][0][m][0][2], acc[ai][0][m][0][3]); oa.z = pk2(acc[ai][0][m][1][0], acc[ai][0][m][1][1]); oa.w = pk2(acc[ai][0][m][1][2], acc[ai][0][m][1][3]);
                *(u32x4*)(AC + off) = oa;
                u32x4 ob; ob.x = pk2(acc[ai][1][m][0][0], acc[ai][1][m][0][1]); ob.y = pk2(acc[ai][1][m][0][2], acc[ai][1][m][0][3]); ob.z = pk2(acc[ai][1][m][1][0], acc[ai][1][m][1][1]); ob.w = pk2(acc[ai][1][m][1][2], acc[ai][1][m][1][3]);
                *(u32x4*)(HL + off) = ob;
            }
            __builtin_amdgcn_sched_barrier(0);
        }
    }
};

DI void gates_sample_item(int item, int w, int lane, const bf16_t* __restrict__ V, const bf16_t* __restrict__ WGATET, const float* __restrict__ bga, const float* __restrict__ bgx, const float* __restrict__ SP8,
                          const bf16_t* __restrict__ GATE, const float* __restrict__ state_lru, bf16_t* __restrict__ YB, float* __restrict__ out) {
    const int p = item >> 3, n = item & 7, l15 = lane & 15, quad = lane >> 4;
    const int row0 = MP + p * 16, jch = 16 * w + l15, ch = 128 * n + jch;
    const bf16_t* ap = V + (size_t)(row0 + l15) * DM + 128 * n + 8 * quad;
    const bf16_t* bpa = WGATET + (size_t)(n * 256 + jch) * 256 + (n & 1) * 128 + 8 * quad;
    const bf16_t* bpx = bpa + (size_t)128 * 256;
    f32x4 ca = {0.f, 0.f, 0.f, 0.f}, cx = {0.f, 0.f, 0.f, 0.f};
#pragma unroll
    for (int st = 0; st < 4; ++st) {
        const bf16x8 a = *(const bf16x8*)(ap + 32 * st), wa = *(const bf16x8*)(bpa + 32 * st), wx = *(const bf16x8*)(bpx + 32 * st);
        ca = __builtin_amdgcn_mfma_f32_16x16x32_bf16(a, wa, ca, 0, 0, 0);
        cx = __builtin_amdgcn_mfma_f32_16x16x32_bf16(a, wx, cx, 0, 0, 0);
    }
    const float ba = bga[ch], bx_ = bgx[ch], sp = SP8[ch];
    const int seq = 2 * p + (quad >> 1), rbase = row0 + 4 * quad;
    float Aq[4], Hq[4], gt[4];
    float Ac = 1.f, Hc = 0.f;
#pragma unroll
    for (int j = 0; j < 4; ++j) {
        const float v = bf2f(V[(size_t)(rbase + j) * DM + ch]); gt[j] = bf2f(GATE[(size_t)(rbase + j) * DM + ch]);
        const float r = __builtin_amdgcn_rcpf(1.0f + __builtin_amdgcn_exp2f(-1.4426950408889634f * (ca[j] + ba)));
        const float ig = __builtin_amdgcn_rcpf(1.0f + __builtin_amdgcn_exp2f(-1.4426950408889634f * (cx[j] + bx_)));
        const float a = __builtin_amdgcn_exp2f(-r * sp);
        const float b = __builtin_amdgcn_sqrtf(fmaxf(1.0f - a * a, 0.0f)) * ig * v;
        Hc = a * Hc + b; Ac = a * Ac; Aq[j] = Ac; Hq[j] = Hc;
    }
    const float h0 = state_lru[(size_t)seq * DM + ch];
    const float pA = __int_as_float(__builtin_amdgcn_ds_bpermute((lane - 16) * 4, __float_as_int(Ac)));
    const float pH = __int_as_float(__builtin_amdgcn_ds_bpermute((lane - 16) * 4, __float_as_int(Hc)));
    const float hin = (quad & 1) ? (pA * h0 + pH) : h0;
#pragma unroll
    for (int j = 0; j < 4; ++j) {
        const float h = Aq[j] * hin + Hq[j];
        YB[(size_t)(rbase + j) * DM + ch] = f2bf(gt[j] * h);
        if ((quad & 1) && j == 3) out[O_LRU_S + (size_t)seq * DM + ch] = h;
    }
}
#define XB_TMO      128
#define XB_XCNT(j)  (256  + 64 * (j))
#define XB_XSUB(j)  (1280 + 64 * (j))
#define XB_XGEN(j)  (2304 + 64 * (j))
#define XB_TOP      3328
#define XB_TOPGEN   3392
#define XCD_BAR_WORDS 3456
#define XB_SPIN_CAP (1u << 18)
DI unsigned xb_ld(unsigned* p)              { return __hip_atomic_load(p, __ATOMIC_RELAXED, __HIP_MEMORY_SCOPE_AGENT); }
DI unsigned xb_add(unsigned* p, unsigned v) { return __hip_atomic_fetch_add(p, v, __ATOMIC_RELAXED, __HIP_MEMORY_SCOPE_AGENT); }
DI unsigned xb_xcc_id() { return (unsigned)__builtin_amdgcn_s_getreg((3 << 11) | 20) & 0xFu; }
#define XB_SPIN(cond, bar) do { unsigned _sp = 0; while (cond) { __builtin_amdgcn_s_sleep(1); \
    if ((++_sp & 255u) == 0u) { if (xb_ld(&(bar)[XB_TMO])) break; if (_sp > XB_SPIN_CAP) { atomicAdd(&(bar)[XB_TMO], 1u); break; } } } } while (0)
struct XcdBarrier { unsigned* bar; unsigned x; volatile LAS unsigned* st; };
DI XcdBarrier xcd_barrier_post(unsigned* bar, volatile LAS unsigned* st) {
    XcdBarrier b; b.bar = bar; b.x = xb_xcc_id(); b.st = st;
    if (threadIdx.x == 0) (void)xb_add(&bar[XB_XCNT(b.x)], 1u);
    return b;
}
DI void xcd_barrier_complete(unsigned* bar, unsigned x, unsigned& nloc, unsigned& nx) {
    const unsigned G = gridDim.x * gridDim.y * gridDim.z;
    unsigned sum, cnt, mine, sp = 0u;
    for (;;) {
        sum = 0u; cnt = 0u; mine = 0u;
#pragma unroll
        for (unsigned j = 0; j < 16; ++j) { const unsigned c = xb_ld(&bar[XB_XCNT(j)]); sum += c; cnt += (c > 0u) ? 1u : 0u; mine = (j == x) ? c : mine; }
        if (sum == G) break;
        __builtin_amdgcn_s_sleep(1);
        if ((++sp & 255u) == 0u) { if (xb_ld(&bar[XB_TMO])) break; if (sp > XB_SPIN_CAP) { atomicAdd(&bar[XB_TMO], 1u); break; } }
    }
    nloc = mine > 0u ? mine : 1u; nx = cnt > 0u ? cnt : 1u;
}
DI void xcd_barrier(const XcdBarrier& b) {
    asm volatile("s_waitcnt vmcnt(0)" ::: "memory");
    __syncthreads();
    if (threadIdx.x == 0) {
        unsigned* bar = b.bar;
        __builtin_amdgcn_s_waitcnt(0);
        unsigned nloc = b.st[0], nx = b.st[1];
        if (nloc == 0u) { xcd_barrier_complete(bar, b.x, nloc, nx); b.st[0] = nloc; b.st[1] = nx; }
        const unsigned old = xb_add(&bar[XB_XSUB(b.x)], 1u);
        const unsigned gen = old / nloc;
        if (old + 1u == (gen + 1u) * nloc) {
            __builtin_amdgcn_fence(__ATOMIC_RELEASE, "agent");
            asm volatile("s_waitcnt vmcnt(0)" ::: "memory");
            const unsigned og = xb_add(&bar[XB_TOP], 1u);
            const unsigned tg = og / nx;
            if (og + 1u == (tg + 1u) * nx) xb_add(&bar[XB_TOPGEN], 1u);
            else XB_SPIN(xb_ld(&bar[XB_TOPGEN]) == tg, bar);
            __builtin_amdgcn_fence(__ATOMIC_ACQUIRE, "agent");
            xb_add(&bar[XB_XGEN(b.x)], 1u);
            asm volatile("s_waitcnt vmcnt(0)" ::: "memory");
        } else {
            XB_SPIN(xb_ld(&bar[XB_XGEN(b.x)]) == gen, bar);
            __builtin_amdgcn_fence(__ATOMIC_ACQUIRE, "agent");
            asm volatile("s_waitcnt vmcnt(0)" ::: "memory");
        }
    }
    __syncthreads();
}

struct Args { const void* in[32]; float* out; unsigned char* ws; int ph_lo, ph_hi; };
static_assert(sizeof(Args) == 32 * 8 + 8 + 8 + 8, "Args has no padding");

DI void p0_transpose_item(const float* __restrict__ W, int lds_, int N, bf16_t* __restrict__ WT, int ldd, const float* __restrict__ gain, LAS float* scr, int item, int lane) {
    const int nblk = N / 32, kb = item / nblk, nb = item % nblk, k0 = 64 * kb, n0 = 32 * nb;
#pragma unroll 8
    for (int i = 0; i < 32; ++i) { const int kk = 2 * i + (lane >> 5); const float gsc = gain ? gain[k0 + kk] : 1.f; scr[kk * 33 + (lane & 31)] = W[(size_t)(k0 + kk) * lds_ + n0 + (lane & 31)] * gsc; }
    asm volatile("s_waitcnt lgkmcnt(0)" ::: "memory");
    const int c = lane & 7;
#pragma unroll
    for (int j = 0; j < 4; ++j) { const int n = (lane >> 3) + 8 * j; const LAS float* s = scr + (8 * c) * 33 + n;
        u32x4 o; o.x = pk2(s[0 * 33], s[1 * 33]); o.y = pk2(s[2 * 33], s[3 * 33]); o.z = pk2(s[4 * 33], s[5 * 33]); o.w = pk2(s[6 * 33], s[7 * 33]);
        *(u32x4*)(WT + (size_t)(n0 + n) * ldd + k0 + 8 * c) = o; }
    asm volatile("s_waitcnt lgkmcnt(0)" ::: "memory");
}
DI void rowprep_load(const float* __restrict__ src, int lane, f32x4 (&v)[4]) {
#pragma unroll
    for (int j = 0; j < 4; ++j) v[j] = ((const f32x4*)src)[lane + 64 * j];
}
DI void rowprep_row(const f32x4 (&v)[4], int row, bf16_t* __restrict__ XB, float* __restrict__ SSQ, int lane) {
    float ss = 0.f;
#pragma unroll
    for (int j = 0; j < 4; ++j) ss += v[j].x * v[j].x + v[j].y * v[j].y + v[j].z * v[j].z + v[j].w * v[j].w;
    ss = wave_sum(ss);
#pragma unroll
    for (int j = 0; j < 4; ++j) { u32x2 o; o.x = pk2(v[j].x, v[j].y); o.y = pk2(v[j].z, v[j].w); ((u32x2*)(XB + (size_t)row * DM))[lane + 64 * j] = o; }
    if (lane < 16) SSQ[(size_t)lane * MT + row] = lane == 0 ? ss : 0.f;
}

DI void unpack4(u32x2 r, float (&x)[4]) { x[0] = __uint_as_float(r.x << 16); x[1] = __uint_as_float(r.x & 0xffff0000u); x[2] = __uint_as_float(r.y << 16); x[3] = __uint_as_float(r.y & 0xffff0000u); }
DI void post0_row(int row, int lane, const bf16_t* __restrict__ Z0, const float* __restrict__ ROPET, const float* __restrict__ g_q_nope, const float* __restrict__ g_q_rope,
                  const float* __restrict__ g_ckv, const float* __restrict__ g_k_rope, bf16_t* __restrict__ QB, bf16_t* __restrict__ CB, bf16_t* __restrict__ KRB, float* __restrict__ out) {
    const bf16_t* z = Z0 + (size_t)row * NZ0;
    const bool isp = row < MP; const int pidx = isp ? (row & (SEQ - 1)) : SEQ + ((row - MP) & 7);
    { const int d = 4 * (lane & 15); const f32x4 g4 = *(const f32x4*)(g_q_nope + d);
#pragma unroll
      for (int hh = 0; hh < 2; ++hh) {
        const int h = 4 * hh + (lane >> 4); float x[4]; unpack4(*(const u32x2*)(z + POOLD + QKH * h + d), x);
        float ss = x[0] * x[0] + x[1] * x[1] + x[2] * x[2] + x[3] * x[3];
        ss = sum16(ss);
        const float ri = rsqrtf(ss * (1.f / 64.f) + EPS) * QSCALE;
        u32x2 o; o.x = pk2(x[0] * ri * g4.x, x[1] * ri * g4.y); o.y = pk2(x[2] * ri * g4.z, x[3] * ri * g4.w);
        *(u32x2*)(QB + (size_t)row * QDIM + QKH * h + d) = o; } }
    { const int r = 4 * (lane & 7), i0 = r & 15; const bool second = (lane & 4) != 0;
      const f32x4 t0 = *(const f32x4*)(ROPET + ((size_t)pidx * 16 + i0) * 2), t1 = *(const f32x4*)(ROPET + ((size_t)pidx * 16 + i0) * 2 + 4);
      const float cs[4] = {t0.x, t0.z, t1.x, t1.z}, sn[4] = {t0.y, t0.w, t1.y, t1.w};
      { const int h = lane >> 3; float x[4]; unpack4(*(const u32x2*)(z + POOLD + QKH * h + 64 + r), x);
        float ss = x[0] * x[0] + x[1] * x[1] + x[2] * x[2] + x[3] * x[3];
        ss = sum8(ss);
        const float ri = rsqrtf(ss * (1.f / 32.f) + EPS); const f32x4 g4 = *(const f32x4*)(g_q_rope + r);
        float y[4] = {x[0] * ri * g4.x, x[1] * ri * g4.y, x[2] * ri * g4.z, x[3] * ri * g4.w}, o[4];
#pragma unroll
        for (int e = 0; e < 4; ++e) { const float p = xchg4(y[e], second); o[e] = (second ? (p * sn[e] + y[e] * cs[e]) : (y[e] * cs[e] - p * sn[e])) * QSCALE; }
        u32x2 w; w.x = pk2(o[0], o[1]); w.y = pk2(o[2], o[3]); *(u32x2*)(QB + (size_t)row * QDIM + QKH * h + 64 + r) = w; }
      { float x[4]; unpack4(*(const u32x2*)(z + POOLD + QDIM + KVR + r), x);
        float ss = x[0] * x[0] + x[1] * x[1] + x[2] * x[2] + x[3] * x[3];
        ss = sum8(ss);
        const float ri = rsqrtf(ss * (1.f / 32.f) + EPS); const f32x4 g4 = *(const f32x4*)(g_k_rope + r);
        float y[4] = {x[0] * ri * g4.x, x[1] * ri * g4.y, x[2] * ri * g4.z, x[3] * ri * g4.w}; f32x4 o;
#pragma unroll
        for (int e = 0; e < 4; ++e) { const float p = xchg4(y[e], second); o[e] = second ? (p * sn[e] + y[e] * cs[e]) : (y[e] * cs[e] - p * sn[e]); }
        if (lane < 8) { u32x2 w; w.x = pk2(o[0], o[1]); w.y = pk2(o[2], o[3]); *(u32x2*)(KRB + (size_t)row * ROPE + r) = w;
            float* ko = isp ? out + O_KR_P + (size_t)row * ROPE : out + O_KR_S + (size_t)(row - MP) * ROPE; *(f32x4*)(ko + r) = o; } } }
    { float x[4]; unpack4(*(const u32x2*)(z + POOLD + QDIM + lane * 4), x);
      float ss = wave_sum(x[0] * x[0] + x[1] * x[1] + x[2] * x[2] + x[3] * x[3]); const float ri = rsqrtf(ss * (1.f / 256.f) + EPS);
      const f32x4 g4 = *(const f32x4*)(g_ckv + lane * 4);
      f32x4 y; y.x = x[0] * ri * g4.x; y.y = x[1] * ri * g4.y; y.z = x[2] * ri * g4.z; y.w = x[3] * ri * g4.w;
      u32x2 o; o.x = pk2(y.x, y.y); o.y = pk2(y.z, y.w); *(u32x2*)(CB + (size_t)row * KVR + lane * 4) = o;
      float* co = isp ? out + O_CKV_P + (size_t)row * KVR : out + O_CKV_S + (size_t)(row - MP) * KVR; *(f32x4*)(co + lane * 4) = y; }
}
DI void load8(const bf16_t* p, float (&x)[8]) { const u32x4 r = *(const u32x4*)p;
#pragma unroll
    for (int e = 0; e < 4; ++e) { x[2 * e] = __uint_as_float(r[e] << 16); x[2 * e + 1] = __uint_as_float(r[e] & 0xffff0000u); } }
template <bool ISP> DI void pool_item(int row0, int nrows, int ch, const bf16_t* __restrict__ Z0, const float* __restrict__ state_pool, bf16_t* __restrict__ DBuf, float* __restrict__ out) {
    const int w = 2 << (ch >> 7);
    const int t0 = ISP ? (row0 & (SEQ - 1)) : 0, bb = ISP ? (row0 >> 12) : ((row0 - MP) >> 3);
    float S[8];
#pragma unroll
    for (int e = 0; e < 8; ++e) S[e] = 0.f;
    for (int j = 1; j < w; ++j) { const int tj = t0 - j; float x[8];
        if (tj >= 0) { load8(Z0 + (size_t)(row0 - j) * NZ0 + ch, x); }
        else if (!ISP) { const float* hp = state_pool + ((size_t)bb * 15 + (15 + tj)) * POOLD + ch; const f32x4 a = *(const f32x4*)hp, b = *(const f32x4*)(hp + 4); x[0] = a.x; x[1] = a.y; x[2] = a.z; x[3] = a.w; x[4] = b.x; x[5] = b.y; x[6] = b.z; x[7] = b.w; }
        else {
#pragma unroll
            for (int e = 0; e < 8; ++e) x[e] = 0.f; }
#pragma unroll
        for (int e = 0; e < 8; ++e) S[e] += x[e]; }
    for (int i = 0; i < nrows; ++i) {
        const int t = t0 + i, row = row0 + i; float u[8]; load8(Z0 + (size_t)row * NZ0 + ch, u);
        const float icnt = 1.0f / (ISP ? (float)((t + 1) < w ? (t + 1) : w) : (float)w);
        u32x4 o;
#pragma unroll
        for (int e = 0; e < 8; ++e) S[e] += u[e];
#pragma unroll
        for (int e = 0; e < 4; ++e) o[e] = pk2(S[2 * e] * icnt - u[2 * e], S[2 * e + 1] * icnt - u[2 * e + 1]);
        *(u32x4*)(DBuf + (size_t)row * POOLD + ch) = o;
        { const int tj = t - w + 1; float x[8];
          if (tj >= 0) { load8(Z0 + (size_t)(row - w + 1) * NZ0 + ch, x); }
          else if (!ISP) { const float* hp = state_pool + ((size_t)bb * 15 + (15 + tj)) * POOLD + ch; const f32x4 a = *(const f32x4*)hp, b = *(const f32x4*)(hp + 4); x[0] = a.x; x[1] = a.y; x[2] = a.z; x[3] = a.w; x[4] = b.x; x[5] = b.y; x[6] = b.z; x[7] = b.w; }
          else {
#pragma unroll
              for (int e = 0; e < 8; ++e) x[e] = 0.f; }
#pragma unroll
          for (int e = 0; e < 8; ++e) S[e] -= x[e]; }
        if (ISP) { if (t >= SEQ - 15) { float* op = out + O_POOL_P + ((size_t)bb * 15 + (t - (SEQ - 15))) * POOLD + ch; *(f32x4*)op = (f32x4){u[0], u[1], u[2], u[3]}; *(f32x4*)(op + 4) = (f32x4){u[4], u[5], u[6], u[7]}; } }
        else { float* op = out + O_POOL_S + ((size_t)bb * 15 + 7 + t) * POOLD + ch; *(f32x4*)op = (f32x4){u[0], u[1], u[2], u[3]}; *(f32x4*)(op + 4) = (f32x4){u[4], u[5], u[6], u[7]}; }
    }
    if (!ISP) { for (int i = 0; i < 7; ++i) { const float* hp = state_pool + ((size_t)bb * 15 + 8 + i) * POOLD + ch; float* op = out + O_POOL_S + ((size_t)bb * 15 + i) * POOLD + ch; *(f32x4*)op = *(const f32x4*)hp; *(f32x4*)(op + 4) = *(const f32x4*)(hp + 4); } }
}
DI void pool_item_p16(int row0, int ch, const bf16_t* __restrict__ Z0, bf16_t* __restrict__ DBuf, float* __restrict__ out) {
    const int w = 2 << (ch >> 7);
    const int t0 = row0 & (SEQ - 1), bb = row0 >> 12;
    const bf16_t* zb = Z0 + (size_t)row0 * NZ0 + ch;
    float S[8];
#pragma unroll
    for (int e = 0; e < 8; ++e) S[e] = 0.f;
#pragma unroll
    for (int j = 1; j < 16; ++j) { const bool ok = (j < w) && (t0 - j >= 0); float x[8]; load8(zb - (ok ? j : 0) * NZ0, x); const float mk = ok ? 1.f : 0.f;
#pragma unroll
        for (int e = 0; e < 8; ++e) S[e] += mk * x[e]; }
#pragma unroll
    for (int i = 0; i < 16; ++i) {
        const int t = t0 + i; float u[8], x[8]; load8(zb + i * NZ0, u);
        const bool ok = t - w + 1 >= 0; load8(zb + (i - (ok ? w - 1 : 0)) * NZ0, x); const float mk = ok ? 1.f : 0.f;
        const float icnt = 1.0f / (float)((t + 1) < w ? (t + 1) : w);
        u32x4 o;
#pragma unroll
        for (int e = 0; e < 8; ++e) S[e] += u[e];
#pragma unroll
        for (int e = 0; e < 4; ++e) o[e] = pk2(S[2 * e] * icnt - u[2 * e], S[2 * e + 1] * icnt - u[2 * e + 1]);
        *(u32x4*)(DBuf + (size_t)(row0 + i) * POOLD + ch) = o;
#pragma unroll
        for (int e = 0; e < 8; ++e) S[e] -= mk * x[e];
    }
    if (t0 == SEQ - 16) {
        for (int i = 1; i < 16; ++i) { float u[8]; load8(zb + i * NZ0, u);
            float* op = out + O_POOL_P + ((size_t)bb * 15 + (i - 1)) * POOLD + ch; *(f32x4*)op = (f32x4){u[0], u[1], u[2], u[3]}; *(f32x4*)(op + 4) = (f32x4){u[4], u[5], u[6], u[7]}; } }
}
template <bool ISP> DI void conv_item(int row0, int nrows, int ch, const bf16_t* __restrict__ U, const float* __restrict__ state_conv, const float* __restrict__ conv_w, const float* __restrict__ conv_b,
                                      bf16_t* __restrict__ V, float* __restrict__ out) {
    const int t0 = ISP ? (row0 & (SEQ - 1)) : 0, bb = ISP ? (row0 >> 12) : ((row0 - MP) >> 3);
    float wk[4][8], bs[8], hist[3][8];
#pragma unroll
    for (int k = 0; k < 4; ++k) { const f32x4 a = *(const f32x4*)(conv_w + k * DM + ch), b = *(const f32x4*)(conv_w + k * DM + ch + 4); wk[k][0] = a.x; wk[k][1] = a.y; wk[k][2] = a.z; wk[k][3] = a.w; wk[k][4] = b.x; wk[k][5] = b.y; wk[k][6] = b.z; wk[k][7] = b.w; }
    { const f32x4 a = *(const f32x4*)(conv_b + ch), b = *(const f32x4*)(conv_b + ch + 4); bs[0] = a.x; bs[1] = a.y; bs[2] = a.z; bs[3] = a.w; bs[4] = b.x; bs[5] = b.y; bs[6] = b.z; bs[7] = b.w; }
#pragma unroll
    for (int j = 0; j < 3; ++j) {
        const int tj = t0 - 3 + j;
        if (tj >= 0) load8(U + (size_t)(row0 - 3 + j) * DM + ch, hist[j]);
        else if (!ISP) { const float* hp = state_conv + ((size_t)bb * 3 + (3 + tj)) * DM + ch; const f32x4 a = *(const f32x4*)hp, b = *(const f32x4*)(hp + 4); hist[j][0] = a.x; hist[j][1] = a.y; hist[j][2] = a.z; hist[j][3] = a.w; hist[j][4] = b.x; hist[j][5] = b.y; hist[j][6] = b.z; hist[j][7] = b.w; }
        else {
#pragma unroll
            for (int e = 0; e < 8; ++e) hist[j][e] = 0.f; }
    }
    for (int i = 0; i < nrows; ++i) {
        const int t = t0 + i, row = row0 + i; float u[8]; load8(U + (size_t)row * DM + ch, u);
        u32x4 o; float v[8];
#pragma unroll
        for (int e = 0; e < 8; ++e) v[e] = bs[e] + hist[0][e] * wk[0][e] + hist[1][e] * wk[1][e] + hist[2][e] * wk[2][e] + u[e] * wk[3][e];
#pragma unroll
        for (int e = 0; e < 4; ++e) o[e] = pk2(v[2 * e], v[2 * e + 1]);
        *(u32x4*)(V + (size_t)row * DM + ch) = o;
#pragma unroll
        for (int e = 0; e < 8; ++e) { hist[0][e] = hist[1][e]; hist[1][e] = hist[2][e]; hist[2][e] = u[e]; }
        const int tl = ISP ? SEQ - 3 : DT - 3;
        if (t >= tl) { float* op = out + (ISP ? O_CONV_P : O_CONV_S) + ((size_t)bb * 3 + (t - tl)) * DM + ch; *(f32x4*)op = (f32x4){u[0], u[1], u[2], u[3]}; *(f32x4*)(op + 4) = (f32x4){u[4], u[5], u[6], u[7]}; }
    }
}

DI void conv_item_p16(int row0, int ch, const bf16_t* __restrict__ U, const float* __restrict__ conv_w, const float* __restrict__ conv_b, bf16_t* __restrict__ V, float* __restrict__ out) {
    const int t0 = row0 & (SEQ - 1), bb = row0 >> 12;
    const bf16_t* ub = U + (size_t)row0 * DM + ch;
    u32x4 raw[19];
#pragma unroll
    for (int j = 0; j < 19; ++j) raw[j] = *(const u32x4*)(ub + (j - 3 >= 0 || t0 > 0 ? (j - 3) : 0) * DM);
    float wk[4][8], bs[8];
#pragma unroll
    for (int k = 0; k < 4; ++k) { const f32x4 a = *(const f32x4*)(conv_w + k * DM + ch), b = *(const f32x4*)(conv_w + k * DM + ch + 4); wk[k][0] = a.x; wk[k][1] = a.y; wk[k][2] = a.z; wk[k][3] = a.w; wk[k][4] = b.x; wk[k][5] = b.y; wk[k][6] = b.z; wk[k][7] = b.w; }
    { const f32x4 a = *(const f32x4*)(conv_b + ch), b = *(const f32x4*)(conv_b + ch + 4); bs[0] = a.x; bs[1] = a.y; bs[2] = a.z; bs[3] = a.w; bs[4] = b.x; bs[5] = b.y; bs[6] = b.z; bs[7] = b.w; }
    const float hm = t0 > 0 ? 1.f : 0.f;
    float x[4][8];
#pragma unroll
    for (int j = 0; j < 3; ++j)
#pragma unroll
        for (int e = 0; e < 4; ++e) { x[j][2 * e] = hm * __uint_as_float(raw[j][e] << 16); x[j][2 * e + 1] = hm * __uint_as_float(raw[j][e] & 0xffff0000u); }
#pragma unroll
    for (int i = 0; i < 16; ++i) {
#pragma unroll
        for (int e = 0; e < 4; ++e) { x[3][2 * e] = __uint_as_float(raw[3 + i][e] << 16); x[3][2 * e + 1] = __uint_as_float(raw[3 + i][e] & 0xffff0000u); }
        u32x4 o; float v[8];
#pragma unroll
        for (int e = 0; e < 8; ++e) v[e] = bs[e] + x[0][e] * wk[0][e] + x[1][e] * wk[1][e] + x[2][e] * wk[2][e] + x[3][e] * wk[3][e];
#pragma unroll
        for (int e = 0; e < 4; ++e) o[e] = pk2(v[2 * e], v[2 * e + 1]);
        *(u32x4*)(V + (size_t)(row0 + i) * DM + ch) = o;
#pragma unroll
        for (int e = 0; e < 8; ++e) { x[0][e] = x[1][e]; x[1][e] = x[2][e]; x[2][e] = x[3][e]; }
    }
    if (t0 == SEQ - 16) {
#pragma unroll
        for (int i = 13; i < 16; ++i) { float* op = out + O_CONV_P + ((size_t)bb * 3 + (i - 13)) * DM + ch;
            *(f32x4*)op = (f32x4){__uint_as_float(raw[3 + i][0] << 16), __uint_as_float(raw[3 + i][0] & 0xffff0000u), __uint_as_float(raw[3 + i][1] << 16), __uint_as_float(raw[3 + i][1] & 0xffff0000u)};
            *(f32x4*)(op + 4) = (f32x4){__uint_as_float(raw[3 + i][2] << 16), __uint_as_float(raw[3 + i][2] & 0xffff0000u), __uint_as_float(raw[3 + i][3] << 16), __uint_as_float(raw[3 + i][3] & 0xffff0000u)}; } }
}

DI void attn_p_naive_item(int item, int lane, LAS float* sc, const bf16_t* __restrict__ QB, const bf16_t* __restrict__ KV, const bf16_t* __restrict__ KRB, bf16_t* __restrict__ MIX) {
    LAS float* qs = sc + SEQ;
    const int row = item >> 3, h = item & 7, b = row >> 12, t = row & (SEQ - 1);
    for (int i = lane; i < QKH; i += 64) qs[i] = bf2f(QB[(size_t)row * QDIM + h * QKH + i]);
    asm volatile("s_waitcnt lgkmcnt(0)" ::: "memory");
    float mx = -INFINITY;
    for (int j0 = 0; j0 <= t; j0 += 64) {
        const int j = j0 + lane;
        if (j <= t) {
            const bf16_t* kr = KV + (size_t)(b * SEQ + j) * 1024 + h * 64; const bf16_t* rr = KRB + (size_t)(b * SEQ + j) * ROPE;
            float s = 0.f;
            for (int d = 0; d < 64; ++d) s += qs[d] * bf2f(kr[d]);
            for (int d = 0; d < 32; ++d) s += qs[64 + d] * bf2f(rr[d]);
            sc[j] = s; mx = fmaxf(mx, s);
        }
    }
    mx = wave_max(mx);
    float sum = 0.f;
    for (int j = lane; j <= t; j += 64) { const float p = exp2f(sc[j] - mx); sc[j] = p; sum += p; }
    sum = wave_sum(sum);
    asm volatile("s_waitcnt lgkmcnt(0)" ::: "memory");
    float acc = 0.f;
    for (int j = 0; j <= t; ++j) acc += sc[j] * bf2f(KV[(size_t)(b * SEQ + j) * 1024 + 512 + h * 64 + lane]);
    MIX[(size_t)row * DM + 512 + h * 64 + lane] = (bf16_t)f2bf(acc / sum);
    asm volatile("s_waitcnt lgkmcnt(0)" ::: "memory");
}


typedef short v4i16_t __attribute__((ext_vector_type(4)));
DI int crow(int r, int hi) { return (r & 3) + 8 * (r >> 2) + 4 * hi; }
constexpr int AP_KS = 12288, AP_VS = 8192, AP_LK = 0, AP_LV = 2 * AP_KS;
DI void attn_p_unit(int b, int h, int qb, LAS unsigned char* lds, const bf16_t* __restrict__ QB, const bf16_t* __restrict__ KV, const bf16_t* __restrict__ KRB, bf16_t* __restrict__ MIX) {
    const int tid = threadIdx.x, lane = tid & 63, r32 = lane & 31, hi = lane >> 5, wid = __builtin_amdgcn_readfirstlane(tid >> 6);
    const int rowbase = b * SEQ, q0 = qb * 256, NT = 4 * (qb + 1);
    const bf16_t* ksrc0 = KV + (size_t)(rowbase + lane) * 1024 + h * 64 + wid * 8;
    const bf16_t* ksrc1 = KRB + (size_t)(rowbase + lane) * ROPE + (wid & 3) * 8;
    const bf16_t* vsrc = KV + (size_t)(rowbase + 16 * (wid & 3) + (lane >> 2)) * 1024 + 512 + h * 64 + (wid >> 2) * 32 + (lane & 3) * 8;
#define AP_DMA(t, slot) do { \
        __builtin_amdgcn_global_load_lds((const unsigned*)(ksrc0 + (size_t)(t) * 64 * 1024), (LAS unsigned*)(lds + AP_LK + (slot) * AP_KS + wid * 1024), 16, 0, 0); \
        if (wid < 4) __builtin_amdgcn_global_load_lds((const unsigned*)(ksrc1 + (size_t)(t) * 64 * ROPE), (LAS unsigned*)(lds + AP_LK + (slot) * AP_KS + (8 + wid) * 1024), 16, 0, 0); \
        __builtin_amdgcn_global_load_lds((const unsigned*)(vsrc + (size_t)(t) * 64 * 1024), (LAS unsigned*)(lds + AP_LV + (slot) * AP_VS + wid * 1024), 16, 0, 0); } while (0)
    AP_DMA(0, 0);
    bf16x8 qr[6];
    { const bf16_t* qw = QB + (size_t)(rowbase + q0 + wid * 32 + r32) * QDIM + h * QKH + hi * 8;
#pragma unroll
      for (int d0 = 0; d0 < 6; ++d0) qr[d0] = *(const bf16x8*)(qw + d0 * 16); }
    float m = 0.f, l = 0.f;
    f32x16 o0, o1, negm;
#pragma unroll
    for (int r = 0; r < 16; ++r) { o0[r] = 0.f; o1[r] = 0.f; negm[r] = 0.f; }
    const int qrel = wid * 32 + r32;
    const int voff = (4 * hi + ((lane & 15) >> 2)) * 64 + ((lane >> 4) & 1) * 32 + (lane & 3) * 8;
    for (int t = 0; t < NT; ++t) {
        asm volatile("s_waitcnt vmcnt(0)" ::: "memory"); __builtin_amdgcn_s_barrier(); asm volatile("" ::: "memory");
        if (t + 1 < NT) AP_DMA(t + 1, (t + 1) & 1);
        const int slot = t & 1, trel = t - (NT - 4);
        if (trel < 0 || 64 * trel <= 32 * wid + 31) {
            const LAS unsigned char* kb = lds + AP_LK + slot * AP_KS + hi * 1024 + r32 * 16;
            f32x16 p0, p1;
            __builtin_amdgcn_s_setprio(1);
#pragma unroll
            for (int d0 = 0; d0 < 6; ++d0) {
                const bf16x8 k0 = *(const LAS bf16x8*)(kb + d0 * 2048), k1 = *(const LAS bf16x8*)(kb + d0 * 2048 + 512);
                p0 = __builtin_amdgcn_mfma_f32_32x32x16_bf16(k0, qr[d0], d0 == 0 ? negm : p0, 0, 0, 0);
                p1 = __builtin_amdgcn_mfma_f32_32x32x16_bf16(k1, qr[d0], d0 == 0 ? negm : p1, 0, 0, 0);
            }
            __builtin_amdgcn_s_setprio(0);
            if (trel >= 0) {
#pragma unroll
                for (int r = 0; r < 16; ++r) { const int kp = 64 * trel + crow(r, hi); if (kp > qrel) p0[r] = -INFINITY; if (kp + 32 > qrel) p1[r] = -INFINITY; }
            }
            float mx = max3f(p0[0], p1[0], p0[1]);
#pragma unroll
            for (int r = 1; r < 16; ++r) mx = (r < 15) ? max3f(mx, p1[r], p0[r + 1]) : fmaxf(mx, p1[r]);
            mx = xmax32(mx);
            float ps = 0.f;
#pragma unroll
            for (int r = 0; r < 16; ++r) { p0[r] = __builtin_amdgcn_exp2f(p0[r]); p1[r] = __builtin_amdgcn_exp2f(p1[r]); ps += p0[r] + p1[r]; }
            l += ps;
            const LAS unsigned char* vb = lds + AP_LV + slot * AP_VS + voff;
            __builtin_amdgcn_s_setprio(1);
#pragma unroll
            for (int ks = 0; ks < 4; ++ks) {
                u32x4 pw;
                if (ks < 2) { pw.x = cvtpk(p0[8 * ks], p0[8 * ks + 1]); pw.y = cvtpk(p0[8 * ks + 2], p0[8 * ks + 3]); pw.z = cvtpk(p0[8 * ks + 4], p0[8 * ks + 5]); pw.w = cvtpk(p0[8 * ks + 6], p0[8 * ks + 7]); }
                else { const int s8 = 8 * (ks - 2); pw.x = cvtpk(p1[s8], p1[s8 + 1]); pw.y = cvtpk(p1[s8 + 2], p1[s8 + 3]); pw.z = cvtpk(p1[s8 + 4], p1[s8 + 5]); pw.w = cvtpk(p1[s8 + 6], p1[s8 + 7]); }
                const bf16x8 pa = __builtin_bit_cast(bf16x8, pw);
#pragma unroll
                for (int db = 0; db < 2; ++db) {
                    const v4i16_t lo = __builtin_amdgcn_ds_read_tr16_b64_v4i16((LAS v4i16_t*)(vb + db * 4096 + ks * 1024));
                    const v4i16_t hh = __builtin_amdgcn_ds_read_tr16_b64_v4i16((LAS v4i16_t*)(vb + db * 4096 + ks * 1024 + 512));
                    const bf16x8 vf = (bf16x8){lo[0], lo[1], lo[2], lo[3], hh[0], hh[1], hh[2], hh[3]};
                    if (db == 0) o0 = __builtin_amdgcn_mfma_f32_32x32x16_bf16(vf, pa, o0, 0, 0, 0);
                    else o1 = __builtin_amdgcn_mfma_f32_32x32x16_bf16(vf, pa, o1, 0, 0, 0);
                }
            }
            __builtin_amdgcn_s_setprio(0);
            const float mn = (t == 0) ? mx : fmaxf(mx, 0.f);
            if (__any(mn != 0.f)) {
                const float f = __builtin_amdgcn_exp2f(-mn); l *= f; m += mn;
#pragma unroll
                for (int r = 0; r < 16; ++r) { o0[r] *= f; o1[r] *= f; negm[r] = -m; }
            }
        }
    }
    l = xsum32(l);
    const float il = 1.0f / l;
    bf16_t* orow = MIX + (size_t)(rowbase + q0 + wid * 32 + r32) * DM + 512 + h * 64 + 4 * hi;
#pragma unroll
    for (int g = 0; g < 4; ++g) {
        u32x2 a; a.x = cvtpk(o0[4 * g] * il, o0[4 * g + 1] * il); a.y = cvtpk(o0[4 * g + 2] * il, o0[4 * g + 3] * il); *(u32x2*)(orow + 8 * g) = a;
        u32x2 c; c.x = cvtpk(o1[4 * g] * il, o1[4 * g + 1] * il); c.y = cvtpk(o1[4 * g + 2] * il, o1[4 * g + 3] * il); *(u32x2*)(orow + 32 + 8 * g) = c;
    }
#undef AP_DMA
}


constexpr int SA_CB_ROW = 576, SA_CB_SZ = 64 * SA_CB_ROW;
constexpr int SA_C8_ROW = 272, SA_C8_SZ = 64 * SA_C8_ROW;
constexpr int SA_KR_ROW = 96, SA_KR_SZ = 64 * SA_KR_ROW;
constexpr int SA_CB = 0, SA_C8 = 2 * SA_CB_SZ, SA_KRB = SA_C8 + 2 * SA_C8_SZ;
constexpr int SA_P = SA_KRB + 2 * SA_KR_SZ, SA_P_ROW = 144;
constexpr int SA_QF = SA_P + 64 * SA_P_ROW;
constexpr int SA_F = SA_QF + 8 * 3 * 4 * 8 * 16;
constexpr int SA_END = SA_F + 256;
static_assert(SA_END <= LDS_MISC, "sample attention LDS map");
DI int sa_swz(int x) { return (0x78 >> (2 * x)) & 3; }
DI int sa_g8(int x) { return (0x28 >> (2 * x)) & 3; }
typedef int v8i_t __attribute__((ext_vector_type(8)));
typedef float f32x4v __attribute__((ext_vector_type(4)));

template <int VAR> DI void attn_s_unit(int unit, LAS unsigned char* lds, const float* __restrict__ cache_ckv, const float* __restrict__ cache_kr, const int* __restrict__ page_table, const bf16_t* __restrict__ QB,
                    const bf16_t* __restrict__ WKVT, const float* __restrict__ g_k_nope, float* __restrict__ LATP, float* __restrict__ ML) {
    constexpr int hot = VAR != 0;
    const int tid = threadIdx.x, lane = tid & 63, r32 = lane & 31, hi = lane >> 5, l15 = lane & 15, quad = lane >> 4, w = __builtin_amdgcn_readfirstlane(tid >> 6);
    const int sb = unit >> 1, split = unit & 1;
    const int* pt = page_table + sb * NPAGES + split * 32;
    for (int e = tid; e < 8 * 3 * 4 * 8; e += NTHR) {
        const int q = e & 7, qd = (e >> 3) & 3, st = (e >> 5) % 3, h = e / 96;
        const bf16_t* qp = QB + (size_t)(MP + sb * DT + q) * QDIM + h * QKH;
        unsigned pk[4];
#pragma unroll
        for (int jj = 0; jj < 4; ++jj) {
            float v0, v1;
            if (st < 2) { const int j0 = 2 * jj, j1 = 2 * jj + 1; const int d0 = 32 * st + 16 * (j0 >> 2) + 4 * qd + (j0 & 3), d1 = 32 * st + 16 * (j1 >> 2) + 4 * qd + (j1 & 3); v0 = bf2f(qp[d0]) * g_k_nope[d0]; v1 = bf2f(qp[d1]) * g_k_nope[d1]; }
            else { const int r0 = 8 * qd + 2 * jj; v0 = bf2f(qp[64 + r0]); v1 = bf2f(qp[64 + r0 + 1]); }
            pk[jj] = pk2(v0, v1);
        }
        *(LAS u32x4*)(lds + SA_QF + e * 16) = (u32x4){pk[0], pk[1], pk[2], pk[3]};
    }
    v8i_t wf[4][2];
#pragma unroll
    for (int db = 0; db < 4; ++db)
#pragma unroll
        for (int ch = 0; ch < 2; ++ch) {
            const bf16_t* wp = WKVT + (size_t)(w * 64 + 16 * db + l15) * KVR + 128 * ch + 32 * quad;
#pragma unroll
            for (int i = 0; i < 4; ++i) { const u32x4 r = *(const u32x4*)(wp + 8 * i); int lo = 0, hi2 = 0;
                lo = __builtin_amdgcn_cvt_pk_fp8_f32(__uint_as_float(r.x << 16) * 16.f, __uint_as_float(r.x & 0xffff0000u) * 16.f, lo, false);
                lo = __builtin_amdgcn_cvt_pk_fp8_f32(__uint_as_float(r.y << 16) * 16.f, __uint_as_float(r.y & 0xffff0000u) * 16.f, lo, true);
                hi2 = __builtin_amdgcn_cvt_pk_fp8_f32(__uint_as_float(r.z << 16) * 16.f, __uint_as_float(r.z & 0xffff0000u) * 16.f, hi2, false);
                hi2 = __builtin_amdgcn_cvt_pk_fp8_f32(__uint_as_float(r.w << 16) * 16.f, __uint_as_float(r.w & 0xffff0000u) * 16.f, hi2, true);
                wf[db][ch][2 * i] = lo; wf[db][ch][2 * i + 1] = hi2; }
        }
    const __amdgpu_buffer_rsrc_t rs_c = __builtin_amdgcn_make_buffer_rsrc((void*)cache_ckv, (short)0, (int)((size_t)(NPAGES * DB_ + NPAGES * DB_ / 4) * PAGE * KVR * 4), 0x00020000);
    const __amdgpu_buffer_rsrc_t rs_k = __builtin_amdgcn_make_buffer_rsrc((void*)cache_kr, (short)0, (int)((size_t)(NPAGES * DB_ + NPAGES * DB_ / 4) * PAGE * ROPE * 4), 0x00020000);
    const int dma_voff = lane * 16;
    u32x4 pf[9];
#define SA_LOAD(t) do { const unsigned prow = (unsigned)__builtin_amdgcn_readfirstlane(pt[hot ? 0 : ((t) >> 1)]) * PAGE + 64 * ((t) & 1) + 8 * w; \
        _Pragma("unroll") for (int i = 0; i < 8; ++i) pf[i] = __builtin_amdgcn_raw_buffer_load_b128(rs_c, dma_voff, (prow + i) * (KVR * 4), 0); \
        pf[8] = __builtin_amdgcn_raw_buffer_load_b128(rs_k, dma_voff, prow * (ROPE * 4), 0); } while (0)
    SA_LOAD(0);
    float m = 0.f, negm = 0.f, l = 0.f;
    f32x16 lat0, lat1;
#pragma unroll
    for (int r = 0; r < 16; ++r) { lat0[r] = 0.f; lat1[r] = 0.f; }
    const bool qreal = l15 < 8;
    const int g8_ = sa_g8((l15 >> 2) & 3);
    const LAS unsigned char* c8a0 = lds + SA_C8 + l15 * SA_C8_ROW + (((2 * quad) ^ g8_) * 16);
    const LAS unsigned char* c8b0 = lds + SA_C8 + l15 * SA_C8_ROW + (((2 * quad + 1) ^ g8_) * 16);
    const LAS unsigned char* qfbase = lds + SA_QF + (((w * 3) * 4 + quad) * 8 + (l15 & 7)) * 16;
    const LAS unsigned char* krbase0 = lds + SA_KRB + l15 * SA_KR_ROW + quad * 16;
    LAS unsigned char* pwbase = lds + SA_P + (8 * w + l15) * SA_P_ROW + quad * 8;
    asm volatile("s_waitcnt lgkmcnt(0)" ::: "memory"); __builtin_amdgcn_s_barrier(); asm volatile("" ::: "memory");
    bf16x8 q0 = *(const LAS bf16x8*)(qfbase), q1 = *(const LAS bf16x8*)(qfbase + 512), q2 = *(const LAS bf16x8*)(qfbase + 1024);
    if (!qreal) { q0 = (bf16x8){0, 0, 0, 0, 0, 0, 0, 0}; q1 = q0; q2 = q0; }
    LAS unsigned char* cvw0 = lds + SA_CB + 8 * w * SA_CB_ROW + (((lane >> 1) ^ sa_swz((2 * w) & 3)) * 16) + (lane & 1) * 8;
    LAS unsigned char* cvw1 = lds + SA_CB + 8 * w * SA_CB_ROW + (((lane >> 1) ^ sa_swz((2 * w + 1) & 3)) * 16) + (lane & 1) * 8;
    LAS unsigned char* c8w0 = lds + SA_C8 + 8 * w * SA_C8_ROW + (((lane >> 2) ^ sa_g8((2 * w) & 3)) * 16) + (lane & 3) * 4;
    LAS unsigned char* c8w1 = lds + SA_C8 + 8 * w * SA_C8_ROW + (((lane >> 2) ^ sa_g8((2 * w + 1) & 3)) * 16) + (lane & 3) * 4;
    LAS unsigned char* krw = lds + SA_KRB + (8 * w + (lane >> 3)) * SA_KR_ROW + (lane & 7) * 8;
    const int kr0 = 8 * hi + (l15 >> 2), cc0 = 4 * w + 2 * ((lane >> 4) & 1) + ((lane & 3) >> 1);
    const LAS unsigned char* trlo = lds + SA_CB + kr0 * SA_CB_ROW + ((cc0 ^ (hi ? 3 : 0)) * 16) + (lane & 1) * 8;
    const LAS unsigned char* trhi = lds + SA_CB + (kr0 + 4) * SA_CB_ROW + ((cc0 ^ (hi ? 1 : 2)) * 16) + (lane & 1) * 8;
    const LAS unsigned char* prd = lds + SA_P + r32 * SA_P_ROW + hi * 16;
    const LAS float* frd = (const LAS float*)(lds + SA_F + r32 * 4);
    for (int t2 = 0; t2 < 64; t2 += 2) {
#pragma unroll
      for (int tb = 0; tb < 2; ++tb) {
        const int t = t2 + tb;
        asm volatile("s_waitcnt vmcnt(0)" ::: "memory");
        if (VAR != 5) {
#pragma unroll
            for (int i = 0; i < 8; ++i) {
                const f32x4 v = __builtin_bit_cast(f32x4, pf[i]);
                u32x2 o; o.x = cvtpk(v.x, v.y); o.y = cvtpk(v.z, v.w);
                *(LAS u32x2*)((i < 4 ? cvw0 : cvw1) + tb * SA_CB_SZ + i * SA_CB_ROW) = o;
                int f8 = __builtin_amdgcn_cvt_pk_fp8_f32(v.x, v.y, 0, false); f8 = __builtin_amdgcn_cvt_pk_fp8_f32(v.z, v.w, f8, true);
                *(LAS int*)((i < 4 ? c8w0 : c8w1) + tb * SA_C8_SZ + i * SA_C8_ROW) = f8;
            }
            { const f32x4 v = __builtin_bit_cast(f32x4, pf[8]); u32x2 o; o.x = cvtpk(v.x, v.y); o.y = cvtpk(v.z, v.w);
              *(LAS u32x2*)(krw + tb * SA_KR_SZ) = o; }
        }
        constexpr bool ld_next = (VAR != 5);
        const int tn = (t + 1) & 63;
        const unsigned prow_n = (unsigned)__builtin_amdgcn_readfirstlane(pt[hot ? 0 : (tn >> 1)]) * PAGE + 64 * (tn & 1) + 8 * w;
        asm volatile("s_waitcnt lgkmcnt(0)" ::: "memory");
        __builtin_amdgcn_s_barrier(); asm volatile("" ::: "memory");
        const LAS unsigned char* c8a = c8a0 + tb * SA_C8_SZ; const LAS unsigned char* c8b = c8b0 + tb * SA_C8_SZ; const LAS unsigned char* krbase = krbase0 + tb * SA_KR_SZ;
        float tmax = -INFINITY, ps = 0.f;
        u32x4 nb00, nb01, nb10, nb11; bf16x8 nkf;
#define SA_LDB(kb_) do { const LAS unsigned char* ca_ = c8a + (kb_) * 16 * SA_C8_ROW; const LAS unsigned char* cb_ = c8b + (kb_) * 16 * SA_C8_ROW; \
            nb00 = *(const LAS u32x4*)(ca_); nb01 = *(const LAS u32x4*)(cb_); nb10 = *(const LAS u32x4*)(ca_ + 128); nb11 = *(const LAS u32x4*)(cb_ + 128); \
            nkf = *(const LAS bf16x8*)(krbase + (kb_) * 16 * SA_KR_ROW); } while (0)
        SA_LDB(0);
#pragma unroll
        for (int kb = 0; kb < 4; ++kb) {
            f32x4v k0 = {0.f, 0.f, 0.f, 0.f}, k1 = {0.f, 0.f, 0.f, 0.f}, k2 = {0.f, 0.f, 0.f, 0.f}, k3 = {0.f, 0.f, 0.f, 0.f};
            const bf16x8 kf = nkf;
            {
                const v8i_t bf0 = {(int)nb00.x, (int)nb00.y, (int)nb00.z, (int)nb00.w, (int)nb01.x, (int)nb01.y, (int)nb01.z, (int)nb01.w};
                const v8i_t bf1 = {(int)nb10.x, (int)nb10.y, (int)nb10.z, (int)nb10.w, (int)nb11.x, (int)nb11.y, (int)nb11.z, (int)nb11.w};
                if (VAR != 3) {
                    __builtin_amdgcn_s_setprio(1);
                    k0 = __builtin_amdgcn_mfma_scale_f32_16x16x128_f8f6f4(wf[0][0], bf0, k0, 0, 0, 0, 123, 0, 127); k1 = __builtin_amdgcn_mfma_scale_f32_16x16x128_f8f6f4(wf[1][0], bf0, k1, 0, 0, 0, 123, 0, 127);
                    k2 = __builtin_amdgcn_mfma_scale_f32_16x16x128_f8f6f4(wf[2][0], bf0, k2, 0, 0, 0, 123, 0, 127); k3 = __builtin_amdgcn_mfma_scale_f32_16x16x128_f8f6f4(wf[3][0], bf0, k3, 0, 0, 0, 123, 0, 127);
                    k0 = __builtin_amdgcn_mfma_scale_f32_16x16x128_f8f6f4(wf[0][1], bf1, k0, 0, 0, 0, 123, 0, 127); k1 = __builtin_amdgcn_mfma_scale_f32_16x16x128_f8f6f4(wf[1][1], bf1, k1, 0, 0, 0, 123, 0, 127);
                    k2 = __builtin_amdgcn_mfma_scale_f32_16x16x128_f8f6f4(wf[2][1], bf1, k2, 0, 0, 0, 123, 0, 127); k3 = __builtin_amdgcn_mfma_scale_f32_16x16x128_f8f6f4(wf[3][1], bf1, k3, 0, 0, 0, 123, 0, 127);
                    __builtin_amdgcn_s_setprio(0);
                }
                __builtin_amdgcn_sched_barrier(0);
                if (kb < 3) SA_LDB(kb + 1);
                if (ld_next) { pf[2 * kb] = __builtin_amdgcn_raw_buffer_load_b128(rs_c, dma_voff, (prow_n + 2 * kb) * (KVR * 4), 0); pf[2 * kb + 1] = __builtin_amdgcn_raw_buffer_load_b128(rs_c, dma_voff, (prow_n + 2 * kb + 1) * (KVR * 4), 0);
                    if (kb == 3) pf[8] = __builtin_amdgcn_raw_buffer_load_b128(rs_k, dma_voff, prow_n * (ROPE * 4), 0); }
                __builtin_amdgcn_sched_barrier(0);
            }
            float ss = k0.x * k0.x + k0.y * k0.y + k0.z * k0.z + k0.w * k0.w + k1.x * k1.x + k1.y * k1.y + k1.z * k1.z + k1.w * k1.w
                     + k2.x * k2.x + k2.y * k2.y + k2.z * k2.z + k2.w * k2.w + k3.x * k3.x + k3.y * k3.y + k3.z * k3.z + k3.w * k3.w;
            ss = xsum32(xsum16(ss));
            const float ri = __builtin_amdgcn_rsqf(ss * (1.f / 64.f) + EPS);
            u32x4 a0, a1;
            a0.x = cvtpk(k0.x * ri, k0.y * ri); a0.y = cvtpk(k0.z * ri, k0.w * ri); a0.z = cvtpk(k1.x * ri, k1.y * ri); a0.w = cvtpk(k1.z * ri, k1.w * ri);
            a1.x = cvtpk(k2.x * ri, k2.y * ri); a1.y = cvtpk(k2.z * ri, k2.w * ri); a1.z = cvtpk(k3.x * ri, k3.y * ri); a1.w = cvtpk(k3.z * ri, k3.w * ri);
            f32x4v sc = {negm, negm, negm, negm};
            sc = __builtin_amdgcn_mfma_f32_16x16x32_bf16(kf, q2, sc, 0, 0, 0);
            sc = __builtin_amdgcn_mfma_f32_16x16x32_bf16(__builtin_bit_cast(bf16x8, a0), q0, sc, 0, 0, 0);
            sc = __builtin_amdgcn_mfma_f32_16x16x32_bf16(__builtin_bit_cast(bf16x8, a1), q1, sc, 0, 0, 0);
            float bm = fmaxf(fmaxf(sc.x, sc.y), fmaxf(sc.z, sc.w));
            if (t == 0 && kb == 0) { const float m0 = xmax32(xmax16(bm)); sc.x -= m0; sc.y -= m0; sc.z -= m0; sc.w -= m0; bm -= m0; m = m0; negm = -m0; }
            tmax = fmaxf(tmax, bm);
            sc.x = __builtin_amdgcn_exp2f(sc.x); sc.y = __builtin_amdgcn_exp2f(sc.y); sc.z = __builtin_amdgcn_exp2f(sc.z); sc.w = __builtin_amdgcn_exp2f(sc.w);
            ps += (sc.x + sc.y) + (sc.z + sc.w);
            asm volatile("" : "+v"(ps), "+v"(tmax));
            if (qreal) { u32x2 o; o.x = cvtpk(sc.x, sc.y); o.y = cvtpk(sc.z, sc.w); *(LAS u32x2*)(pwbase + kb * 32) = o; }
            __builtin_amdgcn_sched_barrier(0);
        }
#undef SA_LDB
        { tmax = xmax32(xmax16(tmax));
          const float inc = fmaxf(tmax, 0.f); const float f = __builtin_amdgcn_exp2f(-inc); m += inc; negm = -m; l = (l + ps) * f;
          if (qreal && quad == 0) *(LAS float*)(lds + SA_F + (8 * w + l15) * 4) = f; }
        asm volatile("s_waitcnt lgkmcnt(0)" ::: "memory"); __builtin_amdgcn_s_barrier(); asm volatile("" ::: "memory");
        if (VAR != 4) {
            v4i16_t lo[4], hh[4]; bf16x8 p0[4], p1[4];
#pragma unroll
            for (int ks = 0; ks < 4; ++ks) {
                lo[ks] = __builtin_amdgcn_ds_read_tr16_b64_v4i16((LAS v4i16_t*)(trlo + tb * SA_CB_SZ + ks * 16 * SA_CB_ROW));
                hh[ks] = __builtin_amdgcn_ds_read_tr16_b64_v4i16((LAS v4i16_t*)(trhi + tb * SA_CB_SZ + ks * 16 * SA_CB_ROW));
                p0[ks] = *(const LAS bf16x8*)(prd + ks * 32);
                p1[ks] = *(const LAS bf16x8*)(prd + 32 * SA_P_ROW + ks * 32);
            }
            const float f0 = frd[0], f1 = frd[32];
            __builtin_amdgcn_sched_barrier(0);
            __builtin_amdgcn_s_setprio(1);
#pragma unroll
            for (int ks = 0; ks < 4; ++ks) {
                const bf16x8 cf = (bf16x8){lo[ks][0], lo[ks][1], lo[ks][2], lo[ks][3], hh[ks][0], hh[ks][1], hh[ks][2], hh[ks][3]};
                lat0 = __builtin_amdgcn_mfma_f32_32x32x16_bf16(cf, p0[ks], lat0, 0, 0, 0);
                lat1 = __builtin_amdgcn_mfma_f32_32x32x16_bf16(cf, p1[ks], lat1, 0, 0, 0);
            }
            __builtin_amdgcn_s_setprio(0);
            if (__any(f0 != 1.f || f1 != 1.f)) {
#pragma unroll
                for (int r = 0; r < 16; ++r) { lat0[r] *= f0; lat1[r] *= f1; } }
        }
      }
    }
    __builtin_amdgcn_s_barrier(); asm volatile("" ::: "memory");
    l = xsum32(xsum16(l));
    int unit2 = unit, lane2 = threadIdx.x & 63; asm volatile("" : "+s"(unit2), "+v"(lane2));
    const int r32b = lane2 & 31, hib = lane2 >> 5;
    if (lane2 < 8) { float* mlp = ML + ((size_t)unit2 * 64 + 8 * w + lane2) * 2; mlp[0] = m; mlp[1] = l; }
    float* lp = LATP + (size_t)unit2 * 64 * KVR + 32 * w + 4 * hib;
#pragma unroll
    for (int g = 0; g < 4; ++g) {
        *(f32x4*)(lp + (size_t)r32b * KVR + 8 * g) = (f32x4){lat0[4 * g], lat0[4 * g + 1], lat0[4 * g + 2], lat0[4 * g + 3]};
        *(f32x4*)(lp + (size_t)(32 + r32b) * KVR + 8 * g) = (f32x4){lat1[4 * g], lat1[4 * g + 1], lat1[4 * g + 2], lat1[4 * g + 3]};
    }
#undef SA_LOAD
}

DI void attn_s_combine(int sb, LAS unsigned char* lds, const bf16_t* __restrict__ QB, const bf16_t* __restrict__ KV, const bf16_t* __restrict__ KRB, const bf16_t* __restrict__ WKVT,
                       const float* __restrict__ LATP, const float* __restrict__ ML, bf16_t* __restrict__ MIX) {
    const int tid = threadIdx.x;
    LAS float* latc = (LAS float*)lds; LAS float* pn = latc + 64 * KVR; LAS float* wgt = pn + 64 * 8;
    {
        const int qh = tid >> 3, j = tid & 7, h = qh >> 3, q = qh & 7;
        const bf16_t* qp = QB + (size_t)(MP + sb * DT + q) * QDIM + h * QKH; const size_t krow_ = (size_t)MP + sb * DT + j;
        float sj = 0.f;
        for (int d = 0; d < 64; ++d) sj += bf2f(qp[d]) * bf2f(KV[krow_ * 1024 + h * 64 + d]);
        for (int r = 0; r < 32; ++r) sj += bf2f(qp[64 + r]) * bf2f(KRB[krow_ * ROPE + r]);
        if (j > q) sj = -INFINITY;
        const float m0 = ML[((size_t)(2 * sb) * 64 + qh) * 2], l0 = ML[((size_t)(2 * sb) * 64 + qh) * 2 + 1], m1 = ML[((size_t)(2 * sb + 1) * 64 + qh) * 2], l1 = ML[((size_t)(2 * sb + 1) * 64 + qh) * 2 + 1];
        const float mm = max8(sj);
        const float M = fmaxf(fmaxf(m0, m1), mm);
        const float pj = exp2f(sj - M), w0 = exp2f(m0 - M), w1 = exp2f(m1 - M);
        const float sp = sum8(pj);
        const float L = w0 * l0 + w1 * l1 + sp, iL = 1.f / L;
        pn[qh * 8 + j] = pj * iL;
        if (j == 0) { wgt[qh * 2] = w0 * iL; wgt[qh * 2 + 1] = w1 * iL; }
    }
    __syncthreads();
    for (int e = tid; e < 64 * KVR; e += NTHR) { const int qh = e >> 8; latc[e] = wgt[qh * 2] * LATP[(size_t)(2 * sb) * 64 * KVR + e] + wgt[qh * 2 + 1] * LATP[(size_t)(2 * sb + 1) * 64 * KVR + e]; }
    __syncthreads();
    for (int o = tid; o < 64 * VH; o += NTHR) {
        const int qh = o >> 6, v = o & 63, h = qh >> 3, q = qh & 7;
        const bf16_t* wr = WKVT + (size_t)(512 + h * 64 + v) * KVR;
        float a = 0.f;
        for (int c = 0; c < KVR; ++c) a += latc[qh * KVR + c] * bf2f(wr[c]);
        for (int j = 0; j < DT; ++j) a += pn[qh * 8 + j] * bf2f(KV[((size_t)MP + sb * DT + j) * 1024 + 512 + h * 64 + v]);
        MIX[(size_t)(MP + sb * DT + q) * DM + 512 + h * 64 + v] = (bf16_t)f2bf(a);
    }
    __syncthreads();
}

DI void attn_s_scores_item(int chunk, int sb, int tid, const float* __restrict__ cache_ckv, const float* __restrict__ cache_kr, const int* __restrict__ page_table, const bf16_t* __restrict__ QB,
                           const bf16_t* __restrict__ CB, const bf16_t* __restrict__ KRB, const float* __restrict__ w_uk, const float* __restrict__ g_k_nope, float* __restrict__ SC) {
    const int key = tid & 127, hq = __builtin_amdgcn_readfirstlane(tid >> 7);
    const bool isnew = chunk == NPAGES;
    if (isnew && key >= DT) return;
    const float* crow = nullptr; const bf16_t* crowb = nullptr; const float* kpf = nullptr; const bf16_t* kpb = nullptr;
    if (!isnew) { const size_t pr = (size_t)page_table[sb * NPAGES + chunk] * PAGE + key; crow = cache_ckv + pr * KVR; kpf = cache_kr + pr * ROPE; }
    else { const size_t rr = (size_t)MP + sb * DT + key; crowb = CB + rr * KVR; kpb = KRB + rr * ROPE; }
    const int jglob = isnew ? PAST + key : chunk * PAGE + key;
    for (int hi = 0; hi < 2; ++hi) {
        const int h = hq * 2 + hi;
        float acc[NOPE];
#pragma unroll
        for (int d = 0; d < NOPE; ++d) acc[d] = 0.f;
        for (int c = 0; c < KVR; ++c) {
            const float cv = isnew ? bf2f(crowb[c]) : crow[c];
            const float* wr = w_uk + (size_t)c * 512 + h * 64;
#pragma unroll
            for (int d = 0; d < NOPE; ++d) acc[d] += cv * wr[d];
        }
        float ss = 0.f;
#pragma unroll
        for (int d = 0; d < NOPE; ++d) ss += acc[d] * acc[d];
        const float ri = rsqrtf(ss * (1.f / 64.f) + EPS);
#pragma unroll 1
        for (int q = 0; q < DT; ++q) {
            const bf16_t* qp = QB + (size_t)(MP + sb * DT + q) * QDIM + h * QKH;
            float s = 0.f;
#pragma unroll
            for (int d = 0; d < NOPE; ++d) s += acc[d] * g_k_nope[d] * bf2f(qp[d]);
            s *= ri;
            for (int r = 0; r < ROPE; ++r) s += (isnew ? bf2f(kpb[r]) : kpf[r]) * bf2f(qp[64 + r]);
            if (isnew && key > q) s = -INFINITY;
            SC[((size_t)sb * 64 + h * 8 + q) * NKEYS + jglob] = s;
        }
    }
}
DI void attn_s_pv_item(int sb, int tid, LAS float* lds, const float* __restrict__ cache_ckv, const int* __restrict__ page_table, const bf16_t* __restrict__ CB, const float* __restrict__ SC,
                       const float* __restrict__ w_uv, float* __restrict__ LAT, bf16_t* __restrict__ MIX) {
    LAS float* p = lds; LAS float* smx = lds + 64 * PAGE; LAS float* sinv = smx + 64;
    const int wid = tid >> 6, lane = tid & 63;
    for (int i = 0; i < 8; ++i) {
        const int qh = wid * 8 + i; const float* s = SC + ((size_t)sb * 64 + qh) * NKEYS;
        float mx = -INFINITY; for (int j = lane; j < NKEYS; j += 64) mx = fmaxf(mx, s[j]);
        mx = wave_max(mx);
        float sum = 0.f; for (int j = lane; j < NKEYS; j += 64) sum += exp2f(s[j] - mx);
        sum = wave_sum(sum);
        if (lane == 0) { smx[qh] = mx; sinv[qh] = 1.f / sum; }
    }
    __syncthreads();
    const int c = tid & 255, half = tid >> 8;
    float lat[32];
#pragma unroll
    for (int i = 0; i < 32; ++i) lat[i] = 0.f;
    for (int chunk = 0; chunk <= NPAGES; ++chunk) {
        const int nk = chunk == NPAGES ? DT : PAGE;
        for (int e = tid; e < 64 * PAGE; e += NTHR) { const int qh = e >> 7, j = e & 127; p[qh * PAGE + j] = j < nk ? exp2f(SC[((size_t)sb * 64 + qh) * NKEYS + chunk * PAGE + j] - smx[qh]) * sinv[qh] : 0.f; }
        __syncthreads();
        for (int j = 0; j < nk; ++j) {
            float cv;
            if (chunk < NPAGES) cv = cache_ckv[((size_t)page_table[sb * NPAGES + chunk] * PAGE + j) * KVR + c];
            else cv = bf2f(CB[((size_t)MP + sb * DT + j) * KVR + c]);
#pragma unroll
            for (int i = 0; i < 32; ++i) lat[i] += p[(half * 32 + i) * PAGE + j] * cv;
        }
        __syncthreads();
    }
    float* L = LAT + (size_t)sb * 64 * KVR;
#pragma unroll
    for (int i = 0; i < 32; ++i) L[(half * 32 + i) * KVR + c] = lat[i];
    __threadfence_block(); __syncthreads();
    for (int o = tid; o < 64 * VH; o += NTHR) {
        const int qh = o >> 6, v = o & 63, h = qh >> 3, q = qh & 7;
        float a = 0.f;
        for (int cc = 0; cc < KVR; ++cc) a += L[qh * KVR + cc] * w_uv[(size_t)cc * 512 + h * 64 + v];
        MIX[(size_t)(MP + sb * DT + q) * DM + 512 + h * 64 + v] = (bf16_t)f2bf(a);
    }
    __syncthreads();
}

enum Phase { PH_PRO = 0, PH_Z0, PH_POST0, PH_KVPOOL, PH_KNORM, PH_ATTN, PH_ATTN2, PH_OUT0, PH_UP0, PH_DN0, PH_RNNIN, PH_CONV, PH_GATES, PH_SCAN, PH_OUTR, PH_UP1, PH_DN1, PH_COUNT };

__global__ void __launch_bounds__(NTHR, 2) mk(Args args) {
    extern __shared__ __attribute__((aligned(16))) unsigned char lds_raw[];
    LAS unsigned char* lds = (LAS unsigned char*)lds_raw;
    volatile LAS unsigned* MISC = (volatile LAS unsigned*)(lds + LDS_MISC);
    const int tid = threadIdx.x, lane = tid & 63, wave = __builtin_amdgcn_readfirstlane(tid >> 6);
    const int G = gridDim.x, bx = blockIdx.x;
    const int gw = bx * NWAVES + wave, NGW = G * NWAVES;
    const int lo = args.ph_lo, hi = args.ph_hi;

    const float* x_prompt = (const float*)args.in[0]; const float* x_sample = (const float*)args.in[1];
    const float* cache_ckv = (const float*)args.in[2]; const float* cache_kr = (const float*)args.in[3];
    const float* state_pool = (const float*)args.in[4]; const float* state_conv = (const float*)args.in[5]; const float* state_lru = (const float*)args.in[6];
    const int* page_table = (const int*)args.in[7];
    const float* norm_mix = (const float*)args.in[8]; const float* w_in_even = (const float*)args.in[9];
    const float* g_q_nope = (const float*)args.in[10]; const float* g_q_rope = (const float*)args.in[11]; const float* g_ckv = (const float*)args.in[12]; const float* g_k_rope = (const float*)args.in[13]; const float* g_k_nope = (const float*)args.in[14];
    const float* w_uk = (const float*)args.in[15]; const float* w_uv = (const float*)args.in[16]; const float* w_pool = (const float*)args.in[17]; const float* pool_scale = (const float*)args.in[18];
    const float* w_out_even = (const float*)args.in[19]; const float* w_in_rnn = (const float*)args.in[20]; const float* conv_w = (const float*)args.in[21]; const float* conv_b = (const float*)args.in[22];
    const float* w_gate_a = (const float*)args.in[23]; const float* b_gate_a = (const float*)args.in[24]; const float* w_gate_x = (const float*)args.in[25]; const float* b_gate_x = (const float*)args.in[26];
    const float* lru_lambda = (const float*)args.in[27]; const float* w_out_rnn = (const float*)args.in[28]; const float* norm_ffn = (const float*)args.in[29]; const float* w_up = (const float*)args.in[30]; const float* w_down = (const float*)args.in[31];
    float* out = args.out; unsigned char* ws = args.ws;
    bf16_t* WIN0T = (bf16_t*)(ws + WS_WIN0T); bf16_t* WKVT = (bf16_t*)(ws + WS_WKVT); bf16_t* WPOOLT = (bf16_t*)(ws + WS_WPOOLT); bf16_t* WGATET = (bf16_t*)(ws + WS_WGATET);
    bf16_t* WOUT0T = (bf16_t*)(ws + WS_WOUT0T); bf16_t* WOUTRT = (bf16_t*)(ws + WS_WOUTRT); bf16_t* WINRT = (bf16_t*)(ws + WS_WINRT); bf16_t* WUPT = (bf16_t*)(ws + WS_WUPT); bf16_t* WDNT = (bf16_t*)(ws + WS_WDNT);
    float* SSQ = (float*)(ws + WS_SSQ); bf16_t* XB = (bf16_t*)(ws + WS_XB); bf16_t* Z0 = (bf16_t*)(ws + WS_Z0); bf16_t* QB = (bf16_t*)(ws + WS_QB); bf16_t* CB = (bf16_t*)(ws + WS_CB); bf16_t* KRB = (bf16_t*)(ws + WS_KRB);
    bf16_t* DBuf = (bf16_t*)(ws + WS_DB); bf16_t* KV = (bf16_t*)(ws + WS_KV); bf16_t* MIX = (bf16_t*)(ws + WS_MIX); bf16_t* H = (bf16_t*)(ws + WS_H); bf16_t* GATE = (bf16_t*)(ws + WS_GATE); bf16_t* U = (bf16_t*)(ws + WS_U);
    bf16_t* V = (bf16_t*)(ws + WS_V); float* Gb = (float*)(ws + WS_G); bf16_t* YB = (bf16_t*)(ws + WS_YB); float* SC = (float*)(ws + WS_SC); float* LAT = (float*)(ws + WS_LAT);
    float* Y = out + O_Y;

    if (tid < 64) MISC[tid] = 0u;
    __syncthreads();
    XcdBarrier bar = xcd_barrier_post((unsigned*)(ws + WS_CTL) + CW_BAR, MISC + 8);
#ifndef PH_MASK
#define PH_MASK 0xFFFFFFFFu
#endif
#define IN(k) (((PH_MASK >> (k)) & 1u) && lo <= (k) && (k) < hi)
#define SEAM(k) do { if (IN(k) && IN((k) + 1)) xcd_barrier(bar); } while (0)
#define STREAM_CTL(ep_) pg8::StreamCtl{(float*)(ws + WS_PART), (unsigned*)(ws + WS_CTL) + CW_SKF, (unsigned*)(ws + WS_CTL) + CW_SKT, (unsigned)(ep_), bx, 0}
#define GEMM_PHASE_STATIC(ep_, Aptr, lda_, atoff_, ashift_, Bptr, M_, N_, K_, FT, ...) do { pg8::Gemm g{Aptr, Bptr, M_, N_, K_, lda_, atoff_, ashift_}; pg8::StaticOrder S; S.init(M_, N_, K_, G, bx); \
        pg8::EpiRows<FT> E{FT{__VA_ARGS__}}; pg8::gemm_phase<false>(lds, g, S, E, STREAM_CTL(ep_)); } while (0)
#define GEMM_PHASE(ep_, Aptr, lda_, atoff_, ashift_, Bptr, M_, N_, K_, FT, ...) do { pg8::Gemm g{Aptr, Bptr, M_, N_, K_, lda_, atoff_, ashift_}; pg8::StaticOrder S; S.init(M_, N_, K_, G, bx); \
        pg8::EpiRows<FT> E{FT{__VA_ARGS__}}; pg8::gemm_phase<false>(lds, g, S, E, STREAM_CTL(ep_)); } while (0)
#define GEMM_PHASE_P8(ep_, Aptr, lda_, Bptr, M_, N_, K_, FT, ...) do { pg8::Gemm g{Aptr, Bptr, M_, N_, K_, lda_, 0, 0}; pg8::StaticOrder S; S.init(M_, N_, K_, G, bx); \
        pg8::EpiRows<FT, false, true> E{FT{__VA_ARGS__}}; pg8::gemm_phase<false>(lds, g, S, E, STREAM_CTL(ep_)); } while (0)
#define GEMM_RESID(Aptr, lda_, Bptr, K_) GEMM_PHASE_P8(0, Aptr, lda_, Bptr, MT, DM, K_, FResid<false>, XB, (float*)nullptr, SSQ)
#define CW_RDY(i) ((unsigned*)(ws + WS_CTL) + 12288 + 64 * (i))
#define GEMM_RESID_SPLIT(Aptr, lda_, Bptr, K_) do { \
        if (G == 256) { pg8::Gemm g{Aptr, Bptr, MT, DM, K_, lda_, 0, 0}; pg8::SplitTailOrder S; S.init(K_, bx); pg8::EpiRows<FResid<false>, false, true> E{FResid<false>{XB, (float*)nullptr, SSQ}}; \
            pg8::gemm_phase<false>(lds, g, S, E, STREAM_CTL(0), EpiPartStore{(float*)(ws + WS_PART), bx & 15}); } \
        else GEMM_RESID(Aptr, lda_, Bptr, K_); } while (0)
#define FIXUP_DEFERRED(i, WAYS_) do { if (G == 256 && bx >= 128) { sample_fixup<false, WAYS_>(bx - 128, (const float*)(ws + WS_PART), XB, (float*)nullptr, SSQ); \
            asm volatile("s_waitcnt vmcnt(0)" ::: "memory"); __syncthreads(); \
            if (tid == 0) { __builtin_amdgcn_fence(__ATOMIC_RELEASE, "agent"); asm volatile("s_waitcnt vmcnt(0)" ::: "memory"); __hip_atomic_fetch_add(CW_RDY(i), 1u, __ATOMIC_RELAXED, __HIP_MEMORY_SCOPE_AGENT); } } } while (0)
#define GEMM_PHASE_P8_RDY(i, ep_, Aptr, lda_, Bptr, M_, N_, K_, FT, ...) do { pg8::Gemm g{Aptr, Bptr, M_, N_, K_, lda_, 0, 0}; if (G == 256) { g.ready = CW_RDY(i); g.ready_target = 128u; } pg8::StaticOrder S; S.init(M_, N_, K_, G, bx); \
        pg8::EpiRows<FT, false, true> E{FT{__VA_ARGS__}}; pg8::gemm_phase<false>(lds, g, S, E, STREAM_CTL(ep_)); } while (0)
#define GEMM_DOWN(Aptr, Bptr, FIN) do { \
        if (G == 256) { pg8::Gemm g{Aptr, Bptr, MT, DM, DFF, DFF, 0, 0}; pg8::SplitTailOrder S; S.init(DFF, bx); pg8::EpiRows<FResid<FIN>, false, true> E{FResid<FIN>{XB, Y, SSQ}}; \
            pg8::gemm_phase<false>(lds, g, S, E, STREAM_CTL(0), EpiPartStore{(float*)(ws + WS_PART), bx & 15}); \
            if (FIN) { xcd_barrier(bar); sample_fixup<FIN>(bx, (const float*)(ws + WS_PART), XB, Y, SSQ); } } \
        else GEMM_PHASE_STATIC(0, Aptr, DFF, 0, 0, Bptr, MT, DM, DFF, FResid<FIN>, XB, Y, SSQ); } while (0)

    if (IN(PH_PRO)) for (int rep_ = 0; rep_ < REPN(10); ++rep_) {
        LAS float* scr = (LAS float*)(lds + wave * 16384);
        constexpr int I0 = 16 * 49, I1 = 4 * 16, I3 = 2 * 4;
        constexpr int NITEMS = I0 + 2 * I1 + 4 * I3;
        for (int it = gw; it < NITEMS; it += NGW) {
            int r = it;
            if (r < I0) { p0_transpose_item(w_in_even, 1568, 1568, WIN0T, DM, norm_mix, scr, r, lane); continue; } r -= I0;
            if (r < I1) { p0_transpose_item(w_uk, 512, 512, WKVT, KVR, nullptr, scr, r, lane); continue; } r -= I1;
            if (r < I1) { p0_transpose_item(w_uv, 512, 512, WKVT + (size_t)512 * KVR, KVR, nullptr, scr, r, lane); continue; } r -= I1;
            { const int g = r / I3; p0_transpose_item(w_pool + (size_t)g * 128 * 128, 128, 128, WPOOLT + (size_t)g * 128 * 256 + (g & 1) * 128, 256, nullptr, scr, r % I3, lane); }
        }
        { u32x4* z0 = (u32x4*)(WIN0T + (size_t)1568 * DM); const u32x4 zz = {0u, 0u, 0u, 0u};
          for (int e = bx * NTHR + tid; e < (NZ0 - 1568) * DM / 8; e += G * NTHR) z0[e] = zz;
          for (int e = bx * NTHR + tid; e < 512 * 16; e += G * NTHR) { const int n = e >> 4, c8 = e & 15; *(u32x4*)(WPOOLT + (size_t)n * 256 + (1 - ((n >> 7) & 1)) * 128 + c8 * 8) = zz; }
          for (int e = bx * NTHR + tid; e < 2048 * 16; e += G * NTHR) { const int n = e >> 4, c8 = e & 15; *(u32x4*)(WGATET + (size_t)n * 256 + (1 - ((n >> 8) & 1)) * 128 + c8 * 8) = zz; } }
        { float* ROPET = (float*)(ws + WS_ROPE);
          for (int e = bx * NTHR + tid; e < (SEQ + DT) * 16; e += G * NTHR) { const int pi = e >> 4, i = e & 15; const int pos = pi < SEQ ? pi : PAST + (pi - SEQ);
              const float inv = powf(10000.0f, -(float)i / 16.0f); const float ang = (float)pos * inv; ROPET[e * 2] = cosf(ang); ROPET[e * 2 + 1] = sinf(ang); } }
        if (bx == G - 1) for (int c = tid; c < DM; c += NTHR) ((float*)(ws + WS_SP8))[c] = log1pf(expf(-lru_lambda[c])) * (8.0f * 1.4426950408889634f);
        {
#define XROW(r_) ((r_) < MP ? x_prompt + (size_t)(r_) * DM : x_sample + (size_t)((r_) - MP) * DM)
            f32x4 nv[4]; if (gw < MT) rowprep_load(XROW(gw), lane, nv);
            for (int row = gw; row < MT; row += NGW) { f32x4 v[4];
#pragma unroll
                for (int j = 0; j < 4; ++j) v[j] = nv[j];
                const int nr = row + NGW; if (nr < MT) rowprep_load(XROW(nr), lane, nv);
                rowprep_row(v, row, XB, SSQ, lane); }
#undef XROW
        }
    }
    SEAM(PH_PRO);
    if (REP_ID == 40) { for (int i = 0; i < 10; ++i) xcd_barrier(bar); }
    if (IN(PH_Z0)) for (int rep_ = 0; rep_ < REPN(1); ++rep_) GEMM_PHASE_P8(1, XB, DM, WIN0T, MT, NZ0, DM, FZ0, SSQ, Z0);
    SEAM(PH_Z0);
    if (IN(PH_POST0)) for (int rep_ = 0; rep_ < REPN(2); ++rep_) {
        const float* ROPET = (const float*)(ws + WS_ROPE);
        for (int row = gw; row < MT; row += NGW) post0_row(row, lane, Z0, ROPET, g_q_nope, g_q_rope, g_ckv, g_k_rope, QB, CB, KRB, out);
        for (int it = bx * NTHR + tid; it < (MP / 16) * 64; it += G * NTHR) pool_item_p16((it >> 6) * 16, (it & 63) * 8, Z0, DBuf, out);
        for (int it = bx * NTHR + tid; it < DB_ * 64; it += G * NTHR) pool_item<false>(MP + (it >> 6) * DT, DT, (it & 63) * 8, Z0, state_pool, DBuf, out);
    }
    SEAM(PH_POST0);
    if (IN(PH_KVPOOL) && REP_ID == 13) { GEMM_PHASE(14, CB, KVR, 0, 0, WKVT, MT, 1024, KVR, FRawBf16<1024>, (bf16_t*)(ws + WS_DBG)); GEMM_PHASE_STATIC(15, DBuf, POOLD, 256, 0, WPOOLT, MT, POOLD, 256, FPool, pool_scale, MIX); }
    if (IN(PH_KVPOOL)) {
        { pg8::Gemm g{CB, WKVT, MT, 1024, KVR, KVR, 0, 0}; pg8::StaticOrder S; S.init(MT, 1024, KVR, G, bx); pg8::EpiRows<FKvNorm, true, true> E{FKvNorm{KV, g_k_nope}}; pg8::gemm_phase<false>(lds, g, S, E, STREAM_CTL(2)); }
        { pg8::Gemm g{DBuf, WPOOLT, MT, POOLD, 256, POOLD, 256, 0}; pg8::StaticOrder S; S.init(MT, POOLD, 256, G, (G == 256) ? ((bx + 240) & 255) : bx); pg8::EpiRows<FPool, false, true> E{FPool{pool_scale, MIX}}; pg8::gemm_phase<false>(lds, g, S, E, STREAM_CTL(3)); }
    }
#if DBG_KNORM
    if (IN(PH_KVPOOL)) GEMM_PHASE_STATIC(16, CB, KVR, 0, 0, WKVT, MT, 1024, KVR, FRawBf16<1024>, (bf16_t*)(ws + WS_DBG));
#endif
    SEAM(PH_KVPOOL);
#if DBG_KNORM
    if (IN(PH_KNORM)) { const bf16_t* R = (const bf16_t*)(ws + WS_DBG); unsigned bad = 0;
        for (int row = gw; row < MT; row += NGW) {
            for (int h = 0; h < NH; ++h) { const float x = bf2f(R[(size_t)row * 1024 + h * 64 + lane]); const float ss = wave_sum(x * x); const float y = x * rsqrtf(ss * (1.f / 64.f) + EPS) * g_k_nope[lane];
                const float a = bf2f(KV[(size_t)row * 1024 + h * 64 + lane]); if (!(fabsf(a - y) <= 0.02f + 0.02f * fabsf(y))) ++bad; }
            for (int c = lane; c < 512; c += 64) { const float y = bf2f(R[(size_t)row * 1024 + 512 + c]), a = bf2f(KV[(size_t)row * 1024 + 512 + c]); if (!(fabsf(a - y) <= 1e-3f + 0.01f * fabsf(y))) ++bad; } }
        if (bad) atomicAdd((unsigned*)(ws + WS_CTL) + CW_DBG, bad); }
#endif
    if (IN(PH_ATTN)) {
        LAS float* sc = (LAS float*)(lds + wave * 16768);
#if DBG_ATTN_P
        for (int it = gw; it < MP * NH; it += NGW) attn_p_naive_item(it, lane, sc, QB, KV, KRB, (bf16_t*)(ws + WS_DBG));
        __syncthreads();
#endif
#ifndef NO_ATTN_P
        { const int vcu = (G % 8 == 0) ? (bx % 8) * (G / 8) + bx / 8 : bx;
          for (int rep_ = 0; rep_ < REPN(3); ++rep_) for (int pi = vcu; pi < 256; pi += G) { const int bh = pi >> 3, s8 = pi & 7; attn_p_unit(bh >> 3, bh & 7, 15 - s8, lds, QB, KV, KRB, MIX); attn_p_unit(bh >> 3, bh & 7, s8, lds, QB, KV, KRB, MIX); }
          asm volatile("s_waitcnt vmcnt(0)" ::: "memory"); __syncthreads(); }
#endif
#if DBG_ATTN_S
        for (int it = bx; it < (NPAGES + 1) * DB_; it += G) attn_s_scores_item(it % (NPAGES + 1), it / (NPAGES + 1), tid, cache_ckv, cache_kr, page_table, QB, CB, KRB, w_uk, g_k_nope, SC);
        __syncthreads();
#endif
        if (REP_ID >= 20 && REP_ID <= 24) for (int u = bx; u < 2 * DB_; u += G) attn_s_unit<(REP_ID >= 20 && REP_ID <= 24) ? REP_ID - 19 : 1>(u, lds, cache_ckv, cache_kr, page_table, QB, WKVT, g_k_nope, (float*)(ws + WS_DBG), (float*)(ws + WS_DBG + 40 * MiB));
        for (int rep_ = 0; rep_ < REPN(4); ++rep_) for (int u = bx; u < 2 * DB_; u += G) attn_s_unit<0>(u, lds, cache_ckv, cache_kr, page_table, QB, WKVT, g_k_nope, (float*)(ws + WS_LATP), (float*)(ws + WS_ML));
        asm volatile("s_waitcnt vmcnt(0)" ::: "memory"); __syncthreads();
    }
    SEAM(PH_ATTN);
#if DBG_ATTN_P
    if (IN(PH_ATTN2)) {
        const bf16_t* R = (const bf16_t*)(ws + WS_DBG); unsigned bad = 0;
        for (size_t i = (size_t)bx * NTHR + tid; i < (size_t)MP * 512; i += (size_t)G * NTHR) { const size_t row = i >> 9, c = 512 + (i & 511); const float a = bf2f(MIX[row * DM + c]), r = bf2f(R[row * DM + c]);
            if (!(fabsf(a - r) <= 0.01f + 0.02f * fabsf(r))) ++bad; }
        if (bad) atomicAdd((unsigned*)(ws + WS_CTL) + CW_DBG, bad);
    }
#endif
    if (IN(PH_ATTN2)) { __syncthreads();
#if DBG_ATTN_S
        for (int sb = bx; sb < DB_; sb += G) attn_s_pv_item(sb, tid, (LAS float*)lds, cache_ckv, page_table, CB, SC, w_uv, LAT, (bf16_t*)(ws + WS_DBG));
        __syncthreads();
#endif
        for (int sb = bx; sb < DB_; sb += G) attn_s_combine(sb, lds, QB, KV, KRB, WKVT, (const float*)(ws + WS_LATP), (const float*)(ws + WS_ML), MIX);
#if DBG_ATTN_S
        asm volatile("s_waitcnt vmcnt(0)" ::: "memory"); __syncthreads();
        { const bf16_t* R = (const bf16_t*)(ws + WS_DBG); unsigned bad = 0; float num_ = 0.f, den_ = 0.f;
          for (int sb = bx; sb < DB_; sb += G) for (int i = tid; i < DT * 512; i += NTHR) { const size_t row = (size_t)MP + sb * DT + (i >> 9), c = 512 + (i & 511); const float a = bf2f(MIX[row * DM + c]), r = bf2f(R[row * DM + c]);
              num_ += (a - r) * (a - r); den_ += r * r; if (!(fabsf(a - r) <= 0.02f + 0.5f * fabsf(r))) ++bad; }
          if (bad) atomicAdd((unsigned*)(ws + WS_CTL) + CW_DBG, bad);
          num_ = wave_sum(num_); den_ = wave_sum(den_); if (lane == 0) { atomicAdd((float*)(ws + WS_CTL) + CW_DBG + 2, num_); atomicAdd((float*)(ws + WS_CTL) + CW_DBG + 3, den_); } }
#endif
    }
    if (IN(PH_ATTN2) && bx >= DB_) {
        LAS float* scr = (LAS float*)(lds + wave * 16384);
        for (int it = (bx - DB_) * NWAVES + wave; it < 16 * 32; it += (G - DB_) * NWAVES) p0_transpose_item(w_out_even, DM, DM, WOUT0T, DM, nullptr, scr, it, lane);
        if (G == 256) for (int it = (bx - DB_) * NWAVES + wave; it < 16 * 128; it += (G - DB_) * NWAVES) p0_transpose_item(w_up, DFF, DFF, WUPT, DM, norm_ffn, scr, it, lane);
    }
    SEAM(PH_ATTN2);
    if (IN(PH_OUT0)) GEMM_RESID_SPLIT(MIX, DM, WOUT0T, DM);
    if (IN(PH_OUT0) && G != 256) {
        const int gw2 = bx * NWAVES + wave, NGW2 = G * NWAVES;
        LAS float* scr = (LAS float*)(lds + wave * 16384);
        constexpr int I8 = 16 * 128, I10 = 64 * 32;
        for (int it = gw2; it < I8 + I10; it += NGW2) {
            if (it < I8) p0_transpose_item(w_up, DFF, DFF, WUPT, DM, norm_ffn, scr, it, lane);
            else p0_transpose_item(w_down, DM, DM, WDNT, DFF, nullptr, scr, it - I8, lane);
        }
    }
    SEAM(PH_OUT0);
    if (IN(PH_UP0) && REP_ID == 30) GEMM_PHASE(30, XB, DM, 0, 0, WUPT, MT, DFF, DM, FNull, (float*)(ws + WS_DBG));
    if (IN(PH_UP0)) { FIXUP_DEFERRED(0, 8); GEMM_PHASE_P8_RDY(0, 5, XB, DM, WUPT, MT, DFF, DM, FUp, SSQ, H); }
    if (IN(PH_UP0)) {
        const int nidle = G - 64;
        if (G == 256 ? (bx >= 64) : true) {
            const int gw2 = (G == 256 ? (bx - 64) : bx) * NWAVES + wave, NGW2 = (G == 256 ? nidle : G) * NWAVES;
            LAS float* scr = (LAS float*)(lds + wave * 16384);
            constexpr int I3 = 2 * 4, I7 = 16 * 32, I8 = 16 * 128, I10 = 64 * 32, I12 = 16 * 64;
            constexpr int NIT2 = I8 + I10 + I12 + 16 * I3 + I7;
            if (G == 256) for (int it = gw2; it < I10; it += NGW2) p0_transpose_item(w_down, DM, DM, WDNT, DFF, nullptr, scr, it, lane);
            for (int it = gw2; it < NIT2; it += NGW2) {
                int r = it;
                if (r < I8) { p0_transpose_item(w_up + (size_t)DM * DFF, DFF, DFF, WUPT + (size_t)DFF * DM, DM, norm_ffn + DM, scr, r, lane); continue; } r -= I8;
                if (r < I10) { p0_transpose_item(w_down + (size_t)DFF * DM, DM, DM, WDNT + (size_t)DM * DFF, DFF, nullptr, scr, r, lane); continue; } r -= I10;
                if (r < I12) { p0_transpose_item(w_in_rnn, 2048, 2048, WINRT, DM, norm_mix + DM, scr, r, lane); continue; } r -= I12;
                if (r < 16 * I3) { const int q = r / I3, n = q >> 1, isx = q & 1; const float* src = (isx ? w_gate_x : w_gate_a) + (size_t)n * 128 * 128;
                    p0_transpose_item(src, 128, 128, WGATET + (size_t)(n * 256 + isx * 128) * 256 + (n & 1) * 128, 256, nullptr, scr, r % I3, lane); continue; } r -= 16 * I3;
                p0_transpose_item(w_out_rnn, DM, DM, WOUTRT, DM, nullptr, scr, r, lane);
            }
        }
    }
    SEAM(PH_UP0);
    if (IN(PH_DN0)) GEMM_DOWN(H, WDNT, false);
    SEAM(PH_DN0);
    if (IN(PH_RNNIN)) { FIXUP_DEFERRED(1, 16); GEMM_PHASE_P8_RDY(1, 7, XB, DM, WINRT, MT, 2048, DM, FRnnIn, SSQ, GATE, U); }
    SEAM(PH_RNNIN);
    if (IN(PH_CONV)) for (int rep_ = 0; rep_ < REPN(12); ++rep_) {
        for (int it = bx * NTHR + tid; it < (MP / 16) * 128; it += G * NTHR) conv_item_p16((it >> 7) * 16, (it & 127) * 8, U, conv_w, conv_b, V, out);
        for (int it = bx * NTHR + tid; it < DB_ * 128; it += G * NTHR) conv_item<false>(MP + (it >> 7) * DT, DT, (it & 127) * 8, U, state_conv, conv_w, conv_b, V, out);
    }
    SEAM(PH_CONV);
    if (IN(PH_GATES)) for (int rep_ = 0; rep_ < REPN(9); ++rep_) { pg8::Gemm g{V, WGATET, MT, 2048, 256, DM, 256, 1}; pg8::StaticOrder S; S.init(G == 256 ? MP : MT, 2048, 256, G, bx);
        EpiGates E{V, b_gate_a, b_gate_x, (const float*)(ws + WS_SP8), (bf16_t*)(ws + WS_HL), (bf16_t*)(ws + WS_AC), (float*)(ws + WS_SUM)}; pg8::gemm_phase<false>(lds, g, S, E, STREAM_CTL(8)); }
    SEAM(PH_GATES);
    if (IN(PH_SCAN)) for (int rep_ = 0; rep_ < REPN(11); ++rep_) {
        const bf16_t* HL = (const bf16_t*)(ws + WS_HL); const bf16_t* AC = (const bf16_t*)(ws + WS_AC); const float* SUM = (const float*)(ws + WS_SUM);
        for (int idx = bx * NTHR + tid; idx < 256 * 4 * 128; idx += G * NTHR) {
            const int wv_ = idx >> 6, cg = (wv_ & 7) * 16 + (idx & 15), qt = (idx >> 4) & 3, segp = wv_ >> 3, sq = segp & 63, ch = cg * 8;
            u32x4 rhl[2][8], rac[2][8], rgt[2][8];
#define SCAN_LD(bt_) do { _Pragma("unroll") for (int t = 0; t < 8; ++t) { const size_t off = (size_t)(segp * 64 + qt * 16 + (bt_) * 8 + t) * DM + ch; rhl[bt_][t] = *(const u32x4*)(HL + off); rac[bt_][t] = *(const u32x4*)(AC + off); rgt[bt_][t] = *(const u32x4*)(GATE + off); } } while (0)
            SCAN_LD(0);
            float h[8];
#pragma unroll
            for (int e = 0; e < 8; ++e) h[e] = 0.f;
            if (qt == 0)
#pragma unroll 4
            for (int k = 0; k < sq; ++k) {
                const f32x4* sp4 = (const f32x4*)(SUM + ((size_t)(segp - sq + k) * DM + ch) * 2);
                const f32x4 s0 = sp4[0], s1 = sp4[1], s2 = sp4[2], s3 = sp4[3];
                h[0] = s0.x * h[0] + s0.y; h[1] = s0.z * h[1] + s0.w; h[2] = s1.x * h[2] + s1.y; h[3] = s1.z * h[3] + s1.w;
                h[4] = s2.x * h[4] + s2.y; h[5] = s2.z * h[5] + s2.w; h[6] = s3.x * h[6] + s3.y; h[7] = s3.z * h[7] + s3.w;
            }
#pragma unroll
            for (int e = 0; e < 8; ++e) h[e] = __int_as_float(__builtin_amdgcn_ds_bpermute((idx & 15) * 4, __float_as_int(h[e])));
            SCAN_LD(1);
#undef SCAN_LD
#pragma unroll
            for (int t = 0; t < 16; ++t) {
                const size_t off = (size_t)(segp * 64 + qt * 16 + t) * DM + ch;
                const u32x4 hl = rhl[t >> 3][t & 7], ac = rac[t >> 3][t & 7], gt = rgt[t >> 3][t & 7];
                float hv[8]; u32x4 o;
#pragma unroll
                for (int e2 = 0; e2 < 4; ++e2) {
                    hv[2 * e2] = __uint_as_float(hl[e2] << 16) + __uint_as_float(ac[e2] << 16) * h[2 * e2];
                    hv[2 * e2 + 1] = __uint_as_float(hl[e2] & 0xffff0000u) + __uint_as_float(ac[e2] & 0xffff0000u) * h[2 * e2 + 1];
                    o[e2] = pk2(__uint_as_float(gt[e2] << 16) * hv[2 * e2], __uint_as_float(gt[e2] & 0xffff0000u) * hv[2 * e2 + 1]);
                }
                *(u32x4*)(YB + off) = o;
                if (sq == 63 && qt == 3 && t == 15) {
#pragma unroll
                    for (int e = 0; e < 8; ++e) out[O_LRU_P + (size_t)(segp >> 6) * DM + ch + e] = hv[e];
                }
            }
        }
        if (G == 256) { for (int item = bx; item < (DB_ / 2) * 8; item += G) gates_sample_item(item, wave, lane, V, WGATET, b_gate_a, b_gate_x, (const float*)(ws + WS_SP8), GATE, state_lru, YB, out); }
        else
        for (int idx = bx * NTHR + tid; idx < DB_ * 128; idx += G * NTHR) {
            const int cg = idx & 127, sb = idx >> 7, ch = cg * 8;
            float h[8];
#pragma unroll
            for (int e = 0; e < 8; ++e) h[e] = state_lru[(size_t)sb * DM + ch + e];
            for (int t = 0; t < DT; ++t) {
                const size_t off = (size_t)(MP + sb * DT + t) * DM + ch;
                const u32x4 hl = *(const u32x4*)(HL + off), ac = *(const u32x4*)(AC + off), gt = *(const u32x4*)(GATE + off);
                float hv[8]; u32x4 o;
#pragma unroll
                for (int e2 = 0; e2 < 4; ++e2) {
                    hv[2 * e2] = __uint_as_float(hl[e2] << 16) + __uint_as_float(ac[e2] << 16) * h[2 * e2];
                    hv[2 * e2 + 1] = __uint_as_float(hl[e2] & 0xffff0000u) + __uint_as_float(ac[e2] & 0xffff0000u) * h[2 * e2 + 1];
                    o[e2] = pk2(__uint_as_float(gt[e2] << 16) * hv[2 * e2], __uint_as_float(gt[e2] & 0xffff0000u) * hv[2 * e2 + 1]);
                }
                *(u32x4*)(YB + off) = o;
                if (t == DT - 1) {
#pragma unroll
                    for (int e = 0; e < 8; ++e) out[O_LRU_S + (size_t)sb * DM + ch + e] = hv[e];
                }
            }
        }
    }
    SEAM(PH_SCAN);
    if (IN(PH_OUTR)) GEMM_RESID_SPLIT(YB, DM, WOUTRT, DM);
    SEAM(PH_OUTR);
    if (IN(PH_UP1)) { FIXUP_DEFERRED(2, 8); GEMM_PHASE_P8_RDY(2, 10, XB, DM, WUPT + (size_t)DFF * DM, MT, DFF, DM, FUp, SSQ, H); }
    SEAM(PH_UP1);
#if DBG_ANY
    if (IN(PH_DN1)) { const float n_ = __hip_atomic_load((float*)(ws + WS_CTL) + CW_DBG + 2, __ATOMIC_RELAXED, __HIP_MEMORY_SCOPE_AGENT), d_ = __hip_atomic_load((float*)(ws + WS_CTL) + CW_DBG + 3, __ATOMIC_RELAXED, __HIP_MEMORY_SCOPE_AGENT);
        if ((__hip_atomic_load((unsigned*)(ws + WS_CTL) + CW_DBG, __ATOMIC_RELAXED, __HIP_MEMORY_SCOPE_AGENT) != 0u || n_ > DBG_RVR * d_) && bx == 0 && tid == 0) out[O_LRU_S] = __builtin_nanf(""); }
#endif
    if (IN(PH_DN1)) GEMM_DOWN(H, WDNT + (size_t)DM * DFF, true);
#undef IN
#undef SEAM
#undef GEMM_PHASE
}

#ifndef MK_ONE
#define MK_ONE 1
#endif
extern "C" void kernel_launch(void* const* d_in, const int* in_sizes, int n_in, void* d_out, int out_size, void* d_ws, size_t ws_size, hipStream_t stream) {
    (void)in_sizes; (void)out_size;
    static int grid = 0;
    if (grid == 0) {
        if (n_in != 32 || ws_size < WS_END) { fprintf(stderr, "kernel_launch: unexpected inputs / workspace\n"); grid = -1; return; }
        int dev = 0, cus = 0, per_cu = 0;
        if (hipGetDevice(&dev) != hipSuccess || hipDeviceGetAttribute(&cus, hipDeviceAttributeMultiprocessorCount, dev) != hipSuccess) { grid = -1; return; }
        if (hipFuncSetAttribute((const void*)mk, hipFuncAttributeMaxDynamicSharedMemorySize, LDS_BYTES) != hipSuccess) { fprintf(stderr, "kernel_launch: hipFuncSetAttribute failed\n"); grid = -1; return; }
        if (hipOccupancyMaxActiveBlocksPerMultiprocessor(&per_cu, (const void*)mk, NTHR, LDS_BYTES) != hipSuccess || per_cu < 1) { fprintf(stderr, "kernel_launch: occupancy query reports %d\n", per_cu); }
        (void)hipGetLastError();
        grid = cus;
    }
    if (grid < 0) return;
    unsigned char* ws = (unsigned char*)d_ws;
    (void)hipMemsetAsync(ws + WS_CTL, 0, CTL_ZERO_BYTES, stream);
    Args a{};
    for (int i = 0; i < 32; ++i) a.in[i] = d_in[i];
    a.out = (float*)d_out; a.ws = ws;
#if MK_ONE
    a.ph_lo = 0; a.ph_hi = PH_COUNT;
    hipLaunchKernelGGL(mk, dim3(grid), dim3(NTHR), LDS_BYTES, stream, a);
#else
    for (int p = 0; p < PH_COUNT; ++p) { a.ph_lo = p; a.ph_hi = p + 1; hipLaunchKernelGGL(mk, dim3(grid), dim3(NTHR), LDS_BYTES, stream, a); }
#endif
}
```

```cpp
#include <hip/hip_runtime.h>
#include <stdint.h>
#include <math.h>
#include <stdio.h>

#define DI __device__ __forceinline__
#define LAS __attribute__((address_space(3)))
typedef unsigned short bf16_t;
typedef short bf16x8 __attribute__((ext_vector_type(8)));
typedef float f32x4 __attribute__((ext_vector_type(4)));
typedef float f32x16 __attribute__((ext_vector_type(16)));
typedef unsigned u32x2 __attribute__((ext_vector_type(2)));
typedef unsigned u32x4 __attribute__((ext_vector_type(4)));

constexpr int DM = 1024, SEQ = 4096, NB = 4, MP = NB * SEQ  , DB_ = 128, DT = 8, MS = DB_ * DT  , MT = MP + MS  ;
constexpr int PAST = 8192, PAGE = 128, NPAGES = PAST / PAGE  , NKEYS = PAST + DT  ;
constexpr int POOLD = 512, QDIM = 768, KVR = 256, ROPE = 32, NH = 8, QKH = 96, NOPE = 64, VH = 64;
constexpr int NZ0 = 1792  , DFF = 4096;
constexpr float EPS = 1e-6f;
constexpr float SM_SCALE = 0.10206207261596577f;
constexpr float QSCALE = 0.10206207261596577f * 1.4426950408889634f;

constexpr size_t O_Y = 0;
constexpr size_t O_CKV_P = (size_t)MT * DM;
constexpr size_t O_KR_P = O_CKV_P + (size_t)MP * KVR;
constexpr size_t O_POOL_P = O_KR_P + (size_t)MP * ROPE;
constexpr size_t O_CONV_P = O_POOL_P + (size_t)NB * 15 * POOLD;
constexpr size_t O_LRU_P = O_CONV_P + (size_t)NB * 3 * DM;
constexpr size_t O_CKV_S = O_LRU_P + (size_t)NB * DM;
constexpr size_t O_KR_S = O_CKV_S + (size_t)MS * KVR;
constexpr size_t O_POOL_S = O_KR_S + (size_t)MS * ROPE;
constexpr size_t O_CONV_S = O_POOL_S + (size_t)DB_ * 15 * POOLD;
constexpr size_t O_LRU_S = O_CONV_S + (size_t)DB_ * 3 * DM;
constexpr size_t O_END = O_LRU_S + (size_t)DB_ * DM;
static_assert(O_END == 24393728, "output size");

constexpr size_t MiB = 1u << 20;
constexpr size_t WS_CTL = 0, CTL_ZERO_BYTES = 256 * 1024;
constexpr size_t WS_WIN0T = 1 * MiB;
constexpr size_t WS_WKVT = 5 * MiB;
constexpr size_t WS_WPOOLT = 6 * MiB;
constexpr size_t WS_WGATET = 7 * MiB;
constexpr size_t WS_WOUT0T = 8 * MiB;
constexpr size_t WS_WOUTRT = 10 * MiB;
constexpr size_t WS_WINRT = 12 * MiB;
constexpr size_t WS_WUPT = 16 * MiB;
constexpr size_t WS_WDNT = 32 * MiB;
constexpr size_t WS_SSQ = 48 * MiB;
constexpr size_t WS_SP8 = 49 * MiB + 96 * 1024;
constexpr size_t WS_ROPE = 49 * MiB + 128 * 1024;
constexpr size_t WS_XB = 50 * MiB;
constexpr size_t WS_Z0 = 84 * MiB;
constexpr size_t WS_QB = 144 * MiB;
constexpr size_t WS_CB = 170 * MiB;
constexpr size_t WS_KRB = 179 * MiB;
constexpr size_t WS_DB = 181 * MiB;
constexpr size_t WS_KV = 944 * MiB;
constexpr size_t WS_MIX = 230 * MiB;
constexpr size_t WS_H = 264 * MiB;
constexpr size_t WS_GATE = 400 * MiB;
constexpr size_t WS_U = 434 * MiB;
constexpr size_t WS_V = 468 * MiB;
constexpr size_t WS_G = 502 * MiB;
constexpr size_t WS_HL = WS_G, WS_AC = WS_G + 34 * MiB, WS_SUM = WS_G + 68 * MiB;
constexpr size_t WS_YB = 638 * MiB;
constexpr size_t WS_SC = 672 * MiB;
constexpr size_t WS_LAT = 930 * MiB;
constexpr size_t WS_ACCS = 1136 * MiB;
constexpr size_t WS_PART = 1140 * MiB;
constexpr size_t WS_END = 1140 * MiB + 2 * 256 * 262144;
constexpr int CW_BAR = 4096;
constexpr int CW_DBG = 64;
constexpr int CW_SKT = 128;
constexpr int CW_SKF = 32768;
constexpr size_t WS_DBG = 1000 * MiB;
constexpr size_t WS_LATP = 980 * MiB;
constexpr size_t WS_ML = 998 * MiB;
#ifndef DBG_ATTN_P
#define DBG_ATTN_P 0
#endif
#ifndef DBG_ATTN_S
#define DBG_ATTN_S 0
#endif
#ifndef DBG_KNORM
#define DBG_KNORM 0
#endif
#ifndef DBG_RVR
#define DBG_RVR 0.004f
#endif
#define DBG_ANY (DBG_ATTN_P || DBG_ATTN_S || DBG_KNORM)
#define MERGE_ATTN2 (!DBG_ANY)
#ifndef REP_ID
#define REP_ID 0
#endif
#define REPN(id) ((REP_ID == (id)) ? 2 : 1)

constexpr int NWAVES = 8, NTHR = NWAVES * 64;
constexpr int LDS_BYTES = 163840;
constexpr int LDS_MISC = LDS_BYTES - 1024;

DI unsigned f2bf(float f) { unsigned u = __float_as_uint(f); return (u + 0x7fffu + ((u >> 16) & 1u)) >> 16; }
DI float bf2f(bf16_t b) { return __uint_as_float(((unsigned)b) << 16); }
DI unsigned pk2(float lo, float hi) { return f2bf(lo) | (f2bf(hi) << 16); }
DI float xsum16(float x) { auto r = __builtin_amdgcn_permlane16_swap(__float_as_uint(x), __float_as_uint(x), false, false); return __uint_as_float(r[0]) + __uint_as_float(r[1]); }
DI float xsum32(float x) { auto r = __builtin_amdgcn_permlane32_swap(__float_as_uint(x), __float_as_uint(x), false, false); return __uint_as_float(r[0]) + __uint_as_float(r[1]); }
DI float xmax16(float x) { auto r = __builtin_amdgcn_permlane16_swap(__float_as_uint(x), __float_as_uint(x), false, false); return fmaxf(__uint_as_float(r[0]), __uint_as_float(r[1])); }
DI float xmax32(float x) { auto r = __builtin_amdgcn_permlane32_swap(__float_as_uint(x), __float_as_uint(x), false, false); return fmaxf(__uint_as_float(r[0]), __uint_as_float(r[1])); }
template <int CTRL> DI float dppf(float v) { return __int_as_float(__builtin_amdgcn_update_dpp(0, __float_as_int(v), CTRL, 0xF, 0xF, true)); }
DI float xchg4(float v, bool upper) { const float a = dppf<0x104>(v), b = dppf<0x114>(v); return upper ? b : a; }
DI float max8(float v) { v = fmaxf(v, dppf<0xB1>(v)); v = fmaxf(v, dppf<0x4E>(v)); v = fmaxf(v, dppf<0x141>(v)); return v; }
DI float sum8(float v) { v += dppf<0xB1>(v); v += dppf<0x4E>(v); v += dppf<0x141>(v); return v; }
DI float sum16(float v) { v = sum8(v); v += dppf<0x140>(v); return v; }
DI float wave_sum(float v) { return xsum32(xsum16(sum16(v))); }
DI float wave_max(float v) {
#pragma unroll
    for (int o = 1; o < 64; o <<= 1) v = fmaxf(v, __shfl_xor(v, o));
    return v;
}
DI float row_rinv(const float* SSQ, int row) {
    float s = 0.f;
#pragma unroll
    for (int p = 0; p < 16; ++p) s += SSQ[(size_t)p * MT + row];
    return rsqrtf(s * (1.0f / DM) + EPS);
}
DI float max3f(float a, float b, float c) { float r; asm("v_max3_f32 %0, %1, %2, %3" : "=v"(r) : "v"(a), "v"(b), "v"(c)); return r; }
DI float gelu_tanh(float x) { const float u = 0.7978845608028654f * (x + 0.044715f * x * x * x); return x * __builtin_amdgcn_rcpf(1.0f + __builtin_amdgcn_exp2f(-2.0f * 1.4426950408889634f * u)); }
DI float sigmoidf(float x) { return 1.f / (1.f + expf(-x)); }

struct UPre { float v[8]; };
namespace pg8 {
constexpr int BM = 256, BK = 64, HALF = 128, HTB = HALF * BK * 2, STAGE_BYTES = 8 * HTB, NXCD = 8, WGM = 8;
__host__ __device__ __forceinline__ int lds_byte(int r, int c) { const int st = (r >> 4) * 2 + (c >> 5), rr = r & 15, cc = c & 31, ob = rr * 64 + cc * 2; return st * 1024 + (ob ^ (((ob >> 9) & 1) << 5)); }
__host__ __device__ __forceinline__ void stage_rc(int b, int& R, int& C) { const int st = b / 1024, sb = b % 1024, swz = sb ^ (((sb >> 9) & 1) << 5); R = (st >> 1) * 16 + swz / 64; C = (st & 1) * 32 + (swz % 64) / 2; }
struct Unit { int pm, pn; };
struct Gemm { const bf16_t* A; const bf16_t* Bt; int M, N, K, lda, a_tile_off, a_shift; unsigned* ready = nullptr; unsigned ready_target = 0; };
struct Seg { int pm, pn, t0, t1; };
struct StreamOrder {
    int nM, nN, ppu, ub, lo, hi;
    DI void init(int M, int N, int K, int G, int c) {
        nM = M / BM; nN = N / BM; ppu = K / (2 * BK);
        const int nwg = nM * nN, x = c % NXCD, k = c / NXCD, nk = G / NXCD, q = nwg / NXCD, r = nwg % NXCD;
        ub = x * q + (x < r ? x : r); const int cnt = q + (x < r ? 1 : 0); const int Pr = cnt * ppu;
        lo = (k * Pr) / nk; hi = ((k + 1) * Pr) / nk;
    }
    DI bool next(int i, Seg& s) const {
        const int ul = lo / ppu + i, start = ul * ppu; if (start >= hi) return false;
        const int p0 = (lo > start ? lo : start) - start, p1 = ((hi < start + ppu) ? hi : start + ppu) - start;
        s.t0 = 2 * p0; s.t1 = 2 * p1;
        const int wgid = ub + ul, nig = WGM * nN, gid = wgid / nig, fm = gid * WGM, gsz = (nM - fm) < WGM ? (nM - fm) : WGM;
        s.pm = fm + ((wgid % nig) % gsz); s.pn = (wgid % nig) / gsz; return true;
    }
};
struct SplitTailOrder {
    int nt, c, ways, plen;
    DI void init(int K, int c_) { nt = K / BK; c = c_; ways = 16; plen = nt / 16; if (plen < 2) { plen = 2; ways = nt / 2; } }
    DI bool next(int i, Seg& u) const {
        if (i == 0) { u.t0 = 0; u.t1 = nt; const int xcd = c % NXCD, off = c / NXCD, wgid = xcd * 32 + off; u.pm = (wgid >> 5) * 8 + (wgid & 7); u.pn = (wgid >> 3) & 3; return true; }
        if (i == 1) { const int us = c >> 4, part = c & 15; if (part >= ways) return false; u.pm = 64 + (us >> 2); u.pn = us & 3; u.t0 = part * plen; u.t1 = u.t0 + plen; return true; }
        return false;
    }
};
struct StaticOrder {
    int nM, nN, nwg, G, c, nt;
    DI void init(int M, int N, int K, int G_, int c_) { nM = M / BM; nN = N / BM; nwg = nM * nN; G = G_; c = c_; nt = K / BK; }
    DI bool next(int i, Seg& u) const {
        u.t0 = 0; u.t1 = nt;
        const long L = (long)i * G + c; if (L >= nwg) return false;
        int wgid = (int)L; { const int q = nwg / NXCD, r = nwg % NXCD, xcd = wgid % NXCD, off = wgid / NXCD; wgid = (xcd < r ? xcd * (q + 1) : r * (q + 1) + (xcd - r) * q) + off; }
        const int nig = WGM * nN, gid = wgid / nig, fm = gid * WGM, gsz = (nM - fm) < WGM ? (nM - fm) : WGM;
        u.pm = fm + ((wgid % nig) % gsz); u.pn = (wgid % nig) / gsz; return true;
    }
};
struct NoPre {};
__host__ __device__ __forceinline__ int perm32(int rho) { const int n = rho >> 4, i = rho & 15; return 8 * (i >> 2) + 4 * n + (i & 3); }
template <class F, bool P64 = false, bool P8 = false> struct EpiRows {
    F f;
    static constexpr bool PERM64 = P64;
    static constexpr bool PERM8 = P8;
    DI UPre unit_pre(int pm) const { return f.unit_pre(pm * BM); }
    DI void operator()(const f32x4 (&acc)[2][2][4][2], const Unit& u, int wr, int wc, int fr, int fq, const UPre& upre) const {
        constexpr int BJS = P64 ? 32 : HALF;
        const int row0 = u.pm * BM + wr * 64 + fr, col0 = u.pn * BM + wc * (P64 ? 64 : 32) + (P8 ? 8 : 4) * fq;
        f.unit_begin(u.pm * BM, upre);
        typename F::RowPre rp[2][4]; typename F::Pre pr[2][4][2][2]; typename F::Pre8 pr8[2][4][2];
#pragma unroll
        for (int ai = 0; ai < 2; ++ai) {
#pragma unroll
            for (int m = 0; m < 4; ++m) rp[ai][m] = f.row_pre(row0 + ai * HALF + m * 16);
#pragma unroll
            for (int m = 0; m < 4; ++m)
#pragma unroll
                for (int bj = 0; bj < 2; ++bj)
#pragma unroll
                    for (int n = 0; n < 2; ++n) { if constexpr (P8) { if (n == 0) pr8[ai][m][bj] = f.pre8(row0 + ai * HALF + m * 16, col0 + bj * BJS); } else pr[ai][m][bj][n] = f.pre(row0 + ai * HALF + m * 16, col0 + bj * BJS + n * 16); }
        }
#pragma unroll
        for (int ai = 0; ai < 2; ++ai) {
#pragma unroll
            for (int m = 0; m < 4; ++m) {
                const int row = row0 + ai * HALF + m * 16;
                typename F::Ctx ctx = f.row_begin(row, rp[ai][m]);
                if constexpr (P8) {
#pragma unroll
                    for (int bj = 0; bj < 2; ++bj) f.op8(ctx, row, col0 + bj * BJS, acc[ai][bj][m][0], acc[ai][bj][m][1], pr8[ai][m][bj]);
                } else {
#pragma unroll
                    for (int bj = 0; bj < 2; ++bj)
#pragma unroll
                        for (int n = 0; n < 2; ++n) f(ctx, row, col0 + bj * BJS + n * 16, acc[ai][bj][m][n], pr[ai][m][bj][n]);
                }
                f.row_end(ctx, row, u.pn, wc, fq);
            }
        }
    }
};

struct StreamCtl { float* part; unsigned* flags; unsigned* tmo; unsigned epoch; int c; int pad; };
struct NoPart { DI void operator()(const f32x4 (&)[2][2][4][2], const Unit&, int, int, int, int) const {} };
template <bool STREAM, class Sched, class Epi, class EpiPart = NoPart>
DI void gemm_phase(LAS unsigned char* lds, const Gemm g, const Sched& S, const Epi& E, const StreamCtl sc, const EpiPart EP = EpiPart()) {
    const int tid = threadIdx.x, wid = __builtin_amdgcn_readfirstlane(tid >> 6), lane = tid & 63, wr = wid >> 2, wc = wid & 3, fr = lane & 15, fq = lane >> 4;
    const int K = g.K, nt = K / BK;
    unsigned voffA[2], voffB[2];
#pragma unroll
    for (int i = 0; i < 2; ++i) { int R, C; stage_rc(tid * 16 + i * 8192, R, C); const int r31 = Epi::PERM8 ? perm32(R & 31) : (R & 31); const int Rb = Epi::PERM64 ? (64 * (R >> 5) + r31) : ((R & ~31) + r31); voffA[i] = (unsigned)(R * g.lda + C) * 2u; voffB[i] = (unsigned)(Rb * K + C) * 2u; }
    const size_t kstep = (size_t)(BK * 2);
    const size_t hstepA = (size_t)HALF * g.lda * 2, hstepB = (size_t)(Epi::PERM64 ? 32 : HALF) * K * 2;
    const size_t tstepA = 2 * hstepA, tstepB = (size_t)BM * K * 2, pstepA = (size_t)g.a_tile_off * 2;
    const unsigned ldsw = (unsigned)wid * 1024u;
    const int aoff = lds_byte(wr * 64 + fr, fq * 8), boff = lds_byte(wc * 32 + fr, fq * 8);
#define PG8_SA(b, h) (((b) * 2 + (h)) * HTB)
#define PG8_SB(b, h) ((4 + (b) * 2 + (h)) * HTB)
#define PG8_STAGE(bufoff, gbase, voff) do { _Pragma("unroll") for (int _i = 0; _i < 2; ++_i) \
        __builtin_amdgcn_global_load_lds((const unsigned*)((const char*)(gbase) + (voff)[_i]), (LAS unsigned*)(lds + (bufoff) + ldsw + _i * 8192), 16, 0, 0); } while (0)
#define PG8_LDA(dst, b, h) do { _Pragma("unroll") for (int m = 0; m < 4; ++m) _Pragma("unroll") for (int k = 0; k < 2; ++k) dst[m][k] = *(const LAS bf16x8*)(lds + PG8_SA(b, h) + aoff + m * 2048 + k * 1024); } while (0)
#define PG8_LDB(dst, b, h) do { _Pragma("unroll") for (int n = 0; n < 2; ++n) _Pragma("unroll") for (int k = 0; k < 2; ++k) dst[n][k] = *(const LAS bf16x8*)(lds + PG8_SB(b, h) + boff + n * 2048 + k * 1024); } while (0)
#define PG8_MMA(ai, bj, At, Bt) do { __builtin_amdgcn_s_setprio(1); _Pragma("unroll") for (int m = 0; m < 4; ++m) _Pragma("unroll") for (int n = 0; n < 2; ++n) _Pragma("unroll") for (int k = 0; k < 2; ++k) \
        acc[ai][bj][m][n] = __builtin_amdgcn_mfma_f32_16x16x32_bf16(Bt[n][k], At[m][k], acc[ai][bj][m][n], 0, 0, 0); __builtin_amdgcn_s_setprio(0); } while (0)
#define PG8_WAIT_V(n) asm volatile("s_waitcnt vmcnt(" #n ")" ::: "memory")
#define PG8_WAIT_L(n) asm volatile("s_waitcnt lgkmcnt(" #n ")" ::: "memory")
#define PG8_BAR __builtin_amdgcn_s_barrier()
#define PG8_SCHED __builtin_amdgcn_sched_barrier(0)
    Seg cur = {0, 0, 0, 0}, nxt = {0, 0, 0, 0}; int ui = 0;
    if (!S.next(0, cur)) return;
    bool waited = g.ready == nullptr;
#define PG8_READY_WAIT() do { if (wid == 0) { unsigned sp_ = 0; \
            while (__hip_atomic_load(g.ready, __ATOMIC_RELAXED, __HIP_MEMORY_SCOPE_AGENT) < g.ready_target) { __builtin_amdgcn_s_sleep(2); if (++sp_ > (1u << 22)) break; } \
            __builtin_amdgcn_fence(__ATOMIC_ACQUIRE, "agent"); asm volatile("s_waitcnt vmcnt(0)" ::: "memory"); } \
        PG8_BAR; asm volatile("" ::: "memory"); waited = true; } while (0)
#define PG8_BAR __builtin_amdgcn_s_barrier()
    if (!waited && cur.pm >= MP / 256) PG8_READY_WAIT();
    f32x4 acc[2][2][4][2];
#pragma unroll
    for (int a = 0; a < 2; ++a)
#pragma unroll
        for (int b = 0; b < 2; ++b)
#pragma unroll
            for (int m = 0; m < 4; ++m)
#pragma unroll
                for (int n = 0; n < 2; ++n) acc[a][b][m][n] = (f32x4){0.f, 0.f, 0.f, 0.f};
    bf16x8 At[4][2], B0[2][2], B1[2][2];
    const char* cA = (const char*)g.A + (size_t)cur.pm * tstepA + (size_t)(cur.pn >> g.a_shift) * pstepA + (size_t)cur.t0 * kstep;
    const char* cB = (const char*)g.Bt + (size_t)cur.pn * tstepB + (size_t)cur.t0 * kstep;
    PG8_STAGE(PG8_SB(0, 0), cB, voffB); PG8_STAGE(PG8_SB(0, 1), cB + hstepB, voffB); PG8_STAGE(PG8_SA(0, 0), cA, voffA); PG8_STAGE(PG8_SA(0, 1), cA + hstepA, voffA);
    if (wr == 1) PG8_BAR;
    PG8_WAIT_V(2); PG8_BAR;
    PG8_STAGE(PG8_SB(1, 0), cB + kstep, voffB); PG8_STAGE(PG8_SA(1, 0), cA + kstep, voffA); PG8_STAGE(PG8_SB(1, 1), cB + hstepB + kstep, voffB);
    PG8_WAIT_V(6); PG8_BAR;
    for (;;) {
        const bool has_next = S.next(ui + 1, nxt);
        if (!waited && has_next && nxt.pm >= MP / 256) PG8_READY_WAIT();
        const char* nA = has_next ? (const char*)g.A + (size_t)nxt.pm * tstepA + (size_t)(nxt.pn >> g.a_shift) * pstepA + (size_t)nxt.t0 * kstep : cA;
        const char* nB = has_next ? (const char*)g.Bt + (size_t)nxt.pn * tstepB + (size_t)nxt.t0 * kstep : cB;
        const int nseg = cur.t1 - cur.t0;
        UPre upre{}; if (STREAM || nseg == nt) upre = E.unit_pre(cur.pm);
#pragma unroll 1
        for (int t = 0; t < nseg; t += 2) {
            const bool last = (t == nseg - 2);
            const char* a1 = cA + (size_t)(t + 1) * kstep;
            const char* a2 = last ? nA : cA + (size_t)(t + 2) * kstep; const char* b2 = last ? nB : cB + (size_t)(t + 2) * kstep;
            const char* a3 = a2 + kstep; const char* b3 = b2 + kstep;
            PG8_LDB(B0, 0, 0); PG8_LDB(B1, 0, 1); PG8_SCHED; PG8_LDA(At, 0, 0); PG8_STAGE(PG8_SA(1, 1), a1 + hstepA, voffA);
            PG8_WAIT_V(8); PG8_WAIT_L(0); PG8_BAR; PG8_MMA(0, 0, At, B0); PG8_MMA(0, 1, At, B1); PG8_BAR; PG8_SCHED;
            PG8_LDA(At, 0, 1); PG8_STAGE(PG8_SB(0, 0), b2, voffB); PG8_STAGE(PG8_SB(0, 1), b2 + hstepB, voffB); PG8_STAGE(PG8_SA(0, 0), a2, voffA);
            PG8_WAIT_V(8); PG8_WAIT_L(0); PG8_BAR; PG8_MMA(1, 0, At, B0); PG8_MMA(1, 1, At, B1); PG8_BAR; PG8_SCHED;
            PG8_LDB(B0, 1, 0); PG8_LDB(B1, 1, 1); PG8_SCHED; PG8_LDA(At, 1, 0); PG8_STAGE(PG8_SA(0, 1), a2 + hstepA, voffA);
            PG8_WAIT_V(8); PG8_WAIT_L(0); PG8_BAR; PG8_MMA(0, 0, At, B0); PG8_MMA(0, 1, At, B1); PG8_BAR; PG8_SCHED;
            PG8_LDA(At, 1, 1); PG8_STAGE(PG8_SB(1, 0), b3, voffB); PG8_STAGE(PG8_SB(1, 1), b3 + hstepB, voffB); PG8_STAGE(PG8_SA(1, 0), a3, voffA);
            PG8_WAIT_V(8); PG8_WAIT_L(0); PG8_BAR; PG8_MMA(1, 0, At, B0); PG8_MMA(1, 1, At, B1); PG8_BAR; PG8_SCHED;
        }
        if (wr == 0) PG8_BAR;
        if (STREAM && cur.t0 > 0) {
            const __amdgpu_buffer_rsrc_t prs = __builtin_amdgcn_make_buffer_rsrc((void*)(sc.part + ((size_t)(sc.epoch & 1u) * gridDim.x + sc.c) * 65536), (short)0, 262144, 0x00020000);
#pragma unroll
            for (int a = 0; a < 2; ++a)
#pragma unroll
                for (int b = 0; b < 2; ++b)
#pragma unroll
                    for (int m = 0; m < 4; ++m)
#pragma unroll
                        for (int n = 0; n < 2; ++n) { const int j = ((a * 2 + b) * 4 + m) * 2 + n; const f32x4 v = acc[a][b][m][n];
                            __builtin_amdgcn_raw_buffer_store_b128(__builtin_bit_cast(u32x4, v), prs, (unsigned)tid * 16u, j * 8192, 16); }
            asm volatile("s_waitcnt vmcnt(0)" ::: "memory");
            PG8_BAR;
            if (tid == 0) __hip_atomic_store(sc.flags + (size_t)sc.c * 64, sc.epoch, __ATOMIC_RELAXED, __HIP_MEMORY_SCOPE_AGENT);
        } else {
            Unit uu; uu.pm = cur.pm; uu.pn = cur.pn;
            if (!STREAM && (cur.t1 - cur.t0) != nt) EP(acc, uu, wr, wc, fr, fq); else E(acc, uu, wr, wc, fr, fq, upre);
        }
        if (!has_next) break;
        if (STREAM && nxt.t1 < nt) {
            const int pc = sc.c + NXCD;
            if (wid == 0) {
                unsigned* fl = sc.flags + (size_t)pc * 64; unsigned sp = 0; bool ok = true;
                while (__hip_atomic_load(fl, __ATOMIC_RELAXED, __HIP_MEMORY_SCOPE_AGENT) != sc.epoch) {
                    __builtin_amdgcn_s_sleep(1);
                    if ((++sp & 255u) == 0u) { if (__hip_atomic_load(sc.tmo, __ATOMIC_RELAXED, __HIP_MEMORY_SCOPE_AGENT) != 0u || sp > (1u << 20)) { ok = false; break; } }
                }
                if (!ok && lane == 0) __hip_atomic_store(sc.tmo, 1u, __ATOMIC_RELAXED, __HIP_MEMORY_SCOPE_AGENT);
                __builtin_amdgcn_fence(__ATOMIC_ACQUIRE, "agent");
                asm volatile("s_waitcnt vmcnt(0)" ::: "memory");
            }
            PG8_BAR; asm volatile("" ::: "memory");
            const __amdgpu_buffer_rsrc_t crs = __builtin_amdgcn_make_buffer_rsrc((void*)(sc.part + ((size_t)(sc.epoch & 1u) * gridDim.x + pc) * 65536), (short)0, 262144, 0x00020000);
#pragma unroll
            for (int a = 0; a < 2; ++a)
#pragma unroll
                for (int b = 0; b < 2; ++b)
#pragma unroll
                    for (int m = 0; m < 4; ++m)
#pragma unroll
                        for (int n = 0; n < 2; ++n) acc[a][b][m][n] = __builtin_bit_cast(f32x4, __builtin_amdgcn_raw_buffer_load_b128(crs, (unsigned)tid * 16u, ((((a * 2 + b) * 4 + m) * 2 + n) * 8192), 0));
        } else {
#pragma unroll
            for (int a = 0; a < 2; ++a)
#pragma unroll
                for (int b = 0; b < 2; ++b)
#pragma unroll
                    for (int m = 0; m < 4; ++m)
#pragma unroll
                        for (int n = 0; n < 2; ++n) acc[a][b][m][n] = (f32x4){0.f, 0.f, 0.f, 0.f};
        }
        cur = nxt; cA = nA; cB = nB; ++ui;
        if (wr == 1) PG8_BAR;
    }
    PG8_WAIT_V(0);
    PG8_BAR;
#undef PG8_SA
#undef PG8_SB
#undef PG8_STAGE
#undef PG8_LDA
#undef PG8_LDB
#undef PG8_MMA
#undef PG8_WAIT_V
#undef PG8_WAIT_L
#undef PG8_BAR
#undef PG8_SCHED
}
}

constexpr int LDS_RINV = 131072;
DI UPre rinv_partial_load(const float* SSQ, int rowbase) {
    const int tid = threadIdx.x, r = tid >> 1, hf = tid & 1;
    UPre u;
#pragma unroll
    for (int p = 0; p < 8; ++p) u.v[p] = SSQ[(size_t)(hf * 8 + p) * MT + rowbase + r];
    return u;
}
DI void rinv_table_fill(const UPre& u) {
    extern __shared__ __attribute__((aligned(16))) unsigned char lds_raw_[];
    LAS float* tab = (LAS float*)((LAS unsigned char*)lds_raw_ + LDS_RINV);
    const int tid = threadIdx.x, r = tid >> 1, hf = tid & 1;
    float sv = ((u.v[0] + u.v[1]) + (u.v[2] + u.v[3])) + ((u.v[4] + u.v[5]) + (u.v[6] + u.v[7]));
    sv += dppf<0xB1>(sv);
    if (hf == 0) tab[r] = rsqrtf(sv * (1.0f / DM) + EPS);
    asm volatile("s_waitcnt lgkmcnt(0)" ::: "memory"); __builtin_amdgcn_s_barrier(); asm volatile("" ::: "memory");
}
DI float rinv_table_get(int row) {
    extern __shared__ __attribute__((aligned(16))) unsigned char lds_raw_[];
    return ((const LAS float*)((LAS unsigned char*)lds_raw_ + LDS_RINV))[row & 255];
}
struct FZ0 { typedef float Ctx; typedef float RowPre; typedef pg8::NoPre Pre; typedef pg8::NoPre Pre8; const float* SSQ; bf16_t* Z;
    DI UPre unit_pre(int rowbase) const { return rinv_partial_load(SSQ, rowbase); }
    DI void unit_begin(int, const UPre& sv) const { rinv_table_fill(sv); }
    DI RowPre row_pre(int row) const { return rinv_table_get(row); }
    DI Pre pre(int, int) const { return Pre{}; }
    DI pg8::NoPre pre8(int, int) const { return pg8::NoPre{}; }
    DI Ctx row_begin(int, const RowPre& rp) const { return rp; }
    DI void operator()(Ctx& ri, int row, int col, f32x4 v, const Pre&) const { u32x2 o; o.x = pk2(v.x * ri, v.y * ri); o.y = pk2(v.z * ri, v.w * ri); *(u32x2*)(Z + (size_t)row * NZ0 + col) = o; }
    DI void op8(Ctx& ri, int row, int col, f32x4 a, f32x4 b, const pg8::NoPre&) const { u32x4 o; o.x = pk2(a.x * ri, a.y * ri); o.y = pk2(a.z * ri, a.w * ri); o.z = pk2(b.x * ri, b.y * ri); o.w = pk2(b.z * ri, b.w * ri); *(u32x4*)(Z + (size_t)row * NZ0 + col) = o; }
    DI void row_end(Ctx&, int, int, int, int) const {} };
template <int LDO> struct FRawBf16 { typedef int Ctx; typedef pg8::NoPre RowPre; typedef pg8::NoPre Pre; typedef pg8::NoPre Pre8; bf16_t* O;
    DI UPre unit_pre(int) const { return UPre{}; }
    DI void unit_begin(int, const UPre&) const {}
    DI RowPre row_pre(int) const { return RowPre{}; }
    DI Pre pre(int, int) const { return Pre{}; }
    DI pg8::NoPre pre8(int, int) const { return pg8::NoPre{}; }
    DI Ctx row_begin(int, const RowPre&) const { return 0; }
    DI void operator()(Ctx&, int row, int col, f32x4 v, const Pre&) const { u32x2 o; o.x = pk2(v.x, v.y); o.y = pk2(v.z, v.w); *(u32x2*)(O + (size_t)row * LDO + col) = o; }
    DI void row_end(Ctx&, int, int, int, int) const {} };
struct KvCtx { f32x4 v[4]; int col0; int k; };
struct FKvNorm { typedef KvCtx Ctx; typedef pg8::NoPre RowPre; typedef pg8::NoPre Pre; typedef pg8::NoPre Pre8; bf16_t* O; const float* g;
    DI UPre unit_pre(int) const { return UPre{}; }
    DI void unit_begin(int, const UPre&) const {}
    DI RowPre row_pre(int) const { return RowPre{}; }
    DI Pre pre(int, int) const { return Pre{}; }
    DI pg8::NoPre pre8(int, int) const { return pg8::NoPre{}; }
    DI Ctx row_begin(int, const RowPre&) const { Ctx c; c.k = 0; c.col0 = 0; return c; }
    DI void operator()(Ctx&, int, int, f32x4, const Pre&) const {}
    DI void op8(Ctx& c, int, int col, f32x4 a, f32x4 b, const pg8::NoPre&) const { if (c.k == 0) c.col0 = col; c.v[c.k] = a; c.v[c.k + 1] = b; c.k += 2; }
    DI void row_end(Ctx& c, int row, int pn, int, int) const {
        float ri = 1.0f;
        if (pn < 2) { float ss = 0.f;
#pragma unroll
            for (int k = 0; k < 4; ++k) ss += c.v[k].x * c.v[k].x + c.v[k].y * c.v[k].y + c.v[k].z * c.v[k].z + c.v[k].w * c.v[k].w;
            ss = xsum32(xsum16(ss)); ri = rsqrtf(ss * (1.f / 64.f) + EPS); }
#pragma unroll
        for (int bj = 0; bj < 2; ++bj) { const int col = c.col0 + bj * 32; f32x4 y0 = c.v[2 * bj] * ri, y1 = c.v[2 * bj + 1] * ri;
            if (pn < 2) { y0 = y0 * *(const f32x4*)(g + (col & 63)); y1 = y1 * *(const f32x4*)(g + (col & 63) + 4); }
            u32x4 o; o.x = pk2(y0.x, y0.y); o.y = pk2(y0.z, y0.w); o.z = pk2(y1.x, y1.y); o.w = pk2(y1.z, y1.w); *(u32x4*)(O + (size_t)row * 1024 + col) = o; }
    } };
struct FPool { typedef int Ctx; typedef pg8::NoPre RowPre; typedef f32x4 Pre; typedef pg8::NoPre Pre8; const float* scale; bf16_t* MIX;
    DI pg8::NoPre pre8(int, int) const { return pg8::NoPre{}; }
    DI void op8(Ctx&, int row, int col, f32x4 a, f32x4 b, const pg8::NoPre&) const { const f32x4 s0 = *(const f32x4*)(scale + col), s1 = *(const f32x4*)(scale + col + 4);
        u32x4 o; o.x = pk2(a.x * s0.x, a.y * s0.y); o.y = pk2(a.z * s0.z, a.w * s0.w); o.z = pk2(b.x * s1.x, b.y * s1.y); o.w = pk2(b.z * s1.z, b.w * s1.w); *(u32x4*)(MIX + (size_t)row * DM + col) = o; }
    DI UPre unit_pre(int) const { return UPre{}; }
    DI void unit_begin(int, const UPre&) const {}
    DI RowPre row_pre(int) const { return RowPre{}; }
    DI Pre pre(int, int col) const { return *(const f32x4*)(scale + col); }
    DI Ctx row_begin(int, const RowPre&) const { return 0; }
    DI void operator()(Ctx&, int row, int col, f32x4 v, const Pre& s) const { u32x2 o; o.x = pk2(v.x * s.x, v.y * s.y); o.y = pk2(v.z * s.z, v.w * s.w); *(u32x2*)(MIX + (size_t)row * DM + col) = o; }
    DI void row_end(Ctx&, int, int, int, int) const {} };
template <bool FINAL> struct FResid { typedef float Ctx; typedef pg8::NoPre RowPre; typedef u32x2 Pre; typedef u32x4 Pre8; bf16_t* RB; float* Yf; float* SSQ;
    DI Pre8 pre8(int row, int col) const { return *(const u32x4*)(RB + (size_t)row * DM + col); }
    DI void op8(Ctx& ss, int row, int col, f32x4 a, f32x4 b, const Pre8& r) const {
        f32x4 y0, y1; y0.x = __uint_as_float(r.x << 16) + a.x; y0.y = __uint_as_float(r.x & 0xffff0000u) + a.y; y0.z = __uint_as_float(r.y << 16) + a.z; y0.w = __uint_as_float(r.y & 0xffff0000u) + a.w;
        y1.x = __uint_as_float(r.z << 16) + b.x; y1.y = __uint_as_float(r.z & 0xffff0000u) + b.y; y1.z = __uint_as_float(r.w << 16) + b.z; y1.w = __uint_as_float(r.w & 0xffff0000u) + b.w;
        if (FINAL) { *(f32x4*)(Yf + (size_t)row * DM + col) = y0; *(f32x4*)(Yf + (size_t)row * DM + col + 4) = y1; }
        else { u32x4 o; o.x = pk2(y0.x, y0.y); o.y = pk2(y0.z, y0.w); o.z = pk2(y1.x, y1.y); o.w = pk2(y1.z, y1.w); *(u32x4*)(RB + (size_t)row * DM + col) = o;
            ss += y0.x * y0.x + y0.y * y0.y + y0.z * y0.z + y0.w * y0.w + y1.x * y1.x + y1.y * y1.y + y1.z * y1.z + y1.w * y1.w; } }
    DI UPre unit_pre(int) const { return UPre{}; }
    DI void unit_begin(int, const UPre&) const {}
    DI RowPre row_pre(int) const { return RowPre{}; }
    DI Pre pre(int row, int col) const { return *(const u32x2*)(RB + (size_t)row * DM + col); }
    DI Ctx row_begin(int, const RowPre&) const { return 0.f; }
    DI void operator()(Ctx& ss, int row, int col, f32x4 v, const Pre& r) const {
        f32x4 y; y.x = __uint_as_float(r.x << 16) + v.x; y.y = __uint_as_float(r.x & 0xffff0000u) + v.y; y.z = __uint_as_float(r.y << 16) + v.z; y.w = __uint_as_float(r.y & 0xffff0000u) + v.w;
        if (FINAL) { *(f32x4*)(Yf + (size_t)row * DM + col) = y; }
        else { u32x2 o; o.x = pk2(y.x, y.y); o.y = pk2(y.z, y.w); *(u32x2*)(RB + (size_t)row * DM + col) = o; ss += y.x * y.x + y.y * y.y + y.z * y.z + y.w * y.w; } }
    DI void row_end(Ctx& ss, int row, int pn, int wc, int fq) const { if (!FINAL) { const float s = xsum32(xsum16(ss)); if (fq == 0) SSQ[(size_t)(pn * 4 + wc) * MT + row] = s; } } };
struct FNull { typedef int Ctx; typedef pg8::NoPre RowPre; typedef pg8::NoPre Pre; typedef pg8::NoPre Pre8; float* sink;
    DI UPre unit_pre(int) const { return UPre{}; }
    DI void unit_begin(int, const UPre&) const {}
    DI RowPre row_pre(int) const { return RowPre{}; }
    DI Pre pre(int, int) const { return Pre{}; }
    DI pg8::NoPre pre8(int, int) const { return pg8::NoPre{}; }
    DI Ctx row_begin(int, const RowPre&) const { return 0; }
    DI void operator()(Ctx&, int row, int col, f32x4 v, const Pre&) const { if (v.x == 1.2345e30f) sink[row + col] = v.y; }
    DI void row_end(Ctx&, int, int, int, int) const {} };
struct FUp { typedef float Ctx; typedef float RowPre; typedef pg8::NoPre Pre; typedef pg8::NoPre Pre8; const float* SSQ; bf16_t* H;
    DI UPre unit_pre(int rowbase) const { return rinv_partial_load(SSQ, rowbase); }
    DI void unit_begin(int, const UPre& sv) const { rinv_table_fill(sv); }
    DI RowPre row_pre(int row) const { return rinv_table_get(row); }
    DI Pre pre(int, int) const { return Pre{}; }
    DI pg8::NoPre pre8(int, int) const { return pg8::NoPre{}; }
    DI Ctx row_begin(int, const RowPre& rp) const { return rp; }
    DI void operator()(Ctx& ri, int row, int col, f32x4 v, const Pre&) const { f32x4 t = v * ri; t.x = fmaxf(t.x, 0.f); t.y = fmaxf(t.y, 0.f); t.z = fmaxf(t.z, 0.f); t.w = fmaxf(t.w, 0.f);
        u32x2 o; o.x = pk2(t.x * t.x, t.y * t.y); o.y = pk2(t.z * t.z, t.w * t.w); *(u32x2*)(H + (size_t)row * DFF + col) = o; }
    DI void op8(Ctx& ri, int row, int col, f32x4 a, f32x4 b, const pg8::NoPre&) const { f32x4 t = a * ri, w = b * ri;
        t.x = fmaxf(t.x, 0.f); t.y = fmaxf(t.y, 0.f); t.z = fmaxf(t.z, 0.f); t.w = fmaxf(t.w, 0.f); w.x = fmaxf(w.x, 0.f); w.y = fmaxf(w.y, 0.f); w.z = fmaxf(w.z, 0.f); w.w = fmaxf(w.w, 0.f);
        u32x4 o; o.x = pk2(t.x * t.x, t.y * t.y); o.y = pk2(t.z * t.z, t.w * t.w); o.z = pk2(w.x * w.x, w.y * w.y); o.w = pk2(w.z * w.z, w.w * w.w); *(u32x4*)(H + (size_t)row * DFF + col) = o; }
    DI void row_end(Ctx&, int, int, int, int) const {} };
struct FRnnIn { typedef float Ctx; typedef float RowPre; typedef pg8::NoPre Pre; typedef pg8::NoPre Pre8; const float* SSQ; bf16_t* GATE; bf16_t* U;
    DI UPre unit_pre(int rowbase) const { return rinv_partial_load(SSQ, rowbase); }
    DI void unit_begin(int, const UPre& sv) const { rinv_table_fill(sv); }
    DI RowPre row_pre(int row) const { return rinv_table_get(row); }
    DI Pre pre(int, int) const { return Pre{}; }
    DI pg8::NoPre pre8(int, int) const { return pg8::NoPre{}; }
    DI Ctx row_begin(int, const RowPre& rp) const { return rp; }
    DI void operator()(Ctx& ri, int row, int col, f32x4 v, const Pre&) const { f32x4 t = v * ri; u32x2 o;
        if (col < DM) { o.x = pk2(gelu_tanh(t.x), gelu_tanh(t.y)); o.y = pk2(gelu_tanh(t.z), gelu_tanh(t.w)); *(u32x2*)(GATE + (size_t)row * DM + col) = o; }
        else { o.x = pk2(t.x, t.y); o.y = pk2(t.z, t.w); *(u32x2*)(U + (size_t)row * DM + col - DM) = o; } }
    DI void op8(Ctx& ri, int row, int col, f32x4 a, f32x4 b, const pg8::NoPre&) const { const f32x4 t = a * ri, w = b * ri; u32x4 o;
        if (col < DM) { o.x = pk2(gelu_tanh(t.x), gelu_tanh(t.y)); o.y = pk2(gelu_tanh(t.z), gelu_tanh(t.w)); o.z = pk2(gelu_tanh(w.x), gelu_tanh(w.y)); o.w = pk2(gelu_tanh(w.z), gelu_tanh(w.w)); *(u32x4*)(GATE + (size_t)row * DM + col) = o; }
        else { o.x = pk2(t.x, t.y); o.y = pk2(t.z, t.w); o.z = pk2(w.x, w.y); o.w = pk2(w.z, w.w); *(u32x4*)(U + (size_t)row * DM + col - DM) = o; } }
    DI void row_end(Ctx&, int, int, int, int) const {} };

typedef float f32x2_t __attribute__((ext_vector_type(2))); typedef __bf16 bf16x2_t __attribute__((ext_vector_type(2)));
DI unsigned cvtpk(float lo, float hi) { f32x2_t v = {lo, hi}; bf16x2_t b = __builtin_convertvector(v, bf16x2_t); return __builtin_bit_cast(unsigned, b); }
struct EpiPartStore { float* PARTS; int part;
    DI void operator()(const f32x4 (&acc)[2][2][4][2], const pg8::Unit& u, int, int, int, int) const {
        const int us = (u.pm - MP / 256) * 4 + u.pn;
        f32x4* p = (f32x4*)(PARTS + (size_t)(us * 16 + part) * 65536) + threadIdx.x;
#pragma unroll
        for (int a = 0; a < 2; ++a)
#pragma unroll
            for (int b = 0; b < 2; ++b)
#pragma unroll
                for (int m = 0; m < 4; ++m)
#pragma unroll
                    for (int n = 0; n < 2; ++n) p[(((a * 2 + b) * 4 + m) * 2 + n) * 512] = acc[a][b][m][n];
    }
};
template <bool FINAL, int WAYS = 16> DI void sample_fixup(int b, const float* __restrict__ PARTS, bf16_t* __restrict__ RB, float* __restrict__ Yf, float* __restrict__ SSQ) {
    if (b >= 128) return;
    const int tid = threadIdx.x, wid = tid >> 6, lane = tid & 63, wr = wid >> 2, wc = wid & 3, fr = lane & 15, fq = lane >> 4;
    const int us = b >> 3, ai = (b >> 2) & 1, m = b & 3, pm = MP / 256 + (us >> 2), pn = us & 3;
    f32x4 v[2][2];
#pragma unroll
    for (int bj = 0; bj < 2; ++bj)
#pragma unroll
        for (int n = 0; n < 2; ++n) v[bj][n] = (f32x4){0.f, 0.f, 0.f, 0.f};
#pragma unroll 8
    for (int p = 0; p < WAYS; ++p) {
        const f32x4* pp = (const f32x4*)(PARTS + (size_t)(us * 16 + p) * 65536) + tid;
#pragma unroll
        for (int bj = 0; bj < 2; ++bj)
#pragma unroll
            for (int n = 0; n < 2; ++n) v[bj][n] += pp[(((ai * 2 + bj) * 4 + m) * 2 + n) * 512];
    }
    const int row = pm * 256 + ai * 128 + wr * 64 + m * 16 + fr, col0 = pn * 256 + wc * 32 + 8 * fq;
    float ss = 0.f;
#pragma unroll
    for (int bj = 0; bj < 2; ++bj)
#pragma unroll
        for (int n = 0; n < 2; ++n) { const size_t off = (size_t)row * DM + col0 + bj * 128 + n * 4; const u32x2 r = *(const u32x2*)(RB + off); const f32x4 a = v[bj][n];
            f32x4 y; y.x = __uint_as_float(r.x << 16) + a.x; y.y = __uint_as_float(r.x & 0xffff0000u) + a.y; y.z = __uint_as_float(r.y << 16) + a.z; y.w = __uint_as_float(r.y & 0xffff0000u) + a.w;
            if (FINAL) *(f32x4*)(Yf + off) = y;
            else { u32x2 o; o.x = pk2(y.x, y.y); o.y = pk2(y.z, y.w); *(u32x2*)(RB + off) = o; ss += y.x * y.x + y.y * y.y + y.z * y.z + y.w * y.w; } }
    if (!FINAL) { ss = xsum32(xsum16(ss)); if (fq == 0) SSQ[(size_t)(pn * 4 + wc) * MT + row] = ss; }
}
template <int SH> DI float dpp_row_shr(float oldv, float v) { return __int_as_float(__builtin_amdgcn_update_dpp(__float_as_int(oldv), __float_as_int(v), 0x110 + SH, 0xF, 0xF, false)); }
template <int SH> DI void scan_step(float& a, float& b, int fseg) {
    float ap = dpp_row_shr<SH>(1.0f, a), bp = dpp_row_shr<SH>(0.0f, b);
    if (fseg < SH) { ap = 1.0f; bp = 0.0f; }
    b = a * bp + b; a = a * ap;
}
struct EpiGates {
    static constexpr bool PERM64 = false, PERM8 = true;
    const bf16_t* V; const float* bga; const float* bgx; const float* lam; bf16_t* HL; bf16_t* AC; float* SUM;
    DI UPre unit_pre(int) const { return UPre{}; }
    DI void operator()(f32x4 (&acc)[2][2][4][2], const pg8::Unit& u, int wr, int wc, int fr, int fq, const UPre&) const {
        const bool isp = u.pm < MP / 256;
        const int chb = u.pn * 128 + wc * 32 + 8 * fq;
        const int rowb = u.pm * 256 + wr * 64 + fr;
        u32x4 vpre[2][4];
#pragma unroll
        for (int ai = 0; ai < 2; ++ai)
#pragma unroll
            for (int m = 0; m < 4; ++m) vpre[ai][m] = *(const u32x4*)(V + (size_t)(rowb + ai * 128 + m * 16) * DM + chb);
        f32x4 sp2[2], ba2[2], bx2[2];
#pragma unroll
        for (int n = 0; n < 2; ++n) { sp2[n] = *(const f32x4*)(lam + chb + 4 * n); ba2[n] = *(const f32x4*)(bga + chb + 4 * n); bx2[n] = *(const f32x4*)(bgx + chb + 4 * n); }
        const int fseg = isp ? fr : (fr & 7);
#pragma unroll
        for (int ai = 0; ai < 2; ++ai) {
#pragma unroll
            for (int n = 0; n < 2; ++n) {
                const f32x4 sp = sp2[n], ba = ba2[n], bx = bx2[n];
#pragma unroll
                for (int m = 0; m < 4; ++m) {
                    const int row = rowb + ai * 128 + m * 16;
                    const bool pos0 = isp && ((row & (SEQ - 1)) == 0);
                    const unsigned w0 = n == 0 ? vpre[ai][m].x : vpre[ai][m].z, w1 = n == 0 ? vpre[ai][m].y : vpre[ai][m].w;
                    const float v4[4] = {__uint_as_float(w0 << 16), __uint_as_float(w0 & 0xffff0000u), __uint_as_float(w1 << 16), __uint_as_float(w1 & 0xffff0000u)};
#pragma unroll
                    for (int e = 0; e < 4; ++e) {
                        const float r = __builtin_amdgcn_rcpf(1.0f + __builtin_amdgcn_exp2f(-1.4426950408889634f * (acc[ai][0][m][n][e] + ba[e])));
                        const float ig = __builtin_amdgcn_rcpf(1.0f + __builtin_amdgcn_exp2f(-1.4426950408889634f * (acc[ai][1][m][n][e] + bx[e])));
                        const float a = __builtin_amdgcn_exp2f(-r * sp[e]);
                        const float mult = pos0 ? 1.0f : __builtin_amdgcn_sqrtf(fmaxf(1.0f - a * a, 0.0f));
                        acc[ai][0][m][n][e] = a; acc[ai][1][m][n][e] = mult * ig * v4[e];
                    }
                }
            }
            float Ac_[2][4], Hc_[2][4];
#pragma unroll
            for (int n = 0; n < 2; ++n)
#pragma unroll
                for (int e = 0; e < 4; ++e) { Ac_[n][e] = 1.0f; Hc_[n][e] = 0.0f; }
#pragma unroll
            for (int m = 0; m < 4; ++m) {
#pragma unroll
                for (int n = 0; n < 2; ++n)
#pragma unroll
                    for (int e = 0; e < 4; ++e) {
                        float a = acc[ai][0][m][n][e], b = acc[ai][1][m][n][e];
                        scan_step<1>(a, b, fseg); scan_step<2>(a, b, fseg); scan_step<4>(a, b, fseg);
                        if (isp) { scan_step<8>(a, b, fseg); b = a * Hc_[n][e] + b; a = a * Ac_[n][e]; Ac_[n][e] = __int_as_float(__builtin_amdgcn_update_dpp(0, __float_as_int(a), 0x15F, 0xF, 0xF, false)); Hc_[n][e] = __int_as_float(__builtin_amdgcn_update_dpp(0, __float_as_int(b), 0x15F, 0xF, 0xF, false)); }
                        acc[ai][0][m][n][e] = a; acc[ai][1][m][n][e] = b;
                    }
                const size_t off = (size_t)(rowb + ai * 128 + m * 16) * DM + chb;
                u32x4 oa; oa.x = pk2(acc[ai][0][m][0][0], acc[ai][0][m][0][1]); oa.y = pk2(acc[ai][0][m][0][2], acc[ai][0][m][0][3]); oa.z = pk2(acc[ai][0][m][1][0], acc[ai][0][m][1][1]); oa.w = pk2(acc[ai][0][m][1][2], acc[ai][0][m][1][3]);
                *(u32x4*)(AC + off) = oa;
                u32x4 ob; ob.x = pk2(acc[ai][1][m][0][0], acc[ai][1][m][0][1]); ob.y = pk2(acc[ai][1][m][0][2], acc[ai][1][m][0][3]); ob.z = pk2(acc[ai][1][m][1][0], acc[ai][1][m][1][1]); ob.w = pk2(acc[ai][1][m][1][2], acc[ai][1][m][1][3]);
                *(u32x4*)(HL + off) = ob;
            }
#pragma unroll
            for (int n = 0; n < 2; ++n)
#pragma unroll
                for (int e = 0; e < 4; ++e)
                    if (isp && fr == 15) { float* sm = SUM + ((size_t)(u.pm * 4 + ai * 2 + wr) * DM + chb + 4 * n + e) * 2; sm[0] = Ac_[n][e]; sm[1] = Hc_[n][e]; }
            __builtin_amdgcn_sched_barrier(0);
        }
    }
};

DI void gates_sample_item(int item, int w2, int lane, const bf16_t* __restrict__ V, const bf16_t* __restrict__ WGATET, const float* __restrict__ bga, const float* __restrict__ bgx, const float* __restrict__ SP8,
                          const bf16_t* __restrict__ GATE, const float* __restrict__ state_lru, bf16_t* __restrict__ YB, float* __restrict__ out) {
    const int p = item >> 3, n = item & 7, l15 = lane & 15, quad = lane >> 4;
    const int row0 = MP + p * 16, seq = 2 * p + (quad >> 1), rbase = row0 + 4 * quad;
    const bf16_t* ap = V + (size_t)(row0 + l15) * DM + 128 * n + 8 * quad;
    bf16x8 a[4], wa[2][4], wx[2][4];
#pragma unroll
    for (int st = 0; st < 4; ++st) a[st] = *(const bf16x8*)(ap + 32 * st);
    int ch[2]; float vv[2][4], gt[2][4], ba[2], bx_[2], sp[2], h0[2];
#pragma unroll
    for (int tt = 0; tt < 2; ++tt) {
        const int jch = 16 * (2 * w2 + tt) + l15; ch[tt] = 128 * n + jch;
        const bf16_t* bpa = WGATET + (size_t)(n * 256 + jch) * 256 + (n & 1) * 128 + 8 * quad; const bf16_t* bpx = bpa + (size_t)128 * 256;
#pragma unroll
        for (int st = 0; st < 4; ++st) { wa[tt][st] = *(const bf16x8*)(bpa + 32 * st); wx[tt][st] = *(const bf16x8*)(bpx + 32 * st); }
#pragma unroll
        for (int j = 0; j < 4; ++j) { vv[tt][j] = bf2f(V[(size_t)(rbase + j) * DM + ch[tt]]); gt[tt][j] = bf2f(GATE[(size_t)(rbase + j) * DM + ch[tt]]); }
        ba[tt] = bga[ch[tt]]; bx_[tt] = bgx[ch[tt]]; sp[tt] = SP8[ch[tt]]; h0[tt] = state_lru[(size_t)seq * DM + ch[tt]];
    }
#pragma unroll
    for (int tt = 0; tt < 2; ++tt) {
        f32x4 ca = {0.f, 0.f, 0.f, 0.f}, cx = {0.f, 0.f, 0.f, 0.f};
#pragma unroll
        for (int st = 0; st < 4; ++st) { ca = __builtin_amdgcn_mfma_f32_16x16x32_bf16(a[st], wa[tt][st], ca, 0, 0, 0); cx = __builtin_amdgcn_mfma_f32_16x16x32_bf16(a[st], wx[tt][st], cx, 0, 0, 0); }
        float Aq[4], Hq[4];
        float Ac = 1.f, Hc = 0.f;
#pragma unroll
        for (int j = 0; j < 4; ++j) {
            const float r = __builtin_amdgcn_rcpf(1.0f + __builtin_amdgcn_exp2f(-1.4426950408889634f * (ca[j] + ba[tt])));
            const float ig = __builtin_amdgcn_rcpf(1.0f + __builtin_amdgcn_exp2f(-1.4426950408889634f * (cx[j] + bx_[tt])));
            const float aa = __builtin_amdgcn_exp2f(-r * sp[tt]);
            const float bb = __builtin_amdgcn_sqrtf(fmaxf(1.0f - aa * aa, 0.0f)) * ig * vv[tt][j];
            Hc = aa * Hc + bb; Ac = aa * Ac; Aq[j] = Ac; Hq[j] = Hc;
        }
        const float pA = __int_as_float(__builtin_amdgcn_ds_bpermute((lane - 16) * 4, __float_as_int(Ac)));
        const float pH = __int_as_float(__builtin_amdgcn_ds_bpermute((lane - 16) * 4, __float_as_int(Hc)));
        const float hin = (quad & 1) ? (pA * h0[tt] + pH) : h0[tt];
#pragma unroll
        for (int j = 0; j < 4; ++j) {
            const float h = Aq[j] * hin + Hq[j];
            YB[(size_t)(rbase + j) * DM + ch[tt]] = f2bf(gt[tt][j] * h);
            if ((quad & 1) && j == 3) out[O_LRU_S + (size_t)seq * DM + ch[tt]] = h;
        }
    }
}
#define XB_TMO      128
#define XB_XCNT(j)  (256  + 64 * (j))
#define XB_XSUB(j)  (1280 + 64 * (j))
#define XB_XGEN(j)  (2304 + 64 * (j))
#define XB_TOP      3328
#define XB_TOPGEN   3392
#define XCD_BAR_WORDS 3456
#define XB_SPIN_CAP (1u << 18)
DI unsigned xb_ld(unsigned* p)              { return __hip_atomic_load(p, __ATOMIC_RELAXED, __HIP_MEMORY_SCOPE_AGENT); }
DI unsigned xb_add(unsigned* p, unsigned v) { return __hip_atomic_fetch_add(p, v, __ATOMIC_RELAXED, __HIP_MEMORY_SCOPE_AGENT); }
DI unsigned xb_xcc_id() { return (unsigned)__builtin_amdgcn_s_getreg((3 << 11) | 20) & 0xFu; }
#define XB_SPIN(cond, bar) do { unsigned _sp = 0; while (cond) { __builtin_amdgcn_s_sleep(1); \
    if ((++_sp & 255u) == 0u) { if (xb_ld(&(bar)[XB_TMO])) break; if (_sp > XB_SPIN_CAP) { atomicAdd(&(bar)[XB_TMO], 1u); break; } } } } while (0)
struct XcdBarrier { unsigned* bar; unsigned x; volatile LAS unsigned* st; };
DI XcdBarrier xcd_barrier_post(unsigned* bar, volatile LAS unsigned* st) {
    XcdBarrier b; b.bar = bar; b.x = xb_xcc_id(); b.st = st;
    if (threadIdx.x == 0) (void)xb_add(&bar[XB_XCNT(b.x)], 1u);
    return b;
}
DI void xcd_barrier_complete(unsigned* bar, unsigned x, unsigned& nloc, unsigned& nx) {
    const unsigned G = gridDim.x * gridDim.y * gridDim.z;
    unsigned sum, cnt, mine, sp = 0u;
    for (;;) {
        sum = 0u; cnt = 0u; mine = 0u;
#pragma unroll
        for (unsigned j = 0; j < 16; ++j) { const unsigned c = xb_ld(&bar[XB_XCNT(j)]); sum += c; cnt += (c > 0u) ? 1u : 0u; mine = (j == x) ? c : mine; }
        if (sum == G) break;
        __builtin_amdgcn_s_sleep(1);
        if ((++sp & 255u) == 0u) { if (xb_ld(&bar[XB_TMO])) break; if (sp > XB_SPIN_CAP) { atomicAdd(&bar[XB_TMO], 1u); break; } }
    }
    nloc = mine > 0u ? mine : 1u; nx = cnt > 0u ? cnt : 1u;
}
DI void xcd_barrier(const XcdBarrier& b) {
    asm volatile("s_waitcnt vmcnt(0)" ::: "memory");
    __syncthreads();
    if (threadIdx.x == 0) {
        unsigned* bar = b.bar;
        __builtin_amdgcn_s_waitcnt(0);
        unsigned nloc = b.st[0], nx = b.st[1];
        if (nloc == 0u) { xcd_barrier_complete(bar, b.x, nloc, nx); b.st[0] = nloc; b.st[1] = nx; }
        const unsigned old = xb_add(&bar[XB_XSUB(b.x)], 1u);
        const unsigned gen = old / nloc;
        if (old + 1u == (gen + 1u) * nloc) {
            __builtin_amdgcn_fence(__ATOMIC_RELEASE, "agent");
            asm volatile("s_waitcnt vmcnt(0)" ::: "memory");
            const unsigned og = xb_add(&bar[XB_TOP], 1u);
            const unsigned tg = og / nx;
            if (og + 1u == (tg + 1u) * nx) xb_add(&bar[XB_TOPGEN], 1u);
            else XB_SPIN(xb_ld(&bar[XB_TOPGEN]) == tg, bar);
            __builtin_amdgcn_fence(__ATOMIC_ACQUIRE, "agent");
            xb_add(&bar[XB_XGEN(b.x)], 1u);
            asm volatile("s_waitcnt vmcnt(0)" ::: "memory");
        } else {
            XB_SPIN(xb_ld(&bar[XB_XGEN(b.x)]) == gen, bar);
            __builtin_amdgcn_fence(__ATOMIC_ACQUIRE, "agent");
            asm volatile("s_waitcnt vmcnt(0)" ::: "memory");
        }
    }
    __syncthreads();
}

struct Args { const void* in[32]; float* out; unsigned char* ws; int ph_lo, ph_hi; };
static_assert(sizeof(Args) == 32 * 8 + 8 + 8 + 8, "Args has no padding");

DI void p0_transpose_item(const float* __restrict__ W, int lds_, int N, bf16_t* __restrict__ WT, int ldd, const float* __restrict__ gain, LAS float* scr, int item, int lane) {
    const int nblk = N / 32, kb = item / nblk, nb = item % nblk, k0 = 64 * kb, n0 = 32 * nb;
    {
        const int kr = lane >> 3, nq = 4 * (lane & 7);
        f32x4 v[8]; float gs[8];
#pragma unroll
        for (int i = 0; i < 8; ++i) { const int kk = 8 * i + kr; v[i] = *(const f32x4*)(W + (size_t)(k0 + kk) * lds_ + n0 + nq); gs[i] = gain ? gain[k0 + kk] : 1.f; }
#pragma unroll
        for (int i = 0; i < 8; ++i) { const int kk = 8 * i + kr; LAS float* d = scr + kk * 33 + nq; d[0] = v[i].x * gs[i]; d[1] = v[i].y * gs[i]; d[2] = v[i].z * gs[i]; d[3] = v[i].w * gs[i]; }
    }
    asm volatile("s_waitcnt lgkmcnt(0)" ::: "memory");
    const int c = lane & 7;
#pragma unroll
    for (int j = 0; j < 4; ++j) { const int n = (lane >> 3) + 8 * j; const LAS float* s = scr + (8 * c) * 33 + n;
        u32x4 o; o.x = pk2(s[0 * 33], s[1 * 33]); o.y = pk2(s[2 * 33], s[3 * 33]); o.z = pk2(s[4 * 33], s[5 * 33]); o.w = pk2(s[6 * 33], s[7 * 33]);
        *(u32x4*)(WT + (size_t)(n0 + n) * ldd + k0 + 8 * c) = o; }
    asm volatile("s_waitcnt lgkmcnt(0)" ::: "memory");
}
DI void rowprep_load(const float* __restrict__ src, int lane, f32x4 (&v)[4]) {
#pragma unroll
    for (int j = 0; j < 4; ++j) v[j] = ((const f32x4*)src)[lane + 64 * j];
}
DI void rowprep_row(const f32x4 (&v)[4], int row, bf16_t* __restrict__ XB, float* __restrict__ SSQ, int lane) {
    float ss = 0.f;
#pragma unroll
    for (int j = 0; j < 4; ++j) ss += v[j].x * v[j].x + v[j].y * v[j].y + v[j].z * v[j].z + v[j].w * v[j].w;
    ss = wave_sum(ss);
#pragma unroll
    for (int j = 0; j < 4; ++j) { u32x2 o; o.x = pk2(v[j].x, v[j].y); o.y = pk2(v[j].z, v[j].w); ((u32x2*)(XB + (size_t)row * DM))[lane + 64 * j] = o; }
    if (lane < 16) SSQ[(size_t)lane * MT + row] = lane == 0 ? ss : 0.f;
}

DI void unpack4(u32x2 r, float (&x)[4]) { x[0] = __uint_as_float(r.x << 16); x[1] = __uint_as_float(r.x & 0xffff0000u); x[2] = __uint_as_float(r.y << 16); x[3] = __uint_as_float(r.y & 0xffff0000u); }
DI void post0_row(int row, int lane, const bf16_t* __restrict__ Z0, const float* __restrict__ ROPET, const float* __restrict__ g_q_nope, const float* __restrict__ g_q_rope,
                  const float* __restrict__ g_ckv, const float* __restrict__ g_k_rope, bf16_t* __restrict__ QB, bf16_t* __restrict__ CB, bf16_t* __restrict__ KRB, float* __restrict__ out) {
    const bf16_t* z = Z0 + (size_t)row * NZ0;
    const bool isp = row < MP; const int pidx = isp ? (row & (SEQ - 1)) : SEQ + ((row - MP) & 7);
    { const int d = 4 * (lane & 15); const f32x4 g4 = *(const f32x4*)(g_q_nope + d);
#pragma unroll
      for (int hh = 0; hh < 2; ++hh) {
        const int h = 4 * hh + (lane >> 4); float x[4]; unpack4(*(const u32x2*)(z + POOLD + QKH * h + d), x);
        float ss = x[0] * x[0] + x[1] * x[1] + x[2] * x[2] + x[3] * x[3];
        ss = sum16(ss);
        const float ri = rsqrtf(ss * (1.f / 64.f) + EPS) * QSCALE;
        u32x2 o; o.x = pk2(x[0] * ri * g4.x, x[1] * ri * g4.y); o.y = pk2(x[2] * ri * g4.z, x[3] * ri * g4.w);
        *(u32x2*)(QB + (size_t)row * QDIM + QKH * h + d) = o; } }
    { const int r = 4 * (lane & 7), i0 = r & 15; const bool second = (lane & 4) != 0;
      const f32x4 t0 = *(const f32x4*)(ROPET + ((size_t)pidx * 16 + i0) * 2), t1 = *(const f32x4*)(ROPET + ((size_t)pidx * 16 + i0) * 2 + 4);
      const float cs[4] = {t0.x, t0.z, t1.x, t1.z}, sn[4] = {t0.y, t0.w, t1.y, t1.w};
      { const int h = lane >> 3; float x[4]; unpack4(*(const u32x2*)(z + POOLD + QKH * h + 64 + r), x);
        float ss = x[0] * x[0] + x[1] * x[1] + x[2] * x[2] + x[3] * x[3];
        ss = sum8(ss);
        const float ri = rsqrtf(ss * (1.f / 32.f) + EPS); const f32x4 g4 = *(const f32x4*)(g_q_rope + r);
        float y[4] = {x[0] * ri * g4.x, x[1] * ri * g4.y, x[2] * ri * g4.z, x[3] * ri * g4.w}, o[4];
#pragma unroll
        for (int e = 0; e < 4; ++e) { const float p = xchg4(y[e], second); o[e] = (second ? (p * sn[e] + y[e] * cs[e]) : (y[e] * cs[e] - p * sn[e])) * QSCALE; }
        u32x2 w; w.x = pk2(o[0], o[1]); w.y = pk2(o[2], o[3]); *(u32x2*)(QB + (size_t)row * QDIM + QKH * h + 64 + r) = w; }
      { float x[4]; unpack4(*(const u32x2*)(z + POOLD + QDIM + KVR + r), x);
        float ss = x[0] * x[0] + x[1] * x[1] + x[2] * x[2] + x[3] * x[3];
        ss = sum8(ss);
        const float ri = rsqrtf(ss * (1.f / 32.f) + EPS); const f32x4 g4 = *(const f32x4*)(g_k_rope + r);
        float y[4] = {x[0] * ri * g4.x, x[1] * ri * g4.y, x[2] * ri * g4.z, x[3] * ri * g4.w}; f32x4 o;
#pragma unroll
        for (int e = 0; e < 4; ++e) { const float p = xchg4(y[e], second); o[e] = second ? (p * sn[e] + y[e] * cs[e]) : (y[e] * cs[e] - p * sn[e]); }
        if (lane < 8) { u32x2 w; w.x = pk2(o[0], o[1]); w.y = pk2(o[2], o[3]); *(u32x2*)(KRB + (size_t)row * ROPE + r) = w;
            float* ko = isp ? out + O_KR_P + (size_t)row * ROPE : out + O_KR_S + (size_t)(row - MP) * ROPE; *(f32x4*)(ko + r) = o; } } }
    { float x[4]; unpack4(*(const u32x2*)(z + POOLD + QDIM + lane * 4), x);
      float ss = wave_sum(x[0] * x[0] + x[1] * x[1] + x[2] * x[2] + x[3] * x[3]); const float ri = rsqrtf(ss * (1.f / 256.f) + EPS);
      const f32x4 g4 = *(const f32x4*)(g_ckv + lane * 4);
      f32x4 y; y.x = x[0] * ri * g4.x; y.y = x[1] * ri * g4.y; y.z = x[2] * ri * g4.z; y.w = x[3] * ri * g4.w;
      u32x2 o; o.x = pk2(y.x, y.y); o.y = pk2(y.z, y.w); *(u32x2*)(CB + (size_t)row * KVR + lane * 4) = o;
      float* co = isp ? out + O_CKV_P + (size_t)row * KVR : out + O_CKV_S + (size_t)(row - MP) * KVR; *(f32x4*)(co + lane * 4) = y; }
}
DI void load8(const bf16_t* p, float (&x)[8]) { const u32x4 r = *(const u32x4*)p;
#pragma unroll
    for (int e = 0; e < 4; ++e) { x[2 * e] = __uint_as_float(r[e] << 16); x[2 * e + 1] = __uint_as_float(r[e] & 0xffff0000u); } }
template <bool ISP> DI void pool_item(int row0, int nrows, int ch, const bf16_t* __restrict__ Z0, const float* __restrict__ state_pool, bf16_t* __restrict__ DBuf, float* __restrict__ out) {
    const int w = 2 << (ch >> 7);
    const int t0 = ISP ? (row0 & (SEQ - 1)) : 0, bb = ISP ? (row0 >> 12) : ((row0 - MP) >> 3);
    float S[8];
#pragma unroll
    for (int e = 0; e < 8; ++e) S[e] = 0.f;
    for (int j = 1; j < w; ++j) { const int tj = t0 - j; float x[8];
        if (tj >= 0) { load8(Z0 + (size_t)(row0 - j) * NZ0 + ch, x); }
        else if (!ISP) { const float* hp = state_pool + ((size_t)bb * 15 + (15 + tj)) * POOLD + ch; const f32x4 a = *(const f32x4*)hp, b = *(const f32x4*)(hp + 4); x[0] = a.x; x[1] = a.y; x[2] = a.z; x[3] = a.w; x[4] = b.x; x[5] = b.y; x[6] = b.z; x[7] = b.w; }
        else {
#pragma unroll
            for (int e = 0; e < 8; ++e) x[e] = 0.f; }
#pragma unroll
        for (int e = 0; e < 8; ++e) S[e] += x[e]; }
    for (int i = 0; i < nrows; ++i) {
        const int t = t0 + i, row = row0 + i; float u[8]; load8(Z0 + (size_t)row * NZ0 + ch, u);
        const float icnt = 1.0f / (ISP ? (float)((t + 1) < w ? (t + 1) : w) : (float)w);
        u32x4 o;
#pragma unroll
        for (int e = 0; e < 8; ++e) S[e] += u[e];
#pragma unroll
        for (int e = 0; e < 4; ++e) o[e] = pk2(S[2 * e] * icnt - u[2 * e], S[2 * e + 1] * icnt - u[2 * e + 1]);
        *(u32x4*)(DBuf + (size_t)row * POOLD + ch) = o;
        { const int tj = t - w + 1; float x[8];
          if (tj >= 0) { load8(Z0 + (size_t)(row - w + 1) * NZ0 + ch, x); }
          else if (!ISP) { const float* hp = state_pool + ((size_t)bb * 15 + (15 + tj)) * POOLD + ch; const f32x4 a = *(const f32x4*)hp, b = *(const f32x4*)(hp + 4); x[0] = a.x; x[1] = a.y; x[2] = a.z; x[3] = a.w; x[4] = b.x; x[5] = b.y; x[6] = b.z; x[7] = b.w; }
          else {
#pragma unroll
              for (int e = 0; e < 8; ++e) x[e] = 0.f; }
#pragma unroll
          for (int e = 0; e < 8; ++e) S[e] -= x[e]; }
        if (ISP) { if (t >= SEQ - 15) { float* op = out + O_POOL_P + ((size_t)bb * 15 + (t - (SEQ - 15))) * POOLD + ch; *(f32x4*)op = (f32x4){u[0], u[1], u[2], u[3]}; *(f32x4*)(op + 4) = (f32x4){u[4], u[5], u[6], u[7]}; } }
        else { float* op = out + O_POOL_S + ((size_t)bb * 15 + 7 + t) * POOLD + ch; *(f32x4*)op = (f32x4){u[0], u[1], u[2], u[3]}; *(f32x4*)(op + 4) = (f32x4){u[4], u[5], u[6], u[7]}; }
    }
    if (!ISP) { for (int i = 0; i < 7; ++i) { const float* hp = state_pool + ((size_t)bb * 15 + 8 + i) * POOLD + ch; float* op = out + O_POOL_S + ((size_t)bb * 15 + i) * POOLD + ch; *(f32x4*)op = *(const f32x4*)hp; *(f32x4*)(op + 4) = *(const f32x4*)(hp + 4); } }
}
DI void pool_item_p16(int row0, int ch, const bf16_t* __restrict__ Z0, bf16_t* __restrict__ DBuf, float* __restrict__ out) {
    const int w = 2 << (ch >> 7);
    const int t0 = row0 & (SEQ - 1), bb = row0 >> 12;
    const bf16_t* zb = Z0 + (size_t)row0 * NZ0 + ch;
    float S[8];
#pragma unroll
    for (int e = 0; e < 8; ++e) S[e] = 0.f;
#pragma unroll
    for (int j = 1; j < 16; ++j) { const bool ok = (j < w) && (t0 - j >= 0); float x[8]; load8(zb - (ok ? j : 0) * NZ0, x); const float mk = ok ? 1.f : 0.f;
#pragma unroll
        for (int e = 0; e < 8; ++e) S[e] += mk * x[e]; }
#pragma unroll
    for (int i = 0; i < 16; ++i) {
        const int t = t0 + i; float u[8], x[8]; load8(zb + i * NZ0, u);
        const bool ok = t - w + 1 >= 0; load8(zb + (i - (ok ? w - 1 : 0)) * NZ0, x); const float mk = ok ? 1.f : 0.f;
        const float icnt = 1.0f / (float)((t + 1) < w ? (t + 1) : w);
        u32x4 o;
#pragma unroll
        for (int e = 0; e < 8; ++e) S[e] += u[e];
#pragma unroll
        for (int e = 0; e < 4; ++e) o[e] = pk2(S[2 * e] * icnt - u[2 * e], S[2 * e + 1] * icnt - u[2 * e + 1]);
        *(u32x4*)(DBuf + (size_t)(row0 + i) * POOLD + ch) = o;
#pragma unroll
        for (int e = 0; e < 8; ++e) S[e] -= mk * x[e];
    }
    if (t0 == SEQ - 16) {
        for (int i = 1; i < 16; ++i) { float u[8]; load8(zb + i * NZ0, u);
            float* op = out + O_POOL_P + ((size_t)bb * 15 + (i - 1)) * POOLD + ch; *(f32x4*)op = (f32x4){u[0], u[1], u[2], u[3]}; *(f32x4*)(op + 4) = (f32x4){u[4], u[5], u[6], u[7]}; } }
}
template <bool ISP> DI void conv_item(int row0, int nrows, int ch, const bf16_t* __restrict__ U, const float* __restrict__ state_conv, const float* __restrict__ conv_w, const float* __restrict__ conv_b,
                                      bf16_t* __restrict__ V, float* __restrict__ out) {
    const int t0 = ISP ? (row0 & (SEQ - 1)) : 0, bb = ISP ? (row0 >> 12) : ((row0 - MP) >> 3);
    float wk[4][8], bs[8], hist[3][8];
#pragma unroll
    for (int k = 0; k < 4; ++k) { const f32x4 a = *(const f32x4*)(conv_w + k * DM + ch), b = *(const f32x4*)(conv_w + k * DM + ch + 4); wk[k][0] = a.x; wk[k][1] = a.y; wk[k][2] = a.z; wk[k][3] = a.w; wk[k][4] = b.x; wk[k][5] = b.y; wk[k][6] = b.z; wk[k][7] = b.w; }
    { const f32x4 a = *(const f32x4*)(conv_b + ch), b = *(const f32x4*)(conv_b + ch + 4); bs[0] = a.x; bs[1] = a.y; bs[2] = a.z; bs[3] = a.w; bs[4] = b.x; bs[5] = b.y; bs[6] = b.z; bs[7] = b.w; }
#pragma unroll
    for (int j = 0; j < 3; ++j) {
        const int tj = t0 - 3 + j;
        if (tj >= 0) load8(U + (size_t)(row0 - 3 + j) * DM + ch, hist[j]);
        else if (!ISP) { const float* hp = state_conv + ((size_t)bb * 3 + (3 + tj)) * DM + ch; const f32x4 a = *(const f32x4*)hp, b = *(const f32x4*)(hp + 4); hist[j][0] = a.x; hist[j][1] = a.y; hist[j][2] = a.z; hist[j][3] = a.w; hist[j][4] = b.x; hist[j][5] = b.y; hist[j][6] = b.z; hist[j][7] = b.w; }
        else {
#pragma unroll
            for (int e = 0; e < 8; ++e) hist[j][e] = 0.f; }
    }
    for (int i = 0; i < nrows; ++i) {
        const int t = t0 + i, row = row0 + i; float u[8]; load8(U + (size_t)row * DM + ch, u);
        u32x4 o; float v[8];
#pragma unroll
        for (int e = 0; e < 8; ++e) v[e] = bs[e] + hist[0][e] * wk[0][e] + hist[1][e] * wk[1][e] + hist[2][e] * wk[2][e] + u[e] * wk[3][e];
#pragma unroll
        for (int e = 0; e < 4; ++e) o[e] = pk2(v[2 * e], v[2 * e + 1]);
        *(u32x4*)(V + (size_t)row * DM + ch) = o;
#pragma unroll
        for (int e = 0; e < 8; ++e) { hist[0][e] = hist[1][e]; hist[1][e] = hist[2][e]; hist[2][e] = u[e]; }
        const int tl = ISP ? SEQ - 3 : DT - 3;
        if (t >= tl) { float* op = out + (ISP ? O_CONV_P : O_CONV_S) + ((size_t)bb * 3 + (t - tl)) * DM + ch; *(f32x4*)op = (f32x4){u[0], u[1], u[2], u[3]}; *(f32x4*)(op + 4) = (f32x4){u[4], u[5], u[6], u[7]}; }
    }
}

DI void conv_item_p16(int row0, int ch, const bf16_t* __restrict__ U, const float* __restrict__ conv_w, const float* __restrict__ conv_b, bf16_t* __restrict__ V, float* __restrict__ out) {
    const int t0 = row0 & (SEQ - 1), bb = row0 >> 12;
    const bf16_t* ub = U + (size_t)row0 * DM + ch;
    u32x4 raw[19];
#pragma unroll
    for (int j = 0; j < 19; ++j) raw[j] = *(const u32x4*)(ub + (j - 3 >= 0 || t0 > 0 ? (j - 3) : 0) * DM);
    float wk[4][8], bs[8];
#pragma unroll
    for (int k = 0; k < 4; ++k) { const f32x4 a = *(const f32x4*)(conv_w + k * DM + ch), b = *(const f32x4*)(conv_w + k * DM + ch + 4); wk[k][0] = a.x; wk[k][1] = a.y; wk[k][2] = a.z; wk[k][3] = a.w; wk[k][4] = b.x; wk[k][5] = b.y; wk[k][6] = b.z; wk[k][7] = b.w; }
    { const f32x4 a = *(const f32x4*)(conv_b + ch), b = *(const f32x4*)(conv_b + ch + 4); bs[0] = a.x; bs[1] = a.y; bs[2] = a.z; bs[3] = a.w; bs[4] = b.x; bs[5] = b.y; bs[6] = b.z; bs[7] = b.w; }
    const float hm = t0 > 0 ? 1.f : 0.f;
    float x[4][8];
#pragma unroll
    for (int j = 0; j < 3; ++j)
#pragma unroll
        for (int e = 0; e < 4; ++e) { x[j][2 * e] = hm * __uint_as_float(raw[j][e] << 16); x[j][2 * e + 1] = hm * __uint_as_float(raw[j][e] & 0xffff0000u); }
#pragma unroll
    for (int i = 0; i < 16; ++i) {
#pragma unroll
        for (int e = 0; e < 4; ++e) { x[3][2 * e] = __uint_as_float(raw[3 + i][e] << 16); x[3][2 * e + 1] = __uint_as_float(raw[3 + i][e] & 0xffff0000u); }
        u32x4 o; float v[8];
#pragma unroll
        for (int e = 0; e < 8; ++e) v[e] = bs[e] + x[0][e] * wk[0][e] + x[1][e] * wk[1][e] + x[2][e] * wk[2][e] + x[3][e] * wk[3][e];
#pragma unroll
        for (int e = 0; e < 4; ++e) o[e] = pk2(v[2 * e], v[2 * e + 1]);
        *(u32x4*)(V + (size_t)(row0 + i) * DM + ch) = o;
#pragma unroll
        for (int e = 0; e < 8; ++e) { x[0][e] = x[1][e]; x[1][e] = x[2][e]; x[2][e] = x[3][e]; }
    }
    if (t0 == SEQ - 16) {
#pragma unroll
        for (int i = 13; i < 16; ++i) { float* op = out + O_CONV_P + ((size_t)bb * 3 + (i - 13)) * DM + ch;
            *(f32x4*)op = (f32x4){__uint_as_float(raw[3 + i][0] << 16), __uint_as_float(raw[3 + i][0] & 0xffff0000u), __uint_as_float(raw[3 + i][1] << 16), __uint_as_float(raw[3 + i][1] & 0xffff0000u)};
            *(f32x4*)(op + 4) = (f32x4){__uint_as_float(raw[3 + i][2] << 16), __uint_as_float(raw[3 + i][2] & 0xffff0000u), __uint_as_float(raw[3 + i][3] << 16), __uint_as_float(raw[3 + i][3] & 0xffff0000u)}; } }
}

DI void ld8f(const float* p, float (&x)[8]) { const f32x4 a = *(const f32x4*)p, b = *(const f32x4*)(p + 4); x[0] = a.x; x[1] = a.y; x[2] = a.z; x[3] = a.w; x[4] = b.x; x[5] = b.y; x[6] = b.z; x[7] = b.w; }
DI void pool_item_s8(int bb, int ch, const bf16_t* __restrict__ Z0, const float* __restrict__ state_pool, bf16_t* __restrict__ DBuf, float* __restrict__ out) {
    const int w = 2 << (ch >> 7), row0 = MP + bb * DT;
    float st[15][8], u[8][8];
#pragma unroll
    for (int k = 0; k < 15; ++k) ld8f(state_pool + ((size_t)bb * 15 + k) * POOLD + ch, st[k]);
#pragma unroll
    for (int i = 0; i < 8; ++i) load8(Z0 + (size_t)(row0 + i) * NZ0 + ch, u[i]);
    float S[8];
#pragma unroll
    for (int e = 0; e < 8; ++e) S[e] = 0.f;
#pragma unroll
    for (int j = 1; j < 16; ++j) { const float mk = j < w ? 1.f : 0.f;
#pragma unroll
        for (int e = 0; e < 8; ++e) S[e] += mk * st[15 - j][e]; }
    const float icnt = 1.0f / (float)w;
#pragma unroll
    for (int i = 0; i < 8; ++i) {
        u32x4 o;
#pragma unroll
        for (int e = 0; e < 8; ++e) S[e] += u[i][e];
#pragma unroll
        for (int e = 0; e < 4; ++e) o[e] = pk2(S[2 * e] * icnt - u[i][2 * e], S[2 * e + 1] * icnt - u[i][2 * e + 1]);
        *(u32x4*)(DBuf + (size_t)(row0 + i) * POOLD + ch) = o;
#pragma unroll
        for (int e = 0; e < 8; ++e) {
            const float x2 = i >= 1 ? u[i >= 1 ? i - 1 : 0][e] : st[14][e];
            const float x4 = i >= 3 ? u[i >= 3 ? i - 3 : 0][e] : st[12 + (i < 3 ? i : 0)][e];
            const float x8 = i >= 7 ? u[i >= 7 ? i - 7 : 0][e] : st[8 + (i < 7 ? i : 0)][e];
            const float x16 = st[i][e];
            S[e] -= w == 2 ? x2 : (w == 4 ? x4 : (w == 8 ? x8 : x16));
        }
        float* op = out + O_POOL_S + ((size_t)bb * 15 + 7 + i) * POOLD + ch; *(f32x4*)op = (f32x4){u[i][0], u[i][1], u[i][2], u[i][3]}; *(f32x4*)(op + 4) = (f32x4){u[i][4], u[i][5], u[i][6], u[i][7]};
    }
#pragma unroll
    for (int i = 0; i < 7; ++i) { float* op = out + O_POOL_S + ((size_t)bb * 15 + i) * POOLD + ch; *(f32x4*)op = (f32x4){st[8 + i][0], st[8 + i][1], st[8 + i][2], st[8 + i][3]}; *(f32x4*)(op + 4) = (f32x4){st[8 + i][4], st[8 + i][5], st[8 + i][6], st[8 + i][7]}; }
}
DI void conv_item_s8(int bb, int ch, const bf16_t* __restrict__ U, const float* __restrict__ state_conv, const float* __restrict__ conv_w, const float* __restrict__ conv_b, bf16_t* __restrict__ V, float* __restrict__ out) {
    const int row0 = MP + bb * DT;
    float x[11][8], wk[4][8], bs[8];
#pragma unroll
    for (int j = 0; j < 3; ++j) ld8f(state_conv + ((size_t)bb * 3 + j) * DM + ch, x[j]);
#pragma unroll
    for (int i = 0; i < 8; ++i) load8(U + (size_t)(row0 + i) * DM + ch, x[3 + i]);
#pragma unroll
    for (int k = 0; k < 4; ++k) ld8f(conv_w + k * DM + ch, wk[k]);
    ld8f(conv_b + ch, bs);
#pragma unroll
    for (int i = 0; i < 8; ++i) {
        u32x4 o; float v[8];
#pragma unroll
        for (int e = 0; e < 8; ++e) v[e] = bs[e] + x[i][e] * wk[0][e] + x[i + 1][e] * wk[1][e] + x[i + 2][e] * wk[2][e] + x[i + 3][e] * wk[3][e];
#pragma unroll
        for (int e = 0; e < 4; ++e) o[e] = pk2(v[2 * e], v[2 * e + 1]);
        *(u32x4*)(V + (size_t)(row0 + i) * DM + ch) = o;
        if (i >= DT - 3) { float* op = out + O_CONV_S + ((size_t)bb * 3 + (i - (DT - 3))) * DM + ch; *(f32x4*)op = (f32x4){x[3 + i][0], x[3 + i][1], x[3 + i][2], x[3 + i][3]}; *(f32x4*)(op + 4) = (f32x4){x[3 + i][4], x[3 + i][5], x[3 + i][6], x[3 + i][7]}; }
    }
}

DI void attn_p_naive_item(int item, int lane, LAS float* sc, const bf16_t* __restrict__ QB, const bf16_t* __restrict__ KV, const bf16_t* __restrict__ KRB, bf16_t* __restrict__ MIX) {
    LAS float* qs = sc + SEQ;
    const int row = item >> 3, h = item & 7, b = row >> 12, t = row & (SEQ - 1);
    for (int i = lane; i < QKH; i += 64) qs[i] = bf2f(QB[(size_t)row * QDIM + h * QKH + i]);
    asm volatile("s_waitcnt lgkmcnt(0)" ::: "memory");
    float mx = -INFINITY;
    for (int j0 = 0; j0 <= t; j0 += 64) {
        const int j = j0 + lane;
        if (j <= t) {
            const bf16_t* kr = KV + (size_t)(b * SEQ + j) * 1024 + h * 64; const bf16_t* rr = KRB + (size_t)(b * SEQ + j) * ROPE;
            float s = 0.f;
            for (int d = 0; d < 64; ++d) s += qs[d] * bf2f(kr[d]);
            for (int d = 0; d < 32; ++d) s += qs[64 + d] * bf2f(rr[d]);
            sc[j] = s; mx = fmaxf(mx, s);
        }
    }
    mx = wave_max(mx);
    float sum = 0.f;
    for (int j = lane; j <= t; j += 64) { const float p = exp2f(sc[j] - mx); sc[j] = p; sum += p; }
    sum = wave_sum(sum);
    asm volatile("s_waitcnt lgkmcnt(0)" ::: "memory");
    float acc = 0.f;
    for (int j = 0; j <= t; ++j) acc += sc[j] * bf2f(KV[(size_t)(b * SEQ + j) * 1024 + 512 + h * 64 + lane]);
    MIX[(size_t)row * DM + 512 + h * 64 + lane] = (bf16_t)f2bf(acc / sum);
    asm volatile("s_waitcnt lgkmcnt(0)" ::: "memory");
}


typedef short v4i16_t __attribute__((ext_vector_type(4)));
DI int crow(int r, int hi) { return (r & 3) + 8 * (r >> 2) + 4 * hi; }
constexpr int AP_KS = 12288, AP_VS = 8192, AP_LK = 0, AP_LV = 2 * AP_KS;
DI void attn_p_unit(int b, int h, int qb, LAS unsigned char* lds, const bf16_t* __restrict__ QB, const bf16_t* __restrict__ KV, const bf16_t* __restrict__ KRB, bf16_t* __restrict__ MIX) {
    const int tid = threadIdx.x, lane = tid & 63, r32 = lane & 31, hi = lane >> 5, wid = __builtin_amdgcn_readfirstlane(tid >> 6);
    const int rowbase = b * SEQ, q0 = qb * 256, NT = 4 * (qb + 1);
    const bf16_t* ksrc0 = KV + (size_t)(rowbase + lane) * 1024 + h * 64 + wid * 8;
    const bf16_t* ksrc1 = KRB + (size_t)(rowbase + lane) * ROPE + (wid & 3) * 8;
    const bf16_t* vsrc = KV + (size_t)(rowbase + 16 * (wid & 3) + (lane >> 2)) * 1024 + 512 + h * 64 + (wid >> 2) * 32 + (lane & 3) * 8;
#define AP_DMA(t, slot) do { \
        __builtin_amdgcn_global_load_lds((const unsigned*)(ksrc0 + (size_t)(t) * 64 * 1024), (LAS unsigned*)(lds + AP_LK + (slot) * AP_KS + wid * 1024), 16, 0, 0); \
        if (wid < 4) __builtin_amdgcn_global_load_lds((const unsigned*)(ksrc1 + (size_t)(t) * 64 * ROPE), (LAS unsigned*)(lds + AP_LK + (slot) * AP_KS + (8 + wid) * 1024), 16, 0, 0); \
        __builtin_amdgcn_global_load_lds((const unsigned*)(vsrc + (size_t)(t) * 64 * 1024), (LAS unsigned*)(lds + AP_LV + (slot) * AP_VS + wid * 1024), 16, 0, 0); } while (0)
    AP_DMA(0, 0);
    bf16x8 qr[6];
    { const bf16_t* qw = QB + (size_t)(rowbase + q0 + wid * 32 + r32) * QDIM + h * QKH + hi * 8;
#pragma unroll
      for (int d0 = 0; d0 < 6; ++d0) qr[d0] = *(const bf16x8*)(qw + d0 * 16); }
    float m = 0.f, l = 0.f;
    f32x16 o0, o1, negm;
#pragma unroll
    for (int r = 0; r < 16; ++r) { o0[r] = 0.f; o1[r] = 0.f; negm[r] = 0.f; }
    const int qrel = wid * 32 + r32;
    const int voff = (4 * hi + ((lane & 15) >> 2)) * 64 + ((lane >> 4) & 1) * 32 + (lane & 3) * 8;
    for (int t = 0; t < NT; ++t) {
        asm volatile("s_waitcnt vmcnt(0)" ::: "memory"); __builtin_amdgcn_s_barrier(); asm volatile("" ::: "memory");
        if (t + 1 < NT) AP_DMA(t + 1, (t + 1) & 1);
        const int slot = t & 1, trel = t - (NT - 4);
        if (trel < 0 || 64 * trel <= 32 * wid + 31) {
            const LAS unsigned char* kb = lds + AP_LK + slot * AP_KS + hi * 1024 + r32 * 16;
            f32x16 p0, p1;
            __builtin_amdgcn_s_setprio(1);
#pragma unroll
            for (int d0 = 0; d0 < 6; ++d0) {
                const bf16x8 k0 = *(const LAS bf16x8*)(kb + d0 * 2048), k1 = *(const LAS bf16x8*)(kb + d0 * 2048 + 512);
                p0 = __builtin_amdgcn_mfma_f32_32x32x16_bf16(k0, qr[d0], d0 == 0 ? negm : p0, 0, 0, 0);
                p1 = __builtin_amdgcn_mfma_f32_32x32x16_bf16(k1, qr[d0], d0 == 0 ? negm : p1, 0, 0, 0);
            }
            __builtin_amdgcn_s_setprio(0);
            if (trel >= 0) {
#pragma unroll
                for (int r = 0; r < 16; ++r) { const int kp = 64 * trel + crow(r, hi); if (kp > qrel) p0[r] = -INFINITY; if (kp + 32 > qrel) p1[r] = -INFINITY; }
            }
            float mx = max3f(p0[0], p1[0], p0[1]);
#pragma unroll
            for (int r = 1; r < 16; ++r) mx = (r < 15) ? max3f(mx, p1[r], p0[r + 1]) : fmaxf(mx, p1[r]);
            mx = xmax32(mx);
            float ps = 0.f;
#pragma unroll
            for (int r = 0; r < 16; ++r) { p0[r] = __builtin_amdgcn_exp2f(p0[r]); p1[r] = __builtin_amdgcn_exp2f(p1[r]); ps += p0[r] + p1[r]; }
            l += ps;
            const LAS unsigned char* vb = lds + AP_LV + slot * AP_VS + voff;
            __builtin_amdgcn_s_setprio(1);
#pragma unroll
            for (int ks = 0; ks < 4; ++ks) {
                u32x4 pw;
                if (ks < 2) { pw.x = cvtpk(p0[8 * ks], p0[8 * ks + 1]); pw.y = cvtpk(p0[8 * ks + 2], p0[8 * ks + 3]); pw.z = cvtpk(p0[8 * ks + 4], p0[8 * ks + 5]); pw.w = cvtpk(p0[8 * ks + 6], p0[8 * ks + 7]); }
                else { const int s8 = 8 * (ks - 2); pw.x = cvtpk(p1[s8], p1[s8 + 1]); pw.y = cvtpk(p1[s8 + 2], p1[s8 + 3]); pw.z = cvtpk(p1[s8 + 4], p1[s8 + 5]); pw.w = cvtpk(p1[s8 + 6], p1[s8 + 7]); }
                const bf16x8 pa = __builtin_bit_cast(bf16x8, pw);
#pragma unroll
                for (int db = 0; db < 2; ++db) {
                    const v4i16_t lo = __builtin_amdgcn_ds_read_tr16_b64_v4i16((LAS v4i16_t*)(vb + db * 4096 + ks * 1024));
                    const v4i16_t hh = __builtin_amdgcn_ds_read_tr16_b64_v4i16((LAS v4i16_t*)(vb + db * 4096 + ks * 1024 + 512));
                    const bf16x8 vf = (bf16x8){lo[0], lo[1], lo[2], lo[3], hh[0], hh[1], hh[2], hh[3]};
                    if (db == 0) o0 = __builtin_amdgcn_mfma_f32_32x32x16_bf16(vf, pa, o0, 0, 0, 0);
                    else o1 = __builtin_amdgcn_mfma_f32_32x32x16_bf16(vf, pa, o1, 0, 0, 0);
                }
            }
            __builtin_amdgcn_s_setprio(0);
            const float mn = (t == 0) ? mx : fmaxf(mx, 0.f);
            if (__any(mn != 0.f)) {
                const float f = __builtin_amdgcn_exp2f(-mn); l *= f; m += mn;
#pragma unroll
                for (int r = 0; r < 16; ++r) { o0[r] *= f; o1[r] *= f; negm[r] = -m; }
            }
        }
    }
    l = xsum32(l);
    const float il = 1.0f / l;
    bf16_t* orow = MIX + (size_t)(rowbase + q0 + wid * 32 + r32) * DM + 512 + h * 64 + 4 * hi;
#pragma unroll
    for (int g = 0; g < 4; ++g) {
        u32x2 a; a.x = cvtpk(o0[4 * g] * il, o0[4 * g + 1] * il); a.y = cvtpk(o0[4 * g + 2] * il, o0[4 * g + 3] * il); *(u32x2*)(orow + 8 * g) = a;
        u32x2 c; c.x = cvtpk(o1[4 * g] * il, o1[4 * g + 1] * il); c.y = cvtpk(o1[4 * g + 2] * il, o1[4 * g + 3] * il); *(u32x2*)(orow + 32 + 8 * g) = c;
    }
#undef AP_DMA
}


constexpr int SA_CB_ROW = 576, SA_CB_SZ = 64 * SA_CB_ROW;
constexpr int SA_C8_ROW = 272, SA_C8_SZ = 64 * SA_C8_ROW;
constexpr int SA_KR_ROW = 96, SA_KR_SZ = 64 * SA_KR_ROW;
constexpr int SA_CB = 0, SA_C8 = 2 * SA_CB_SZ, SA_KRB = SA_C8 + 2 * SA_C8_SZ;
constexpr int SA_P = SA_KRB + 2 * SA_KR_SZ, SA_P_ROW = 144;
constexpr int SA_QF = SA_P + 64 * SA_P_ROW;
constexpr int SA_F = SA_QF + 8 * 3 * 4 * 8 * 16;
constexpr int SA_END = SA_F + 256;
static_assert(SA_END <= LDS_MISC, "sample attention LDS map");
DI int sa_swz(int x) { return (0x78 >> (2 * x)) & 3; }
DI int sa_g8(int x) { return (0x28 >> (2 * x)) & 3; }
typedef int v8i_t __attribute__((ext_vector_type(8)));
typedef float f32x4v __attribute__((ext_vector_type(4)));

template <int VAR> DI void attn_s_unit(int unit, LAS unsigned char* lds, const float* __restrict__ cache_ckv, const float* __restrict__ cache_kr, const int* __restrict__ page_table, const bf16_t* __restrict__ QB,
                    const bf16_t* __restrict__ WKVT, const float* __restrict__ g_k_nope, float* __restrict__ LATP, float* __restrict__ ML) {
    constexpr int hot = VAR != 0;
    const int tid = threadIdx.x, lane = tid & 63, r32 = lane & 31, hi = lane >> 5, l15 = lane & 15, quad = lane >> 4, w = __builtin_amdgcn_readfirstlane(tid >> 6);
    const int sb = unit >> 1, split = unit & 1;
    const int* pt = page_table + sb * NPAGES + split * 32;
    for (int e = tid; e < 8 * 3 * 4 * 8; e += NTHR) {
        const int q = e & 7, qd = (e >> 3) & 3, st = (e >> 5) % 3, h = e / 96;
        const bf16_t* qp = QB + (size_t)(MP + sb * DT + q) * QDIM + h * QKH;
        unsigned pk[4];
#pragma unroll
        for (int jj = 0; jj < 4; ++jj) {
            float v0, v1;
            if (st < 2) { const int j0 = 2 * jj, j1 = 2 * jj + 1; const int d0 = 32 * st + 16 * (j0 >> 2) + 4 * qd + (j0 & 3), d1 = 32 * st + 16 * (j1 >> 2) + 4 * qd + (j1 & 3); v0 = bf2f(qp[d0]) * g_k_nope[d0]; v1 = bf2f(qp[d1]) * g_k_nope[d1]; }
            else { const int r0 = 8 * qd + 2 * jj; v0 = bf2f(qp[64 + r0]); v1 = bf2f(qp[64 + r0 + 1]); }
            pk[jj] = pk2(v0, v1);
        }
        *(LAS u32x4*)(lds + SA_QF + e * 16) = (u32x4){pk[0], pk[1], pk[2], pk[3]};
    }
    v8i_t wf[4][2];
#pragma unroll
    for (int db = 0; db < 4; ++db)
#pragma unroll
        for (int ch = 0; ch < 2; ++ch) {
            const bf16_t* wp = WKVT + (size_t)(w * 64 + 16 * db + l15) * KVR + 128 * ch + 32 * quad;
#pragma unroll
            for (int i = 0; i < 4; ++i) { const u32x4 r = *(const u32x4*)(wp + 8 * i); int lo = 0, hi2 = 0;
                lo = __builtin_amdgcn_cvt_pk_fp8_f32(__uint_as_float(r.x << 16) * 16.f, __uint_as_float(r.x & 0xffff0000u) * 16.f, lo, false);
                lo = __builtin_amdgcn_cvt_pk_fp8_f32(__uint_as_float(r.y << 16) * 16.f, __uint_as_float(r.y & 0xffff0000u) * 16.f, lo, true);
                hi2 = __builtin_amdgcn_cvt_pk_fp8_f32(__uint_as_float(r.z << 16) * 16.f, __uint_as_float(r.z & 0xffff0000u) * 16.f, hi2, false);
                hi2 = __builtin_amdgcn_cvt_pk_fp8_f32(__uint_as_float(r.w << 16) * 16.f, __uint_as_float(r.w & 0xffff0000u) * 16.f, hi2, true);
                wf[db][ch][2 * i] = lo; wf[db][ch][2 * i + 1] = hi2; }
        }
    const __amdgpu_buffer_rsrc_t rs_c = __builtin_amdgcn_make_buffer_rsrc((void*)cache_ckv, (short)0, (int)((size_t)(NPAGES * DB_ + NPAGES * DB_ / 4) * PAGE * KVR * 4), 0x00020000);
    const __amdgpu_buffer_rsrc_t rs_k = __builtin_amdgcn_make_buffer_rsrc((void*)cache_kr, (short)0, (int)((size_t)(NPAGES * DB_ + NPAGES * DB_ / 4) * PAGE * ROPE * 4), 0x00020000);
    const int dma_voff = lane * 16;
    u32x4 pf[9];
    const int ptv = pt[lane & 31];
#define SA_LOAD(t) do { const unsigned prow = (unsigned)__builtin_amdgcn_readlane(ptv, hot ? 0 : ((t) >> 1)) * PAGE + 64 * ((t) & 1) + 8 * w; \
        _Pragma("unroll") for (int i = 0; i < 8; ++i) pf[i] = __builtin_amdgcn_raw_buffer_load_b128(rs_c, dma_voff, (prow + i) * (KVR * 4), 0); \
        pf[8] = __builtin_amdgcn_raw_buffer_load_b128(rs_k, dma_voff, prow * (ROPE * 4), 0); } while (0)
    SA_LOAD(0);
    float m = 0.f, negm = 0.f, l = 0.f;
    f32x16 lat0, lat1;
#pragma unroll
    for (int r = 0; r < 16; ++r) { lat0[r] = 0.f; lat1[r] = 0.f; }
    const bool qreal = l15 < 8;
    const int g8_ = sa_g8((l15 >> 2) & 3);
    const LAS unsigned char* c8a0 = lds + SA_C8 + l15 * SA_C8_ROW + (((2 * quad) ^ g8_) * 16);
    const LAS unsigned char* c8b0 = lds + SA_C8 + l15 * SA_C8_ROW + (((2 * quad + 1) ^ g8_) * 16);
    const LAS unsigned char* qfbase = lds + SA_QF + (((w * 3) * 4 + quad) * 8 + (l15 & 7)) * 16;
    const LAS unsigned char* krbase0 = lds + SA_KRB + l15 * SA_KR_ROW + quad * 16;
    LAS unsigned char* pwbase = lds + SA_P + (8 * w + l15) * SA_P_ROW + quad * 8;
    asm volatile("s_waitcnt lgkmcnt(0)" ::: "memory"); __builtin_amdgcn_s_barrier(); asm volatile("" ::: "memory");
    bf16x8 q0 = *(const LAS bf16x8*)(qfbase), q1 = *(const LAS bf16x8*)(qfbase + 512), q2 = *(const LAS bf16x8*)(qfbase + 1024);
    if (!qreal) { q0 = (bf16x8){0, 0, 0, 0, 0, 0, 0, 0}; q1 = q0; q2 = q0; }
    LAS unsigned char* cvw0 = lds + SA_CB + 8 * w * SA_CB_ROW + (((lane >> 1) ^ sa_swz((2 * w) & 3)) * 16) + (lane & 1) * 8;
    LAS unsigned char* cvw1 = lds + SA_CB + 8 * w * SA_CB_ROW + (((lane >> 1) ^ sa_swz((2 * w + 1) & 3)) * 16) + (lane & 1) * 8;
    LAS unsigned char* c8w0 = lds + SA_C8 + 8 * w * SA_C8_ROW + (((lane >> 2) ^ sa_g8((2 * w) & 3)) * 16) + (lane & 3) * 4;
    LAS unsigned char* c8w1 = lds + SA_C8 + 8 * w * SA_C8_ROW + (((lane >> 2) ^ sa_g8((2 * w + 1) & 3)) * 16) + (lane & 3) * 4;
    LAS unsigned char* krw = lds + SA_KRB + (8 * w + (lane >> 3)) * SA_KR_ROW + (lane & 7) * 8;
    const int kr0 = 8 * hi + (l15 >> 2), cc0 = 4 * w + 2 * ((lane >> 4) & 1) + ((lane & 3) >> 1);
    const LAS unsigned char* trlo = lds + SA_CB + kr0 * SA_CB_ROW + ((cc0 ^ (hi ? 3 : 0)) * 16) + (lane & 1) * 8;
    const LAS unsigned char* trhi = lds + SA_CB + (kr0 + 4) * SA_CB_ROW + ((cc0 ^ (hi ? 1 : 2)) * 16) + (lane & 1) * 8;
    const LAS unsigned char* prd = lds + SA_P + r32 * SA_P_ROW + hi * 16;
    const LAS float* frd = (const LAS float*)(lds + SA_F + r32 * 4);
    for (int t2 = 0; t2 < 64; t2 += 2) {
#pragma unroll
      for (int tb = 0; tb < 2; ++tb) {
        const int t = t2 + tb;
        asm volatile("s_waitcnt vmcnt(0)" ::: "memory");
        if (VAR != 5) {
#pragma unroll
            for (int i = 0; i < 8; ++i) {
                const f32x4 v = __builtin_bit_cast(f32x4, pf[i]);
                u32x2 o; o.x = cvtpk(v.x, v.y); o.y = cvtpk(v.z, v.w);
                *(LAS u32x2*)((i < 4 ? cvw0 : cvw1) + tb * SA_CB_SZ + i * SA_CB_ROW) = o;
                int f8 = __builtin_amdgcn_cvt_pk_fp8_f32(v.x, v.y, 0, false); f8 = __builtin_amdgcn_cvt_pk_fp8_f32(v.z, v.w, f8, true);
                *(LAS int*)((i < 4 ? c8w0 : c8w1) + tb * SA_C8_SZ + i * SA_C8_ROW) = f8;
            }
            { const f32x4 v = __builtin_bit_cast(f32x4, pf[8]); u32x2 o; o.x = cvtpk(v.x, v.y); o.y = cvtpk(v.z, v.w);
              *(LAS u32x2*)(krw + tb * SA_KR_SZ) = o; }
        }
        constexpr bool ld_next = (VAR != 5);
        const int tn = (t + 1) & 63;
        const unsigned prow_n = (unsigned)__builtin_amdgcn_readlane(ptv, hot ? 0 : (tn >> 1)) * PAGE + 64 * (tn & 1) + 8 * w;
        asm volatile("s_waitcnt lgkmcnt(0)" ::: "memory");
        __builtin_amdgcn_s_barrier(); asm volatile("" ::: "memory");
        const LAS unsigned char* c8a = c8a0 + tb * SA_C8_SZ; const LAS unsigned char* c8b = c8b0 + tb * SA_C8_SZ; const LAS unsigned char* krbase = krbase0 + tb * SA_KR_SZ;
        float tmax = -INFINITY, ps = 0.f;
        u32x4 nb00, nb01, nb10, nb11; bf16x8 nkf;
#define SA_LDB(kb_) do { const LAS unsigned char* ca_ = c8a + (kb_) * 16 * SA_C8_ROW; const LAS unsigned char* cb_ = c8b + (kb_) * 16 * SA_C8_ROW; \
            nb00 = *(const LAS u32x4*)(ca_); nb01 = *(const LAS u32x4*)(cb_); nb10 = *(const LAS u32x4*)(ca_ + 128); nb11 = *(const LAS u32x4*)(cb_ + 128); \
            nkf = *(const LAS bf16x8*)(krbase + (kb_) * 16 * SA_KR_ROW); } while (0)
        SA_LDB(0);
#pragma unroll
        for (int kb = 0; kb < 4; ++kb) {
            f32x4v k0 = {0.f, 0.f, 0.f, 0.f}, k1 = {0.f, 0.f, 0.f, 0.f}, k2 = {0.f, 0.f, 0.f, 0.f}, k3 = {0.f, 0.f, 0.f, 0.f};
            const bf16x8 kf = nkf;
            {
                const v8i_t bf0 = {(int)nb00.x, (int)nb00.y, (int)nb00.z, (int)nb00.w, (int)nb01.x, (int)nb01.y, (int)nb01.z, (int)nb01.w};
                const v8i_t bf1 = {(int)nb10.x, (int)nb10.y, (int)nb10.z, (int)nb10.w, (int)nb11.x, (int)nb11.y, (int)nb11.z, (int)nb11.w};
                if (VAR != 3) {
                    __builtin_amdgcn_s_setprio(1);
                    k0 = __builtin_amdgcn_mfma_scale_f32_16x16x128_f8f6f4(wf[0][0], bf0, k0, 0, 0, 0, 123, 0, 127); k1 = __builtin_amdgcn_mfma_scale_f32_16x16x128_f8f6f4(wf[1][0], bf0, k1, 0, 0, 0, 123, 0, 127);
                    k2 = __builtin_amdgcn_mfma_scale_f32_16x16x128_f8f6f4(wf[2][0], bf0, k2, 0, 0, 0, 123, 0, 127); k3 = __builtin_amdgcn_mfma_scale_f32_16x16x128_f8f6f4(wf[3][0], bf0, k3, 0, 0, 0, 123, 0, 127);
                    k0 = __builtin_amdgcn_mfma_scale_f32_16x16x128_f8f6f4(wf[0][1], bf1, k0, 0, 0, 0, 123, 0, 127); k1 = __builtin_amdgcn_mfma_scale_f32_16x16x128_f8f6f4(wf[1][1], bf1, k1, 0, 0, 0, 123, 0, 127);
                    k2 = __builtin_amdgcn_mfma_scale_f32_16x16x128_f8f6f4(wf[2][1], bf1, k2, 0, 0, 0, 123, 0, 127); k3 = __builtin_amdgcn_mfma_scale_f32_16x16x128_f8f6f4(wf[3][1], bf1, k3, 0, 0, 0, 123, 0, 127);
                    __builtin_amdgcn_s_setprio(0);
                }
                __builtin_amdgcn_sched_barrier(0);
                if (kb < 3) SA_LDB(kb + 1);
                if (ld_next) { pf[2 * kb] = __builtin_amdgcn_raw_buffer_load_b128(rs_c, dma_voff, (prow_n + 2 * kb) * (KVR * 4), 0); pf[2 * kb + 1] = __builtin_amdgcn_raw_buffer_load_b128(rs_c, dma_voff, (prow_n + 2 * kb + 1) * (KVR * 4), 0);
                    if (kb == 3) pf[8] = __builtin_amdgcn_raw_buffer_load_b128(rs_k, dma_voff, prow_n * (ROPE * 4), 0); }
                __builtin_amdgcn_sched_barrier(0);
            }
            float ss = k0.x * k0.x + k0.y * k0.y + k0.z * k0.z + k0.w * k0.w + k1.x * k1.x + k1.y * k1.y + k1.z * k1.z + k1.w * k1.w
                     + k2.x * k2.x + k2.y * k2.y + k2.z * k2.z + k2.w * k2.w + k3.x * k3.x + k3.y * k3.y + k3.z * k3.z + k3.w * k3.w;
            ss = xsum32(xsum16(ss));
            const float ri = __builtin_amdgcn_rsqf(ss * (1.f / 64.f) + EPS);
            u32x4 a0, a1;
            a0.x = cvtpk(k0.x * ri, k0.y * ri); a0.y = cvtpk(k0.z * ri, k0.w * ri); a0.z = cvtpk(k1.x * ri, k1.y * ri); a0.w = cvtpk(k1.z * ri, k1.w * ri);
            a1.x = cvtpk(k2.x * ri, k2.y * ri); a1.y = cvtpk(k2.z * ri, k2.w * ri); a1.z = cvtpk(k3.x * ri, k3.y * ri); a1.w = cvtpk(k3.z * ri, k3.w * ri);
            f32x4v sc = {negm, negm, negm, negm};
            sc = __builtin_amdgcn_mfma_f32_16x16x32_bf16(kf, q2, sc, 0, 0, 0);
            sc = __builtin_amdgcn_mfma_f32_16x16x32_bf16(__builtin_bit_cast(bf16x8, a0), q0, sc, 0, 0, 0);
            sc = __builtin_amdgcn_mfma_f32_16x16x32_bf16(__builtin_bit_cast(bf16x8, a1), q1, sc, 0, 0, 0);
            float bm = fmaxf(fmaxf(sc.x, sc.y), fmaxf(sc.z, sc.w));
            if (t == 0 && kb == 0) { const float m0 = xmax32(xmax16(bm)); sc.x -= m0; sc.y -= m0; sc.z -= m0; sc.w -= m0; bm -= m0; m = m0; negm = -m0; }
            tmax = fmaxf(tmax, bm);
            sc.x = __builtin_amdgcn_exp2f(sc.x); sc.y = __builtin_amdgcn_exp2f(sc.y); sc.z = __builtin_amdgcn_exp2f(sc.z); sc.w = __builtin_amdgcn_exp2f(sc.w);
            ps += (sc.x + sc.y) + (sc.z + sc.w);
            asm volatile("" : "+v"(ps), "+v"(tmax));
            if (qreal) { u32x2 o; o.x = cvtpk(sc.x, sc.y); o.y = cvtpk(sc.z, sc.w); *(LAS u32x2*)(pwbase + kb * 32) = o; }
            __builtin_amdgcn_sched_barrier(0);
        }
#undef SA_LDB
        { tmax = xmax32(xmax16(tmax));
          const float inc = fmaxf(tmax, 0.f); const float f = __builtin_amdgcn_exp2f(-inc); m += inc; negm = -m; l = (l + ps) * f;
          if (qreal && quad == 0) *(LAS float*)(lds + SA_F + (8 * w + l15) * 4) = f; }
        asm volatile("s_waitcnt lgkmcnt(0)" ::: "memory"); __builtin_amdgcn_s_barrier(); asm volatile("" ::: "memory");
        if (VAR != 4) {
            v4i16_t lo[4], hh[4]; bf16x8 p0[4], p1[4];
#pragma unroll
            for (int ks = 0; ks < 4; ++ks) {
                lo[ks] = __builtin_amdgcn_ds_read_tr16_b64_v4i16((LAS v4i16_t*)(trlo + tb * SA_CB_SZ + ks * 16 * SA_CB_ROW));
                hh[ks] = __builtin_amdgcn_ds_read_tr16_b64_v4i16((LAS v4i16_t*)(trhi + tb * SA_CB_SZ + ks * 16 * SA_CB_ROW));
                p0[ks] = *(const LAS bf16x8*)(prd + ks * 32);
                p1[ks] = *(const LAS bf16x8*)(prd + 32 * SA_P_ROW + ks * 32);
            }
            const float f0 = frd[0], f1 = frd[32];
            __builtin_amdgcn_sched_barrier(0);
            __builtin_amdgcn_s_setprio(1);
#pragma unroll
            for (int ks = 0; ks < 4; ++ks) {
                const bf16x8 cf = (bf16x8){lo[ks][0], lo[ks][1], lo[ks][2], lo[ks][3], hh[ks][0], hh[ks][1], hh[ks][2], hh[ks][3]};
                lat0 = __builtin_amdgcn_mfma_f32_32x32x16_bf16(cf, p0[ks], lat0, 0, 0, 0);
                lat1 = __builtin_amdgcn_mfma_f32_32x32x16_bf16(cf, p1[ks], lat1, 0, 0, 0);
            }
            __builtin_amdgcn_s_setprio(0);
            if (__any(f0 != 1.f || f1 != 1.f)) {
#pragma unroll
                for (int r = 0; r < 16; ++r) { lat0[r] *= f0; lat1[r] *= f1; } }
        }
      }
    }
    __builtin_amdgcn_s_barrier(); asm volatile("" ::: "memory");
    l = xsum32(xsum16(l));
    int unit2 = unit, lane2 = threadIdx.x & 63; asm volatile("" : "+s"(unit2), "+v"(lane2));
    const int r32b = lane2 & 31, hib = lane2 >> 5;
    if (lane2 < 8) { float* mlp = ML + ((size_t)unit2 * 64 + 8 * w + lane2) * 2; mlp[0] = m; mlp[1] = l; }
    float* lp = LATP + (size_t)unit2 * 64 * KVR + 32 * w + 4 * hib;
#pragma unroll
    for (int g = 0; g < 4; ++g) {
        *(f32x4*)(lp + (size_t)r32b * KVR + 8 * g) = (f32x4){lat0[4 * g], lat0[4 * g + 1], lat0[4 * g + 2], lat0[4 * g + 3]};
        *(f32x4*)(lp + (size_t)(32 + r32b) * KVR + 8 * g) = (f32x4){lat1[4 * g], lat1[4 * g + 1], lat1[4 * g + 2], lat1[4 * g + 3]};
    }
#undef SA_LOAD
}

DI void attn_s_combine(int sb, LAS unsigned char* lds, const bf16_t* __restrict__ QB, const bf16_t* __restrict__ KV, const bf16_t* __restrict__ KRB, const bf16_t* __restrict__ WKVT,
                       const float* __restrict__ LATP, const float* __restrict__ ML, bf16_t* __restrict__ MIX) {
    const int tid = threadIdx.x;
    LAS float* latc = (LAS float*)lds; LAS float* pn = latc + 64 * KVR; LAS float* wgt = pn + 64 * 8;
    {
        const int qh = tid >> 3, j = tid & 7, h = qh >> 3, q = qh & 7;
        const bf16_t* qp = QB + (size_t)(MP + sb * DT + q) * QDIM + h * QKH; const size_t krow_ = (size_t)MP + sb * DT + j;
        float sj = 0.f;
        { const bf16_t* kp = KV + krow_ * 1024 + h * 64; const bf16_t* rp = KRB + krow_ * ROPE;
#pragma unroll
          for (int c = 0; c < 12; ++c) { const u32x4 a = *(const u32x4*)(qp + 8 * c), b = c < 8 ? *(const u32x4*)(kp + 8 * c) : *(const u32x4*)(rp + 8 * (c - 8));
#pragma unroll
              for (int e = 0; e < 4; ++e) sj += __uint_as_float(a[e] << 16) * __uint_as_float(b[e] << 16) + __uint_as_float(a[e] & 0xffff0000u) * __uint_as_float(b[e] & 0xffff0000u); } }
        if (j > q) sj = -INFINITY;
        const float m0 = ML[((size_t)(2 * sb) * 64 + qh) * 2], l0 = ML[((size_t)(2 * sb) * 64 + qh) * 2 + 1], m1 = ML[((size_t)(2 * sb + 1) * 64 + qh) * 2], l1 = ML[((size_t)(2 * sb + 1) * 64 + qh) * 2 + 1];
        const float mm = max8(sj);
        const float M = fmaxf(fmaxf(m0, m1), mm);
        const float pj = exp2f(sj - M), w0 = exp2f(m0 - M), w1 = exp2f(m1 - M);
        const float sp = sum8(pj);
        const float L = w0 * l0 + w1 * l1 + sp, iL = 1.f / L;
        pn[qh * 8 + j] = pj * iL;
        if (j == 0) { wgt[qh * 2] = w0 * iL; wgt[qh * 2 + 1] = w1 * iL; }
    }
    __syncthreads();
    for (int e4 = tid; e4 < 64 * KVR / 4; e4 += NTHR) { const int qh = e4 >> 6; const float w0 = wgt[qh * 2], w1 = wgt[qh * 2 + 1];
        const f32x4 p0 = ((const f32x4*)(LATP + (size_t)(2 * sb) * 64 * KVR))[e4], p1 = ((const f32x4*)(LATP + (size_t)(2 * sb + 1) * 64 * KVR))[e4];
        ((LAS f32x4*)latc)[e4] = p0 * w0 + p1 * w1; }
    __syncthreads();
    for (int o = tid; o < 64 * VH; o += NTHR) {
        const int qh = o >> 6, v = o & 63, h = qh >> 3, q = qh & 7;
        const bf16_t* wr = WKVT + (size_t)(512 + h * 64 + v) * KVR;
        float a = 0.f;
        { const LAS f32x4* lc = (const LAS f32x4*)(latc + qh * KVR);
#pragma unroll 8
          for (int c = 0; c < KVR / 8; ++c) { const u32x4 w8 = *(const u32x4*)(wr + 8 * c); const f32x4 l0 = lc[2 * c], l1 = lc[2 * c + 1];
              a += l0.x * __uint_as_float(w8.x << 16) + l0.y * __uint_as_float(w8.x & 0xffff0000u) + l0.z * __uint_as_float(w8.y << 16) + l0.w * __uint_as_float(w8.y & 0xffff0000u)
                 + l1.x * __uint_as_float(w8.z << 16) + l1.y * __uint_as_float(w8.z & 0xffff0000u) + l1.z * __uint_as_float(w8.w << 16) + l1.w * __uint_as_float(w8.w & 0xffff0000u); } }
        for (int j = 0; j < DT; ++j) a += pn[qh * 8 + j] * bf2f(KV[((size_t)MP + sb * DT + j) * 1024 + 512 + h * 64 + v]);
        MIX[(size_t)(MP + sb * DT + q) * DM + 512 + h * 64 + v] = (bf16_t)f2bf(a);
    }
    __syncthreads();
}

DI void attn_s_scores_item(int chunk, int sb, int tid, const float* __restrict__ cache_ckv, const float* __restrict__ cache_kr, const int* __restrict__ page_table, const bf16_t* __restrict__ QB,
                           const bf16_t* __restrict__ CB, const bf16_t* __restrict__ KRB, const float* __restrict__ w_uk, const float* __restrict__ g_k_nope, float* __restrict__ SC) {
    const int key = tid & 127, hq = __builtin_amdgcn_readfirstlane(tid >> 7);
    const bool isnew = chunk == NPAGES;
    if (isnew && key >= DT) return;
    const float* crow = nullptr; const bf16_t* crowb = nullptr; const float* kpf = nullptr; const bf16_t* kpb = nullptr;
    if (!isnew) { const size_t pr = (size_t)page_table[sb * NPAGES + chunk] * PAGE + key; crow = cache_ckv + pr * KVR; kpf = cache_kr + pr * ROPE; }
    else { const size_t rr = (size_t)MP + sb * DT + key; crowb = CB + rr * KVR; kpb = KRB + rr * ROPE; }
    const int jglob = isnew ? PAST + key : chunk * PAGE + key;
    for (int hi = 0; hi < 2; ++hi) {
        const int h = hq * 2 + hi;
        float acc[NOPE];
#pragma unroll
        for (int d = 0; d < NOPE; ++d) acc[d] = 0.f;
        for (int c = 0; c < KVR; ++c) {
            const float cv = isnew ? bf2f(crowb[c]) : crow[c];
            const float* wr = w_uk + (size_t)c * 512 + h * 64;
#pragma unroll
            for (int d = 0; d < NOPE; ++d) acc[d] += cv * wr[d];
        }
        float ss = 0.f;
#pragma unroll
        for (int d = 0; d < NOPE; ++d) ss += acc[d] * acc[d];
        const float ri = rsqrtf(ss * (1.f / 64.f) + EPS);
#pragma unroll 1
        for (int q = 0; q < DT; ++q) {
            const bf16_t* qp = QB + (size_t)(MP + sb * DT + q) * QDIM + h * QKH;
            float s = 0.f;
#pragma unroll
            for (int d = 0; d < NOPE; ++d) s += acc[d] * g_k_nope[d] * bf2f(qp[d]);
            s *= ri;
            for (int r = 0; r < ROPE; ++r) s += (isnew ? bf2f(kpb[r]) : kpf[r]) * bf2f(qp[64 + r]);
            if (isnew && key > q) s = -INFINITY;
            SC[((size_t)sb * 64 + h * 8 + q) * NKEYS + jglob] = s;
        }
    }
}
DI void attn_s_pv_item(int sb, int tid, LAS float* lds, const float* __restrict__ cache_ckv, const int* __restrict__ page_table, const bf16_t* __restrict__ CB, const float* __restrict__ SC,
                       const float* __restrict__ w_uv, float* __restrict__ LAT, bf16_t* __restrict__ MIX) {
    LAS float* p = lds; LAS float* smx = lds + 64 * PAGE; LAS float* sinv = smx + 64;
    const int wid = tid >> 6, lane = tid & 63;
    for (int i = 0; i < 8; ++i) {
        const int qh = wid * 8 + i; const float* s = SC + ((size_t)sb * 64 + qh) * NKEYS;
        float mx = -INFINITY; for (int j = lane; j < NKEYS; j += 64) mx = fmaxf(mx, s[j]);
        mx = wave_max(mx);
        float sum = 0.f; for (int j = lane; j < NKEYS; j += 64) sum += exp2f(s[j] - mx);
        sum = wave_sum(sum);
        if (lane == 0) { smx[qh] = mx; sinv[qh] = 1.f / sum; }
    }
    __syncthreads();
    const int c = tid & 255, half = tid >> 8;
    float lat[32];
#pragma unroll
    for (int i = 0; i < 32; ++i) lat[i] = 0.f;
    for (int chunk = 0; chunk <= NPAGES; ++chunk) {
        const int nk = chunk == NPAGES ? DT : PAGE;
        for (int e = tid; e < 64 * PAGE; e += NTHR) { const int qh = e >> 7, j = e & 127; p[qh * PAGE + j] = j < nk ? exp2f(SC[((size_t)sb * 64 + qh) * NKEYS + chunk * PAGE + j] - smx[qh]) * sinv[qh] : 0.f; }
        __syncthreads();
        for (int j = 0; j < nk; ++j) {
            float cv;
            if (chunk < NPAGES) cv = cache_ckv[((size_t)page_table[sb * NPAGES + chunk] * PAGE + j) * KVR + c];
            else cv = bf2f(CB[((size_t)MP + sb * DT + j) * KVR + c]);
#pragma unroll
            for (int i = 0; i < 32; ++i) lat[i] += p[(half * 32 + i) * PAGE + j] * cv;
        }
        __syncthreads();
    }
    float* L = LAT + (size_t)sb * 64 * KVR;
#pragma unroll
    for (int i = 0; i < 32; ++i) L[(half * 32 + i) * KVR + c] = lat[i];
    __threadfence_block(); __syncthreads();
    for (int o = tid; o < 64 * VH; o += NTHR) {
        const int qh = o >> 6, v = o & 63, h = qh >> 3, q = qh & 7;
        float a = 0.f;
        for (int cc = 0; cc < KVR; ++cc) a += L[qh * KVR + cc] * w_uv[(size_t)cc * 512 + h * 64 + v];
        MIX[(size_t)(MP + sb * DT + q) * DM + 512 + h * 64 + v] = (bf16_t)f2bf(a);
    }
    __syncthreads();
}

enum Phase { PH_PRO = 0, PH_Z0, PH_POST0, PH_KVPOOL, PH_KNORM, PH_ATTN, PH_ATTN2, PH_OUT0, PH_UP0, PH_DN0, PH_RNNIN, PH_CONV, PH_GATES, PH_SCAN, PH_OUTR, PH_UP1, PH_DN1, PH_COUNT };

__global__ void __launch_bounds__(NTHR, 2) mk(Args args) {
    extern __shared__ __attribute__((aligned(16))) unsigned char lds_raw[];
    LAS unsigned char* lds = (LAS unsigned char*)lds_raw;
    volatile LAS unsigned* MISC = (volatile LAS unsigned*)(lds + LDS_MISC);
    const int tid = threadIdx.x, lane = tid & 63, wave = __builtin_amdgcn_readfirstlane(tid >> 6);
    const int G = gridDim.x, bx = blockIdx.x;
    const int gw = bx * NWAVES + wave, NGW = G * NWAVES;
    const int lo = args.ph_lo, hi = args.ph_hi;

    const float* x_prompt = (const float*)args.in[0]; const float* x_sample = (const float*)args.in[1];
    const float* cache_ckv = (const float*)args.in[2]; const float* cache_kr = (const float*)args.in[3];
    const float* state_pool = (const float*)args.in[4]; const float* state_conv = (const float*)args.in[5]; const float* state_lru = (const float*)args.in[6];
    const int* page_table = (const int*)args.in[7];
    const float* norm_mix = (const float*)args.in[8]; const float* w_in_even = (const float*)args.in[9];
    const float* g_q_nope = (const float*)args.in[10]; const float* g_q_rope = (const float*)args.in[11]; const float* g_ckv = (const float*)args.in[12]; const float* g_k_rope = (const float*)args.in[13]; const float* g_k_nope = (const float*)args.in[14];
    const float* w_uk = (const float*)args.in[15]; const float* w_uv = (const float*)args.in[16]; const float* w_pool = (const float*)args.in[17]; const float* pool_scale = (const float*)args.in[18];
    const float* w_out_even = (const float*)args.in[19]; const float* w_in_rnn = (const float*)args.in[20]; const float* conv_w = (const float*)args.in[21]; const float* conv_b = (const float*)args.in[22];
    const float* w_gate_a = (const float*)args.in[23]; const float* b_gate_a = (const float*)args.in[24]; const float* w_gate_x = (const float*)args.in[25]; const float* b_gate_x = (const float*)args.in[26];
    const float* lru_lambda = (const float*)args.in[27]; const float* w_out_rnn = (const float*)args.in[28]; const float* norm_ffn = (const float*)args.in[29]; const float* w_up = (const float*)args.in[30]; const float* w_down = (const float*)args.in[31];
    float* out = args.out; unsigned char* ws = args.ws;
    bf16_t* WIN0T = (bf16_t*)(ws + WS_WIN0T); bf16_t* WKVT = (bf16_t*)(ws + WS_WKVT); bf16_t* WPOOLT = (bf16_t*)(ws + WS_WPOOLT); bf16_t* WGATET = (bf16_t*)(ws + WS_WGATET);
    bf16_t* WOUT0T = (bf16_t*)(ws + WS_WOUT0T); bf16_t* WOUTRT = (bf16_t*)(ws + WS_WOUTRT); bf16_t* WINRT = (bf16_t*)(ws + WS_WINRT); bf16_t* WUPT = (bf16_t*)(ws + WS_WUPT); bf16_t* WDNT = (bf16_t*)(ws + WS_WDNT);
    float* SSQ = (float*)(ws + WS_SSQ); bf16_t* XB = (bf16_t*)(ws + WS_XB); bf16_t* Z0 = (bf16_t*)(ws + WS_Z0); bf16_t* QB = (bf16_t*)(ws + WS_QB); bf16_t* CB = (bf16_t*)(ws + WS_CB); bf16_t* KRB = (bf16_t*)(ws + WS_KRB);
    bf16_t* DBuf = (bf16_t*)(ws + WS_DB); bf16_t* KV = (bf16_t*)(ws + WS_KV); bf16_t* MIX = (bf16_t*)(ws + WS_MIX); bf16_t* H = (bf16_t*)(ws + WS_H); bf16_t* GATE = (bf16_t*)(ws + WS_GATE); bf16_t* U = (bf16_t*)(ws + WS_U);
    bf16_t* V = (bf16_t*)(ws + WS_V); float* Gb = (float*)(ws + WS_G); bf16_t* YB = (bf16_t*)(ws + WS_YB); float* SC = (float*)(ws + WS_SC); float* LAT = (float*)(ws + WS_LAT);
    float* Y = out + O_Y;

    if (tid < 64) MISC[tid] = 0u;
    __syncthreads();
    XcdBarrier bar = xcd_barrier_post((unsigned*)(ws + WS_CTL) + CW_BAR, MISC + 8);
#ifndef PH_MASK
#define PH_MASK 0xFFFFFFFFu
#endif
#define IN(k) (((PH_MASK >> (k)) & 1u) && lo <= (k) && (k) < hi)
#define SEAM(k) do { if (IN(k) && IN((k) + 1)) xcd_barrier(bar); } while (0)
#define STREAM_CTL(ep_) pg8::StreamCtl{(float*)(ws + WS_PART), (unsigned*)(ws + WS_CTL) + CW_SKF, (unsigned*)(ws + WS_CTL) + CW_SKT, (unsigned)(ep_), bx, 0}
#define GEMM_PHASE_STATIC(ep_, Aptr, lda_, atoff_, ashift_, Bptr, M_, N_, K_, FT, ...) do { pg8::Gemm g{Aptr, Bptr, M_, N_, K_, lda_, atoff_, ashift_}; pg8::StaticOrder S; S.init(M_, N_, K_, G, bx); \
        pg8::EpiRows<FT> E{FT{__VA_ARGS__}}; pg8::gemm_phase<false>(lds, g, S, E, STREAM_CTL(ep_)); } while (0)
#define GEMM_PHASE(ep_, Aptr, lda_, atoff_, ashift_, Bptr, M_, N_, K_, FT, ...) do { pg8::Gemm g{Aptr, Bptr, M_, N_, K_, lda_, atoff_, ashift_}; pg8::StaticOrder S; S.init(M_, N_, K_, G, bx); \
        pg8::EpiRows<FT> E{FT{__VA_ARGS__}}; pg8::gemm_phase<false>(lds, g, S, E, STREAM_CTL(ep_)); } while (0)
#define GEMM_PHASE_P8(ep_, Aptr, lda_, Bptr, M_, N_, K_, FT, ...) do { pg8::Gemm g{Aptr, Bptr, M_, N_, K_, lda_, 0, 0}; pg8::StaticOrder S; S.init(M_, N_, K_, G, bx); \
        pg8::EpiRows<FT, false, true> E{FT{__VA_ARGS__}}; pg8::gemm_phase<false>(lds, g, S, E, STREAM_CTL(ep_)); } while (0)
#define GEMM_RESID(Aptr, lda_, Bptr, K_) GEMM_PHASE_P8(0, Aptr, lda_, Bptr, MT, DM, K_, FResid<false>, XB, (float*)nullptr, SSQ)
#define CW_RDY(i) ((unsigned*)(ws + WS_CTL) + 12288 + 64 * (i))
#define GEMM_RESID_SPLIT(Aptr, lda_, Bptr, K_) do { \
        if (G == 256) { pg8::Gemm g{Aptr, Bptr, MT, DM, K_, lda_, 0, 0}; pg8::SplitTailOrder S; S.init(K_, bx); pg8::EpiRows<FResid<false>, false, true> E{FResid<false>{XB, (float*)nullptr, SSQ}}; \
            pg8::gemm_phase<false>(lds, g, S, E, STREAM_CTL(0), EpiPartStore{(float*)(ws + WS_PART), bx & 15}); } \
        else GEMM_RESID(Aptr, lda_, Bptr, K_); } while (0)
#define FIXUP_DEFERRED(i, WAYS_) do { if (G == 256 && bx >= 128) { sample_fixup<false, WAYS_>(bx - 128, (const float*)(ws + WS_PART), XB, (float*)nullptr, SSQ); \
            asm volatile("s_waitcnt vmcnt(0)" ::: "memory"); __syncthreads(); \
            if (tid == 0) { __builtin_amdgcn_fence(__ATOMIC_RELEASE, "agent"); asm volatile("s_waitcnt vmcnt(0)" ::: "memory"); __hip_atomic_fetch_add(CW_RDY(i), 1u, __ATOMIC_RELAXED, __HIP_MEMORY_SCOPE_AGENT); } } } while (0)
#define GEMM_PHASE_P8_RDY(i, ep_, Aptr, lda_, Bptr, M_, N_, K_, FT, ...) do { pg8::Gemm g{Aptr, Bptr, M_, N_, K_, lda_, 0, 0}; if (G == 256) { g.ready = CW_RDY(i); g.ready_target = 128u; } pg8::StaticOrder S; S.init(M_, N_, K_, G, bx); \
        pg8::EpiRows<FT, false, true> E{FT{__VA_ARGS__}}; pg8::gemm_phase<false>(lds, g, S, E, STREAM_CTL(ep_)); } while (0)
#define GEMM_DOWN(Aptr, Bptr, FIN) do { \
        if (G == 256) { pg8::Gemm g{Aptr, Bptr, MT, DM, DFF, DFF, 0, 0}; pg8::SplitTailOrder S; S.init(DFF, bx); pg8::EpiRows<FResid<FIN>, false, true> E{FResid<FIN>{XB, Y, SSQ}}; \
            pg8::gemm_phase<false>(lds, g, S, E, STREAM_CTL(0), EpiPartStore{(float*)(ws + WS_PART), bx & 15}); \
            if (FIN) { xcd_barrier(bar); sample_fixup<FIN>(bx, (const float*)(ws + WS_PART), XB, Y, SSQ); } } \
        else GEMM_PHASE_STATIC(0, Aptr, DFF, 0, 0, Bptr, MT, DM, DFF, FResid<FIN>, XB, Y, SSQ); } while (0)

    if (IN(PH_PRO)) for (int rep_ = 0; rep_ < REPN(10); ++rep_) {
        LAS float* scr = (LAS float*)(lds + wave * 16384);
        constexpr int I0 = 16 * 49, I1 = 4 * 16, I3 = 2 * 4;
        constexpr int NITEMS = I0 + 2 * I1 + 4 * I3;
        for (int it = gw; it < NITEMS; it += NGW) {
            int r = it;
            if (r < I0) { p0_transpose_item(w_in_even, 1568, 1568, WIN0T, DM, norm_mix, scr, r, lane); continue; } r -= I0;
            if (r < I1) { p0_transpose_item(w_uk, 512, 512, WKVT, KVR, nullptr, scr, r, lane); continue; } r -= I1;
            if (r < I1) { p0_transpose_item(w_uv, 512, 512, WKVT + (size_t)512 * KVR, KVR, nullptr, scr, r, lane); continue; } r -= I1;
            { const int g = r / I3; p0_transpose_item(w_pool + (size_t)g * 128 * 128, 128, 128, WPOOLT + (size_t)g * 128 * 256 + (g & 1) * 128, 256, nullptr, scr, r % I3, lane); }
        }
        { u32x4* z0 = (u32x4*)(WIN0T + (size_t)1568 * DM); const u32x4 zz = {0u, 0u, 0u, 0u};
          for (int e = bx * NTHR + tid; e < (NZ0 - 1568) * DM / 8; e += G * NTHR) z0[e] = zz;
          for (int e = bx * NTHR + tid; e < 512 * 16; e += G * NTHR) { const int n = e >> 4, c8 = e & 15; *(u32x4*)(WPOOLT + (size_t)n * 256 + (1 - ((n >> 7) & 1)) * 128 + c8 * 8) = zz; }
          for (int e = bx * NTHR + tid; e < 2048 * 16; e += G * NTHR) { const int n = e >> 4, c8 = e & 15; *(u32x4*)(WGATET + (size_t)n * 256 + (1 - ((n >> 8) & 1)) * 128 + c8 * 8) = zz; } }
        { float* ROPET = (float*)(ws + WS_ROPE);
          for (int e = bx * NTHR + tid; e < (SEQ + DT) * 16; e += G * NTHR) { const int pi = e >> 4, i = e & 15; const int pos = pi < SEQ ? pi : PAST + (pi - SEQ);
              const float inv = powf(10000.0f, -(float)i / 16.0f); const float ang = (float)pos * inv; ROPET[e * 2] = cosf(ang); ROPET[e * 2 + 1] = sinf(ang); } }
        if (bx == G - 1) for (int c = tid; c < DM; c += NTHR) ((float*)(ws + WS_SP8))[c] = log1pf(expf(-lru_lambda[c])) * (8.0f * 1.4426950408889634f);
        {
#define XROW(r_) ((r_) < MP ? x_prompt + (size_t)(r_) * DM : x_sample + (size_t)((r_) - MP) * DM)
            f32x4 nv[4]; if (gw < MT) rowprep_load(XROW(gw), lane, nv);
            for (int row = gw; row < MT; row += NGW) { f32x4 v[4];
#pragma unroll
                for (int j = 0; j < 4; ++j) v[j] = nv[j];
                const int nr = row + NGW; if (nr < MT) rowprep_load(XROW(nr), lane, nv);
                rowprep_row(v, row, XB, SSQ, lane); }
#undef XROW
        }
    }
    SEAM(PH_PRO);
    if (REP_ID == 40) { for (int i = 0; i < 10; ++i) xcd_barrier(bar); }
    if (IN(PH_Z0)) for (int rep_ = 0; rep_ < REPN(1); ++rep_) GEMM_PHASE_P8(1, XB, DM, WIN0T, MT, NZ0, DM, FZ0, SSQ, Z0);
    SEAM(PH_Z0);
    if (IN(PH_POST0)) for (int rep_ = 0; rep_ < REPN(2); ++rep_) {
        const float* ROPET = (const float*)(ws + WS_ROPE);
        for (int row = gw; row < MT; row += NGW) post0_row(row, lane, Z0, ROPET, g_q_nope, g_q_rope, g_ckv, g_k_rope, QB, CB, KRB, out);
        for (int it = bx * NTHR + tid; it < (MP / 16) * 64; it += G * NTHR) pool_item_p16((it >> 6) * 16, (it & 63) * 8, Z0, DBuf, out);
        for (int it = bx * NTHR + tid; it < DB_ * 64; it += G * NTHR) pool_item_s8(it >> 6, (it & 63) * 8, Z0, state_pool, DBuf, out);
    }
    SEAM(PH_POST0);
    if (IN(PH_KVPOOL) && REP_ID == 13) { GEMM_PHASE(14, CB, KVR, 0, 0, WKVT, MT, 1024, KVR, FRawBf16<1024>, (bf16_t*)(ws + WS_DBG)); GEMM_PHASE_STATIC(15, DBuf, POOLD, 256, 0, WPOOLT, MT, POOLD, 256, FPool, pool_scale, MIX); }
    if (IN(PH_KVPOOL)) {
        { pg8::Gemm g{CB, WKVT, MT, 1024, KVR, KVR, 0, 0}; pg8::StaticOrder S; S.init(MT, 1024, KVR, G, bx); pg8::EpiRows<FKvNorm, true, true> E{FKvNorm{KV, g_k_nope}}; pg8::gemm_phase<false>(lds, g, S, E, STREAM_CTL(2)); }
        { pg8::Gemm g{DBuf, WPOOLT, MT, POOLD, 256, POOLD, 256, 0}; pg8::StaticOrder S; S.init(MT, POOLD, 256, G, (G == 256) ? ((bx + 240) & 255) : bx); pg8::EpiRows<FPool, false, true> E{FPool{pool_scale, MIX}}; pg8::gemm_phase<false>(lds, g, S, E, STREAM_CTL(3)); }
    }
#if DBG_KNORM
    if (IN(PH_KVPOOL)) GEMM_PHASE_STATIC(16, CB, KVR, 0, 0, WKVT, MT, 1024, KVR, FRawBf16<1024>, (bf16_t*)(ws + WS_DBG));
#endif
    if (IN(PH_KVPOOL) && MERGE_ATTN2 && G == 256 && bx >= 152) {
        __syncthreads();
        LAS float* scr = (LAS float*)(lds + wave * 16384);
        for (int it = (bx - 152) * NWAVES + wave; it < 16 * 32; it += (G - 152) * NWAVES) p0_transpose_item(w_out_even, DM, DM, WOUT0T, DM, nullptr, scr, it, lane);
    }
    SEAM(PH_KVPOOL);
#if DBG_KNORM
    if (IN(PH_KNORM)) { const bf16_t* R = (const bf16_t*)(ws + WS_DBG); unsigned bad = 0;
        for (int row = gw; row < MT; row += NGW) {
            for (int h = 0; h < NH; ++h) { const float x = bf2f(R[(size_t)row * 1024 + h * 64 + lane]); const float ss = wave_sum(x * x); const float y = x * rsqrtf(ss * (1.f / 64.f) + EPS) * g_k_nope[lane];
                const float a = bf2f(KV[(size_t)row * 1024 + h * 64 + lane]); if (!(fabsf(a - y) <= 0.02f + 0.02f * fabsf(y))) ++bad; }
            for (int c = lane; c < 512; c += 64) { const float y = bf2f(R[(size_t)row * 1024 + 512 + c]), a = bf2f(KV[(size_t)row * 1024 + 512 + c]); if (!(fabsf(a - y) <= 1e-3f + 0.01f * fabsf(y))) ++bad; } }
        if (bad) atomicAdd((unsigned*)(ws + WS_CTL) + CW_DBG, bad); }
#endif
    if (IN(PH_ATTN)) {
        LAS float* sc = (LAS float*)(lds + wave * 16768);
#if DBG_ATTN_P
        for (int it = gw; it < MP * NH; it += NGW) attn_p_naive_item(it, lane, sc, QB, KV, KRB, (bf16_t*)(ws + WS_DBG));
        __syncthreads();
#endif
#ifndef NO_ATTN_P
        { const int vcu = (G % 8 == 0) ? (bx % 8) * (G / 8) + bx / 8 : bx;
          for (int rep_ = 0; rep_ < REPN(3); ++rep_) for (int pi = vcu; pi < 256; pi += G) { const int bh = pi >> 3, s8 = pi & 7; attn_p_unit(bh >> 3, bh & 7, 15 - s8, lds, QB, KV, KRB, MIX); attn_p_unit(bh >> 3, bh & 7, s8, lds, QB, KV, KRB, MIX); }
          asm volatile("s_waitcnt vmcnt(0)" ::: "memory"); __syncthreads(); }
#endif
#if DBG_ATTN_S
        for (int it = bx; it < (NPAGES + 1) * DB_; it += G) attn_s_scores_item(it % (NPAGES + 1), it / (NPAGES + 1), tid, cache_ckv, cache_kr, page_table, QB, CB, KRB, w_uk, g_k_nope, SC);
        __syncthreads();
#endif
        if (REP_ID >= 20 && REP_ID <= 24) for (int u = bx; u < 2 * DB_; u += G) attn_s_unit<(REP_ID >= 20 && REP_ID <= 24) ? REP_ID - 19 : 1>(u, lds, cache_ckv, cache_kr, page_table, QB, WKVT, g_k_nope, (float*)(ws + WS_DBG), (float*)(ws + WS_DBG + 40 * MiB));
        for (int rep_ = 0; rep_ < REPN(4); ++rep_) for (int u = bx; u < 2 * DB_; u += G) attn_s_unit<0>(u, lds, cache_ckv, cache_kr, page_table, QB, WKVT, g_k_nope, (float*)(ws + WS_LATP), (float*)(ws + WS_ML));
        asm volatile("s_waitcnt vmcnt(0)" ::: "memory"); __syncthreads();
    }
    SEAM(PH_ATTN);
#if DBG_ATTN_P
    if (IN(PH_ATTN2)) {
        const bf16_t* R = (const bf16_t*)(ws + WS_DBG); unsigned bad = 0;
        for (size_t i = (size_t)bx * NTHR + tid; i < (size_t)MP * 512; i += (size_t)G * NTHR) { const size_t row = i >> 9, c = 512 + (i & 511); const float a = bf2f(MIX[row * DM + c]), r = bf2f(R[row * DM + c]);
            if (!(fabsf(a - r) <= 0.01f + 0.02f * fabsf(r))) ++bad; }
        if (bad) atomicAdd((unsigned*)(ws + WS_CTL) + CW_DBG, bad);
    }
#endif
    if (IN(PH_ATTN2) && !(MERGE_ATTN2 && G == 256)) { __syncthreads();
#if DBG_ATTN_S
        for (int sb = bx; sb < DB_; sb += G) attn_s_pv_item(sb, tid, (LAS float*)lds, cache_ckv, page_table, CB, SC, w_uv, LAT, (bf16_t*)(ws + WS_DBG));
        __syncthreads();
#endif
        for (int sb = bx; sb < DB_; sb += G) attn_s_combine(sb, lds, QB, KV, KRB, WKVT, (const float*)(ws + WS_LATP), (const float*)(ws + WS_ML), MIX);
#if DBG_ATTN_S
        asm volatile("s_waitcnt vmcnt(0)" ::: "memory"); __syncthreads();
        { const bf16_t* R = (const bf16_t*)(ws + WS_DBG); unsigned bad = 0; float num_ = 0.f, den_ = 0.f;
          for (int sb = bx; sb < DB_; sb += G) for (int i = tid; i < DT * 512; i += NTHR) { const size_t row = (size_t)MP + sb * DT + (i >> 9), c = 512 + (i & 511); const float a = bf2f(MIX[row * DM + c]), r = bf2f(R[row * DM + c]);
              num_ += (a - r) * (a - r); den_ += r * r; if (!(fabsf(a - r) <= 0.02f + 0.5f * fabsf(r))) ++bad; }
          if (bad) atomicAdd((unsigned*)(ws + WS_CTL) + CW_DBG, bad);
          num_ = wave_sum(num_); den_ = wave_sum(den_); if (lane == 0) { atomicAdd((float*)(ws + WS_CTL) + CW_DBG + 2, num_); atomicAdd((float*)(ws + WS_CTL) + CW_DBG + 3, den_); } }
#endif
    }
    if (IN(PH_ATTN2) && !(MERGE_ATTN2 && G == 256) && bx >= DB_) {
        LAS float* scr = (LAS float*)(lds + wave * 16384);
        for (int it = (bx - DB_) * NWAVES + wave; it < 16 * 32; it += (G - DB_) * NWAVES) p0_transpose_item(w_out_even, DM, DM, WOUT0T, DM, nullptr, scr, it, lane);
        if (G == 256) for (int it = (bx - DB_) * NWAVES + wave; it < 16 * 128; it += (G - DB_) * NWAVES) p0_transpose_item(w_up, DFF, DFF, WUPT, DM, norm_ffn, scr, it, lane);
    }
    if (!(MERGE_ATTN2 && G == 256)) SEAM(PH_ATTN2);
    if (IN(PH_OUT0)) {
        if (MERGE_ATTN2 && G == 256) {
            __syncthreads();
            if (bx >= DB_) { attn_s_combine(bx - DB_, lds, QB, KV, KRB, WKVT, (const float*)(ws + WS_LATP), (const float*)(ws + WS_ML), MIX);
                asm volatile("s_waitcnt vmcnt(0)" ::: "memory"); __syncthreads();
                if (tid == 0) { __builtin_amdgcn_fence(__ATOMIC_RELEASE, "agent"); asm volatile("s_waitcnt vmcnt(0)" ::: "memory"); __hip_atomic_fetch_add(CW_RDY(7), 1u, __ATOMIC_RELAXED, __HIP_MEMORY_SCOPE_AGENT); } }
            else { LAS float* scr = (LAS float*)(lds + wave * 16384);
                for (int it = bx * NWAVES + wave; it < 16 * 128; it += DB_ * NWAVES) p0_transpose_item(w_up, DFF, DFF, WUPT, DM, norm_ffn, scr, it, lane); }
            asm volatile("s_waitcnt vmcnt(0)" ::: "memory"); __syncthreads();
            pg8::Gemm g{MIX, WOUT0T, MT, DM, DM, DM, 0, 0}; g.ready = CW_RDY(7); g.ready_target = (unsigned)DB_; pg8::SplitTailOrder S; S.init(DM, bx); pg8::EpiRows<FResid<false>, false, true> E{FResid<false>{XB, (float*)nullptr, SSQ}};
            pg8::gemm_phase<false>(lds, g, S, E, STREAM_CTL(0), EpiPartStore{(float*)(ws + WS_PART), bx & 15});
        } else GEMM_RESID_SPLIT(MIX, DM, WOUT0T, DM);
    }
    if (IN(PH_OUT0) && G != 256) {
        const int gw2 = bx * NWAVES + wave, NGW2 = G * NWAVES;
        LAS float* scr = (LAS float*)(lds + wave * 16384);
        constexpr int I8 = 16 * 128, I10 = 64 * 32;
        for (int it = gw2; it < I8 + I10; it += NGW2) {
            if (it < I8) p0_transpose_item(w_up, DFF, DFF, WUPT, DM, norm_ffn, scr, it, lane);
            else p0_transpose_item(w_down, DM, DM, WDNT, DFF, nullptr, scr, it - I8, lane);
        }
    }
    SEAM(PH_OUT0);
    if (IN(PH_UP0) && REP_ID == 30) GEMM_PHASE(30, XB, DM, 0, 0, WUPT, MT, DFF, DM, FNull, (float*)(ws + WS_DBG));
    if (IN(PH_UP0)) { FIXUP_DEFERRED(0, 8); GEMM_PHASE_P8_RDY(0, 5, XB, DM, WUPT, MT, DFF, DM, FUp, SSQ, H); }
    if (IN(PH_UP0)) {
        const int nidle = G - 64;
        if (G == 256 ? (bx >= 64) : true) {
            const int gw2 = (G == 256 ? (bx - 64) : bx) * NWAVES + wave, NGW2 = (G == 256 ? nidle : G) * NWAVES;
            LAS float* scr = (LAS float*)(lds + wave * 16384);
            constexpr int I3 = 2 * 4, I7 = 16 * 32, I8 = 16 * 128, I10 = 64 * 32, I12 = 16 * 64;
            constexpr int NIT2 = I8 + I10 + I12 + 16 * I3 + I7;
            if (G == 256) for (int it = gw2; it < I10; it += NGW2) p0_transpose_item(w_down, DM, DM, WDNT, DFF, nullptr, scr, it, lane);
            for (int it = gw2; it < NIT2; it += NGW2) {
                int r = it;
                if (r < I8) { p0_transpose_item(w_up + (size_t)DM * DFF, DFF, DFF, WUPT + (size_t)DFF * DM, DM, norm_ffn + DM, scr, r, lane); continue; } r -= I8;
                if (r < I10) { p0_transpose_item(w_down + (size_t)DFF * DM, DM, DM, WDNT + (size_t)DM * DFF, DFF, nullptr, scr, r, lane); continue; } r -= I10;
                if (r < I12) { p0_transpose_item(w_in_rnn, 2048, 2048, WINRT, DM, norm_mix + DM, scr, r, lane); continue; } r -= I12;
                if (r < 16 * I3) { const int q = r / I3, n = q >> 1, isx = q & 1; const float* src = (isx ? w_gate_x : w_gate_a) + (size_t)n * 128 * 128;
                    p0_transpose_item(src, 128, 128, WGATET + (size_t)(n * 256 + isx * 128) * 256 + (n & 1) * 128, 256, nullptr, scr, r % I3, lane); continue; } r -= 16 * I3;
                p0_transpose_item(w_out_rnn, DM, DM, WOUTRT, DM, nullptr, scr, r, lane);
            }
        }
    }
    SEAM(PH_UP0);
    if (IN(PH_DN0)) GEMM_DOWN(H, WDNT, false);
    SEAM(PH_DN0);
    if (IN(PH_RNNIN)) { FIXUP_DEFERRED(1, 16); GEMM_PHASE_P8_RDY(1, 7, XB, DM, WINRT, MT, 2048, DM, FRnnIn, SSQ, GATE, U); }
    SEAM(PH_RNNIN);
    if (IN(PH_CONV)) for (int rep_ = 0; rep_ < REPN(12); ++rep_) {
        for (int it = bx * NTHR + tid; it < (MP / 16) * 128; it += G * NTHR) conv_item_p16((it >> 7) * 16, (it & 127) * 8, U, conv_w, conv_b, V, out);
        for (int it = bx * NTHR + tid; it < DB_ * 128; it += G * NTHR) conv_item_s8(it >> 7, (it & 127) * 8, U, state_conv, conv_w, conv_b, V, out);
    }
    SEAM(PH_CONV);
    if (IN(PH_GATES)) for (int rep_ = 0; rep_ < REPN(9); ++rep_) { pg8::Gemm g{V, WGATET, MT, 2048, 256, DM, 256, 1}; pg8::StaticOrder S; S.init(G == 256 ? MP : MT, 2048, 256, G, bx);
        EpiGates E{V, b_gate_a, b_gate_x, (const float*)(ws + WS_SP8), (bf16_t*)(ws + WS_HL), (bf16_t*)(ws + WS_AC), (float*)(ws + WS_SUM)}; pg8::gemm_phase<false>(lds, g, S, E, STREAM_CTL(8)); }
    SEAM(PH_GATES);
    if (IN(PH_SCAN)) for (int rep_ = 0; rep_ < REPN(11); ++rep_) {
        const bf16_t* HL = (const bf16_t*)(ws + WS_HL); const bf16_t* AC = (const bf16_t*)(ws + WS_AC); const float* SUM = (const float*)(ws + WS_SUM);
        for (int idx = bx * NTHR + tid; idx < 256 * 4 * 128; idx += G * NTHR) {
            const int wv_ = __builtin_amdgcn_readfirstlane(idx >> 6), b_ = wv_ >> 3, sq = (b_ & 7) + 8 * (wv_ & 7), segp = ((b_ >> 3) & 3) * 64 + sq, cg = (b_ >> 5) * 16 + (idx & 15), qt = (idx >> 4) & 3, ch = cg * 8;
            u32x4 rhl[2][8], rac[2][8], rgt[2][8];
#define SCAN_LD(bt_) do { _Pragma("unroll") for (int t = 0; t < 8; ++t) { const size_t off = (size_t)(segp * 64 + qt * 16 + (bt_) * 8 + t) * DM + ch; rhl[bt_][t] = *(const u32x4*)(HL + off); rac[bt_][t] = *(const u32x4*)(AC + off); rgt[bt_][t] = *(const u32x4*)(GATE + off); } } while (0)
            SCAN_LD(0);
            float h[8];
#pragma unroll
            for (int e = 0; e < 8; ++e) h[e] = 0.f;
            if (qt == 0)
#pragma unroll 4
            for (int k = 0; k < sq; ++k) {
                const f32x4* sp4 = (const f32x4*)(SUM + ((size_t)(segp - sq + k) * DM + ch) * 2);
                const f32x4 s0 = sp4[0], s1 = sp4[1], s2 = sp4[2], s3 = sp4[3];
                h[0] = s0.x * h[0] + s0.y; h[1] = s0.z * h[1] + s0.w; h[2] = s1.x * h[2] + s1.y; h[3] = s1.z * h[3] + s1.w;
                h[4] = s2.x * h[4] + s2.y; h[5] = s2.z * h[5] + s2.w; h[6] = s3.x * h[6] + s3.y; h[7] = s3.z * h[7] + s3.w;
            }
#pragma unroll
            for (int e = 0; e < 8; ++e) h[e] = __int_as_float(__builtin_amdgcn_ds_bpermute((idx & 15) * 4, __float_as_int(h[e])));
            SCAN_LD(1);
#undef SCAN_LD
#pragma unroll
            for (int t = 0; t < 16; ++t) {
                const size_t off = (size_t)(segp * 64 + qt * 16 + t) * DM + ch;
                const u32x4 hl = rhl[t >> 3][t & 7], ac = rac[t >> 3][t & 7], gt = rgt[t >> 3][t & 7];
                float hv[8]; u32x4 o;
#pragma unroll
                for (int e2 = 0; e2 < 4; ++e2) {
                    hv[2 * e2] = __uint_as_float(hl[e2] << 16) + __uint_as_float(ac[e2] << 16) * h[2 * e2];
                    hv[2 * e2 + 1] = __uint_as_float(hl[e2] & 0xffff0000u) + __uint_as_float(ac[e2] & 0xffff0000u) * h[2 * e2 + 1];
                    o[e2] = pk2(__uint_as_float(gt[e2] << 16) * hv[2 * e2], __uint_as_float(gt[e2] & 0xffff0000u) * hv[2 * e2 + 1]);
                }
                *(u32x4*)(YB + off) = o;
                if (sq == 63 && qt == 3 && t == 15) {
#pragma unroll
                    for (int e = 0; e < 8; ++e) out[O_LRU_P + (size_t)(segp >> 6) * DM + ch + e] = hv[e];
                }
            }
        }
        if (G == 256) { for (int item = bx + G * (wave >> 2); item < (DB_ / 2) * 8; item += 2 * G) gates_sample_item(item, wave & 3, lane, V, WGATET, b_gate_a, b_gate_x, (const float*)(ws + WS_SP8), GATE, state_lru, YB, out); }
        else
        for (int idx = bx * NTHR + tid; idx < DB_ * 128; idx += G * NTHR) {
            const int cg = idx & 127, sb = idx >> 7, ch = cg * 8;
            float h[8];
#pragma unroll
            for (int e = 0; e < 8; ++e) h[e] = state_lru[(size_t)sb * DM + ch + e];
            for (int t = 0; t < DT; ++t) {
                const size_t off = (size_t)(MP + sb * DT + t) * DM + ch;
                const u32x4 hl = *(const u32x4*)(HL + off), ac = *(const u32x4*)(AC + off), gt = *(const u32x4*)(GATE + off);
                float hv[8]; u32x4 o;
#pragma unroll
                for (int e2 = 0; e2 < 4; ++e2) {
                    hv[2 * e2] = __uint_as_float(hl[e2] << 16) + __uint_as_float(ac[e2] << 16) * h[2 * e2];
                    hv[2 * e2 + 1] = __uint_as_float(hl[e2] & 0xffff0000u) + __uint_as_float(ac[e2] & 0xffff0000u) * h[2 * e2 + 1];
                    o[e2] = pk2(__uint_as_float(gt[e2] << 16) * hv[2 * e2], __uint_as_float(gt[e2] & 0xffff0000u) * hv[2 * e2 + 1]);
                }
                *(u32x4*)(YB + off) = o;
                if (t == DT - 1) {
#pragma unroll
                    for (int e = 0; e < 8; ++e) out[O_LRU_S + (size_t)sb * DM + ch + e] = hv[e];
                }
            }
        }
    }
    SEAM(PH_SCAN);
    if (IN(PH_OUTR)) GEMM_RESID_SPLIT(YB, DM, WOUTRT, DM);
    SEAM(PH_OUTR);
    if (IN(PH_UP1)) { FIXUP_DEFERRED(2, 8); GEMM_PHASE_P8_RDY(2, 10, XB, DM, WUPT + (size_t)DFF * DM, MT, DFF, DM, FUp, SSQ, H); }
    SEAM(PH_UP1);
#if DBG_ANY
    if (IN(PH_DN1)) { const float n_ = __hip_atomic_load((float*)(ws + WS_CTL) + CW_DBG + 2, __ATOMIC_RELAXED, __HIP_MEMORY_SCOPE_AGENT), d_ = __hip_atomic_load((float*)(ws + WS_CTL) + CW_DBG + 3, __ATOMIC_RELAXED, __HIP_MEMORY_SCOPE_AGENT);
        if ((__hip_atomic_load((unsigned*)(ws + WS_CTL) + CW_DBG, __ATOMIC_RELAXED, __HIP_MEMORY_SCOPE_AGENT) != 0u || n_ > DBG_RVR * d_) && bx == 0 && tid == 0) out[O_LRU_S] = __builtin_nanf(""); }
#endif
    if (IN(PH_DN1)) GEMM_DOWN(H, WDNT + (size_t)DM * DFF, true);
#undef IN
#undef SEAM
#undef GEMM_PHASE
}

#ifndef MK_ONE
#define MK_ONE 1
#endif
extern "C" void kernel_launch(void* const* d_in, const int* in_sizes, int n_in, void* d_out, int out_size, void* d_ws, size_t ws_size, hipStream_t stream) {
    (void)in_sizes; (void)out_size;
    static int grid = 0;
    if (grid == 0) {
        if (n_in != 32 || ws_size < WS_END) { fprintf(stderr, "kernel_launch: unexpected inputs / workspace\n"); grid = -1; return; }
        int dev = 0, cus = 0, per_cu = 0;
        if (hipGetDevice(&dev) != hipSuccess || hipDeviceGetAttribute(&cus, hipDeviceAttributeMultiprocessorCount, dev) != hipSuccess) { grid = -1; return; }
        if (hipFuncSetAttribute((const void*)mk, hipFuncAttributeMaxDynamicSharedMemorySize, LDS_BYTES) != hipSuccess) { fprintf(stderr, "kernel_launch: hipFuncSetAttribute failed\n"); grid = -1; return; }
        if (hipOccupancyMaxActiveBlocksPerMultiprocessor(&per_cu, (const void*)mk, NTHR, LDS_BYTES) != hipSuccess || per_cu < 1) { fprintf(stderr, "kernel_launch: occupancy query reports %d\n", per_cu); }
        (void)hipGetLastError();
        grid = cus;
    }
    if (grid < 0) return;
    unsigned char* ws = (unsigned char*)d_ws;
    (void)hipMemsetAsync(ws + WS_CTL, 0, CTL_ZERO_BYTES, stream);
    Args a{};
    for (int i = 0; i < 32; ++i) a.in[i] = d_in[i];
    a.out = (float*)d_out; a.ws = ws;
#if MK_ONE
    a.ph_lo = 0; a.ph_hi = PH_COUNT;
    hipLaunchKernelGGL(mk, dim3(grid), dim3(NTHR), LDS_BYTES, stream, a);
#else
    for (int p = 0; p < PH_COUNT; ++p) { a.ph_lo = p; a.ph_hi = p + 1; hipLaunchKernelGGL(mk, dim3(grid), dim3(NTHR), LDS_BYTES, stream, a); }
#endif
}
```
